# Optimizing an MI355X kernel written in HIP

```python
import jax, jax.numpy as jnp
from jax import lax
import numpy as np

D_MODEL = 2048
BATCH = 8
SEQ = 2048
DEPTH = 1

HEAD_DIM = 128
D_MIX = D_MODEL
N_HEADS_DIL = (D_MIX // 2) // HEAD_DIM
D_DIL = N_HEADS_DIL * HEAD_DIM
DIL_PATTERNS = ((128, 1), (512, 4), (2048, 16))
BLOCK = 128
V_HEAD = 128
N_HEADS_MLA = (D_MIX - D_DIL) // V_HEAD
D_MLA = N_HEADS_MLA * V_HEAD
Q_LORA = 512
KV_LORA = 512
QK_NOPE = 128
QK_ROPE = 64
ROPE_THETA = 10000.0
D_IN = 3 * D_DIL + Q_LORA + KV_LORA + QK_ROPE
IN_SPLITS = [D_DIL, 2 * D_DIL, 3 * D_DIL, 3 * D_DIL + Q_LORA, 3 * D_DIL + Q_LORA + KV_LORA]
PEER_HEADS = 8
PEER_NKEYS = 128
PEER_N = PEER_NKEYS * PEER_NKEYS
PEER_QDIM = 256
PEER_TOPK = 16
PEER_CHUNK = 128
PEER_V_STD = 0.5

EPS = 1e-6
NEG = -1e30
f32 = jnp.float32

kernel_name = "hymba_dilated_mla_peer_block"


def rmsnorm(x, g):
    xf = x.astype(f32)
    y = xf * lax.rsqrt(jnp.mean(xf * xf, axis=-1, keepdims=True) + EPS)
    return (y * g.astype(f32)).astype(x.dtype)


def alibi_slopes(n):
    return 2.0 ** (-8.0 * jnp.arange(1, n + 1, dtype=f32) / n)


def rope(x, pos):
    half = x.shape[-1] // 2
    freqs = ROPE_THETA ** (-jnp.arange(half, dtype=f32) / half)
    ang = pos.astype(f32)[:, None] * freqs[None, :]
    cos, sin = jnp.cos(ang), jnp.sin(ang)
    x1, x2 = x[..., :half].astype(f32), x[..., half:].astype(f32)
    return jnp.concatenate([x1 * cos - x2 * sin, x1 * sin + x2 * cos], axis=-1).astype(x.dtype)


def dilated_window_attn(q, k, v, slopes, window, dilation):
    b, h, s, hd = q.shape
    steps = window // dilation
    L = s // dilation

    def split(t):
        return t.reshape(b, h, L, dilation, hd).transpose(0, 1, 3, 2, 4)

    nb = -(-L // BLOCK)
    pad = nb * BLOCK - L
    padcfg = ((0, 0), (0, 0), (0, 0), (0, pad), (0, 0))
    qs = jnp.pad(split(q), padcfg).reshape(b, h, dilation, nb, BLOCK, hd)
    ks = jnp.pad(split(k), padcfg).reshape(b, h, dilation, nb, BLOCK, hd)
    vs = jnp.pad(split(v), padcfg).reshape(b, h, dilation, nb, BLOCK, hd)

    def with_prev(t):
        prev = jnp.pad(t, ((0, 0), (0, 0), (0, 0), (1, 0), (0, 0), (0, 0)))[:, :, :, :-1]
        return jnp.concatenate([prev, t], axis=4)

    kb, vb = with_prev(ks), with_prev(vs)
    sc = jnp.einsum('bhrnqd,bhrnkd->bhrnqk', qs, kb).astype(f32) * (hd ** -0.5)
    qi = jnp.arange(BLOCK)[:, None]
    kj = jnp.arange(2 * BLOCK)[None, :]
    delta = qi + BLOCK - kj
    key_idx = jnp.arange(nb)[:, None, None] * BLOCK - BLOCK + kj
    valid = (delta >= 0) & (delta <= steps) & (key_idx >= 0)
    bias = -slopes[:, None, None, None, None] * (delta * dilation).astype(f32)
    sc = jnp.where(valid, sc + bias, NEG)
    m = jnp.max(sc, axis=-1, keepdims=True)
    p = jnp.exp(sc - m)
    l = jnp.sum(p, axis=-1, keepdims=True)
    o = jnp.einsum('bhrnqk,bhrnkd->bhrnqd', (p / l).astype(v.dtype), vb)
    lse = (m + jnp.log(l))[..., 0]

    def merge(t):
        t = t.reshape(b, h, dilation, nb * BLOCK, *t.shape[5:])[:, :, :, :L]
        t = jnp.moveaxis(t, 2, 3)
        return t.reshape(b, h, s, *t.shape[4:])

    return merge(o), merge(lse)


def dilated_mixture_attention(q, k, v, slopes):
    res = [dilated_window_attn(q, k, v, slopes, w, d) for (w, d) in DIL_PATTERNS]
    outs = jnp.stack([r[0] for r in res], 0).astype(f32)
    lses = jnp.stack([r[1] for r in res], 0)
    wts = jax.nn.softmax(lses, axis=0)
    return jnp.einsum('pbhs,pbhsd->bhsd', wts, outs).astype(q.dtype)


def causal_block_attention(q, k, v, scale):
    b, h, s, dq = q.shape
    nblk = s // BLOCK
    qb = q.reshape(b, h, nblk, BLOCK, dq).transpose(2, 0, 1, 3, 4)
    kpos = jnp.arange(s)

    def one(args):
        qi, i = args
        sc = jnp.einsum('bhqd,bhkd->bhqk', qi, k).astype(f32) * scale
        qpos = i * BLOCK + jnp.arange(BLOCK)
        sc = jnp.where(kpos[None, :] <= qpos[:, None], sc, NEG)
        p = jax.nn.softmax(sc, axis=-1)
        return jnp.einsum('bhqk,bhkd->bhqd', p.astype(v.dtype), v)

    o = lax.map(one, (qb, jnp.arange(nblk)))
    return o.transpose(1, 2, 0, 3, 4).reshape(b, h, s, v.shape[-1])


def mla_attention(c_q, c_kv, k_rope, q_a_norm, kv_a_norm, w_uq, w_ukv, pos):
    b, s, _ = c_q.shape
    H = N_HEADS_MLA
    q = (rmsnorm(c_q, q_a_norm) @ w_uq).reshape(b, s, H, QK_NOPE + QK_ROPE).transpose(0, 2, 1, 3)
    kv = (rmsnorm(c_kv, kv_a_norm) @ w_ukv).reshape(b, s, H, QK_NOPE + V_HEAD).transpose(0, 2, 1, 3)
    q_nope, q_pe = q[..., :QK_NOPE], q[..., QK_NOPE:]
    k_nope, v = kv[..., :QK_NOPE], kv[..., QK_NOPE:]
    q_pe = rope(q_pe, pos)
    k_pe = jnp.broadcast_to(rope(k_rope, pos)[:, None], (b, H, s, QK_ROPE))
    qf = jnp.concatenate([q_nope, q_pe], axis=-1)
    kf = jnp.concatenate([k_nope, k_pe], axis=-1)
    o = causal_block_attention(qf, kf, v, (QK_NOPE + QK_ROPE) ** -0.5)
    return o.transpose(0, 2, 1, 3).reshape(b, s, D_MLA)


def peer_ffn(xn, w_pq, sub_keys, peer_u, peer_v):
    b, s, d = xn.shape
    T = b * s
    t = xn.reshape(T, d)
    q = (t @ w_pq).reshape(T, PEER_HEADS, 2, PEER_QDIM // 2)
    sc = jnp.einsum('thpc,hpnc->thpn', q, sub_keys).astype(f32)
    top_s, top_i = lax.top_k(sc, PEER_TOPK)
    cand_s = (top_s[:, :, 0, :, None] + top_s[:, :, 1, None, :]).reshape(T, PEER_HEADS, PEER_TOPK * PEER_TOPK)
    cand_i = (top_i[:, :, 0, :, None] * PEER_NKEYS + top_i[:, :, 1, None, :]).reshape(T, PEER_HEADS, PEER_TOPK * PEER_TOPK)
    best_s, best_p = lax.top_k(cand_s, PEER_TOPK)
    idx = jnp.take_along_axis(cand_i, best_p, axis=-1).reshape(T, PEER_HEADS * PEER_TOPK)
    gate = jax.nn.softmax(best_s, axis=-1).reshape(T, PEER_HEADS * PEER_TOPK)
    nchunk = T // PEER_CHUNK

    def expert_chunk(args):
        xc, ic, gc = args
        u = jnp.take(peer_u, ic, axis=0)
        a = jax.nn.gelu(jnp.einsum('cd,ced->ce', xc, u).astype(f32), approximate=False) * gc
        vsel = jnp.take(peer_v, ic, axis=0)
        return jnp.einsum('ce,ced->cd', a.astype(vsel.dtype), vsel)

    y = lax.map(expert_chunk, (t.reshape(nchunk, PEER_CHUNK, d),
                               idx.reshape(nchunk, PEER_CHUNK, -1),
                               gate.reshape(nchunk, PEER_CHUNK, -1)))
    return y.reshape(b, s, d)


def setup_inputs(seed: int = 0) -> dict:
    key = jax.random.key(seed)
    ks = jax.random.split(key, 20)
    nrm = lambda k, shape, std: jax.random.normal(k, shape, f32) * std
    gain = lambda k, shape: 1.0 + 0.02 * jax.random.normal(k, shape, f32)
    return {
        "x": nrm(ks[0], (BATCH, SEQ, D_MODEL), 1.0),
        "ln1_g": gain(ks[1], (DEPTH, D_MODEL)),
        "w_in": nrm(ks[2], (DEPTH, D_MODEL, D_IN), D_MODEL ** -0.5),
        "q_a_norm": gain(ks[3], (DEPTH, Q_LORA)),
        "kv_a_norm": gain(ks[4], (DEPTH, KV_LORA)),
        "w_uq": nrm(ks[5], (DEPTH, Q_LORA, N_HEADS_MLA * (QK_NOPE + QK_ROPE)), Q_LORA ** -0.5),
        "w_ukv": nrm(ks[6], (DEPTH, KV_LORA, N_HEADS_MLA * (QK_NOPE + V_HEAD)), KV_LORA ** -0.5),
        "out_norm_dil": gain(ks[7], (DEPTH, D_DIL)),
        "out_norm_mla": gain(ks[8], (DEPTH, D_MLA)),
        "w_o": nrm(ks[9], (DEPTH, D_MIX, D_MODEL), D_MIX ** -0.5),
        "ln2_g": gain(ks[10], (DEPTH, D_MODEL)),
        "peer_wq": nrm(ks[11], (DEPTH, D_MODEL, PEER_HEADS * PEER_QDIM), D_MODEL ** -0.5),
        "peer_sub_keys": nrm(ks[12], (DEPTH, PEER_HEADS, 2, PEER_NKEYS, PEER_QDIM // 2), (PEER_QDIM // 2) ** -0.5),
        "peer_u": nrm(ks[13], (DEPTH, PEER_N, D_MODEL), D_MODEL ** -0.5),
        "peer_v": nrm(ks[14], (DEPTH, PEER_N, D_MODEL), PEER_V_STD),
        "lnf_g": gain(ks[15], (D_MODEL,)),
    }


def reference(x, ln1_g, w_in, q_a_norm, kv_a_norm, w_uq, w_ukv, out_norm_dil, out_norm_mla, w_o,
              ln2_g, peer_wq, peer_sub_keys, peer_u, peer_v, lnf_g):
    b, s, _ = x.shape
    pos = jnp.arange(s)
    slopes = alibi_slopes(N_HEADS_DIL)
    h = x
    for l in range(DEPTH):
        xn = rmsnorm(h, ln1_g[l])
        z = xn @ w_in[l]
        q_a, k_a, v_a, c_q, c_kv, k_r = jnp.split(z, IN_SPLITS, axis=-1)
        to_heads = lambda t: t.reshape(b, s, N_HEADS_DIL, HEAD_DIM).transpose(0, 2, 1, 3)
        o_a = dilated_mixture_attention(to_heads(q_a), to_heads(k_a), to_heads(v_a), slopes)
        o_a = rmsnorm(o_a.transpose(0, 2, 1, 3).reshape(b, s, D_DIL), out_norm_dil[l])
        o_b = rmsnorm(mla_attention(c_q, c_kv, k_r, q_a_norm[l], kv_a_norm[l], w_uq[l], w_ukv[l], pos),
                      out_norm_mla[l])
        h = h + jnp.concatenate([o_a, o_b], axis=-1) @ w_o[l]
        h = h + peer_ffn(rmsnorm(h, ln2_g[l]), peer_wq[l], peer_sub_keys[l], peer_u[l], peer_v[l])
    return rmsnorm(h, lnf_g)
```

```cpp
#include <hip/hip_runtime.h>
#include <cstdio>
#include <cstdint>
namespace orc {
constexpr int M = 16384, S = 2048, D = 2048, DIN = 4160;

__global__ void k_rmsnorm(const float* __restrict__ x, int ldx, const float* __restrict__ g, float* __restrict__ y, int ldy, int d) {
    const float* xr = x + (size_t)blockIdx.x * ldx; float* yr = y + (size_t)blockIdx.x * ldy;
    __shared__ float red[256];
    float s = 0.f;
    for (int i = threadIdx.x; i < d; i += 256) { float v = xr[i]; s += v * v; }
    red[threadIdx.x] = s; __syncthreads();
    for (int o = 128; o > 0; o >>= 1) { if (threadIdx.x < o) red[threadIdx.x] += red[threadIdx.x + o]; __syncthreads(); }
    const float rs = rsqrtf(red[0] / (float)d + 1e-6f);
    for (int i = threadIdx.x; i < d; i += 256) yr[i] = xr[i] * rs * g[i];
}

__global__ void __launch_bounds__(256) k_gemm(const float* __restrict__ A, int lda, const float* __restrict__ W, int ldw, float* __restrict__ C, int ldc,
                                               const float* __restrict__ R, int ldr, int K) {
    __shared__ float As[16][65], Bs[16][64];
    const int tx = threadIdx.x & 15, ty = threadIdx.x >> 4;
    const int row0 = blockIdx.y * 64, col0 = blockIdx.x * 64;
    float acc[4][4] = {};
    for (int k0 = 0; k0 < K; k0 += 16) {
        for (int i = threadIdx.x; i < 1024; i += 256) { int r = i >> 4, c = i & 15; As[c][r] = A[(size_t)(row0 + r) * lda + k0 + c]; }
        for (int i = threadIdx.x; i < 1024; i += 256) { int r = i >> 6, c = i & 63; Bs[r][c] = W[(size_t)(k0 + r) * ldw + col0 + c]; }
        __syncthreads();
#pragma unroll
        for (int k = 0; k < 16; ++k) {
            float a[4], b[4];
#pragma unroll
            for (int i = 0; i < 4; ++i) { a[i] = As[k][ty * 4 + i]; b[i] = Bs[k][tx * 4 + i]; }
#pragma unroll
            for (int i = 0; i < 4; ++i)
#pragma unroll
                for (int j = 0; j < 4; ++j) acc[i][j] += a[i] * b[j];
        }
        __syncthreads();
    }
    for (int i = 0; i < 4; ++i) for (int j = 0; j < 4; ++j) {
        const int r = row0 + ty * 4 + i, c = col0 + tx * 4 + j;
        float v = acc[i][j]; if (R) v += R[(size_t)r * ldr + c];
        C[(size_t)r * ldc + c] = v;
    }
}

__global__ void k_rope(float* __restrict__ x, int ld, int off, int stride, int nh) {
    const int row = blockIdx.x; const int pos = row % S;
    for (int i = threadIdx.x; i < nh * 32; i += blockDim.x) {
        const int h = i >> 5, j = i & 31;
        const float freq = powf(10000.0f, -(float)j / 32.0f), ang = (float)pos * freq, c = cosf(ang), s = sinf(ang);
        float* p = x + (size_t)row * ld + off + h * stride;
        const float x1 = p[j], x2 = p[j + 32];
        p[j] = x1 * c - x2 * s; p[j + 32] = x1 * s + x2 * c;
    }
}

__global__ void __launch_bounds__(64) k_attn_mla(const float* __restrict__ q, const float* __restrict__ kv, const float* __restrict__ z, float* __restrict__ O, int ldo) {
    const int t = blockIdx.x, h = blockIdx.y, b = t / S, qi = t % S, lane = threadIdx.x;
    __shared__ float qs[192]; __shared__ float sc[S];
    for (int i = lane; i < 192; i += 64) qs[i] = q[(size_t)t * 1536 + h * 192 + i];
    __syncthreads();
    const float scale = 0.07216878364870323f;
    float mx = -1e30f;
    for (int k = lane; k <= qi; k += 64) {
        const size_t tk = (size_t)b * S + k;
        const float* kn = kv + tk * 2048 + h * 256; const float* kp = z + tk * DIN + 4096;
        float s = 0.f;
        for (int d = 0; d < 128; ++d) s += qs[d] * kn[d];
        for (int d = 0; d < 64; ++d) s += qs[128 + d] * kp[d];
        s *= scale; sc[k] = s; mx = fmaxf(mx, s);
    }
    for (int o = 32; o > 0; o >>= 1) mx = fmaxf(mx, __shfl_xor(mx, o));
    float l = 0.f;
    for (int k = lane; k <= qi; k += 64) { const float p = expf(sc[k] - mx); sc[k] = p; l += p; }
    for (int o = 32; o > 0; o >>= 1) l += __shfl_xor(l, o);
    __syncthreads();
    float a0 = 0.f, a1 = 0.f;
    for (int k = 0; k <= qi; ++k) { const float* v = kv + ((size_t)b * S + k) * 2048 + h * 256 + 128; const float p = sc[k]; a0 += p * v[lane]; a1 += p * v[lane + 64]; }
    O[(size_t)t * ldo + 1024 + h * 128 + lane] = a0 / l; O[(size_t)t * ldo + 1024 + h * 128 + lane + 64] = a1 / l;
}

__global__ void __launch_bounds__(64) k_attn_dil(const float* __restrict__ z, float* __restrict__ O, int ldo) {
    const int t = blockIdx.x, h = blockIdx.y, b = t / S, ti = t % S, lane = threadIdx.x;
    __shared__ float qs[128]; __shared__ float sc[160];
    for (int i = lane; i < 128; i += 64) qs[i] = z[(size_t)t * DIN + h * 128 + i];
    __syncthreads();
    const float slope = exp2f(-8.0f * (float)(h + 1) / 8.0f);
    const int dils[3] = {1, 4, 16};
    float outp[3][2], lse[3];
    for (int p = 0; p < 3; ++p) {
        const int dl = dils[p], l = ti / dl, r = ti % dl;
        const int lo = l - 128 < 0 ? 0 : l - 128, n = l - lo + 1;
        float mx = -1e30f;
        for (int j = lane; j < n; j += 64) {
            const int lk = lo + j; const size_t tk = (size_t)b * S + (size_t)lk * dl + r;
            const float* kr = z + tk * DIN + 1024 + h * 128;
            float s = 0.f; for (int d = 0; d < 128; ++d) s += qs[d] * kr[d];
            s = s * 0.08838834764831845f - slope * (float)((l - lk) * dl);
            sc[j] = s; mx = fmaxf(mx, s);
        }
        for (int o = 32; o > 0; o >>= 1) mx = fmaxf(mx, __shfl_xor(mx, o));
        float ls = 0.f;
        for (int j = lane; j < n; j += 64) { const float pv = expf(sc[j] - mx); sc[j] = pv; ls += pv; }
        for (int o = 32; o > 0; o >>= 1) ls += __shfl_xor(ls, o);
        __syncthreads();
        float a0 = 0.f, a1 = 0.f;
        for (int j = 0; j < n; ++j) { const float* v = z + ((size_t)b * S + (size_t)(lo + j) * dl + r) * DIN + 2048 + h * 128; a0 += sc[j] * v[lane]; a1 += sc[j] * v[lane + 64]; }
        outp[p][0] = a0 / ls; outp[p][1] = a1 / ls; lse[p] = mx + logf(ls);
        __syncthreads();
    }
    const float mm = fmaxf(lse[0], fmaxf(lse[1], lse[2]));
    const float w0 = expf(lse[0] - mm), w1 = expf(lse[1] - mm), w2 = expf(lse[2] - mm), ws = w0 + w1 + w2;
    O[(size_t)t * ldo + h * 128 + lane]      = (w0 * outp[0][0] + w1 * outp[1][0] + w2 * outp[2][0]) / ws;
    O[(size_t)t * ldo + h * 128 + lane + 64] = (w0 * outp[0][1] + w1 * outp[1][1] + w2 * outp[2][1]) / ws;
}

__global__ void __launch_bounds__(128) k_peer_top1(const float* __restrict__ qp, const float* __restrict__ sk, float* __restrict__ ts, int* __restrict__ ti) {
    const int t = blockIdx.x, hp = blockIdx.y, n = threadIdx.x;
    __shared__ float qs[128]; __shared__ float sc[128];
    qs[n] = qp[(size_t)t * 2048 + hp * 128 + n]; __syncthreads();
    const float* kr = sk + ((size_t)hp * 128 + n) * 128; float s = 0.f;
    for (int c = 0; c < 128; ++c) s += qs[c] * kr[c];
    sc[n] = s; __syncthreads();
    if (n == 0) {
        for (int k = 0; k < 16; ++k) { int bi = 0; float bv = sc[0]; for (int i = 1; i < 128; ++i) if (sc[i] > bv) { bv = sc[i]; bi = i; }
            ts[((size_t)t * 16 + hp) * 16 + k] = bv; ti[((size_t)t * 16 + hp) * 16 + k] = bi; sc[bi] = -3e38f; }
    }
}
__global__ void k_peer_top2(const float* __restrict__ ts, const int* __restrict__ ti, int* __restrict__ ridx, float* __restrict__ rgate) {
    const int i = blockIdx.x * blockDim.x + threadIdx.x; if (i >= M * 8) return;
    const int t = i >> 3, h = i & 7;
    const float* s1 = ts + ((size_t)t * 16 + h * 2) * 16; const float* s2 = s1 + 16; const int* i1 = ti + ((size_t)t * 16 + h * 2) * 16; const int* i2 = i1 + 16;
    unsigned long long used[4] = {0, 0, 0, 0};
    float bs[16]; int bi[16];
    for (int k = 0; k < 16; ++k) { float bv = -3e38f; int bp = -1;
        for (int c = 0; c < 256; ++c) { if ((used[c >> 6] >> (c & 63)) & 1ull) continue; const float v = s1[c >> 4] + s2[c & 15]; if (v > bv) { bv = v; bp = c; } }
        used[bp >> 6] |= 1ull << (bp & 63); bs[k] = bv; bi[k] = i1[bp >> 4] * 128 + i2[bp & 15]; }
    const float bmax = bs[0]; float l = 0.f; for (int k = 0; k < 16; ++k) { bs[k] = expf(bs[k] - bmax); l += bs[k]; }
    for (int k = 0; k < 16; ++k) { ridx[(size_t)t * 128 + h * 16 + k] = bi[k]; rgate[(size_t)t * 128 + h * 16 + k] = bs[k] / l; }
}
__global__ void __launch_bounds__(256) k_peer_a(const float* __restrict__ xn, const float* __restrict__ U, const int* __restrict__ ridx, const float* __restrict__ rgate, float* __restrict__ a) {
    const int w = blockIdx.x * 4 + (threadIdx.x >> 6), lane = threadIdx.x & 63; const int t = w >> 7;
    const float* x = xn + (size_t)t * 2048; const float* u = U + (size_t)ridx[w] * 2048; float s = 0.f;
    for (int i = lane; i < 2048; i += 64) s += x[i] * u[i];
    for (int o = 32; o > 0; o >>= 1) s += __shfl_xor(s, o);
    if (lane == 0) a[w] = 0.5f * s * (1.0f + erff(s * 0.7071067811865476f)) * rgate[w];
}
__global__ void __launch_bounds__(256) k_peer_y(const float* __restrict__ h1, const float* __restrict__ V, const int* __restrict__ ridx, const float* __restrict__ a, const float* __restrict__ g, float* __restrict__ out) {
    const int t = blockIdx.x; __shared__ float as[128]; __shared__ int is[128]; __shared__ float red[256];
    if (threadIdx.x < 128) { as[threadIdx.x] = a[(size_t)t * 128 + threadIdx.x]; is[threadIdx.x] = ridx[(size_t)t * 128 + threadIdx.x]; }
    __syncthreads();
    float y[8]; for (int j = 0; j < 8; ++j) y[j] = h1[(size_t)t * 2048 + threadIdx.x + 256 * j];
    for (int e = 0; e < 128; ++e) { const float* v = V + (size_t)is[e] * 2048; const float ae = as[e]; for (int j = 0; j < 8; ++j) y[j] += ae * v[threadIdx.x + 256 * j]; }
    float s = 0.f; for (int j = 0; j < 8; ++j) s += y[j] * y[j];
    red[threadIdx.x] = s; __syncthreads();
    for (int o = 128; o > 0; o >>= 1) { if (threadIdx.x < o) red[threadIdx.x] += red[threadIdx.x + o]; __syncthreads(); }
    const float rs = rsqrtf(red[0] / 2048.0f + 1e-6f);
    for (int j = 0; j < 8; ++j) out[(size_t)t * 2048 + threadIdx.x + 256 * j] = y[j] * rs * g[threadIdx.x + 256 * j];
}

struct In { const float *x, *ln1, *w_in, *qan, *kvan, *w_uq, *w_ukv, *ond, *onm, *w_o, *ln2, *wq, *sk, *pu, *pv, *lnf; };

static void forward(const In& I, float* out, char* ws, hipStream_t st) {
    const size_t MB = 1u << 20;
    float* z   = (float*)(ws);
    float* q   = (float*)(ws + 260 * MB);
    float* kv  = (float*)(ws + 356 * MB);
    float* cn  = (float*)(ws + 484 * MB);
    (void)cn;
    float* xn  = out;
    k_rmsnorm<<<M, 256, 0, st>>>(I.x, D, I.ln1, xn, D, D);
    k_gemm<<<dim3(DIN / 64, M / 64), 256, 0, st>>>(xn, D, I.w_in, DIN, z, DIN, nullptr, 0, D);
    float* cq = out;
    k_rmsnorm<<<M, 256, 0, st>>>(z + 3072, DIN, I.qan, cq, 512, 512);
    k_gemm<<<dim3(1536 / 64, M / 64), 256, 0, st>>>(cq, 512, I.w_uq, 1536, q, 1536, nullptr, 0, 512);
    k_rmsnorm<<<M, 256, 0, st>>>(z + 3584, DIN, I.kvan, cq, 512, 512);
    k_gemm<<<dim3(2048 / 64, M / 64), 256, 0, st>>>(cq, 512, I.w_ukv, 2048, kv, 2048, nullptr, 0, 512);
    k_rope<<<M, 256, 0, st>>>(q, 1536, 128, 192, 8);
    k_rope<<<M, 64, 0, st>>>(z, DIN, 4096, 0, 1);
    float* o = out;
    k_attn_dil<<<dim3(M, 8), 64, 0, st>>>(z, o, D);
    k_attn_mla<<<dim3(M, 8), 64, 0, st>>>(q, kv, z, o, D);
    float* on  = (float*)(ws);
    float* h1  = (float*)(ws + 128 * MB);
    float* xn2 = (float*)(ws + 256 * MB);
    float* qp  = (float*)(ws + 384 * MB);
    k_rmsnorm<<<M, 256, 0, st>>>(o, D, I.ond, on, D, 1024);
    k_rmsnorm<<<M, 256, 0, st>>>(o + 1024, D, I.onm, on + 1024, D, 1024);
    k_gemm<<<dim3(D / 64, M / 64), 256, 0, st>>>(on, D, I.w_o, D, h1, D, I.x, D, D);
    k_rmsnorm<<<M, 256, 0, st>>>(h1, D, I.ln2, xn2, D, D);
    k_gemm<<<dim3(D / 64, M / 64), 256, 0, st>>>(xn2, D, I.wq, D, qp, D, nullptr, 0, D);
    float* ts = (float*)(ws);
    int* ti   = (int*)(ws + 16 * MB);
    int* ridx = (int*)(ws + 32 * MB);
    float* rg = (float*)(ws + 40 * MB);
    float* a  = (float*)(ws + 48 * MB);
    k_peer_top1<<<dim3(M, 16), 128, 0, st>>>(qp, I.sk, ts, ti);
    k_peer_top2<<<(M * 8 + 255) / 256, 256, 0, st>>>(ts, ti, ridx, rg);
    k_peer_a<<<M * 128 / 4, 256, 0, st>>>(xn2, I.pu, ridx, rg, a);
    k_peer_y<<<M, 256, 0, st>>>(h1, I.pv, ridx, a, I.lnf, out);
}
}
extern "C" void kernel_launch(void* const* d_in, const int* in_sizes, int n_in, void* d_out, int out_size, void* d_ws, size_t ws_size, hipStream_t stream) {
    orc::In I;
    I.x = (const float*)d_in[0]; I.ln1 = (const float*)d_in[1]; I.w_in = (const float*)d_in[2]; I.qan = (const float*)d_in[3]; I.kvan = (const float*)d_in[4];
    I.w_uq = (const float*)d_in[5]; I.w_ukv = (const float*)d_in[6]; I.ond = (const float*)d_in[7]; I.onm = (const float*)d_in[8]; I.w_o = (const float*)d_in[9];
    I.ln2 = (const float*)d_in[10]; I.wq = (const float*)d_in[11]; I.sk = (const float*)d_in[12]; I.pu = (const float*)d_in[13]; I.pv = (const float*)d_in[14]; I.lnf = (const float*)d_in[15];
    orc::forward(I, (float*)d_out, (char*)d_ws, stream);
}
```

```cpp
#include <hip/hip_runtime.h>
#include <hip/hip_cooperative_groups.h>
#include <cstdio>
#include <cstdint>
namespace cg = cooperative_groups;
#define GAS __attribute__((address_space(1)))
#define LAS __attribute__((address_space(3)))
typedef unsigned short bf16;
typedef unsigned v4u __attribute__((ext_vector_type(4)));
typedef unsigned v2u __attribute__((ext_vector_type(2)));
typedef float f32x2 __attribute__((ext_vector_type(2)));
typedef float f32x4 __attribute__((ext_vector_type(4)));
typedef float f32x16 __attribute__((ext_vector_type(16)));
typedef short bf16x8 __attribute__((ext_vector_type(8)));
typedef short s16x4 __attribute__((ext_vector_type(4)));
typedef __bf16 bf16x2_t __attribute__((ext_vector_type(2)));

constexpr int M = 16384, SEQ = 2048, DM = 2048, NWAVES = 8, NTHREADS = 512;
constexpr float EPS = 1e-6f, LOG2E = 1.4426950408889634f;
constexpr float QSCALE_DIL = 0.08838834764831845f * LOG2E;
constexpr float QSCALE_MLA = 0.07216878364870323f * LOG2E;

constexpr size_t MiB = 1u << 20;
constexpr size_t WS_CTL = 0, CTL_ZERO_BYTES = 64 * 1024;
constexpr size_t WS_ROPE = 1 * MiB;
constexpr size_t WS_SK = 2 * MiB;
constexpr size_t WS_BTKR = 3 * MiB;
constexpr size_t WS_BT2Q = 4 * MiB;
constexpr size_t WS_BT2KV = 6 * MiB;
constexpr size_t WS_BT1 = 8 * MiB;
constexpr size_t WS_BT3 = 24 * MiB;
constexpr size_t WS_BT4 = 32 * MiB;
constexpr size_t WS_SSQCQ = 40 * MiB;
constexpr size_t WS_SSQCKV = 40 * MiB + 512 * 1024;
constexpr size_t WS_SSQO = 41 * MiB;
constexpr size_t WS_SSQH = 42 * MiB;
constexpr size_t WS_KPE = 44 * MiB;
constexpr size_t WS_UB = 48 * MiB;
constexpr size_t WS_VB = 112 * MiB;
constexpr size_t WS_A = 176 * MiB;
constexpr size_t WS_B = 240 * MiB;
constexpr size_t WS_C = 336 * MiB;
constexpr size_t WS_QN = WS_C, WS_QPE = WS_C + 32 * MiB, WS_KN = WS_C + 48 * MiB, WS_VM = WS_C + 80 * MiB;
constexpr size_t WS_QP = WS_C, WS_RIDX = WS_C + 64 * MiB, WS_RGATE = WS_C + 72 * MiB;
constexpr size_t WS_D = 448 * MiB;
constexpr size_t WS_CQ = WS_D, WS_CKV = WS_D + 16 * MiB;
constexpr size_t WS_END = 480 * MiB;

constexpr int RING_BYTES = 131072;
constexpr int MISC_OFF = RING_BYTES;
constexpr int LDS_BYTES = 147456;

#define LDS_WAIT() asm volatile("s_waitcnt lgkmcnt(0)" ::: "memory")
#define VM_WAIT() asm volatile("s_waitcnt vmcnt(0)" ::: "memory")

__device__ __forceinline__ unsigned f2bf(float f) { unsigned u = __builtin_bit_cast(unsigned, f); return (u + 0x7fffu + ((u >> 16) & 1u)) >> 16; }
__device__ __forceinline__ unsigned pk2(float lo, float hi) { f32x2 v = {lo, hi}; bf16x2_t b = __builtin_convertvector(v, bf16x2_t); return __builtin_bit_cast(unsigned, b); }
__device__ __forceinline__ float bflo(unsigned u) { return __builtin_bit_cast(float, u << 16); }
__device__ __forceinline__ float bfhi(unsigned u) { return __builtin_bit_cast(float, u & 0xffff0000u); }
__device__ __forceinline__ float bf2f(bf16 b) { return __builtin_bit_cast(float, (unsigned)b << 16); }
__device__ __forceinline__ float wave_sum(float v) {
#pragma unroll
    for (int o = 1; o < 64; o <<= 1) v += __shfl_xor(v, o);
    return v;
}

struct Params {
    const float *x, *ln1, *w_in, *qan, *kvan, *w_uq, *w_ukv, *ond, *onm, *w_o, *ln2, *wq, *sk, *pu, *pv, *lnf;
    float* out; unsigned char* ws;
    int ph_lo, ph_hi;
};
__device__ __forceinline__ int map_ident(int c) { return c; }
__device__ __forceinline__ int map_kr(int c) { const int p = c - 4096; return 2 * (p & 31) + (p >> 5); }
__device__ __forceinline__ int map_uq(int c) { const int h = c / 192, e = c % 192; if (e < 128) return h * 128 + e; const int p = e - 128; return 1024 + h * 64 + 2 * (p & 31) + (p >> 5); }
__device__ __forceinline__ int map_ukv(int c) { const int h = c >> 8, e = c & 255; return e < 128 ? h * 128 + e : 1024 + h * 128 + (e - 128); }

template <int MAP>
__device__ __forceinline__ void p0_transpose_item(const float* __restrict__ W, int K, int ldw, int c0, const float* __restrict__ g0, const float* __restrict__ g1, int gsplit,
                                                  bf16* __restrict__ WT, LAS float* scr, int item, int nblk, int lane) {
    const int kb = item / nblk, nb = item % nblk, k0 = 64 * kb, n0 = c0 + 32 * nb;
#pragma unroll 8
    for (int i = 0; i < 32; ++i) { const int kk = 2 * i + (lane >> 5); const int k = k0 + kk;
        float w = W[(size_t)k * ldw + n0 + (lane & 31)];
        if (g0) w *= (k < gsplit ? g0[k] : g1[k - gsplit]);
        scr[kk * 33 + (lane & 31)] = w; }
    LDS_WAIT(); asm volatile("" ::: "memory");
    const int c = lane & 7;
#pragma unroll
    for (int j = 0; j < 4; ++j) { const int n = (lane >> 3) + 8 * j; const LAS float* s = scr + (8 * c) * 33 + n;
        v4u o; o.x = pk2(s[0 * 33], s[1 * 33]); o.y = pk2(s[2 * 33], s[3 * 33]); o.z = pk2(s[4 * 33], s[5 * 33]); o.w = pk2(s[6 * 33], s[7 * 33]);
        const int src = n0 + n;
        const int dr = MAP == 0 ? map_ident(src) : MAP == 1 ? map_kr(src) : MAP == 2 ? map_uq(src) : map_ukv(src);
        *(v4u*)(WT + (size_t)dr * K + k0 + 8 * c) = o; }
    LDS_WAIT(); asm volatile("" ::: "memory");
}

__device__ __forceinline__ void phase_prep(const Params& P, LAS unsigned char* lds, int vcu, int G) {
    int tid_ = threadIdx.x; asm volatile("" : "+v"(tid_));
    const int tid = tid_, lane = tid & 63, wave = __builtin_amdgcn_readfirstlane(tid >> 6);
    unsigned char* ws = P.ws;
    LAS float* scr = (LAS float*)(lds + wave * 16384);
    const int gw = vcu * NWAVES + wave, NGW = G * NWAVES;
    constexpr int I1 = 32 * 128, IKR = 32 * 2, I2Q = 8 * 48, I2KV = 8 * 64, I3 = 32 * 64, I4 = 32 * 64;
    constexpr int NITEMS = I1 + IKR + I2Q + I2KV + I3 + I4;
    for (int it = gw; it < NITEMS; it += NGW) {
        int r = it;
        if (r < I1) { p0_transpose_item<0>(P.w_in, 2048, 4160, 0, nullptr, nullptr, 0, (bf16*)(ws + WS_BT1), scr, r, 128, lane); continue; } r -= I1;
        if (r < IKR) { p0_transpose_item<1>(P.w_in, 2048, 4160, 4096, nullptr, nullptr, 0, (bf16*)(ws + WS_BTKR), scr, r, 2, lane); continue; } r -= IKR;
        if (r < I2Q) { p0_transpose_item<2>(P.w_uq, 512, 1536, 0, P.qan, P.qan, 512, (bf16*)(ws + WS_BT2Q), scr, r, 48, lane); continue; } r -= I2Q;
        if (r < I2KV) { p0_transpose_item<3>(P.w_ukv, 512, 2048, 0, P.kvan, P.kvan, 512, (bf16*)(ws + WS_BT2KV), scr, r, 64, lane); continue; } r -= I2KV;
        if (r < I3) { p0_transpose_item<0>(P.w_o, 2048, 2048, 0, P.ond, P.onm, 1024, (bf16*)(ws + WS_BT3), scr, r, 64, lane); continue; } r -= I3;
        p0_transpose_item<0>(P.wq, 2048, 2048, 0, P.ln2, P.ln2, 2048, (bf16*)(ws + WS_BT4), scr, r, 64, lane);
    }
    {
        bf16* XN = (bf16*)(ws + WS_A);
        f32x4 gv[8];
#pragma unroll
        for (int j = 0; j < 8; ++j) gv[j] = ((const f32x4*)P.ln1)[lane + 64 * j];
        for (int m = gw; m < M; m += NGW) {
            const f32x4* xr = (const f32x4*)(P.x + (size_t)m * DM) + lane;
            f32x4 v[8]; float s = 0.f;
#pragma unroll
            for (int j = 0; j < 8; ++j) { v[j] = xr[64 * j]; s += (v[j].x * v[j].x + v[j].y * v[j].y) + (v[j].z * v[j].z + v[j].w * v[j].w); }
            const float rs = rsqrtf(wave_sum(s) * (1.f / DM) + EPS);
            v2u* o8 = (v2u*)(XN + (size_t)m * DM) + lane;
#pragma unroll
            for (int j = 0; j < 8; ++j) { v2u o; o.x = pk2(v[j].x * rs * gv[j].x, v[j].y * rs * gv[j].y); o.y = pk2(v[j].z * rs * gv[j].z, v[j].w * rs * gv[j].w); o8[64 * j] = o; }
        }
    }
    const int gt = vcu * NTHREADS + tid, NGT = G * NTHREADS;
    {
        f32x2* R = (f32x2*)(ws + WS_ROPE);
        for (int i = gt; i < 2048 * 32; i += NGT) { const int pos = i >> 5, j = i & 31; const float freq = powf(10000.0f, -(float)j / 32.0f), ang = (float)pos * freq;
            f32x2 cs; cs.x = cosf(ang); cs.y = sinf(ang); R[i] = cs; }
    }
    {
        v4u* o = (v4u*)(ws + WS_SK);
        for (int i = gt; i < 16 * 128 * 128 / 8; i += NGT) { const f32x4 a = ((const f32x4*)P.sk)[2 * i], b = ((const f32x4*)P.sk)[2 * i + 1];
            v4u w; w.x = pk2(a.x, a.y); w.y = pk2(a.z, a.w); w.z = pk2(b.x, b.y); w.w = pk2(b.z, b.w); o[i] = w; }
    }
    {
        v4u* ou = (v4u*)(ws + WS_UB); v4u* ov = (v4u*)(ws + WS_VB);
        for (int i = gt; i < 16384 * 2048 / 8; i += NGT) {
            const f32x4 a = __builtin_nontemporal_load((const f32x4*)P.pu + 2 * i), b = __builtin_nontemporal_load((const f32x4*)P.pu + 2 * i + 1);
            const int k8 = (i & 255) * 2; const f32x4 g0 = ((const f32x4*)P.ln2)[k8], g1 = ((const f32x4*)P.ln2)[k8 + 1];
            v4u w; w.x = pk2(a.x * g0.x, a.y * g0.y); w.y = pk2(a.z * g0.z, a.w * g0.w); w.z = pk2(b.x * g1.x, b.y * g1.y); w.w = pk2(b.z * g1.z, b.w * g1.w); ou[i] = w;
            const f32x4 c = __builtin_nontemporal_load((const f32x4*)P.pv + 2 * i), d = __builtin_nontemporal_load((const f32x4*)P.pv + 2 * i + 1);
            v4u y; y.x = pk2(c.x, c.y); y.y = pk2(c.z, c.w); y.z = pk2(d.x, d.y); y.w = pk2(d.z, d.w); ov[i] = y;
        }
    }
}
namespace pg8 {
constexpr int BM = 256, BK = 64, HALF = 128, HTB = HALF * BK * 2, STAGE_BYTES = 8 * HTB, NXCD = 8, WGM = 8;
__host__ __device__ __forceinline__ int lds_byte(int r, int c) { const int st = (r >> 4) * 2 + (c >> 5), rr = r & 15, cc = c & 31, ob = rr * 64 + cc * 2; return st * 1024 + (ob ^ (((ob >> 9) & 1) << 5)); }
__host__ __device__ __forceinline__ void stage_rc(int b, int& R, int& C) { const int st = b / 1024, sb = b % 1024, swz = sb ^ (((sb >> 9) & 1) << 5); R = (st >> 1) * 16 + swz / 64; C = (st & 1) * 32 + (swz % 64) / 2; }
__host__ __device__ __forceinline__ int perm32(int rho) { const int n = rho >> 4, i = rho & 15; return 8 * (i >> 2) + 4 * n + (i & 3); }

struct Unit { int pm, pn, g; };
struct GemmSet { const bf16 *A0, *A1, *Bt0, *Bt1; int K; };

struct StaticOrder {
    int nM, nN0, nN, nwg, G, c;
    __device__ void init(int Mrows, int N0, int N1, int G_, int c_) { nM = Mrows / BM; nN0 = N0 / BM; nN = nN0 + N1 / BM; nwg = nM * nN; G = G_; c = c_; }
    __device__ bool next(int i, Unit& u) const {
        const long L = (long)i * G + c; if (L >= nwg) return false;
        int wgid = (int)L; { const int q = nwg / NXCD, r = nwg % NXCD, xcd = wgid % NXCD, off = wgid / NXCD; wgid = (xcd < r ? xcd * (q + 1) : r * (q + 1) + (xcd - r) * q) + off; }
        const int nig = WGM * nN, gid = wgid / nig, fm = gid * WGM, gsz = (nM - fm) < WGM ? (nM - fm) : WGM;
        u.pm = fm + ((wgid % nig) % gsz); int pn = (wgid % nig) / gsz; u.g = pn >= nN0 ? 1 : 0; u.pn = pn >= nN0 ? pn - nN0 : pn; return true;
    }
};

template <class Epi, class Sched>
__device__ __forceinline__ void gemm_phase(LAS unsigned char* lds, const GemmSet g, const Sched& S, const Epi& E) {
    int tid_ = threadIdx.x; asm volatile("" : "+v"(tid_));
    const int tid = tid_, wid = __builtin_amdgcn_readfirstlane(tid >> 6), lane = tid & 63, wr = wid >> 2, wc = wid & 3, fr = lane & 15, fq = lane >> 4;
    const int K = g.K, nt = K / BK;
    unsigned voffA[2], voffB[2];
#pragma unroll
    for (int i = 0; i < 2; ++i) { int R, C; stage_rc(tid * 16 + i * 8192, R, C); const int Rb = (R & ~31) + perm32(R & 31);
        voffA[i] = (unsigned)(R * K + C) * 2u; voffB[i] = (unsigned)(Rb * K + C) * 2u; }
    const size_t kstep = (size_t)(BK * 2);
    const size_t hstep = (size_t)HALF * K * 2;
    const size_t tstep = 2 * hstep;
    const unsigned ldsw = (unsigned)wid * 1024u;
    const int aoff = lds_byte(wr * 64 + fr, fq * 8), boff = lds_byte(wc * 32 + fr, fq * 8);
#define PG8_SA(b, h) (((b) * 2 + (h)) * HTB)
#define PG8_SB(b, h) ((4 + (b) * 2 + (h)) * HTB)
#define PG8_STAGE(bufoff, gbase, voff) do { _Pragma("unroll") for (int _i = 0; _i < 2; ++_i) \
        __builtin_amdgcn_global_load_lds((const unsigned*)((const char*)(gbase) + (voff)[_i]), (LAS unsigned*)(lds + (bufoff) + ldsw + _i * 8192), 16, 0, 0); } while (0)
#define PG8_LDA(dst, b, h) do { _Pragma("unroll") for (int m = 0; m < 4; ++m) _Pragma("unroll") for (int k = 0; k < 2; ++k) dst[m][k] = *(const LAS bf16x8*)(lds + PG8_SA(b, h) + aoff + m * 2048 + k * 1024); } while (0)
#define PG8_LDB(dst, b, h) do { _Pragma("unroll") for (int n = 0; n < 2; ++n) _Pragma("unroll") for (int k = 0; k < 2; ++k) dst[n][k] = *(const LAS bf16x8*)(lds + PG8_SB(b, h) + boff + n * 2048 + k * 1024); } while (0)
#define PG8_MMA(ai, bj, At, Bt) do { __builtin_amdgcn_s_setprio(1); _Pragma("unroll") for (int m = 0; m < 4; ++m) _Pragma("unroll") for (int n = 0; n < 2; ++n) _Pragma("unroll") for (int k = 0; k < 2; ++k) \
        acc[ai][bj][m][n] = __builtin_amdgcn_mfma_f32_16x16x32_bf16(Bt[n][k], At[m][k], acc[ai][bj][m][n], 0, 0, 0); __builtin_amdgcn_s_setprio(0); } while (0)
#define PG8_WAIT_V(n) asm volatile("s_waitcnt vmcnt(" #n ")" ::: "memory")
#define PG8_WAIT_L(n) asm volatile("s_waitcnt lgkmcnt(" #n ")" ::: "memory")
#define PG8_BAR __builtin_amdgcn_s_barrier()
#define PG8_SCHED __builtin_amdgcn_sched_barrier(0)
    Unit cur, nxt; int ui = 0;
    if (!S.next(0, cur)) return;
    f32x4 acc[2][2][4][2];
#pragma unroll
    for (int a = 0; a < 2; ++a)
#pragma unroll
        for (int b = 0; b < 2; ++b)
#pragma unroll
            for (int m = 0; m < 4; ++m)
#pragma unroll
                for (int n = 0; n < 2; ++n) acc[a][b][m][n] = (f32x4){0.f, 0.f, 0.f, 0.f};
    bf16x8 At[4][2], B0[2][2], B1[2][2];
    const char* cA = (const char*)(cur.g ? g.A1 : g.A0) + (size_t)cur.pm * tstep; const char* cB = (const char*)(cur.g ? g.Bt1 : g.Bt0) + (size_t)cur.pn * tstep;
    E.unit_begin(cur, 0, tid);
    PG8_STAGE(PG8_SB(0, 0), cB, voffB); PG8_STAGE(PG8_SB(0, 1), cB + hstep, voffB); PG8_STAGE(PG8_SA(0, 0), cA, voffA); PG8_STAGE(PG8_SA(0, 1), cA + hstep, voffA);
    if (wr == 1) PG8_BAR;
    PG8_WAIT_V(2); PG8_BAR;
    PG8_STAGE(PG8_SB(1, 0), cB + kstep, voffB); PG8_STAGE(PG8_SA(1, 0), cA + kstep, voffA); PG8_STAGE(PG8_SB(1, 1), cB + hstep + kstep, voffB);
    PG8_WAIT_V(6); PG8_BAR;
    for (;;) {
        const bool has_next = S.next(ui + 1, nxt);
        const char* nA = has_next ? (const char*)(nxt.g ? g.A1 : g.A0) + (size_t)nxt.pm * tstep : cA; const char* nB = has_next ? (const char*)(nxt.g ? g.Bt1 : g.Bt0) + (size_t)nxt.pn * tstep : cB;
        for (int t = 0; t < nt; t += 2) {
            const bool last = (t == nt - 2);
            const char* a1 = cA + (size_t)(t + 1) * kstep;
            const char* a2 = last ? nA : cA + (size_t)(t + 2) * kstep; const char* b2 = last ? nB : cB + (size_t)(t + 2) * kstep;
            const char* a3 = a2 + kstep; const char* b3 = b2 + kstep;
            if constexpr (Epi::MIDSCALE) { if (t == nt / 2) E.midscale(acc, ui & 1, wr, fr); }
            PG8_LDB(B0, 0, 0); PG8_LDB(B1, 0, 1); PG8_SCHED; PG8_LDA(At, 0, 0); PG8_STAGE(PG8_SA(1, 1), a1 + hstep, voffA);
            PG8_WAIT_V(8); PG8_WAIT_L(0); PG8_BAR; PG8_MMA(0, 0, At, B0); PG8_MMA(0, 1, At, B1); PG8_BAR; PG8_SCHED;
            PG8_LDA(At, 0, 1); PG8_STAGE(PG8_SB(0, 0), b2, voffB); PG8_STAGE(PG8_SB(0, 1), b2 + hstep, voffB); PG8_STAGE(PG8_SA(0, 0), a2, voffA);
            PG8_WAIT_V(8); PG8_WAIT_L(0); PG8_BAR; PG8_MMA(1, 0, At, B0); PG8_MMA(1, 1, At, B1); PG8_BAR; PG8_SCHED;
            PG8_LDB(B0, 1, 0); PG8_LDB(B1, 1, 1); PG8_SCHED; PG8_LDA(At, 1, 0); PG8_STAGE(PG8_SA(0, 1), a2 + hstep, voffA);
            PG8_WAIT_V(8); PG8_WAIT_L(0); PG8_BAR; PG8_MMA(0, 0, At, B0); PG8_MMA(0, 1, At, B1); PG8_BAR; PG8_SCHED;
            PG8_LDA(At, 1, 1); PG8_STAGE(PG8_SB(1, 0), b3, voffB); PG8_STAGE(PG8_SB(1, 1), b3 + hstep, voffB); PG8_STAGE(PG8_SA(1, 0), a3, voffA);
            PG8_WAIT_V(8); PG8_WAIT_L(0); PG8_BAR; PG8_MMA(1, 0, At, B0); PG8_MMA(1, 1, At, B1); PG8_BAR; PG8_SCHED;
        }
        if (wr == 0) PG8_BAR;
        E(acc, cur, ui & 1, wr, wc, fr, fq);
        if (!has_next) break;
#pragma unroll
        for (int a = 0; a < 2; ++a)
#pragma unroll
            for (int b = 0; b < 2; ++b)
#pragma unroll
                for (int m = 0; m < 4; ++m)
#pragma unroll
                    for (int n = 0; n < 2; ++n) acc[a][b][m][n] = (f32x4){0.f, 0.f, 0.f, 0.f};
        cur = nxt; cA = nA; cB = nB; ++ui;
        E.unit_begin(cur, ui & 1, tid);
        if (wr == 1) PG8_BAR;
    }
    PG8_WAIT_V(0);
    PG8_BAR;
#undef PG8_SA
#undef PG8_SB
#undef PG8_STAGE
#undef PG8_LDA
#undef PG8_LDB
#undef PG8_MMA
#undef PG8_WAIT_V
#undef PG8_WAIT_L
#undef PG8_BAR
#undef PG8_SCHED
}
}
namespace pg8 {
__device__ __forceinline__ v4u pack8(const f32x4& v0, const f32x4& v1) { v4u w; w.x = pk2(v0[0], v0[1]); w.y = pk2(v0[2], v0[3]); w.z = pk2(v1[0], v1[1]); w.w = pk2(v1[2], v1[3]); return w; }
__device__ __forceinline__ float sq8(const f32x4& v0, const f32x4& v1) { return (v0[0] * v0[0] + v0[1] * v0[1]) + (v0[2] * v0[2] + v0[3] * v0[3]) + (v1[0] * v1[0] + v1[1] * v1[1]) + (v1[2] * v1[2] + v1[3] * v1[3]); }

struct Epi1 {
    static constexpr bool MIDSCALE = false;
    bf16 *QKV, *CQ, *CKV; float *SSQCQ, *SSQCKV;
    __device__ __forceinline__ void midscale(f32x4 (&)[2][2][4][2], int, int, int) const {}
    __device__ __forceinline__ void unit_begin(const Unit&, int, int) const {}
    __device__ __forceinline__ void operator()(const f32x4 (&acc)[2][2][4][2], const Unit& u, int par, int wr, int wc, int fr, int fq) const {
        const int pn = u.pn; bf16* base; int ldc, colt; float sc = 1.f; float* ssq = nullptr; int sslot = 0;
        if (pn < 12) { base = QKV; ldc = 3072; colt = pn * 256; if (pn < 4) sc = QSCALE_DIL; }
        else if (pn < 14) { base = CQ; ldc = 512; colt = (pn - 12) * 256; ssq = SSQCQ; sslot = (pn - 12) * 4 + wc; }
        else { base = CKV; ldc = 512; colt = (pn - 14) * 256; ssq = SSQCKV; sslot = (pn - 14) * 4 + wc; }
        const int row0 = u.pm * BM + wr * 64 + fr, col0 = colt + wc * 32 + 8 * fq;
#pragma unroll
        for (int ai = 0; ai < 2; ++ai)
#pragma unroll
            for (int m = 0; m < 4; ++m) { const int row = row0 + ai * HALF + m * 16; bf16* rowp = base + (size_t)row * ldc + col0; float ss = 0.f;
#pragma unroll
                for (int bj = 0; bj < 2; ++bj) { const f32x4 v0 = acc[ai][bj][m][0] * sc, v1 = acc[ai][bj][m][1] * sc; ss += sq8(v0, v1); *(v4u*)(rowp + bj * HALF) = pack8(v0, v1); }
                if (ssq) { ss += __shfl_xor(ss, 16); ss += __shfl_xor(ss, 32); if (fq == 0) ssq[(size_t)row * 8 + sslot] = ss; } }
    }
};

struct Epi2 {
    static constexpr bool MIDSCALE = false;
    bf16 *QN, *QPE, *KN, *VM; const float *SSQCQ, *SSQCKV; const f32x2* ROPE;
    __device__ __forceinline__ void midscale(f32x4 (&)[2][2][4][2], int, int, int) const {}
    __device__ __forceinline__ void unit_begin(const Unit&, int, int) const {}
    __device__ __forceinline__ void operator()(const f32x4 (&acc)[2][2][4][2], const Unit& u, int par, int wr, int wc, int fr, int fq) const {
        const int pn = u.pn; bf16* base; int ldc, colt; float sc = 1.f; bool rope = false; const float* ssq;
        if (u.g == 0) { ssq = SSQCQ; sc = QSCALE_MLA; if (pn < 4) { base = QN; ldc = 1024; colt = pn * 256; } else { base = QPE; ldc = 512; colt = (pn - 4) * 256; rope = true; } }
        else { ssq = SSQCKV; if (pn < 4) { base = KN; ldc = 1024; colt = pn * 256; } else { base = VM; ldc = 1024; colt = (pn - 4) * 256; } }
        const int row0 = u.pm * BM + wr * 64 + fr, col0 = colt + wc * 32 + 8 * fq;
#pragma unroll
        for (int ai = 0; ai < 2; ++ai)
#pragma unroll
            for (int m = 0; m < 4; ++m) { const int row = row0 + ai * HALF + m * 16; bf16* rowp = base + (size_t)row * ldc + col0;
                const f32x4 p0 = *(const f32x4*)(ssq + (size_t)row * 8), p1 = *(const f32x4*)(ssq + (size_t)row * 8 + 4);
                const float rs = rsqrtf(((p0[0] + p0[1]) + (p0[2] + p0[3]) + (p1[0] + p1[1]) + (p1[2] + p1[3])) * (1.f / 512.f) + EPS) * sc;
#pragma unroll
                for (int bj = 0; bj < 2; ++bj) { f32x4 v0 = acc[ai][bj][m][0] * rs, v1 = acc[ai][bj][m][1] * rs;
                    if (rope) { const int j0 = ((col0 + bj * HALF) & 63) >> 1; const f32x4* rp = (const f32x4*)(ROPE + (size_t)(row & (SEQ - 1)) * 32 + j0);
                        const f32x4 r0 = rp[0], r1 = rp[1];
                        f32x4 w0, w1;
                        w0[0] = v0[0] * r0[0] - v0[1] * r0[1]; w0[1] = v0[0] * r0[1] + v0[1] * r0[0];
                        w0[2] = v0[2] * r0[2] - v0[3] * r0[3]; w0[3] = v0[2] * r0[3] + v0[3] * r0[2];
                        w1[0] = v1[0] * r1[0] - v1[1] * r1[1]; w1[1] = v1[0] * r1[1] + v1[1] * r1[0];
                        w1[2] = v1[2] * r1[2] - v1[3] * r1[3]; w1[3] = v1[2] * r1[3] + v1[3] * r1[2];
                        v0 = w0; v1 = w1; }
                    *(v4u*)(rowp + bj * HALF) = pack8(v0, v1); } }
    }
};

struct Epi3 {
    static constexpr bool MIDSCALE = true;
    bf16* H1B; const float* X; const float* SSQO; float* SSQH; LAS f32x2* RS;
    __device__ __forceinline__ void unit_begin(const Unit& u, int par, int tid) const {
        if (tid < 256) { const f32x4* p = (const f32x4*)(SSQO + (size_t)(u.pm * BM + tid) * 16); const f32x4 a0 = p[0], a1 = p[1], b0 = p[2], b1 = p[3];
            const float ra = rsqrtf(((a0[0] + a0[1]) + (a0[2] + a0[3]) + (a1[0] + a1[1]) + (a1[2] + a1[3])) * (1.f / 1024.f) + EPS);
            const float rb = rsqrtf(((b0[0] + b0[1]) + (b0[2] + b0[3]) + (b1[0] + b1[1]) + (b1[2] + b1[3])) * (1.f / 1024.f) + EPS);
            f32x2 v; v.x = ra / rb; v.y = rb; RS[par * 256 + tid] = v; }
    }
    __device__ __forceinline__ void midscale(f32x4 (&acc)[2][2][4][2], int par, int wr, int fr) const {
#pragma unroll
        for (int ai = 0; ai < 2; ++ai)
#pragma unroll
            for (int m = 0; m < 4; ++m) { const float f = RS[par * 256 + ai * HALF + wr * 64 + m * 16 + fr].x;
#pragma unroll
                for (int bj = 0; bj < 2; ++bj) { acc[ai][bj][m][0] = acc[ai][bj][m][0] * f; acc[ai][bj][m][1] = acc[ai][bj][m][1] * f; } }
    }
    __device__ __forceinline__ void operator()(const f32x4 (&acc)[2][2][4][2], const Unit& u, int par, int wr, int wc, int fr, int fq) const {
        const int row0 = u.pm * BM + wr * 64 + fr, col0 = u.pn * BM + wc * 32 + 8 * fq, sslot = u.pn * 4 + wc;
#pragma unroll
        for (int ai = 0; ai < 2; ++ai)
#pragma unroll
            for (int m = 0; m < 4; ++m) { const int row = row0 + ai * HALF + m * 16; const float rb = RS[par * 256 + ai * HALF + wr * 64 + m * 16 + fr].y; float ss = 0.f;
#pragma unroll
                for (int bj = 0; bj < 2; ++bj) { const float* xp = X + (size_t)row * DM + col0 + bj * HALF; const f32x4 x0 = *(const f32x4*)xp, x1 = *(const f32x4*)(xp + 4);
                    const f32x4 v0 = acc[ai][bj][m][0] * rb + x0, v1 = acc[ai][bj][m][1] * rb + x1; ss += sq8(v0, v1);
                    *(v4u*)(H1B + (size_t)row * DM + col0 + bj * HALF) = pack8(v0, v1); }
                ss += __shfl_xor(ss, 16); ss += __shfl_xor(ss, 32); if (fq == 0) SSQH[(size_t)row * 32 + sslot] = ss; }
    }
};

struct Epi4 {
    static constexpr bool MIDSCALE = false;
    bf16* QP; const float* SSQH; LAS f32x2* RS;
    __device__ __forceinline__ void midscale(f32x4 (&)[2][2][4][2], int, int, int) const {}
    __device__ __forceinline__ void unit_begin(const Unit& u, int par, int tid) const {
        if (tid < 256) { const f32x4* p = (const f32x4*)(SSQH + (size_t)(u.pm * BM + tid) * 32); f32x4 s = p[0];
#pragma unroll
            for (int i = 1; i < 8; ++i) s = s + p[i];
            f32x2 v; v.x = rsqrtf(((s[0] + s[1]) + (s[2] + s[3])) * (1.f / 2048.f) + EPS); v.y = 0.f; RS[par * 256 + tid] = v; }
    }
    __device__ __forceinline__ void operator()(const f32x4 (&acc)[2][2][4][2], const Unit& u, int par, int wr, int wc, int fr, int fq) const {
        const int row0 = u.pm * BM + wr * 64 + fr, col0 = u.pn * BM + wc * 32 + 8 * fq;
#pragma unroll
        for (int ai = 0; ai < 2; ++ai)
#pragma unroll
            for (int m = 0; m < 4; ++m) { const int row = row0 + ai * HALF + m * 16; const float rs = RS[par * 256 + ai * HALF + wr * 64 + m * 16 + fr].x;
#pragma unroll
                for (int bj = 0; bj < 2; ++bj) *(v4u*)(QP + (size_t)row * DM + col0 + bj * HALF) = pack8(acc[ai][bj][m][0] * rs, acc[ai][bj][m][1] * rs); }
    }
};
}

__device__ __forceinline__ void kr_item(const bf16* __restrict__ XN, const bf16* __restrict__ BT, const f32x2* __restrict__ ROPE, bf16* __restrict__ KPE, int item, int wave, int lane) {
    const int fr = lane & 15, fq = lane >> 4, row = item * 128 + wave * 16 + fr;
    const bf16* ap = XN + (size_t)row * 2048 + fq * 8; const bf16* bp = BT + (size_t)fr * 2048 + fq * 8;
    f32x4 acc[4];
#pragma unroll
    for (int nb = 0; nb < 4; ++nb) acc[nb] = (f32x4){0.f, 0.f, 0.f, 0.f};
#pragma unroll 4
    for (int k0 = 0; k0 < 2048; k0 += 32) {
        const bf16x8 a = *(const bf16x8*)(ap + k0);
#pragma unroll
        for (int nb = 0; nb < 4; ++nb) { const bf16x8 b = *(const bf16x8*)(bp + (size_t)nb * 16 * 2048 + k0); acc[nb] = __builtin_amdgcn_mfma_f32_16x16x32_bf16(b, a, acc[nb], 0, 0, 0); }
    }
    const int pos = row & (SEQ - 1);
#pragma unroll
    for (int nb = 0; nb < 4; ++nb) { const int j0 = 8 * nb + 2 * fq; const f32x4 r = *(const f32x4*)(ROPE + (size_t)pos * 32 + j0); const f32x4 v = acc[nb];
        v2u o; o.x = pk2(v[0] * r[0] - v[1] * r[1], v[0] * r[1] + v[1] * r[0]); o.y = pk2(v[2] * r[2] - v[3] * r[3], v[2] * r[3] + v[3] * r[2]);
        *(v2u*)(KPE + (size_t)row * 64 + 16 * nb + 4 * fq) = o; }
}
namespace att {
typedef short v4i16_t __attribute__((ext_vector_type(4)));
#define MFMA32(a, b, c) __builtin_amdgcn_mfma_f32_32x32x16_bf16((a), (b), (c), 0, 0, 0)
__device__ __forceinline__ s16x4 vtr(const LAS unsigned char* p) { return __builtin_bit_cast(s16x4, __builtin_amdgcn_ds_read_tr16_b64_v4i16((LAS v4i16_t*)p)); }
__device__ __forceinline__ int crow(int r, int hi) { return (r & 3) + 8 * (r >> 2) + 4 * hi; }
constexpr int VS = 320;
constexpr int KS = 400;
constexpr float NEG = -1e30f;

__device__ __forceinline__ bf16x8 pack8r(const f32x16& p, int s) {
    v4u w; w.x = pk2(p[8 * s + 0], p[8 * s + 1]); w.y = pk2(p[8 * s + 2], p[8 * s + 3]); w.z = pk2(p[8 * s + 4], p[8 * s + 5]); w.w = pk2(p[8 * s + 6], p[8 * s + 7]);
    return __builtin_bit_cast(bf16x8, w);
}
__device__ __forceinline__ void pv32(f32x16 (&o)[4], const LAS unsigned char* vb, const bf16x8 pb0, const bf16x8 pb1) {
#pragma unroll
    for (int d = 0; d < 4; ++d) {
        const s16x4 l0 = vtr(vb + d * 64), h0 = vtr(vb + d * 64 + 8 * VS), l1 = vtr(vb + d * 64 + 16 * VS), h1 = vtr(vb + d * 64 + 24 * VS);
        const bf16x8 a0 = __builtin_shufflevector(l0, h0, 0, 1, 2, 3, 4, 5, 6, 7), a1 = __builtin_shufflevector(l1, h1, 0, 1, 2, 3, 4, 5, 6, 7);
        o[d] = MFMA32(a0, pb0, o[d]); o[d] = MFMA32(a1, pb1, o[d]);
    }
}
template <int NS>
__device__ __forceinline__ void softmax_step(f32x16 (&s)[NS], float& m, float& l, f32x16 (&o)[4], bf16x8 (&pb)[2 * NS]) {
    float mx = s[0][0];
#pragma unroll
    for (int t = 0; t < NS; ++t)
#pragma unroll
        for (int r = 0; r < 16; ++r) mx = fmaxf(mx, s[t][r]);
    mx = fmaxf(mx, __shfl_xor(mx, 32));
    const float mn = fmaxf(m, mx), alpha = __builtin_amdgcn_exp2f(m - mn); m = mn;
    float ps = 0.f;
#pragma unroll
    for (int t = 0; t < NS; ++t)
#pragma unroll
        for (int r = 0; r < 16; ++r) { const float p = __builtin_amdgcn_exp2f(s[t][r] - mn); s[t][r] = p; ps += p; }
    l = l * alpha + ps;
    if (!__all(alpha == 1.0f)) {
#pragma unroll
        for (int d = 0; d < 4; ++d) o[d] = o[d] * alpha;
    }
#pragma unroll
    for (int t = 0; t < NS; ++t) { pb[2 * t] = pack8r(s[t], 0); pb[2 * t + 1] = pack8r(s[t], 1); }
}
__device__ __forceinline__ void store_o(f32x16 (&o)[4], float l, bf16* __restrict__ orow  , float* __restrict__ ssq  , int hh) {
    l += __shfl_xor(l, 32);
    const float inv = 1.0f / l; float ss = 0.f;
#pragma unroll
    for (int d = 0; d < 4; ++d) { o[d] = o[d] * inv;
#pragma unroll
        for (int g = 0; g < 4; ++g) { const float a = o[d][4 * g], b = o[d][4 * g + 1], c = o[d][4 * g + 2], e = o[d][4 * g + 3];
            ss += (a * a + b * b) + (c * c + e * e);
            v2u w; w.x = pk2(a, b); w.y = pk2(c, e); *(v2u*)(orow + 32 * d + 8 * g + 4 * hh) = w; } }
    ss += __shfl_xor(ss, 32);
    if (hh == 0) *ssq = ss;
}

constexpr int KTB = 64 * KS, VTB = 64 * VS, BUFB = KTB + VTB;
__device__ __forceinline__ void mla_unit(const unsigned char* ws, LAS unsigned char* lds, int b, int h, int qblk, int tid, int wave, int lane) {
    const bf16* QN = (const bf16*)(ws + WS_QN); const bf16* QPE = (const bf16*)(ws + WS_QPE); const bf16* KN = (const bf16*)(ws + WS_KN);
    const bf16* KPE = (const bf16*)(ws + WS_KPE); const bf16* VM = (const bf16*)(ws + WS_VM);
    bf16* O = (bf16*)(ws + WS_A); float* SSQO = (float*)(ws + WS_SSQO);
    const int r32 = lane & 31, hh = lane >> 5;
    const size_t tok0 = (size_t)b * SEQ;
    const int row_lo = qblk * 256 + wave * 32, qrow = row_lo + r32;
    bf16x8 qf[12];
    { const bf16* qn = QN + (tok0 + qrow) * 1024 + h * 128 + 8 * hh;
#pragma unroll
      for (int s = 0; s < 8; ++s) qf[s] = *(const bf16x8*)(qn + 16 * s);
      const bf16* qp = QPE + (tok0 + qrow) * 512 + h * 64 + 8 * hh;
#pragma unroll
      for (int s = 0; s < 4; ++s) qf[8 + s] = *(const bf16x8*)(qp + 16 * s); }
    const int c0 = tid, c1 = tid + 512;
    const bf16* gkn0 = KN + (tok0 + (c0 >> 4)) * 1024 + h * 128 + (c0 & 15) * 8; const bf16* gkn1 = KN + (tok0 + (c1 >> 4)) * 1024 + h * 128 + (c1 & 15) * 8;
    const bf16* gkp = KPE + (tok0 + (tid >> 3)) * 64 + (tid & 7) * 8;
    const bf16* gv0 = VM + (tok0 + (c0 >> 4)) * 1024 + h * 128 + (c0 & 15) * 8; const bf16* gv1 = VM + (tok0 + (c1 >> 4)) * 1024 + h * 128 + (c1 & 15) * 8;
    const int lkn0 = (c0 >> 4) * KS + (c0 & 15) * 16, lkn1 = (c1 >> 4) * KS + (c1 & 15) * 16, lkp = (tid >> 3) * KS + 256 + (tid & 7) * 16;
    const int lv0 = KTB + (c0 >> 4) * VS + (c0 & 15) * 16, lv1 = KTB + (c1 >> 4) * VS + (c1 & 15) * 16;
    v4u st0, st1, st2, st3, st4;
#define MLA_GLOAD(kt) do { const size_t _o = (size_t)(kt) * 64; st0 = *(const v4u*)(gkn0 + _o * 1024); st1 = *(const v4u*)(gkn1 + _o * 1024); st2 = *(const v4u*)(gkp + _o * 64); \
        st3 = *(const v4u*)(gv0 + _o * 1024); st4 = *(const v4u*)(gv1 + _o * 1024); } while (0)
#define MLA_LWRITE(buf) do { LAS unsigned char* _b = lds + (buf) * BUFB; *(LAS v4u*)(_b + lkn0) = st0; *(LAS v4u*)(_b + lkn1) = st1; *(LAS v4u*)(_b + lkp) = st2; \
        *(LAS v4u*)(_b + lv0) = st3; *(LAS v4u*)(_b + lv1) = st4; } while (0)
    const int nkt = 4 * (qblk + 1);
    MLA_GLOAD(0); MLA_LWRITE(0);
    __syncthreads();
    f32x16 o[4];
#pragma unroll
    for (int d = 0; d < 4; ++d)
#pragma unroll
        for (int r = 0; r < 16; ++r) o[d][r] = 0.f;
    float m = NEG, l = 0.f;
    const int kread = r32 * KS + 16 * hh;
    const int vread = KTB + (4 * hh + ((lane & 15) >> 2)) * VS + (16 * ((lane >> 4) & 1) + 4 * (lane & 3)) * 2;
    for (int kt = 0; kt < nkt; ++kt) {
        if (kt + 1 < nkt) MLA_GLOAD(kt + 1);
        const int k0 = kt * 64;
        if (k0 <= row_lo + 31) {
            const LAS unsigned char* kb = lds + (kt & 1) * BUFB;
            f32x16 s[2];
#pragma unroll
            for (int r = 0; r < 16; ++r) { s[0][r] = 0.f; s[1][r] = 0.f; }
#pragma unroll
            for (int ks = 0; ks < 12; ++ks) { const bf16x8 k0f = *(const LAS bf16x8*)(kb + kread + 32 * ks), k1f = *(const LAS bf16x8*)(kb + kread + 32 * KS + 32 * ks);
                s[0] = MFMA32(k0f, qf[ks], s[0]); s[1] = MFMA32(k1f, qf[ks], s[1]); }
            if (k0 + 63 > row_lo) {
#pragma unroll
                for (int r = 0; r < 16; ++r) { const int key = k0 + crow(r, hh); if (key > qrow) s[0][r] = NEG; if (key + 32 > qrow) s[1][r] = NEG; }
            }
            bf16x8 pb[4];
            softmax_step<2>(s, m, l, o, pb);
            pv32(o, kb + vread, pb[0], pb[1]);
            pv32(o, kb + vread + 32 * VS, pb[2], pb[3]);
        }
        if (kt + 1 < nkt) MLA_LWRITE((kt + 1) & 1);
        __syncthreads();
    }
#undef MLA_GLOAD
#undef MLA_LWRITE
    store_o(o, l, O + (tok0 + qrow) * 2048 + 1024 + h * 128, SSQO + (tok0 + qrow) * 16 + 8 + h, hh);
}

__device__ __forceinline__ void dil_tile(const unsigned char* ws, LAS unsigned char* vl  , int b, int h, int j, int r16, int lane) {
    const bf16* QKV = (const bf16*)(ws + WS_B); bf16* O = (bf16*)(ws + WS_A); float* SSQO = (float*)(ws + WS_SSQO);
    const int r32 = lane & 31, hh = lane >> 5;
    const size_t tok0 = (size_t)b * SEQ;
    const int tq = 512 * j + 16 * r32 + r16;
    bf16x8 qf[8];
    { const bf16* qp = QKV + (tok0 + tq) * 3072 + h * 128 + 8 * hh;
#pragma unroll
      for (int s = 0; s < 8; ++s) qf[s] = *(const bf16x8*)(qp + 16 * s); }
    const float slope2 = __builtin_amdgcn_exp2f(-(float)(h + 1)) * LOG2E;
    const int m0 = (j == 0) ? 4 : 0, n3 = j + 1, n2 = 8 - m0, n1 = 20 - m0, nt = n3 + n2 + n1;
    const bf16* kcol = QKV + tok0 * 3072 + 1024 + h * 128 + 8 * hh;
    const bf16* vcol = QKV + tok0 * 3072 + 2048 + h * 128 + (lane & 15) * 8;
    const int vrow = lane >> 4;
    const int vwr = vrow * VS + (lane & 15) * 16;
    const int vread = (4 * hh + ((lane & 15) >> 2)) * VS + (16 * ((lane >> 4) & 1) + 4 * (lane & 3)) * 2;
    int kbase, kstride, maxd;
#define DIL_DESC(idx) do { const int _i = (idx); if (_i < n3) { kbase = 512 * (j - _i) + r16; kstride = 16; maxd = 2048; } \
        else if (_i < n3 + n2) { kbase = 4 * (128 * j - 128 + 32 * (m0 + _i - n3)) + (r16 & 3); kstride = 4; maxd = 512; } \
        else { kbase = 512 * j - 128 + 32 * (m0 + _i - n3 - n2); kstride = 1; maxd = 128; } } while (0)
    bf16x8 kc[8], kn[8]; v4u vn[8];
    DIL_DESC(0);
    { const bf16* kp = kcol + (size_t)(kbase + kstride * r32) * 3072;
#pragma unroll
      for (int s = 0; s < 8; ++s) kc[s] = *(const bf16x8*)(kp + 16 * s);
#pragma unroll
      for (int i = 0; i < 8; ++i) vn[i] = *(const v4u*)(vcol + (size_t)(kbase + kstride * (4 * i + vrow)) * 3072);
#pragma unroll
      for (int i = 0; i < 8; ++i) *(LAS v4u*)(vl + vwr + 4 * i * VS) = vn[i]; }
    f32x16 o[4];
#pragma unroll
    for (int d = 0; d < 4; ++d)
#pragma unroll
        for (int r = 0; r < 16; ++r) o[d][r] = 0.f;
    float m = NEG, l = 0.f;
    for (int idx = 0; idx < nt; ++idx) {
        const int cb = kbase, cs = kstride, cm = maxd;
        if (idx + 1 < nt) {
            DIL_DESC(idx + 1);
            const bf16* kp = kcol + (size_t)(kbase + kstride * r32) * 3072;
#pragma unroll
            for (int s = 0; s < 8; ++s) kn[s] = *(const bf16x8*)(kp + 16 * s);
#pragma unroll
            for (int i = 0; i < 8; ++i) vn[i] = *(const v4u*)(vcol + (size_t)(kbase + kstride * (4 * i + vrow)) * 3072);
        }
        f32x16 s[1];
#pragma unroll
        for (int r = 0; r < 16; ++r) s[0][r] = 0.f;
#pragma unroll
        for (int ks = 0; ks < 8; ++ks) s[0] = MFMA32(kc[ks], qf[ks], s[0]);
        const int d0 = tq - cb - cs * 4 * hh;
#pragma unroll
        for (int r = 0; r < 16; ++r) { const int dist = d0 - cs * ((r & 3) + 8 * (r >> 2)); const float v = s[0][r] - slope2 * (float)dist; s[0][r] = ((unsigned)dist <= (unsigned)cm) ? v : NEG; }
        bf16x8 pb[2];
        softmax_step<1>(s, m, l, o, pb);
        pv32(o, vl + vread, pb[0], pb[1]);
        if (idx + 1 < nt) {
#pragma unroll
            for (int i = 0; i < 8; ++i) *(LAS v4u*)(vl + vwr + 4 * i * VS) = vn[i];
#pragma unroll
            for (int s2 = 0; s2 < 8; ++s2) kc[s2] = kn[s2];
        }
    }
#undef DIL_DESC
    store_o(o, l, O + (tok0 + tq) * 2048 + h * 128, SSQO + (tok0 + tq) * 16 + h, hh);
}

__device__ __forceinline__ void phase_attn(const Params& P, LAS unsigned char* lds, int vcu, int G) {
    int tid_ = threadIdx.x; asm volatile("" : "+v"(tid_));
    const int tid = tid_, lane = tid & 63, wave = __builtin_amdgcn_readfirstlane(tid >> 6);
    const unsigned char* ws = P.ws;
    for (int u = vcu; u < 256; u += G) { const int bh = u >> 2, pr = u & 3;
        mla_unit(ws, lds, bh >> 3, bh & 7, 7 - pr, tid, wave, lane);
        mla_unit(ws, lds, bh >> 3, bh & 7, pr, tid, wave, lane); }
    __syncthreads();
    LAS unsigned char* vl = lds + wave * (32 * VS);
    if (G == 256) {
#pragma unroll 1
        for (int k = 0; k < 2; ++k) { const int t = (vcu >> 5) * 512 + k * 256 + (vcu & 31) * 8 + wave; const int bh = t >> 6, rem = t & 63, jj = rem >> 4, r16 = rem & 15;
            dil_tile(ws, vl, bh >> 3, bh & 7, k == 0 ? jj : 3 - jj, r16, lane); }
    } else {
#pragma unroll 1
        for (int t = vcu * 8 + wave; t < 4096; t += G * 8) { const int bh = t >> 6, rem = t & 63; dil_tile(ws, vl, bh >> 3, bh & 7, rem >> 4, rem & 15, lane); }
    }
}
}
namespace peer {
typedef __bf16 bf2_t __attribute__((ext_vector_type(2)));
#define MFMA32(a, b, c) __builtin_amdgcn_mfma_f32_32x32x16_bf16((a), (b), (c), 0, 0, 0)
__device__ __forceinline__ float fmax3(float a, float b, float c) { return fmaxf(fmaxf(a, b), c); }
__device__ __forceinline__ float asf(unsigned u) { return __builtin_bit_cast(float, u); }
__device__ __forceinline__ unsigned asu(float f) { return __builtin_bit_cast(unsigned, f); }

__device__ __forceinline__ void route_item(const unsigned char* ws, LAS unsigned* sc, int tile, int h, int lane) {
    const bf16* QP = (const bf16*)(ws + WS_QP); const bf16* SK = (const bf16*)(ws + WS_SK);
    int* RIDX = (int*)(ws + WS_RIDX); float* RGATE = (float*)(ws + WS_RGATE);
    const int r32 = lane & 31, hh = lane >> 5;
    const size_t tok = (size_t)tile * 32 + r32;
#pragma unroll 1
    for (int p = 0; p < 2; ++p) {
        f32x16 s[4];
#pragma unroll
        for (int kb = 0; kb < 4; ++kb)
#pragma unroll
            for (int r = 0; r < 16; ++r) s[kb][r] = 0.f;
        const bf16* qp = QP + tok * 2048 + h * 256 + p * 128 + 8 * hh;
        const bf16* kp = SK + ((size_t)(h * 2 + p) * 128 + r32) * 128 + 8 * hh;
#pragma unroll
        for (int ks = 0; ks < 8; ++ks) { const bf16x8 q = *(const bf16x8*)(qp + 16 * ks);
#pragma unroll
            for (int kb = 0; kb < 4; ++kb) { const bf16x8 k = *(const bf16x8*)(kp + (size_t)kb * 32 * 128 + 16 * ks); s[kb] = MFMA32(k, q, s[kb]); } }
#pragma unroll
        for (int kb = 0; kb < 4; ++kb)
#pragma unroll
            for (int r = 0; r < 16; ++r) s[kb][r] = asf((asu(s[kb][r]) & ~127u) | (unsigned)(32 * kb + (r & 3) + 8 * (r >> 2) + 4 * hh));
#pragma unroll 1
        for (int k = 0; k < 16; ++k) {
            float mx = s[0][0];
#pragma unroll
            for (int kb = 0; kb < 4; ++kb)
#pragma unroll
                for (int r = 0; r < 16; r += 2) mx = fmax3(mx, s[kb][r], s[kb][r + 1]);
            mx = fmaxf(mx, __shfl_xor(mx, 32));
            if (hh == 0) sc[(p * 32 + r32) * 16 + k] = asu(mx);
#pragma unroll
            for (int kb = 0; kb < 4; ++kb)
#pragma unroll
                for (int r = 0; r < 16; ++r) s[kb][r] = (s[kb][r] == mx) ? -3.0e38f : s[kb][r];
        }
    }
    unsigned t1[16], t2[16];
#pragma unroll
    for (int i = 0; i < 16; i += 4) { const v4u a = *(const LAS v4u*)(sc + r32 * 16 + i), b = *(const LAS v4u*)(sc + (32 + r32) * 16 + i);
        t1[i] = a.x; t1[i + 1] = a.y; t1[i + 2] = a.z; t1[i + 3] = a.w; t2[i] = b.x; t2[i + 1] = b.y; t2[i + 2] = b.z; t2[i + 3] = b.w; }
    float c[50]; int n = 0;
#pragma unroll
    for (int i = 0; i < 16; ++i)
#pragma unroll
        for (int j = 0; j < 16; ++j) if ((i + 1) * (j + 1) <= 16) { const float v = asf(t1[i] & ~127u) + asf(t2[j] & ~127u); c[n] = asf((asu(v) & ~255u) | (unsigned)(i * 16 + j)); ++n; }
    float best[8]; float bmax = 0.f, esum = 0.f;
#pragma unroll
    for (int k = 0; k < 16; ++k) {
        float mx = c[0];
#pragma unroll
        for (int q = 1; q < 49; q += 2) mx = fmax3(mx, c[q], c[q + 1]);
        mx = fmaxf(mx, c[49]);
#pragma unroll
        for (int q = 0; q < 50; ++q) c[q] = (c[q] == mx) ? -3.0e38f : c[q];
        const float val = asf(asu(mx) & ~255u);
        if (k == 0) bmax = val;
        esum += __expf(val - bmax);
        if ((k >> 3) == hh) best[k & 7] = mx;
    }
    const float inv = 1.0f / esum;
    int idx[8]; float gate[8];
#pragma unroll
    for (int k = 0; k < 8; ++k) { const unsigned code = asu(best[k]) & 255u; const unsigned a = sc[r32 * 16 + (code >> 4)], b = sc[(32 + r32) * 16 + (code & 15)];
        idx[k] = (int)((a & 127u) * 128u + (b & 127u)); gate[k] = __expf(asf(asu(best[k]) & ~255u) - bmax) * inv; }
    int* ip = RIDX + tok * 128 + h * 16 + 8 * hh; float* gp = RGATE + tok * 128 + h * 16 + 8 * hh;
    *(v4u*)ip = (v4u){(unsigned)idx[0], (unsigned)idx[1], (unsigned)idx[2], (unsigned)idx[3]}; *(v4u*)(ip + 4) = (v4u){(unsigned)idx[4], (unsigned)idx[5], (unsigned)idx[6], (unsigned)idx[7]};
    *(f32x4*)gp = (f32x4){gate[0], gate[1], gate[2], gate[3]}; *(f32x4*)(gp + 4) = (f32x4){gate[4], gate[5], gate[6], gate[7]};
}

__device__ __forceinline__ void phase_route(const Params& P, LAS unsigned char* lds, int vcu, int G) {
    int tid_ = threadIdx.x; asm volatile("" : "+v"(tid_));
    const int lane = tid_ & 63, wave = __builtin_amdgcn_readfirstlane(tid_ >> 6);
    LAS unsigned* sc = (LAS unsigned*)(lds + wave * 4096);
#pragma unroll 1
    for (int it = vcu * NWAVES + wave; it < 512 * 8; it += G * NWAVES) route_item(P.ws, sc, it >> 3, it & 7, lane);
}

__device__ __forceinline__ float dot2(unsigned a, unsigned b, float c) { return __builtin_amdgcn_fdot2_f32_bf16(__builtin_bit_cast(bf2_t, a), __builtin_bit_cast(bf2_t, b), c, false); }
__device__ __forceinline__ float dot8(const v4u& a, const v4u& b, float c) {
    const unsigned a0 = a.x, a1 = a.y, a2 = a.z, a3 = a.w, b0 = b.x, b1 = b.y, b2 = b.z, b3 = b.w;
    c = dot2(a0, b0, c); c = dot2(a1, b1, c); c = dot2(a2, b2, c); c = dot2(a3, b3, c);
    return c;
}
__device__ __forceinline__ void axpy8(float (&y)[8], float a, const v4u& v) {
    y[0] = fmaf(a, bflo(v.x), y[0]); y[1] = fmaf(a, bfhi(v.x), y[1]); y[2] = fmaf(a, bflo(v.y), y[2]); y[3] = fmaf(a, bfhi(v.y), y[3]);
    y[4] = fmaf(a, bflo(v.z), y[4]); y[5] = fmaf(a, bfhi(v.z), y[5]); y[6] = fmaf(a, bflo(v.w), y[6]); y[7] = fmaf(a, bfhi(v.w), y[7]);
}
__device__ __forceinline__ void peer_token(const Params& P, size_t tok, int lane) {
    const unsigned char* ws = P.ws;
    const bf16* H1B = (const bf16*)(ws + WS_B); const bf16* UB = (const bf16*)(ws + WS_UB); const bf16* VB = (const bf16*)(ws + WS_VB);
    const int* RIDX = (const int*)(ws + WS_RIDX); const float* RGATE = (const float*)(ws + WS_RGATE); const float* SSQH = (const float*)(ws + WS_SSQH);
    v4u xr[4];
#pragma unroll
    for (int j = 0; j < 4; ++j) xr[j] = *(const v4u*)(H1B + tok * 2048 + 8 * lane + 512 * j);
    const float rs2 = rsqrtf(wave_sum(lane < 32 ? SSQH[tok * 32 + lane] : 0.f) * (1.f / 2048.f) + EPS);
    const int i0 = RIDX[tok * 128 + lane], i1 = RIDX[tok * 128 + 64 + lane];
    const float g0 = RGATE[tok * 128 + lane], g1 = RGATE[tok * 128 + 64 + lane];
    float d0 = 0.f, d1 = 0.f;
#pragma unroll 1
    for (int g = 0; g < 16; ++g) {
        float pt[8];
#pragma unroll
        for (int e = 0; e < 8; ++e) { const int row = __builtin_amdgcn_readlane(g < 8 ? i0 : i1, (g & 7) * 8 + e);
            const bf16* up = UB + (size_t)row * 2048 + 8 * lane; float s = 0.f;
#pragma unroll
            for (int j = 0; j < 4; ++j) s = dot8(xr[j], *(const v4u*)(up + 512 * j), s);
            pt[e] = s; }
        float a4[4], a2[2], a1;
#pragma unroll
        for (int i = 0; i < 4; ++i) { const float keep = (lane & 1) ? pt[2 * i + 1] : pt[2 * i], give = (lane & 1) ? pt[2 * i] : pt[2 * i + 1]; a4[i] = keep + __shfl_xor(give, 1); }
#pragma unroll
        for (int i = 0; i < 2; ++i) { const float keep = (lane & 2) ? a4[2 * i + 1] : a4[2 * i], give = (lane & 2) ? a4[2 * i] : a4[2 * i + 1]; a2[i] = keep + __shfl_xor(give, 2); }
        { const float keep = (lane & 4) ? a2[1] : a2[0], give = (lane & 4) ? a2[0] : a2[1]; a1 = keep + __shfl_xor(give, 4); }
        a1 += __shfl_xor(a1, 8); a1 += __shfl_xor(a1, 16); a1 += __shfl_xor(a1, 32);
        if ((lane >> 3) == (g & 7)) { if (g < 8) d0 = a1; else d1 = a1; }
    }
    float z0 = d0 * rs2, z1 = d1 * rs2;
    const float a0 = 0.5f * z0 * (1.0f + erff(z0 * 0.7071067811865476f)) * g0, a1v = 0.5f * z1 * (1.0f + erff(z1 * 0.7071067811865476f)) * g1;
    float y[4][8];
#pragma unroll
    for (int j = 0; j < 4; ++j) { y[j][0] = bflo(xr[j].x); y[j][1] = bfhi(xr[j].x); y[j][2] = bflo(xr[j].y); y[j][3] = bfhi(xr[j].y); y[j][4] = bflo(xr[j].z); y[j][5] = bfhi(xr[j].z); y[j][6] = bflo(xr[j].w); y[j][7] = bfhi(xr[j].w); }
#pragma unroll 1
    for (int g = 0; g < 16; ++g) {
#pragma unroll
        for (int e = 0; e < 8; ++e) { const int src = (g & 7) * 8 + e; const int row = __builtin_amdgcn_readlane(g < 8 ? i0 : i1, src);
            const float ae = __builtin_bit_cast(float, __builtin_amdgcn_readlane(__builtin_bit_cast(int, g < 8 ? a0 : a1v), src));
            const bf16* vp = VB + (size_t)row * 2048 + 8 * lane;
#pragma unroll
            for (int j = 0; j < 4; ++j) axpy8(y[j], ae, *(const v4u*)(vp + 512 * j)); }
    }
    float ss = 0.f;
#pragma unroll
    for (int j = 0; j < 4; ++j)
#pragma unroll
        for (int i = 0; i < 8; ++i) ss += y[j][i] * y[j][i];
    const float rsf = rsqrtf(wave_sum(ss) * (1.f / 2048.f) + EPS);
#pragma unroll
    for (int j = 0; j < 4; ++j) { const f32x4 ga = *(const f32x4*)(P.lnf + 8 * lane + 512 * j), gb = *(const f32x4*)(P.lnf + 8 * lane + 512 * j + 4);
        float* op = P.out + tok * 2048 + 8 * lane + 512 * j;
        *(f32x4*)op = (f32x4){y[j][0] * rsf * ga[0], y[j][1] * rsf * ga[1], y[j][2] * rsf * ga[2], y[j][3] * rsf * ga[3]};
        *(f32x4*)(op + 4) = (f32x4){y[j][4] * rsf * gb[0], y[j][5] * rsf * gb[1], y[j][6] * rsf * gb[2], y[j][7] * rsf * gb[3]}; }
}
__device__ __forceinline__ void phase_peer(const Params& P, int vcu, int G) {
    int tid_ = threadIdx.x; asm volatile("" : "+v"(tid_));
    const int lane = tid_ & 63, wave = __builtin_amdgcn_readfirstlane(tid_ >> 6);
#pragma unroll 1
    for (int t = vcu * NWAVES + wave; t < M; t += G * NWAVES) peer_token(P, (size_t)t, lane);
}
#undef MFMA32
}
constexpr int N_PHASES = 8;
__global__ void __launch_bounds__(NTHREADS, 2) mega(Params P) {
    extern __shared__ __attribute__((aligned(16))) unsigned char lds_raw[];
    LAS unsigned char* lds = (LAS unsigned char*)lds_raw;
    cg::grid_group grid = cg::this_grid();
    const int tid = threadIdx.x, lane = tid & 63, wave = __builtin_amdgcn_readfirstlane(tid >> 6);
    const int G = gridDim.x, bx = blockIdx.x;
    const int vcu = (G % 8 == 0) ? (bx % 8) * (G / 8) + bx / 8 : bx;
    unsigned char* ws = P.ws;
    const int lo = P.ph_lo, hi = P.ph_hi;
#define IN(k) (lo <= (k) && (k) < hi)
#define SEAM(k) do { if (IN(k) && IN((k) + 1)) grid.sync(); } while (0)

    if (IN(0)) { phase_prep(P, lds, vcu, G); }
    SEAM(0);
    if (IN(1)) {
        pg8::GemmSet g; g.A0 = g.A1 = (const bf16*)(ws + WS_A); g.Bt0 = g.Bt1 = (const bf16*)(ws + WS_BT1); g.K = 2048;
        pg8::StaticOrder S; S.init(M, 4096, 0, G, bx);
        pg8::Epi1 E{(bf16*)(ws + WS_B), (bf16*)(ws + WS_CQ), (bf16*)(ws + WS_CKV), (float*)(ws + WS_SSQCQ), (float*)(ws + WS_SSQCKV)};
        pg8::gemm_phase<pg8::Epi1, pg8::StaticOrder>(lds, g, S, E);
    }
    SEAM(1);
    if (IN(2)) {
        pg8::GemmSet g; g.A0 = (const bf16*)(ws + WS_CQ); g.A1 = (const bf16*)(ws + WS_CKV); g.Bt0 = (const bf16*)(ws + WS_BT2Q); g.Bt1 = (const bf16*)(ws + WS_BT2KV); g.K = 512;
        pg8::StaticOrder S; S.init(M, 1536, 2048, G, bx);
        pg8::Epi2 E{(bf16*)(ws + WS_QN), (bf16*)(ws + WS_QPE), (bf16*)(ws + WS_KN), (bf16*)(ws + WS_VM), (const float*)(ws + WS_SSQCQ), (const float*)(ws + WS_SSQCKV), (const f32x2*)(ws + WS_ROPE)};
        pg8::gemm_phase<pg8::Epi2, pg8::StaticOrder>(lds, g, S, E);
        for (int it = G - 1 - bx; it < 128; it += G) kr_item((const bf16*)(ws + WS_A), (const bf16*)(ws + WS_BTKR), (const f32x2*)(ws + WS_ROPE), (bf16*)(ws + WS_KPE), it, wave, lane);
    }
    SEAM(2);
    if (IN(3)) { att::phase_attn(P, lds, vcu, G); }
    SEAM(3);
    if (IN(4)) {
        pg8::GemmSet g; g.A0 = g.A1 = (const bf16*)(ws + WS_A); g.Bt0 = g.Bt1 = (const bf16*)(ws + WS_BT3); g.K = 2048;
        pg8::StaticOrder S; S.init(M, 2048, 0, G, bx);
        pg8::Epi3 E{(bf16*)(ws + WS_B), P.x, (const float*)(ws + WS_SSQO), (float*)(ws + WS_SSQH), (LAS f32x2*)(lds + MISC_OFF)};
        pg8::gemm_phase<pg8::Epi3, pg8::StaticOrder>(lds, g, S, E);
    }
    SEAM(4);
    if (IN(5)) {
        pg8::GemmSet g; g.A0 = g.A1 = (const bf16*)(ws + WS_B); g.Bt0 = g.Bt1 = (const bf16*)(ws + WS_BT4); g.K = 2048;
        pg8::StaticOrder S; S.init(M, 2048, 0, G, bx);
        pg8::Epi4 E{(bf16*)(ws + WS_QP), (const float*)(ws + WS_SSQH), (LAS f32x2*)(lds + MISC_OFF)};
        pg8::gemm_phase<pg8::Epi4, pg8::StaticOrder>(lds, g, S, E);
    }
    SEAM(5);
    if (IN(6)) { peer::phase_route(P, lds, vcu, G); }
    SEAM(6);
    if (IN(7)) { peer::phase_peer(P, vcu, G); }
#undef IN
#undef SEAM
}

static int mega_grid() {
    static int grid = 0;
    if (grid == 0) {
        int dev = 0, cus = 0, per_cu = 0;
        (void)hipGetDevice(&dev); (void)hipDeviceGetAttribute(&cus, hipDeviceAttributeMultiprocessorCount, dev);
        (void)hipFuncSetAttribute((const void*)mega, hipFuncAttributeMaxDynamicSharedMemorySize, LDS_BYTES);
        (void)hipOccupancyMaxActiveBlocksPerMultiprocessor(&per_cu, (const void*)mega, NTHREADS, LDS_BYTES);
        if (per_cu < 1) { fprintf(stderr, "mega: occupancy query says %d blocks/CU\n", per_cu); per_cu = 1; }
        grid = cus;
        (void)hipGetLastError();
    }
    return grid;
}
static void fill_params(Params& P, void* const* d_in, void* d_out, void* d_ws) {
    P.x = (const float*)d_in[0]; P.ln1 = (const float*)d_in[1]; P.w_in = (const float*)d_in[2]; P.qan = (const float*)d_in[3]; P.kvan = (const float*)d_in[4];
    P.w_uq = (const float*)d_in[5]; P.w_ukv = (const float*)d_in[6]; P.ond = (const float*)d_in[7]; P.onm = (const float*)d_in[8]; P.w_o = (const float*)d_in[9];
    P.ln2 = (const float*)d_in[10]; P.wq = (const float*)d_in[11]; P.sk = (const float*)d_in[12]; P.pu = (const float*)d_in[13]; P.pv = (const float*)d_in[14]; P.lnf = (const float*)d_in[15];
    P.out = (float*)d_out; P.ws = (unsigned char*)d_ws;
}
static void launch_phases(Params P, int lo, int hi, hipStream_t st) {
    P.ph_lo = lo; P.ph_hi = hi;
    void* args[] = {&P};
    hipError_t e = hipLaunchCooperativeKernel((const void*)mega, dim3(mega_grid()), dim3(NTHREADS), args, LDS_BYTES, st);
    if (e != hipSuccess) fprintf(stderr, "mega launch [%d,%d) failed: %s\n", lo, hi, hipGetErrorString(e));
}
extern "C" void kernel_launch(void* const* d_in, const int* in_sizes, int n_in, void* d_out, int out_size, void* d_ws, size_t ws_size, hipStream_t stream) {
    Params P{}; fill_params(P, d_in, d_out, d_ws);
    launch_phases(P, 0, N_PHASES, stream);
}
```

```cpp
#include <hip/hip_runtime.h>
#include <hip/hip_cooperative_groups.h>
#include <cstdio>
#include <cstdint>
namespace cg = cooperative_groups;
#define GAS __attribute__((address_space(1)))
#define LAS __attribute__((address_space(3)))
typedef unsigned short bf16;
typedef unsigned v4u __attribute__((ext_vector_type(4)));
typedef unsigned v2u __attribute__((ext_vector_type(2)));
typedef float f32x2 __attribute__((ext_vector_type(2)));
typedef float f32x4 __attribute__((ext_vector_type(4)));
typedef float f32x16 __attribute__((ext_vector_type(16)));
typedef short bf16x8 __attribute__((ext_vector_type(8)));
typedef short s16x4 __attribute__((ext_vector_type(4)));
typedef __bf16 bf16x2_t __attribute__((ext_vector_type(2)));

constexpr int M = 16384, SEQ = 2048, DM = 2048, NWAVES = 8, NTHREADS = 512;
constexpr float EPS = 1e-6f, LOG2E = 1.4426950408889634f;
constexpr float QSCALE_DIL = 0.08838834764831845f * LOG2E;
constexpr float QSCALE_MLA = 0.07216878364870323f * LOG2E;

constexpr size_t MiB = 1u << 20;
constexpr size_t WS_CTL = 0, CTL_ZERO_BYTES = 64 * 1024;
constexpr size_t WS_ROPE = 1 * MiB;
constexpr size_t WS_SK = 2 * MiB;
constexpr size_t WS_BTKR = 3 * MiB;
constexpr size_t WS_BT2Q = 4 * MiB;
constexpr size_t WS_BT2KV = 6 * MiB;
constexpr size_t WS_BT1 = 8 * MiB;
constexpr size_t WS_BT3 = 24 * MiB;
constexpr size_t WS_BT4 = 32 * MiB;
constexpr size_t WS_SSQCQ = 40 * MiB;
constexpr size_t WS_SSQCKV = 40 * MiB + 512 * 1024;
constexpr size_t WS_SSQO = 41 * MiB;
constexpr size_t WS_SSQH = 42 * MiB;
constexpr size_t WS_KPE = 44 * MiB;
constexpr size_t WS_UB = 48 * MiB;
constexpr size_t WS_VB = 112 * MiB;
constexpr size_t WS_A = 176 * MiB;
constexpr size_t WS_B = 240 * MiB;
constexpr size_t WS_C = 336 * MiB;
constexpr size_t WS_QN = WS_C, WS_QPE = WS_C + 32 * MiB, WS_KN = WS_C + 48 * MiB, WS_VM = WS_C + 80 * MiB;
constexpr size_t WS_QP = WS_C, WS_RIDX = WS_C + 64 * MiB, WS_RGATE = WS_C + 72 * MiB, WS_PKV = WS_C + 80 * MiB;
constexpr size_t WS_D = 448 * MiB;
constexpr size_t WS_CQ = WS_D, WS_CKV = WS_D + 16 * MiB;
constexpr size_t WS_END = 480 * MiB;

constexpr int RING_BYTES = 131072;
constexpr int MISC_OFF = RING_BYTES;
constexpr int LDS_BYTES = 147456;

#define LDS_WAIT() asm volatile("s_waitcnt lgkmcnt(0)" ::: "memory")
#define VM_WAIT() asm volatile("s_waitcnt vmcnt(0)" ::: "memory")

__device__ __forceinline__ unsigned f2bf(float f) { unsigned u = __builtin_bit_cast(unsigned, f); return (u + 0x7fffu + ((u >> 16) & 1u)) >> 16; }
__device__ __forceinline__ unsigned pk2(float lo, float hi) { f32x2 v = {lo, hi}; bf16x2_t b = __builtin_convertvector(v, bf16x2_t); return __builtin_bit_cast(unsigned, b); }
__device__ __forceinline__ float bflo(unsigned u) { return __builtin_bit_cast(float, u << 16); }
__device__ __forceinline__ float bfhi(unsigned u) { return __builtin_bit_cast(float, u & 0xffff0000u); }
__device__ __forceinline__ float bf2f(bf16 b) { return __builtin_bit_cast(float, (unsigned)b << 16); }
__device__ __forceinline__ float wave_sum(float v) {
#pragma unroll
    for (int o = 1; o < 64; o <<= 1) v += __shfl_xor(v, o);
    return v;
}

struct Params {
    const float *x, *ln1, *w_in, *qan, *kvan, *w_uq, *w_ukv, *ond, *onm, *w_o, *ln2, *wq, *sk, *pu, *pv, *lnf;
    float* out; unsigned char* ws;
    int ph_lo, ph_hi;
};
__device__ __forceinline__ int map_ident(int c) { return c; }
__device__ __forceinline__ int map_kr(int c) { const int p = c - 4096; return 2 * (p & 31) + (p >> 5); }
__device__ __forceinline__ int map_uq(int c) { const int h = c / 192, e = c % 192; if (e < 128) return h * 128 + e; const int p = e - 128; return 1024 + h * 64 + 2 * (p & 31) + (p >> 5); }
__device__ __forceinline__ int map_ukv(int c) { const int h = c >> 8, e = c & 255; return e < 128 ? h * 128 + e : 1024 + h * 128 + (e - 128); }

template <int MAP>
__device__ __forceinline__ void p0_transpose_item(const float* __restrict__ W, int K, int ldw, int c0, const float* __restrict__ g0, const float* __restrict__ g1, int gsplit,
                                                  bf16* __restrict__ WT, LAS float* scr, int item, int nblk, int lane) {
    const int kb = item / nblk, nb = item % nblk, k0 = 64 * kb, n0 = c0 + 32 * nb;
#pragma unroll 8
    for (int i = 0; i < 32; ++i) { const int kk = 2 * i + (lane >> 5); const int k = k0 + kk;
        float w = W[(size_t)k * ldw + n0 + (lane & 31)];
        if (g0) w *= (k < gsplit ? g0[k] : g1[k - gsplit]);
        scr[kk * 33 + (lane & 31)] = w; }
    LDS_WAIT(); asm volatile("" ::: "memory");
    const int c = lane & 7;
#pragma unroll
    for (int j = 0; j < 4; ++j) { const int n = (lane >> 3) + 8 * j; const LAS float* s = scr + (8 * c) * 33 + n;
        v4u o; o.x = pk2(s[0 * 33], s[1 * 33]); o.y = pk2(s[2 * 33], s[3 * 33]); o.z = pk2(s[4 * 33], s[5 * 33]); o.w = pk2(s[6 * 33], s[7 * 33]);
        const int src = n0 + n;
        const int dr = MAP == 0 ? map_ident(src) : MAP == 1 ? map_kr(src) : MAP == 2 ? map_uq(src) : map_ukv(src);
        *(v4u*)(WT + (size_t)dr * K + k0 + 8 * c) = o; }
    LDS_WAIT(); asm volatile("" ::: "memory");
}

__device__ __forceinline__ void phase_prep(const Params& P, LAS unsigned char* lds, int vcu, int G) {
    int tid_ = threadIdx.x; asm volatile("" : "+v"(tid_));
    const int tid = tid_, lane = tid & 63, wave = __builtin_amdgcn_readfirstlane(tid >> 6);
    unsigned char* ws = P.ws;
    LAS float* scr = (LAS float*)(lds + wave * 16384);
    const int gw = vcu * NWAVES + wave, NGW = G * NWAVES;
    constexpr int I1 = 32 * 128, IKR = 32 * 2, I2Q = 8 * 48, I2KV = 8 * 64, I3 = 32 * 64, I4 = 32 * 64;
    constexpr int NITEMS = I1 + IKR + I2Q + I2KV + I3 + I4;
    for (int it = gw; it < NITEMS; it += NGW) {
        int r = it;
        if (r < I1) { p0_transpose_item<0>(P.w_in, 2048, 4160, 0, nullptr, nullptr, 0, (bf16*)(ws + WS_BT1), scr, r, 128, lane); continue; } r -= I1;
        if (r < IKR) { p0_transpose_item<1>(P.w_in, 2048, 4160, 4096, nullptr, nullptr, 0, (bf16*)(ws + WS_BTKR), scr, r, 2, lane); continue; } r -= IKR;
        if (r < I2Q) { p0_transpose_item<2>(P.w_uq, 512, 1536, 0, P.qan, P.qan, 512, (bf16*)(ws + WS_BT2Q), scr, r, 48, lane); continue; } r -= I2Q;
        if (r < I2KV) { p0_transpose_item<3>(P.w_ukv, 512, 2048, 0, P.kvan, P.kvan, 512, (bf16*)(ws + WS_BT2KV), scr, r, 64, lane); continue; } r -= I2KV;
        if (r < I3) { p0_transpose_item<0>(P.w_o, 2048, 2048, 0, P.ond, P.onm, 1024, (bf16*)(ws + WS_BT3), scr, r, 64, lane); continue; } r -= I3;
        p0_transpose_item<0>(P.wq, 2048, 2048, 0, P.ln2, P.ln2, 2048, (bf16*)(ws + WS_BT4), scr, r, 64, lane);
    }
    {
        bf16* XN = (bf16*)(ws + WS_A);
        f32x4 gv[8];
#pragma unroll
        for (int j = 0; j < 8; ++j) gv[j] = ((const f32x4*)P.ln1)[lane + 64 * j];
        for (int m = gw; m < M; m += NGW) {
            const f32x4* xr = (const f32x4*)(P.x + (size_t)m * DM) + lane;
            f32x4 v[8]; float s = 0.f;
#pragma unroll
            for (int j = 0; j < 8; ++j) { v[j] = xr[64 * j]; s += (v[j].x * v[j].x + v[j].y * v[j].y) + (v[j].z * v[j].z + v[j].w * v[j].w); }
            const float rs = rsqrtf(wave_sum(s) * (1.f / DM) + EPS);
            v2u* o8 = (v2u*)(XN + (size_t)m * DM) + lane;
#pragma unroll
            for (int j = 0; j < 8; ++j) { v2u o; o.x = pk2(v[j].x * rs * gv[j].x, v[j].y * rs * gv[j].y); o.y = pk2(v[j].z * rs * gv[j].z, v[j].w * rs * gv[j].w); o8[64 * j] = o; }
        }
    }
    const int gt = vcu * NTHREADS + tid, NGT = G * NTHREADS;
    {
        f32x2* R = (f32x2*)(ws + WS_ROPE);
        for (int i = gt; i < 2048 * 32; i += NGT) { const int pos = i >> 5, j = i & 31; const float freq = powf(10000.0f, -(float)j / 32.0f), ang = (float)pos * freq;
            f32x2 cs; cs.x = cosf(ang); cs.y = sinf(ang); R[i] = cs; }
    }
    {
        v4u* o = (v4u*)(ws + WS_SK);
        for (int i = gt; i < 16 * 128 * 128 / 8; i += NGT) { const f32x4 a = ((const f32x4*)P.sk)[2 * i], b = ((const f32x4*)P.sk)[2 * i + 1];
            v4u w; w.x = pk2(a.x, a.y); w.y = pk2(a.z, a.w); w.z = pk2(b.x, b.y); w.w = pk2(b.z, b.w); o[i] = w; }
    }
    {
        v2u* ou = (v2u*)(ws + WS_UB);
        for (int i = gt; i < 16384 * 2048 / 8; i += NGT) {
            const f32x4 a = __builtin_nontemporal_load((const f32x4*)P.pu + 2 * i), b = __builtin_nontemporal_load((const f32x4*)P.pu + 2 * i + 1);
            const int k8 = (i & 255) * 2; const f32x4 g0 = ((const f32x4*)P.ln2)[k8] * 32.f, g1 = ((const f32x4*)P.ln2)[k8 + 1] * 32.f;
            int w0 = 0, w1 = 0;
            w0 = __builtin_amdgcn_cvt_pk_fp8_f32(a.x * g0.x, a.y * g0.y, w0, false); w0 = __builtin_amdgcn_cvt_pk_fp8_f32(a.z * g0.z, a.w * g0.w, w0, true);
            w1 = __builtin_amdgcn_cvt_pk_fp8_f32(b.x * g1.x, b.y * g1.y, w1, false); w1 = __builtin_amdgcn_cvt_pk_fp8_f32(b.z * g1.z, b.w * g1.w, w1, true);
            v2u w; w.x = (unsigned)w0; w.y = (unsigned)w1; ou[i] = w;
        }
        __syncthreads();
        LAS v2u* tl = (LAS v2u*)lds;
        v2u* ov = (v2u*)(ws + WS_VB);
        for (int tile = vcu; tile < 1024; tile += G) {
            const int e0 = (tile >> 2) * 64, c0 = (tile & 3) * 64;
#pragma unroll
            for (int k = 0; k < 8; ++k) { const int it = tid + 512 * k, e = it >> 6, c = it & 63;
                const f32x4* src = (const f32x4*)(P.pv + (size_t)(e0 + e) * 2048 + (size_t)(c0 + c) * 8);
                const f32x4 a = __builtin_nontemporal_load(src), b = __builtin_nontemporal_load(src + 1);
                int w0 = 0, w1 = 0;
                w0 = __builtin_amdgcn_cvt_pk_fp8_f32(a.x * 2.f, a.y * 2.f, w0, false); w0 = __builtin_amdgcn_cvt_pk_fp8_f32(a.z * 2.f, a.w * 2.f, w0, true);
                w1 = __builtin_amdgcn_cvt_pk_fp8_f32(b.x * 2.f, b.y * 2.f, w1, false); w1 = __builtin_amdgcn_cvt_pk_fp8_f32(b.z * 2.f, b.w * 2.f, w1, true);
                v2u w; w.x = (unsigned)w0; w.y = (unsigned)w1; tl[c * 65 + e] = w; }
            __syncthreads();
#pragma unroll
            for (int k = 0; k < 8; ++k) { const int it = tid + 512 * k, c = it >> 6, e = it & 63; ov[(size_t)(c0 + c) * 16384 + e0 + e] = tl[c * 65 + e]; }
            __syncthreads();
        }
    }
}
namespace pg8 {
constexpr int BM = 256, BK = 64, HALF = 128, HTB = HALF * BK * 2, STAGE_BYTES = 8 * HTB, NXCD = 8, WGM = 8;
__host__ __device__ __forceinline__ int lds_byte(int r, int c) { const int st = (r >> 4) * 2 + (c >> 5), rr = r & 15, cc = c & 31, ob = rr * 64 + cc * 2; return st * 1024 + (ob ^ (((ob >> 9) & 1) << 5)); }
__host__ __device__ __forceinline__ void stage_rc(int b, int& R, int& C) { const int st = b / 1024, sb = b % 1024, swz = sb ^ (((sb >> 9) & 1) << 5); R = (st >> 1) * 16 + swz / 64; C = (st & 1) * 32 + (swz % 64) / 2; }
__host__ __device__ __forceinline__ int perm32(int rho) { const int n = rho >> 4, i = rho & 15; return 8 * (i >> 2) + 4 * n + (i & 3); }

struct Unit { int pm, pn, g; };
struct GemmSet { const bf16 *A0, *A1, *Bt0, *Bt1; int K; };

struct StaticOrder {
    int nM, nN0, nN, nwg, G, c;
    __device__ void init(int Mrows, int N0, int N1, int G_, int c_) { nM = Mrows / BM; nN0 = N0 / BM; nN = nN0 + N1 / BM; nwg = nM * nN; G = G_; c = c_; }
    __device__ bool next(int i, Unit& u) const {
        const long L = (long)i * G + c; if (L >= nwg) return false;
        int wgid = (int)L; { const int q = nwg / NXCD, r = nwg % NXCD, xcd = wgid % NXCD, off = wgid / NXCD; wgid = (xcd < r ? xcd * (q + 1) : r * (q + 1) + (xcd - r) * q) + off; }
        const int nig = WGM * nN, gid = wgid / nig, fm = gid * WGM, gsz = (nM - fm) < WGM ? (nM - fm) : WGM;
        u.pm = fm + ((wgid % nig) % gsz); int pn = (wgid % nig) / gsz; u.g = pn >= nN0 ? 1 : 0; u.pn = pn >= nN0 ? pn - nN0 : pn; return true;
    }
};

template <class Epi, class Sched>
__device__ __forceinline__ void gemm_phase(LAS unsigned char* lds, const GemmSet g, const Sched& S, const Epi& E) {
    int tid_ = threadIdx.x; asm volatile("" : "+v"(tid_));
    const int tid = tid_, wid = __builtin_amdgcn_readfirstlane(tid >> 6), lane = tid & 63, wr = wid >> 2, wc = wid & 3, fr = lane & 15, fq = lane >> 4;
    const int K = g.K, nt = K / BK;
    unsigned voffA[2], voffB[2];
#pragma unroll
    for (int i = 0; i < 2; ++i) { int R, C; stage_rc(tid * 16 + i * 8192, R, C); const int Rb = (R & ~31) + perm32(R & 31);
        voffA[i] = (unsigned)(R * K + C) * 2u; voffB[i] = (unsigned)(Rb * K + C) * 2u; }
    const size_t kstep = (size_t)(BK * 2);
    const size_t hstep = (size_t)HALF * K * 2;
    const size_t tstep = 2 * hstep;
    const unsigned ldsw = (unsigned)wid * 1024u;
    const int aoff = lds_byte(wr * 64 + fr, fq * 8), boff = lds_byte(wc * 32 + fr, fq * 8);
#define PG8_SA(b, h) (((b) * 2 + (h)) * HTB)
#define PG8_SB(b, h) ((4 + (b) * 2 + (h)) * HTB)
#define PG8_STAGE(bufoff, gbase, voff) do { _Pragma("unroll") for (int _i = 0; _i < 2; ++_i) \
        __builtin_amdgcn_global_load_lds((const unsigned*)((const char*)(gbase) + (voff)[_i]), (LAS unsigned*)(lds + (bufoff) + ldsw + _i * 8192), 16, 0, 0); } while (0)
#define PG8_LDA(dst, b, h) do { _Pragma("unroll") for (int m = 0; m < 4; ++m) _Pragma("unroll") for (int k = 0; k < 2; ++k) dst[m][k] = *(const LAS bf16x8*)(lds + PG8_SA(b, h) + aoff + m * 2048 + k * 1024); } while (0)
#define PG8_LDB(dst, b, h) do { _Pragma("unroll") for (int n = 0; n < 2; ++n) _Pragma("unroll") for (int k = 0; k < 2; ++k) dst[n][k] = *(const LAS bf16x8*)(lds + PG8_SB(b, h) + boff + n * 2048 + k * 1024); } while (0)
#define PG8_MMA(ai, bj, At, Bt) do { __builtin_amdgcn_s_setprio(1); _Pragma("unroll") for (int m = 0; m < 4; ++m) _Pragma("unroll") for (int n = 0; n < 2; ++n) _Pragma("unroll") for (int k = 0; k < 2; ++k) \
        acc[ai][bj][m][n] = __builtin_amdgcn_mfma_f32_16x16x32_bf16(Bt[n][k], At[m][k], acc[ai][bj][m][n], 0, 0, 0); __builtin_amdgcn_s_setprio(0); } while (0)
#define PG8_WAIT_V(n) asm volatile("s_waitcnt vmcnt(" #n ")" ::: "memory")
#define PG8_WAIT_L(n) asm volatile("s_waitcnt lgkmcnt(" #n ")" ::: "memory")
#define PG8_BAR __builtin_amdgcn_s_barrier()
#define PG8_SCHED __builtin_amdgcn_sched_barrier(0)
    Unit cur, nxt; int ui = 0;
    if (!S.next(0, cur)) return;
    f32x4 acc[2][2][4][2];
#pragma unroll
    for (int a = 0; a < 2; ++a)
#pragma unroll
        for (int b = 0; b < 2; ++b)
#pragma unroll
            for (int m = 0; m < 4; ++m)
#pragma unroll
                for (int n = 0; n < 2; ++n) acc[a][b][m][n] = (f32x4){0.f, 0.f, 0.f, 0.f};
    bf16x8 At[4][2], B0[2][2], B1[2][2];
    const char* cA = (const char*)(cur.g ? g.A1 : g.A0) + (size_t)cur.pm * tstep; const char* cB = (const char*)(cur.g ? g.Bt1 : g.Bt0) + (size_t)cur.pn * tstep;
    E.unit_begin(cur, 0, tid);
    PG8_STAGE(PG8_SB(0, 0), cB, voffB); PG8_STAGE(PG8_SB(0, 1), cB + hstep, voffB); PG8_STAGE(PG8_SA(0, 0), cA, voffA); PG8_STAGE(PG8_SA(0, 1), cA + hstep, voffA);
    if (wr == 1) PG8_BAR;
    PG8_WAIT_V(2); PG8_BAR;
    PG8_STAGE(PG8_SB(1, 0), cB + kstep, voffB); PG8_STAGE(PG8_SA(1, 0), cA + kstep, voffA); PG8_STAGE(PG8_SB(1, 1), cB + hstep + kstep, voffB);
    PG8_WAIT_V(6); PG8_BAR;
    for (;;) {
        const bool has_next = S.next(ui + 1, nxt);
        const char* nA = has_next ? (const char*)(nxt.g ? g.A1 : g.A0) + (size_t)nxt.pm * tstep : cA; const char* nB = has_next ? (const char*)(nxt.g ? g.Bt1 : g.Bt0) + (size_t)nxt.pn * tstep : cB;
        for (int t = 0; t < nt; t += 2) {
            const bool last = (t == nt - 2);
            const char* a1 = cA + (size_t)(t + 1) * kstep;
            const char* a2 = last ? nA : cA + (size_t)(t + 2) * kstep; const char* b2 = last ? nB : cB + (size_t)(t + 2) * kstep;
            const char* a3 = a2 + kstep; const char* b3 = b2 + kstep;
            if constexpr (Epi::MIDSCALE) { if (t == nt / 2) E.midscale(acc, ui & 1, wr, fr); }
            PG8_LDB(B0, 0, 0); PG8_LDB(B1, 0, 1); PG8_SCHED; PG8_LDA(At, 0, 0); PG8_STAGE(PG8_SA(1, 1), a1 + hstep, voffA);
            PG8_WAIT_V(8); PG8_WAIT_L(0); PG8_BAR; PG8_MMA(0, 0, At, B0); PG8_MMA(0, 1, At, B1); PG8_BAR; PG8_SCHED;
            PG8_LDA(At, 0, 1); PG8_STAGE(PG8_SB(0, 0), b2, voffB); PG8_STAGE(PG8_SB(0, 1), b2 + hstep, voffB); PG8_STAGE(PG8_SA(0, 0), a2, voffA);
            PG8_WAIT_V(8); PG8_WAIT_L(0); PG8_BAR; PG8_MMA(1, 0, At, B0); PG8_MMA(1, 1, At, B1); PG8_BAR; PG8_SCHED;
            PG8_LDB(B0, 1, 0); PG8_LDB(B1, 1, 1); PG8_SCHED; PG8_LDA(At, 1, 0); PG8_STAGE(PG8_SA(0, 1), a2 + hstep, voffA);
            PG8_WAIT_V(8); PG8_WAIT_L(0); PG8_BAR; PG8_MMA(0, 0, At, B0); PG8_MMA(0, 1, At, B1); PG8_BAR; PG8_SCHED;
            PG8_LDA(At, 1, 1); PG8_STAGE(PG8_SB(1, 0), b3, voffB); PG8_STAGE(PG8_SB(1, 1), b3 + hstep, voffB); PG8_STAGE(PG8_SA(1, 0), a3, voffA);
            PG8_WAIT_V(8); PG8_WAIT_L(0); PG8_BAR; PG8_MMA(1, 0, At, B0); PG8_MMA(1, 1, At, B1); PG8_BAR; PG8_SCHED;
        }
        if (wr == 0) PG8_BAR;
        E(acc, cur, ui & 1, wr, wc, fr, fq);
        if (!has_next) break;
#pragma unroll
        for (int a = 0; a < 2; ++a)
#pragma unroll
            for (int b = 0; b < 2; ++b)
#pragma unroll
                for (int m = 0; m < 4; ++m)
#pragma unroll
                    for (int n = 0; n < 2; ++n) acc[a][b][m][n] = (f32x4){0.f, 0.f, 0.f, 0.f};
        cur = nxt; cA = nA; cB = nB; ++ui;
        E.unit_begin(cur, ui & 1, tid);
        if (wr == 1) PG8_BAR;
    }
    PG8_WAIT_V(0);
    PG8_BAR;
#undef PG8_SA
#undef PG8_SB
#undef PG8_STAGE
#undef PG8_LDA
#undef PG8_LDB
#undef PG8_MMA
#undef PG8_WAIT_V
#undef PG8_WAIT_L
#undef PG8_BAR
#undef PG8_SCHED
}
}
namespace pg8 {
__device__ __forceinline__ v4u pack8(const f32x4& v0, const f32x4& v1) { v4u w; w.x = pk2(v0[0], v0[1]); w.y = pk2(v0[2], v0[3]); w.z = pk2(v1[0], v1[1]); w.w = pk2(v1[2], v1[3]); return w; }
__device__ __forceinline__ float sq8(const f32x4& v0, const f32x4& v1) { return (v0[0] * v0[0] + v0[1] * v0[1]) + (v0[2] * v0[2] + v0[3] * v0[3]) + (v1[0] * v1[0] + v1[1] * v1[1]) + (v1[2] * v1[2] + v1[3] * v1[3]); }

struct Epi1 {
    static constexpr bool MIDSCALE = false;
    bf16 *QKV, *CQ, *CKV; float *SSQCQ, *SSQCKV;
    __device__ __forceinline__ void midscale(f32x4 (&)[2][2][4][2], int, int, int) const {}
    __device__ __forceinline__ void unit_begin(const Unit&, int, int) const {}
    __device__ __forceinline__ void operator()(const f32x4 (&acc)[2][2][4][2], const Unit& u, int par, int wr, int wc, int fr, int fq) const {
        const int pn = u.pn; bf16* base; int ldc, colt; float sc = 1.f; float* ssq = nullptr; int sslot = 0;
        if (pn < 12) { base = QKV; ldc = 3072; colt = pn * 256; if (pn < 4) sc = QSCALE_DIL; }
        else if (pn < 14) { base = CQ; ldc = 512; colt = (pn - 12) * 256; ssq = SSQCQ; sslot = (pn - 12) * 4 + wc; }
        else { base = CKV; ldc = 512; colt = (pn - 14) * 256; ssq = SSQCKV; sslot = (pn - 14) * 4 + wc; }
        const int row0 = u.pm * BM + wr * 64 + fr, col0 = colt + wc * 32 + 8 * fq;
#pragma unroll
        for (int ai = 0; ai < 2; ++ai)
#pragma unroll
            for (int m = 0; m < 4; ++m) { const int row = row0 + ai * HALF + m * 16; bf16* rowp = base + (size_t)row * ldc + col0; float ss = 0.f;
#pragma unroll
                for (int bj = 0; bj < 2; ++bj) { const f32x4 v0 = acc[ai][bj][m][0] * sc, v1 = acc[ai][bj][m][1] * sc; ss += sq8(v0, v1); *(v4u*)(rowp + bj * HALF) = pack8(v0, v1); }
                if (ssq) { ss += __shfl_xor(ss, 16); ss += __shfl_xor(ss, 32); if (fq == 0) ssq[(size_t)row * 8 + sslot] = ss; } }
    }
};

struct Epi2 {
    static constexpr bool MIDSCALE = false;
    bf16 *QN, *QPE, *KN, *VM; const float *SSQCQ, *SSQCKV; const f32x2* ROPE;
    __device__ __forceinline__ void midscale(f32x4 (&)[2][2][4][2], int, int, int) const {}
    __device__ __forceinline__ void unit_begin(const Unit&, int, int) const {}
    __device__ __forceinline__ void operator()(const f32x4 (&acc)[2][2][4][2], const Unit& u, int par, int wr, int wc, int fr, int fq) const {
        const int pn = u.pn; bf16* base; int ldc, colt; float sc = 1.f; bool rope = false; const float* ssq;
        if (u.g == 0) { ssq = SSQCQ; sc = QSCALE_MLA; if (pn < 4) { base = QN; ldc = 1024; colt = pn * 256; } else { base = QPE; ldc = 512; colt = (pn - 4) * 256; rope = true; } }
        else { ssq = SSQCKV; if (pn < 4) { base = KN; ldc = 1024; colt = pn * 256; } else { base = VM; ldc = 1024; colt = (pn - 4) * 256; } }
        const int row0 = u.pm * BM + wr * 64 + fr, col0 = colt + wc * 32 + 8 * fq;
#pragma unroll
        for (int ai = 0; ai < 2; ++ai)
#pragma unroll
            for (int m = 0; m < 4; ++m) { const int row = row0 + ai * HALF + m * 16; bf16* rowp = base + (size_t)row * ldc + col0;
                const f32x4 p0 = *(const f32x4*)(ssq + (size_t)row * 8), p1 = *(const f32x4*)(ssq + (size_t)row * 8 + 4);
                const float rs = rsqrtf(((p0[0] + p0[1]) + (p0[2] + p0[3]) + (p1[0] + p1[1]) + (p1[2] + p1[3])) * (1.f / 512.f) + EPS) * sc;
#pragma unroll
                for (int bj = 0; bj < 2; ++bj) { f32x4 v0 = acc[ai][bj][m][0] * rs, v1 = acc[ai][bj][m][1] * rs;
                    if (rope) { const int j0 = ((col0 + bj * HALF) & 63) >> 1; const f32x4* rp = (const f32x4*)(ROPE + (size_t)(row & (SEQ - 1)) * 32 + j0);
                        const f32x4 r0 = rp[0], r1 = rp[1];
                        f32x4 w0, w1;
                        w0[0] = v0[0] * r0[0] - v0[1] * r0[1]; w0[1] = v0[0] * r0[1] + v0[1] * r0[0];
                        w0[2] = v0[2] * r0[2] - v0[3] * r0[3]; w0[3] = v0[2] * r0[3] + v0[3] * r0[2];
                        w1[0] = v1[0] * r1[0] - v1[1] * r1[1]; w1[1] = v1[0] * r1[1] + v1[1] * r1[0];
                        w1[2] = v1[2] * r1[2] - v1[3] * r1[3]; w1[3] = v1[2] * r1[3] + v1[3] * r1[2];
                        v0 = w0; v1 = w1; }
                    *(v4u*)(rowp + bj * HALF) = pack8(v0, v1); } }
    }
};

struct Epi3 {
    static constexpr bool MIDSCALE = true;
    bf16* H1B; const float* X; const float* SSQO; float* SSQH; LAS f32x2* RS;
    __device__ __forceinline__ void unit_begin(const Unit& u, int par, int tid) const {
        if (tid < 256) { const f32x4* p = (const f32x4*)(SSQO + (size_t)(u.pm * BM + tid) * 16); const f32x4 a0 = p[0], a1 = p[1], b0 = p[2], b1 = p[3];
            const float ra = rsqrtf(((a0[0] + a0[1]) + (a0[2] + a0[3]) + (a1[0] + a1[1]) + (a1[2] + a1[3])) * (1.f / 1024.f) + EPS);
            const float rb = rsqrtf(((b0[0] + b0[1]) + (b0[2] + b0[3]) + (b1[0] + b1[1]) + (b1[2] + b1[3])) * (1.f / 1024.f) + EPS);
            f32x2 v; v.x = ra / rb; v.y = rb; RS[par * 256 + tid] = v; }
    }
    __device__ __forceinline__ void midscale(f32x4 (&acc)[2][2][4][2], int par, int wr, int fr) const {
#pragma unroll
        for (int ai = 0; ai < 2; ++ai)
#pragma unroll
            for (int m = 0; m < 4; ++m) { const float f = RS[par * 256 + ai * HALF + wr * 64 + m * 16 + fr].x;
#pragma unroll
                for (int bj = 0; bj < 2; ++bj) { acc[ai][bj][m][0] = acc[ai][bj][m][0] * f; acc[ai][bj][m][1] = acc[ai][bj][m][1] * f; } }
    }
    __device__ __forceinline__ void operator()(const f32x4 (&acc)[2][2][4][2], const Unit& u, int par, int wr, int wc, int fr, int fq) const {
        const int row0 = u.pm * BM + wr * 64 + fr, col0 = u.pn * BM + wc * 32 + 8 * fq, sslot = u.pn * 4 + wc;
#pragma unroll
        for (int ai = 0; ai < 2; ++ai)
#pragma unroll
            for (int m = 0; m < 4; ++m) { const int row = row0 + ai * HALF + m * 16; const float rb = RS[par * 256 + ai * HALF + wr * 64 + m * 16 + fr].y; float ss = 0.f;
#pragma unroll
                for (int bj = 0; bj < 2; ++bj) { const float* xp = X + (size_t)row * DM + col0 + bj * HALF; const f32x4 x0 = *(const f32x4*)xp, x1 = *(const f32x4*)(xp + 4);
                    const f32x4 v0 = acc[ai][bj][m][0] * rb + x0, v1 = acc[ai][bj][m][1] * rb + x1; ss += sq8(v0, v1);
                    *(v4u*)(H1B + (size_t)row * DM + col0 + bj * HALF) = pack8(v0, v1); }
                ss += __shfl_xor(ss, 16); ss += __shfl_xor(ss, 32); if (fq == 0) SSQH[(size_t)row * 32 + sslot] = ss; }
    }
};

struct Epi4 {
    static constexpr bool MIDSCALE = false;
    bf16* QP; const float* SSQH; LAS f32x2* RS;
    __device__ __forceinline__ void midscale(f32x4 (&)[2][2][4][2], int, int, int) const {}
    __device__ __forceinline__ void unit_begin(const Unit& u, int par, int tid) const {
        if (tid < 256) { const f32x4* p = (const f32x4*)(SSQH + (size_t)(u.pm * BM + tid) * 32); f32x4 s = p[0];
#pragma unroll
            for (int i = 1; i < 8; ++i) s = s + p[i];
            f32x2 v; v.x = rsqrtf(((s[0] + s[1]) + (s[2] + s[3])) * (1.f / 2048.f) + EPS); v.y = 0.f; RS[par * 256 + tid] = v; }
    }
    __device__ __forceinline__ void operator()(const f32x4 (&acc)[2][2][4][2], const Unit& u, int par, int wr, int wc, int fr, int fq) const {
        const int row0 = u.pm * BM + wr * 64 + fr, col0 = u.pn * BM + wc * 32 + 8 * fq;
#pragma unroll
        for (int ai = 0; ai < 2; ++ai)
#pragma unroll
            for (int m = 0; m < 4; ++m) { const int row = row0 + ai * HALF + m * 16; const float rs = RS[par * 256 + ai * HALF + wr * 64 + m * 16 + fr].x;
#pragma unroll
                for (int bj = 0; bj < 2; ++bj) *(v4u*)(QP + (size_t)row * DM + col0 + bj * HALF) = pack8(acc[ai][bj][m][0] * rs, acc[ai][bj][m][1] * rs); }
    }
};
}

__device__ __forceinline__ void kr_item(const bf16* __restrict__ XN, const bf16* __restrict__ BT, const f32x2* __restrict__ ROPE, bf16* __restrict__ KPE, int item, int wave, int lane) {
    const int fr = lane & 15, fq = lane >> 4, row = item * 128 + wave * 16 + fr;
    const bf16* ap = XN + (size_t)row * 2048 + fq * 8; const bf16* bp = BT + (size_t)fr * 2048 + fq * 8;
    f32x4 acc[4];
#pragma unroll
    for (int nb = 0; nb < 4; ++nb) acc[nb] = (f32x4){0.f, 0.f, 0.f, 0.f};
#pragma unroll 4
    for (int k0 = 0; k0 < 2048; k0 += 32) {
        const bf16x8 a = *(const bf16x8*)(ap + k0);
#pragma unroll
        for (int nb = 0; nb < 4; ++nb) { const bf16x8 b = *(const bf16x8*)(bp + (size_t)nb * 16 * 2048 + k0); acc[nb] = __builtin_amdgcn_mfma_f32_16x16x32_bf16(b, a, acc[nb], 0, 0, 0); }
    }
    const int pos = row & (SEQ - 1);
#pragma unroll
    for (int nb = 0; nb < 4; ++nb) { const int j0 = 8 * nb + 2 * fq; const f32x4 r = *(const f32x4*)(ROPE + (size_t)pos * 32 + j0); const f32x4 v = acc[nb];
        v2u o; o.x = pk2(v[0] * r[0] - v[1] * r[1], v[0] * r[1] + v[1] * r[0]); o.y = pk2(v[2] * r[2] - v[3] * r[3], v[2] * r[3] + v[3] * r[2]);
        *(v2u*)(KPE + (size_t)row * 64 + 16 * nb + 4 * fq) = o; }
}
namespace att {
typedef short v4i16_t __attribute__((ext_vector_type(4)));
#define MFMA32(a, b, c) __builtin_amdgcn_mfma_f32_32x32x16_bf16((a), (b), (c), 0, 0, 0)
__device__ __forceinline__ s16x4 vtr(const LAS unsigned char* p) { return __builtin_bit_cast(s16x4, __builtin_amdgcn_ds_read_tr16_b64_v4i16((LAS v4i16_t*)p)); }
__device__ __forceinline__ int crow(int r, int hi) { return (r & 3) + 8 * (r >> 2) + 4 * hi; }
constexpr int VS = 320;
constexpr int KS = 400;
constexpr float NEG = -1e30f;

__device__ __forceinline__ bf16x8 pack8r(const f32x16& p, int s) {
    v4u w; w.x = pk2(p[8 * s + 0], p[8 * s + 1]); w.y = pk2(p[8 * s + 2], p[8 * s + 3]); w.z = pk2(p[8 * s + 4], p[8 * s + 5]); w.w = pk2(p[8 * s + 6], p[8 * s + 7]);
    return __builtin_bit_cast(bf16x8, w);
}
__device__ __forceinline__ void pv32(f32x16 (&o)[4], const LAS unsigned char* vb, const bf16x8 pb0, const bf16x8 pb1) {
#pragma unroll
    for (int d = 0; d < 4; ++d) {
        const s16x4 l0 = vtr(vb + d * 64), h0 = vtr(vb + d * 64 + 8 * VS), l1 = vtr(vb + d * 64 + 16 * VS), h1 = vtr(vb + d * 64 + 24 * VS);
        const bf16x8 a0 = __builtin_shufflevector(l0, h0, 0, 1, 2, 3, 4, 5, 6, 7), a1 = __builtin_shufflevector(l1, h1, 0, 1, 2, 3, 4, 5, 6, 7);
        o[d] = MFMA32(a0, pb0, o[d]); o[d] = MFMA32(a1, pb1, o[d]);
    }
}
template <int NS>
__device__ __forceinline__ void softmax_step(f32x16 (&s)[NS], float& m, float& l, f32x16 (&o)[4], bf16x8 (&pb)[2 * NS]) {
    float mx = s[0][0];
#pragma unroll
    for (int t = 0; t < NS; ++t)
#pragma unroll
        for (int r = 0; r < 16; ++r) mx = fmaxf(mx, s[t][r]);
    mx = fmaxf(mx, __shfl_xor(mx, 32));
    const float mn = fmaxf(m, mx), alpha = __builtin_amdgcn_exp2f(m - mn); m = mn;
    float ps = 0.f;
#pragma unroll
    for (int t = 0; t < NS; ++t)
#pragma unroll
        for (int r = 0; r < 16; ++r) { const float p = __builtin_amdgcn_exp2f(s[t][r] - mn); s[t][r] = p; ps += p; }
    l = l * alpha + ps;
    if (!__all(alpha == 1.0f)) {
#pragma unroll
        for (int d = 0; d < 4; ++d) o[d] = o[d] * alpha;
    }
#pragma unroll
    for (int t = 0; t < NS; ++t) { pb[2 * t] = pack8r(s[t], 0); pb[2 * t + 1] = pack8r(s[t], 1); }
}
__device__ __forceinline__ void store_o(f32x16 (&o)[4], float l, bf16* __restrict__ orow  , float* __restrict__ ssq  , int hh) {
    l += __shfl_xor(l, 32);
    const float inv = 1.0f / l; float ss = 0.f;
#pragma unroll
    for (int d = 0; d < 4; ++d) { o[d] = o[d] * inv;
#pragma unroll
        for (int g = 0; g < 4; ++g) { const float a = o[d][4 * g], b = o[d][4 * g + 1], c = o[d][4 * g + 2], e = o[d][4 * g + 3];
            ss += (a * a + b * b) + (c * c + e * e);
            v2u w; w.x = pk2(a, b); w.y = pk2(c, e); *(v2u*)(orow + 32 * d + 8 * g + 4 * hh) = w; } }
    ss += __shfl_xor(ss, 32);
    if (hh == 0) *ssq = ss;
}

constexpr int KTB = 64 * KS, VTB = 64 * VS, BUFB = KTB + VTB;
__device__ __forceinline__ void mla_unit(const unsigned char* ws, LAS unsigned char* lds, int b, int h, int qblk, int tid, int wave, int lane) {
    const bf16* QN = (const bf16*)(ws + WS_QN); const bf16* QPE = (const bf16*)(ws + WS_QPE); const bf16* KN = (const bf16*)(ws + WS_KN);
    const bf16* KPE = (const bf16*)(ws + WS_KPE); const bf16* VM = (const bf16*)(ws + WS_VM);
    bf16* O = (bf16*)(ws + WS_A); float* SSQO = (float*)(ws + WS_SSQO);
    const int r32 = lane & 31, hh = lane >> 5;
    const size_t tok0 = (size_t)b * SEQ;
    const int row_lo = qblk * 256 + wave * 32, qrow = row_lo + r32;
    bf16x8 qf[12];
    { const bf16* qn = QN + (tok0 + qrow) * 1024 + h * 128 + 8 * hh;
#pragma unroll
      for (int s = 0; s < 8; ++s) qf[s] = *(const bf16x8*)(qn + 16 * s);
      const bf16* qp = QPE + (tok0 + qrow) * 512 + h * 64 + 8 * hh;
#pragma unroll
      for (int s = 0; s < 4; ++s) qf[8 + s] = *(const bf16x8*)(qp + 16 * s); }
    const int c0 = tid, c1 = tid + 512;
    const bf16* gkn0 = KN + (tok0 + (c0 >> 4)) * 1024 + h * 128 + (c0 & 15) * 8; const bf16* gkn1 = KN + (tok0 + (c1 >> 4)) * 1024 + h * 128 + (c1 & 15) * 8;
    const bf16* gkp = KPE + (tok0 + (tid >> 3)) * 64 + (tid & 7) * 8;
    const bf16* gv0 = VM + (tok0 + (c0 >> 4)) * 1024 + h * 128 + (c0 & 15) * 8; const bf16* gv1 = VM + (tok0 + (c1 >> 4)) * 1024 + h * 128 + (c1 & 15) * 8;
    const int lkn0 = (c0 >> 4) * KS + (c0 & 15) * 16, lkn1 = (c1 >> 4) * KS + (c1 & 15) * 16, lkp = (tid >> 3) * KS + 256 + (tid & 7) * 16;
    const int lv0 = KTB + (c0 >> 4) * VS + (c0 & 15) * 16, lv1 = KTB + (c1 >> 4) * VS + (c1 & 15) * 16;
    v4u st0, st1, st2, st3, st4;
#define MLA_GLOAD(kt) do { const size_t _o = (size_t)(kt) * 64; st0 = *(const v4u*)(gkn0 + _o * 1024); st1 = *(const v4u*)(gkn1 + _o * 1024); st2 = *(const v4u*)(gkp + _o * 64); \
        st3 = *(const v4u*)(gv0 + _o * 1024); st4 = *(const v4u*)(gv1 + _o * 1024); } while (0)
#define MLA_LWRITE(buf) do { LAS unsigned char* _b = lds + (buf) * BUFB; *(LAS v4u*)(_b + lkn0) = st0; *(LAS v4u*)(_b + lkn1) = st1; *(LAS v4u*)(_b + lkp) = st2; \
        *(LAS v4u*)(_b + lv0) = st3; *(LAS v4u*)(_b + lv1) = st4; } while (0)
    const int nkt = 4 * (qblk + 1);
    MLA_GLOAD(0); MLA_LWRITE(0);
    __syncthreads();
    f32x16 o[4];
#pragma unroll
    for (int d = 0; d < 4; ++d)
#pragma unroll
        for (int r = 0; r < 16; ++r) o[d][r] = 0.f;
    float m = NEG, l = 0.f;
    const int kread = r32 * KS + 16 * hh;
    const int vread = KTB + (4 * hh + ((lane & 15) >> 2)) * VS + (16 * ((lane >> 4) & 1) + 4 * (lane & 3)) * 2;
    for (int kt = 0; kt < nkt; ++kt) {
        if (kt + 1 < nkt) MLA_GLOAD(kt + 1);
        const int k0 = kt * 64;
        if (k0 <= row_lo + 31) {
            const LAS unsigned char* kb = lds + (kt & 1) * BUFB;
            const bool diag = (k0 + 63 > row_lo);
#pragma unroll
            for (int sub = 0; sub < 2; ++sub) {
                if (sub == 1 && k0 + 32 > row_lo + 31) break;
                f32x16 s[1];
#pragma unroll
                for (int r = 0; r < 16; ++r) s[0][r] = 0.f;
#pragma unroll
                for (int ks = 0; ks < 12; ++ks) { const bf16x8 kf = *(const LAS bf16x8*)(kb + kread + sub * 32 * KS + 32 * ks); s[0] = MFMA32(kf, qf[ks], s[0]); }
                if (diag) {
#pragma unroll
                    for (int r = 0; r < 16; ++r) { const int key = k0 + 32 * sub + crow(r, hh); if (key > qrow) s[0][r] = NEG; }
                }
                bf16x8 pb[2];
                softmax_step<1>(s, m, l, o, pb);
                pv32(o, kb + vread + sub * 32 * VS, pb[0], pb[1]);
            }
        }
        if (kt + 1 < nkt) MLA_LWRITE((kt + 1) & 1);
        __syncthreads();
    }
#undef MLA_GLOAD
#undef MLA_LWRITE
    store_o(o, l, O + (tok0 + qrow) * 2048 + 1024 + h * 128, SSQO + (tok0 + qrow) * 16 + 8 + h, hh);
}

__device__ __forceinline__ void dil_tile(const unsigned char* ws, LAS unsigned char* vl  , int b, int h, int j, int r16, int lane) {
    const bf16* QKV = (const bf16*)(ws + WS_B); bf16* O = (bf16*)(ws + WS_A); float* SSQO = (float*)(ws + WS_SSQO);
    const int r32 = lane & 31, hh = lane >> 5;
    const size_t tok0 = (size_t)b * SEQ;
    const int tq = 512 * j + 16 * r32 + r16;
    bf16x8 qf[8];
    { const bf16* qp = QKV + (tok0 + tq) * 3072 + h * 128 + 8 * hh;
#pragma unroll
      for (int s = 0; s < 8; ++s) qf[s] = *(const bf16x8*)(qp + 16 * s); }
    const float slope2 = __builtin_amdgcn_exp2f(-(float)(h + 1)) * LOG2E;
    const int m0 = (j == 0) ? 4 : 0, n3 = j + 1, n2 = 8 - m0, n1 = 20 - m0, nt = n3 + n2 + n1;
    const bf16* kcol = QKV + tok0 * 3072 + 1024 + h * 128 + 8 * hh;
    const bf16* vcol = QKV + tok0 * 3072 + 2048 + h * 128 + (lane & 15) * 8;
    const int vrow = lane >> 4;
    const int vwr = vrow * VS + (lane & 15) * 16;
    const int vread = (4 * hh + ((lane & 15) >> 2)) * VS + (16 * ((lane >> 4) & 1) + 4 * (lane & 3)) * 2;
    int kbase, kstride, maxd;
#define DIL_DESC(idx) do { const int _i = (idx); if (_i < n3) { kbase = 512 * (j - _i) + r16; kstride = 16; maxd = 2048; } \
        else if (_i < n3 + n2) { kbase = 4 * (128 * j - 128 + 32 * (m0 + _i - n3)) + (r16 & 3); kstride = 4; maxd = 512; } \
        else { kbase = 512 * j - 128 + 32 * (m0 + _i - n3 - n2); kstride = 1; maxd = 128; } } while (0)
    bf16x8 kc[8]; v4u vn[8];
    DIL_DESC(0);
    { const bf16* kp = kcol + (size_t)(kbase + kstride * r32) * 3072;
#pragma unroll
      for (int s = 0; s < 8; ++s) kc[s] = *(const bf16x8*)(kp + 16 * s);
#pragma unroll
      for (int i = 0; i < 8; ++i) vn[i] = *(const v4u*)(vcol + (size_t)(kbase + kstride * (4 * i + vrow)) * 3072);
#pragma unroll
      for (int i = 0; i < 8; ++i) *(LAS v4u*)(vl + vwr + 4 * i * VS) = vn[i]; }
    f32x16 o[4];
#pragma unroll
    for (int d = 0; d < 4; ++d)
#pragma unroll
        for (int r = 0; r < 16; ++r) o[d][r] = 0.f;
    float m = NEG, l = 0.f;
    for (int idx = 0; idx < nt; ++idx) {
        const int cb = kbase, cs = kstride, cm = maxd;
        const bool more = idx + 1 < nt;
        if (more) {
            DIL_DESC(idx + 1);
#pragma unroll
            for (int i = 0; i < 8; ++i) vn[i] = *(const v4u*)(vcol + (size_t)(kbase + kstride * (4 * i + vrow)) * 3072);
        }
        f32x16 s[1];
#pragma unroll
        for (int r = 0; r < 16; ++r) s[0][r] = 0.f;
#pragma unroll
        for (int ks = 0; ks < 8; ++ks) s[0] = MFMA32(kc[ks], qf[ks], s[0]);
        if (more) {
            const bf16* kp = kcol + (size_t)(kbase + kstride * r32) * 3072;
#pragma unroll
            for (int s2 = 0; s2 < 8; ++s2) kc[s2] = *(const bf16x8*)(kp + 16 * s2);
        }
        const int d0 = tq - cb - cs * 4 * hh;
#pragma unroll
        for (int r = 0; r < 16; ++r) { const int dist = d0 - cs * ((r & 3) + 8 * (r >> 2)); const float v = s[0][r] - slope2 * (float)dist; s[0][r] = ((unsigned)dist <= (unsigned)cm) ? v : NEG; }
        bf16x8 pb[2];
        softmax_step<1>(s, m, l, o, pb);
        pv32(o, vl + vread, pb[0], pb[1]);
        if (more) {
#pragma unroll
            for (int i = 0; i < 8; ++i) *(LAS v4u*)(vl + vwr + 4 * i * VS) = vn[i];
        }
    }
#undef DIL_DESC
    store_o(o, l, O + (tok0 + tq) * 2048 + h * 128, SSQO + (tok0 + tq) * 16 + h, hh);
}

__device__ __forceinline__ void phase_attn(const Params& P, LAS unsigned char* lds, int vcu, int G) {
    int tid_ = threadIdx.x; asm volatile("" : "+v"(tid_));
    const int tid = tid_, lane = tid & 63, wave = __builtin_amdgcn_readfirstlane(tid >> 6);
    const unsigned char* ws = P.ws;
    for (int u = vcu; u < 256; u += G) { const int bh = u >> 2, pr = u & 3;
        mla_unit(ws, lds, bh >> 3, bh & 7, 7 - pr, tid, wave, lane);
        mla_unit(ws, lds, bh >> 3, bh & 7, pr, tid, wave, lane); }
    __syncthreads();
    LAS unsigned char* vl = lds + wave * (32 * VS);
    if (G == 256) {
#pragma unroll 1
        for (int k = 0; k < 2; ++k) { const int t = (vcu >> 5) * 512 + k * 256 + (vcu & 31) * 8 + wave; const int bh = t >> 6, rem = t & 63, jj = rem >> 4, r16 = rem & 15;
            dil_tile(ws, vl, bh >> 3, bh & 7, k == 0 ? jj : 3 - jj, r16, lane); }
    } else {
#pragma unroll 1
        for (int t = vcu * 8 + wave; t < 4096; t += G * 8) { const int bh = t >> 6, rem = t & 63; dil_tile(ws, vl, bh >> 3, bh & 7, rem >> 4, rem & 15, lane); }
    }
}
}
namespace peer {
typedef __bf16 bf2_t __attribute__((ext_vector_type(2)));
#define MFMA32(a, b, c) __builtin_amdgcn_mfma_f32_32x32x16_bf16((a), (b), (c), 0, 0, 0)
__device__ __forceinline__ float fmax3(float a, float b, float c) { return fmaxf(fmaxf(a, b), c); }
__device__ __forceinline__ float asf(unsigned u) { return __builtin_bit_cast(float, u); }
__device__ __forceinline__ unsigned asu(float f) { return __builtin_bit_cast(unsigned, f); }

__device__ __forceinline__ void route_item(const unsigned char* ws, LAS unsigned* sc, int tile, int h, int lane) {
    const bf16* QP = (const bf16*)(ws + WS_QP); const bf16* SK = (const bf16*)(ws + WS_SK);
    int* RIDX = (int*)(ws + WS_RIDX); float* RGATE = (float*)(ws + WS_RGATE);
    const int r32 = lane & 31, hh = lane >> 5;
    const size_t tok = (size_t)tile * 32 + r32;
#pragma unroll 1
    for (int p = 0; p < 2; ++p) {
        f32x16 s[4];
#pragma unroll
        for (int kb = 0; kb < 4; ++kb)
#pragma unroll
            for (int r = 0; r < 16; ++r) s[kb][r] = 0.f;
        const bf16* qp = QP + tok * 2048 + h * 256 + p * 128 + 8 * hh;
        const bf16* kp = SK + ((size_t)(h * 2 + p) * 128 + r32) * 128 + 8 * hh;
#pragma unroll
        for (int ks = 0; ks < 8; ++ks) { const bf16x8 q = *(const bf16x8*)(qp + 16 * ks);
#pragma unroll
            for (int kb = 0; kb < 4; ++kb) { const bf16x8 k = *(const bf16x8*)(kp + (size_t)kb * 32 * 128 + 16 * ks); s[kb] = MFMA32(k, q, s[kb]); } }
#pragma unroll
        for (int kb = 0; kb < 4; ++kb)
#pragma unroll
            for (int r = 0; r < 16; ++r) s[kb][r] = asf((asu(s[kb][r]) & ~127u) | (unsigned)(32 * kb + (r & 3) + 8 * (r >> 2) + 4 * hh));
#pragma unroll 1
        for (int k = 0; k < 16; ++k) {
            float mx = s[0][0];
#pragma unroll
            for (int kb = 0; kb < 4; ++kb)
#pragma unroll
                for (int r = 0; r < 16; r += 2) mx = fmax3(mx, s[kb][r], s[kb][r + 1]);
            mx = fmaxf(mx, __shfl_xor(mx, 32));
            if (hh == 0) sc[(p * 32 + r32) * 16 + k] = asu(mx);
#pragma unroll
            for (int kb = 0; kb < 4; ++kb)
#pragma unroll
                for (int r = 0; r < 16; ++r) s[kb][r] = (s[kb][r] == mx) ? -3.0e38f : s[kb][r];
        }
    }
    unsigned t1[16], t2[16];
#pragma unroll
    for (int i = 0; i < 16; i += 4) { const v4u a = *(const LAS v4u*)(sc + r32 * 16 + i), b = *(const LAS v4u*)(sc + (32 + r32) * 16 + i);
        t1[i] = a.x; t1[i + 1] = a.y; t1[i + 2] = a.z; t1[i + 3] = a.w; t2[i] = b.x; t2[i + 1] = b.y; t2[i + 2] = b.z; t2[i + 3] = b.w; }
    float c[50]; int n = 0;
#pragma unroll
    for (int i = 0; i < 16; ++i)
#pragma unroll
        for (int j = 0; j < 16; ++j) if ((i + 1) * (j + 1) <= 16) { const float v = asf(t1[i] & ~127u) + asf(t2[j] & ~127u); c[n] = asf((asu(v) & ~255u) | (unsigned)(i * 16 + j)); ++n; }
    float best[8]; float bmax = 0.f, esum = 0.f;
#pragma unroll
    for (int k = 0; k < 16; ++k) {
        float mx = c[0];
#pragma unroll
        for (int q = 1; q < 49; q += 2) mx = fmax3(mx, c[q], c[q + 1]);
        mx = fmaxf(mx, c[49]);
#pragma unroll
        for (int q = 0; q < 50; ++q) c[q] = (c[q] == mx) ? -3.0e38f : c[q];
        const float val = asf(asu(mx) & ~255u);
        if (k == 0) bmax = val;
        esum += __expf(val - bmax);
        if ((k >> 3) == hh) best[k & 7] = mx;
    }
    const float inv = 1.0f / esum;
    int idx[8]; float gate[8];
#pragma unroll
    for (int k = 0; k < 8; ++k) { const unsigned code = asu(best[k]) & 255u; const unsigned a = sc[r32 * 16 + (code >> 4)], b = sc[(32 + r32) * 16 + (code & 15)];
        idx[k] = (int)((a & 127u) * 128u + (b & 127u)); gate[k] = __expf(asf(asu(best[k]) & ~255u) - bmax) * inv; }
    int* ip = RIDX + tok * 128 + h * 16 + 8 * hh; float* gp = RGATE + tok * 128 + h * 16 + 8 * hh;
    *(v4u*)ip = (v4u){(unsigned)idx[0], (unsigned)idx[1], (unsigned)idx[2], (unsigned)idx[3]}; *(v4u*)(ip + 4) = (v4u){(unsigned)idx[4], (unsigned)idx[5], (unsigned)idx[6], (unsigned)idx[7]};
    *(f32x4*)gp = (f32x4){gate[0], gate[1], gate[2], gate[3]}; *(f32x4*)(gp + 4) = (f32x4){gate[4], gate[5], gate[6], gate[7]};
}

__device__ __forceinline__ void phase_route(const Params& P, LAS unsigned char* lds, int vcu, int G) {
    int tid_ = threadIdx.x; asm volatile("" : "+v"(tid_));
    const int lane = tid_ & 63, wave = __builtin_amdgcn_readfirstlane(tid_ >> 6);
    LAS unsigned* sc = (LAS unsigned*)(lds + wave * 4096);
#pragma unroll 1
    for (int it = vcu * NWAVES + wave; it < 512 * 8; it += G * NWAVES) route_item(P.ws, sc, it >> 3, it & 7, lane);
}

__device__ __forceinline__ float dot16_f8(const float (&x)[16], const v4u& u, float c) {
    const int u0 = (int)u.x, u1 = (int)u.y, u2 = (int)u.z, u3 = (int)u.w;
    const f32x2 a0 = __builtin_amdgcn_cvt_pk_f32_fp8(u0, false), a1 = __builtin_amdgcn_cvt_pk_f32_fp8(u0, true);
    const f32x2 a2 = __builtin_amdgcn_cvt_pk_f32_fp8(u1, false), a3 = __builtin_amdgcn_cvt_pk_f32_fp8(u1, true);
    const f32x2 a4 = __builtin_amdgcn_cvt_pk_f32_fp8(u2, false), a5 = __builtin_amdgcn_cvt_pk_f32_fp8(u2, true);
    const f32x2 a6 = __builtin_amdgcn_cvt_pk_f32_fp8(u3, false), a7 = __builtin_amdgcn_cvt_pk_f32_fp8(u3, true);
    c = fmaf(x[0], a0.x, c); c = fmaf(x[1], a0.y, c); c = fmaf(x[2], a1.x, c); c = fmaf(x[3], a1.y, c);
    c = fmaf(x[4], a2.x, c); c = fmaf(x[5], a2.y, c); c = fmaf(x[6], a3.x, c); c = fmaf(x[7], a3.y, c);
    c = fmaf(x[8], a4.x, c); c = fmaf(x[9], a4.y, c); c = fmaf(x[10], a5.x, c); c = fmaf(x[11], a5.y, c);
    c = fmaf(x[12], a6.x, c); c = fmaf(x[13], a6.y, c); c = fmaf(x[14], a7.x, c); c = fmaf(x[15], a7.y, c);
    return c;
}
__device__ __forceinline__ void unpack8(float* x, const v4u& v) { x[0] = bflo(v.x); x[1] = bfhi(v.x); x[2] = bflo(v.y); x[3] = bfhi(v.y); x[4] = bflo(v.z); x[5] = bfhi(v.z); x[6] = bflo(v.w); x[7] = bfhi(v.w); }
__device__ __forceinline__ void peer_u_token(const Params& P, size_t tok, int lane) {
    const unsigned char* ws = P.ws;
    const bf16* H1B = (const bf16*)(ws + WS_B); const unsigned char* U8 = ws + WS_UB;
    const int* RIDX = (const int*)(ws + WS_RIDX); const float* RGATE = (const float*)(ws + WS_RGATE); const float* SSQH = (const float*)(ws + WS_SSQH);
    unsigned* PKV = (unsigned*)(ws + WS_PKV);
    float x0[16], x1[16];
    { const bf16* hp = H1B + tok * 2048 + 16 * lane; const v4u a = *(const v4u*)hp, b = *(const v4u*)(hp + 8), c = *(const v4u*)(hp + 1024), d = *(const v4u*)(hp + 1032);
      unpack8(x0, a); unpack8(x0 + 8, b); unpack8(x1, c); unpack8(x1 + 8, d); }
    const float rs2 = rsqrtf(wave_sum(lane < 32 ? SSQH[tok * 32 + lane] : 0.f) * (1.f / 2048.f) + EPS) * (1.f / 32.f);
    const int i0 = RIDX[tok * 128 + lane], i1 = RIDX[tok * 128 + 64 + lane];
    const float g0 = RGATE[tok * 128 + lane], g1 = RGATE[tok * 128 + 64 + lane];
    float d0 = 0.f, d1 = 0.f;
#pragma unroll 1
    for (int g = 0; g < 16; ++g) {
        float pt[8];
#pragma unroll
        for (int e = 0; e < 8; ++e) { const int row = __builtin_amdgcn_readlane(g < 8 ? i0 : i1, (g & 7) * 8 + e);
            const unsigned char* up = U8 + (size_t)row * 2048 + 16 * lane;
            pt[e] = dot16_f8(x1, *(const v4u*)(up + 1024), dot16_f8(x0, *(const v4u*)up, 0.f)); }
        float a4[4], a2[2], a1;
#pragma unroll
        for (int i = 0; i < 4; ++i) { const float keep = (lane & 1) ? pt[2 * i + 1] : pt[2 * i], give = (lane & 1) ? pt[2 * i] : pt[2 * i + 1]; a4[i] = keep + __shfl_xor(give, 1); }
#pragma unroll
        for (int i = 0; i < 2; ++i) { const float keep = (lane & 2) ? a4[2 * i + 1] : a4[2 * i], give = (lane & 2) ? a4[2 * i] : a4[2 * i + 1]; a2[i] = keep + __shfl_xor(give, 2); }
        { const float keep = (lane & 4) ? a2[1] : a2[0], give = (lane & 4) ? a2[0] : a2[1]; a1 = keep + __shfl_xor(give, 4); }
        a1 += __shfl_xor(a1, 8); a1 += __shfl_xor(a1, 16); a1 += __shfl_xor(a1, 32);
        if ((lane >> 3) == (g & 7)) { if (g < 8) d0 = a1; else d1 = a1; }
    }
    const float z0 = d0 * rs2, z1 = d1 * rs2;
    const float a0 = 0.25f * z0 * (1.0f + erff(z0 * 0.7071067811865476f)) * g0, a1v = 0.25f * z1 * (1.0f + erff(z1 * 0.7071067811865476f)) * g1;
    unsigned* pk = PKV + ((tok >> 6) * 128) * 64 + (tok & 63);
    pk[(size_t)lane * 64] = (unsigned)i0 | (f2bf(a0) << 16);
    pk[(size_t)(64 + lane) * 64] = (unsigned)i1 | (f2bf(a1v) << 16);
}
__device__ __forceinline__ void phase_peer_u(const Params& P, int vcu, int G) {
    int tid_ = threadIdx.x; asm volatile("" : "+v"(tid_));
    const int lane = tid_ & 63, wave = __builtin_amdgcn_readfirstlane(tid_ >> 6);
#pragma unroll 1
    for (int t = vcu * NWAVES + wave; t < M; t += G * NWAVES) peer_u_token(P, (size_t)t, lane);
}
__device__ __forceinline__ void phase_peer_v(const Params& P, LAS unsigned char* lds, int vcu, int G) {
    int tid_ = threadIdx.x; asm volatile("" : "+v"(tid_));
    const int tid = tid_, lane = tid & 63, wave = __builtin_amdgcn_readfirstlane(tid >> 6);
    const unsigned char* ws = P.ws;
    const bf16* H1B = (const bf16*)(ws + WS_B); const unsigned* PKV = (const unsigned*)(ws + WS_PKV);
#pragma unroll 1
    for (int c = vcu; c < 256; c += G) {
        __syncthreads();
        { const v4u* src = (const v4u*)(ws + WS_VB + (size_t)c * 131072);
#pragma unroll 4
          for (int i = tid; i < 8192; i += NTHREADS) *(LAS v4u*)(lds + 16 * i) = src[i]; }
        __syncthreads();
#pragma unroll 1
        for (int b = wave; b < 256; b += NWAVES) {
            const size_t tok = (size_t)b * 64 + lane;
            float y[8]; { const v4u hx = *(const v4u*)(H1B + tok * 2048 + 8 * c); unpack8(y, hx); }
            const unsigned* pk = PKV + (size_t)b * 128 * 64 + lane;
#pragma unroll 8
            for (int e = 0; e < 128; ++e) { const unsigned w = pk[e * 64]; const float a = asf(w & 0xffff0000u);
                const v2u vv = *(const LAS v2u*)(lds + (w & 0x3fffu) * 8);
                const f32x2 p0 = __builtin_amdgcn_cvt_pk_f32_fp8((int)vv.x, false), p1 = __builtin_amdgcn_cvt_pk_f32_fp8((int)vv.x, true);
                const f32x2 p2 = __builtin_amdgcn_cvt_pk_f32_fp8((int)vv.y, false), p3 = __builtin_amdgcn_cvt_pk_f32_fp8((int)vv.y, true);
                y[0] = fmaf(a, p0.x, y[0]); y[1] = fmaf(a, p0.y, y[1]); y[2] = fmaf(a, p1.x, y[2]); y[3] = fmaf(a, p1.y, y[3]);
                y[4] = fmaf(a, p2.x, y[4]); y[5] = fmaf(a, p2.y, y[5]); y[6] = fmaf(a, p3.x, y[6]); y[7] = fmaf(a, p3.y, y[7]); }
            float* op = P.out + tok * 2048 + 8 * c;
            *(f32x4*)op = (f32x4){y[0], y[1], y[2], y[3]}; *(f32x4*)(op + 4) = (f32x4){y[4], y[5], y[6], y[7]};
        }
    }
}
__device__ __forceinline__ void phase_final(const Params& P, int vcu, int G) {
    int tid_ = threadIdx.x; asm volatile("" : "+v"(tid_));
    const int lane = tid_ & 63, wave = __builtin_amdgcn_readfirstlane(tid_ >> 6);
    f32x4 gv[8];
#pragma unroll
    for (int j = 0; j < 8; ++j) gv[j] = ((const f32x4*)P.lnf)[lane + 64 * j];
#pragma unroll 1
    for (int t = vcu * NWAVES + wave; t < M; t += G * NWAVES) {
        f32x4* row = (f32x4*)(P.out + (size_t)t * 2048) + lane;
        f32x4 v[8]; float s = 0.f;
#pragma unroll
        for (int j = 0; j < 8; ++j) { v[j] = row[64 * j]; s += (v[j].x * v[j].x + v[j].y * v[j].y) + (v[j].z * v[j].z + v[j].w * v[j].w); }
        const float rs = rsqrtf(wave_sum(s) * (1.f / 2048.f) + EPS);
#pragma unroll
        for (int j = 0; j < 8; ++j) row[64 * j] = v[j] * rs * gv[j];
    }
}
#undef MFMA32
}
constexpr int N_PHASES = 10;
#ifndef REP_PHASE
#define REP_PHASE -1
#endif
#ifndef REP_N
#define REP_N 1
#endif
#ifndef EXTRA_SYNCS
#define EXTRA_SYNCS 0
#endif
__global__ void __launch_bounds__(NTHREADS, 2) mega(Params P) {
    extern __shared__ __attribute__((aligned(16))) unsigned char lds_raw[];
    LAS unsigned char* lds = (LAS unsigned char*)lds_raw;
    cg::grid_group grid = cg::this_grid();
    const int tid = threadIdx.x, lane = tid & 63, wave = __builtin_amdgcn_readfirstlane(tid >> 6);
    const int G = gridDim.x, bx = blockIdx.x;
    const int vcu = (G % 8 == 0) ? (bx % 8) * (G / 8) + bx / 8 : bx;
    unsigned char* ws = P.ws;
    const int lo = P.ph_lo, hi = P.ph_hi;
#define IN(k) (lo <= (k) && (k) < hi)
#define SEAM(k) do { if (IN(k) && IN((k) + 1)) grid.sync(); } while (0)

    for (int rep_ = 0; rep_ < (REP_PHASE == 0 ? 1 + REP_N : 1); ++rep_) if (IN(0)) { if (rep_) grid.sync(); phase_prep(P, lds, vcu, G); }
    SEAM(0);
    for (int es_ = 0; es_ < EXTRA_SYNCS; ++es_) grid.sync();
    for (int rep_ = 0; rep_ < (REP_PHASE == 1 ? 1 + REP_N : 1); ++rep_) if (IN(1)) { if (rep_) grid.sync();
        pg8::GemmSet g; g.A0 = g.A1 = (const bf16*)(ws + WS_A); g.Bt0 = g.Bt1 = (const bf16*)(ws + WS_BT1); g.K = 2048;
        pg8::StaticOrder S; S.init(M, 4096, 0, G, bx);
        pg8::Epi1 E{(bf16*)(ws + WS_B), (bf16*)(ws + WS_CQ), (bf16*)(ws + WS_CKV), (float*)(ws + WS_SSQCQ), (float*)(ws + WS_SSQCKV)};
        pg8::gemm_phase<pg8::Epi1, pg8::StaticOrder>(lds, g, S, E);
    }
    SEAM(1);
    for (int rep_ = 0; rep_ < (REP_PHASE == 2 ? 1 + REP_N : 1); ++rep_) if (IN(2)) { if (rep_) grid.sync();
        pg8::GemmSet g; g.A0 = (const bf16*)(ws + WS_CQ); g.A1 = (const bf16*)(ws + WS_CKV); g.Bt0 = (const bf16*)(ws + WS_BT2Q); g.Bt1 = (const bf16*)(ws + WS_BT2KV); g.K = 512;
        pg8::StaticOrder S; S.init(M, 1536, 2048, G, bx);
        pg8::Epi2 E{(bf16*)(ws + WS_QN), (bf16*)(ws + WS_QPE), (bf16*)(ws + WS_KN), (bf16*)(ws + WS_VM), (const float*)(ws + WS_SSQCQ), (const float*)(ws + WS_SSQCKV), (const f32x2*)(ws + WS_ROPE)};
        pg8::gemm_phase<pg8::Epi2, pg8::StaticOrder>(lds, g, S, E);
        for (int it = G - 1 - bx; it < 128; it += G) kr_item((const bf16*)(ws + WS_A), (const bf16*)(ws + WS_BTKR), (const f32x2*)(ws + WS_ROPE), (bf16*)(ws + WS_KPE), it, wave, lane);
    }
    SEAM(2);
    for (int rep_ = 0; rep_ < (REP_PHASE == 3 ? 1 + REP_N : 1); ++rep_) if (IN(3)) { if (rep_) grid.sync(); att::phase_attn(P, lds, vcu, G); }
    SEAM(3);
    for (int rep_ = 0; rep_ < (REP_PHASE == 4 ? 1 + REP_N : 1); ++rep_) if (IN(4)) { if (rep_) grid.sync();
        pg8::GemmSet g; g.A0 = g.A1 = (const bf16*)(ws + WS_A); g.Bt0 = g.Bt1 = (const bf16*)(ws + WS_BT3); g.K = 2048;
        pg8::StaticOrder S; S.init(M, 2048, 0, G, bx);
        pg8::Epi3 E{(bf16*)(ws + WS_B), P.x, (const float*)(ws + WS_SSQO), (float*)(ws + WS_SSQH), (LAS f32x2*)(lds + MISC_OFF)};
        pg8::gemm_phase<pg8::Epi3, pg8::StaticOrder>(lds, g, S, E);
    }
    SEAM(4);
    for (int rep_ = 0; rep_ < (REP_PHASE == 5 ? 1 + REP_N : 1); ++rep_) if (IN(5)) { if (rep_) grid.sync();
        pg8::GemmSet g; g.A0 = g.A1 = (const bf16*)(ws + WS_B); g.Bt0 = g.Bt1 = (const bf16*)(ws + WS_BT4); g.K = 2048;
        pg8::StaticOrder S; S.init(M, 2048, 0, G, bx);
        pg8::Epi4 E{(bf16*)(ws + WS_QP), (const float*)(ws + WS_SSQH), (LAS f32x2*)(lds + MISC_OFF)};
        pg8::gemm_phase<pg8::Epi4, pg8::StaticOrder>(lds, g, S, E);
    }
    SEAM(5);
    for (int rep_ = 0; rep_ < (REP_PHASE == 6 ? 1 + REP_N : 1); ++rep_) if (IN(6)) { if (rep_) grid.sync(); peer::phase_route(P, lds, vcu, G); }
    SEAM(6);
    for (int rep_ = 0; rep_ < (REP_PHASE == 7 ? 1 + REP_N : 1); ++rep_) if (IN(7)) { if (rep_) grid.sync(); peer::phase_peer_u(P, vcu, G); }
    SEAM(7);
    for (int rep_ = 0; rep_ < (REP_PHASE == 8 ? 1 + REP_N : 1); ++rep_) if (IN(8)) { if (rep_) grid.sync(); peer::phase_peer_v(P, lds, vcu, G); }
    SEAM(8);
    for (int rep_ = 0; rep_ < (REP_PHASE == 9 ? 1 + REP_N : 1); ++rep_) if (IN(9)) { if (rep_) grid.sync(); peer::phase_final(P, vcu, G); }
#undef IN
#undef SEAM
}

static int mega_grid() {
    static int grid = 0;
    if (grid == 0) {
        int dev = 0, cus = 0, per_cu = 0;
        (void)hipGetDevice(&dev); (void)hipDeviceGetAttribute(&cus, hipDeviceAttributeMultiprocessorCount, dev);
        (void)hipFuncSetAttribute((const void*)mega, hipFuncAttributeMaxDynamicSharedMemorySize, LDS_BYTES);
        (void)hipOccupancyMaxActiveBlocksPerMultiprocessor(&per_cu, (const void*)mega, NTHREADS, LDS_BYTES);
        if (per_cu < 1) { fprintf(stderr, "mega: occupancy query says %d blocks/CU\n", per_cu); per_cu = 1; }
        grid = cus;
        (void)hipGetLastError();
    }
    return grid;
}
static void fill_params(Params& P, void* const* d_in, void* d_out, void* d_ws) {
    P.x = (const float*)d_in[0]; P.ln1 = (const float*)d_in[1]; P.w_in = (const float*)d_in[2]; P.qan = (const float*)d_in[3]; P.kvan = (const float*)d_in[4];
    P.w_uq = (const float*)d_in[5]; P.w_ukv = (const float*)d_in[6]; P.ond = (const float*)d_in[7]; P.onm = (const float*)d_in[8]; P.w_o = (const float*)d_in[9];
    P.ln2 = (const float*)d_in[10]; P.wq = (const float*)d_in[11]; P.sk = (const float*)d_in[12]; P.pu = (const float*)d_in[13]; P.pv = (const float*)d_in[14]; P.lnf = (const float*)d_in[15];
    P.out = (float*)d_out; P.ws = (unsigned char*)d_ws;
}
static void launch_phases(Params P, int lo, int hi, hipStream_t st) {
    P.ph_lo = lo; P.ph_hi = hi;
    void* args[] = {&P};
    hipError_t e = hipLaunchCooperativeKernel((const void*)mega, dim3(mega_grid()), dim3(NTHREADS), args, LDS_BYTES, st);
    if (e != hipSuccess) fprintf(stderr, "mega launch [%d,%d) failed: %s\n", lo, hi, hipGetErrorString(e));
}
extern "C" void kernel_launch(void* const* d_in, const int* in_sizes, int n_in, void* d_out, int out_size, void* d_ws, size_t ws_size, hipStream_t stream) {
    Params P{}; fill_params(P, d_in, d_out, d_ws);
    launch_phases(P, 0, N_PHASES, stream);
}
```

```cpp
#include <hip/hip_runtime.h>
#include <hip/hip_cooperative_groups.h>
#include <cstdio>
#include <cstdint>
namespace cg = cooperative_groups;
#define GAS __attribute__((address_space(1)))
#define LAS __attribute__((address_space(3)))
typedef unsigned short bf16;
typedef unsigned v4u __attribute__((ext_vector_type(4)));
typedef unsigned v2u __attribute__((ext_vector_type(2)));
typedef float f32x2 __attribute__((ext_vector_type(2)));
typedef float f32x4 __attribute__((ext_vector_type(4)));
typedef float f32x16 __attribute__((ext_vector_type(16)));
typedef short bf16x8 __attribute__((ext_vector_type(8)));
typedef short s16x4 __attribute__((ext_vector_type(4)));
typedef __bf16 bf16x2_t __attribute__((ext_vector_type(2)));

constexpr int M = 16384, SEQ = 2048, DM = 2048, NWAVES = 8, NTHREADS = 512;
constexpr float EPS = 1e-6f, LOG2E = 1.4426950408889634f;
constexpr float QSCALE_DIL = 0.08838834764831845f * LOG2E;
constexpr float QSCALE_MLA = 0.07216878364870323f * LOG2E;

constexpr size_t MiB = 1u << 20;
constexpr size_t WS_CTL = 0, CTL_ZERO_BYTES = 64 * 1024;
constexpr size_t WS_ROPE = 1 * MiB;
constexpr size_t WS_SK = 2 * MiB;
constexpr size_t WS_BTKR = 3 * MiB;
constexpr size_t WS_BT2Q = 4 * MiB;
constexpr size_t WS_BT2KV = 6 * MiB;
constexpr size_t WS_BT1 = 8 * MiB;
constexpr size_t WS_BT3 = 24 * MiB;
constexpr size_t WS_BT4 = 32 * MiB;
constexpr size_t WS_SSQCQ = 40 * MiB;
constexpr size_t WS_SSQCKV = 40 * MiB + 512 * 1024;
constexpr size_t WS_SSQO = 41 * MiB;
constexpr size_t WS_SSQH = 42 * MiB;
constexpr size_t WS_KPE = 44 * MiB;
constexpr size_t WS_UB = 48 * MiB;
constexpr size_t WS_VB = 112 * MiB;
constexpr size_t WS_A = 176 * MiB;
constexpr size_t WS_B = 240 * MiB;
constexpr size_t WS_C = 336 * MiB;
constexpr size_t WS_QN = WS_C, WS_QPE = WS_C + 32 * MiB, WS_KN = WS_C + 48 * MiB, WS_VM = WS_C + 80 * MiB;
constexpr size_t WS_QP = WS_C, WS_RIDX = WS_C + 64 * MiB, WS_RGATE = WS_C + 72 * MiB, WS_PKV = WS_C + 80 * MiB;
constexpr size_t WS_D = 448 * MiB;
constexpr size_t WS_CQ = WS_D, WS_CKV = WS_D + 16 * MiB;
constexpr size_t WS_END = 480 * MiB;

constexpr int RING_BYTES = 131072;
constexpr int MISC_OFF = RING_BYTES;
constexpr int LDS_BYTES = 147456;

#define LDS_WAIT() asm volatile("s_waitcnt lgkmcnt(0)" ::: "memory")
#define VM_WAIT() asm volatile("s_waitcnt vmcnt(0)" ::: "memory")

__device__ __forceinline__ unsigned f2bf(float f) { unsigned u = __builtin_bit_cast(unsigned, f); return (u + 0x7fffu + ((u >> 16) & 1u)) >> 16; }
__device__ __forceinline__ unsigned pk2(float lo, float hi) { f32x2 v = {lo, hi}; bf16x2_t b = __builtin_convertvector(v, bf16x2_t); return __builtin_bit_cast(unsigned, b); }
__device__ __forceinline__ float bflo(unsigned u) { return __builtin_bit_cast(float, u << 16); }
__device__ __forceinline__ float bfhi(unsigned u) { return __builtin_bit_cast(float, u & 0xffff0000u); }
__device__ __forceinline__ float bf2f(bf16 b) { return __builtin_bit_cast(float, (unsigned)b << 16); }
__device__ __forceinline__ float wave_sum(float v) {
#pragma unroll
    for (int o = 1; o < 64; o <<= 1) v += __shfl_xor(v, o);
    return v;
}

struct Params {
    const float *x, *ln1, *w_in, *qan, *kvan, *w_uq, *w_ukv, *ond, *onm, *w_o, *ln2, *wq, *sk, *pu, *pv, *lnf;
    float* out; unsigned char* ws;
    int ph_lo, ph_hi;
};
__device__ __forceinline__ int map_ident(int c) { return c; }
__device__ __forceinline__ int map_kr(int c) { const int p = c - 4096; return 2 * (p & 31) + (p >> 5); }
__device__ __forceinline__ int map_uq(int c) { const int h = c / 192, e = c % 192; if (e < 128) return h * 128 + e; const int p = e - 128; return 1024 + h * 64 + 2 * (p & 31) + (p >> 5); }
__device__ __forceinline__ int map_ukv(int c) { const int h = c >> 8, e = c & 255; return e < 128 ? h * 128 + e : 1024 + h * 128 + (e - 128); }

template <int MAP>
__device__ __forceinline__ void p0_transpose_item(const float* __restrict__ W, int K, int ldw, int c0, const float* __restrict__ g0, const float* __restrict__ g1, int gsplit,
                                                  bf16* __restrict__ WT, LAS float* scr, int item, int nblk, int lane) {
    const int kb = item / nblk, nb = item % nblk, k0 = 64 * kb, n0 = c0 + 32 * nb;
#pragma unroll 8
    for (int i = 0; i < 32; ++i) { const int kk = 2 * i + (lane >> 5); const int k = k0 + kk;
        float w = W[(size_t)k * ldw + n0 + (lane & 31)];
        if (g0) w *= (k < gsplit ? g0[k] : g1[k - gsplit]);
        scr[kk * 33 + (lane & 31)] = w; }
    LDS_WAIT(); asm volatile("" ::: "memory");
    const int c = lane & 7;
#pragma unroll
    for (int j = 0; j < 4; ++j) { const int n = (lane >> 3) + 8 * j; const LAS float* s = scr + (8 * c) * 33 + n;
        v4u o; o.x = pk2(s[0 * 33], s[1 * 33]); o.y = pk2(s[2 * 33], s[3 * 33]); o.z = pk2(s[4 * 33], s[5 * 33]); o.w = pk2(s[6 * 33], s[7 * 33]);
        const int src = n0 + n;
        const int dr = MAP == 0 ? map_ident(src) : MAP == 1 ? map_kr(src) : MAP == 2 ? map_uq(src) : map_ukv(src);
        *(v4u*)(WT + (size_t)dr * K + k0 + 8 * c) = o; }
    LDS_WAIT(); asm volatile("" ::: "memory");
}

__device__ __forceinline__ void phase_prep(const Params& P, LAS unsigned char* lds, int vcu, int G) {
    int tid_ = threadIdx.x; asm volatile("" : "+v"(tid_));
    const int tid = tid_, lane = tid & 63, wave = __builtin_amdgcn_readfirstlane(tid >> 6);
    unsigned char* ws = P.ws;
    LAS float* scr = (LAS float*)(lds + wave * 16384);
    const int gw = vcu * NWAVES + wave, NGW = G * NWAVES;
    constexpr int I1 = 32 * 128, IKR = 32 * 2, I2Q = 8 * 48, I2KV = 8 * 64, I3 = 32 * 64, I4 = 32 * 64;
    constexpr int NITEMS = I1 + IKR + I2Q + I2KV + I3 + I4;
    for (int it = gw; it < NITEMS; it += NGW) {
        int r = it;
        if (r < I1) { p0_transpose_item<0>(P.w_in, 2048, 4160, 0, nullptr, nullptr, 0, (bf16*)(ws + WS_BT1), scr, r, 128, lane); continue; } r -= I1;
        if (r < IKR) { p0_transpose_item<1>(P.w_in, 2048, 4160, 4096, nullptr, nullptr, 0, (bf16*)(ws + WS_BTKR), scr, r, 2, lane); continue; } r -= IKR;
        if (r < I2Q) { p0_transpose_item<2>(P.w_uq, 512, 1536, 0, P.qan, P.qan, 512, (bf16*)(ws + WS_BT2Q), scr, r, 48, lane); continue; } r -= I2Q;
        if (r < I2KV) { p0_transpose_item<3>(P.w_ukv, 512, 2048, 0, P.kvan, P.kvan, 512, (bf16*)(ws + WS_BT2KV), scr, r, 64, lane); continue; } r -= I2KV;
        if (r < I3) { p0_transpose_item<0>(P.w_o, 2048, 2048, 0, P.ond, P.onm, 1024, (bf16*)(ws + WS_BT3), scr, r, 64, lane); continue; } r -= I3;
        p0_transpose_item<0>(P.wq, 2048, 2048, 0, P.ln2, P.ln2, 2048, (bf16*)(ws + WS_BT4), scr, r, 64, lane);
    }
    {
        bf16* XN = (bf16*)(ws + WS_A);
        f32x4 gv[8];
#pragma unroll
        for (int j = 0; j < 8; ++j) gv[j] = ((const f32x4*)P.ln1)[lane + 64 * j];
        for (int m = gw; m < M; m += NGW) {
            const f32x4* xr = (const f32x4*)(P.x + (size_t)m * DM) + lane;
            f32x4 v[8]; float s = 0.f;
#pragma unroll
            for (int j = 0; j < 8; ++j) { v[j] = xr[64 * j]; s += (v[j].x * v[j].x + v[j].y * v[j].y) + (v[j].z * v[j].z + v[j].w * v[j].w); }
            const float rs = rsqrtf(wave_sum(s) * (1.f / DM) + EPS);
            v2u* o8 = (v2u*)(XN + (size_t)m * DM) + lane;
#pragma unroll
            for (int j = 0; j < 8; ++j) { v2u o; o.x = pk2(v[j].x * rs * gv[j].x, v[j].y * rs * gv[j].y); o.y = pk2(v[j].z * rs * gv[j].z, v[j].w * rs * gv[j].w); o8[64 * j] = o; }
        }
    }
    const int gt = vcu * NTHREADS + tid, NGT = G * NTHREADS;
    {
        f32x2* R = (f32x2*)(ws + WS_ROPE);
        for (int i = gt; i < 2048 * 32; i += NGT) { const int pos = i >> 5, j = i & 31; const float freq = powf(10000.0f, -(float)j / 32.0f), ang = (float)pos * freq;
            f32x2 cs; cs.x = cosf(ang); cs.y = sinf(ang); R[i] = cs; }
    }
    {
        v4u* o = (v4u*)(ws + WS_SK);
        for (int i = gt; i < 16 * 128 * 128 / 8; i += NGT) { const f32x4 a = ((const f32x4*)P.sk)[2 * i], b = ((const f32x4*)P.sk)[2 * i + 1];
            v4u w; w.x = pk2(a.x, a.y); w.y = pk2(a.z, a.w); w.z = pk2(b.x, b.y); w.w = pk2(b.z, b.w); o[i] = w; }
    }
    {
        v2u* ou = (v2u*)(ws + WS_UB);
        for (int i = gt; i < 16384 * 2048 / 8; i += NGT) {
            const f32x4 a = __builtin_nontemporal_load((const f32x4*)P.pu + 2 * i), b = __builtin_nontemporal_load((const f32x4*)P.pu + 2 * i + 1);
            const int k8 = (i & 255) * 2; const f32x4 g0 = ((const f32x4*)P.ln2)[k8] * 32.f, g1 = ((const f32x4*)P.ln2)[k8 + 1] * 32.f;
            int w0 = 0, w1 = 0;
            w0 = __builtin_amdgcn_cvt_pk_fp8_f32(a.x * g0.x, a.y * g0.y, w0, false); w0 = __builtin_amdgcn_cvt_pk_fp8_f32(a.z * g0.z, a.w * g0.w, w0, true);
            w1 = __builtin_amdgcn_cvt_pk_fp8_f32(b.x * g1.x, b.y * g1.y, w1, false); w1 = __builtin_amdgcn_cvt_pk_fp8_f32(b.z * g1.z, b.w * g1.w, w1, true);
            v2u w; w.x = (unsigned)w0; w.y = (unsigned)w1; ou[i] = w;
        }
        __syncthreads();
        LAS v2u* tl = (LAS v2u*)lds;
        v2u* ov = (v2u*)(ws + WS_VB);
        for (int tile = vcu; tile < 1024; tile += G) {
            const int e0 = (tile >> 2) * 64, c0 = (tile & 3) * 64;
#pragma unroll
            for (int k = 0; k < 8; ++k) { const int it = tid + 512 * k, e = it >> 6, c = it & 63;
                const f32x4* src = (const f32x4*)(P.pv + (size_t)(e0 + e) * 2048 + (size_t)(c0 + c) * 8);
                const f32x4 a = __builtin_nontemporal_load(src), b = __builtin_nontemporal_load(src + 1);
                int w0 = 0, w1 = 0;
                w0 = __builtin_amdgcn_cvt_pk_fp8_f32(a.x * 2.f, a.y * 2.f, w0, false); w0 = __builtin_amdgcn_cvt_pk_fp8_f32(a.z * 2.f, a.w * 2.f, w0, true);
                w1 = __builtin_amdgcn_cvt_pk_fp8_f32(b.x * 2.f, b.y * 2.f, w1, false); w1 = __builtin_amdgcn_cvt_pk_fp8_f32(b.z * 2.f, b.w * 2.f, w1, true);
                v2u w; w.x = (unsigned)w0; w.y = (unsigned)w1; tl[c * 65 + e] = w; }
            __syncthreads();
#pragma unroll
            for (int k = 0; k < 8; ++k) { const int it = tid + 512 * k, c = it >> 6, e = it & 63; ov[(size_t)(c0 + c) * 16384 + e0 + e] = tl[c * 65 + e]; }
            __syncthreads();
        }
    }
}
namespace pg8 {
constexpr int BM = 256, BK = 64, HALF = 128, HTB = HALF * BK * 2, STAGE_BYTES = 8 * HTB, NXCD = 8, WGM = 8;
__host__ __device__ __forceinline__ int lds_byte(int r, int c) { const int st = (r >> 4) * 2 + (c >> 5), rr = r & 15, cc = c & 31, ob = rr * 64 + cc * 2; return st * 1024 + (ob ^ (((ob >> 9) & 1) << 5)); }
__host__ __device__ __forceinline__ void stage_rc(int b, int& R, int& C) { const int st = b / 1024, sb = b % 1024, swz = sb ^ (((sb >> 9) & 1) << 5); R = (st >> 1) * 16 + swz / 64; C = (st & 1) * 32 + (swz % 64) / 2; }
__host__ __device__ __forceinline__ int perm32(int rho) { const int n = rho >> 4, i = rho & 15; return 8 * (i >> 2) + 4 * n + (i & 3); }

struct Unit { int pm, pn, g; };
struct GemmSet { const bf16 *A0, *A1, *Bt0, *Bt1; int K; };

struct StaticOrder {
    int nM, nN0, nN, nwg, G, c;
    __device__ void init(int Mrows, int N0, int N1, int G_, int c_) { nM = Mrows / BM; nN0 = N0 / BM; nN = nN0 + N1 / BM; nwg = nM * nN; G = G_; c = c_; }
    __device__ bool next(int i, Unit& u) const {
        const long L = (long)i * G + c; if (L >= nwg) return false;
        int wgid = (int)L; { const int q = nwg / NXCD, r = nwg % NXCD, xcd = wgid % NXCD, off = wgid / NXCD; wgid = (xcd < r ? xcd * (q + 1) : r * (q + 1) + (xcd - r) * q) + off; }
        const int nig = WGM * nN, gid = wgid / nig, fm = gid * WGM, gsz = (nM - fm) < WGM ? (nM - fm) : WGM;
        u.pm = fm + ((wgid % nig) % gsz); int pn = (wgid % nig) / gsz; u.g = pn >= nN0 ? 1 : 0; u.pn = pn >= nN0 ? pn - nN0 : pn; return true;
    }
};

template <class Epi, class Sched>
__device__ __forceinline__ void gemm_phase(LAS unsigned char* lds, const GemmSet g, const Sched& S, const Epi& E) {
    int tid_ = threadIdx.x; asm volatile("" : "+v"(tid_));
    const int tid = tid_, wid = __builtin_amdgcn_readfirstlane(tid >> 6), lane = tid & 63, wr = wid >> 2, wc = wid & 3, fr = lane & 15, fq = lane >> 4;
    const int K = g.K, nt = K / BK;
    unsigned voffA[2], voffB[2];
#pragma unroll
    for (int i = 0; i < 2; ++i) { int R, C; stage_rc(tid * 16 + i * 8192, R, C); const int Rb = (R & ~31) + perm32(R & 31);
        voffA[i] = (unsigned)(R * K + C) * 2u; voffB[i] = (unsigned)(Rb * K + C) * 2u; }
    const size_t kstep = (size_t)(BK * 2);
    const size_t hstep = (size_t)HALF * K * 2;
    const size_t tstep = 2 * hstep;
    const unsigned ldsw = (unsigned)wid * 1024u;
    const int aoff = lds_byte(wr * 64 + fr, fq * 8), boff = lds_byte(wc * 32 + fr, fq * 8);
#define PG8_SA(b, h) (((b) * 2 + (h)) * HTB)
#define PG8_SB(b, h) ((4 + (b) * 2 + (h)) * HTB)
#define PG8_STAGE(bufoff, gbase, voff) do { _Pragma("unroll") for (int _i = 0; _i < 2; ++_i) \
        __builtin_amdgcn_global_load_lds((const unsigned*)((const char*)(gbase) + (voff)[_i]), (LAS unsigned*)(lds + (bufoff) + ldsw + _i * 8192), 16, 0, 0); } while (0)
#define PG8_LDA(dst, b, h) do { _Pragma("unroll") for (int m = 0; m < 4; ++m) _Pragma("unroll") for (int k = 0; k < 2; ++k) dst[m][k] = *(const LAS bf16x8*)(lds + PG8_SA(b, h) + aoff + m * 2048 + k * 1024); } while (0)
#define PG8_LDB(dst, b, h) do { _Pragma("unroll") for (int n = 0; n < 2; ++n) _Pragma("unroll") for (int k = 0; k < 2; ++k) dst[n][k] = *(const LAS bf16x8*)(lds + PG8_SB(b, h) + boff + n * 2048 + k * 1024); } while (0)
#define PG8_MMA(ai, bj, At, Bt) do { __builtin_amdgcn_s_setprio(1); _Pragma("unroll") for (int m = 0; m < 4; ++m) _Pragma("unroll") for (int n = 0; n < 2; ++n) _Pragma("unroll") for (int k = 0; k < 2; ++k) \
        acc[ai][bj][m][n] = __builtin_amdgcn_mfma_f32_16x16x32_bf16(Bt[n][k], At[m][k], acc[ai][bj][m][n], 0, 0, 0); __builtin_amdgcn_s_setprio(0); } while (0)
#define PG8_WAIT_V(n) asm volatile("s_waitcnt vmcnt(" #n ")" ::: "memory")
#define PG8_WAIT_L(n) asm volatile("s_waitcnt lgkmcnt(" #n ")" ::: "memory")
#define PG8_BAR __builtin_amdgcn_s_barrier()
#define PG8_SCHED __builtin_amdgcn_sched_barrier(0)
    Unit cur, nxt; int ui = 0;
    if (!S.next(0, cur)) return;
    f32x4 acc[2][2][4][2];
#pragma unroll
    for (int a = 0; a < 2; ++a)
#pragma unroll
        for (int b = 0; b < 2; ++b)
#pragma unroll
            for (int m = 0; m < 4; ++m)
#pragma unroll
                for (int n = 0; n < 2; ++n) acc[a][b][m][n] = (f32x4){0.f, 0.f, 0.f, 0.f};
    bf16x8 At[4][2], B0[2][2], B1[2][2];
    const char* cA = (const char*)(cur.g ? g.A1 : g.A0) + (size_t)cur.pm * tstep; const char* cB = (const char*)(cur.g ? g.Bt1 : g.Bt0) + (size_t)cur.pn * tstep;
    E.unit_begin(cur, 0, tid);
    PG8_STAGE(PG8_SB(0, 0), cB, voffB); PG8_STAGE(PG8_SB(0, 1), cB + hstep, voffB); PG8_STAGE(PG8_SA(0, 0), cA, voffA); PG8_STAGE(PG8_SA(0, 1), cA + hstep, voffA);
    if (wr == 1) PG8_BAR;
    PG8_WAIT_V(2); PG8_BAR;
    PG8_STAGE(PG8_SB(1, 0), cB + kstep, voffB); PG8_STAGE(PG8_SA(1, 0), cA + kstep, voffA); PG8_STAGE(PG8_SB(1, 1), cB + hstep + kstep, voffB);
    PG8_WAIT_V(6); PG8_BAR;
    for (;;) {
        const bool has_next = S.next(ui + 1, nxt);
        const char* nA = has_next ? (const char*)(nxt.g ? g.A1 : g.A0) + (size_t)nxt.pm * tstep : cA; const char* nB = has_next ? (const char*)(nxt.g ? g.Bt1 : g.Bt0) + (size_t)nxt.pn * tstep : cB;
        for (int t = 0; t < nt; t += 2) {
            const bool last = (t == nt - 2);
            const char* a1 = cA + (size_t)(t + 1) * kstep;
            const char* a2 = last ? nA : cA + (size_t)(t + 2) * kstep; const char* b2 = last ? nB : cB + (size_t)(t + 2) * kstep;
            const char* a3 = a2 + kstep; const char* b3 = b2 + kstep;
            if constexpr (Epi::MIDSCALE) { if (t == nt / 2) E.midscale(acc, ui & 1, wr, fr); }
            PG8_LDB(B0, 0, 0); PG8_LDB(B1, 0, 1); PG8_SCHED; PG8_LDA(At, 0, 0); PG8_STAGE(PG8_SA(1, 1), a1 + hstep, voffA);
            PG8_WAIT_V(8); PG8_WAIT_L(0); PG8_BAR; PG8_MMA(0, 0, At, B0); PG8_MMA(0, 1, At, B1); PG8_BAR; PG8_SCHED;
            PG8_LDA(At, 0, 1); PG8_STAGE(PG8_SB(0, 0), b2, voffB); PG8_STAGE(PG8_SB(0, 1), b2 + hstep, voffB); PG8_STAGE(PG8_SA(0, 0), a2, voffA);
            PG8_WAIT_V(8); PG8_WAIT_L(0); PG8_BAR; PG8_MMA(1, 0, At, B0); PG8_MMA(1, 1, At, B1); PG8_BAR; PG8_SCHED;
            PG8_LDB(B0, 1, 0); PG8_LDB(B1, 1, 1); PG8_SCHED; PG8_LDA(At, 1, 0); PG8_STAGE(PG8_SA(0, 1), a2 + hstep, voffA);
            PG8_WAIT_V(8); PG8_WAIT_L(0); PG8_BAR; PG8_MMA(0, 0, At, B0); PG8_MMA(0, 1, At, B1); PG8_BAR; PG8_SCHED;
            PG8_LDA(At, 1, 1); PG8_STAGE(PG8_SB(1, 0), b3, voffB); PG8_STAGE(PG8_SB(1, 1), b3 + hstep, voffB); PG8_STAGE(PG8_SA(1, 0), a3, voffA);
            PG8_WAIT_V(8); PG8_WAIT_L(0); PG8_BAR; PG8_MMA(1, 0, At, B0); PG8_MMA(1, 1, At, B1); PG8_BAR; PG8_SCHED;
        }
        if (wr == 0) PG8_BAR;
        E(acc, cur, ui & 1, wr, wc, fr, fq);
        if (!has_next) break;
#pragma unroll
        for (int a = 0; a < 2; ++a)
#pragma unroll
            for (int b = 0; b < 2; ++b)
#pragma unroll
                for (int m = 0; m < 4; ++m)
#pragma unroll
                    for (int n = 0; n < 2; ++n) acc[a][b][m][n] = (f32x4){0.f, 0.f, 0.f, 0.f};
        cur = nxt; cA = nA; cB = nB; ++ui;
        E.unit_begin(cur, ui & 1, tid);
        if (wr == 1) PG8_BAR;
    }
    PG8_WAIT_V(0);
    PG8_BAR;
#undef PG8_SA
#undef PG8_SB
#undef PG8_STAGE
#undef PG8_LDA
#undef PG8_LDB
#undef PG8_MMA
#undef PG8_WAIT_V
#undef PG8_WAIT_L
#undef PG8_BAR
#undef PG8_SCHED
}
}
namespace pg8 {
__device__ __forceinline__ v4u pack8(const f32x4& v0, const f32x4& v1) { v4u w; w.x = pk2(v0[0], v0[1]); w.y = pk2(v0[2], v0[3]); w.z = pk2(v1[0], v1[1]); w.w = pk2(v1[2], v1[3]); return w; }
__device__ __forceinline__ float sq8(const f32x4& v0, const f32x4& v1) { return (v0[0] * v0[0] + v0[1] * v0[1]) + (v0[2] * v0[2] + v0[3] * v0[3]) + (v1[0] * v1[0] + v1[1] * v1[1]) + (v1[2] * v1[2] + v1[3] * v1[3]); }

struct Epi1 {
    static constexpr bool MIDSCALE = false;
    bf16 *QKV, *CQ, *CKV; float *SSQCQ, *SSQCKV;
    __device__ __forceinline__ void midscale(f32x4 (&)[2][2][4][2], int, int, int) const {}
    __device__ __forceinline__ void unit_begin(const Unit&, int, int) const {}
    __device__ __forceinline__ void operator()(const f32x4 (&acc)[2][2][4][2], const Unit& u, int par, int wr, int wc, int fr, int fq) const {
        const int pn = u.pn; bf16* base; int ldc, colt; float sc = 1.f; float* ssq = nullptr; int sslot = 0;
        if (pn < 12) { base = QKV; ldc = 3072; colt = pn * 256; if (pn < 4) sc = QSCALE_DIL; }
        else if (pn < 14) { base = CQ; ldc = 512; colt = (pn - 12) * 256; ssq = SSQCQ; sslot = (pn - 12) * 4 + wc; }
        else { base = CKV; ldc = 512; colt = (pn - 14) * 256; ssq = SSQCKV; sslot = (pn - 14) * 4 + wc; }
        const int row0 = u.pm * BM + wr * 64 + fr, col0 = colt + wc * 32 + 8 * fq;
#pragma unroll
        for (int ai = 0; ai < 2; ++ai)
#pragma unroll
            for (int m = 0; m < 4; ++m) { const int row = row0 + ai * HALF + m * 16; bf16* rowp = base + (size_t)row * ldc + col0; float ss = 0.f;
#pragma unroll
                for (int bj = 0; bj < 2; ++bj) { const f32x4 v0 = acc[ai][bj][m][0] * sc, v1 = acc[ai][bj][m][1] * sc; ss += sq8(v0, v1); *(v4u*)(rowp + bj * HALF) = pack8(v0, v1); }
                if (ssq) { ss += __shfl_xor(ss, 16); ss += __shfl_xor(ss, 32); if (fq == 0) ssq[(size_t)row * 8 + sslot] = ss; } }
    }
};

struct Epi2 {
    static constexpr bool MIDSCALE = false;
    bf16 *QN, *QPE, *KN, *VM; const float *SSQCQ, *SSQCKV; const f32x2* ROPE;
    __device__ __forceinline__ void midscale(f32x4 (&)[2][2][4][2], int, int, int) const {}
    __device__ __forceinline__ void unit_begin(const Unit&, int, int) const {}
    __device__ __forceinline__ void operator()(const f32x4 (&acc)[2][2][4][2], const Unit& u, int par, int wr, int wc, int fr, int fq) const {
        const int pn = u.pn; bf16* base; int ldc, colt; float sc = 1.f; bool rope = false; const float* ssq;
        if (u.g == 0) { ssq = SSQCQ; sc = QSCALE_MLA; if (pn < 4) { base = QN; ldc = 1024; colt = pn * 256; } else { base = QPE; ldc = 512; colt = (pn - 4) * 256; rope = true; } }
        else { ssq = SSQCKV; if (pn < 4) { base = KN; ldc = 1024; colt = pn * 256; } else { base = VM; ldc = 1024; colt = (pn - 4) * 256; } }
        const int row0 = u.pm * BM + wr * 64 + fr, col0 = colt + wc * 32 + 8 * fq;
#pragma unroll
        for (int ai = 0; ai < 2; ++ai)
#pragma unroll
            for (int m = 0; m < 4; ++m) { const int row = row0 + ai * HALF + m * 16; bf16* rowp = base + (size_t)row * ldc + col0;
                const f32x4 p0 = *(const f32x4*)(ssq + (size_t)row * 8), p1 = *(const f32x4*)(ssq + (size_t)row * 8 + 4);
                const float rs = rsqrtf(((p0[0] + p0[1]) + (p0[2] + p0[3]) + (p1[0] + p1[1]) + (p1[2] + p1[3])) * (1.f / 512.f) + EPS) * sc;
#pragma unroll
                for (int bj = 0; bj < 2; ++bj) { f32x4 v0 = acc[ai][bj][m][0] * rs, v1 = acc[ai][bj][m][1] * rs;
                    if (rope) { const int j0 = ((col0 + bj * HALF) & 63) >> 1; const f32x4* rp = (const f32x4*)(ROPE + (size_t)(row & (SEQ - 1)) * 32 + j0);
                        const f32x4 r0 = rp[0], r1 = rp[1];
                        f32x4 w0, w1;
                        w0[0] = v0[0] * r0[0] - v0[1] * r0[1]; w0[1] = v0[0] * r0[1] + v0[1] * r0[0];
                        w0[2] = v0[2] * r0[2] - v0[3] * r0[3]; w0[3] = v0[2] * r0[3] + v0[3] * r0[2];
                        w1[0] = v1[0] * r1[0] - v1[1] * r1[1]; w1[1] = v1[0] * r1[1] + v1[1] * r1[0];
                        w1[2] = v1[2] * r1[2] - v1[3] * r1[3]; w1[3] = v1[2] * r1[3] + v1[3] * r1[2];
                        v0 = w0; v1 = w1; }
                    *(v4u*)(rowp + bj * HALF) = pack8(v0, v1); } }
    }
};

struct Epi3 {
    static constexpr bool MIDSCALE = true;
    bf16* H1B; const float* X; const float* SSQO; float* SSQH; LAS f32x2* RS;
    __device__ __forceinline__ void unit_begin(const Unit& u, int par, int tid) const {
        if (tid < 256) { const f32x4* p = (const f32x4*)(SSQO + (size_t)(u.pm * BM + tid) * 16); const f32x4 a0 = p[0], a1 = p[1], b0 = p[2], b1 = p[3];
            const float ra = rsqrtf(((a0[0] + a0[1]) + (a0[2] + a0[3]) + (a1[0] + a1[1]) + (a1[2] + a1[3])) * (1.f / 1024.f) + EPS);
            const float rb = rsqrtf(((b0[0] + b0[1]) + (b0[2] + b0[3]) + (b1[0] + b1[1]) + (b1[2] + b1[3])) * (1.f / 1024.f) + EPS);
            f32x2 v; v.x = ra / rb; v.y = rb; RS[par * 256 + tid] = v; }
    }
    __device__ __forceinline__ void midscale(f32x4 (&acc)[2][2][4][2], int par, int wr, int fr) const {
#pragma unroll
        for (int ai = 0; ai < 2; ++ai)
#pragma unroll
            for (int m = 0; m < 4; ++m) { const float f = RS[par * 256 + ai * HALF + wr * 64 + m * 16 + fr].x;
#pragma unroll
                for (int bj = 0; bj < 2; ++bj) { acc[ai][bj][m][0] = acc[ai][bj][m][0] * f; acc[ai][bj][m][1] = acc[ai][bj][m][1] * f; } }
    }
    __device__ __forceinline__ void operator()(const f32x4 (&acc)[2][2][4][2], const Unit& u, int par, int wr, int wc, int fr, int fq) const {
        const int row0 = u.pm * BM + wr * 64 + fr, col0 = u.pn * BM + wc * 32 + 8 * fq, sslot = u.pn * 4 + wc;
#pragma unroll
        for (int ai = 0; ai < 2; ++ai)
#pragma unroll
            for (int m = 0; m < 4; ++m) { const int row = row0 + ai * HALF + m * 16; const float rb = RS[par * 256 + ai * HALF + wr * 64 + m * 16 + fr].y; float ss = 0.f;
#pragma unroll
                for (int bj = 0; bj < 2; ++bj) { const float* xp = X + (size_t)row * DM + col0 + bj * HALF; const f32x4 x0 = *(const f32x4*)xp, x1 = *(const f32x4*)(xp + 4);
                    const f32x4 v0 = acc[ai][bj][m][0] * rb + x0, v1 = acc[ai][bj][m][1] * rb + x1; ss += sq8(v0, v1);
                    *(v4u*)(H1B + (size_t)row * DM + col0 + bj * HALF) = pack8(v0, v1); }
                ss += __shfl_xor(ss, 16); ss += __shfl_xor(ss, 32); if (fq == 0) SSQH[(size_t)row * 32 + sslot] = ss; }
    }
};

struct Epi4 {
    static constexpr bool MIDSCALE = false;
    bf16* QP; const float* SSQH; LAS f32x2* RS;
    __device__ __forceinline__ void midscale(f32x4 (&)[2][2][4][2], int, int, int) const {}
    __device__ __forceinline__ void unit_begin(const Unit& u, int par, int tid) const {
        if (tid < 256) { const f32x4* p = (const f32x4*)(SSQH + (size_t)(u.pm * BM + tid) * 32); f32x4 s = p[0];
#pragma unroll
            for (int i = 1; i < 8; ++i) s = s + p[i];
            f32x2 v; v.x = rsqrtf(((s[0] + s[1]) + (s[2] + s[3])) * (1.f / 2048.f) + EPS); v.y = 0.f; RS[par * 256 + tid] = v; }
    }
    __device__ __forceinline__ void operator()(const f32x4 (&acc)[2][2][4][2], const Unit& u, int par, int wr, int wc, int fr, int fq) const {
        const int row0 = u.pm * BM + wr * 64 + fr, col0 = u.pn * BM + wc * 32 + 8 * fq;
#pragma unroll
        for (int ai = 0; ai < 2; ++ai)
#pragma unroll
            for (int m = 0; m < 4; ++m) { const int row = row0 + ai * HALF + m * 16; const float rs = RS[par * 256 + ai * HALF + wr * 64 + m * 16 + fr].x;
#pragma unroll
                for (int bj = 0; bj < 2; ++bj) *(v4u*)(QP + (size_t)row * DM + col0 + bj * HALF) = pack8(acc[ai][bj][m][0] * rs, acc[ai][bj][m][1] * rs); }
    }
};
}

__device__ __forceinline__ void kr_item(const bf16* __restrict__ XN, const bf16* __restrict__ BT, const f32x2* __restrict__ ROPE, bf16* __restrict__ KPE, int item, int wave, int lane) {
    const int fr = lane & 15, fq = lane >> 4, row = item * 128 + wave * 16 + fr;
    const bf16* ap = XN + (size_t)row * 2048 + fq * 8; const bf16* bp = BT + (size_t)fr * 2048 + fq * 8;
    f32x4 acc[4];
#pragma unroll
    for (int nb = 0; nb < 4; ++nb) acc[nb] = (f32x4){0.f, 0.f, 0.f, 0.f};
#pragma unroll 4
    for (int k0 = 0; k0 < 2048; k0 += 32) {
        const bf16x8 a = *(const bf16x8*)(ap + k0);
#pragma unroll
        for (int nb = 0; nb < 4; ++nb) { const bf16x8 b = *(const bf16x8*)(bp + (size_t)nb * 16 * 2048 + k0); acc[nb] = __builtin_amdgcn_mfma_f32_16x16x32_bf16(b, a, acc[nb], 0, 0, 0); }
    }
    const int pos = row & (SEQ - 1);
#pragma unroll
    for (int nb = 0; nb < 4; ++nb) { const int j0 = 8 * nb + 2 * fq; const f32x4 r = *(const f32x4*)(ROPE + (size_t)pos * 32 + j0); const f32x4 v = acc[nb];
        v2u o; o.x = pk2(v[0] * r[0] - v[1] * r[1], v[0] * r[1] + v[1] * r[0]); o.y = pk2(v[2] * r[2] - v[3] * r[3], v[2] * r[3] + v[3] * r[2]);
        *(v2u*)(KPE + (size_t)row * 64 + 16 * nb + 4 * fq) = o; }
}
namespace att {
typedef short v4i16_t __attribute__((ext_vector_type(4)));
#define MFMA32(a, b, c) __builtin_amdgcn_mfma_f32_32x32x16_bf16((a), (b), (c), 0, 0, 0)
__device__ __forceinline__ s16x4 vtr(const LAS unsigned char* p) { return __builtin_bit_cast(s16x4, __builtin_amdgcn_ds_read_tr16_b64_v4i16((LAS v4i16_t*)p)); }
__device__ __forceinline__ int crow(int r, int hi) { return (r & 3) + 8 * (r >> 2) + 4 * hi; }
constexpr int VS = 320;
constexpr int KS = 400;
constexpr float NEG = -1e30f;

__device__ __forceinline__ bf16x8 pack8r(const f32x16& p, int s) {
    v4u w; w.x = pk2(p[8 * s + 0], p[8 * s + 1]); w.y = pk2(p[8 * s + 2], p[8 * s + 3]); w.z = pk2(p[8 * s + 4], p[8 * s + 5]); w.w = pk2(p[8 * s + 6], p[8 * s + 7]);
    return __builtin_bit_cast(bf16x8, w);
}
__device__ __forceinline__ void pv32(f32x16 (&o)[4], const LAS unsigned char* vb, const bf16x8 pb0, const bf16x8 pb1) {
#pragma unroll
    for (int d = 0; d < 4; ++d) {
        const s16x4 l0 = vtr(vb + d * 64), h0 = vtr(vb + d * 64 + 8 * VS), l1 = vtr(vb + d * 64 + 16 * VS), h1 = vtr(vb + d * 64 + 24 * VS);
        const bf16x8 a0 = __builtin_shufflevector(l0, h0, 0, 1, 2, 3, 4, 5, 6, 7), a1 = __builtin_shufflevector(l1, h1, 0, 1, 2, 3, 4, 5, 6, 7);
        o[d] = MFMA32(a0, pb0, o[d]); o[d] = MFMA32(a1, pb1, o[d]);
    }
}
template <int NS>
__device__ __forceinline__ void softmax_step(f32x16 (&s)[NS], float& m, float& l, f32x16 (&o)[4], bf16x8 (&pb)[2 * NS]) {
    float mx = s[0][0];
#pragma unroll
    for (int t = 0; t < NS; ++t)
#pragma unroll
        for (int r = 0; r < 16; ++r) mx = fmaxf(mx, s[t][r]);
    mx = fmaxf(mx, __shfl_xor(mx, 32));
    const float mn = fmaxf(m, mx), alpha = __builtin_amdgcn_exp2f(m - mn); m = mn;
    float ps = 0.f;
#pragma unroll
    for (int t = 0; t < NS; ++t)
#pragma unroll
        for (int r = 0; r < 16; ++r) { const float p = __builtin_amdgcn_exp2f(s[t][r] - mn); s[t][r] = p; ps += p; }
    l = l * alpha + ps;
    if (!__all(alpha == 1.0f)) {
#pragma unroll
        for (int d = 0; d < 4; ++d) o[d] = o[d] * alpha;
    }
#pragma unroll
    for (int t = 0; t < NS; ++t) { pb[2 * t] = pack8r(s[t], 0); pb[2 * t + 1] = pack8r(s[t], 1); }
}
__device__ __forceinline__ void store_o(f32x16 (&o)[4], float l, bf16* __restrict__ orow  , float* __restrict__ ssq  , int hh) {
    l += __shfl_xor(l, 32);
    const float inv = 1.0f / l; float ss = 0.f;
#pragma unroll
    for (int d = 0; d < 4; ++d) { o[d] = o[d] * inv;
#pragma unroll
        for (int g = 0; g < 4; ++g) { const float a = o[d][4 * g], b = o[d][4 * g + 1], c = o[d][4 * g + 2], e = o[d][4 * g + 3];
            ss += (a * a + b * b) + (c * c + e * e);
            v2u w; w.x = pk2(a, b); w.y = pk2(c, e); *(v2u*)(orow + 32 * d + 8 * g + 4 * hh) = w; } }
    ss += __shfl_xor(ss, 32);
    if (hh == 0) *ssq = ss;
}

constexpr int KTB = 64 * KS, VTB = 64 * VS, BUFB = KTB + VTB;
__device__ __forceinline__ void mla_unit(const unsigned char* ws, LAS unsigned char* lds, int b, int h, int qblk, int tid, int wave, int lane) {
    const bf16* QN = (const bf16*)(ws + WS_QN); const bf16* QPE = (const bf16*)(ws + WS_QPE); const bf16* KN = (const bf16*)(ws + WS_KN);
    const bf16* KPE = (const bf16*)(ws + WS_KPE); const bf16* VM = (const bf16*)(ws + WS_VM);
    bf16* O = (bf16*)(ws + WS_A); float* SSQO = (float*)(ws + WS_SSQO);
    const int r32 = lane & 31, hh = lane >> 5;
    const size_t tok0 = (size_t)b * SEQ;
    const int row_lo = qblk * 256 + wave * 32, qrow = row_lo + r32;
    bf16x8 qf[12];
    { const bf16* qn = QN + (tok0 + qrow) * 1024 + h * 128 + 8 * hh;
#pragma unroll
      for (int s = 0; s < 8; ++s) qf[s] = *(const bf16x8*)(qn + 16 * s);
      const bf16* qp = QPE + (tok0 + qrow) * 512 + h * 64 + 8 * hh;
#pragma unroll
      for (int s = 0; s < 4; ++s) qf[8 + s] = *(const bf16x8*)(qp + 16 * s); }
    const int c0 = tid, c1 = tid + 512;
    const bf16* gkn0 = KN + (tok0 + (c0 >> 4)) * 1024 + h * 128 + (c0 & 15) * 8; const bf16* gkn1 = KN + (tok0 + (c1 >> 4)) * 1024 + h * 128 + (c1 & 15) * 8;
    const bf16* gkp = KPE + (tok0 + (tid >> 3)) * 64 + (tid & 7) * 8;
    const bf16* gv0 = VM + (tok0 + (c0 >> 4)) * 1024 + h * 128 + (c0 & 15) * 8; const bf16* gv1 = VM + (tok0 + (c1 >> 4)) * 1024 + h * 128 + (c1 & 15) * 8;
    const int lkn0 = (c0 >> 4) * KS + (c0 & 15) * 16, lkn1 = (c1 >> 4) * KS + (c1 & 15) * 16, lkp = (tid >> 3) * KS + 256 + (tid & 7) * 16;
    const int lv0 = KTB + (c0 >> 4) * VS + (c0 & 15) * 16, lv1 = KTB + (c1 >> 4) * VS + (c1 & 15) * 16;
    v4u st0, st1, st2, st3, st4;
#define MLA_GLOAD(kt) do { const size_t _o = (size_t)(kt) * 64; st0 = *(const v4u*)(gkn0 + _o * 1024); st1 = *(const v4u*)(gkn1 + _o * 1024); st2 = *(const v4u*)(gkp + _o * 64); \
        st3 = *(const v4u*)(gv0 + _o * 1024); st4 = *(const v4u*)(gv1 + _o * 1024); } while (0)
#define MLA_LWRITE(buf) do { LAS unsigned char* _b = lds + (buf) * BUFB; *(LAS v4u*)(_b + lkn0) = st0; *(LAS v4u*)(_b + lkn1) = st1; *(LAS v4u*)(_b + lkp) = st2; \
        *(LAS v4u*)(_b + lv0) = st3; *(LAS v4u*)(_b + lv1) = st4; } while (0)
    const int nkt = 4 * (qblk + 1);
    MLA_GLOAD(0); MLA_LWRITE(0);
    __syncthreads();
    f32x16 o[4];
#pragma unroll
    for (int d = 0; d < 4; ++d)
#pragma unroll
        for (int r = 0; r < 16; ++r) o[d][r] = 0.f;
    float m = NEG, l = 0.f;
    const int kread = r32 * KS + 16 * hh;
    const int vread = KTB + (4 * hh + ((lane & 15) >> 2)) * VS + (16 * ((lane >> 4) & 1) + 4 * (lane & 3)) * 2;
    for (int kt = 0; kt < nkt; ++kt) {
        if (kt + 1 < nkt) MLA_GLOAD(kt + 1);
        const int k0 = kt * 64;
        if (k0 <= row_lo + 31) {
            const LAS unsigned char* kb = lds + (kt & 1) * BUFB;
            const bool diag = (k0 + 63 > row_lo);
#pragma unroll
            for (int sub = 0; sub < 2; ++sub) {
                if (sub == 1 && k0 + 32 > row_lo + 31) break;
                f32x16 s[1];
#pragma unroll
                for (int r = 0; r < 16; ++r) s[0][r] = 0.f;
#pragma unroll
                for (int ks = 0; ks < 12; ++ks) { const bf16x8 kf = *(const LAS bf16x8*)(kb + kread + sub * 32 * KS + 32 * ks); s[0] = MFMA32(kf, qf[ks], s[0]); }
                if (diag) {
#pragma unroll
                    for (int r = 0; r < 16; ++r) { const int key = k0 + 32 * sub + crow(r, hh); if (key > qrow) s[0][r] = NEG; }
                }
                bf16x8 pb[2];
                softmax_step<1>(s, m, l, o, pb);
                pv32(o, kb + vread + sub * 32 * VS, pb[0], pb[1]);
            }
        }
        if (kt + 1 < nkt) MLA_LWRITE((kt + 1) & 1);
        __syncthreads();
    }
#undef MLA_GLOAD
#undef MLA_LWRITE
    store_o(o, l, O + (tok0 + qrow) * 2048 + 1024 + h * 128, SSQO + (tok0 + qrow) * 16 + 8 + h, hh);
}

__device__ __forceinline__ void dil_tile(const unsigned char* ws, LAS unsigned char* vl  , int b, int h, int j, int r16, int lane) {
    const bf16* QKV = (const bf16*)(ws + WS_B); bf16* O = (bf16*)(ws + WS_A); float* SSQO = (float*)(ws + WS_SSQO);
    const int r32 = lane & 31, hh = lane >> 5;
    const size_t tok0 = (size_t)b * SEQ;
    const int tq = 512 * j + 16 * r32 + r16;
    bf16x8 qf[8];
    { const bf16* qp = QKV + (tok0 + tq) * 3072 + h * 128 + 8 * hh;
#pragma unroll
      for (int s = 0; s < 8; ++s) qf[s] = *(const bf16x8*)(qp + 16 * s); }
    const float slope2 = __builtin_amdgcn_exp2f(-(float)(h + 1)) * LOG2E;
    const int m0 = (j == 0) ? 4 : 0, n3 = j + 1, n2 = 8 - m0, n1 = 20 - m0, nt = n3 + n2 + n1;
    const bf16* kcol = QKV + tok0 * 3072 + 1024 + h * 128 + 8 * hh;
    const bf16* vcol = QKV + tok0 * 3072 + 2048 + h * 128 + (lane & 15) * 8;
    const int vrow = lane >> 4;
    const int vwr = vrow * VS + (lane & 15) * 16;
    const int vread = (4 * hh + ((lane & 15) >> 2)) * VS + (16 * ((lane >> 4) & 1) + 4 * (lane & 3)) * 2;
    int kbase, kstride, maxd;
#define DIL_DESC(idx) do { const int _i = (idx); if (_i < n3) { kbase = 512 * (j - _i) + r16; kstride = 16; maxd = 2048; } \
        else if (_i < n3 + n2) { kbase = 4 * (128 * j - 128 + 32 * (m0 + _i - n3)) + (r16 & 3); kstride = 4; maxd = 512; } \
        else { kbase = 512 * j - 128 + 32 * (m0 + _i - n3 - n2); kstride = 1; maxd = 128; } } while (0)
    bf16x8 kc[8]; v4u vn[8];
    DIL_DESC(0);
    { const bf16* kp = kcol + (size_t)(kbase + kstride * r32) * 3072;
#pragma unroll
      for (int s = 0; s < 8; ++s) kc[s] = *(const bf16x8*)(kp + 16 * s);
#pragma unroll
      for (int i = 0; i < 8; ++i) vn[i] = *(const v4u*)(vcol + (size_t)(kbase + kstride * (4 * i + vrow)) * 3072);
#pragma unroll
      for (int i = 0; i < 8; ++i) *(LAS v4u*)(vl + vwr + 4 * i * VS) = vn[i]; }
    f32x16 o[4];
#pragma unroll
    for (int d = 0; d < 4; ++d)
#pragma unroll
        for (int r = 0; r < 16; ++r) o[d][r] = 0.f;
    float m = NEG, l = 0.f;
    for (int idx = 0; idx < nt; ++idx) {
        const int cb = kbase, cs = kstride, cm = maxd;
        const bool more = idx + 1 < nt;
        if (more) {
            DIL_DESC(idx + 1);
#pragma unroll
            for (int i = 0; i < 8; ++i) vn[i] = *(const v4u*)(vcol + (size_t)(kbase + kstride * (4 * i + vrow)) * 3072);
        }
        f32x16 s[1];
#pragma unroll
        for (int r = 0; r < 16; ++r) s[0][r] = 0.f;
#pragma unroll
        for (int ks = 0; ks < 8; ++ks) s[0] = MFMA32(kc[ks], qf[ks], s[0]);
        if (more) {
            const bf16* kp = kcol + (size_t)(kbase + kstride * r32) * 3072;
#pragma unroll
            for (int s2 = 0; s2 < 8; ++s2) kc[s2] = *(const bf16x8*)(kp + 16 * s2);
        }
        const int d0 = tq - cb - cs * 4 * hh;
#pragma unroll
        for (int r = 0; r < 16; ++r) { const int dist = d0 - cs * ((r & 3) + 8 * (r >> 2)); const float v = s[0][r] - slope2 * (float)dist; s[0][r] = ((unsigned)dist <= (unsigned)cm) ? v : NEG; }
        bf16x8 pb[2];
        softmax_step<1>(s, m, l, o, pb);
        pv32(o, vl + vread, pb[0], pb[1]);
        if (more) {
#pragma unroll
            for (int i = 0; i < 8; ++i) *(LAS v4u*)(vl + vwr + 4 * i * VS) = vn[i];
        }
    }
#undef DIL_DESC
    store_o(o, l, O + (tok0 + tq) * 2048 + h * 128, SSQO + (tok0 + tq) * 16 + h, hh);
}

__device__ __forceinline__ void phase_attn(const Params& P, LAS unsigned char* lds, int vcu, int G) {
    int tid_ = threadIdx.x; asm volatile("" : "+v"(tid_));
    const int tid = tid_, lane = tid & 63, wave = __builtin_amdgcn_readfirstlane(tid >> 6);
    const unsigned char* ws = P.ws;
    for (int u = vcu; u < 256; u += G) { const int bh = u >> 2, pr = u & 3;
        mla_unit(ws, lds, bh >> 3, bh & 7, 7 - pr, tid, wave, lane);
        mla_unit(ws, lds, bh >> 3, bh & 7, pr, tid, wave, lane); }
    __syncthreads();
    LAS unsigned char* vl = lds + wave * (32 * VS);
    if (G == 256) {
#pragma unroll 1
        for (int k = 0; k < 2; ++k) { const int t = (vcu >> 5) * 512 + k * 256 + (vcu & 31) * 8 + wave; const int bh = t >> 6, rem = t & 63, jj = rem >> 4, r16 = rem & 15;
            dil_tile(ws, vl, bh >> 3, bh & 7, k == 0 ? jj : 3 - jj, r16, lane); }
    } else {
#pragma unroll 1
        for (int t = vcu * 8 + wave; t < 4096; t += G * 8) { const int bh = t >> 6, rem = t & 63; dil_tile(ws, vl, bh >> 3, bh & 7, rem >> 4, rem & 15, lane); }
    }
}
}
namespace peer {
typedef __bf16 bf2_t __attribute__((ext_vector_type(2)));
#define MFMA32(a, b, c) __builtin_amdgcn_mfma_f32_32x32x16_bf16((a), (b), (c), 0, 0, 0)
__device__ __forceinline__ float fmax3(float a, float b, float c) { return fmaxf(fmaxf(a, b), c); }
__device__ __forceinline__ float asf(unsigned u) { return __builtin_bit_cast(float, u); }
__device__ __forceinline__ unsigned asu(float f) { return __builtin_bit_cast(unsigned, f); }

__device__ __forceinline__ void route_item(const unsigned char* ws, LAS unsigned* sc, int tile, int h, int lane) {
    const bf16* QP = (const bf16*)(ws + WS_QP); const bf16* SK = (const bf16*)(ws + WS_SK);
    int* RIDX = (int*)(ws + WS_RIDX); float* RGATE = (float*)(ws + WS_RGATE);
    const int r32 = lane & 31, hh = lane >> 5;
    const size_t tok = (size_t)tile * 32 + r32;
#pragma unroll 1
    for (int p = 0; p < 2; ++p) {
        f32x16 s[4];
#pragma unroll
        for (int kb = 0; kb < 4; ++kb)
#pragma unroll
            for (int r = 0; r < 16; ++r) s[kb][r] = 0.f;
        const bf16* qp = QP + tok * 2048 + h * 256 + p * 128 + 8 * hh;
        const bf16* kp = SK + ((size_t)(h * 2 + p) * 128 + r32) * 128 + 8 * hh;
#pragma unroll
        for (int ks = 0; ks < 8; ++ks) { const bf16x8 q = *(const bf16x8*)(qp + 16 * ks);
#pragma unroll
            for (int kb = 0; kb < 4; ++kb) { const bf16x8 k = *(const bf16x8*)(kp + (size_t)kb * 32 * 128 + 16 * ks); s[kb] = MFMA32(k, q, s[kb]); } }
#pragma unroll
        for (int kb = 0; kb < 4; ++kb)
#pragma unroll
            for (int r = 0; r < 16; ++r) s[kb][r] = asf((asu(s[kb][r]) & ~127u) | (unsigned)(32 * kb + (r & 3) + 8 * (r >> 2) + 4 * hh));
#pragma unroll 1
        for (int k = 0; k < 16; ++k) {
            float mx = s[0][0];
#pragma unroll
            for (int kb = 0; kb < 4; ++kb)
#pragma unroll
                for (int r = 0; r < 16; r += 2) mx = fmax3(mx, s[kb][r], s[kb][r + 1]);
            mx = fmaxf(mx, __shfl_xor(mx, 32));
            if (hh == 0) sc[(p * 32 + r32) * 16 + k] = asu(mx);
#pragma unroll
            for (int kb = 0; kb < 4; ++kb)
#pragma unroll
                for (int r = 0; r < 16; ++r) s[kb][r] = (s[kb][r] == mx) ? -3.0e38f : s[kb][r];
        }
    }
    unsigned t1[16], t2[16];
#pragma unroll
    for (int i = 0; i < 16; i += 4) { const v4u a = *(const LAS v4u*)(sc + r32 * 16 + i), b = *(const LAS v4u*)(sc + (32 + r32) * 16 + i);
        t1[i] = a.x; t1[i + 1] = a.y; t1[i + 2] = a.z; t1[i + 3] = a.w; t2[i] = b.x; t2[i + 1] = b.y; t2[i + 2] = b.z; t2[i + 3] = b.w; }
    float c[50]; int n = 0;
#pragma unroll
    for (int i = 0; i < 16; ++i)
#pragma unroll
        for (int j = 0; j < 16; ++j) if ((i + 1) * (j + 1) <= 16) { const float v = asf(t1[i] & ~127u) + asf(t2[j] & ~127u); c[n] = asf((asu(v) & ~255u) | (unsigned)(i * 16 + j)); ++n; }
    float best[8]; float bmax = 0.f, esum = 0.f;
#pragma unroll
    for (int k = 0; k < 16; ++k) {
        float mx = c[0];
#pragma unroll
        for (int q = 1; q < 49; q += 2) mx = fmax3(mx, c[q], c[q + 1]);
        mx = fmaxf(mx, c[49]);
#pragma unroll
        for (int q = 0; q < 50; ++q) c[q] = (c[q] == mx) ? -3.0e38f : c[q];
        const float val = asf(asu(mx) & ~255u);
        if (k == 0) bmax = val;
        esum += __expf(val - bmax);
        if ((k >> 3) == hh) best[k & 7] = mx;
    }
    const float inv = 1.0f / esum;
    int idx[8]; float gate[8];
#pragma unroll
    for (int k = 0; k < 8; ++k) { const unsigned code = asu(best[k]) & 255u; const unsigned a = sc[r32 * 16 + (code >> 4)], b = sc[(32 + r32) * 16 + (code & 15)];
        idx[k] = (int)((a & 127u) * 128u + (b & 127u)); gate[k] = __expf(asf(asu(best[k]) & ~255u) - bmax) * inv; }
    int* ip = RIDX + tok * 128 + h * 16 + 8 * hh; float* gp = RGATE + tok * 128 + h * 16 + 8 * hh;
    *(v4u*)ip = (v4u){(unsigned)idx[0], (unsigned)idx[1], (unsigned)idx[2], (unsigned)idx[3]}; *(v4u*)(ip + 4) = (v4u){(unsigned)idx[4], (unsigned)idx[5], (unsigned)idx[6], (unsigned)idx[7]};
    *(f32x4*)gp = (f32x4){gate[0], gate[1], gate[2], gate[3]}; *(f32x4*)(gp + 4) = (f32x4){gate[4], gate[5], gate[6], gate[7]};
}

__device__ __forceinline__ void phase_route(const Params& P, LAS unsigned char* lds, int vcu, int G) {
    int tid_ = threadIdx.x; asm volatile("" : "+v"(tid_));
    const int lane = tid_ & 63, wave = __builtin_amdgcn_readfirstlane(tid_ >> 6);
    LAS unsigned* sc = (LAS unsigned*)(lds + wave * 4096);
#pragma unroll 1
    for (int it = vcu * NWAVES + wave; it < 512 * 8; it += G * NWAVES) route_item(P.ws, sc, it >> 3, it & 7, lane);
}

__device__ __forceinline__ float dot16_f8(const float (&x)[16], const v4u& u, float c) {
    const int u0 = (int)u.x, u1 = (int)u.y, u2 = (int)u.z, u3 = (int)u.w;
    const f32x2 a0 = __builtin_amdgcn_cvt_pk_f32_fp8(u0, false), a1 = __builtin_amdgcn_cvt_pk_f32_fp8(u0, true);
    const f32x2 a2 = __builtin_amdgcn_cvt_pk_f32_fp8(u1, false), a3 = __builtin_amdgcn_cvt_pk_f32_fp8(u1, true);
    const f32x2 a4 = __builtin_amdgcn_cvt_pk_f32_fp8(u2, false), a5 = __builtin_amdgcn_cvt_pk_f32_fp8(u2, true);
    const f32x2 a6 = __builtin_amdgcn_cvt_pk_f32_fp8(u3, false), a7 = __builtin_amdgcn_cvt_pk_f32_fp8(u3, true);
    c = fmaf(x[0], a0.x, c); c = fmaf(x[1], a0.y, c); c = fmaf(x[2], a1.x, c); c = fmaf(x[3], a1.y, c);
    c = fmaf(x[4], a2.x, c); c = fmaf(x[5], a2.y, c); c = fmaf(x[6], a3.x, c); c = fmaf(x[7], a3.y, c);
    c = fmaf(x[8], a4.x, c); c = fmaf(x[9], a4.y, c); c = fmaf(x[10], a5.x, c); c = fmaf(x[11], a5.y, c);
    c = fmaf(x[12], a6.x, c); c = fmaf(x[13], a6.y, c); c = fmaf(x[14], a7.x, c); c = fmaf(x[15], a7.y, c);
    return c;
}
__device__ __forceinline__ void unpack8(float* x, const v4u& v) { x[0] = bflo(v.x); x[1] = bfhi(v.x); x[2] = bflo(v.y); x[3] = bfhi(v.y); x[4] = bflo(v.z); x[5] = bfhi(v.z); x[6] = bflo(v.w); x[7] = bfhi(v.w); }
__device__ __forceinline__ void peer_u_token(const Params& P, size_t tok, int lane) {
    const unsigned char* ws = P.ws;
    const bf16* H1B = (const bf16*)(ws + WS_B); const unsigned char* U8 = ws + WS_UB;
    const int* RIDX = (const int*)(ws + WS_RIDX); const float* RGATE = (const float*)(ws + WS_RGATE); const float* SSQH = (const float*)(ws + WS_SSQH);
    unsigned* PKV = (unsigned*)(ws + WS_PKV);
    float x0[16], x1[16];
    { const bf16* hp = H1B + tok * 2048 + 16 * lane; const v4u a = *(const v4u*)hp, b = *(const v4u*)(hp + 8), c = *(const v4u*)(hp + 1024), d = *(const v4u*)(hp + 1032);
      unpack8(x0, a); unpack8(x0 + 8, b); unpack8(x1, c); unpack8(x1 + 8, d); }
    const float rs2 = rsqrtf(wave_sum(lane < 32 ? SSQH[tok * 32 + lane] : 0.f) * (1.f / 2048.f) + EPS) * (1.f / 32.f);
    const int i0 = RIDX[tok * 128 + lane], i1 = RIDX[tok * 128 + 64 + lane];
    const float g0 = RGATE[tok * 128 + lane], g1 = RGATE[tok * 128 + 64 + lane];
    float d0 = 0.f, d1 = 0.f;
    v4u ra[16], rb[16];
#define PU_LOAD(buf, g) do { _Pragma("unroll") for (int e = 0; e < 8; ++e) { const int row = __builtin_amdgcn_readlane((g) < 8 ? i0 : i1, ((g) & 7) * 8 + e); \
        const unsigned char* up = U8 + (size_t)row * 2048 + 16 * lane; buf[2 * e] = *(const v4u*)up; buf[2 * e + 1] = *(const v4u*)(up + 1024); } } while (0)
#define PU_COMPUTE(buf, g) do { float pt[8]; _Pragma("unroll") for (int e = 0; e < 8; ++e) pt[e] = dot16_f8(x1, buf[2 * e + 1], dot16_f8(x0, buf[2 * e], 0.f)); \
        float a4[4], a2[2], a1; \
        _Pragma("unroll") for (int i = 0; i < 4; ++i) { const float keep = (lane & 1) ? pt[2 * i + 1] : pt[2 * i], give = (lane & 1) ? pt[2 * i] : pt[2 * i + 1]; a4[i] = keep + __shfl_xor(give, 1); } \
        _Pragma("unroll") for (int i = 0; i < 2; ++i) { const float keep = (lane & 2) ? a4[2 * i + 1] : a4[2 * i], give = (lane & 2) ? a4[2 * i] : a4[2 * i + 1]; a2[i] = keep + __shfl_xor(give, 2); } \
        { const float keep = (lane & 4) ? a2[1] : a2[0], give = (lane & 4) ? a2[0] : a2[1]; a1 = keep + __shfl_xor(give, 4); } \
        a1 += __shfl_xor(a1, 8); a1 += __shfl_xor(a1, 16); a1 += __shfl_xor(a1, 32); \
        if ((lane >> 3) == ((g) & 7)) { if ((g) < 8) d0 = a1; else d1 = a1; } } while (0)
    PU_LOAD(ra, 0);
#pragma unroll 1
    for (int g = 0; g < 16; g += 2) {
        PU_LOAD(rb, g + 1);
        PU_COMPUTE(ra, g);
        if (g + 2 < 16) PU_LOAD(ra, g + 2);
        PU_COMPUTE(rb, g + 1);
    }
#undef PU_LOAD
#undef PU_COMPUTE
    const float z0 = d0 * rs2, z1 = d1 * rs2;
    const float a0 = 0.25f * z0 * (1.0f + erff(z0 * 0.7071067811865476f)) * g0, a1v = 0.25f * z1 * (1.0f + erff(z1 * 0.7071067811865476f)) * g1;
    unsigned* pk = PKV + ((tok >> 6) * 128) * 64 + (tok & 63);
    pk[(size_t)lane * 64] = (unsigned)i0 | (f2bf(a0) << 16);
    pk[(size_t)(64 + lane) * 64] = (unsigned)i1 | (f2bf(a1v) << 16);
}
__device__ __forceinline__ void phase_peer_u(const Params& P, int vcu, int G) {
    int tid_ = threadIdx.x; asm volatile("" : "+v"(tid_));
    const int lane = tid_ & 63, wave = __builtin_amdgcn_readfirstlane(tid_ >> 6);
#pragma unroll 1
    for (int t = vcu * NWAVES + wave; t < M; t += G * NWAVES) peer_u_token(P, (size_t)t, lane);
}
__device__ __forceinline__ void phase_peer_v(const Params& P, LAS unsigned char* lds, int vcu, int G) {
    int tid_ = threadIdx.x; asm volatile("" : "+v"(tid_));
    const int tid = tid_, lane = tid & 63, wave = __builtin_amdgcn_readfirstlane(tid >> 6);
    const unsigned char* ws = P.ws;
    const bf16* H1B = (const bf16*)(ws + WS_B); const unsigned* PKV = (const unsigned*)(ws + WS_PKV);
#pragma unroll 1
    for (int c = vcu; c < 256; c += G) {
        __syncthreads();
        { const v4u* src = (const v4u*)(ws + WS_VB + (size_t)c * 131072);
#pragma unroll 4
          for (int i = tid; i < 8192; i += NTHREADS) *(LAS v4u*)(lds + 16 * i) = src[i]; }
        __syncthreads();
#pragma unroll 1
        for (int b = wave; b < 256; b += NWAVES) {
            const size_t tok = (size_t)b * 64 + lane;
            float y[8]; { const v4u hx = *(const v4u*)(H1B + tok * 2048 + 8 * c); unpack8(y, hx); }
            const unsigned* pk = PKV + (size_t)b * 128 * 64 + lane;
#pragma unroll 1
            for (int e0 = 0; e0 < 128; e0 += 16) {
                unsigned w[16]; v2u vv[16];
#pragma unroll
                for (int i = 0; i < 16; ++i) w[i] = pk[(e0 + i) * 64];
#pragma unroll
                for (int i = 0; i < 16; ++i) vv[i] = *(const LAS v2u*)(lds + (w[i] & 0x3fffu) * 8);
#pragma unroll
                for (int i = 0; i < 16; ++i) { const float a = asf(w[i] & 0xffff0000u);
                    const f32x2 p0 = __builtin_amdgcn_cvt_pk_f32_fp8((int)vv[i].x, false), p1 = __builtin_amdgcn_cvt_pk_f32_fp8((int)vv[i].x, true);
                    const f32x2 p2 = __builtin_amdgcn_cvt_pk_f32_fp8((int)vv[i].y, false), p3 = __builtin_amdgcn_cvt_pk_f32_fp8((int)vv[i].y, true);
                    y[0] = fmaf(a, p0.x, y[0]); y[1] = fmaf(a, p0.y, y[1]); y[2] = fmaf(a, p1.x, y[2]); y[3] = fmaf(a, p1.y, y[3]);
                    y[4] = fmaf(a, p2.x, y[4]); y[5] = fmaf(a, p2.y, y[5]); y[6] = fmaf(a, p3.x, y[6]); y[7] = fmaf(a, p3.y, y[7]); }
            }
            float* op = P.out + tok * 2048 + 8 * c;
            *(f32x4*)op = (f32x4){y[0], y[1], y[2], y[3]}; *(f32x4*)(op + 4) = (f32x4){y[4], y[5], y[6], y[7]};
        }
    }
}
__device__ __forceinline__ void phase_final(const Params& P, int vcu, int G) {
    int tid_ = threadIdx.x; asm volatile("" : "+v"(tid_));
    const int lane = tid_ & 63, wave = __builtin_amdgcn_readfirstlane(tid_ >> 6);
    f32x4 gv[8];
#pragma unroll
    for (int j = 0; j < 8; ++j) gv[j] = ((const f32x4*)P.lnf)[lane + 64 * j];
#pragma unroll 1
    for (int t = vcu * NWAVES + wave; t < M; t += G * NWAVES) {
        f32x4* row = (f32x4*)(P.out + (size_t)t * 2048) + lane;
        f32x4 v[8]; float s = 0.f;
#pragma unroll
        for (int j = 0; j < 8; ++j) { v[j] = row[64 * j]; s += (v[j].x * v[j].x + v[j].y * v[j].y) + (v[j].z * v[j].z + v[j].w * v[j].w); }
        const float rs = rsqrtf(wave_sum(s) * (1.f / 2048.f) + EPS);
#pragma unroll
        for (int j = 0; j < 8; ++j) row[64 * j] = v[j] * rs * gv[j];
    }
}
#undef MFMA32
}
#define XB_TMO      128
#define XB_XCNT(j)  (256  + 64 * (j))
#define XB_XSUB(j)  (1280 + 64 * (j))
#define XB_XGEN(j)  (2304 + 64 * (j))
#define XB_TOP      3328
#define XB_TOPGEN   3392
#define XCD_BAR_WORDS 3456
#define XB_SPIN_CAP (1u << 22)
__device__ __forceinline__ unsigned xb_ld(unsigned* p)              { return __hip_atomic_load(p, __ATOMIC_RELAXED, __HIP_MEMORY_SCOPE_AGENT); }
__device__ __forceinline__ unsigned xb_add(unsigned* p, unsigned v) { return __hip_atomic_fetch_add(p, v, __ATOMIC_RELAXED, __HIP_MEMORY_SCOPE_AGENT); }
__device__ __forceinline__ unsigned xb_xcc_id() { return (unsigned)__builtin_amdgcn_s_getreg((3 << 11) | 20) & 0xFu; }
#define XB_SPIN(cond, bar) do { unsigned _sp = 0; while (cond) { __builtin_amdgcn_s_sleep(1); \
    if ((++_sp & 255u) == 0u) { if (xb_ld(&(bar)[XB_TMO])) break; if (_sp > XB_SPIN_CAP) { atomicAdd(&(bar)[XB_TMO], 1u); break; } } } } while (0)
struct XcdBarrier { unsigned* bar; unsigned x; volatile LAS unsigned* st; };
__device__ __forceinline__ XcdBarrier xcd_barrier_post(unsigned* bar, volatile LAS unsigned* st) {
    XcdBarrier b; b.bar = bar; b.x = xb_xcc_id(); b.st = st;
    if (threadIdx.x == 0) (void)xb_add(&bar[XB_XCNT(b.x)], 1u);
    return b;
}
__device__ __forceinline__ void xcd_barrier_complete(unsigned* bar, unsigned x, unsigned& nloc, unsigned& nx) {
    const unsigned G = gridDim.x * gridDim.y * gridDim.z;
    unsigned sum, cnt, mine, sp = 0u;
    for (;;) {
        sum = 0u; cnt = 0u; mine = 0u;
#pragma unroll
        for (unsigned j = 0; j < 16; ++j) { const unsigned c = xb_ld(&bar[XB_XCNT(j)]); sum += c; cnt += (c > 0u) ? 1u : 0u; mine = (j == x) ? c : mine; }
        if (sum == G) break;
        __builtin_amdgcn_s_sleep(1);
        if ((++sp & 255u) == 0u) { if (xb_ld(&bar[XB_TMO])) break; if (sp > XB_SPIN_CAP) { atomicAdd(&bar[XB_TMO], 1u); break; } }
    }
    nloc = mine > 0u ? mine : 1u; nx = cnt > 0u ? cnt : 1u;
}
__device__ __forceinline__ void xcd_barrier(const XcdBarrier& b) {
    asm volatile("s_waitcnt vmcnt(0)" ::: "memory");
    __syncthreads();
    if (threadIdx.x == 0) {
        unsigned* bar = b.bar;
        __builtin_amdgcn_s_waitcnt(0);
        unsigned nloc = b.st[0], nx = b.st[1];
        if (nloc == 0u) { xcd_barrier_complete(bar, b.x, nloc, nx); b.st[0] = nloc; b.st[1] = nx; }
        const unsigned old = xb_add(&bar[XB_XSUB(b.x)], 1u);
        const unsigned gen = old / nloc;
        if (old + 1u == (gen + 1u) * nloc) {
            __builtin_amdgcn_fence(__ATOMIC_RELEASE, "agent");
            asm volatile("s_waitcnt vmcnt(0)" ::: "memory");
            const unsigned og = xb_add(&bar[XB_TOP], 1u);
            const unsigned tg = og / nx;
            if (og + 1u == (tg + 1u) * nx) xb_add(&bar[XB_TOPGEN], 1u);
            else XB_SPIN(xb_ld(&bar[XB_TOPGEN]) == tg, bar);
            __builtin_amdgcn_fence(__ATOMIC_ACQUIRE, "agent");
            xb_add(&bar[XB_XGEN(b.x)], 1u);
            asm volatile("s_waitcnt vmcnt(0)" ::: "memory");
        } else {
            XB_SPIN(xb_ld(&bar[XB_XGEN(b.x)]) == gen, bar);
            __builtin_amdgcn_fence(__ATOMIC_ACQUIRE, "agent");
            asm volatile("s_waitcnt vmcnt(0)" ::: "memory");
        }
    }
    __syncthreads();
}
constexpr int N_PHASES = 10;
#ifndef REP_PHASE
#define REP_PHASE -1
#endif
#ifndef REP_N
#define REP_N 1
#endif
#ifndef EXTRA_SYNCS
#define EXTRA_SYNCS 0
#endif
__global__ void __launch_bounds__(NTHREADS, 2) mega(Params P) {
    extern __shared__ __attribute__((aligned(16))) unsigned char lds_raw[];
    LAS unsigned char* lds = (LAS unsigned char*)lds_raw;
    cg::grid_group grid = cg::this_grid();
    const int tid = threadIdx.x, lane = tid & 63, wave = __builtin_amdgcn_readfirstlane(tid >> 6);
    const int G = gridDim.x, bx = blockIdx.x;
    const int vcu = (G % 8 == 0) ? (bx % 8) * (G / 8) + bx / 8 : bx;
    unsigned char* ws = P.ws;
    const int lo = P.ph_lo, hi = P.ph_hi;
#define IN(k) (lo <= (k) && (k) < hi)
#ifndef CG_SEAMS
#define CG_SEAMS 1
#endif
    volatile LAS unsigned* xbst = (volatile LAS unsigned*)(lds + MISC_OFF + 8192);
    if (tid == 0) { xbst[0] = 0u; xbst[1] = 0u; xbst[2] = 0u; xbst[3] = 0u; }
    __syncthreads();
    const XcdBarrier xbar = xcd_barrier_post((unsigned*)(ws + WS_CTL) + 4096, xbst);
#define GSYNC(k) do { if ((k) < CG_SEAMS) grid.sync(); else xcd_barrier(xbar); } while (0)
#define SEAM(k) do { if (IN(k) && IN((k) + 1)) GSYNC(k); } while (0)

    for (int rep_ = 0; rep_ < (REP_PHASE == 0 ? 1 + REP_N : 1); ++rep_) if (IN(0)) { if (rep_) GSYNC(9); phase_prep(P, lds, vcu, G); }
    SEAM(0);
    for (int es_ = 0; es_ < EXTRA_SYNCS; ++es_) GSYNC(9);
    for (int rep_ = 0; rep_ < (REP_PHASE == 1 ? 1 + REP_N : 1); ++rep_) if (IN(1)) { if (rep_) GSYNC(9);
        pg8::GemmSet g; g.A0 = g.A1 = (const bf16*)(ws + WS_A); g.Bt0 = g.Bt1 = (const bf16*)(ws + WS_BT1); g.K = 2048;
        pg8::StaticOrder S; S.init(M, 4096, 0, G, bx);
        pg8::Epi1 E{(bf16*)(ws + WS_B), (bf16*)(ws + WS_CQ), (bf16*)(ws + WS_CKV), (float*)(ws + WS_SSQCQ), (float*)(ws + WS_SSQCKV)};
        pg8::gemm_phase<pg8::Epi1, pg8::StaticOrder>(lds, g, S, E);
    }
    SEAM(1);
    for (int rep_ = 0; rep_ < (REP_PHASE == 2 ? 1 + REP_N : 1); ++rep_) if (IN(2)) { if (rep_) GSYNC(9);
        pg8::GemmSet g; g.A0 = (const bf16*)(ws + WS_CQ); g.A1 = (const bf16*)(ws + WS_CKV); g.Bt0 = (const bf16*)(ws + WS_BT2Q); g.Bt1 = (const bf16*)(ws + WS_BT2KV); g.K = 512;
        pg8::StaticOrder S; S.init(M, 1536, 2048, G, bx);
        pg8::Epi2 E{(bf16*)(ws + WS_QN), (bf16*)(ws + WS_QPE), (bf16*)(ws + WS_KN), (bf16*)(ws + WS_VM), (const float*)(ws + WS_SSQCQ), (const float*)(ws + WS_SSQCKV), (const f32x2*)(ws + WS_ROPE)};
        pg8::gemm_phase<pg8::Epi2, pg8::StaticOrder>(lds, g, S, E);
        for (int it = G - 1 - bx; it < 128; it += G) kr_item((const bf16*)(ws + WS_A), (const bf16*)(ws + WS_BTKR), (const f32x2*)(ws + WS_ROPE), (bf16*)(ws + WS_KPE), it, wave, lane);
    }
    SEAM(2);
    for (int rep_ = 0; rep_ < (REP_PHASE == 3 ? 1 + REP_N : 1); ++rep_) if (IN(3)) { if (rep_) GSYNC(9); att::phase_attn(P, lds, vcu, G); }
    SEAM(3);
    for (int rep_ = 0; rep_ < (REP_PHASE == 4 ? 1 + REP_N : 1); ++rep_) if (IN(4)) { if (rep_) GSYNC(9);
        pg8::GemmSet g; g.A0 = g.A1 = (const bf16*)(ws + WS_A); g.Bt0 = g.Bt1 = (const bf16*)(ws + WS_BT3); g.K = 2048;
        pg8::StaticOrder S; S.init(M, 2048, 0, G, bx);
        pg8::Epi3 E{(bf16*)(ws + WS_B), P.x, (const float*)(ws + WS_SSQO), (float*)(ws + WS_SSQH), (LAS f32x2*)(lds + MISC_OFF)};
        pg8::gemm_phase<pg8::Epi3, pg8::StaticOrder>(lds, g, S, E);
    }
    SEAM(4);
    for (int rep_ = 0; rep_ < (REP_PHASE == 5 ? 1 + REP_N : 1); ++rep_) if (IN(5)) { if (rep_) GSYNC(9);
        pg8::GemmSet g; g.A0 = g.A1 = (const bf16*)(ws + WS_B); g.Bt0 = g.Bt1 = (const bf16*)(ws + WS_BT4); g.K = 2048;
        pg8::StaticOrder S; S.init(M, 2048, 0, G, bx);
        pg8::Epi4 E{(bf16*)(ws + WS_QP), (const float*)(ws + WS_SSQH), (LAS f32x2*)(lds + MISC_OFF)};
        pg8::gemm_phase<pg8::Epi4, pg8::StaticOrder>(lds, g, S, E);
    }
    SEAM(5);
    for (int rep_ = 0; rep_ < (REP_PHASE == 6 ? 1 + REP_N : 1); ++rep_) if (IN(6)) { if (rep_) GSYNC(9); peer::phase_route(P, lds, vcu, G); }
    SEAM(6);
    for (int rep_ = 0; rep_ < (REP_PHASE == 7 ? 1 + REP_N : 1); ++rep_) if (IN(7)) { if (rep_) GSYNC(9); peer::phase_peer_u(P, vcu, G); }
    SEAM(7);
    for (int rep_ = 0; rep_ < (REP_PHASE == 8 ? 1 + REP_N : 1); ++rep_) if (IN(8)) { if (rep_) GSYNC(9); peer::phase_peer_v(P, lds, vcu, G); }
    SEAM(8);
    for (int rep_ = 0; rep_ < (REP_PHASE == 9 ? 1 + REP_N : 1); ++rep_) if (IN(9)) { if (rep_) GSYNC(9); peer::phase_final(P, vcu, G); }
#undef IN
#undef SEAM
}

static int mega_grid() {
    static int grid = 0;
    if (grid == 0) {
        int dev = 0, cus = 0, per_cu = 0;
        (void)hipGetDevice(&dev); (void)hipDeviceGetAttribute(&cus, hipDeviceAttributeMultiprocessorCount, dev);
        (void)hipFuncSetAttribute((const void*)mega, hipFuncAttributeMaxDynamicSharedMemorySize, LDS_BYTES);
        (void)hipOccupancyMaxActiveBlocksPerMultiprocessor(&per_cu, (const void*)mega, NTHREADS, LDS_BYTES);
        if (per_cu < 1) { fprintf(stderr, "mega: occupancy query says %d blocks/CU\n", per_cu); per_cu = 1; }
        grid = cus;
        (void)hipGetLastError();
    }
    return grid;
}
static void fill_params(Params& P, void* const* d_in, void* d_out, void* d_ws) {
    P.x = (const float*)d_in[0]; P.ln1 = (const float*)d_in[1]; P.w_in = (const float*)d_in[2]; P.qan = (const float*)d_in[3]; P.kvan = (const float*)d_in[4];
    P.w_uq = (const float*)d_in[5]; P.w_ukv = (const float*)d_in[6]; P.ond = (const float*)d_in[7]; P.onm = (const float*)d_in[8]; P.w_o = (const float*)d_in[9];
    P.ln2 = (const float*)d_in[10]; P.wq = (const float*)d_in[11]; P.sk = (const float*)d_in[12]; P.pu = (const float*)d_in[13]; P.pv = (const float*)d_in[14]; P.lnf = (const float*)d_in[15];
    P.out = (float*)d_out; P.ws = (unsigned char*)d_ws;
}
static void launch_phases(Params P, int lo, int hi, hipStream_t st) {
    P.ph_lo = lo; P.ph_hi = hi;
    (void)hipMemsetAsync(P.ws + WS_CTL, 0, CTL_ZERO_BYTES, st);
    void* args[] = {&P};
    hipError_t e = hipLaunchCooperativeKernel((const void*)mega, dim3(mega_grid()), dim3(NTHREADS), args, LDS_BYTES, st);
    if (e != hipSuccess) fprintf(stderr, "mega launch [%d,%d) failed: %s\n", lo, hi, hipGetErrorString(e));
}
extern "C" void kernel_launch(void* const* d_in, const int* in_sizes, int n_in, void* d_out, int out_size, void* d_ws, size_t ws_size, hipStream_t stream) {
    Params P{}; fill_params(P, d_in, d_out, d_ws);
    launch_phases(P, 0, N_PHASES, stream);
}
```

```cpp
#include <hip/hip_runtime.h>
#include <hip/hip_cooperative_groups.h>
#include <cstdio>
#include <cstdint>
namespace cg = cooperative_groups;
#define GAS __attribute__((address_space(1)))
#define LAS __attribute__((address_space(3)))
typedef unsigned short bf16;
typedef unsigned v4u __attribute__((ext_vector_type(4)));
typedef unsigned v2u __attribute__((ext_vector_type(2)));
typedef float f32x2 __attribute__((ext_vector_type(2)));
typedef float f32x4 __attribute__((ext_vector_type(4)));
typedef float f32x16 __attribute__((ext_vector_type(16)));
typedef short bf16x8 __attribute__((ext_vector_type(8)));
typedef short s16x4 __attribute__((ext_vector_type(4)));
typedef __bf16 bf16x2_t __attribute__((ext_vector_type(2)));

constexpr int M = 16384, SEQ = 2048, DM = 2048, NWAVES = 8, NTHREADS = 512;
constexpr float EPS = 1e-6f, LOG2E = 1.4426950408889634f;
constexpr float QSCALE_DIL = 0.08838834764831845f * LOG2E;
constexpr float QSCALE_MLA = 0.07216878364870323f * LOG2E;

constexpr size_t MiB = 1u << 20;
constexpr size_t WS_CTL = 0, CTL_ZERO_BYTES = 64 * 1024;
constexpr size_t WS_ROPE = 1 * MiB;
constexpr size_t WS_SK = 2 * MiB;
constexpr size_t WS_BTKR = 3 * MiB;
constexpr size_t WS_BT2Q = 4 * MiB;
constexpr size_t WS_BT2KV = 6 * MiB;
constexpr size_t WS_BT1 = 8 * MiB;
constexpr size_t WS_BT3 = 24 * MiB;
constexpr size_t WS_BT4 = 32 * MiB;
constexpr size_t WS_SSQCQ = 40 * MiB;
constexpr size_t WS_SSQCKV = 40 * MiB + 512 * 1024;
constexpr size_t WS_SSQO = 41 * MiB;
constexpr size_t WS_SSQH = 42 * MiB;
constexpr size_t WS_KPE = 44 * MiB;
constexpr size_t WS_UB = 48 * MiB;
constexpr size_t WS_VB = 112 * MiB;
constexpr size_t WS_A = 176 * MiB;
constexpr size_t WS_B = 240 * MiB;
constexpr size_t WS_C = 336 * MiB;
constexpr size_t WS_QN = WS_C, WS_QPE = WS_C + 32 * MiB, WS_KN = WS_C + 48 * MiB, WS_VM = WS_C + 80 * MiB;
constexpr size_t WS_QP = WS_C, WS_RIDX = WS_C + 64 * MiB, WS_RGATE = WS_C + 72 * MiB, WS_PKV = WS_C + 80 * MiB,
                 WS_SIDX = WS_C + 88 * MiB, WS_SGATE = WS_C + 96 * MiB, WS_GOFF = WS_C + 104 * MiB;
constexpr size_t WS_D = 448 * MiB;
constexpr size_t WS_CQ = WS_D, WS_CKV = WS_D + 16 * MiB;
constexpr size_t WS_END = 480 * MiB;

constexpr int RING_BYTES = 131072;
constexpr int MISC_OFF = RING_BYTES;
constexpr int LDS_BYTES = 147456;

#define LDS_WAIT() asm volatile("s_waitcnt lgkmcnt(0)" ::: "memory")
#define VM_WAIT() asm volatile("s_waitcnt vmcnt(0)" ::: "memory")

__device__ __forceinline__ unsigned f2bf(float f) { unsigned u = __builtin_bit_cast(unsigned, f); return (u + 0x7fffu + ((u >> 16) & 1u)) >> 16; }
__device__ __forceinline__ unsigned pk2(float lo, float hi) { f32x2 v = {lo, hi}; bf16x2_t b = __builtin_convertvector(v, bf16x2_t); return __builtin_bit_cast(unsigned, b); }
__device__ __forceinline__ float bflo(unsigned u) { return __builtin_bit_cast(float, u << 16); }
__device__ __forceinline__ float bfhi(unsigned u) { return __builtin_bit_cast(float, u & 0xffff0000u); }
__device__ __forceinline__ float bf2f(bf16 b) { return __builtin_bit_cast(float, (unsigned)b << 16); }
__device__ __forceinline__ float wave_sum(float v) {
#pragma unroll
    for (int o = 1; o < 64; o <<= 1) v += __shfl_xor(v, o);
    return v;
}

struct Params {
    const float *x, *ln1, *w_in, *qan, *kvan, *w_uq, *w_ukv, *ond, *onm, *w_o, *ln2, *wq, *sk, *pu, *pv, *lnf;
    float* out; unsigned char* ws;
    int ph_lo, ph_hi;
};
__device__ __forceinline__ int map_ident(int c) { return c; }
__device__ __forceinline__ int map_kr(int c) { const int p = c - 4096; return 2 * (p & 31) + (p >> 5); }
__device__ __forceinline__ int map_uq(int c) { const int h = c / 192, e = c % 192; if (e < 128) return h * 128 + e; const int p = e - 128; return 1024 + h * 64 + 2 * (p & 31) + (p >> 5); }
__device__ __forceinline__ int map_ukv(int c) { const int h = c >> 8, e = c & 255; return e < 128 ? h * 128 + e : 1024 + h * 128 + (e - 128); }

template <int MAP>
__device__ __forceinline__ void p0_transpose_item(const float* __restrict__ W, int K, int ldw, int c0, const float* __restrict__ g0, const float* __restrict__ g1, int gsplit,
                                                  bf16* __restrict__ WT, LAS float* scr, int item, int nblk, int lane) {
    const int kb = item / nblk, nb = item % nblk, k0 = 64 * kb, n0 = c0 + 32 * nb;
#pragma unroll 8
    for (int i = 0; i < 32; ++i) { const int kk = 2 * i + (lane >> 5); const int k = k0 + kk;
        float w = W[(size_t)k * ldw + n0 + (lane & 31)];
        if (g0) w *= (k < gsplit ? g0[k] : g1[k - gsplit]);
        scr[kk * 33 + (lane & 31)] = w; }
    LDS_WAIT(); asm volatile("" ::: "memory");
    const int c = lane & 7;
#pragma unroll
    for (int j = 0; j < 4; ++j) { const int n = (lane >> 3) + 8 * j; const LAS float* s = scr + (8 * c) * 33 + n;
        v4u o; o.x = pk2(s[0 * 33], s[1 * 33]); o.y = pk2(s[2 * 33], s[3 * 33]); o.z = pk2(s[4 * 33], s[5 * 33]); o.w = pk2(s[6 * 33], s[7 * 33]);
        const int src = n0 + n;
        const int dr = MAP == 0 ? map_ident(src) : MAP == 1 ? map_kr(src) : MAP == 2 ? map_uq(src) : map_ukv(src);
        *(v4u*)(WT + (size_t)dr * K + k0 + 8 * c) = o; }
    LDS_WAIT(); asm volatile("" ::: "memory");
}

__device__ __forceinline__ void phase_prep(const Params& P, LAS unsigned char* lds, int vcu, int G) {
    int tid_ = threadIdx.x; asm volatile("" : "+v"(tid_));
    const int tid = tid_, lane = tid & 63, wave = __builtin_amdgcn_readfirstlane(tid >> 6);
    unsigned char* ws = P.ws;
    LAS float* scr = (LAS float*)(lds + wave * 16384);
    const int gw = vcu * NWAVES + wave, NGW = G * NWAVES;
    const int gt = vcu * NTHREADS + tid, NGT = G * NTHREADS;
#pragma unroll 1
    for (int pi = 0; pi < 3; ++pi) {
        const int part = (pi + wave) % 3;
        if (part == 0) {
    constexpr int I1 = 32 * 128, IKR = 32 * 2, I2Q = 8 * 48, I2KV = 8 * 64, I3 = 32 * 64, I4 = 32 * 64;
    constexpr int NITEMS = I1 + IKR + I2Q + I2KV + I3 + I4;
    for (int it = gw; it < NITEMS; it += NGW) {
        int r = it;
        if (r < I1) { p0_transpose_item<0>(P.w_in, 2048, 4160, 0, nullptr, nullptr, 0, (bf16*)(ws + WS_BT1), scr, r, 128, lane); continue; } r -= I1;
        if (r < IKR) { p0_transpose_item<1>(P.w_in, 2048, 4160, 4096, nullptr, nullptr, 0, (bf16*)(ws + WS_BTKR), scr, r, 2, lane); continue; } r -= IKR;
        if (r < I2Q) { p0_transpose_item<2>(P.w_uq, 512, 1536, 0, P.qan, P.qan, 512, (bf16*)(ws + WS_BT2Q), scr, r, 48, lane); continue; } r -= I2Q;
        if (r < I2KV) { p0_transpose_item<3>(P.w_ukv, 512, 2048, 0, P.kvan, P.kvan, 512, (bf16*)(ws + WS_BT2KV), scr, r, 64, lane); continue; } r -= I2KV;
        if (r < I3) { p0_transpose_item<0>(P.w_o, 2048, 2048, 0, P.ond, P.onm, 1024, (bf16*)(ws + WS_BT3), scr, r, 64, lane); continue; } r -= I3;
        p0_transpose_item<0>(P.wq, 2048, 2048, 0, P.ln2, P.ln2, 2048, (bf16*)(ws + WS_BT4), scr, r, 64, lane);
    }
        } else if (part == 1) {
    {
        bf16* XN = (bf16*)(ws + WS_A);
        f32x4 gv[8];
#pragma unroll
        for (int j = 0; j < 8; ++j) gv[j] = ((const f32x4*)P.ln1)[lane + 64 * j];
        for (int m = gw; m < M; m += NGW) {
            const f32x4* xr = (const f32x4*)(P.x + (size_t)m * DM) + lane;
            f32x4 v[8]; float s = 0.f;
#pragma unroll
            for (int j = 0; j < 8; ++j) { v[j] = xr[64 * j]; s += (v[j].x * v[j].x + v[j].y * v[j].y) + (v[j].z * v[j].z + v[j].w * v[j].w); }
            const float rs = rsqrtf(wave_sum(s) * (1.f / DM) + EPS);
            v2u* o8 = (v2u*)(XN + (size_t)m * DM) + lane;
#pragma unroll
            for (int j = 0; j < 8; ++j) { v2u o; o.x = pk2(v[j].x * rs * gv[j].x, v[j].y * rs * gv[j].y); o.y = pk2(v[j].z * rs * gv[j].z, v[j].w * rs * gv[j].w); o8[64 * j] = o; }
        }
    }
        } else {
        v2u* ou = (v2u*)(ws + WS_UB);
#pragma unroll 4
        for (int i = gt; i < 16384 * 2048 / 8; i += NGT) {
            const f32x4 a = __builtin_nontemporal_load((const f32x4*)P.pu + 2 * i), b = __builtin_nontemporal_load((const f32x4*)P.pu + 2 * i + 1);
            const int k8 = (i & 255) * 2; const f32x4 g0 = ((const f32x4*)P.ln2)[k8] * 32.f, g1 = ((const f32x4*)P.ln2)[k8 + 1] * 32.f;
            int w0 = 0, w1 = 0;
            w0 = __builtin_amdgcn_cvt_pk_fp8_f32(a.x * g0.x, a.y * g0.y, w0, false); w0 = __builtin_amdgcn_cvt_pk_fp8_f32(a.z * g0.z, a.w * g0.w, w0, true);
            w1 = __builtin_amdgcn_cvt_pk_fp8_f32(b.x * g1.x, b.y * g1.y, w1, false); w1 = __builtin_amdgcn_cvt_pk_fp8_f32(b.z * g1.z, b.w * g1.w, w1, true);
            v2u w; w.x = (unsigned)w0; w.y = (unsigned)w1; ou[i] = w;
        }
        }
    }
    {
        f32x2* R = (f32x2*)(ws + WS_ROPE);
        for (int i = gt; i < 2048 * 32; i += NGT) { const int pos = i >> 5, j = i & 31; const float freq = powf(10000.0f, -(float)j / 32.0f), ang = (float)pos * freq;
            f32x2 cs; cs.x = cosf(ang); cs.y = sinf(ang); R[i] = cs; }
    }
    {
        v4u* o = (v4u*)(ws + WS_SK);
        for (int i = gt; i < 16 * 128 * 128 / 8; i += NGT) { const f32x4 a = ((const f32x4*)P.sk)[2 * i], b = ((const f32x4*)P.sk)[2 * i + 1];
            v4u w; w.x = pk2(a.x, a.y); w.y = pk2(a.z, a.w); w.z = pk2(b.x, b.y); w.w = pk2(b.z, b.w); o[i] = w; }
    }
    {
        __syncthreads();
        LAS v2u* tl = (LAS v2u*)lds;
        v2u* ov = (v2u*)(ws + WS_VB);
        for (int tile = vcu; tile < 1024; tile += G) {
            const int e0 = (tile >> 2) * 64, c0 = (tile & 3) * 64;
#pragma unroll
            for (int k = 0; k < 8; ++k) { const int it = tid + 512 * k, e = it >> 6, c = it & 63;
                const f32x4* src = (const f32x4*)(P.pv + (size_t)(e0 + e) * 2048 + (size_t)(c0 + c) * 8);
                const f32x4 a = __builtin_nontemporal_load(src), b = __builtin_nontemporal_load(src + 1);
                int w0 = 0, w1 = 0;
                w0 = __builtin_amdgcn_cvt_pk_fp8_f32(a.x * 2.f, a.y * 2.f, w0, false); w0 = __builtin_amdgcn_cvt_pk_fp8_f32(a.z * 2.f, a.w * 2.f, w0, true);
                w1 = __builtin_amdgcn_cvt_pk_fp8_f32(b.x * 2.f, b.y * 2.f, w1, false); w1 = __builtin_amdgcn_cvt_pk_fp8_f32(b.z * 2.f, b.w * 2.f, w1, true);
                v2u w; w.x = (unsigned)w0; w.y = (unsigned)w1; tl[c * 65 + e] = w; }
            __syncthreads();
#pragma unroll
            for (int k = 0; k < 8; ++k) { const int it = tid + 512 * k, c = it >> 6, e = it & 63; ov[(size_t)(c0 + c) * 16384 + e0 + e] = tl[c * 65 + e]; }
            __syncthreads();
        }
    }
}
namespace pg8 {
constexpr int BM = 256, BK = 64, HALF = 128, HTB = HALF * BK * 2, STAGE_BYTES = 8 * HTB, NXCD = 8, WGM = 8;
__host__ __device__ __forceinline__ int lds_byte(int r, int c) { const int st = (r >> 4) * 2 + (c >> 5), rr = r & 15, cc = c & 31, ob = rr * 64 + cc * 2; return st * 1024 + (ob ^ (((ob >> 9) & 1) << 5)); }
__host__ __device__ __forceinline__ void stage_rc(int b, int& R, int& C) { const int st = b / 1024, sb = b % 1024, swz = sb ^ (((sb >> 9) & 1) << 5); R = (st >> 1) * 16 + swz / 64; C = (st & 1) * 32 + (swz % 64) / 2; }
__host__ __device__ __forceinline__ int perm32(int rho) { const int n = rho >> 4, i = rho & 15; return 8 * (i >> 2) + 4 * n + (i & 3); }

struct Unit { int pm, pn, g; };
struct GemmSet { const bf16 *A0, *A1, *Bt0, *Bt1; int K; };

struct StaticOrder {
    int nM, nN0, nN, nwg, G, c;
    __device__ void init(int Mrows, int N0, int N1, int G_, int c_) { nM = Mrows / BM; nN0 = N0 / BM; nN = nN0 + N1 / BM; nwg = nM * nN; G = G_; c = c_; }
    __device__ bool next(int i, Unit& u) const {
        const long L = (long)i * G + c; if (L >= nwg) return false;
        int wgid = (int)L; { const int q = nwg / NXCD, r = nwg % NXCD, xcd = wgid % NXCD, off = wgid / NXCD; wgid = (xcd < r ? xcd * (q + 1) : r * (q + 1) + (xcd - r) * q) + off; }
        const int nig = WGM * nN, gid = wgid / nig, fm = gid * WGM, gsz = (nM - fm) < WGM ? (nM - fm) : WGM;
        u.pm = fm + ((wgid % nig) % gsz); int pn = (wgid % nig) / gsz; u.g = pn >= nN0 ? 1 : 0; u.pn = pn >= nN0 ? pn - nN0 : pn; return true;
    }
};

template <class Epi, class Sched>
__device__ __forceinline__ void gemm_phase(LAS unsigned char* lds, const GemmSet g, const Sched& S, const Epi& E) {
    int tid_ = threadIdx.x; asm volatile("" : "+v"(tid_));
    const int tid = tid_, wid = __builtin_amdgcn_readfirstlane(tid >> 6), lane = tid & 63, wr = wid >> 2, wc = wid & 3, fr = lane & 15, fq = lane >> 4;
    const int K = g.K, nt = K / BK;
    unsigned voffA[2], voffB[2];
#pragma unroll
    for (int i = 0; i < 2; ++i) { int R, C; stage_rc(tid * 16 + i * 8192, R, C); const int Rb = (R & ~31) + perm32(R & 31);
        voffA[i] = (unsigned)(R * K + C) * 2u; voffB[i] = (unsigned)(Rb * K + C) * 2u; }
    const size_t kstep = (size_t)(BK * 2);
    const size_t hstep = (size_t)HALF * K * 2;
    const size_t tstep = 2 * hstep;
    const unsigned ldsw = (unsigned)wid * 1024u;
    const int aoff = lds_byte(wr * 64 + fr, fq * 8), boff = lds_byte(wc * 32 + fr, fq * 8);
#define PG8_SA(b, h) (((b) * 2 + (h)) * HTB)
#define PG8_SB(b, h) ((4 + (b) * 2 + (h)) * HTB)
#define PG8_STAGE(bufoff, gbase, voff) do { _Pragma("unroll") for (int _i = 0; _i < 2; ++_i) \
        __builtin_amdgcn_global_load_lds((const unsigned*)((const char*)(gbase) + (voff)[_i]), (LAS unsigned*)(lds + (bufoff) + ldsw + _i * 8192), 16, 0, 0); } while (0)
#define PG8_LDA(dst, b, h) do { _Pragma("unroll") for (int m = 0; m < 4; ++m) _Pragma("unroll") for (int k = 0; k < 2; ++k) dst[m][k] = *(const LAS bf16x8*)(lds + PG8_SA(b, h) + aoff + m * 2048 + k * 1024); } while (0)
#define PG8_LDB(dst, b, h) do { _Pragma("unroll") for (int n = 0; n < 2; ++n) _Pragma("unroll") for (int k = 0; k < 2; ++k) dst[n][k] = *(const LAS bf16x8*)(lds + PG8_SB(b, h) + boff + n * 2048 + k * 1024); } while (0)
#define PG8_MMA(ai, bj, At, Bt) do { __builtin_amdgcn_s_setprio(1); _Pragma("unroll") for (int m = 0; m < 4; ++m) _Pragma("unroll") for (int n = 0; n < 2; ++n) _Pragma("unroll") for (int k = 0; k < 2; ++k) \
        acc[ai][bj][m][n] = __builtin_amdgcn_mfma_f32_16x16x32_bf16(Bt[n][k], At[m][k], acc[ai][bj][m][n], 0, 0, 0); __builtin_amdgcn_s_setprio(0); } while (0)
#define PG8_WAIT_V(n) asm volatile("s_waitcnt vmcnt(" #n ")" ::: "memory")
#define PG8_WAIT_L(n) asm volatile("s_waitcnt lgkmcnt(" #n ")" ::: "memory")
#define PG8_BAR __builtin_amdgcn_s_barrier()
#define PG8_SCHED __builtin_amdgcn_sched_barrier(0)
    Unit cur, nxt; int ui = 0;
    if (!S.next(0, cur)) return;
    f32x4 acc[2][2][4][2];
#pragma unroll
    for (int a = 0; a < 2; ++a)
#pragma unroll
        for (int b = 0; b < 2; ++b)
#pragma unroll
            for (int m = 0; m < 4; ++m)
#pragma unroll
                for (int n = 0; n < 2; ++n) acc[a][b][m][n] = (f32x4){0.f, 0.f, 0.f, 0.f};
    bf16x8 At[4][2], B0[2][2], B1[2][2];
    const char* cA = (const char*)(cur.g ? g.A1 : g.A0) + (size_t)cur.pm * tstep; const char* cB = (const char*)(cur.g ? g.Bt1 : g.Bt0) + (size_t)cur.pn * tstep;
    E.unit_begin(cur, 0, tid);
    PG8_STAGE(PG8_SB(0, 0), cB, voffB); PG8_STAGE(PG8_SB(0, 1), cB + hstep, voffB); PG8_STAGE(PG8_SA(0, 0), cA, voffA); PG8_STAGE(PG8_SA(0, 1), cA + hstep, voffA);
    if (wr == 1) PG8_BAR;
    PG8_WAIT_V(2); PG8_BAR;
    PG8_STAGE(PG8_SB(1, 0), cB + kstep, voffB); PG8_STAGE(PG8_SA(1, 0), cA + kstep, voffA); PG8_STAGE(PG8_SB(1, 1), cB + hstep + kstep, voffB);
    PG8_WAIT_V(6); PG8_BAR;
    for (;;) {
        const bool has_next = S.next(ui + 1, nxt);
        const char* nA = has_next ? (const char*)(nxt.g ? g.A1 : g.A0) + (size_t)nxt.pm * tstep : cA; const char* nB = has_next ? (const char*)(nxt.g ? g.Bt1 : g.Bt0) + (size_t)nxt.pn * tstep : cB;
        for (int t = 0; t < nt; t += 2) {
            const bool last = (t == nt - 2);
            const char* a1 = cA + (size_t)(t + 1) * kstep;
            const char* a2 = last ? nA : cA + (size_t)(t + 2) * kstep; const char* b2 = last ? nB : cB + (size_t)(t + 2) * kstep;
            const char* a3 = a2 + kstep; const char* b3 = b2 + kstep;
            if constexpr (Epi::MIDSCALE) { if (t == nt / 2) E.midscale(acc, ui & 1, wr, fr); }
            PG8_LDB(B0, 0, 0); PG8_LDB(B1, 0, 1); PG8_SCHED; PG8_LDA(At, 0, 0); PG8_STAGE(PG8_SA(1, 1), a1 + hstep, voffA);
            PG8_WAIT_V(8); PG8_WAIT_L(0); PG8_BAR; PG8_MMA(0, 0, At, B0); PG8_MMA(0, 1, At, B1); PG8_BAR; PG8_SCHED;
            PG8_LDA(At, 0, 1); PG8_STAGE(PG8_SB(0, 0), b2, voffB); PG8_STAGE(PG8_SB(0, 1), b2 + hstep, voffB); PG8_STAGE(PG8_SA(0, 0), a2, voffA);
            PG8_WAIT_V(8); PG8_WAIT_L(0); PG8_BAR; PG8_MMA(1, 0, At, B0); PG8_MMA(1, 1, At, B1); PG8_BAR; PG8_SCHED;
            PG8_LDB(B0, 1, 0); PG8_LDB(B1, 1, 1); PG8_SCHED; PG8_LDA(At, 1, 0); PG8_STAGE(PG8_SA(0, 1), a2 + hstep, voffA);
            PG8_WAIT_V(8); PG8_WAIT_L(0); PG8_BAR; PG8_MMA(0, 0, At, B0); PG8_MMA(0, 1, At, B1); PG8_BAR; PG8_SCHED;
            PG8_LDA(At, 1, 1); PG8_STAGE(PG8_SB(1, 0), b3, voffB); PG8_STAGE(PG8_SB(1, 1), b3 + hstep, voffB); PG8_STAGE(PG8_SA(1, 0), a3, voffA);
            PG8_WAIT_V(8); PG8_WAIT_L(0); PG8_BAR; PG8_MMA(1, 0, At, B0); PG8_MMA(1, 1, At, B1); PG8_BAR; PG8_SCHED;
        }
        if (wr == 0) PG8_BAR;
        E(acc, cur, ui & 1, wr, wc, fr, fq);
        if (!has_next) break;
#pragma unroll
        for (int a = 0; a < 2; ++a)
#pragma unroll
            for (int b = 0; b < 2; ++b)
#pragma unroll
                for (int m = 0; m < 4; ++m)
#pragma unroll
                    for (int n = 0; n < 2; ++n) acc[a][b][m][n] = (f32x4){0.f, 0.f, 0.f, 0.f};
        cur = nxt; cA = nA; cB = nB; ++ui;
        E.unit_begin(cur, ui & 1, tid);
        if (wr == 1) PG8_BAR;
    }
    PG8_WAIT_V(0);
    PG8_BAR;
#undef PG8_SA
#undef PG8_SB
#undef PG8_STAGE
#undef PG8_LDA
#undef PG8_LDB
#undef PG8_MMA
#undef PG8_WAIT_V
#undef PG8_WAIT_L
#undef PG8_BAR
#undef PG8_SCHED
}
}
namespace pg8 {
__device__ __forceinline__ v4u pack8(const f32x4& v0, const f32x4& v1) { v4u w; w.x = pk2(v0[0], v0[1]); w.y = pk2(v0[2], v0[3]); w.z = pk2(v1[0], v1[1]); w.w = pk2(v1[2], v1[3]); return w; }
__device__ __forceinline__ float sq8(const f32x4& v0, const f32x4& v1) { return (v0[0] * v0[0] + v0[1] * v0[1]) + (v0[2] * v0[2] + v0[3] * v0[3]) + (v1[0] * v1[0] + v1[1] * v1[1]) + (v1[2] * v1[2] + v1[3] * v1[3]); }

struct Epi1 {
    static constexpr bool MIDSCALE = false;
    bf16 *QKV, *CQ, *CKV; float *SSQCQ, *SSQCKV;
    __device__ __forceinline__ void midscale(f32x4 (&)[2][2][4][2], int, int, int) const {}
    __device__ __forceinline__ void unit_begin(const Unit&, int, int) const {}
    __device__ __forceinline__ void operator()(const f32x4 (&acc)[2][2][4][2], const Unit& u, int par, int wr, int wc, int fr, int fq) const {
        const int pn = u.pn; bf16* base; int ldc, colt; float sc = 1.f; float* ssq = nullptr; int sslot = 0;
        if (pn < 12) { base = QKV; ldc = 3072; colt = pn * 256; if (pn < 4) sc = QSCALE_DIL; }
        else if (pn < 14) { base = CQ; ldc = 512; colt = (pn - 12) * 256; ssq = SSQCQ; sslot = (pn - 12) * 4 + wc; }
        else { base = CKV; ldc = 512; colt = (pn - 14) * 256; ssq = SSQCKV; sslot = (pn - 14) * 4 + wc; }
        const int row0 = u.pm * BM + wr * 64 + fr, col0 = colt + wc * 32 + 8 * fq;
#pragma unroll
        for (int ai = 0; ai < 2; ++ai)
#pragma unroll
            for (int m = 0; m < 4; ++m) { const int row = row0 + ai * HALF + m * 16; bf16* rowp = base + (size_t)row * ldc + col0; float ss = 0.f;
#pragma unroll
                for (int bj = 0; bj < 2; ++bj) { const f32x4 v0 = acc[ai][bj][m][0] * sc, v1 = acc[ai][bj][m][1] * sc; ss += sq8(v0, v1); *(v4u*)(rowp + bj * HALF) = pack8(v0, v1); }
                if (ssq) { ss += __shfl_xor(ss, 16); ss += __shfl_xor(ss, 32); if (fq == 0) ssq[(size_t)row * 8 + sslot] = ss; } }
    }
};

struct Epi2 {
    static constexpr bool MIDSCALE = false;
    bf16 *QN, *QPE, *KN, *VM; const float *SSQCQ, *SSQCKV; const f32x2* ROPE;
    __device__ __forceinline__ void midscale(f32x4 (&)[2][2][4][2], int, int, int) const {}
    __device__ __forceinline__ void unit_begin(const Unit&, int, int) const {}
    __device__ __forceinline__ void operator()(const f32x4 (&acc)[2][2][4][2], const Unit& u, int par, int wr, int wc, int fr, int fq) const {
        const int pn = u.pn; bf16* base; int ldc, colt; float sc = 1.f; bool rope = false; const float* ssq;
        if (u.g == 0) { ssq = SSQCQ; sc = QSCALE_MLA; if (pn < 4) { base = QN; ldc = 1024; colt = pn * 256; } else { base = QPE; ldc = 512; colt = (pn - 4) * 256; rope = true; } }
        else { ssq = SSQCKV; if (pn < 4) { base = KN; ldc = 1024; colt = pn * 256; } else { base = VM; ldc = 1024; colt = (pn - 4) * 256; } }
        const int row0 = u.pm * BM + wr * 64 + fr, col0 = colt + wc * 32 + 8 * fq;
#pragma unroll
        for (int ai = 0; ai < 2; ++ai)
#pragma unroll
            for (int m = 0; m < 4; ++m) { const int row = row0 + ai * HALF + m * 16; bf16* rowp = base + (size_t)row * ldc + col0;
                const f32x4 p0 = *(const f32x4*)(ssq + (size_t)row * 8), p1 = *(const f32x4*)(ssq + (size_t)row * 8 + 4);
                const float rs = rsqrtf(((p0[0] + p0[1]) + (p0[2] + p0[3]) + (p1[0] + p1[1]) + (p1[2] + p1[3])) * (1.f / 512.f) + EPS) * sc;
#pragma unroll
                for (int bj = 0; bj < 2; ++bj) { f32x4 v0 = acc[ai][bj][m][0] * rs, v1 = acc[ai][bj][m][1] * rs;
                    if (rope) { const int j0 = ((col0 + bj * HALF) & 63) >> 1; const f32x4* rp = (const f32x4*)(ROPE + (size_t)(row & (SEQ - 1)) * 32 + j0);
                        const f32x4 r0 = rp[0], r1 = rp[1];
                        f32x4 w0, w1;
                        w0[0] = v0[0] * r0[0] - v0[1] * r0[1]; w0[1] = v0[0] * r0[1] + v0[1] * r0[0];
                        w0[2] = v0[2] * r0[2] - v0[3] * r0[3]; w0[3] = v0[2] * r0[3] + v0[3] * r0[2];
                        w1[0] = v1[0] * r1[0] - v1[1] * r1[1]; w1[1] = v1[0] * r1[1] + v1[1] * r1[0];
                        w1[2] = v1[2] * r1[2] - v1[3] * r1[3]; w1[3] = v1[2] * r1[3] + v1[3] * r1[2];
                        v0 = w0; v1 = w1; }
                    *(v4u*)(rowp + bj * HALF) = pack8(v0, v1); } }
    }
};

struct Epi3 {
    static constexpr bool MIDSCALE = true;
    bf16* H1B; const float* X; const float* SSQO; float* SSQH; LAS f32x2* RS;
    __device__ __forceinline__ void unit_begin(const Unit& u, int par, int tid) const {
        if (tid < 256) { const f32x4* p = (const f32x4*)(SSQO + (size_t)(u.pm * BM + tid) * 16); const f32x4 a0 = p[0], a1 = p[1], b0 = p[2], b1 = p[3];
            const float ra = rsqrtf(((a0[0] + a0[1]) + (a0[2] + a0[3]) + (a1[0] + a1[1]) + (a1[2] + a1[3])) * (1.f / 1024.f) + EPS);
            const float rb = rsqrtf(((b0[0] + b0[1]) + (b0[2] + b0[3]) + (b1[0] + b1[1]) + (b1[2] + b1[3])) * (1.f / 1024.f) + EPS);
            f32x2 v; v.x = ra / rb; v.y = rb; RS[par * 256 + tid] = v; }
    }
    __device__ __forceinline__ void midscale(f32x4 (&acc)[2][2][4][2], int par, int wr, int fr) const {
#pragma unroll
        for (int ai = 0; ai < 2; ++ai)
#pragma unroll
            for (int m = 0; m < 4; ++m) { const float f = RS[par * 256 + ai * HALF + wr * 64 + m * 16 + fr].x;
#pragma unroll
                for (int bj = 0; bj < 2; ++bj) { acc[ai][bj][m][0] = acc[ai][bj][m][0] * f; acc[ai][bj][m][1] = acc[ai][bj][m][1] * f; } }
    }
    __device__ __forceinline__ void operator()(const f32x4 (&acc)[2][2][4][2], const Unit& u, int par, int wr, int wc, int fr, int fq) const {
        const int row0 = u.pm * BM + wr * 64 + fr, col0 = u.pn * BM + wc * 32 + 8 * fq, sslot = u.pn * 4 + wc;
#pragma unroll
        for (int ai = 0; ai < 2; ++ai)
#pragma unroll
            for (int m = 0; m < 4; ++m) { const int row = row0 + ai * HALF + m * 16; const float rb = RS[par * 256 + ai * HALF + wr * 64 + m * 16 + fr].y; float ss = 0.f;
#pragma unroll
                for (int bj = 0; bj < 2; ++bj) { const float* xp = X + (size_t)row * DM + col0 + bj * HALF; const f32x4 x0 = *(const f32x4*)xp, x1 = *(const f32x4*)(xp + 4);
                    const f32x4 v0 = acc[ai][bj][m][0] * rb + x0, v1 = acc[ai][bj][m][1] * rb + x1; ss += sq8(v0, v1);
                    *(v4u*)(H1B + (size_t)row * DM + col0 + bj * HALF) = pack8(v0, v1); }
                ss += __shfl_xor(ss, 16); ss += __shfl_xor(ss, 32); if (fq == 0) SSQH[(size_t)row * 32 + sslot] = ss; }
    }
};

struct Epi4 {
    static constexpr bool MIDSCALE = false;
    bf16* QP;
    __device__ __forceinline__ void midscale(f32x4 (&)[2][2][4][2], int, int, int) const {}
    __device__ __forceinline__ void unit_begin(const Unit&, int, int) const {}
    __device__ __forceinline__ void operator()(const f32x4 (&acc)[2][2][4][2], const Unit& u, int par, int wr, int wc, int fr, int fq) const {
        const int row0 = u.pm * BM + wr * 64 + fr, col0 = u.pn * BM + wc * 32 + 8 * fq;
#pragma unroll
        for (int ai = 0; ai < 2; ++ai)
#pragma unroll
            for (int m = 0; m < 4; ++m) { const int row = row0 + ai * HALF + m * 16;
#pragma unroll
                for (int bj = 0; bj < 2; ++bj) *(v4u*)(QP + (size_t)row * DM + col0 + bj * HALF) = pack8(acc[ai][bj][m][0], acc[ai][bj][m][1]); }
    }
};
}

__device__ __forceinline__ void kr_item(const bf16* __restrict__ XN, const bf16* __restrict__ BT, const f32x2* __restrict__ ROPE, bf16* __restrict__ KPE, int item, int wave, int lane) {
    const int fr = lane & 15, fq = lane >> 4, row = item * 128 + wave * 16 + fr;
    const bf16* ap = XN + (size_t)row * 2048 + fq * 8; const bf16* bp = BT + (size_t)fr * 2048 + fq * 8;
    f32x4 acc[4];
#pragma unroll
    for (int nb = 0; nb < 4; ++nb) acc[nb] = (f32x4){0.f, 0.f, 0.f, 0.f};
#pragma unroll 4
    for (int k0 = 0; k0 < 2048; k0 += 32) {
        const bf16x8 a = *(const bf16x8*)(ap + k0);
#pragma unroll
        for (int nb = 0; nb < 4; ++nb) { const bf16x8 b = *(const bf16x8*)(bp + (size_t)nb * 16 * 2048 + k0); acc[nb] = __builtin_amdgcn_mfma_f32_16x16x32_bf16(b, a, acc[nb], 0, 0, 0); }
    }
    const int pos = row & (SEQ - 1);
#pragma unroll
    for (int nb = 0; nb < 4; ++nb) { const int j0 = 8 * nb + 2 * fq; const f32x4 r = *(const f32x4*)(ROPE + (size_t)pos * 32 + j0); const f32x4 v = acc[nb];
        v2u o; o.x = pk2(v[0] * r[0] - v[1] * r[1], v[0] * r[1] + v[1] * r[0]); o.y = pk2(v[2] * r[2] - v[3] * r[3], v[2] * r[3] + v[3] * r[2]);
        *(v2u*)(KPE + (size_t)row * 64 + 16 * nb + 4 * fq) = o; }
}
namespace att {
typedef short v4i16_t __attribute__((ext_vector_type(4)));
#define MFMA32(a, b, c) __builtin_amdgcn_mfma_f32_32x32x16_bf16((a), (b), (c), 0, 0, 0)
__device__ __forceinline__ s16x4 vtr(const LAS unsigned char* p) { return __builtin_bit_cast(s16x4, __builtin_amdgcn_ds_read_tr16_b64_v4i16((LAS v4i16_t*)p)); }
__device__ __forceinline__ int crow(int r, int hi) { return (r & 3) + 8 * (r >> 2) + 4 * hi; }
constexpr int VS = 320;
constexpr int KS = 400;
constexpr float NEG = -1e30f;

__device__ __forceinline__ bf16x8 pack8r(const f32x16& p, int s) {
    v4u w; w.x = pk2(p[8 * s + 0], p[8 * s + 1]); w.y = pk2(p[8 * s + 2], p[8 * s + 3]); w.z = pk2(p[8 * s + 4], p[8 * s + 5]); w.w = pk2(p[8 * s + 6], p[8 * s + 7]);
    return __builtin_bit_cast(bf16x8, w);
}
__device__ __forceinline__ void pv32(f32x16 (&o)[4], const LAS unsigned char* vb, const bf16x8 pb0, const bf16x8 pb1) {
#pragma unroll
    for (int d = 0; d < 4; ++d) {
        const s16x4 l0 = vtr(vb + d * 64), h0 = vtr(vb + d * 64 + 8 * VS), l1 = vtr(vb + d * 64 + 16 * VS), h1 = vtr(vb + d * 64 + 24 * VS);
        const bf16x8 a0 = __builtin_shufflevector(l0, h0, 0, 1, 2, 3, 4, 5, 6, 7), a1 = __builtin_shufflevector(l1, h1, 0, 1, 2, 3, 4, 5, 6, 7);
        o[d] = MFMA32(a0, pb0, o[d]); o[d] = MFMA32(a1, pb1, o[d]);
    }
}
template <int NS>
__device__ __forceinline__ void softmax_step(f32x16 (&s)[NS], float& m, float& l, f32x16 (&o)[4], bf16x8 (&pb)[2 * NS]) {
    float mx = s[0][0];
#pragma unroll
    for (int t = 0; t < NS; ++t)
#pragma unroll
        for (int r = 0; r < 16; ++r) mx = fmaxf(mx, s[t][r]);
    mx = fmaxf(mx, __shfl_xor(mx, 32));
    const float mn = fmaxf(m, mx), alpha = __builtin_amdgcn_exp2f(m - mn); m = mn;
    float ps = 0.f;
#pragma unroll
    for (int t = 0; t < NS; ++t)
#pragma unroll
        for (int r = 0; r < 16; ++r) { const float p = __builtin_amdgcn_exp2f(s[t][r] - mn); s[t][r] = p; ps += p; }
    l = l * alpha + ps;
    if (!__all(alpha == 1.0f)) {
#pragma unroll
        for (int d = 0; d < 4; ++d) o[d] = o[d] * alpha;
    }
#pragma unroll
    for (int t = 0; t < NS; ++t) { pb[2 * t] = pack8r(s[t], 0); pb[2 * t + 1] = pack8r(s[t], 1); }
}
__device__ __forceinline__ void store_o(f32x16 (&o)[4], float l, bf16* __restrict__ orow  , float* __restrict__ ssq  , int hh) {
    l += __shfl_xor(l, 32);
    const float inv = 1.0f / l; float ss = 0.f;
#pragma unroll
    for (int d = 0; d < 4; ++d) { o[d] = o[d] * inv;
#pragma unroll
        for (int g = 0; g < 4; ++g) { const float a = o[d][4 * g], b = o[d][4 * g + 1], c = o[d][4 * g + 2], e = o[d][4 * g + 3];
            ss += (a * a + b * b) + (c * c + e * e);
            v2u w; w.x = pk2(a, b); w.y = pk2(c, e); *(v2u*)(orow + 32 * d + 8 * g + 4 * hh) = w; } }
    ss += __shfl_xor(ss, 32);
    if (hh == 0) *ssq = ss;
}

constexpr int KTB = 64 * KS, VTB = 64 * VS, BUFB = KTB + VTB;
__device__ __forceinline__ void mla_unit(const unsigned char* ws, LAS unsigned char* lds, int b, int h, int qblk, int tid, int wave, int lane) {
    const bf16* QN = (const bf16*)(ws + WS_QN); const bf16* QPE = (const bf16*)(ws + WS_QPE); const bf16* KN = (const bf16*)(ws + WS_KN);
    const bf16* KPE = (const bf16*)(ws + WS_KPE); const bf16* VM = (const bf16*)(ws + WS_VM);
    bf16* O = (bf16*)(ws + WS_A); float* SSQO = (float*)(ws + WS_SSQO);
    const int r32 = lane & 31, hh = lane >> 5;
    const size_t tok0 = (size_t)b * SEQ;
    const int row_lo = qblk * 256 + wave * 32, qrow = row_lo + r32;
    bf16x8 qf[12];
    { const bf16* qn = QN + (tok0 + qrow) * 1024 + h * 128 + 8 * hh;
#pragma unroll
      for (int s = 0; s < 8; ++s) qf[s] = *(const bf16x8*)(qn + 16 * s);
      const bf16* qp = QPE + (tok0 + qrow) * 512 + h * 64 + 8 * hh;
#pragma unroll
      for (int s = 0; s < 4; ++s) qf[8 + s] = *(const bf16x8*)(qp + 16 * s); }
    const int c0 = tid, c1 = tid + 512;
    const bf16* gkn0 = KN + (tok0 + (c0 >> 4)) * 1024 + h * 128 + (c0 & 15) * 8; const bf16* gkn1 = KN + (tok0 + (c1 >> 4)) * 1024 + h * 128 + (c1 & 15) * 8;
    const bf16* gkp = KPE + (tok0 + (tid >> 3)) * 64 + (tid & 7) * 8;
    const bf16* gv0 = VM + (tok0 + (c0 >> 4)) * 1024 + h * 128 + (c0 & 15) * 8; const bf16* gv1 = VM + (tok0 + (c1 >> 4)) * 1024 + h * 128 + (c1 & 15) * 8;
    const int lkn0 = (c0 >> 4) * KS + (c0 & 15) * 16, lkn1 = (c1 >> 4) * KS + (c1 & 15) * 16, lkp = (tid >> 3) * KS + 256 + (tid & 7) * 16;
    const int lv0 = KTB + (c0 >> 4) * VS + (c0 & 15) * 16, lv1 = KTB + (c1 >> 4) * VS + (c1 & 15) * 16;
    v4u st0, st1, st2, st3, st4;
#define MLA_GLOAD(kt) do { const size_t _o = (size_t)(kt) * 64; st0 = *(const v4u*)(gkn0 + _o * 1024); st1 = *(const v4u*)(gkn1 + _o * 1024); st2 = *(const v4u*)(gkp + _o * 64); \
        st3 = *(const v4u*)(gv0 + _o * 1024); st4 = *(const v4u*)(gv1 + _o * 1024); } while (0)
#define MLA_LWRITE(buf) do { LAS unsigned char* _b = lds + (buf) * BUFB; *(LAS v4u*)(_b + lkn0) = st0; *(LAS v4u*)(_b + lkn1) = st1; *(LAS v4u*)(_b + lkp) = st2; \
        *(LAS v4u*)(_b + lv0) = st3; *(LAS v4u*)(_b + lv1) = st4; } while (0)
    const int nkt = 4 * (qblk + 1);
    MLA_GLOAD(0); MLA_LWRITE(0);
    __syncthreads();
    f32x16 o[4];
#pragma unroll
    for (int d = 0; d < 4; ++d)
#pragma unroll
        for (int r = 0; r < 16; ++r) o[d][r] = 0.f;
    float m = NEG, l = 0.f;
    const int kread = r32 * KS + 16 * hh;
    const int vread = KTB + (4 * hh + ((lane & 15) >> 2)) * VS + (16 * ((lane >> 4) & 1) + 4 * (lane & 3)) * 2;
    for (int kt = 0; kt < nkt; ++kt) {
        if (kt + 1 < nkt) MLA_GLOAD(kt + 1);
        const int k0 = kt * 64;
        if (k0 <= row_lo + 31) {
            const LAS unsigned char* kb = lds + (kt & 1) * BUFB;
            const bool diag = (k0 + 63 > row_lo);
#pragma unroll
            for (int sub = 0; sub < 2; ++sub) {
                if (sub == 1 && k0 + 32 > row_lo + 31) break;
                f32x16 s[1];
#pragma unroll
                for (int r = 0; r < 16; ++r) s[0][r] = 0.f;
#pragma unroll
                for (int ks = 0; ks < 12; ++ks) { const bf16x8 kf = *(const LAS bf16x8*)(kb + kread + sub * 32 * KS + 32 * ks); s[0] = MFMA32(kf, qf[ks], s[0]); }
                if (diag) {
#pragma unroll
                    for (int r = 0; r < 16; ++r) { const int key = k0 + 32 * sub + crow(r, hh); if (key > qrow) s[0][r] = NEG; }
                }
                bf16x8 pb[2];
                softmax_step<1>(s, m, l, o, pb);
                pv32(o, kb + vread + sub * 32 * VS, pb[0], pb[1]);
            }
        }
        if (kt + 1 < nkt) MLA_LWRITE((kt + 1) & 1);
        __syncthreads();
    }
#undef MLA_GLOAD
#undef MLA_LWRITE
    store_o(o, l, O + (tok0 + qrow) * 2048 + 1024 + h * 128, SSQO + (tok0 + qrow) * 16 + 8 + h, hh);
}

__device__ __forceinline__ void dil_tile(const unsigned char* ws, LAS unsigned char* vl  , int b, int h, int j, int r16, int lane) {
    const bf16* QKV = (const bf16*)(ws + WS_B); bf16* O = (bf16*)(ws + WS_A); float* SSQO = (float*)(ws + WS_SSQO);
    const int r32 = lane & 31, hh = lane >> 5;
    const size_t tok0 = (size_t)b * SEQ;
    const int tq = 512 * j + 16 * r32 + r16;
    bf16x8 qf[8];
    { const bf16* qp = QKV + (tok0 + tq) * 3072 + h * 128 + 8 * hh;
#pragma unroll
      for (int s = 0; s < 8; ++s) qf[s] = *(const bf16x8*)(qp + 16 * s); }
    const float slope2 = __builtin_amdgcn_exp2f(-(float)(h + 1)) * LOG2E;
    const int m0 = (j == 0) ? 4 : 0, n3 = j + 1, n2 = 8 - m0, n1 = 20 - m0, nt = n3 + n2 + n1;
    const bf16* kcol = QKV + tok0 * 3072 + 1024 + h * 128 + 8 * hh;
    const bf16* vcol = QKV + tok0 * 3072 + 2048 + h * 128 + (lane & 15) * 8;
    const int vrow = lane >> 4;
    const int vwr = vrow * VS + (lane & 15) * 16;
    const int vread = (4 * hh + ((lane & 15) >> 2)) * VS + (16 * ((lane >> 4) & 1) + 4 * (lane & 3)) * 2;
    int kbase, kstride, maxd;
#define DIL_DESC(idx) do { const int _i = (idx); if (_i < n3) { kbase = 512 * (j - _i) + r16; kstride = 16; maxd = 2048; } \
        else if (_i < n3 + n2) { kbase = 4 * (128 * j - 128 + 32 * (m0 + _i - n3)) + (r16 & 3); kstride = 4; maxd = 512; } \
        else { kbase = 512 * j - 128 + 32 * (m0 + _i - n3 - n2); kstride = 1; maxd = 128; } } while (0)
    bf16x8 kc[8]; v4u vn[8];
    DIL_DESC(0);
    { const bf16* kp = kcol + (size_t)(kbase + kstride * r32) * 3072;
#pragma unroll
      for (int s = 0; s < 8; ++s) kc[s] = *(const bf16x8*)(kp + 16 * s);
#pragma unroll
      for (int i = 0; i < 8; ++i) vn[i] = *(const v4u*)(vcol + (size_t)(kbase + kstride * (4 * i + vrow)) * 3072);
#pragma unroll
      for (int i = 0; i < 8; ++i) *(LAS v4u*)(vl + vwr + 4 * i * VS) = vn[i]; }
    f32x16 o[4];
#pragma unroll
    for (int d = 0; d < 4; ++d)
#pragma unroll
        for (int r = 0; r < 16; ++r) o[d][r] = 0.f;
    float m = NEG, l = 0.f;
    for (int idx = 0; idx < nt; ++idx) {
        const int cb = kbase, cs = kstride, cm = maxd;
        const bool more = idx + 1 < nt;
        if (more) {
            DIL_DESC(idx + 1);
#pragma unroll
            for (int i = 0; i < 8; ++i) vn[i] = *(const v4u*)(vcol + (size_t)(kbase + kstride * (4 * i + vrow)) * 3072);
        }
        f32x16 s[1];
#pragma unroll
        for (int r = 0; r < 16; ++r) s[0][r] = 0.f;
#pragma unroll
        for (int ks = 0; ks < 8; ++ks) s[0] = MFMA32(kc[ks], qf[ks], s[0]);
        if (more) {
            const bf16* kp = kcol + (size_t)(kbase + kstride * r32) * 3072;
#pragma unroll
            for (int s2 = 0; s2 < 8; ++s2) kc[s2] = *(const bf16x8*)(kp + 16 * s2);
        }
        const int d0 = tq - cb - cs * 4 * hh;
#pragma unroll
        for (int r = 0; r < 16; ++r) { const int dist = d0 - cs * ((r & 3) + 8 * (r >> 2)); const float v = s[0][r] - slope2 * (float)dist; s[0][r] = ((unsigned)dist <= (unsigned)cm) ? v : NEG; }
        bf16x8 pb[2];
        softmax_step<1>(s, m, l, o, pb);
        pv32(o, vl + vread, pb[0], pb[1]);
        if (more) {
#pragma unroll
            for (int i = 0; i < 8; ++i) *(LAS v4u*)(vl + vwr + 4 * i * VS) = vn[i];
        }
    }
#undef DIL_DESC
    store_o(o, l, O + (tok0 + tq) * 2048 + h * 128, SSQO + (tok0 + tq) * 16 + h, hh);
}

__device__ __forceinline__ void phase_attn(const Params& P, LAS unsigned char* lds, int vcu, int G) {
    int tid_ = threadIdx.x; asm volatile("" : "+v"(tid_));
    const int tid = tid_, lane = tid & 63, wave = __builtin_amdgcn_readfirstlane(tid >> 6);
    const unsigned char* ws = P.ws;
#ifndef REP_MLA
#define REP_MLA 1
#endif
#ifndef REP_DIL
#define REP_DIL 1
#endif
    for (int rm_ = 0; rm_ < REP_MLA; ++rm_)
    for (int u = vcu; u < 256; u += G) { const int bh = u >> 2, pr = u & 3;
        mla_unit(ws, lds, bh >> 3, bh & 7, 7 - pr, tid, wave, lane);
        mla_unit(ws, lds, bh >> 3, bh & 7, pr, tid, wave, lane); }
    __syncthreads();
    LAS unsigned char* vl = lds + wave * (32 * VS);
    for (int rd_ = 0; rd_ < REP_DIL; ++rd_)
    if (G == 256) {
#pragma unroll 1
        for (int k = 0; k < 2; ++k) { const int t = (vcu >> 5) * 512 + k * 256 + (vcu & 31) * 8 + wave; const int bh = t >> 6, rem = t & 63, jj = rem >> 4, r16 = rem & 15;
            dil_tile(ws, vl, bh >> 3, bh & 7, k == 0 ? jj : 3 - jj, r16, lane); }
    } else {
#pragma unroll 1
        for (int t = vcu * 8 + wave; t < 4096; t += G * 8) { const int bh = t >> 6, rem = t & 63; dil_tile(ws, vl, bh >> 3, bh & 7, rem >> 4, rem & 15, lane); }
    }
}
}
namespace peer {
typedef __bf16 bf2_t __attribute__((ext_vector_type(2)));
#define MFMA32(a, b, c) __builtin_amdgcn_mfma_f32_32x32x16_bf16((a), (b), (c), 0, 0, 0)
__device__ __forceinline__ float fmax3(float a, float b, float c) { return fmaxf(fmaxf(a, b), c); }
__device__ __forceinline__ float asf(unsigned u) { return __builtin_bit_cast(float, u); }
__device__ __forceinline__ unsigned asu(float f) { return __builtin_bit_cast(unsigned, f); }

__device__ __forceinline__ void route_item(const unsigned char* ws, LAS unsigned* sc, int tile, int h, int lane) {
    const bf16* QP = (const bf16*)(ws + WS_QP); const bf16* SK = (const bf16*)(ws + WS_SK);
    int* RIDX = (int*)(ws + WS_RIDX); float* RGATE = (float*)(ws + WS_RGATE);
    const int r32 = lane & 31, hh = lane >> 5;
    const size_t tok = (size_t)tile * 32 + r32;
    float rs2; { const f32x4* sp = (const f32x4*)((const float*)(ws + WS_SSQH) + tok * 32); f32x4 a = sp[0];
#pragma unroll
        for (int i = 1; i < 8; ++i) a = a + sp[i];
        rs2 = rsqrtf(((a[0] + a[1]) + (a[2] + a[3])) * (1.f / 2048.f) + EPS); }
#pragma unroll 1
    for (int p = 0; p < 2; ++p) {
        f32x16 s[4];
#pragma unroll
        for (int kb = 0; kb < 4; ++kb)
#pragma unroll
            for (int r = 0; r < 16; ++r) s[kb][r] = 0.f;
        const bf16* qp = QP + tok * 2048 + h * 256 + p * 128 + 8 * hh;
        const bf16* kp = SK + ((size_t)(h * 2 + p) * 128 + r32) * 128 + 8 * hh;
#pragma unroll
        for (int ks = 0; ks < 8; ++ks) { const bf16x8 q = *(const bf16x8*)(qp + 16 * ks);
#pragma unroll
            for (int kb = 0; kb < 4; ++kb) { const bf16x8 k = *(const bf16x8*)(kp + (size_t)kb * 32 * 128 + 16 * ks); s[kb] = MFMA32(k, q, s[kb]); } }
#pragma unroll
        for (int kb = 0; kb < 4; ++kb)
#pragma unroll
            for (int r = 0; r < 16; ++r) s[kb][r] = asf((asu(s[kb][r] * rs2) & ~127u) | (unsigned)(32 * kb + (r & 3) + 8 * (r >> 2) + 4 * hh));
#pragma unroll 1
        for (int k = 0; k < 16; ++k) {
            float mx = s[0][0];
#pragma unroll
            for (int kb = 0; kb < 4; ++kb)
#pragma unroll
                for (int r = 0; r < 16; r += 2) mx = fmax3(mx, s[kb][r], s[kb][r + 1]);
            mx = fmaxf(mx, __shfl_xor(mx, 32));
            if (hh == 0) sc[(p * 32 + r32) * 16 + k] = asu(mx);
#pragma unroll
            for (int kb = 0; kb < 4; ++kb)
#pragma unroll
                for (int r = 0; r < 16; ++r) s[kb][r] = (s[kb][r] == mx) ? -3.0e38f : s[kb][r];
        }
    }
    unsigned t1[16], t2[16];
#pragma unroll
    for (int i = 0; i < 16; i += 4) { const v4u a = *(const LAS v4u*)(sc + r32 * 16 + i), b = *(const LAS v4u*)(sc + (32 + r32) * 16 + i);
        t1[i] = a.x; t1[i + 1] = a.y; t1[i + 2] = a.z; t1[i + 3] = a.w; t2[i] = b.x; t2[i + 1] = b.y; t2[i + 2] = b.z; t2[i + 3] = b.w; }
    float c[50]; int n = 0;
#pragma unroll
    for (int i = 0; i < 16; ++i)
#pragma unroll
        for (int j = 0; j < 16; ++j) if ((i + 1) * (j + 1) <= 16) { const float v = asf(t1[i] & ~127u) + asf(t2[j] & ~127u); c[n] = asf((asu(v) & ~255u) | (unsigned)(i * 16 + j)); ++n; }
    float best[8]; float bmax = 0.f, esum = 0.f;
#pragma unroll
    for (int k = 0; k < 16; ++k) {
        float mx = c[0];
#pragma unroll
        for (int q = 1; q < 49; q += 2) mx = fmax3(mx, c[q], c[q + 1]);
        mx = fmaxf(mx, c[49]);
#pragma unroll
        for (int q = 0; q < 50; ++q) c[q] = (c[q] == mx) ? -3.0e38f : c[q];
        const float val = asf(asu(mx) & ~255u);
        if (k == 0) bmax = val;
        esum += __expf(val - bmax);
        if ((k >> 3) == hh) best[k & 7] = mx;
    }
    const float inv = 1.0f / esum;
    int idx[8]; float gate[8];
#pragma unroll
    for (int k = 0; k < 8; ++k) { const unsigned code = asu(best[k]) & 255u; const unsigned a = sc[r32 * 16 + (code >> 4)], b = sc[(32 + r32) * 16 + (code & 15)];
        idx[k] = (int)((a & 127u) * 128u + (b & 127u)); gate[k] = __expf(asf(asu(best[k]) & ~255u) - bmax) * inv; }
    int* ip = RIDX + tok * 128 + h * 16 + 8 * hh; float* gp = RGATE + tok * 128 + h * 16 + 8 * hh;
    *(v4u*)ip = (v4u){(unsigned)idx[0], (unsigned)idx[1], (unsigned)idx[2], (unsigned)idx[3]}; *(v4u*)(ip + 4) = (v4u){(unsigned)idx[4], (unsigned)idx[5], (unsigned)idx[6], (unsigned)idx[7]};
    *(f32x4*)gp = (f32x4){gate[0], gate[1], gate[2], gate[3]}; *(f32x4*)(gp + 4) = (f32x4){gate[4], gate[5], gate[6], gate[7]};
}

__device__ __forceinline__ void phase_route(const Params& P, LAS unsigned char* lds, int vcu, int G) {
    int tid_ = threadIdx.x; asm volatile("" : "+v"(tid_));
    const int lane = tid_ & 63, wave = __builtin_amdgcn_readfirstlane(tid_ >> 6);
    LAS unsigned* sc = (LAS unsigned*)(lds + wave * 4096);
#pragma unroll 1
    for (int it = vcu * NWAVES + wave; it < 512 * 8; it += G * NWAVES) route_item(P.ws, sc, it >> 3, it & 7, lane);
}

__device__ __forceinline__ float dot16_f8(const float (&x)[16], const v4u& u, float c) {
    const int u0 = (int)u.x, u1 = (int)u.y, u2 = (int)u.z, u3 = (int)u.w;
    const f32x2 a0 = __builtin_amdgcn_cvt_pk_f32_fp8(u0, false), a1 = __builtin_amdgcn_cvt_pk_f32_fp8(u0, true);
    const f32x2 a2 = __builtin_amdgcn_cvt_pk_f32_fp8(u1, false), a3 = __builtin_amdgcn_cvt_pk_f32_fp8(u1, true);
    const f32x2 a4 = __builtin_amdgcn_cvt_pk_f32_fp8(u2, false), a5 = __builtin_amdgcn_cvt_pk_f32_fp8(u2, true);
    const f32x2 a6 = __builtin_amdgcn_cvt_pk_f32_fp8(u3, false), a7 = __builtin_amdgcn_cvt_pk_f32_fp8(u3, true);
    c = fmaf(x[0], a0.x, c); c = fmaf(x[1], a0.y, c); c = fmaf(x[2], a1.x, c); c = fmaf(x[3], a1.y, c);
    c = fmaf(x[4], a2.x, c); c = fmaf(x[5], a2.y, c); c = fmaf(x[6], a3.x, c); c = fmaf(x[7], a3.y, c);
    c = fmaf(x[8], a4.x, c); c = fmaf(x[9], a4.y, c); c = fmaf(x[10], a5.x, c); c = fmaf(x[11], a5.y, c);
    c = fmaf(x[12], a6.x, c); c = fmaf(x[13], a6.y, c); c = fmaf(x[14], a7.x, c); c = fmaf(x[15], a7.y, c);
    return c;
}
__device__ __forceinline__ void unpack8(float* x, const v4u& v) { x[0] = bflo(v.x); x[1] = bfhi(v.x); x[2] = bflo(v.y); x[3] = bfhi(v.y); x[4] = bflo(v.z); x[5] = bfhi(v.z); x[6] = bflo(v.w); x[7] = bfhi(v.w); }
__device__ __forceinline__ void peer_u_token(const Params& P, size_t tok, int lane) {
    const unsigned char* ws = P.ws;
    const bf16* H1B = (const bf16*)(ws + WS_B); const unsigned char* U8 = ws + WS_UB;
    const int* RIDX = (const int*)(ws + WS_RIDX); const float* RGATE = (const float*)(ws + WS_RGATE); const float* SSQH = (const float*)(ws + WS_SSQH);
    unsigned* PKV = (unsigned*)(ws + WS_PKV);
    float x0[16], x1[16];
    { const bf16* hp = H1B + tok * 2048 + 16 * lane; const v4u a = *(const v4u*)hp, b = *(const v4u*)(hp + 8), c = *(const v4u*)(hp + 1024), d = *(const v4u*)(hp + 1032);
      unpack8(x0, a); unpack8(x0 + 8, b); unpack8(x1, c); unpack8(x1 + 8, d); }
    const float rs2 = rsqrtf(wave_sum(lane < 32 ? SSQH[tok * 32 + lane] : 0.f) * (1.f / 2048.f) + EPS) * (1.f / 32.f);
    const int i0 = RIDX[tok * 128 + lane], i1 = RIDX[tok * 128 + 64 + lane];
    const float g0 = RGATE[tok * 128 + lane], g1 = RGATE[tok * 128 + 64 + lane];
    float d0 = 0.f, d1 = 0.f;
    v4u ra[16], rb[16];
#define PU_LOAD(buf, g) do { _Pragma("unroll") for (int e = 0; e < 8; ++e) { const int row = __builtin_amdgcn_readlane((g) < 8 ? i0 : i1, ((g) & 7) * 8 + e); \
        const unsigned char* up = U8 + (size_t)row * 2048 + 16 * lane; buf[2 * e] = *(const v4u*)up; buf[2 * e + 1] = *(const v4u*)(up + 1024); } } while (0)
#define PU_COMPUTE(buf, g) do { float pt[8]; _Pragma("unroll") for (int e = 0; e < 8; ++e) pt[e] = dot16_f8(x1, buf[2 * e + 1], dot16_f8(x0, buf[2 * e], 0.f)); \
        float a4[4], a2[2], a1; \
        _Pragma("unroll") for (int i = 0; i < 4; ++i) { const float keep = (lane & 1) ? pt[2 * i + 1] : pt[2 * i], give = (lane & 1) ? pt[2 * i] : pt[2 * i + 1]; a4[i] = keep + __shfl_xor(give, 1); } \
        _Pragma("unroll") for (int i = 0; i < 2; ++i) { const float keep = (lane & 2) ? a4[2 * i + 1] : a4[2 * i], give = (lane & 2) ? a4[2 * i] : a4[2 * i + 1]; a2[i] = keep + __shfl_xor(give, 2); } \
        { const float keep = (lane & 4) ? a2[1] : a2[0], give = (lane & 4) ? a2[0] : a2[1]; a1 = keep + __shfl_xor(give, 4); } \
        a1 += __shfl_xor(a1, 8); a1 += __shfl_xor(a1, 16); a1 += __shfl_xor(a1, 32); \
        if ((lane >> 3) == ((g) & 7)) { if ((g) < 8) d0 = a1; else d1 = a1; } } while (0)
    PU_LOAD(ra, 0);
#pragma unroll 1
    for (int g = 0; g < 16; g += 2) {
        PU_LOAD(rb, g + 1);
        PU_COMPUTE(ra, g);
        if (g + 2 < 16) PU_LOAD(ra, g + 2);
        PU_COMPUTE(rb, g + 1);
    }
#undef PU_LOAD
#undef PU_COMPUTE
    const float z0 = d0 * rs2, z1 = d1 * rs2;
    const float a0 = 0.25f * z0 * (1.0f + erff(z0 * 0.7071067811865476f)) * g0, a1v = 0.25f * z1 * (1.0f + erff(z1 * 0.7071067811865476f)) * g1;
    unsigned* pk = PKV + ((tok >> 6) * 128) * 64 + (tok & 63);
    pk[(size_t)lane * 64] = ((unsigned)i0 << 3) | ((asu(a0) + 0x10000u) & 0xfffe0000u);
    pk[(size_t)(64 + lane) * 64] = ((unsigned)i1 << 3) | ((asu(a1v) + 0x10000u) & 0xfffe0000u);
}
__device__ __forceinline__ void phase_peer_u(const Params& P, int vcu, int G) {
    int tid_ = threadIdx.x; asm volatile("" : "+v"(tid_));
    const int lane = tid_ & 63, wave = __builtin_amdgcn_readfirstlane(tid_ >> 6);
#pragma unroll 1
    for (int t = vcu * NWAVES + wave; t < M; t += G * NWAVES) peer_u_token(P, (size_t)t, lane);
}
__device__ __forceinline__ void phase_peer_v(const Params& P, LAS unsigned char* lds, int vcu, int G) {
    int tid_ = threadIdx.x; asm volatile("" : "+v"(tid_));
    const int tid = tid_, lane = tid & 63, wave = __builtin_amdgcn_readfirstlane(tid >> 6);
    const unsigned char* ws = P.ws;
    const bf16* H1B = (const bf16*)(ws + WS_B); const unsigned* PKV = (const unsigned*)(ws + WS_PKV);
#pragma unroll 1
    for (int c = vcu; c < 256; c += G) {
        __syncthreads();
        { const v4u* src = (const v4u*)(ws + WS_VB + (size_t)c * 131072);
#pragma unroll 4
          for (int i = tid; i < 8192; i += NTHREADS) *(LAS v4u*)(lds + 16 * i) = src[i]; }
        __syncthreads();
#pragma unroll 1
        for (int b = wave; b < 256; b += NWAVES) {
            const size_t tok = (size_t)b * 64 + lane;
            float y[8]; { const v4u hx = *(const v4u*)(H1B + tok * 2048 + 8 * c); unpack8(y, hx); }
            const unsigned* pk = PKV + (size_t)b * 128 * 64 + lane;
#pragma unroll 1
            for (int e0 = 0; e0 < 128; e0 += 16) {
                unsigned w[16]; v2u vv[16];
#pragma unroll
                for (int i = 0; i < 16; ++i) w[i] = pk[(e0 + i) * 64];
#pragma unroll
                for (int i = 0; i < 16; ++i) vv[i] = *(const LAS v2u*)(size_t)(w[i] & 0x1ffffu);
#pragma unroll
                for (int i = 0; i < 16; ++i) { const float a = asf(w[i] & 0xfffe0000u);
                    const f32x2 p0 = __builtin_amdgcn_cvt_pk_f32_fp8((int)vv[i].x, false), p1 = __builtin_amdgcn_cvt_pk_f32_fp8((int)vv[i].x, true);
                    const f32x2 p2 = __builtin_amdgcn_cvt_pk_f32_fp8((int)vv[i].y, false), p3 = __builtin_amdgcn_cvt_pk_f32_fp8((int)vv[i].y, true);
                    y[0] = fmaf(a, p0.x, y[0]); y[1] = fmaf(a, p0.y, y[1]); y[2] = fmaf(a, p1.x, y[2]); y[3] = fmaf(a, p1.y, y[3]);
                    y[4] = fmaf(a, p2.x, y[4]); y[5] = fmaf(a, p2.y, y[5]); y[6] = fmaf(a, p3.x, y[6]); y[7] = fmaf(a, p3.y, y[7]); }
            }
            float* op = P.out + tok * 2048 + 8 * c;
            *(f32x4*)op = (f32x4){y[0], y[1], y[2], y[3]}; *(f32x4*)(op + 4) = (f32x4){y[4], y[5], y[6], y[7]};
        }
    }
}
__device__ __forceinline__ void phase_final(const Params& P, int vcu, int G) {
    int tid_ = threadIdx.x; asm volatile("" : "+v"(tid_));
    const int lane = tid_ & 63, wave = __builtin_amdgcn_readfirstlane(tid_ >> 6);
    f32x4 gv[8];
#pragma unroll
    for (int j = 0; j < 8; ++j) gv[j] = ((const f32x4*)P.lnf)[lane + 64 * j];
#pragma unroll 1
    for (int t = vcu * NWAVES + wave; t < M; t += G * NWAVES) {
        f32x4* row = (f32x4*)(P.out + (size_t)t * 2048) + lane;
        f32x4 v[8]; float s = 0.f;
#pragma unroll
        for (int j = 0; j < 8; ++j) { v[j] = row[64 * j]; s += (v[j].x * v[j].x + v[j].y * v[j].y) + (v[j].z * v[j].z + v[j].w * v[j].w); }
        const float rs = rsqrtf(wave_sum(s) * (1.f / 2048.f) + EPS);
#pragma unroll
        for (int j = 0; j < 8; ++j) row[64 * j] = v[j] * rs * gv[j];
    }
}
#undef MFMA32
}
#define XB_TMO      128
#define XB_XCNT(j)  (256  + 64 * (j))
#define XB_XSUB(j)  (1280 + 64 * (j))
#define XB_XGEN(j)  (2304 + 64 * (j))
#define XB_TOP      3328
#define XB_TOPGEN   3392
#define XCD_BAR_WORDS 3456
#define XB_SPIN_CAP (1u << 22)
__device__ __forceinline__ unsigned xb_ld(unsigned* p)              { return __hip_atomic_load(p, __ATOMIC_RELAXED, __HIP_MEMORY_SCOPE_AGENT); }
__device__ __forceinline__ unsigned xb_add(unsigned* p, unsigned v) { return __hip_atomic_fetch_add(p, v, __ATOMIC_RELAXED, __HIP_MEMORY_SCOPE_AGENT); }
__device__ __forceinline__ unsigned xb_xcc_id() { return (unsigned)__builtin_amdgcn_s_getreg((3 << 11) | 20) & 0xFu; }
#define XB_SPIN(cond, bar) do { unsigned _sp = 0; while (cond) { __builtin_amdgcn_s_sleep(1); \
    if ((++_sp & 255u) == 0u) { if (xb_ld(&(bar)[XB_TMO])) break; if (_sp > XB_SPIN_CAP) { atomicAdd(&(bar)[XB_TMO], 1u); break; } } } } while (0)
struct XcdBarrier { unsigned* bar; unsigned x; volatile LAS unsigned* st; };
__device__ __forceinline__ XcdBarrier xcd_barrier_post(unsigned* bar, volatile LAS unsigned* st) {
    XcdBarrier b; b.bar = bar; b.x = xb_xcc_id(); b.st = st;
    if (threadIdx.x == 0) (void)xb_add(&bar[XB_XCNT(b.x)], 1u);
    return b;
}
__device__ __forceinline__ void xcd_barrier_complete(unsigned* bar, unsigned x, unsigned& nloc, unsigned& nx) {
    const unsigned G = gridDim.x * gridDim.y * gridDim.z;
    unsigned sum, cnt, mine, sp = 0u;
    for (;;) {
        sum = 0u; cnt = 0u; mine = 0u;
#pragma unroll
        for (unsigned j = 0; j < 16; ++j) { const unsigned c = xb_ld(&bar[XB_XCNT(j)]); sum += c; cnt += (c > 0u) ? 1u : 0u; mine = (j == x) ? c : mine; }
        if (sum == G) break;
        __builtin_amdgcn_s_sleep(1);
        if ((++sp & 255u) == 0u) { if (xb_ld(&bar[XB_TMO])) break; if (sp > XB_SPIN_CAP) { atomicAdd(&bar[XB_TMO], 1u); break; } }
    }
    nloc = mine > 0u ? mine : 1u; nx = cnt > 0u ? cnt : 1u;
}
__device__ __forceinline__ void xcd_barrier(const XcdBarrier& b) {
    asm volatile("s_waitcnt vmcnt(0)" ::: "memory");
    __syncthreads();
    if (threadIdx.x == 0) {
        unsigned* bar = b.bar;
        __builtin_amdgcn_s_waitcnt(0);
        unsigned nloc = b.st[0], nx = b.st[1];
        if (nloc == 0u) { xcd_barrier_complete(bar, b.x, nloc, nx); b.st[0] = nloc; b.st[1] = nx; }
        const unsigned old = xb_add(&bar[XB_XSUB(b.x)], 1u);
        const unsigned gen = old / nloc;
        if (old + 1u == (gen + 1u) * nloc) {
            __builtin_amdgcn_fence(__ATOMIC_RELEASE, "agent");
            asm volatile("s_waitcnt vmcnt(0)" ::: "memory");
            const unsigned og = xb_add(&bar[XB_TOP], 1u);
            const unsigned tg = og / nx;
            if (og + 1u == (tg + 1u) * nx) xb_add(&bar[XB_TOPGEN], 1u);
            else XB_SPIN(xb_ld(&bar[XB_TOPGEN]) == tg, bar);
            __builtin_amdgcn_fence(__ATOMIC_ACQUIRE, "agent");
            xb_add(&bar[XB_XGEN(b.x)], 1u);
            asm volatile("s_waitcnt vmcnt(0)" ::: "memory");
        } else {
            XB_SPIN(xb_ld(&bar[XB_XGEN(b.x)]) == gen, bar);
            __builtin_amdgcn_fence(__ATOMIC_ACQUIRE, "agent");
            asm volatile("s_waitcnt vmcnt(0)" ::: "memory");
        }
    }
    __syncthreads();
}
constexpr int N_PHASES = 10;
#ifndef REP_PHASE
#define REP_PHASE -1
#endif
#ifndef REP_N
#define REP_N 1
#endif
#ifndef EXTRA_SYNCS
#define EXTRA_SYNCS 0
#endif
__global__ void __launch_bounds__(NTHREADS, 2) mega(Params P) {
    extern __shared__ __attribute__((aligned(16))) unsigned char lds_raw[];
    LAS unsigned char* lds = (LAS unsigned char*)lds_raw;
    cg::grid_group grid = cg::this_grid();
    const int tid = threadIdx.x, lane = tid & 63, wave = __builtin_amdgcn_readfirstlane(tid >> 6);
    const int G = gridDim.x, bx = blockIdx.x;
    const int vcu = (G % 8 == 0) ? (bx % 8) * (G / 8) + bx / 8 : bx;
    unsigned char* ws = P.ws;
    const int lo = P.ph_lo, hi = P.ph_hi;
#define IN(k) (lo <= (k) && (k) < hi)
#ifndef CG_SEAMS
#define CG_SEAMS 1
#endif
    volatile LAS unsigned* xbst = (volatile LAS unsigned*)(lds + MISC_OFF + 8192);
    if (tid == 0) { xbst[0] = 0u; xbst[1] = 0u; xbst[2] = 0u; xbst[3] = 0u; }
    __syncthreads();
    const XcdBarrier xbar = xcd_barrier_post((unsigned*)(ws + WS_CTL) + 4096, xbst);
#define GSYNC(k) do { if ((k) < CG_SEAMS) grid.sync(); else xcd_barrier(xbar); } while (0)
#define SEAM(k) do { if (IN(k) && IN((k) + 1)) GSYNC(k); } while (0)

    for (int rep_ = 0; rep_ < (REP_PHASE == 0 ? 1 + REP_N : 1); ++rep_) if (IN(0)) { if (rep_) GSYNC(9); phase_prep(P, lds, vcu, G); }
    SEAM(0);
    for (int es_ = 0; es_ < EXTRA_SYNCS; ++es_) GSYNC(9);
    for (int rep_ = 0; rep_ < (REP_PHASE == 1 ? 1 + REP_N : 1); ++rep_) if (IN(1)) { if (rep_) GSYNC(9);
        pg8::GemmSet g; g.A0 = g.A1 = (const bf16*)(ws + WS_A); g.Bt0 = g.Bt1 = (const bf16*)(ws + WS_BT1); g.K = 2048;
        pg8::StaticOrder S; S.init(M, 4096, 0, G, bx);
        pg8::Epi1 E{(bf16*)(ws + WS_B), (bf16*)(ws + WS_CQ), (bf16*)(ws + WS_CKV), (float*)(ws + WS_SSQCQ), (float*)(ws + WS_SSQCKV)};
        pg8::gemm_phase<pg8::Epi1, pg8::StaticOrder>(lds, g, S, E);
    }
    SEAM(1);
    for (int rep_ = 0; rep_ < (REP_PHASE == 2 ? 1 + REP_N : 1); ++rep_) if (IN(2)) { if (rep_) GSYNC(9);
        pg8::GemmSet g; g.A0 = (const bf16*)(ws + WS_CQ); g.A1 = (const bf16*)(ws + WS_CKV); g.Bt0 = (const bf16*)(ws + WS_BT2Q); g.Bt1 = (const bf16*)(ws + WS_BT2KV); g.K = 512;
        pg8::StaticOrder S; S.init(M, 1536, 2048, G, bx);
        pg8::Epi2 E{(bf16*)(ws + WS_QN), (bf16*)(ws + WS_QPE), (bf16*)(ws + WS_KN), (bf16*)(ws + WS_VM), (const float*)(ws + WS_SSQCQ), (const float*)(ws + WS_SSQCKV), (const f32x2*)(ws + WS_ROPE)};
        pg8::gemm_phase<pg8::Epi2, pg8::StaticOrder>(lds, g, S, E);
        for (int it = G - 1 - bx; it < 128; it += G) kr_item((const bf16*)(ws + WS_A), (const bf16*)(ws + WS_BTKR), (const f32x2*)(ws + WS_ROPE), (bf16*)(ws + WS_KPE), it, wave, lane);
    }
    SEAM(2);
    for (int rep_ = 0; rep_ < (REP_PHASE == 3 ? 1 + REP_N : 1); ++rep_) if (IN(3)) { if (rep_) GSYNC(9); att::phase_attn(P, lds, vcu, G); }
    SEAM(3);
    for (int rep_ = 0; rep_ < (REP_PHASE == 4 ? 1 + REP_N : 1); ++rep_) if (IN(4)) { if (rep_) GSYNC(9);
        pg8::GemmSet g; g.A0 = g.A1 = (const bf16*)(ws + WS_A); g.Bt0 = g.Bt1 = (const bf16*)(ws + WS_BT3); g.K = 2048;
        pg8::StaticOrder S; S.init(M, 2048, 0, G, bx);
        pg8::Epi3 E{(bf16*)(ws + WS_B), P.x, (const float*)(ws + WS_SSQO), (float*)(ws + WS_SSQH), (LAS f32x2*)(lds + MISC_OFF)};
        pg8::gemm_phase<pg8::Epi3, pg8::StaticOrder>(lds, g, S, E);
    }
    SEAM(4);
    for (int rep_ = 0; rep_ < (REP_PHASE == 5 ? 1 + REP_N : 1); ++rep_) if (IN(5)) { if (rep_) GSYNC(9);
        pg8::GemmSet g; g.A0 = g.A1 = (const bf16*)(ws + WS_B); g.Bt0 = g.Bt1 = (const bf16*)(ws + WS_BT4); g.K = 2048;
        pg8::StaticOrder S; S.init(M, 2048, 0, G, bx);
        pg8::Epi4 E{(bf16*)(ws + WS_QP)};
        pg8::gemm_phase<pg8::Epi4, pg8::StaticOrder>(lds, g, S, E);
    }
    SEAM(5);
    for (int rep_ = 0; rep_ < (REP_PHASE == 6 ? 1 + REP_N : 1); ++rep_) if (IN(6)) { if (rep_) GSYNC(9); peer::phase_route(P, lds, vcu, G); }
    SEAM(6);
    for (int rep_ = 0; rep_ < (REP_PHASE == 7 ? 1 + REP_N : 1); ++rep_) if (IN(7)) { if (rep_) GSYNC(9); peer::phase_peer_u(P, vcu, G); }
    SEAM(7);
    for (int rep_ = 0; rep_ < (REP_PHASE == 8 ? 1 + REP_N : 1); ++rep_) if (IN(8)) { if (rep_) GSYNC(9); peer::phase_peer_v(P, lds, vcu, G); }
    SEAM(8);
    for (int rep_ = 0; rep_ < (REP_PHASE == 9 ? 1 + REP_N : 1); ++rep_) if (IN(9)) { if (rep_) GSYNC(9); peer::phase_final(P, vcu, G); }
#undef IN
#undef SEAM
}

static int mega_grid() {
    static int grid = 0;
    if (grid == 0) {
        int dev = 0, cus = 0, per_cu = 0;
        (void)hipGetDevice(&dev); (void)hipDeviceGetAttribute(&cus, hipDeviceAttributeMultiprocessorCount, dev);
        (void)hipFuncSetAttribute((const void*)mega, hipFuncAttributeMaxDynamicSharedMemorySize, LDS_BYTES);
        (void)hipOccupancyMaxActiveBlocksPerMultiprocessor(&per_cu, (const void*)mega, NTHREADS, LDS_BYTES);
        if (per_cu < 1) { fprintf(stderr, "mega: occupancy query says %d blocks/CU\n", per_cu); per_cu = 1; }
        grid = cus;
        (void)hipGetLastError();
    }
    return grid;
}
static void fill_params(Params& P, void* const* d_in, void* d_out, void* d_ws) {
    P.x = (const float*)d_in[0]; P.ln1 = (const float*)d_in[1]; P.w_in = (const float*)d_in[2]; P.qan = (const float*)d_in[3]; P.kvan = (const float*)d_in[4];
    P.w_uq = (const float*)d_in[5]; P.w_ukv = (const float*)d_in[6]; P.ond = (const float*)d_in[7]; P.onm = (const float*)d_in[8]; P.w_o = (const float*)d_in[9];
    P.ln2 = (const float*)d_in[10]; P.wq = (const float*)d_in[11]; P.sk = (const float*)d_in[12]; P.pu = (const float*)d_in[13]; P.pv = (const float*)d_in[14]; P.lnf = (const float*)d_in[15];
    P.out = (float*)d_out; P.ws = (unsigned char*)d_ws;
}
static void launch_phases(Params P, int lo, int hi, hipStream_t st) {
    P.ph_lo = lo; P.ph_hi = hi;
    (void)hipMemsetAsync(P.ws + WS_CTL, 0, CTL_ZERO_BYTES, st);
    void* args[] = {&P};
    hipError_t e = hipLaunchCooperativeKernel((const void*)mega, dim3(mega_grid()), dim3(NTHREADS), args, LDS_BYTES, st);
    if (e != hipSuccess) fprintf(stderr, "mega launch [%d,%d) failed: %s\n", lo, hi, hipGetErrorString(e));
}
extern "C" void kernel_launch(void* const* d_in, const int* in_sizes, int n_in, void* d_out, int out_size, void* d_ws, size_t ws_size, hipStream_t stream) {
    Params P{}; fill_params(P, d_in, d_out, d_ws);
    launch_phases(P, 0, N_PHASES, stream);
}
```

```cpp
#include <hip/hip_runtime.h>
#include <hip/hip_cooperative_groups.h>
#include <cstdio>
#include <cstdint>
#include <cstddef>
namespace cg = cooperative_groups;
#define GAS __attribute__((address_space(1)))
#define LAS __attribute__((address_space(3)))
typedef unsigned short bf16;
typedef unsigned v4u __attribute__((ext_vector_type(4)));
typedef unsigned v2u __attribute__((ext_vector_type(2)));
typedef float f32x2 __attribute__((ext_vector_type(2)));
typedef float f32x4 __attribute__((ext_vector_type(4)));
typedef float f32x16 __attribute__((ext_vector_type(16)));
typedef short bf16x8 __attribute__((ext_vector_type(8)));
typedef short s16x4 __attribute__((ext_vector_type(4)));
typedef __bf16 bf16x2_t __attribute__((ext_vector_type(2)));

constexpr int M = 16384, SEQ = 2048, DM = 2048, NWAVES = 8, NTHREADS = 512;
constexpr float EPS = 1e-6f, LOG2E = 1.4426950408889634f;
constexpr float QSCALE_DIL = 0.08838834764831845f * LOG2E;
constexpr float QSCALE_MLA = 0.07216878364870323f * LOG2E;

constexpr size_t MiB = 1u << 20;
constexpr size_t WS_CTL = 0, CTL_ZERO_BYTES = 64 * 1024;
constexpr size_t WS_ROPE = 1 * MiB;
constexpr size_t WS_SK = 2 * MiB;
constexpr size_t WS_BTKR = 3 * MiB;
constexpr size_t WS_BT2Q = 4 * MiB;
constexpr size_t WS_BT2KV = 6 * MiB;
constexpr size_t WS_BT1 = 8 * MiB;
constexpr size_t WS_BT3 = 24 * MiB;
constexpr size_t WS_BT4 = 32 * MiB;
constexpr size_t WS_SSQCQ = 40 * MiB;
constexpr size_t WS_SSQCKV = 40 * MiB + 512 * 1024;
constexpr size_t WS_SSQO = 41 * MiB;
constexpr size_t WS_SSQH = 42 * MiB;
constexpr size_t WS_KPE = 44 * MiB;
constexpr size_t WS_UB = 48 * MiB;
constexpr size_t WS_VB = 112 * MiB;
constexpr size_t WS_A = 176 * MiB;
constexpr size_t WS_B = 240 * MiB;
constexpr size_t WS_C = 336 * MiB;
constexpr size_t WS_QN = WS_C, WS_QPE = WS_C + 32 * MiB, WS_KN = WS_C + 48 * MiB, WS_VM = WS_C + 80 * MiB;
constexpr size_t WS_QP = WS_C, WS_RIDX = WS_C + 64 * MiB, WS_RGATE = WS_C + 72 * MiB, WS_PKV = WS_C + 80 * MiB,
                 WS_SIDX = WS_C + 88 * MiB, WS_SGATE = WS_C + 96 * MiB, WS_GOFF = WS_C + 104 * MiB;
constexpr size_t WS_D = 448 * MiB;
constexpr size_t WS_CQ = WS_D, WS_CKV = WS_D + 16 * MiB;
constexpr size_t WS_END = 480 * MiB;

constexpr int RING_BYTES = 131072;
constexpr int MISC_OFF = RING_BYTES;
constexpr int LDS_BYTES = 147456;

#define LDS_WAIT() asm volatile("s_waitcnt lgkmcnt(0)" ::: "memory")
#define VM_WAIT() asm volatile("s_waitcnt vmcnt(0)" ::: "memory")

__device__ __forceinline__ unsigned f2bf(float f) { unsigned u = __builtin_bit_cast(unsigned, f); return (u + 0x7fffu + ((u >> 16) & 1u)) >> 16; }
__device__ __forceinline__ unsigned pk2(float lo, float hi) { f32x2 v = {lo, hi}; bf16x2_t b = __builtin_convertvector(v, bf16x2_t); return __builtin_bit_cast(unsigned, b); }
__device__ __forceinline__ float bflo(unsigned u) { return __builtin_bit_cast(float, u << 16); }
__device__ __forceinline__ float bfhi(unsigned u) { return __builtin_bit_cast(float, u & 0xffff0000u); }
__device__ __forceinline__ float bf2f(bf16 b) { return __builtin_bit_cast(float, (unsigned)b << 16); }
__device__ __forceinline__ float wave_sum(float v) {
#pragma unroll
    for (int o = 1; o < 64; o <<= 1) v += __shfl_xor(v, o);
    return v;
}

__device__ __forceinline__ int hw_lane() { int l; asm volatile("v_mbcnt_lo_u32_b32 %0, -1, 0\n\tv_mbcnt_hi_u32_b32 %0, -1, %0" : "=v"(l)); return l; }

struct Params {
    const float *x, *ln1, *w_in, *qan, *kvan, *w_uq, *w_ukv, *ond, *onm, *w_o, *ln2, *wq, *sk, *pu, *pv, *lnf;
    float* out; unsigned char* ws;
    int ph_lo, ph_hi;
};
__device__ __forceinline__ int map_ident(int c) { return c; }
__device__ __forceinline__ int map_kr(int c) { const int p = c - 4096; return 2 * (p & 31) + (p >> 5); }
__device__ __forceinline__ int map_uq(int c) { const int h = c / 192, e = c % 192; if (e < 128) return h * 128 + e; const int p = e - 128; return 1024 + h * 64 + 2 * (p & 31) + (p >> 5); }
__device__ __forceinline__ int map_ukv(int c) { const int h = c >> 8, e = c & 255; return e < 128 ? h * 128 + e : 1024 + h * 128 + (e - 128); }

template <int MAP>
__device__ __forceinline__ void p0_transpose_item(const float* __restrict__ W, int K, int ldw, int c0, const float* __restrict__ g0, const float* __restrict__ g1, int gsplit,
                                                  bf16* __restrict__ WT, LAS float* scr, int item, int nblk, int lane) {
    const int kb = item / nblk, nb = item % nblk, k0 = 64 * kb, n0 = c0 + 32 * nb;
#pragma unroll 8
    for (int i = 0; i < 32; ++i) { const int kk = 2 * i + (lane >> 5); const int k = k0 + kk;
        float w = W[(size_t)k * ldw + n0 + (lane & 31)];
        if (g0) w *= (k < gsplit ? g0[k] : g1[k - gsplit]);
        scr[kk * 33 + (lane & 31)] = w; }
    LDS_WAIT(); asm volatile("" ::: "memory");
    const int c = lane & 7;
#pragma unroll
    for (int j = 0; j < 4; ++j) { const int n = (lane >> 3) + 8 * j; const LAS float* s = scr + (8 * c) * 33 + n;
        v4u o; o.x = pk2(s[0 * 33], s[1 * 33]); o.y = pk2(s[2 * 33], s[3 * 33]); o.z = pk2(s[4 * 33], s[5 * 33]); o.w = pk2(s[6 * 33], s[7 * 33]);
        const int src = n0 + n;
        const int dr = MAP == 0 ? map_ident(src) : MAP == 1 ? map_kr(src) : MAP == 2 ? map_uq(src) : map_ukv(src);
        *(v4u*)(WT + (size_t)dr * K + k0 + 8 * c) = o; }
    LDS_WAIT(); asm volatile("" ::: "memory");
}

__device__ __forceinline__ void phase_prep(const Params& P, LAS unsigned char* lds, int vcu, int G, int wave) {
    const int lane = hw_lane(), tid = wave * 64 + lane;
    unsigned char* ws = P.ws;
    LAS float* scr = (LAS float*)(lds + wave * 16384);
    const int gw = vcu * NWAVES + wave, NGW = G * NWAVES;
    const int gt = vcu * NTHREADS + tid, NGT = G * NTHREADS;
#pragma unroll 1
    for (int pi = 0; pi < 3; ++pi) {
        const int part = (pi + wave) % 3;
        if (part == 0) {
    constexpr int I1 = 32 * 128, IKR = 32 * 2, I2Q = 8 * 48, I2KV = 8 * 64, I3 = 32 * 64, I4 = 32 * 64;
    constexpr int NITEMS = I1 + IKR + I2Q + I2KV + I3 + I4;
    for (int it = gw; it < NITEMS; it += NGW) {
        int r = it;
        if (r < I1) { p0_transpose_item<0>(P.w_in, 2048, 4160, 0, nullptr, nullptr, 0, (bf16*)(ws + WS_BT1), scr, r, 128, lane); continue; } r -= I1;
        if (r < IKR) { p0_transpose_item<1>(P.w_in, 2048, 4160, 4096, nullptr, nullptr, 0, (bf16*)(ws + WS_BTKR), scr, r, 2, lane); continue; } r -= IKR;
        if (r < I2Q) { p0_transpose_item<2>(P.w_uq, 512, 1536, 0, P.qan, P.qan, 512, (bf16*)(ws + WS_BT2Q), scr, r, 48, lane); continue; } r -= I2Q;
        if (r < I2KV) { p0_transpose_item<3>(P.w_ukv, 512, 2048, 0, P.kvan, P.kvan, 512, (bf16*)(ws + WS_BT2KV), scr, r, 64, lane); continue; } r -= I2KV;
        if (r < I3) { p0_transpose_item<0>(P.w_o, 2048, 2048, 0, P.ond, P.onm, 1024, (bf16*)(ws + WS_BT3), scr, r, 64, lane); continue; } r -= I3;
        p0_transpose_item<0>(P.wq, 2048, 2048, 0, P.ln2, P.ln2, 2048, (bf16*)(ws + WS_BT4), scr, r, 64, lane);
    }
        } else if (part == 1) {
    {
        bf16* XN = (bf16*)(ws + WS_A);
        f32x4 gv[8];
#pragma unroll
        for (int j = 0; j < 8; ++j) gv[j] = ((const f32x4*)P.ln1)[lane + 64 * j];
        for (int m = gw; m < M; m += NGW) {
            const f32x4* xr = (const f32x4*)(P.x + (size_t)m * DM) + lane;
            f32x4 v[8]; float s = 0.f;
#pragma unroll
            for (int j = 0; j < 8; ++j) { v[j] = xr[64 * j]; s += (v[j].x * v[j].x + v[j].y * v[j].y) + (v[j].z * v[j].z + v[j].w * v[j].w); }
            const float rs = rsqrtf(wave_sum(s) * (1.f / DM) + EPS);
            v2u* o8 = (v2u*)(XN + (size_t)m * DM) + lane;
#pragma unroll
            for (int j = 0; j < 8; ++j) { v2u o; o.x = pk2(v[j].x * rs * gv[j].x, v[j].y * rs * gv[j].y); o.y = pk2(v[j].z * rs * gv[j].z, v[j].w * rs * gv[j].w); o8[64 * j] = o; }
        }
    }
        } else {
        v2u* ou = (v2u*)(ws + WS_UB);
#pragma unroll 4
        for (int i = gt; i < 16384 * 2048 / 8; i += NGT) {
            const f32x4 a = __builtin_nontemporal_load((const f32x4*)P.pu + 2 * i), b = __builtin_nontemporal_load((const f32x4*)P.pu + 2 * i + 1);
            const int k8 = (i & 255) * 2; const f32x4 g0 = ((const f32x4*)P.ln2)[k8] * 32.f, g1 = ((const f32x4*)P.ln2)[k8 + 1] * 32.f;
            int w0 = 0, w1 = 0;
            w0 = __builtin_amdgcn_cvt_pk_fp8_f32(a.x * g0.x, a.y * g0.y, w0, false); w0 = __builtin_amdgcn_cvt_pk_fp8_f32(a.z * g0.z, a.w * g0.w, w0, true);
            w1 = __builtin_amdgcn_cvt_pk_fp8_f32(b.x * g1.x, b.y * g1.y, w1, false); w1 = __builtin_amdgcn_cvt_pk_fp8_f32(b.z * g1.z, b.w * g1.w, w1, true);
            v2u w; w.x = (unsigned)w0; w.y = (unsigned)w1; ou[i] = w;
        }
        }
    }
    {
        f32x2* R = (f32x2*)(ws + WS_ROPE);
        for (int i = gt; i < 2048 * 32; i += NGT) { const int pos = i >> 5, j = i & 31; const float freq = powf(10000.0f, -(float)j / 32.0f), ang = (float)pos * freq;
            f32x2 cs; cs.x = cosf(ang); cs.y = sinf(ang); R[i] = cs; }
    }
    {
        v4u* o = (v4u*)(ws + WS_SK);
        for (int i = gt; i < 16 * 128 * 128 / 8; i += NGT) { const f32x4 a = ((const f32x4*)P.sk)[2 * i], b = ((const f32x4*)P.sk)[2 * i + 1];
            v4u w; w.x = pk2(a.x, a.y); w.y = pk2(a.z, a.w); w.z = pk2(b.x, b.y); w.w = pk2(b.z, b.w); o[i] = w; }
    }
    {
        __syncthreads();
        LAS v2u* tl = (LAS v2u*)lds;
        v2u* ov = (v2u*)(ws + WS_VB);
        for (int tile = vcu; tile < 1024; tile += G) {
            const int e0 = (tile >> 2) * 64, c0 = (tile & 3) * 64;
#pragma unroll
            for (int k = 0; k < 8; ++k) { const int it = tid + 512 * k, e = it >> 6, c = it & 63;
                const f32x4* src = (const f32x4*)(P.pv + (size_t)(e0 + e) * 2048 + (size_t)(c0 + c) * 8);
                const f32x4 a = __builtin_nontemporal_load(src), b = __builtin_nontemporal_load(src + 1);
                int w0 = 0, w1 = 0;
                w0 = __builtin_amdgcn_cvt_pk_fp8_f32(a.x * 2.f, a.y * 2.f, w0, false); w0 = __builtin_amdgcn_cvt_pk_fp8_f32(a.z * 2.f, a.w * 2.f, w0, true);
                w1 = __builtin_amdgcn_cvt_pk_fp8_f32(b.x * 2.f, b.y * 2.f, w1, false); w1 = __builtin_amdgcn_cvt_pk_fp8_f32(b.z * 2.f, b.w * 2.f, w1, true);
                v2u w; w.x = (unsigned)w0; w.y = (unsigned)w1; tl[c * 65 + e] = w; }
            __syncthreads();
#pragma unroll
            for (int k = 0; k < 8; ++k) { const int it = tid + 512 * k, c = it >> 6, e = it & 63; ov[(size_t)(c0 + c) * 16384 + e0 + e] = tl[c * 65 + e]; }
            __syncthreads();
        }
    }
}
namespace pg8 {
constexpr int BM = 256, BK = 64, HALF = 128, HTB = HALF * BK * 2, STAGE_BYTES = 8 * HTB, NXCD = 8, WGM = 8;
__host__ __device__ __forceinline__ int lds_byte(int r, int c) { const int st = (r >> 4) * 2 + (c >> 5), rr = r & 15, cc = c & 31, ob = rr * 64 + cc * 2; return st * 1024 + (ob ^ (((ob >> 9) & 1) << 5)); }
__host__ __device__ __forceinline__ void stage_rc(int b, int& R, int& C) { const int st = b / 1024, sb = b % 1024, swz = sb ^ (((sb >> 9) & 1) << 5); R = (st >> 1) * 16 + swz / 64; C = (st & 1) * 32 + (swz % 64) / 2; }
__host__ __device__ __forceinline__ int perm32(int rho) { const int n = rho >> 4, i = rho & 15; return 8 * (i >> 2) + 4 * n + (i & 3); }

struct Unit { int pm, pn, g; };
struct GemmSet { const bf16 *A0, *A1, *Bt0, *Bt1; int K; };

struct StaticOrder {
    int nM, nN0, nN, nwg, G, c;
    __device__ void init(int Mrows, int N0, int N1, int G_, int c_) { nM = Mrows / BM; nN0 = N0 / BM; nN = nN0 + N1 / BM; nwg = nM * nN; G = G_; c = c_; }
    __device__ bool next(int i, Unit& u) const {
        const long L = (long)i * G + c; if (L >= nwg) return false;
        int wgid = (int)L; { const int q = nwg / NXCD, r = nwg % NXCD, xcd = wgid % NXCD, off = wgid / NXCD; wgid = (xcd < r ? xcd * (q + 1) : r * (q + 1) + (xcd - r) * q) + off; }
        const int nig = WGM * nN, gid = wgid / nig, fm = gid * WGM, gsz = (nM - fm) < WGM ? (nM - fm) : WGM;
        u.pm = fm + ((wgid % nig) % gsz); int pn = (wgid % nig) / gsz; u.g = pn >= nN0 ? 1 : 0; u.pn = pn >= nN0 ? pn - nN0 : pn; return true;
    }
};

template <class Epi, class Sched>
__device__ __forceinline__ void gemm_phase(LAS unsigned char* lds, const GemmSet g, const Sched& S, const Epi& E, int wid) {
    const int lane = hw_lane(), tid = wid * 64 + lane, wr = wid >> 2, wc = wid & 3, fr = lane & 15, fq = lane >> 4;
    const int K = g.K, nt = K / BK;
    unsigned voffA[2], voffB[2];
#pragma unroll
    for (int i = 0; i < 2; ++i) { int R, C; stage_rc(tid * 16 + i * 8192, R, C); const int Rb = (R & ~31) + perm32(R & 31);
        voffA[i] = (unsigned)(R * K + C) * 2u; voffB[i] = (unsigned)(Rb * K + C) * 2u; }
    const size_t kstep = (size_t)(BK * 2);
    const size_t hstep = (size_t)HALF * K * 2;
    const size_t tstep = 2 * hstep;
    const unsigned ldsw = (unsigned)wid * 1024u;
    const int aoff = lds_byte(wr * 64 + fr, fq * 8), boff = lds_byte(wc * 32 + fr, fq * 8);
#define PG8_SA(b, h) (((b) * 2 + (h)) * HTB)
#define PG8_SB(b, h) ((4 + (b) * 2 + (h)) * HTB)
#define PG8_STAGE(bufoff, gbase, voff) do { _Pragma("unroll") for (int _i = 0; _i < 2; ++_i) \
        __builtin_amdgcn_global_load_lds((const unsigned*)((const char*)(gbase) + (voff)[_i]), (LAS unsigned*)(lds + (bufoff) + ldsw + _i * 8192), 16, 0, 0); } while (0)
#define PG8_LDA(dst, b, h) do { _Pragma("unroll") for (int m = 0; m < 4; ++m) _Pragma("unroll") for (int k = 0; k < 2; ++k) dst[m][k] = *(const LAS bf16x8*)(lds + PG8_SA(b, h) + aoff + m * 2048 + k * 1024); } while (0)
#define PG8_LDB(dst, b, h) do { _Pragma("unroll") for (int n = 0; n < 2; ++n) _Pragma("unroll") for (int k = 0; k < 2; ++k) dst[n][k] = *(const LAS bf16x8*)(lds + PG8_SB(b, h) + boff + n * 2048 + k * 1024); } while (0)
#define PG8_MMA(ai, bj, At, Bt) do { __builtin_amdgcn_s_setprio(1); _Pragma("unroll") for (int m = 0; m < 4; ++m) _Pragma("unroll") for (int n = 0; n < 2; ++n) _Pragma("unroll") for (int k = 0; k < 2; ++k) \
        acc[ai][bj][m][n] = __builtin_amdgcn_mfma_f32_16x16x32_bf16(Bt[n][k], At[m][k], acc[ai][bj][m][n], 0, 0, 0); __builtin_amdgcn_s_setprio(0); } while (0)
#define PG8_WAIT_V(n) asm volatile("s_waitcnt vmcnt(" #n ")" ::: "memory")
#define PG8_WAIT_L(n) asm volatile("s_waitcnt lgkmcnt(" #n ")" ::: "memory")
#define PG8_BAR __builtin_amdgcn_s_barrier()
#define PG8_SCHED __builtin_amdgcn_sched_barrier(0)
    Unit cur, nxt; int ui = 0;
    if (!S.next(0, cur)) return;
    f32x4 acc[2][2][4][2];
#pragma unroll
    for (int a = 0; a < 2; ++a)
#pragma unroll
        for (int b = 0; b < 2; ++b)
#pragma unroll
            for (int m = 0; m < 4; ++m)
#pragma unroll
                for (int n = 0; n < 2; ++n) acc[a][b][m][n] = (f32x4){0.f, 0.f, 0.f, 0.f};
    bf16x8 At[4][2], B0[2][2], B1[2][2];
    const char* cA = (const char*)(cur.g ? g.A1 : g.A0) + (size_t)cur.pm * tstep; const char* cB = (const char*)(cur.g ? g.Bt1 : g.Bt0) + (size_t)cur.pn * tstep;
    E.unit_begin(cur, 0, tid);
    PG8_STAGE(PG8_SB(0, 0), cB, voffB); PG8_STAGE(PG8_SB(0, 1), cB + hstep, voffB); PG8_STAGE(PG8_SA(0, 0), cA, voffA); PG8_STAGE(PG8_SA(0, 1), cA + hstep, voffA);
    if (wr == 1) PG8_BAR;
    PG8_WAIT_V(2); PG8_BAR;
    PG8_STAGE(PG8_SB(1, 0), cB + kstep, voffB); PG8_STAGE(PG8_SA(1, 0), cA + kstep, voffA); PG8_STAGE(PG8_SB(1, 1), cB + hstep + kstep, voffB);
    PG8_WAIT_V(6); PG8_BAR;
    for (;;) {
        const bool has_next = S.next(ui + 1, nxt);
        const char* nA = has_next ? (const char*)(nxt.g ? g.A1 : g.A0) + (size_t)nxt.pm * tstep : cA; const char* nB = has_next ? (const char*)(nxt.g ? g.Bt1 : g.Bt0) + (size_t)nxt.pn * tstep : cB;
        for (int t = 0; t < nt; t += 2) {
            const bool last = (t == nt - 2);
            const char* a1 = cA + (size_t)(t + 1) * kstep;
            const char* a2 = last ? nA : cA + (size_t)(t + 2) * kstep; const char* b2 = last ? nB : cB + (size_t)(t + 2) * kstep;
            const char* a3 = a2 + kstep; const char* b3 = b2 + kstep;
            if constexpr (Epi::MIDSCALE) { if (t == nt / 2) E.midscale(acc, ui & 1, wr, fr); }
            PG8_LDB(B0, 0, 0); PG8_LDB(B1, 0, 1); PG8_SCHED; PG8_LDA(At, 0, 0); PG8_STAGE(PG8_SA(1, 1), a1 + hstep, voffA);
            PG8_WAIT_V(8); PG8_WAIT_L(0); PG8_BAR; PG8_MMA(0, 0, At, B0); PG8_MMA(0, 1, At, B1); PG8_BAR; PG8_SCHED;
            PG8_LDA(At, 0, 1); PG8_STAGE(PG8_SB(0, 0), b2, voffB); PG8_STAGE(PG8_SB(0, 1), b2 + hstep, voffB); PG8_STAGE(PG8_SA(0, 0), a2, voffA);
            PG8_WAIT_V(8); PG8_WAIT_L(0); PG8_BAR; PG8_MMA(1, 0, At, B0); PG8_MMA(1, 1, At, B1); PG8_BAR; PG8_SCHED;
            PG8_LDB(B0, 1, 0); PG8_LDB(B1, 1, 1); PG8_SCHED; PG8_LDA(At, 1, 0); PG8_STAGE(PG8_SA(0, 1), a2 + hstep, voffA);
            PG8_WAIT_V(8); PG8_WAIT_L(0); PG8_BAR; PG8_MMA(0, 0, At, B0); PG8_MMA(0, 1, At, B1); PG8_BAR; PG8_SCHED;
            PG8_LDA(At, 1, 1); PG8_STAGE(PG8_SB(1, 0), b3, voffB); PG8_STAGE(PG8_SB(1, 1), b3 + hstep, voffB); PG8_STAGE(PG8_SA(1, 0), a3, voffA);
            PG8_WAIT_V(8); PG8_WAIT_L(0); PG8_BAR; PG8_MMA(1, 0, At, B0); PG8_MMA(1, 1, At, B1); PG8_BAR; PG8_SCHED;
        }
        if (wr == 0) PG8_BAR;
        E(acc, cur, ui & 1, wr, wc, fr, fq);
        if (!has_next) break;
#pragma unroll
        for (int a = 0; a < 2; ++a)
#pragma unroll
            for (int b = 0; b < 2; ++b)
#pragma unroll
                for (int m = 0; m < 4; ++m)
#pragma unroll
                    for (int n = 0; n < 2; ++n) acc[a][b][m][n] = (f32x4){0.f, 0.f, 0.f, 0.f};
        cur = nxt; cA = nA; cB = nB; ++ui;
        E.unit_begin(cur, ui & 1, tid);
        if (wr == 1) PG8_BAR;
    }
    PG8_WAIT_V(0);
    PG8_BAR;
#undef PG8_SA
#undef PG8_SB
#undef PG8_STAGE
#undef PG8_LDA
#undef PG8_LDB
#undef PG8_MMA
#undef PG8_WAIT_V
#undef PG8_WAIT_L
#undef PG8_BAR
#undef PG8_SCHED
}
}
namespace pg8 {
__device__ __forceinline__ v4u pack8(const f32x4& v0, const f32x4& v1) { v4u w; w.x = pk2(v0[0], v0[1]); w.y = pk2(v0[2], v0[3]); w.z = pk2(v1[0], v1[1]); w.w = pk2(v1[2], v1[3]); return w; }
__device__ __forceinline__ float sq8(const f32x4& v0, const f32x4& v1) { return (v0[0] * v0[0] + v0[1] * v0[1]) + (v0[2] * v0[2] + v0[3] * v0[3]) + (v1[0] * v1[0] + v1[1] * v1[1]) + (v1[2] * v1[2] + v1[3] * v1[3]); }

struct Epi1 {
    static constexpr bool MIDSCALE = false;
    bf16 *QKV, *CQ, *CKV; float *SSQCQ, *SSQCKV;
    __device__ __forceinline__ void midscale(f32x4 (&)[2][2][4][2], int, int, int) const {}
    __device__ __forceinline__ void unit_begin(const Unit&, int, int) const {}
    __device__ __forceinline__ void operator()(const f32x4 (&acc)[2][2][4][2], const Unit& u, int par, int wr, int wc, int fr, int fq) const {
        const int pn = u.pn; bf16* base; int ldc, colt; float sc = 1.f; float* ssq = nullptr; int sslot = 0;
        if (pn < 12) { base = QKV; ldc = 3072; colt = pn * 256; if (pn < 4) sc = QSCALE_DIL; }
        else if (pn < 14) { base = CQ; ldc = 512; colt = (pn - 12) * 256; ssq = SSQCQ; sslot = (pn - 12) * 4 + wc; }
        else { base = CKV; ldc = 512; colt = (pn - 14) * 256; ssq = SSQCKV; sslot = (pn - 14) * 4 + wc; }
        const int row0 = u.pm * BM + wr * 64 + fr, col0 = colt + wc * 32 + 8 * fq;
#pragma unroll
        for (int ai = 0; ai < 2; ++ai)
#pragma unroll
            for (int m = 0; m < 4; ++m) { const int row = row0 + ai * HALF + m * 16; bf16* rowp = base + (size_t)row * ldc + col0; float ss = 0.f;
#pragma unroll
                for (int bj = 0; bj < 2; ++bj) { const f32x4 v0 = acc[ai][bj][m][0] * sc, v1 = acc[ai][bj][m][1] * sc; ss += sq8(v0, v1); *(v4u*)(rowp + bj * HALF) = pack8(v0, v1); }
                if (ssq) { ss += __shfl_xor(ss, 16); ss += __shfl_xor(ss, 32); if (fq == 0) ssq[(size_t)row * 8 + sslot] = ss; } }
    }
};

struct Epi2 {
    static constexpr bool MIDSCALE = false;
    bf16 *QN, *QPE, *KN, *VM; const float *SSQCQ, *SSQCKV; const f32x2* ROPE;
    __device__ __forceinline__ void midscale(f32x4 (&)[2][2][4][2], int, int, int) const {}
    __device__ __forceinline__ void unit_begin(const Unit&, int, int) const {}
    __device__ __forceinline__ void operator()(const f32x4 (&acc)[2][2][4][2], const Unit& u, int par, int wr, int wc, int fr, int fq) const {
        const int pn = u.pn; bf16* base; int ldc, colt; float sc = 1.f; bool rope = false; const float* ssq;
        if (u.g == 0) { ssq = SSQCQ; sc = QSCALE_MLA; if (pn < 4) { base = QN; ldc = 1024; colt = pn * 256; } else { base = QPE; ldc = 512; colt = (pn - 4) * 256; rope = true; } }
        else { ssq = SSQCKV; if (pn < 4) { base = KN; ldc = 1024; colt = pn * 256; } else { base = VM; ldc = 1024; colt = (pn - 4) * 256; } }
        const int row0 = u.pm * BM + wr * 64 + fr, col0 = colt + wc * 32 + 8 * fq;
#pragma unroll
        for (int ai = 0; ai < 2; ++ai)
#pragma unroll
            for (int m = 0; m < 4; ++m) { const int row = row0 + ai * HALF + m * 16; bf16* rowp = base + (size_t)row * ldc + col0;
                const f32x4 p0 = *(const f32x4*)(ssq + (size_t)row * 8), p1 = *(const f32x4*)(ssq + (size_t)row * 8 + 4);
                const float rs = rsqrtf(((p0[0] + p0[1]) + (p0[2] + p0[3]) + (p1[0] + p1[1]) + (p1[2] + p1[3])) * (1.f / 512.f) + EPS) * sc;
#pragma unroll
                for (int bj = 0; bj < 2; ++bj) { f32x4 v0 = acc[ai][bj][m][0] * rs, v1 = acc[ai][bj][m][1] * rs;
                    if (rope) { const int j0 = ((col0 + bj * HALF) & 63) >> 1; const f32x4* rp = (const f32x4*)(ROPE + (size_t)(row & (SEQ - 1)) * 32 + j0);
                        const f32x4 r0 = rp[0], r1 = rp[1];
                        f32x4 w0, w1;
                        w0[0] = v0[0] * r0[0] - v0[1] * r0[1]; w0[1] = v0[0] * r0[1] + v0[1] * r0[0];
                        w0[2] = v0[2] * r0[2] - v0[3] * r0[3]; w0[3] = v0[2] * r0[3] + v0[3] * r0[2];
                        w1[0] = v1[0] * r1[0] - v1[1] * r1[1]; w1[1] = v1[0] * r1[1] + v1[1] * r1[0];
                        w1[2] = v1[2] * r1[2] - v1[3] * r1[3]; w1[3] = v1[2] * r1[3] + v1[3] * r1[2];
                        v0 = w0; v1 = w1; }
                    *(v4u*)(rowp + bj * HALF) = pack8(v0, v1); } }
    }
};

struct Epi3 {
    static constexpr bool MIDSCALE = true;
    bf16* H1B; const float* X; const float* SSQO; float* SSQH; LAS f32x2* RS;
    __device__ __forceinline__ void unit_begin(const Unit& u, int par, int tid) const {
        if (tid < 256) { const f32x4* p = (const f32x4*)(SSQO + (size_t)(u.pm * BM + tid) * 16); const f32x4 a0 = p[0], a1 = p[1], b0 = p[2], b1 = p[3];
            const float ra = rsqrtf(((a0[0] + a0[1]) + (a0[2] + a0[3]) + (a1[0] + a1[1]) + (a1[2] + a1[3])) * (1.f / 1024.f) + EPS);
            const float rb = rsqrtf(((b0[0] + b0[1]) + (b0[2] + b0[3]) + (b1[0] + b1[1]) + (b1[2] + b1[3])) * (1.f / 1024.f) + EPS);
            f32x2 v; v.x = ra / rb; v.y = rb; RS[par * 256 + tid] = v; }
    }
    __device__ __forceinline__ void midscale(f32x4 (&acc)[2][2][4][2], int par, int wr, int fr) const {
#pragma unroll
        for (int ai = 0; ai < 2; ++ai)
#pragma unroll
            for (int m = 0; m < 4; ++m) { const float f = RS[par * 256 + ai * HALF + wr * 64 + m * 16 + fr].x;
#pragma unroll
                for (int bj = 0; bj < 2; ++bj) { acc[ai][bj][m][0] = acc[ai][bj][m][0] * f; acc[ai][bj][m][1] = acc[ai][bj][m][1] * f; } }
    }
    __device__ __forceinline__ void operator()(const f32x4 (&acc)[2][2][4][2], const Unit& u, int par, int wr, int wc, int fr, int fq) const {
        const int row0 = u.pm * BM + wr * 64 + fr, col0 = u.pn * BM + wc * 32 + 8 * fq, sslot = u.pn * 4 + wc;
#pragma unroll
        for (int ai = 0; ai < 2; ++ai)
#pragma unroll
            for (int m = 0; m < 4; ++m) { const int row = row0 + ai * HALF + m * 16; const float rb = RS[par * 256 + ai * HALF + wr * 64 + m * 16 + fr].y; float ss = 0.f;
#pragma unroll
                for (int bj = 0; bj < 2; ++bj) { const float* xp = X + (size_t)row * DM + col0 + bj * HALF; const f32x4 x0 = *(const f32x4*)xp, x1 = *(const f32x4*)(xp + 4);
                    const f32x4 v0 = acc[ai][bj][m][0] * rb + x0, v1 = acc[ai][bj][m][1] * rb + x1; ss += sq8(v0, v1);
                    *(v4u*)(H1B + (size_t)row * DM + col0 + bj * HALF) = pack8(v0, v1); }
                ss += __shfl_xor(ss, 16); ss += __shfl_xor(ss, 32); if (fq == 0) SSQH[(size_t)row * 32 + sslot] = ss; }
    }
};

struct Epi4 {
    static constexpr bool MIDSCALE = false;
    bf16* QP;
    __device__ __forceinline__ void midscale(f32x4 (&)[2][2][4][2], int, int, int) const {}
    __device__ __forceinline__ void unit_begin(const Unit&, int, int) const {}
    __device__ __forceinline__ void operator()(const f32x4 (&acc)[2][2][4][2], const Unit& u, int par, int wr, int wc, int fr, int fq) const {
        const int row0 = u.pm * BM + wr * 64 + fr, col0 = u.pn * BM + wc * 32 + 8 * fq;
#pragma unroll
        for (int ai = 0; ai < 2; ++ai)
#pragma unroll
            for (int m = 0; m < 4; ++m) { const int row = row0 + ai * HALF + m * 16;
#pragma unroll
                for (int bj = 0; bj < 2; ++bj) *(v4u*)(QP + (size_t)row * DM + col0 + bj * HALF) = pack8(acc[ai][bj][m][0], acc[ai][bj][m][1]); }
    }
};
}

__device__ __forceinline__ void kr_item(const bf16* __restrict__ XN, const bf16* __restrict__ BT, const f32x2* __restrict__ ROPE, bf16* __restrict__ KPE, int item, int wave, int lane) {
    const int fr = lane & 15, fq = lane >> 4, row = item * 128 + wave * 16 + fr;
    const bf16* ap = XN + (size_t)row * 2048 + fq * 8; const bf16* bp = BT + (size_t)fr * 2048 + fq * 8;
    f32x4 acc[4];
#pragma unroll
    for (int nb = 0; nb < 4; ++nb) acc[nb] = (f32x4){0.f, 0.f, 0.f, 0.f};
#pragma unroll 4
    for (int k0 = 0; k0 < 2048; k0 += 32) {
        const bf16x8 a = *(const bf16x8*)(ap + k0);
#pragma unroll
        for (int nb = 0; nb < 4; ++nb) { const bf16x8 b = *(const bf16x8*)(bp + (size_t)nb * 16 * 2048 + k0); acc[nb] = __builtin_amdgcn_mfma_f32_16x16x32_bf16(b, a, acc[nb], 0, 0, 0); }
    }
    const int pos = row & (SEQ - 1);
#pragma unroll
    for (int nb = 0; nb < 4; ++nb) { const int j0 = 8 * nb + 2 * fq; const f32x4 r = *(const f32x4*)(ROPE + (size_t)pos * 32 + j0); const f32x4 v = acc[nb];
        v2u o; o.x = pk2(v[0] * r[0] - v[1] * r[1], v[0] * r[1] + v[1] * r[0]); o.y = pk2(v[2] * r[2] - v[3] * r[3], v[2] * r[3] + v[3] * r[2]);
        *(v2u*)(KPE + (size_t)row * 64 + 16 * nb + 4 * fq) = o; }
}
namespace att {
typedef short v4i16_t __attribute__((ext_vector_type(4)));
#define MFMA32(a, b, c) __builtin_amdgcn_mfma_f32_32x32x16_bf16((a), (b), (c), 0, 0, 0)
__device__ __forceinline__ s16x4 vtr(const LAS unsigned char* p) { return __builtin_bit_cast(s16x4, __builtin_amdgcn_ds_read_tr16_b64_v4i16((LAS v4i16_t*)p)); }
__device__ __forceinline__ int crow(int r, int hi) { return (r & 3) + 8 * (r >> 2) + 4 * hi; }
constexpr int VS = 320;
constexpr int KS = 400;
constexpr float NEG = -1e30f;

__device__ __forceinline__ bf16x8 pack8r(const f32x16& p, int s) {
    v4u w; w.x = pk2(p[8 * s + 0], p[8 * s + 1]); w.y = pk2(p[8 * s + 2], p[8 * s + 3]); w.z = pk2(p[8 * s + 4], p[8 * s + 5]); w.w = pk2(p[8 * s + 6], p[8 * s + 7]);
    return __builtin_bit_cast(bf16x8, w);
}
__device__ __forceinline__ void pv32(f32x16 (&o)[4], const LAS unsigned char* vb, const bf16x8 pb0, const bf16x8 pb1) {
#pragma unroll
    for (int d = 0; d < 4; ++d) {
        const s16x4 l0 = vtr(vb + d * 64), h0 = vtr(vb + d * 64 + 8 * VS), l1 = vtr(vb + d * 64 + 16 * VS), h1 = vtr(vb + d * 64 + 24 * VS);
        const bf16x8 a0 = __builtin_shufflevector(l0, h0, 0, 1, 2, 3, 4, 5, 6, 7), a1 = __builtin_shufflevector(l1, h1, 0, 1, 2, 3, 4, 5, 6, 7);
        o[d] = MFMA32(a0, pb0, o[d]); o[d] = MFMA32(a1, pb1, o[d]);
    }
}
template <int NS>
__device__ __forceinline__ void softmax_step(f32x16 (&s)[NS], float& m, float& l, f32x16 (&o)[4], bf16x8 (&pb)[2 * NS]) {
    float mx = s[0][0];
#pragma unroll
    for (int t = 0; t < NS; ++t)
#pragma unroll
        for (int r = 0; r < 16; ++r) mx = fmaxf(mx, s[t][r]);
    mx = fmaxf(mx, __shfl_xor(mx, 32));
    const float mn = fmaxf(m, mx), alpha = __builtin_amdgcn_exp2f(m - mn); m = mn;
    float ps = 0.f;
#pragma unroll
    for (int t = 0; t < NS; ++t)
#pragma unroll
        for (int r = 0; r < 16; ++r) { const float p = __builtin_amdgcn_exp2f(s[t][r] - mn); s[t][r] = p; ps += p; }
    l = l * alpha + ps;
    if (!__all(alpha == 1.0f)) {
#pragma unroll
        for (int d = 0; d < 4; ++d) o[d] = o[d] * alpha;
    }
#pragma unroll
    for (int t = 0; t < NS; ++t) { pb[2 * t] = pack8r(s[t], 0); pb[2 * t + 1] = pack8r(s[t], 1); }
}
__device__ __forceinline__ void store_o(f32x16 (&o)[4], float l, bf16* __restrict__ orow  , float* __restrict__ ssq  , int hh) {
    l += __shfl_xor(l, 32);
    const float inv = 1.0f / l; float ss = 0.f;
#pragma unroll
    for (int d = 0; d < 4; ++d) { o[d] = o[d] * inv;
#pragma unroll
        for (int g = 0; g < 4; ++g) { const float a = o[d][4 * g], b = o[d][4 * g + 1], c = o[d][4 * g + 2], e = o[d][4 * g + 3];
            ss += (a * a + b * b) + (c * c + e * e);
            v2u w; w.x = pk2(a, b); w.y = pk2(c, e); *(v2u*)(orow + 32 * d + 8 * g + 4 * hh) = w; } }
    ss += __shfl_xor(ss, 32);
    if (hh == 0) *ssq = ss;
}

constexpr int KTB = 64 * KS, VTB = 64 * VS, BUFB = KTB + VTB;
__device__ __forceinline__ void mla_unit(const unsigned char* ws, LAS unsigned char* lds, int b, int h, int qblk, int tid, int wave, int lane) {
    const bf16* QN = (const bf16*)(ws + WS_QN); const bf16* QPE = (const bf16*)(ws + WS_QPE);
    bf16* O = (bf16*)(ws + WS_A); float* SSQO = (float*)(ws + WS_SSQO);
    const int r32 = lane & 31, hh = lane >> 5;
    const size_t tok0 = (size_t)b * SEQ;
    const int row_lo = qblk * 256 + wave * 32, qrow = row_lo + r32;
    bf16x8 qf[12];
    { const bf16* qn = QN + (tok0 + qrow) * 1024 + h * 128 + 8 * hh;
#pragma unroll
      for (int s = 0; s < 8; ++s) qf[s] = *(const bf16x8*)(qn + 16 * s);
      const bf16* qp = QPE + (tok0 + qrow) * 512 + h * 64 + 8 * hh;
#pragma unroll
      for (int s = 0; s < 4; ++s) qf[8 + s] = *(const bf16x8*)(qp + 16 * s); }
    const int c0 = tid, c1 = tid + 512;
    const unsigned okn0 = (unsigned)WS_KN + (unsigned)(((unsigned)tok0 + (c0 >> 4)) * 1024u + h * 128 + (c0 & 15) * 8) * 2u, okn1 = okn0 + 32u * 1024u * 2u;
    const unsigned okp = (unsigned)WS_KPE + (unsigned)(((unsigned)tok0 + (tid >> 3)) * 64u + (tid & 7) * 8) * 2u;
    const unsigned ov0 = okn0 + (unsigned)(WS_VM - WS_KN), ov1 = ov0 + 32u * 1024u * 2u;
    const int lkn0 = (c0 >> 4) * KS + (c0 & 15) * 16, lkn1 = (c1 >> 4) * KS + (c1 & 15) * 16, lkp = (tid >> 3) * KS + 256 + (tid & 7) * 16;
    const int lv0 = KTB + (c0 >> 4) * VS + (c0 & 15) * 16, lv1 = KTB + (c1 >> 4) * VS + (c1 & 15) * 16;
    v4u st0, st1, st2, st3, st4;
#define MLA_GLOAD(kt) do { const unsigned _o = (unsigned)(kt) * 131072u, _p = (unsigned)(kt) * 8192u; st0 = *(const v4u*)(ws + (size_t)(okn0 + _o)); st1 = *(const v4u*)(ws + (size_t)(okn1 + _o)); \
        st2 = *(const v4u*)(ws + (size_t)(okp + _p)); st3 = *(const v4u*)(ws + (size_t)(ov0 + _o)); st4 = *(const v4u*)(ws + (size_t)(ov1 + _o)); } while (0)
#define MLA_LWRITE(buf) do { LAS unsigned char* _b = lds + (buf) * BUFB; *(LAS v4u*)(_b + lkn0) = st0; *(LAS v4u*)(_b + lkn1) = st1; *(LAS v4u*)(_b + lkp) = st2; \
        *(LAS v4u*)(_b + lv0) = st3; *(LAS v4u*)(_b + lv1) = st4; } while (0)
    const int nkt = 4 * (qblk + 1);
    MLA_GLOAD(0); MLA_LWRITE(0);
    __syncthreads();
    f32x16 o[4];
#pragma unroll
    for (int d = 0; d < 4; ++d)
#pragma unroll
        for (int r = 0; r < 16; ++r) o[d][r] = 0.f;
    float m = NEG, l = 0.f;
    const int kread = r32 * KS + 16 * hh;
    const int vread = KTB + (4 * hh + ((lane & 15) >> 2)) * VS + (16 * ((lane >> 4) & 1) + 4 * (lane & 3)) * 2;
    for (int kt = 0; kt < nkt; ++kt) {
        if (kt + 1 < nkt) MLA_GLOAD(kt + 1);
        const int k0 = kt * 64;
        if (k0 <= row_lo + 31) {
            const LAS unsigned char* kb = lds + (kt & 1) * BUFB;
            const bool diag = (k0 + 63 > row_lo);
#pragma unroll
            for (int sub = 0; sub < 2; ++sub) {
                if (sub == 1 && k0 + 32 > row_lo + 31) break;
                f32x16 s[1];
#pragma unroll
                for (int r = 0; r < 16; ++r) s[0][r] = 0.f;
#pragma unroll
                for (int ks = 0; ks < 12; ++ks) { const bf16x8 kf = *(const LAS bf16x8*)(kb + kread + sub * 32 * KS + 32 * ks); s[0] = MFMA32(kf, qf[ks], s[0]); }
                if (diag) {
#pragma unroll
                    for (int r = 0; r < 16; ++r) { const int key = k0 + 32 * sub + crow(r, hh); if (key > qrow) s[0][r] = NEG; }
                }
                bf16x8 pb[2];
                softmax_step<1>(s, m, l, o, pb);
                pv32(o, kb + vread + sub * 32 * VS, pb[0], pb[1]);
            }
        }
        if (kt + 1 < nkt) MLA_LWRITE((kt + 1) & 1);
        __syncthreads();
    }
#undef MLA_GLOAD
#undef MLA_LWRITE
    store_o(o, l, O + (tok0 + qrow) * 2048 + 1024 + h * 128, SSQO + (tok0 + qrow) * 16 + 8 + h, hh);
}

constexpr int DKS = 272, DSH = 32 * DKS + 32 * VS;
__device__ __forceinline__ void dil_tile(const unsigned char* ws, LAS unsigned char* vl  , LAS unsigned char* sh  , int b, int h, int j, int r16, int tid, int lane) {
    const bf16* QKV = (const bf16*)(ws + WS_B);
    const int r32 = lane & 31, hh = lane >> 5;
    const size_t tok0 = (size_t)b * SEQ;
    const int tq = 512 * j + 16 * r32 + r16;
    bf16x8 qf[8];
    { const bf16* qp = QKV + (tok0 + tq) * 3072 + h * 128 + 8 * hh;
#pragma unroll
      for (int s = 0; s < 8; ++s) qf[s] = *(const bf16x8*)(qp + 16 * s); }
    const float slope2 = __builtin_amdgcn_exp2f(-(float)(h + 1)) * LOG2E;
    const int m0 = (j == 0) ? 4 : 0, n3 = j + 1, n2 = 8 - m0, n1 = 20 - m0, nt = n3 + n2;
    const unsigned kcol = (unsigned)WS_B + ((unsigned)tok0 * 3072u + 1024u + h * 128 + 8 * hh) * 2u;
    const unsigned vcol = (unsigned)WS_B + ((unsigned)tok0 * 3072u + 2048u + h * 128 + (lane & 15) * 8) * 2u;
    const int vrow = lane >> 4;
    const int vwr = vrow * VS + (lane & 15) * 16;
    const int vread = (4 * hh + ((lane & 15) >> 2)) * VS + (16 * ((lane >> 4) & 1) + 4 * (lane & 3)) * 2;
    int kbase, kstride, maxd;
#define DIL_DESC(idx) do { const int _i = (idx); if (_i < n3) { kbase = 512 * (j - _i) + r16; kstride = 16; maxd = 2048; } \
        else if (_i < n3 + n2) { kbase = 4 * (128 * j - 128 + 32 * (m0 + _i - n3)) + (r16 & 3); kstride = 4; maxd = 512; } \
        else { kbase = 512 * j - 128 + 32 * (m0 + _i - n3 - n2); kstride = 1; maxd = 128; } } while (0)
    bf16x8 kc[8]; v4u vn[8];
    DIL_DESC(0);
    { const unsigned kp = kcol + (unsigned)(kbase + kstride * r32) * 6144u;
#pragma unroll
      for (int s = 0; s < 8; ++s) kc[s] = *(const bf16x8*)(ws + (size_t)(kp + 32 * s));
#pragma unroll
      for (int i = 0; i < 8; ++i) vn[i] = *(const v4u*)(ws + (size_t)(vcol + (unsigned)(kbase + kstride * (4 * i + vrow)) * 6144u));
#pragma unroll
      for (int i = 0; i < 8; ++i) *(LAS v4u*)(vl + vwr + 4 * i * VS) = vn[i]; }
    f32x16 o[4];
#pragma unroll
    for (int d = 0; d < 4; ++d)
#pragma unroll
        for (int r = 0; r < 16; ++r) o[d][r] = 0.f;
    float m = NEG, l = 0.f;
    for (int idx = 0; idx < nt; ++idx) {
        const int cb = kbase, cs = kstride, cm = maxd;
        const bool more = idx + 1 < nt;
        if (more) {
            DIL_DESC(idx + 1);
#pragma unroll
            for (int i = 0; i < 8; ++i) vn[i] = *(const v4u*)(ws + (size_t)(vcol + (unsigned)(kbase + kstride * (4 * i + vrow)) * 6144u));
        }
        f32x16 s[1];
#pragma unroll
        for (int r = 0; r < 16; ++r) s[0][r] = 0.f;
#pragma unroll
        for (int ks = 0; ks < 8; ++ks) s[0] = MFMA32(kc[ks], qf[ks], s[0]);
        if (more) {
            const unsigned kp = kcol + (unsigned)(kbase + kstride * r32) * 6144u;
#pragma unroll
            for (int s2 = 0; s2 < 8; ++s2) kc[s2] = *(const bf16x8*)(ws + (size_t)(kp + 32 * s2));
        }
        const int d0 = tq - cb - cs * 4 * hh;
#pragma unroll
        for (int r = 0; r < 16; ++r) { const int dist = d0 - cs * ((r & 3) + 8 * (r >> 2)); const float v = s[0][r] - slope2 * (float)dist; s[0][r] = ((unsigned)dist <= (unsigned)cm) ? v : NEG; }
        bf16x8 pb[2];
        softmax_step<1>(s, m, l, o, pb);
        pv32(o, vl + vread, pb[0], pb[1]);
        if (more) {
#pragma unroll
            for (int i = 0; i < 8; ++i) *(LAS v4u*)(vl + vwr + 4 * i * VS) = vn[i];
        }
    }
#undef DIL_DESC
    {
        const int kb0 = 512 * j - 128 + 32 * m0;
        const int row = tid >> 4, ch = tid & 15;
        const unsigned gk = (unsigned)WS_B + (((unsigned)tok0 + kb0 + row) * 3072u + 1024u + h * 128 + ch * 8) * 2u;
        const int lk = row * DKS + ch * 16, lv = 32 * DKS + row * VS + ch * 16;
        const int kread = r32 * DKS + 16 * hh;
        const int vread1 = 32 * DKS + (4 * hh + ((lane & 15) >> 2)) * VS + (16 * ((lane >> 4) & 1) + 4 * (lane & 3)) * 2;
        v4u sk = *(const v4u*)(ws + (size_t)gk), sv = *(const v4u*)(ws + (size_t)(gk + 2048u));
        *(LAS v4u*)(sh + lk) = sk; *(LAS v4u*)(sh + lv) = sv;
        __syncthreads();
        for (int mi = 0; mi < n1; ++mi) {
            const bool more = mi + 1 < n1;
            if (more) { const unsigned g2 = gk + (unsigned)(mi + 1) * 32u * 6144u; sk = *(const v4u*)(ws + (size_t)g2); sv = *(const v4u*)(ws + (size_t)(g2 + 2048u)); }
            const LAS unsigned char* tb = sh + (mi & 1) * DSH;
            f32x16 s[1];
#pragma unroll
            for (int r = 0; r < 16; ++r) s[0][r] = 0.f;
#pragma unroll
            for (int ks = 0; ks < 8; ++ks) { const bf16x8 kf = *(const LAS bf16x8*)(tb + kread + 32 * ks); s[0] = MFMA32(kf, qf[ks], s[0]); }
            const int d0 = tq - (kb0 + 32 * mi) - 4 * hh;
#pragma unroll
            for (int r = 0; r < 16; ++r) { const int dist = d0 - ((r & 3) + 8 * (r >> 2)); const float v = s[0][r] - slope2 * (float)dist; s[0][r] = ((unsigned)dist <= 128u) ? v : NEG; }
            bf16x8 pb[2];
            softmax_step<1>(s, m, l, o, pb);
            pv32(o, tb + vread1, pb[0], pb[1]);
            if (more) { LAS unsigned char* nb = sh + ((mi + 1) & 1) * DSH; *(LAS v4u*)(nb + lk) = sk; *(LAS v4u*)(nb + lv) = sv; }
            __syncthreads();
        }
    }
    store_o(o, l, (bf16*)(const_cast<unsigned char*>(ws) + WS_A) + (tok0 + tq) * 2048 + h * 128, (float*)(const_cast<unsigned char*>(ws) + WS_SSQO) + (tok0 + tq) * 16 + h, hh);
}

__device__ __forceinline__ void phase_attn(const Params& P, LAS unsigned char* lds, int vcu, int G, int wave) {
    const int lane = hw_lane(), tid = wave * 64 + lane;
    const unsigned char* ws = P.ws;
#ifndef REP_MLA
#define REP_MLA 1
#endif
#ifndef REP_DIL
#define REP_DIL 1
#endif
    for (int rm_ = 0; rm_ < REP_MLA; ++rm_)
    for (int u = vcu; u < 256; u += G) { const int bh = u >> 2, pr = u & 3;
        mla_unit(ws, lds, bh >> 3, bh & 7, 7 - pr, tid, wave, lane);
        mla_unit(ws, lds, bh >> 3, bh & 7, pr, tid, wave, lane); }
    __syncthreads();
    LAS unsigned char* vl = lds + wave * (32 * VS); LAS unsigned char* sh = lds + NWAVES * (32 * VS);
    for (int rd_ = 0; rd_ < REP_DIL; ++rd_)
    if (G == 256) {
#pragma unroll 1
        for (int k = 0; k < 2; ++k) { const int t = (vcu >> 5) * 512 + k * 256 + (vcu & 31) * 8 + wave; const int bh = t >> 6, rem = t & 63, jj = rem >> 4, r16 = rem & 15;
            dil_tile(ws, vl, sh, bh >> 3, bh & 7, k == 0 ? jj : 3 - jj, r16, tid, lane); }
    } else {
#pragma unroll 1
        for (int t = vcu * 8 + wave; t < 4096; t += G * 8) { const int bh = t >> 6, rem = t & 63; dil_tile(ws, vl, sh, bh >> 3, bh & 7, rem >> 4, rem & 15, tid, lane); }
    }
}
}
namespace peer {
typedef __bf16 bf2_t __attribute__((ext_vector_type(2)));
#define MFMA32(a, b, c) __builtin_amdgcn_mfma_f32_32x32x16_bf16((a), (b), (c), 0, 0, 0)
__device__ __forceinline__ float fmax3(float a, float b, float c) { return fmaxf(fmaxf(a, b), c); }
__device__ __forceinline__ float asf(unsigned u) { return __builtin_bit_cast(float, u); }
__device__ __forceinline__ unsigned asu(float f) { return __builtin_bit_cast(unsigned, f); }

__device__ __forceinline__ void route_item(const unsigned char* ws, LAS unsigned* sc, int tile, int h, int lane) {
    const bf16* QP = (const bf16*)(ws + WS_QP); const bf16* SK = (const bf16*)(ws + WS_SK);
    int* RIDX = (int*)(ws + WS_RIDX); float* RGATE = (float*)(ws + WS_RGATE);
    const int r32 = lane & 31, hh = lane >> 5;
    const size_t tok = (size_t)tile * 32 + r32;
    float rs2; { const f32x4* sp = (const f32x4*)((const float*)(ws + WS_SSQH) + tok * 32); f32x4 a = sp[0];
#pragma unroll
        for (int i = 1; i < 8; ++i) a = a + sp[i];
        rs2 = rsqrtf(((a[0] + a[1]) + (a[2] + a[3])) * (1.f / 2048.f) + EPS); }
#pragma unroll 1
    for (int p = 0; p < 2; ++p) {
        f32x16 s[4];
#pragma unroll
        for (int kb = 0; kb < 4; ++kb)
#pragma unroll
            for (int r = 0; r < 16; ++r) s[kb][r] = 0.f;
        const bf16* qp = QP + tok * 2048 + h * 256 + p * 128 + 8 * hh;
        const bf16* kp = SK + ((size_t)(h * 2 + p) * 128 + r32) * 128 + 8 * hh;
#pragma unroll
        for (int ks = 0; ks < 8; ++ks) { const bf16x8 q = *(const bf16x8*)(qp + 16 * ks);
#pragma unroll
            for (int kb = 0; kb < 4; ++kb) { const bf16x8 k = *(const bf16x8*)(kp + (size_t)kb * 32 * 128 + 16 * ks); s[kb] = MFMA32(k, q, s[kb]); } }
#pragma unroll
        for (int kb = 0; kb < 4; ++kb)
#pragma unroll
            for (int r = 0; r < 16; ++r) s[kb][r] = asf((asu(s[kb][r] * rs2) & ~127u) | (unsigned)(32 * kb + (r & 3) + 8 * (r >> 2) + 4 * hh));
#pragma unroll 1
        for (int k = 0; k < 16; ++k) {
            float mx = s[0][0];
#pragma unroll
            for (int kb = 0; kb < 4; ++kb)
#pragma unroll
                for (int r = 0; r < 16; r += 2) mx = fmax3(mx, s[kb][r], s[kb][r + 1]);
            mx = fmaxf(mx, __shfl_xor(mx, 32));
            if (hh == 0) sc[(p * 32 + r32) * 16 + k] = asu(mx);
#pragma unroll
            for (int kb = 0; kb < 4; ++kb)
#pragma unroll
                for (int r = 0; r < 16; ++r) s[kb][r] = (s[kb][r] == mx) ? -3.0e38f : s[kb][r];
        }
    }
    unsigned t1[16], t2[16];
#pragma unroll
    for (int i = 0; i < 16; i += 4) { const v4u a = *(const LAS v4u*)(sc + r32 * 16 + i), b = *(const LAS v4u*)(sc + (32 + r32) * 16 + i);
        t1[i] = a.x; t1[i + 1] = a.y; t1[i + 2] = a.z; t1[i + 3] = a.w; t2[i] = b.x; t2[i + 1] = b.y; t2[i + 2] = b.z; t2[i + 3] = b.w; }
    float c[50]; int n = 0;
#pragma unroll
    for (int i = 0; i < 16; ++i)
#pragma unroll
        for (int j = 0; j < 16; ++j) if ((i + 1) * (j + 1) <= 16) { const float v = asf(t1[i] & ~127u) + asf(t2[j] & ~127u); c[n] = asf((asu(v) & ~255u) | (unsigned)(i * 16 + j)); ++n; }
    float best[8]; float bmax = 0.f, esum = 0.f;
#pragma unroll
    for (int k = 0; k < 16; ++k) {
        float mx = c[0];
#pragma unroll
        for (int q = 1; q < 49; q += 2) mx = fmax3(mx, c[q], c[q + 1]);
        mx = fmaxf(mx, c[49]);
#pragma unroll
        for (int q = 0; q < 50; ++q) c[q] = (c[q] == mx) ? -3.0e38f : c[q];
        const float val = asf(asu(mx) & ~255u);
        if (k == 0) bmax = val;
        esum += __expf(val - bmax);
        if ((k >> 3) == hh) best[k & 7] = mx;
    }
    const float inv = 1.0f / esum;
    int idx[8]; float gate[8];
#pragma unroll
    for (int k = 0; k < 8; ++k) { const unsigned code = asu(best[k]) & 255u; const unsigned a = sc[r32 * 16 + (code >> 4)], b = sc[(32 + r32) * 16 + (code & 15)];
        idx[k] = (int)((a & 127u) * 128u + (b & 127u)); gate[k] = __expf(asf(asu(best[k]) & ~255u) - bmax) * inv; }
    int* ip = RIDX + tok * 128 + h * 16 + 8 * hh; float* gp = RGATE + tok * 128 + h * 16 + 8 * hh;
    *(v4u*)ip = (v4u){(unsigned)idx[0], (unsigned)idx[1], (unsigned)idx[2], (unsigned)idx[3]}; *(v4u*)(ip + 4) = (v4u){(unsigned)idx[4], (unsigned)idx[5], (unsigned)idx[6], (unsigned)idx[7]};
    *(f32x4*)gp = (f32x4){gate[0], gate[1], gate[2], gate[3]}; *(f32x4*)(gp + 4) = (f32x4){gate[4], gate[5], gate[6], gate[7]};
}

__device__ __forceinline__ void phase_route(const Params& P, LAS unsigned char* lds, int vcu, int G, int wave) {
    const int lane = hw_lane();
    LAS unsigned* sc = (LAS unsigned*)(lds + wave * 4096);
#pragma unroll 1
    for (int it = vcu * NWAVES + wave; it < 512 * 8; it += G * NWAVES) route_item(P.ws, sc, it >> 3, it & 7, lane);
}

__device__ __forceinline__ float dot16_f8(const float (&x)[16], const v4u& u, float c) {
    const int u0 = (int)u.x, u1 = (int)u.y, u2 = (int)u.z, u3 = (int)u.w;
    const f32x2 a0 = __builtin_amdgcn_cvt_pk_f32_fp8(u0, false), a1 = __builtin_amdgcn_cvt_pk_f32_fp8(u0, true);
    const f32x2 a2 = __builtin_amdgcn_cvt_pk_f32_fp8(u1, false), a3 = __builtin_amdgcn_cvt_pk_f32_fp8(u1, true);
    const f32x2 a4 = __builtin_amdgcn_cvt_pk_f32_fp8(u2, false), a5 = __builtin_amdgcn_cvt_pk_f32_fp8(u2, true);
    const f32x2 a6 = __builtin_amdgcn_cvt_pk_f32_fp8(u3, false), a7 = __builtin_amdgcn_cvt_pk_f32_fp8(u3, true);
    c = fmaf(x[0], a0.x, c); c = fmaf(x[1], a0.y, c); c = fmaf(x[2], a1.x, c); c = fmaf(x[3], a1.y, c);
    c = fmaf(x[4], a2.x, c); c = fmaf(x[5], a2.y, c); c = fmaf(x[6], a3.x, c); c = fmaf(x[7], a3.y, c);
    c = fmaf(x[8], a4.x, c); c = fmaf(x[9], a4.y, c); c = fmaf(x[10], a5.x, c); c = fmaf(x[11], a5.y, c);
    c = fmaf(x[12], a6.x, c); c = fmaf(x[13], a6.y, c); c = fmaf(x[14], a7.x, c); c = fmaf(x[15], a7.y, c);
    return c;
}
__device__ __forceinline__ void unpack8(float* x, const v4u& v) { x[0] = bflo(v.x); x[1] = bfhi(v.x); x[2] = bflo(v.y); x[3] = bfhi(v.y); x[4] = bflo(v.z); x[5] = bfhi(v.z); x[6] = bflo(v.w); x[7] = bfhi(v.w); }
__device__ __forceinline__ void peer_u_token(const Params& P, size_t tok, int lane) {
    const unsigned char* ws = P.ws;
    const bf16* H1B = (const bf16*)(ws + WS_B); const unsigned char* U8 = ws + WS_UB;
    const int* RIDX = (const int*)(ws + WS_RIDX); const float* RGATE = (const float*)(ws + WS_RGATE); const float* SSQH = (const float*)(ws + WS_SSQH);
    unsigned* PKV = (unsigned*)(ws + WS_PKV);
    float x0[16], x1[16];
    { const bf16* hp = H1B + tok * 2048 + 16 * lane; const v4u a = *(const v4u*)hp, b = *(const v4u*)(hp + 8), c = *(const v4u*)(hp + 1024), d = *(const v4u*)(hp + 1032);
      unpack8(x0, a); unpack8(x0 + 8, b); unpack8(x1, c); unpack8(x1 + 8, d); }
    const float rs2 = rsqrtf(wave_sum(lane < 32 ? SSQH[tok * 32 + lane] : 0.f) * (1.f / 2048.f) + EPS) * (1.f / 32.f);
    const int i0 = RIDX[tok * 128 + lane], i1 = RIDX[tok * 128 + 64 + lane];
    const float g0 = RGATE[tok * 128 + lane], g1 = RGATE[tok * 128 + 64 + lane];
    float d0 = 0.f, d1 = 0.f;
    v4u ra[16], rb[16];
#define PU_LOAD(buf, g) do { _Pragma("unroll") for (int e = 0; e < 8; ++e) { const int row = __builtin_amdgcn_readlane((g) < 8 ? i0 : i1, ((g) & 7) * 8 + e); \
        const unsigned char* up = U8 + (size_t)row * 2048 + 16 * lane; buf[2 * e] = *(const v4u*)up; buf[2 * e + 1] = *(const v4u*)(up + 1024); } } while (0)
#define PU_COMPUTE(buf, g) do { float pt[8]; _Pragma("unroll") for (int e = 0; e < 8; ++e) pt[e] = dot16_f8(x1, buf[2 * e + 1], dot16_f8(x0, buf[2 * e], 0.f)); \
        float a4[4], a2[2], a1; \
        _Pragma("unroll") for (int i = 0; i < 4; ++i) { const float keep = (lane & 1) ? pt[2 * i + 1] : pt[2 * i], give = (lane & 1) ? pt[2 * i] : pt[2 * i + 1]; a4[i] = keep + __shfl_xor(give, 1); } \
        _Pragma("unroll") for (int i = 0; i < 2; ++i) { const float keep = (lane & 2) ? a4[2 * i + 1] : a4[2 * i], give = (lane & 2) ? a4[2 * i] : a4[2 * i + 1]; a2[i] = keep + __shfl_xor(give, 2); } \
        { const float keep = (lane & 4) ? a2[1] : a2[0], give = (lane & 4) ? a2[0] : a2[1]; a1 = keep + __shfl_xor(give, 4); } \
        a1 += __shfl_xor(a1, 8); a1 += __shfl_xor(a1, 16); a1 += __shfl_xor(a1, 32); \
        if ((lane >> 3) == ((g) & 7)) { if ((g) < 8) d0 = a1; else d1 = a1; } } while (0)
    PU_LOAD(ra, 0);
#pragma unroll 1
    for (int g = 0; g < 16; g += 2) {
        PU_LOAD(rb, g + 1);
        PU_COMPUTE(ra, g);
        if (g + 2 < 16) PU_LOAD(ra, g + 2);
        PU_COMPUTE(rb, g + 1);
    }
#undef PU_LOAD
#undef PU_COMPUTE
    const float z0 = d0 * rs2, z1 = d1 * rs2;
    const float a0 = 8.0f * z0 * (1.0f + erff(z0 * 0.7071067811865476f)) * g0, a1v = 8.0f * z1 * (1.0f + erff(z1 * 0.7071067811865476f)) * g1;
    unsigned* pk = PKV + ((tok >> 6) * 128) * 64 + (tok & 63);
    pk[(size_t)lane * 64] = ((unsigned)i0 << 2) | ((unsigned)__builtin_bit_cast(unsigned short, (_Float16)a0) << 16);
    pk[(size_t)(64 + lane) * 64] = ((unsigned)i1 << 2) | ((unsigned)__builtin_bit_cast(unsigned short, (_Float16)a1v) << 16);
}
__device__ __forceinline__ void phase_peer_u(const Params& P, int vcu, int G, int wave) {
    const int lane = hw_lane();
#pragma unroll 1
    for (int t = vcu * NWAVES + wave; t < M; t += G * NWAVES) peer_u_token(P, (size_t)t, lane);
}
typedef _Float16 h2_t __attribute__((ext_vector_type(2)));
template <int VAR>
__device__ __forceinline__ void phase_peer_v(const Params& P, float* OUTP, LAS unsigned char* lds, int vcu, int G, int wave) {
    const int lane = hw_lane(), tid = wave * 64 + lane;
    const unsigned char* ws = P.ws;
    const bf16* H1B = (const bf16*)(ws + WS_B); const unsigned* PKV = (const unsigned*)(ws + WS_PKV);
#pragma unroll 1
    for (int c = vcu; c < 256; c += G) {
        __syncthreads();
        { const v4u* src = (const v4u*)(ws + WS_VB + (size_t)c * 131072);
#pragma unroll 4
          for (int i = tid; i < 8192; i += NTHREADS) *(LAS v4u*)(lds + 16 * i) = src[i]; }
        __syncthreads();
        unsigned w0[16], w1[16], w2[16], w3[16];
#define PV_LOAD(buf) do { _Pragma("unroll") for (int i = 0; i < 16; ++i) buf[i] = pl[i * 64]; pl += 16 * 64; asm volatile("" : "+v"(pl)); } while (0)
#define PV_PROC(buf) do { v2u vv[16]; _Pragma("unroll") for (int i = 0; i < 16; ++i) vv[i] = *(const LAS v2u*)(size_t)((buf[i] << 1) & 0x1fff8u);     \
            _Pragma("unroll") for (int i = 0; i < 16; ++i) { const _Float16 ah = __builtin_bit_cast(_Float16, (unsigned short)(buf[i] >> 16)); const h2_t a2 = {ah, ah}; \
                y0 = __builtin_elementwise_fma(a2, __builtin_bit_cast(h2_t, __builtin_amdgcn_cvt_scalef32_pk_f16_fp8(vv[i].x, 1.0f, false)), y0); \
                y1 = __builtin_elementwise_fma(a2, __builtin_bit_cast(h2_t, __builtin_amdgcn_cvt_scalef32_pk_f16_fp8(vv[i].x, 1.0f, true)), y1); \
                y2 = __builtin_elementwise_fma(a2, __builtin_bit_cast(h2_t, __builtin_amdgcn_cvt_scalef32_pk_f16_fp8(vv[i].y, 1.0f, false)), y2); \
                y3 = __builtin_elementwise_fma(a2, __builtin_bit_cast(h2_t, __builtin_amdgcn_cvt_scalef32_pk_f16_fp8(vv[i].y, 1.0f, true)), y3); } } while (0)
        const unsigned* pl = PKV + (size_t)wave * 128 * 64 + lane;
        PV_LOAD(w0); PV_LOAD(w1); PV_LOAD(w2);
        v4u hxn = *(const v4u*)(H1B + ((size_t)wave * 64 + lane) * 2048 + 8 * c);
#pragma unroll 1
        for (int b = wave; b < 256; b += NWAVES) {
            const size_t tok = (size_t)b * 64 + lane;
            const int bn = (b + NWAVES < 256) ? b + NWAVES : b;
            h2_t y0 = {0, 0}, y1 = {0, 0}, y2 = {0, 0}, y3 = {0, 0};
            v4u hx = hxn;
#pragma unroll 1
            for (int half = 0; half < 2; ++half) {
                PV_LOAD(w3); PV_PROC(w0);
                if (half == 1) { hxn = *(const v4u*)(H1B + ((size_t)bn * 64 + lane) * 2048 + 8 * c); pl += (ptrdiff_t)(bn - b - 1) * 128 * 64; }
                PV_LOAD(w0); PV_PROC(w1);
                PV_LOAD(w1); PV_PROC(w2);
                PV_LOAD(w2); PV_PROC(w3);
            }
            float y[8]; unpack8(y, hx);
            constexpr float S = 1.0f / 32.0f;
            y[0] += S * (float)y0[0]; y[1] += S * (float)y0[1]; y[2] += S * (float)y1[0]; y[3] += S * (float)y1[1];
            y[4] += S * (float)y2[0]; y[5] += S * (float)y2[1]; y[6] += S * (float)y3[0]; y[7] += S * (float)y3[1];
            float* op = OUTP + tok * 2048 + 8 * c;
            *(f32x4*)op = (f32x4){y[0], y[1], y[2], y[3]}; *(f32x4*)(op + 4) = (f32x4){y[4], y[5], y[6], y[7]};
        }
#undef PV_LOAD
#undef PV_PROC
    }
}
__device__ __forceinline__ void phase_final(const Params& P, int vcu, int G, int wave) {
    const int lane = hw_lane();
    f32x4 gv[8];
#pragma unroll
    for (int j = 0; j < 8; ++j) gv[j] = ((const f32x4*)P.lnf)[lane + 64 * j];
#pragma unroll 1
    for (int t = vcu * NWAVES + wave; t < M; t += G * NWAVES) {
        f32x4* row = (f32x4*)(P.out + (size_t)t * 2048) + lane;
        f32x4 v[8]; float s = 0.f;
#pragma unroll
        for (int j = 0; j < 8; ++j) { v[j] = row[64 * j]; s += (v[j].x * v[j].x + v[j].y * v[j].y) + (v[j].z * v[j].z + v[j].w * v[j].w); }
        const float rs = rsqrtf(wave_sum(s) * (1.f / 2048.f) + EPS);
#pragma unroll
        for (int j = 0; j < 8; ++j) row[64 * j] = v[j] * rs * gv[j];
    }
}
#undef MFMA32
}
#define XB_TMO      128
#define XB_XCNT(j)  (256  + 64 * (j))
#define XB_XSUB(j)  (1280 + 64 * (j))
#define XB_XGEN(j)  (2304 + 64 * (j))
#define XB_TOP      3328
#define XB_TOPGEN   3392
#define XCD_BAR_WORDS 3456
#define XB_SPIN_CAP (1u << 22)
__device__ __forceinline__ unsigned xb_ld(unsigned* p)              { return __hip_atomic_load(p, __ATOMIC_RELAXED, __HIP_MEMORY_SCOPE_AGENT); }
__device__ __forceinline__ unsigned xb_add(unsigned* p, unsigned v) { return __hip_atomic_fetch_add(p, v, __ATOMIC_RELAXED, __HIP_MEMORY_SCOPE_AGENT); }
__device__ __forceinline__ unsigned xb_xcc_id() { return (unsigned)__builtin_amdgcn_s_getreg((3 << 11) | 20) & 0xFu; }
#define XB_SPIN(cond, bar) do { unsigned _sp = 0; while (cond) { __builtin_amdgcn_s_sleep(1); \
    if ((++_sp & 255u) == 0u) { if (xb_ld(&(bar)[XB_TMO])) break; if (_sp > XB_SPIN_CAP) { atomicAdd(&(bar)[XB_TMO], 1u); break; } } } } while (0)
struct XcdBarrier { unsigned* bar; unsigned x; volatile LAS unsigned* st; };
__device__ __forceinline__ XcdBarrier xcd_barrier_post(unsigned* bar, volatile LAS unsigned* st, bool leader) {
    XcdBarrier b; b.bar = bar; b.x = xb_xcc_id(); b.st = st;
    if (leader) (void)xb_add(&bar[XB_XCNT(b.x)], 1u);
    return b;
}
__device__ __forceinline__ void xcd_barrier_complete(unsigned* bar, unsigned x, unsigned& nloc, unsigned& nx) {
    const unsigned G = gridDim.x * gridDim.y * gridDim.z;
    unsigned sum, cnt, mine, sp = 0u;
    for (;;) {
        sum = 0u; cnt = 0u; mine = 0u;
#pragma unroll
        for (unsigned j = 0; j < 16; ++j) { const unsigned c = xb_ld(&bar[XB_XCNT(j)]); sum += c; cnt += (c > 0u) ? 1u : 0u; mine = (j == x) ? c : mine; }
        if (sum == G) break;
        __builtin_amdgcn_s_sleep(1);
        if ((++sp & 255u) == 0u) { if (xb_ld(&bar[XB_TMO])) break; if (sp > XB_SPIN_CAP) { atomicAdd(&bar[XB_TMO], 1u); break; } }
    }
    nloc = mine > 0u ? mine : 1u; nx = cnt > 0u ? cnt : 1u;
}
__device__ __forceinline__ void xcd_barrier(const XcdBarrier& b, int wave) {
    asm volatile("s_waitcnt vmcnt(0)" ::: "memory");
    __syncthreads();
    if (wave == 0 && hw_lane() == 0) {
        unsigned* bar = b.bar;
        __builtin_amdgcn_s_waitcnt(0);
        unsigned nloc = b.st[0], nx = b.st[1];
        if (nloc == 0u) { xcd_barrier_complete(bar, b.x, nloc, nx); b.st[0] = nloc; b.st[1] = nx; }
        const unsigned old = xb_add(&bar[XB_XSUB(b.x)], 1u);
        const unsigned gen = old / nloc;
        if (old + 1u == (gen + 1u) * nloc) {
            __builtin_amdgcn_fence(__ATOMIC_RELEASE, "agent");
            asm volatile("s_waitcnt vmcnt(0)" ::: "memory");
            const unsigned og = xb_add(&bar[XB_TOP], 1u);
            const unsigned tg = og / nx;
            if (og + 1u == (tg + 1u) * nx) xb_add(&bar[XB_TOPGEN], 1u);
            else XB_SPIN(xb_ld(&bar[XB_TOPGEN]) == tg, bar);
            __builtin_amdgcn_fence(__ATOMIC_ACQUIRE, "agent");
            xb_add(&bar[XB_XGEN(b.x)], 1u);
            asm volatile("s_waitcnt vmcnt(0)" ::: "memory");
        } else {
            XB_SPIN(xb_ld(&bar[XB_XGEN(b.x)]) == gen, bar);
            __builtin_amdgcn_fence(__ATOMIC_ACQUIRE, "agent");
            asm volatile("s_waitcnt vmcnt(0)" ::: "memory");
        }
    }
    __syncthreads();
}
constexpr int N_PHASES = 10;
#ifndef REP_PHASE
#define REP_PHASE -1
#endif
#ifndef REP_N
#define REP_N 1
#endif
#ifndef EXTRA_SYNCS
#define EXTRA_SYNCS 0
#endif
__global__ void __launch_bounds__(NTHREADS, 2) mega(Params P) {
    extern __shared__ __attribute__((aligned(16))) unsigned char lds_raw[];
    LAS unsigned char* lds = (LAS unsigned char*)lds_raw;
    cg::grid_group grid = cg::this_grid();
    const int wave = __builtin_amdgcn_readfirstlane((int)threadIdx.x >> 6);
    const int G = gridDim.x, bx = blockIdx.x;
    const int vcu = (G % 8 == 0) ? (bx % 8) * (G / 8) + bx / 8 : bx;
    unsigned char* ws = P.ws;
    const int lo = P.ph_lo, hi = P.ph_hi;
#define IN(k) (lo <= (k) && (k) < hi)
#ifndef CG_SEAMS
#define CG_SEAMS 1
#endif
    volatile LAS unsigned* xbst = (volatile LAS unsigned*)(lds + MISC_OFF + 8192);
    if (wave == 0 && hw_lane() == 0) { xbst[0] = 0u; xbst[1] = 0u; xbst[2] = 0u; xbst[3] = 0u; }
    __syncthreads();
    const XcdBarrier xbar = xcd_barrier_post((unsigned*)(ws + WS_CTL) + 4096, xbst, wave == 0 && hw_lane() == 0);
#define GSYNC(k) do { if ((k) < CG_SEAMS) grid.sync(); else xcd_barrier(xbar, wave); } while (0)
#define SEAM(k) do { if (IN(k) && IN((k) + 1)) GSYNC(k); } while (0)

    for (int rep_ = 0; rep_ < (REP_PHASE == 0 ? 1 + REP_N : 1); ++rep_) if (IN(0)) { if (rep_) GSYNC(9); phase_prep(P, lds, vcu, G, wave); }
    SEAM(0);
    for (int es_ = 0; es_ < EXTRA_SYNCS; ++es_) GSYNC(9);
    for (int rep_ = 0; rep_ < (REP_PHASE == 1 ? 1 + REP_N : 1); ++rep_) if (IN(1)) { if (rep_) GSYNC(9);
        pg8::GemmSet g; g.A0 = g.A1 = (const bf16*)(ws + WS_A); g.Bt0 = g.Bt1 = (const bf16*)(ws + WS_BT1); g.K = 2048;
        pg8::StaticOrder S; S.init(M, 4096, 0, G, bx);
        pg8::Epi1 E{(bf16*)(ws + WS_B), (bf16*)(ws + WS_CQ), (bf16*)(ws + WS_CKV), (float*)(ws + WS_SSQCQ), (float*)(ws + WS_SSQCKV)};
        pg8::gemm_phase<pg8::Epi1, pg8::StaticOrder>(lds, g, S, E, wave);
    }
    SEAM(1);
    for (int rep_ = 0; rep_ < (REP_PHASE == 2 ? 1 + REP_N : 1); ++rep_) if (IN(2)) { if (rep_) GSYNC(9);
        pg8::GemmSet g; g.A0 = (const bf16*)(ws + WS_CQ); g.A1 = (const bf16*)(ws + WS_CKV); g.Bt0 = (const bf16*)(ws + WS_BT2Q); g.Bt1 = (const bf16*)(ws + WS_BT2KV); g.K = 512;
        pg8::StaticOrder S; S.init(M, 1536, 2048, G, bx);
        pg8::Epi2 E{(bf16*)(ws + WS_QN), (bf16*)(ws + WS_QPE), (bf16*)(ws + WS_KN), (bf16*)(ws + WS_VM), (const float*)(ws + WS_SSQCQ), (const float*)(ws + WS_SSQCKV), (const f32x2*)(ws + WS_ROPE)};
        pg8::gemm_phase<pg8::Epi2, pg8::StaticOrder>(lds, g, S, E, wave);
        for (int it = G - 1 - bx; it < 128; it += G) kr_item((const bf16*)(ws + WS_A), (const bf16*)(ws + WS_BTKR), (const f32x2*)(ws + WS_ROPE), (bf16*)(ws + WS_KPE), it, wave, hw_lane());
    }
    SEAM(2);
    for (int rep_ = 0; rep_ < (REP_PHASE == 3 ? 1 + REP_N : 1); ++rep_) if (IN(3)) { if (rep_) GSYNC(9); att::phase_attn(P, lds, vcu, G, wave); }
    SEAM(3);
    for (int rep_ = 0; rep_ < (REP_PHASE == 4 ? 1 + REP_N : 1); ++rep_) if (IN(4)) { if (rep_) GSYNC(9);
        pg8::GemmSet g; g.A0 = g.A1 = (const bf16*)(ws + WS_A); g.Bt0 = g.Bt1 = (const bf16*)(ws + WS_BT3); g.K = 2048;
        pg8::StaticOrder S; S.init(M, 2048, 0, G, bx);
        pg8::Epi3 E{(bf16*)(ws + WS_B), P.x, (const float*)(ws + WS_SSQO), (float*)(ws + WS_SSQH), (LAS f32x2*)(lds + MISC_OFF)};
        pg8::gemm_phase<pg8::Epi3, pg8::StaticOrder>(lds, g, S, E, wave);
    }
    SEAM(4);
    for (int rep_ = 0; rep_ < (REP_PHASE == 5 ? 1 + REP_N : 1); ++rep_) if (IN(5)) { if (rep_) GSYNC(9);
        pg8::GemmSet g; g.A0 = g.A1 = (const bf16*)(ws + WS_B); g.Bt0 = g.Bt1 = (const bf16*)(ws + WS_BT4); g.K = 2048;
        pg8::StaticOrder S; S.init(M, 2048, 0, G, bx);
        pg8::Epi4 E{(bf16*)(ws + WS_QP)};
        pg8::gemm_phase<pg8::Epi4, pg8::StaticOrder>(lds, g, S, E, wave);
    }
    SEAM(5);
    for (int rep_ = 0; rep_ < (REP_PHASE == 6 ? 1 + REP_N : 1); ++rep_) if (IN(6)) { if (rep_) GSYNC(9); peer::phase_route(P, lds, vcu, G, wave); }
    SEAM(6);
    for (int rep_ = 0; rep_ < (REP_PHASE == 7 ? 1 + REP_N : 1); ++rep_) if (IN(7)) { if (rep_) GSYNC(9); peer::phase_peer_u(P, vcu, G, wave); }
    SEAM(7);
    for (int rep_ = 0; rep_ < (REP_PHASE == 8 ? 1 + REP_N : 1); ++rep_) if (IN(8)) { if (rep_) GSYNC(9); peer::phase_peer_v<0>(P, P.out, lds, vcu, G, wave); }
    SEAM(8);
    for (int rep_ = 0; rep_ < (REP_PHASE == 9 ? 1 + REP_N : 1); ++rep_) if (IN(9)) { if (rep_) GSYNC(9); peer::phase_final(P, vcu, G, wave); }
#undef IN
#undef SEAM
}

static int mega_grid() {
    static int grid = 0;
    if (grid == 0) {
        int dev = 0, cus = 0, per_cu = 0;
        (void)hipGetDevice(&dev); (void)hipDeviceGetAttribute(&cus, hipDeviceAttributeMultiprocessorCount, dev);
        (void)hipFuncSetAttribute((const void*)mega, hipFuncAttributeMaxDynamicSharedMemorySize, LDS_BYTES);
        (void)hipOccupancyMaxActiveBlocksPerMultiprocessor(&per_cu, (const void*)mega, NTHREADS, LDS_BYTES);
        if (per_cu < 1) { fprintf(stderr, "mega: occupancy query says %d blocks/CU\n", per_cu); per_cu = 1; }
        grid = cus;
        (void)hipGetLastError();
    }
    return grid;
}
static void fill_params(Params& P, void* const* d_in, void* d_out, void* d_ws) {
    P.x = (const float*)d_in[0]; P.ln1 = (const float*)d_in[1]; P.w_in = (const float*)d_in[2]; P.qan = (const float*)d_in[3]; P.kvan = (const float*)d_in[4];
    P.w_uq = (const float*)d_in[5]; P.w_ukv = (const float*)d_in[6]; P.ond = (const float*)d_in[7]; P.onm = (const float*)d_in[8]; P.w_o = (const float*)d_in[9];
    P.ln2 = (const float*)d_in[10]; P.wq = (const float*)d_in[11]; P.sk = (const float*)d_in[12]; P.pu = (const float*)d_in[13]; P.pv = (const float*)d_in[14]; P.lnf = (const float*)d_in[15];
    P.out = (float*)d_out; P.ws = (unsigned char*)d_ws;
}
static void launch_phases(Params P, int lo, int hi, hipStream_t st) {
    P.ph_lo = lo; P.ph_hi = hi;
    (void)hipMemsetAsync(P.ws + WS_CTL, 0, CTL_ZERO_BYTES, st);
    void* args[] = {&P};
    hipError_t e = hipLaunchCooperativeKernel((const void*)mega, dim3(mega_grid()), dim3(NTHREADS), args, LDS_BYTES, st);
    if (e != hipSuccess) fprintf(stderr, "mega launch [%d,%d) failed: %s\n", lo, hi, hipGetErrorString(e));
}
extern "C" void kernel_launch(void* const* d_in, const int* in_sizes, int n_in, void* d_out, int out_size, void* d_ws, size_t ws_size, hipStream_t stream) {
    Params P{}; fill_params(P, d_in, d_out, d_ws);
    launch_phases(P, 0, N_PHASES, stream);
}
```

```cpp
#include <hip/hip_runtime.h>
#include <hip/hip_cooperative_groups.h>
#include <cstdio>
#include <cstdint>
#include <cstddef>
namespace cg = cooperative_groups;
#define GAS __attribute__((address_space(1)))
#define LAS __attribute__((address_space(3)))
typedef unsigned short bf16;
typedef unsigned v4u __attribute__((ext_vector_type(4)));
typedef unsigned v2u __attribute__((ext_vector_type(2)));
typedef float f32x2 __attribute__((ext_vector_type(2)));
typedef float f32x4 __attribute__((ext_vector_type(4)));
typedef float f32x16 __attribute__((ext_vector_type(16)));
typedef short bf16x8 __attribute__((ext_vector_type(8)));
typedef short s16x4 __attribute__((ext_vector_type(4)));
typedef __bf16 bf16x2_t __attribute__((ext_vector_type(2)));

constexpr int M = 16384, SEQ = 2048, DM = 2048, NWAVES = 8, NTHREADS = 512;
constexpr float EPS = 1e-6f, LOG2E = 1.4426950408889634f;
constexpr float QSCALE_DIL = 0.08838834764831845f * LOG2E;
constexpr float QSCALE_MLA = 0.07216878364870323f * LOG2E;

constexpr size_t MiB = 1u << 20;
constexpr size_t WS_CTL = 0, CTL_ZERO_BYTES = 64 * 1024;
constexpr size_t WS_ROPE = 1 * MiB;
constexpr size_t WS_SK = 2 * MiB;
constexpr size_t WS_BTKR = 3 * MiB;
constexpr size_t WS_BT2Q = 4 * MiB;
constexpr size_t WS_BT2KV = 6 * MiB;
constexpr size_t WS_BT1 = 8 * MiB;
constexpr size_t WS_BT3 = 24 * MiB;
constexpr size_t WS_BT4 = 32 * MiB;
constexpr size_t WS_SSQCQ = 40 * MiB;
constexpr size_t WS_SSQCKV = 40 * MiB + 512 * 1024;
constexpr size_t WS_SSQO = 41 * MiB;
constexpr size_t WS_SSQH = 42 * MiB;
constexpr size_t WS_KPE = 44 * MiB;
constexpr size_t WS_UB = 48 * MiB;
constexpr size_t WS_VB = 112 * MiB;
constexpr size_t WS_A = 176 * MiB;
constexpr size_t WS_B = 240 * MiB;
constexpr size_t WS_C = 336 * MiB;
constexpr size_t WS_QN = WS_C, WS_QPE = WS_C + 32 * MiB, WS_KN = WS_C + 48 * MiB, WS_VM = WS_C + 80 * MiB;
constexpr size_t WS_QP = WS_C, WS_RIDX = WS_C + 64 * MiB, WS_RGATE = WS_C + 72 * MiB, WS_PKV = WS_C + 80 * MiB,
                 WS_SIDX = WS_C + 88 * MiB, WS_SGATE = WS_C + 96 * MiB, WS_GOFF = WS_C + 104 * MiB;
constexpr size_t WS_D = 448 * MiB;
constexpr size_t WS_CQ = WS_D, WS_CKV = WS_D + 16 * MiB;
constexpr size_t WS_END = 480 * MiB;

constexpr int RING_BYTES = 131072;
constexpr int MISC_OFF = RING_BYTES;
constexpr int LDS_BYTES = 147456;

#define LDS_WAIT() asm volatile("s_waitcnt lgkmcnt(0)" ::: "memory")
#define VM_WAIT() asm volatile("s_waitcnt vmcnt(0)" ::: "memory")

__device__ __forceinline__ unsigned f2bf(float f) { unsigned u = __builtin_bit_cast(unsigned, f); return (u + 0x7fffu + ((u >> 16) & 1u)) >> 16; }
__device__ __forceinline__ unsigned pk2(float lo, float hi) { f32x2 v = {lo, hi}; bf16x2_t b = __builtin_convertvector(v, bf16x2_t); return __builtin_bit_cast(unsigned, b); }
__device__ __forceinline__ float bflo(unsigned u) { return __builtin_bit_cast(float, u << 16); }
__device__ __forceinline__ float bfhi(unsigned u) { return __builtin_bit_cast(float, u & 0xffff0000u); }
__device__ __forceinline__ float bf2f(bf16 b) { return __builtin_bit_cast(float, (unsigned)b << 16); }
__device__ __forceinline__ float wave_sum(float v) {
#pragma unroll
    for (int o = 1; o < 64; o <<= 1) v += __shfl_xor(v, o);
    return v;
}

__device__ __forceinline__ int hw_lane() { int l; asm volatile("v_mbcnt_lo_u32_b32 %0, -1, 0\n\tv_mbcnt_hi_u32_b32 %0, -1, %0" : "=v"(l)); return l; }

struct Params {
    const float *x, *ln1, *w_in, *qan, *kvan, *w_uq, *w_ukv, *ond, *onm, *w_o, *ln2, *wq, *sk, *pu, *pv, *lnf;
    float* out; unsigned char* ws;
    int ph_lo, ph_hi;
};
__device__ __forceinline__ int map_ident(int c) { return c; }
__device__ __forceinline__ int map_kr(int c) { const int p = c - 4096; return 2 * (p & 31) + (p >> 5); }
__device__ __forceinline__ int map_uq(int c) { const int h = c / 192, e = c % 192; if (e < 128) return h * 128 + e; const int p = e - 128; return 1024 + h * 64 + 2 * (p & 31) + (p >> 5); }
__device__ __forceinline__ int map_ukv(int c) { const int h = c >> 8, e = c & 255; return e < 128 ? h * 128 + e : 1024 + h * 128 + (e - 128); }

template <int MAP>
__device__ __forceinline__ void p0_transpose_item(const float* __restrict__ W, int K, int ldw, int c0, const float* __restrict__ g0, const float* __restrict__ g1, int gsplit,
                                                  bf16* __restrict__ WT, LAS float* scr, int item, int nblk, int lane) {
    const int kb = item / nblk, nb = item % nblk, k0 = 64 * kb, n0 = c0 + 32 * nb;
#pragma unroll 8
    for (int i = 0; i < 32; ++i) { const int kk = 2 * i + (lane >> 5); const int k = k0 + kk;
        float w = W[(size_t)k * ldw + n0 + (lane & 31)];
        if (g0) w *= (k < gsplit ? g0[k] : g1[k - gsplit]);
        scr[kk * 33 + (lane & 31)] = w; }
    LDS_WAIT(); asm volatile("" ::: "memory");
    const int c = lane & 7;
#pragma unroll
    for (int j = 0; j < 4; ++j) { const int n = (lane >> 3) + 8 * j; const LAS float* s = scr + (8 * c) * 33 + n;
        v4u o; o.x = pk2(s[0 * 33], s[1 * 33]); o.y = pk2(s[2 * 33], s[3 * 33]); o.z = pk2(s[4 * 33], s[5 * 33]); o.w = pk2(s[6 * 33], s[7 * 33]);
        const int src = n0 + n;
        const int dr = MAP == 0 ? map_ident(src) : MAP == 1 ? map_kr(src) : MAP == 2 ? map_uq(src) : map_ukv(src);
        *(v4u*)(WT + (size_t)dr * K + k0 + 8 * c) = o; }
    LDS_WAIT(); asm volatile("" ::: "memory");
}

__device__ __forceinline__ void phase_prep(const Params& P, LAS unsigned char* lds, int vcu, int G, int wave) {
    const int lane = hw_lane(), tid = wave * 64 + lane;
    unsigned char* ws = P.ws;
    LAS float* scr = (LAS float*)(lds + wave * 16384);
    const int gw = vcu * NWAVES + wave, NGW = G * NWAVES;
    const int gt = vcu * NTHREADS + tid, NGT = G * NTHREADS;
#pragma unroll 1
    for (int pi = 0; pi < 3; ++pi) {
        const int part = (pi + wave) % 3;
        if (part == 0) {
    constexpr int I1 = 32 * 128, IKR = 32 * 2, I2Q = 8 * 48, I2KV = 8 * 64, I3 = 32 * 64, I4 = 32 * 64;
    constexpr int NITEMS = I1 + IKR + I2Q + I2KV + I3 + I4;
    for (int it = gw; it < NITEMS; it += NGW) {
        int r = it;
        if (r < I1) { p0_transpose_item<0>(P.w_in, 2048, 4160, 0, nullptr, nullptr, 0, (bf16*)(ws + WS_BT1), scr, r, 128, lane); continue; } r -= I1;
        if (r < IKR) { p0_transpose_item<1>(P.w_in, 2048, 4160, 4096, nullptr, nullptr, 0, (bf16*)(ws + WS_BTKR), scr, r, 2, lane); continue; } r -= IKR;
        if (r < I2Q) { p0_transpose_item<2>(P.w_uq, 512, 1536, 0, P.qan, P.qan, 512, (bf16*)(ws + WS_BT2Q), scr, r, 48, lane); continue; } r -= I2Q;
        if (r < I2KV) { p0_transpose_item<3>(P.w_ukv, 512, 2048, 0, P.kvan, P.kvan, 512, (bf16*)(ws + WS_BT2KV), scr, r, 64, lane); continue; } r -= I2KV;
        if (r < I3) { p0_transpose_item<0>(P.w_o, 2048, 2048, 0, P.ond, P.onm, 1024, (bf16*)(ws + WS_BT3), scr, r, 64, lane); continue; } r -= I3;
        p0_transpose_item<0>(P.wq, 2048, 2048, 0, P.ln2, P.ln2, 2048, (bf16*)(ws + WS_BT4), scr, r, 64, lane);
    }
        } else if (part == 1) {
    {
        bf16* XN = (bf16*)(ws + WS_A);
        f32x4 gv[8];
#pragma unroll
        for (int j = 0; j < 8; ++j) gv[j] = ((const f32x4*)P.ln1)[lane + 64 * j];
        for (int m = gw; m < M; m += NGW) {
            const f32x4* xr = (const f32x4*)(P.x + (size_t)m * DM) + lane;
            f32x4 v[8]; float s = 0.f;
#pragma unroll
            for (int j = 0; j < 8; ++j) { v[j] = xr[64 * j]; s += (v[j].x * v[j].x + v[j].y * v[j].y) + (v[j].z * v[j].z + v[j].w * v[j].w); }
            const float rs = rsqrtf(wave_sum(s) * (1.f / DM) + EPS);
            v2u* o8 = (v2u*)(XN + (size_t)m * DM) + lane;
#pragma unroll
            for (int j = 0; j < 8; ++j) { v2u o; o.x = pk2(v[j].x * rs * gv[j].x, v[j].y * rs * gv[j].y); o.y = pk2(v[j].z * rs * gv[j].z, v[j].w * rs * gv[j].w); o8[64 * j] = o; }
        }
    }
        } else {
        v2u* ou = (v2u*)(ws + WS_UB);
#pragma unroll 4
        for (int i = gt; i < 16384 * 2048 / 8; i += NGT) {
            const f32x4 a = __builtin_nontemporal_load((const f32x4*)P.pu + 2 * i), b = __builtin_nontemporal_load((const f32x4*)P.pu + 2 * i + 1);
            const int k8 = (i & 255) * 2; const f32x4 g0 = ((const f32x4*)P.ln2)[k8] * 32.f, g1 = ((const f32x4*)P.ln2)[k8 + 1] * 32.f;
            int w0 = 0, w1 = 0;
            w0 = __builtin_amdgcn_cvt_pk_fp8_f32(a.x * g0.x, a.y * g0.y, w0, false); w0 = __builtin_amdgcn_cvt_pk_fp8_f32(a.z * g0.z, a.w * g0.w, w0, true);
            w1 = __builtin_amdgcn_cvt_pk_fp8_f32(b.x * g1.x, b.y * g1.y, w1, false); w1 = __builtin_amdgcn_cvt_pk_fp8_f32(b.z * g1.z, b.w * g1.w, w1, true);
            v2u w; w.x = (unsigned)w0; w.y = (unsigned)w1; ou[i] = w;
        }
        }
    }
    {
        f32x2* R = (f32x2*)(ws + WS_ROPE);
        for (int i = gt; i < 2048 * 32; i += NGT) { const int pos = i >> 5, j = i & 31; const float freq = powf(10000.0f, -(float)j / 32.0f), ang = (float)pos * freq;
            f32x2 cs; cs.x = cosf(ang); cs.y = sinf(ang); R[i] = cs; }
    }
    {
        v4u* o = (v4u*)(ws + WS_SK);
        for (int i = gt; i < 16 * 128 * 128 / 8; i += NGT) { const f32x4 a = ((const f32x4*)P.sk)[2 * i], b = ((const f32x4*)P.sk)[2 * i + 1];
            v4u w; w.x = pk2(a.x, a.y); w.y = pk2(a.z, a.w); w.z = pk2(b.x, b.y); w.w = pk2(b.z, b.w); o[i] = w; }
    }
    {
        __syncthreads();
        LAS v2u* tl = (LAS v2u*)lds;
        v2u* ov = (v2u*)(ws + WS_VB);
        for (int tile = vcu; tile < 1024; tile += G) {
            const int e0 = (tile >> 2) * 64, c0 = (tile & 3) * 64;
#pragma unroll
            for (int k = 0; k < 8; ++k) { const int it = tid + 512 * k, e = it >> 6, c = it & 63;
                const f32x4* src = (const f32x4*)(P.pv + (size_t)(e0 + e) * 2048 + (size_t)(c0 + c) * 8);
                const f32x4 a = __builtin_nontemporal_load(src), b = __builtin_nontemporal_load(src + 1);
                int w0 = 0, w1 = 0;
                w0 = __builtin_amdgcn_cvt_pk_fp8_f32(a.x * 2.f, a.y * 2.f, w0, false); w0 = __builtin_amdgcn_cvt_pk_fp8_f32(a.z * 2.f, a.w * 2.f, w0, true);
                w1 = __builtin_amdgcn_cvt_pk_fp8_f32(b.x * 2.f, b.y * 2.f, w1, false); w1 = __builtin_amdgcn_cvt_pk_fp8_f32(b.z * 2.f, b.w * 2.f, w1, true);
                v2u w; w.x = (unsigned)w0; w.y = (unsigned)w1; tl[c * 65 + e] = w; }
            __syncthreads();
#pragma unroll
            for (int k = 0; k < 8; ++k) { const int it = tid + 512 * k, c = it >> 6, e = it & 63; ov[(size_t)(c0 + c) * 16384 + e0 + e] = tl[c * 65 + e]; }
            __syncthreads();
        }
    }
}
namespace pg8 {
constexpr int BM = 256, BK = 64, HALF = 128, HTB = HALF * BK * 2, STAGE_BYTES = 8 * HTB, NXCD = 8, WGM = 8;
__host__ __device__ __forceinline__ int lds_byte(int r, int c) { const int st = (r >> 4) * 2 + (c >> 5), rr = r & 15, cc = c & 31, ob = rr * 64 + cc * 2; return st * 1024 + (ob ^ (((ob >> 9) & 1) << 5)); }
__host__ __device__ __forceinline__ void stage_rc(int b, int& R, int& C) { const int st = b / 1024, sb = b % 1024, swz = sb ^ (((sb >> 9) & 1) << 5); R = (st >> 1) * 16 + swz / 64; C = (st & 1) * 32 + (swz % 64) / 2; }
__host__ __device__ __forceinline__ int perm32(int rho) { const int n = rho >> 4, i = rho & 15; return 8 * (i >> 2) + 4 * n + (i & 3); }

struct Unit { int pm, pn, g; };
struct GemmSet { const bf16 *A0, *A1, *Bt0, *Bt1; int K; };

struct StaticOrder {
    int nM, nN0, nN, nwg, G, c;
    __device__ void init(int Mrows, int N0, int N1, int G_, int c_) { nM = Mrows / BM; nN0 = N0 / BM; nN = nN0 + N1 / BM; nwg = nM * nN; G = G_; c = c_; }
    __device__ bool next(int i, Unit& u) const {
        const long L = (long)i * G + c; if (L >= nwg) return false;
        int wgid = (int)L; { const int q = nwg / NXCD, r = nwg % NXCD, xcd = wgid % NXCD, off = wgid / NXCD; wgid = (xcd < r ? xcd * (q + 1) : r * (q + 1) + (xcd - r) * q) + off; }
        const int nig = WGM * nN, gid = wgid / nig, fm = gid * WGM, gsz = (nM - fm) < WGM ? (nM - fm) : WGM;
        u.pm = fm + ((wgid % nig) % gsz); int pn = (wgid % nig) / gsz; u.g = pn >= nN0 ? 1 : 0; u.pn = pn >= nN0 ? pn - nN0 : pn; return true;
    }
};

template <class Epi, class Sched>
__device__ __forceinline__ void gemm_phase(LAS unsigned char* lds, const GemmSet g, const Sched& S, const Epi& E, int wid) {
    const int lane = hw_lane(), tid = wid * 64 + lane, wr = wid >> 2, wc = wid & 3, fr = lane & 15, fq = lane >> 4;
    const int K = g.K, nt = K / BK;
    unsigned voffA[2], voffB[2];
#pragma unroll
    for (int i = 0; i < 2; ++i) { int R, C; stage_rc(tid * 16 + i * 8192, R, C); const int Rb = (R & ~31) + perm32(R & 31);
        voffA[i] = (unsigned)(R * K + C) * 2u; voffB[i] = (unsigned)(Rb * K + C) * 2u; }
    const size_t kstep = (size_t)(BK * 2);
    const size_t hstep = (size_t)HALF * K * 2;
    const size_t tstep = 2 * hstep;
    const unsigned ldsw = (unsigned)wid * 1024u;
    const int aoff = lds_byte(wr * 64 + fr, fq * 8), boff = lds_byte(wc * 32 + fr, fq * 8);
#define PG8_SA(b, h) (((b) * 2 + (h)) * HTB)
#define PG8_SB(b, h) ((4 + (b) * 2 + (h)) * HTB)
#define PG8_STAGE(bufoff, gbase, voff) do { _Pragma("unroll") for (int _i = 0; _i < 2; ++_i) \
        __builtin_amdgcn_global_load_lds((const unsigned*)((const char*)(gbase) + (voff)[_i]), (LAS unsigned*)(lds + (bufoff) + ldsw + _i * 8192), 16, 0, 0); } while (0)
#define PG8_LDA(dst, b, h) do { _Pragma("unroll") for (int m = 0; m < 4; ++m) _Pragma("unroll") for (int k = 0; k < 2; ++k) dst[m][k] = *(const LAS bf16x8*)(lds + PG8_SA(b, h) + aoff + m * 2048 + k * 1024); } while (0)
#define PG8_LDB(dst, b, h) do { _Pragma("unroll") for (int n = 0; n < 2; ++n) _Pragma("unroll") for (int k = 0; k < 2; ++k) dst[n][k] = *(const LAS bf16x8*)(lds + PG8_SB(b, h) + boff + n * 2048 + k * 1024); } while (0)
#define PG8_MMA(ai, bj, At, Bt) do { __builtin_amdgcn_s_setprio(1); _Pragma("unroll") for (int m = 0; m < 4; ++m) _Pragma("unroll") for (int n = 0; n < 2; ++n) _Pragma("unroll") for (int k = 0; k < 2; ++k) \
        acc[ai][bj][m][n] = __builtin_amdgcn_mfma_f32_16x16x32_bf16(Bt[n][k], At[m][k], acc[ai][bj][m][n], 0, 0, 0); __builtin_amdgcn_s_setprio(0); } while (0)
#define PG8_WAIT_V(n) asm volatile("s_waitcnt vmcnt(" #n ")" ::: "memory")
#define PG8_WAIT_L(n) asm volatile("s_waitcnt lgkmcnt(" #n ")" ::: "memory")
#define PG8_BAR __builtin_amdgcn_s_barrier()
#define PG8_SCHED __builtin_amdgcn_sched_barrier(0)
    Unit cur, nxt; int ui = 0;
    if (!S.next(0, cur)) return;
    f32x4 acc[2][2][4][2];
#pragma unroll
    for (int a = 0; a < 2; ++a)
#pragma unroll
        for (int b = 0; b < 2; ++b)
#pragma unroll
            for (int m = 0; m < 4; ++m)
#pragma unroll
                for (int n = 0; n < 2; ++n) acc[a][b][m][n] = (f32x4){0.f, 0.f, 0.f, 0.f};
    bf16x8 At[4][2], B0[2][2], B1[2][2];
    const char* cA = (const char*)(cur.g ? g.A1 : g.A0) + (size_t)cur.pm * tstep; const char* cB = (const char*)(cur.g ? g.Bt1 : g.Bt0) + (size_t)cur.pn * tstep;
    E.unit_begin(cur, 0, tid);
    PG8_STAGE(PG8_SB(0, 0), cB, voffB); PG8_STAGE(PG8_SB(0, 1), cB + hstep, voffB); PG8_STAGE(PG8_SA(0, 0), cA, voffA); PG8_STAGE(PG8_SA(0, 1), cA + hstep, voffA);
    if (wr == 1) PG8_BAR;
    PG8_WAIT_V(2); PG8_BAR;
    PG8_STAGE(PG8_SB(1, 0), cB + kstep, voffB); PG8_STAGE(PG8_SA(1, 0), cA + kstep, voffA); PG8_STAGE(PG8_SB(1, 1), cB + hstep + kstep, voffB);
    PG8_WAIT_V(6); PG8_BAR;
    for (;;) {
        const bool has_next = S.next(ui + 1, nxt);
        const char* nA = has_next ? (const char*)(nxt.g ? g.A1 : g.A0) + (size_t)nxt.pm * tstep : cA; const char* nB = has_next ? (const char*)(nxt.g ? g.Bt1 : g.Bt0) + (size_t)nxt.pn * tstep : cB;
        for (int t = 0; t < nt; t += 2) {
            const bool last = (t == nt - 2);
            const char* a1 = cA + (size_t)(t + 1) * kstep;
            const char* a2 = last ? nA : cA + (size_t)(t + 2) * kstep; const char* b2 = last ? nB : cB + (size_t)(t + 2) * kstep;
            const char* a3 = a2 + kstep; const char* b3 = b2 + kstep;
            if constexpr (Epi::MIDSCALE) { if (t == nt / 2) E.midscale(acc, ui & 1, wr, fr); }
            PG8_LDB(B0, 0, 0); PG8_LDB(B1, 0, 1); PG8_SCHED; PG8_LDA(At, 0, 0); PG8_STAGE(PG8_SA(1, 1), a1 + hstep, voffA);
            PG8_WAIT_V(8); PG8_WAIT_L(0); PG8_BAR; PG8_MMA(0, 0, At, B0); PG8_MMA(0, 1, At, B1); PG8_BAR; PG8_SCHED;
            PG8_LDA(At, 0, 1); PG8_STAGE(PG8_SB(0, 0), b2, voffB); PG8_STAGE(PG8_SB(0, 1), b2 + hstep, voffB); PG8_STAGE(PG8_SA(0, 0), a2, voffA);
            PG8_WAIT_V(8); PG8_WAIT_L(0); PG8_BAR; PG8_MMA(1, 0, At, B0); PG8_MMA(1, 1, At, B1); PG8_BAR; PG8_SCHED;
            PG8_LDB(B0, 1, 0); PG8_LDB(B1, 1, 1); PG8_SCHED; PG8_LDA(At, 1, 0); PG8_STAGE(PG8_SA(0, 1), a2 + hstep, voffA);
            PG8_WAIT_V(8); PG8_WAIT_L(0); PG8_BAR; PG8_MMA(0, 0, At, B0); PG8_MMA(0, 1, At, B1); PG8_BAR; PG8_SCHED;
            PG8_LDA(At, 1, 1); PG8_STAGE(PG8_SB(1, 0), b3, voffB); PG8_STAGE(PG8_SB(1, 1), b3 + hstep, voffB); PG8_STAGE(PG8_SA(1, 0), a3, voffA);
            PG8_WAIT_V(8); PG8_WAIT_L(0); PG8_BAR; PG8_MMA(1, 0, At, B0); PG8_MMA(1, 1, At, B1); PG8_BAR; PG8_SCHED;
        }
        if (wr == 0) PG8_BAR;
        E(acc, cur, ui & 1, wr, wc, fr, fq);
        if (!has_next) break;
#pragma unroll
        for (int a = 0; a < 2; ++a)
#pragma unroll
            for (int b = 0; b < 2; ++b)
#pragma unroll
                for (int m = 0; m < 4; ++m)
#pragma unroll
                    for (int n = 0; n < 2; ++n) acc[a][b][m][n] = (f32x4){0.f, 0.f, 0.f, 0.f};
        cur = nxt; cA = nA; cB = nB; ++ui;
        E.unit_begin(cur, ui & 1, tid);
        if (wr == 1) PG8_BAR;
    }
    PG8_WAIT_V(0);
    PG8_BAR;
#undef PG8_SA
#undef PG8_SB
#undef PG8_STAGE
#undef PG8_LDA
#undef PG8_LDB
#undef PG8_MMA
#undef PG8_WAIT_V
#undef PG8_WAIT_L
#undef PG8_BAR
#undef PG8_SCHED
}
}
namespace pg8 {
__device__ __forceinline__ v4u pack8(const f32x4& v0, const f32x4& v1) { v4u w; w.x = pk2(v0[0], v0[1]); w.y = pk2(v0[2], v0[3]); w.z = pk2(v1[0], v1[1]); w.w = pk2(v1[2], v1[3]); return w; }
__device__ __forceinline__ float sq8(const f32x4& v0, const f32x4& v1) { return (v0[0] * v0[0] + v0[1] * v0[1]) + (v0[2] * v0[2] + v0[3] * v0[3]) + (v1[0] * v1[0] + v1[1] * v1[1]) + (v1[2] * v1[2] + v1[3] * v1[3]); }

struct Epi1 {
    static constexpr bool MIDSCALE = false;
    bf16 *QKV, *CQ, *CKV; float *SSQCQ, *SSQCKV;
    __device__ __forceinline__ void midscale(f32x4 (&)[2][2][4][2], int, int, int) const {}
    __device__ __forceinline__ void unit_begin(const Unit&, int, int) const {}
    __device__ __forceinline__ void operator()(const f32x4 (&acc)[2][2][4][2], const Unit& u, int par, int wr, int wc, int fr, int fq) const {
        const int pn = u.pn; bf16* base; int ldc, colt; float sc = 1.f; float* ssq = nullptr; int sslot = 0;
        if (pn < 12) { base = QKV; ldc = 3072; colt = pn * 256; if (pn < 4) sc = QSCALE_DIL; }
        else if (pn < 14) { base = CQ; ldc = 512; colt = (pn - 12) * 256; ssq = SSQCQ; sslot = (pn - 12) * 4 + wc; }
        else { base = CKV; ldc = 512; colt = (pn - 14) * 256; ssq = SSQCKV; sslot = (pn - 14) * 4 + wc; }
        const int row0 = u.pm * BM + wr * 64 + fr, col0 = colt + wc * 32 + 8 * fq;
#pragma unroll
        for (int ai = 0; ai < 2; ++ai)
#pragma unroll
            for (int m = 0; m < 4; ++m) { const int row = row0 + ai * HALF + m * 16; bf16* rowp = base + (size_t)row * ldc + col0; float ss = 0.f;
#pragma unroll
                for (int bj = 0; bj < 2; ++bj) { const f32x4 v0 = acc[ai][bj][m][0] * sc, v1 = acc[ai][bj][m][1] * sc; ss += sq8(v0, v1); *(v4u*)(rowp + bj * HALF) = pack8(v0, v1); }
                if (ssq) { ss += __shfl_xor(ss, 16); ss += __shfl_xor(ss, 32); if (fq == 0) ssq[(size_t)row * 8 + sslot] = ss; } }
    }
};

struct Epi2 {
    static constexpr bool MIDSCALE = false;
    bf16 *QN, *QPE, *KN, *VM; const float *SSQCQ, *SSQCKV; const f32x2* ROPE;
    __device__ __forceinline__ void midscale(f32x4 (&)[2][2][4][2], int, int, int) const {}
    __device__ __forceinline__ void unit_begin(const Unit&, int, int) const {}
    __device__ __forceinline__ void operator()(const f32x4 (&acc)[2][2][4][2], const Unit& u, int par, int wr, int wc, int fr, int fq) const {
        const int pn = u.pn; bf16* base; int ldc, colt; float sc = 1.f; bool rope = false; const float* ssq;
        if (u.g == 0) { ssq = SSQCQ; sc = QSCALE_MLA; if (pn < 4) { base = QN; ldc = 1024; colt = pn * 256; } else { base = QPE; ldc = 512; colt = (pn - 4) * 256; rope = true; } }
        else { ssq = SSQCKV; if (pn < 4) { base = KN; ldc = 1024; colt = pn * 256; } else { base = VM; ldc = 1024; colt = (pn - 4) * 256; } }
        const int row0 = u.pm * BM + wr * 64 + fr, col0 = colt + wc * 32 + 8 * fq;
#pragma unroll
        for (int ai = 0; ai < 2; ++ai)
#pragma unroll
            for (int m = 0; m < 4; ++m) { const int row = row0 + ai * HALF + m * 16; bf16* rowp = base + (size_t)row * ldc + col0;
                const f32x4 p0 = *(const f32x4*)(ssq + (size_t)row * 8), p1 = *(const f32x4*)(ssq + (size_t)row * 8 + 4);
                const float rs = rsqrtf(((p0[0] + p0[1]) + (p0[2] + p0[3]) + (p1[0] + p1[1]) + (p1[2] + p1[3])) * (1.f / 512.f) + EPS) * sc;
#pragma unroll
                for (int bj = 0; bj < 2; ++bj) { f32x4 v0 = acc[ai][bj][m][0] * rs, v1 = acc[ai][bj][m][1] * rs;
                    if (rope) { const int j0 = ((col0 + bj * HALF) & 63) >> 1; const f32x4* rp = (const f32x4*)(ROPE + (size_t)(row & (SEQ - 1)) * 32 + j0);
                        const f32x4 r0 = rp[0], r1 = rp[1];
                        f32x4 w0, w1;
                        w0[0] = v0[0] * r0[0] - v0[1] * r0[1]; w0[1] = v0[0] * r0[1] + v0[1] * r0[0];
                        w0[2] = v0[2] * r0[2] - v0[3] * r0[3]; w0[3] = v0[2] * r0[3] + v0[3] * r0[2];
                        w1[0] = v1[0] * r1[0] - v1[1] * r1[1]; w1[1] = v1[0] * r1[1] + v1[1] * r1[0];
                        w1[2] = v1[2] * r1[2] - v1[3] * r1[3]; w1[3] = v1[2] * r1[3] + v1[3] * r1[2];
                        v0 = w0; v1 = w1; }
                    *(v4u*)(rowp + bj * HALF) = pack8(v0, v1); } }
    }
};

struct Epi3 {
    static constexpr bool MIDSCALE = true;
    bf16* H1B; const float* X; const float* SSQO; float* SSQH; LAS f32x2* RS;
    __device__ __forceinline__ void unit_begin(const Unit& u, int par, int tid) const {
        if (tid < 256) { const f32x4* p = (const f32x4*)(SSQO + (size_t)(u.pm * BM + tid) * 16); const f32x4 a0 = p[0], a1 = p[1], b0 = p[2], b1 = p[3];
            const float ra = rsqrtf(((a0[0] + a0[1]) + (a0[2] + a0[3]) + (a1[0] + a1[1]) + (a1[2] + a1[3])) * (1.f / 1024.f) + EPS);
            const float rb = rsqrtf(((b0[0] + b0[1]) + (b0[2] + b0[3]) + (b1[0] + b1[1]) + (b1[2] + b1[3])) * (1.f / 1024.f) + EPS);
            f32x2 v; v.x = ra / rb; v.y = rb; RS[par * 256 + tid] = v; }
    }
    __device__ __forceinline__ void midscale(f32x4 (&acc)[2][2][4][2], int par, int wr, int fr) const {
#pragma unroll
        for (int ai = 0; ai < 2; ++ai)
#pragma unroll
            for (int m = 0; m < 4; ++m) { const float f = RS[par * 256 + ai * HALF + wr * 64 + m * 16 + fr].x;
#pragma unroll
                for (int bj = 0; bj < 2; ++bj) { acc[ai][bj][m][0] = acc[ai][bj][m][0] * f; acc[ai][bj][m][1] = acc[ai][bj][m][1] * f; } }
    }
    __device__ __forceinline__ void operator()(const f32x4 (&acc)[2][2][4][2], const Unit& u, int par, int wr, int wc, int fr, int fq) const {
        const int row0 = u.pm * BM + wr * 64 + fr, col0 = u.pn * BM + wc * 32 + 8 * fq, sslot = u.pn * 4 + wc;
#pragma unroll
        for (int ai = 0; ai < 2; ++ai)
#pragma unroll
            for (int m = 0; m < 4; ++m) { const int row = row0 + ai * HALF + m * 16; const float rb = RS[par * 256 + ai * HALF + wr * 64 + m * 16 + fr].y; float ss = 0.f;
#pragma unroll
                for (int bj = 0; bj < 2; ++bj) { const float* xp = X + (size_t)row * DM + col0 + bj * HALF; const f32x4 x0 = *(const f32x4*)xp, x1 = *(const f32x4*)(xp + 4);
                    const f32x4 v0 = acc[ai][bj][m][0] * rb + x0, v1 = acc[ai][bj][m][1] * rb + x1; ss += sq8(v0, v1);
                    *(v4u*)(H1B + (size_t)row * DM + col0 + bj * HALF) = pack8(v0, v1); }
                ss += __shfl_xor(ss, 16); ss += __shfl_xor(ss, 32); if (fq == 0) SSQH[(size_t)row * 32 + sslot] = ss; }
    }
};

struct Epi4 {
    static constexpr bool MIDSCALE = false;
    bf16* QP;
    __device__ __forceinline__ void midscale(f32x4 (&)[2][2][4][2], int, int, int) const {}
    __device__ __forceinline__ void unit_begin(const Unit&, int, int) const {}
    __device__ __forceinline__ void operator()(const f32x4 (&acc)[2][2][4][2], const Unit& u, int par, int wr, int wc, int fr, int fq) const {
        const int row0 = u.pm * BM + wr * 64 + fr, col0 = u.pn * BM + wc * 32 + 8 * fq;
#pragma unroll
        for (int ai = 0; ai < 2; ++ai)
#pragma unroll
            for (int m = 0; m < 4; ++m) { const int row = row0 + ai * HALF + m * 16;
#pragma unroll
                for (int bj = 0; bj < 2; ++bj) *(v4u*)(QP + (size_t)row * DM + col0 + bj * HALF) = pack8(acc[ai][bj][m][0], acc[ai][bj][m][1]); }
    }
};
struct EpiNull {
    static constexpr bool MIDSCALE = false;
    __device__ __forceinline__ void midscale(f32x4 (&)[2][2][4][2], int, int, int) const {}
    __device__ __forceinline__ void unit_begin(const Unit&, int, int) const {}
    __device__ __forceinline__ void operator()(const f32x4 (&acc)[2][2][4][2], const Unit& u, int par, int wr, int wc, int fr, int fq) const {
#pragma unroll
        for (int ai = 0; ai < 2; ++ai)
#pragma unroll
            for (int bj = 0; bj < 2; ++bj)
#pragma unroll
                for (int m = 0; m < 4; ++m)
#pragma unroll
                    for (int n = 0; n < 2; ++n) asm volatile("" :: "v"(acc[ai][bj][m][n]));
    }
};
}

__device__ __forceinline__ void kr_item(const bf16* __restrict__ XN, const bf16* __restrict__ BT, const f32x2* __restrict__ ROPE, bf16* __restrict__ KPE, int item, int wave, int lane) {
    const int fr = lane & 15, fq = lane >> 4, row = item * 128 + wave * 16 + fr;
    const bf16* ap = XN + (size_t)row * 2048 + fq * 8; const bf16* bp = BT + (size_t)fr * 2048 + fq * 8;
    f32x4 acc[4];
#pragma unroll
    for (int nb = 0; nb < 4; ++nb) acc[nb] = (f32x4){0.f, 0.f, 0.f, 0.f};
#pragma unroll 4
    for (int k0 = 0; k0 < 2048; k0 += 32) {
        const bf16x8 a = *(const bf16x8*)(ap + k0);
#pragma unroll
        for (int nb = 0; nb < 4; ++nb) { const bf16x8 b = *(const bf16x8*)(bp + (size_t)nb * 16 * 2048 + k0); acc[nb] = __builtin_amdgcn_mfma_f32_16x16x32_bf16(b, a, acc[nb], 0, 0, 0); }
    }
    const int pos = row & (SEQ - 1);
#pragma unroll
    for (int nb = 0; nb < 4; ++nb) { const int j0 = 8 * nb + 2 * fq; const f32x4 r = *(const f32x4*)(ROPE + (size_t)pos * 32 + j0); const f32x4 v = acc[nb];
        v2u o; o.x = pk2(v[0] * r[0] - v[1] * r[1], v[0] * r[1] + v[1] * r[0]); o.y = pk2(v[2] * r[2] - v[3] * r[3], v[2] * r[3] + v[3] * r[2]);
        *(v2u*)(KPE + (size_t)row * 64 + 16 * nb + 4 * fq) = o; }
}
namespace att {
typedef short v4i16_t __attribute__((ext_vector_type(4)));
#define MFMA32(a, b, c) __builtin_amdgcn_mfma_f32_32x32x16_bf16((a), (b), (c), 0, 0, 0)
__device__ __forceinline__ s16x4 vtr(const LAS unsigned char* p) { return __builtin_bit_cast(s16x4, __builtin_amdgcn_ds_read_tr16_b64_v4i16((LAS v4i16_t*)p)); }
__device__ __forceinline__ int crow(int r, int hi) { return (r & 3) + 8 * (r >> 2) + 4 * hi; }
constexpr int VS = 320;
constexpr int KS = 400;
constexpr float NEG = -1e30f;

__device__ __forceinline__ bf16x8 pack8r(const f32x16& p, int s) {
    v4u w; w.x = pk2(p[8 * s + 0], p[8 * s + 1]); w.y = pk2(p[8 * s + 2], p[8 * s + 3]); w.z = pk2(p[8 * s + 4], p[8 * s + 5]); w.w = pk2(p[8 * s + 6], p[8 * s + 7]);
    return __builtin_bit_cast(bf16x8, w);
}
__device__ __forceinline__ void pv32(f32x16 (&o)[4], const LAS unsigned char* vb, const bf16x8 pb0, const bf16x8 pb1) {
#pragma unroll
    for (int d = 0; d < 4; ++d) {
        const s16x4 l0 = vtr(vb + d * 64), h0 = vtr(vb + d * 64 + 8 * VS), l1 = vtr(vb + d * 64 + 16 * VS), h1 = vtr(vb + d * 64 + 24 * VS);
        const bf16x8 a0 = __builtin_shufflevector(l0, h0, 0, 1, 2, 3, 4, 5, 6, 7), a1 = __builtin_shufflevector(l1, h1, 0, 1, 2, 3, 4, 5, 6, 7);
        o[d] = MFMA32(a0, pb0, o[d]); o[d] = MFMA32(a1, pb1, o[d]);
    }
}
template <int NS>
__device__ __forceinline__ void softmax_step(f32x16 (&s)[NS], float& m, float& l, f32x16 (&o)[4], bf16x8 (&pb)[2 * NS]) {
    float mx = s[0][0];
#pragma unroll
    for (int t = 0; t < NS; ++t)
#pragma unroll
        for (int r = 0; r < 16; ++r) mx = fmaxf(mx, s[t][r]);
    mx = fmaxf(mx, __shfl_xor(mx, 32));
    const float mn = fmaxf(m, mx), alpha = __builtin_amdgcn_exp2f(m - mn); m = mn;
    float ps = 0.f;
#pragma unroll
    for (int t = 0; t < NS; ++t)
#pragma unroll
        for (int r = 0; r < 16; ++r) { const float p = __builtin_amdgcn_exp2f(s[t][r] - mn); s[t][r] = p; ps += p; }
    l = l * alpha + ps;
    if (!__all(alpha == 1.0f)) {
#pragma unroll
        for (int d = 0; d < 4; ++d) o[d] = o[d] * alpha;
    }
#pragma unroll
    for (int t = 0; t < NS; ++t) { pb[2 * t] = pack8r(s[t], 0); pb[2 * t + 1] = pack8r(s[t], 1); }
}
__device__ __forceinline__ void store_o(f32x16 (&o)[4], float l, bf16* __restrict__ orow  , float* __restrict__ ssq  , int hh) {
    l += __shfl_xor(l, 32);
    const float inv = 1.0f / l; float ss = 0.f;
#pragma unroll
    for (int d = 0; d < 4; ++d) { o[d] = o[d] * inv;
#pragma unroll
        for (int g = 0; g < 4; ++g) { const float a = o[d][4 * g], b = o[d][4 * g + 1], c = o[d][4 * g + 2], e = o[d][4 * g + 3];
            ss += (a * a + b * b) + (c * c + e * e);
            v2u w; w.x = pk2(a, b); w.y = pk2(c, e); *(v2u*)(orow + 32 * d + 8 * g + 4 * hh) = w; } }
    ss += __shfl_xor(ss, 32);
    if (hh == 0) *ssq = ss;
}

constexpr int KTB = 64 * KS, VTB = 64 * VS, BUFB = KTB + VTB;
__device__ __forceinline__ void mla_unit(const unsigned char* ws, LAS unsigned char* lds, int b, int h, int qblk, int tid, int wave, int lane) {
    const bf16* QN = (const bf16*)(ws + WS_QN); const bf16* QPE = (const bf16*)(ws + WS_QPE);
    bf16* O = (bf16*)(ws + WS_A); float* SSQO = (float*)(ws + WS_SSQO);
    const int r32 = lane & 31, hh = lane >> 5;
    const size_t tok0 = (size_t)b * SEQ;
    const int row_lo = qblk * 256 + wave * 32, qrow = row_lo + r32;
    bf16x8 qf[12];
    { const bf16* qn = QN + (tok0 + qrow) * 1024 + h * 128 + 8 * hh;
#pragma unroll
      for (int s = 0; s < 8; ++s) qf[s] = *(const bf16x8*)(qn + 16 * s);
      const bf16* qp = QPE + (tok0 + qrow) * 512 + h * 64 + 8 * hh;
#pragma unroll
      for (int s = 0; s < 4; ++s) qf[8 + s] = *(const bf16x8*)(qp + 16 * s); }
    const int c0 = tid, c1 = tid + 512;
    const unsigned okn0 = (unsigned)WS_KN + (unsigned)(((unsigned)tok0 + (c0 >> 4)) * 1024u + h * 128 + (c0 & 15) * 8) * 2u, okn1 = okn0 + 32u * 1024u * 2u;
    const unsigned okp = (unsigned)WS_KPE + (unsigned)(((unsigned)tok0 + (tid >> 3)) * 64u + (tid & 7) * 8) * 2u;
    const unsigned ov0 = okn0 + (unsigned)(WS_VM - WS_KN), ov1 = ov0 + 32u * 1024u * 2u;
    const int lkn0 = (c0 >> 4) * KS + (c0 & 15) * 16, lkn1 = (c1 >> 4) * KS + (c1 & 15) * 16, lkp = (tid >> 3) * KS + 256 + (tid & 7) * 16;
    const int lv0 = KTB + (c0 >> 4) * VS + (c0 & 15) * 16, lv1 = KTB + (c1 >> 4) * VS + (c1 & 15) * 16;
    v4u st0, st1, st2, st3, st4;
#define MLA_GLOAD(kt) do { const unsigned _o = (unsigned)(kt) * 131072u, _p = (unsigned)(kt) * 8192u; st0 = *(const v4u*)(ws + (size_t)(okn0 + _o)); st1 = *(const v4u*)(ws + (size_t)(okn1 + _o)); \
        st2 = *(const v4u*)(ws + (size_t)(okp + _p)); st3 = *(const v4u*)(ws + (size_t)(ov0 + _o)); st4 = *(const v4u*)(ws + (size_t)(ov1 + _o)); } while (0)
#define MLA_LWRITE(buf) do { LAS unsigned char* _b = lds + (buf) * BUFB; *(LAS v4u*)(_b + lkn0) = st0; *(LAS v4u*)(_b + lkn1) = st1; *(LAS v4u*)(_b + lkp) = st2; \
        *(LAS v4u*)(_b + lv0) = st3; *(LAS v4u*)(_b + lv1) = st4; } while (0)
    const int nkt = 4 * (qblk + 1);
    MLA_GLOAD(0); MLA_LWRITE(0);
    __syncthreads();
    f32x16 o[4];
#pragma unroll
    for (int d = 0; d < 4; ++d)
#pragma unroll
        for (int r = 0; r < 16; ++r) o[d][r] = 0.f;
    float m = NEG, l = 0.f;
    const int kread = r32 * KS + 16 * hh;
    const int vread = KTB + (4 * hh + ((lane & 15) >> 2)) * VS + (16 * ((lane >> 4) & 1) + 4 * (lane & 3)) * 2;
    for (int kt = 0; kt < nkt; ++kt) {
        if (kt + 1 < nkt) MLA_GLOAD(kt + 1);
        const int k0 = kt * 64;
        if (k0 <= row_lo + 31) {
            const LAS unsigned char* kb = lds + (kt & 1) * BUFB;
            const bool diag = (k0 + 63 > row_lo);
#pragma unroll
            for (int sub = 0; sub < 2; ++sub) {
                if (sub == 1 && k0 + 32 > row_lo + 31) break;
                f32x16 s[1];
#pragma unroll
                for (int r = 0; r < 16; ++r) s[0][r] = 0.f;
#pragma unroll
                for (int ks = 0; ks < 12; ++ks) { const bf16x8 kf = *(const LAS bf16x8*)(kb + kread + sub * 32 * KS + 32 * ks); s[0] = MFMA32(kf, qf[ks], s[0]); }
                if (diag) {
#pragma unroll
                    for (int r = 0; r < 16; ++r) { const int key = k0 + 32 * sub + crow(r, hh); if (key > qrow) s[0][r] = NEG; }
                }
                bf16x8 pb[2];
                softmax_step<1>(s, m, l, o, pb);
                pv32(o, kb + vread + sub * 32 * VS, pb[0], pb[1]);
            }
        }
        if (kt + 1 < nkt) MLA_LWRITE((kt + 1) & 1);
        __syncthreads();
    }
#undef MLA_GLOAD
#undef MLA_LWRITE
    store_o(o, l, O + (tok0 + qrow) * 2048 + 1024 + h * 128, SSQO + (tok0 + qrow) * 16 + 8 + h, hh);
}

constexpr int DKS = 272, DSH = 32 * DKS + 32 * VS;
__device__ __forceinline__ void dil_tile(const unsigned char* ws, LAS unsigned char* vl  , LAS unsigned char* sh  , int b, int h, int j, int r16, int tid, int lane) {
    const bf16* QKV = (const bf16*)(ws + WS_B);
    const int r32 = lane & 31, hh = lane >> 5;
    const size_t tok0 = (size_t)b * SEQ;
    const int tq = 512 * j + 16 * r32 + r16;
    bf16x8 qf[8];
    { const bf16* qp = QKV + (tok0 + tq) * 3072 + h * 128 + 8 * hh;
#pragma unroll
      for (int s = 0; s < 8; ++s) qf[s] = *(const bf16x8*)(qp + 16 * s); }
    const float slope2 = __builtin_amdgcn_exp2f(-(float)(h + 1)) * LOG2E;
    const int m0 = (j == 0) ? 4 : 0, n3 = j + 1, n2 = 8 - m0, n1 = 20 - m0, nt = n3 + n2;
    const unsigned kcol = (unsigned)WS_B + ((unsigned)tok0 * 3072u + 1024u + h * 128 + 8 * hh) * 2u;
    const unsigned vcol = (unsigned)WS_B + ((unsigned)tok0 * 3072u + 2048u + h * 128 + (lane & 15) * 8) * 2u;
    const int vrow = lane >> 4;
    const int vwr = vrow * VS + (lane & 15) * 16;
    const int vread = (4 * hh + ((lane & 15) >> 2)) * VS + (16 * ((lane >> 4) & 1) + 4 * (lane & 3)) * 2;
    int kbase, kstride, maxd;
#define DIL_DESC(idx) do { const int _i = (idx); if (_i < n3) { kbase = 512 * (j - _i) + r16; kstride = 16; maxd = 2048; } \
        else if (_i < n3 + n2) { kbase = 4 * (128 * j - 128 + 32 * (m0 + _i - n3)) + (r16 & 3); kstride = 4; maxd = 512; } \
        else { kbase = 512 * j - 128 + 32 * (m0 + _i - n3 - n2); kstride = 1; maxd = 128; } } while (0)
    bf16x8 kc[8]; v4u vn[8];
    DIL_DESC(0);
    { const unsigned kp = kcol + (unsigned)(kbase + kstride * r32) * 6144u;
#pragma unroll
      for (int s = 0; s < 8; ++s) kc[s] = *(const bf16x8*)(ws + (size_t)(kp + 32 * s));
#pragma unroll
      for (int i = 0; i < 8; ++i) vn[i] = *(const v4u*)(ws + (size_t)(vcol + (unsigned)(kbase + kstride * (4 * i + vrow)) * 6144u));
#pragma unroll
      for (int i = 0; i < 8; ++i) *(LAS v4u*)(vl + vwr + 4 * i * VS) = vn[i]; }
    f32x16 o[4];
#pragma unroll
    for (int d = 0; d < 4; ++d)
#pragma unroll
        for (int r = 0; r < 16; ++r) o[d][r] = 0.f;
    float m = NEG, l = 0.f;
    for (int idx = 0; idx < nt; ++idx) {
        const int cb = kbase, cs = kstride, cm = maxd;
        const bool more = idx + 1 < nt;
        if (more) {
            DIL_DESC(idx + 1);
#pragma unroll
            for (int i = 0; i < 8; ++i) vn[i] = *(const v4u*)(ws + (size_t)(vcol + (unsigned)(kbase + kstride * (4 * i + vrow)) * 6144u));
        }
        f32x16 s[1];
#pragma unroll
        for (int r = 0; r < 16; ++r) s[0][r] = 0.f;
#pragma unroll
        for (int ks = 0; ks < 8; ++ks) s[0] = MFMA32(kc[ks], qf[ks], s[0]);
        if (more) {
            const unsigned kp = kcol + (unsigned)(kbase + kstride * r32) * 6144u;
#pragma unroll
            for (int s2 = 0; s2 < 8; ++s2) kc[s2] = *(const bf16x8*)(ws + (size_t)(kp + 32 * s2));
        }
        const int d0 = tq - cb - cs * 4 * hh;
#pragma unroll
        for (int r = 0; r < 16; ++r) { const int dist = d0 - cs * ((r & 3) + 8 * (r >> 2)); const float v = s[0][r] - slope2 * (float)dist; s[0][r] = ((unsigned)dist <= (unsigned)cm) ? v : NEG; }
        bf16x8 pb[2];
        softmax_step<1>(s, m, l, o, pb);
        pv32(o, vl + vread, pb[0], pb[1]);
        if (more) {
#pragma unroll
            for (int i = 0; i < 8; ++i) *(LAS v4u*)(vl + vwr + 4 * i * VS) = vn[i];
        }
    }
#undef DIL_DESC
    {
        const int kb0 = 512 * j - 128 + 32 * m0;
        const int row = tid >> 4, ch = tid & 15;
        const unsigned gk = (unsigned)WS_B + (((unsigned)tok0 + kb0 + row) * 3072u + 1024u + h * 128 + ch * 8) * 2u;
        const int lk = row * DKS + ch * 16, lv = 32 * DKS + row * VS + ch * 16;
        const int kread = r32 * DKS + 16 * hh;
        const int vread1 = 32 * DKS + (4 * hh + ((lane & 15) >> 2)) * VS + (16 * ((lane >> 4) & 1) + 4 * (lane & 3)) * 2;
        v4u sk = *(const v4u*)(ws + (size_t)gk), sv = *(const v4u*)(ws + (size_t)(gk + 2048u));
        *(LAS v4u*)(sh + lk) = sk; *(LAS v4u*)(sh + lv) = sv;
        __syncthreads();
        for (int mi = 0; mi < n1; ++mi) {
            const bool more = mi + 1 < n1;
            if (more) { const unsigned g2 = gk + (unsigned)(mi + 1) * 32u * 6144u; sk = *(const v4u*)(ws + (size_t)g2); sv = *(const v4u*)(ws + (size_t)(g2 + 2048u)); }
            const LAS unsigned char* tb = sh + (mi & 1) * DSH;
            f32x16 s[1];
#pragma unroll
            for (int r = 0; r < 16; ++r) s[0][r] = 0.f;
#pragma unroll
            for (int ks = 0; ks < 8; ++ks) { const bf16x8 kf = *(const LAS bf16x8*)(tb + kread + 32 * ks); s[0] = MFMA32(kf, qf[ks], s[0]); }
            const int d0 = tq - (kb0 + 32 * mi) - 4 * hh;
#pragma unroll
            for (int r = 0; r < 16; ++r) { const int dist = d0 - ((r & 3) + 8 * (r >> 2)); const float v = s[0][r] - slope2 * (float)dist; s[0][r] = ((unsigned)dist <= 128u) ? v : NEG; }
            bf16x8 pb[2];
            softmax_step<1>(s, m, l, o, pb);
            pv32(o, tb + vread1, pb[0], pb[1]);
            if (more) { LAS unsigned char* nb = sh + ((mi + 1) & 1) * DSH; *(LAS v4u*)(nb + lk) = sk; *(LAS v4u*)(nb + lv) = sv; }
            __syncthreads();
        }
    }
    store_o(o, l, (bf16*)(const_cast<unsigned char*>(ws) + WS_A) + (tok0 + tq) * 2048 + h * 128, (float*)(const_cast<unsigned char*>(ws) + WS_SSQO) + (tok0 + tq) * 16 + h, hh);
}

__device__ __forceinline__ void phase_attn(const Params& P, LAS unsigned char* lds, int vcu, int G, int wave) {
    const int lane = hw_lane(), tid = wave * 64 + lane;
    const unsigned char* ws = P.ws;
#ifndef REP_MLA
#define REP_MLA 1
#endif
#ifndef REP_DIL
#define REP_DIL 1
#endif
    for (int rm_ = 0; rm_ < REP_MLA; ++rm_)
    for (int u = vcu; u < 256; u += G) { const int bh = u >> 2, pr = u & 3;
        mla_unit(ws, lds, bh >> 3, bh & 7, 7 - pr, tid, wave, lane);
        mla_unit(ws, lds, bh >> 3, bh & 7, pr, tid, wave, lane); }
    __syncthreads();
    LAS unsigned char* vl = lds + wave * (32 * VS); LAS unsigned char* sh = lds + NWAVES * (32 * VS);
    for (int rd_ = 0; rd_ < REP_DIL; ++rd_)
    if (G == 256) {
#pragma unroll 1
        for (int k = 0; k < 2; ++k) { const int t = (vcu >> 5) * 512 + k * 256 + (vcu & 31) * 8 + wave; const int bh = t >> 6, rem = t & 63, jj = rem >> 4, r16 = rem & 15;
            dil_tile(ws, vl, sh, bh >> 3, bh & 7, k == 0 ? jj : 3 - jj, r16, tid, lane); }
    } else {
#pragma unroll 1
        for (int t = vcu * 8 + wave; t < 4096; t += G * 8) { const int bh = t >> 6, rem = t & 63; dil_tile(ws, vl, sh, bh >> 3, bh & 7, rem >> 4, rem & 15, tid, lane); }
    }
}
}
namespace peer {
typedef __bf16 bf2_t __attribute__((ext_vector_type(2)));
#define MFMA32(a, b, c) __builtin_amdgcn_mfma_f32_32x32x16_bf16((a), (b), (c), 0, 0, 0)
__device__ __forceinline__ float fmax3(float a, float b, float c) { return fmaxf(fmaxf(a, b), c); }
__device__ __forceinline__ float asf(unsigned u) { return __builtin_bit_cast(float, u); }
__device__ __forceinline__ unsigned asu(float f) { return __builtin_bit_cast(unsigned, f); }

__device__ __forceinline__ void route_item(const unsigned char* ws, LAS unsigned* sc, int tile, int h, int lane) {
    const bf16* QP = (const bf16*)(ws + WS_QP); const bf16* SK = (const bf16*)(ws + WS_SK);
    int* RIDX = (int*)(ws + WS_RIDX); float* RGATE = (float*)(ws + WS_RGATE);
    const int r32 = lane & 31, hh = lane >> 5;
    const size_t tok = (size_t)tile * 32 + r32;
    float rs2; { const f32x4* sp = (const f32x4*)((const float*)(ws + WS_SSQH) + tok * 32); f32x4 a = sp[0];
#pragma unroll
        for (int i = 1; i < 8; ++i) a = a + sp[i];
        rs2 = rsqrtf(((a[0] + a[1]) + (a[2] + a[3])) * (1.f / 2048.f) + EPS); }
#pragma unroll 1
    for (int p = 0; p < 2; ++p) {
        f32x16 s[4];
#pragma unroll
        for (int kb = 0; kb < 4; ++kb)
#pragma unroll
            for (int r = 0; r < 16; ++r) s[kb][r] = 0.f;
        const bf16* qp = QP + tok * 2048 + h * 256 + p * 128 + 8 * hh;
        const bf16* kp = SK + ((size_t)(h * 2 + p) * 128 + r32) * 128 + 8 * hh;
#pragma unroll
        for (int ks = 0; ks < 8; ++ks) { const bf16x8 q = *(const bf16x8*)(qp + 16 * ks);
#pragma unroll
            for (int kb = 0; kb < 4; ++kb) { const bf16x8 k = *(const bf16x8*)(kp + (size_t)kb * 32 * 128 + 16 * ks); s[kb] = MFMA32(k, q, s[kb]); } }
#pragma unroll
        for (int kb = 0; kb < 4; ++kb)
#pragma unroll
            for (int r = 0; r < 16; ++r) s[kb][r] = asf((asu(s[kb][r] * rs2) & ~127u) | (unsigned)(32 * kb + (r & 3) + 8 * (r >> 2) + 4 * hh));
#pragma unroll 1
        for (int k = 0; k < 16; ++k) {
            float mx = s[0][0];
#pragma unroll
            for (int kb = 0; kb < 4; ++kb)
#pragma unroll
                for (int r = 0; r < 16; r += 2) mx = fmax3(mx, s[kb][r], s[kb][r + 1]);
            mx = fmaxf(mx, __shfl_xor(mx, 32));
            if (hh == 0) sc[(p * 32 + r32) * 16 + k] = asu(mx);
#pragma unroll
            for (int kb = 0; kb < 4; ++kb)
#pragma unroll
                for (int r = 0; r < 16; ++r) s[kb][r] = (s[kb][r] == mx) ? -3.0e38f : s[kb][r];
        }
    }
    unsigned t1[16], t2[16];
#pragma unroll
    for (int i = 0; i < 16; i += 4) { const v4u a = *(const LAS v4u*)(sc + r32 * 16 + i), b = *(const LAS v4u*)(sc + (32 + r32) * 16 + i);
        t1[i] = a.x; t1[i + 1] = a.y; t1[i + 2] = a.z; t1[i + 3] = a.w; t2[i] = b.x; t2[i + 1] = b.y; t2[i + 2] = b.z; t2[i + 3] = b.w; }
    float c[50]; int n = 0;
#pragma unroll
    for (int i = 0; i < 16; ++i)
#pragma unroll
        for (int j = 0; j < 16; ++j) if ((i + 1) * (j + 1) <= 16) { const float v = asf(t1[i] & ~127u) + asf(t2[j] & ~127u); c[n] = asf((asu(v) & ~255u) | (unsigned)(i * 16 + j)); ++n; }
    float best[8]; float bmax = 0.f, esum = 0.f;
#pragma unroll
    for (int k = 0; k < 16; ++k) {
        float mx = c[0];
#pragma unroll
        for (int q = 1; q < 49; q += 2) mx = fmax3(mx, c[q], c[q + 1]);
        mx = fmaxf(mx, c[49]);
#pragma unroll
        for (int q = 0; q < 50; ++q) c[q] = (c[q] == mx) ? -3.0e38f : c[q];
        const float val = asf(asu(mx) & ~255u);
        if (k == 0) bmax = val;
        esum += __expf(val - bmax);
        if ((k >> 3) == hh) best[k & 7] = mx;
    }
    const float inv = 1.0f / esum;
    int idx[8]; float gate[8];
#pragma unroll
    for (int k = 0; k < 8; ++k) { const unsigned code = asu(best[k]) & 255u; const unsigned a = sc[r32 * 16 + (code >> 4)], b = sc[(32 + r32) * 16 + (code & 15)];
        idx[k] = (int)((a & 127u) * 128u + (b & 127u)); gate[k] = __expf(asf(asu(best[k]) & ~255u) - bmax) * inv; }
    int* ip = RIDX + tok * 128 + h * 16 + 8 * hh; float* gp = RGATE + tok * 128 + h * 16 + 8 * hh;
    *(v4u*)ip = (v4u){(unsigned)idx[0], (unsigned)idx[1], (unsigned)idx[2], (unsigned)idx[3]}; *(v4u*)(ip + 4) = (v4u){(unsigned)idx[4], (unsigned)idx[5], (unsigned)idx[6], (unsigned)idx[7]};
    *(f32x4*)gp = (f32x4){gate[0], gate[1], gate[2], gate[3]}; *(f32x4*)(gp + 4) = (f32x4){gate[4], gate[5], gate[6], gate[7]};
}

__device__ __forceinline__ void phase_route(const Params& P, LAS unsigned char* lds, int vcu, int G, int wave) {
    const int lane = hw_lane();
    LAS unsigned* sc = (LAS unsigned*)(lds + wave * 4096);
#pragma unroll 1
    for (int it = vcu * NWAVES + wave; it < 512 * 8; it += G * NWAVES) route_item(P.ws, sc, it >> 3, it & 7, lane);
}

__device__ __forceinline__ void phase_regroup(const Params& P, int vcu, int G, int wave) {
    const int lane = hw_lane();
    const unsigned char* ws = P.ws;
    const int* RIDX = (const int*)(ws + WS_RIDX); const float* RGATE = (const float*)(ws + WS_RGATE);
    int* SIDX = (int*)(ws + WS_SIDX); float* SGATE = (float*)(ws + WS_SGATE); unsigned char* GOFF = (unsigned char*)(ws + WS_GOFF);
    const unsigned long long lt = (1ull << lane) - 1ull;
#pragma unroll 1
    for (int t = vcu * NWAVES + wave; t < M; t += G * NWAVES) {
        const size_t tok = (size_t)t;
        const int i0 = RIDX[tok * 128 + lane], i1 = RIDX[tok * 128 + 64 + lane];
        const float g0 = RGATE[tok * 128 + lane], g1 = RGATE[tok * 128 + 64 + lane];
        const int q0 = i0 >> 10, q1 = i1 >> 10;
        int off = 0, pos0 = 0, pos1 = 0, myoff = 0;
#pragma unroll
        for (int g = 0; g < 16; ++g) {
            const unsigned long long m0 = __ballot(q0 == g), m1 = __ballot(q1 == g);
            const int c0 = __popcll(m0), c1 = __popcll(m1);
            if (q0 == g) pos0 = off + __popcll(m0 & lt);
            if (q1 == g) pos1 = off + c0 + __popcll(m1 & lt);
            if (lane == g) myoff = off;
            off += c0 + c1;
        }
        if (lane == 16) myoff = 128;
        SIDX[tok * 128 + pos0] = i0; SIDX[tok * 128 + pos1] = i1;
        SGATE[tok * 128 + pos0] = g0; SGATE[tok * 128 + pos1] = g1;
        if (lane < 32) GOFF[tok * 32 + lane] = (unsigned char)(lane <= 16 ? myoff : 128);
    }
}
__device__ __forceinline__ float dot16_f8(const float (&x)[16], const v4u& u, float c) {
    const int u0 = (int)u.x, u1 = (int)u.y, u2 = (int)u.z, u3 = (int)u.w;
    const f32x2 a0 = __builtin_amdgcn_cvt_pk_f32_fp8(u0, false), a1 = __builtin_amdgcn_cvt_pk_f32_fp8(u0, true);
    const f32x2 a2 = __builtin_amdgcn_cvt_pk_f32_fp8(u1, false), a3 = __builtin_amdgcn_cvt_pk_f32_fp8(u1, true);
    const f32x2 a4 = __builtin_amdgcn_cvt_pk_f32_fp8(u2, false), a5 = __builtin_amdgcn_cvt_pk_f32_fp8(u2, true);
    const f32x2 a6 = __builtin_amdgcn_cvt_pk_f32_fp8(u3, false), a7 = __builtin_amdgcn_cvt_pk_f32_fp8(u3, true);
    c = fmaf(x[0], a0.x, c); c = fmaf(x[1], a0.y, c); c = fmaf(x[2], a1.x, c); c = fmaf(x[3], a1.y, c);
    c = fmaf(x[4], a2.x, c); c = fmaf(x[5], a2.y, c); c = fmaf(x[6], a3.x, c); c = fmaf(x[7], a3.y, c);
    c = fmaf(x[8], a4.x, c); c = fmaf(x[9], a4.y, c); c = fmaf(x[10], a5.x, c); c = fmaf(x[11], a5.y, c);
    c = fmaf(x[12], a6.x, c); c = fmaf(x[13], a6.y, c); c = fmaf(x[14], a7.x, c); c = fmaf(x[15], a7.y, c);
    return c;
}
__device__ __forceinline__ void unpack8(float* x, const v4u& v) { x[0] = bflo(v.x); x[1] = bfhi(v.x); x[2] = bflo(v.y); x[3] = bfhi(v.y); x[4] = bflo(v.z); x[5] = bfhi(v.z); x[6] = bflo(v.w); x[7] = bfhi(v.w); }
__device__ __forceinline__ void peer_u_token(const Params& P, size_t tok, int lane) {
    const unsigned char* ws = P.ws;
    const bf16* H1B = (const bf16*)(ws + WS_B); const unsigned char* U8 = ws + WS_UB;
    const int* RIDX = (const int*)(ws + WS_SIDX); const float* RGATE = (const float*)(ws + WS_SGATE); const float* SSQH = (const float*)(ws + WS_SSQH);
    unsigned* PKV = (unsigned*)(ws + WS_PKV);
    float x0[16], x1[16];
    { const bf16* hp = H1B + tok * 2048 + 16 * lane; const v4u a = *(const v4u*)hp, b = *(const v4u*)(hp + 8), c = *(const v4u*)(hp + 1024), d = *(const v4u*)(hp + 1032);
      unpack8(x0, a); unpack8(x0 + 8, b); unpack8(x1, c); unpack8(x1 + 8, d); }
    const float rs2 = rsqrtf(wave_sum(lane < 32 ? SSQH[tok * 32 + lane] : 0.f) * (1.f / 2048.f) + EPS) * (1.f / 32.f);
    const int i0 = RIDX[tok * 128 + lane], i1 = RIDX[tok * 128 + 64 + lane];
    const float g0 = RGATE[tok * 128 + lane], g1 = RGATE[tok * 128 + 64 + lane];
    float d0 = 0.f, d1 = 0.f;
    v4u ra[16], rb[16];
#define PU_LOAD(buf, g) do { _Pragma("unroll") for (int e = 0; e < 8; ++e) { const int row = __builtin_amdgcn_readlane((g) < 8 ? i0 : i1, ((g) & 7) * 8 + e); \
        const unsigned char* up = U8 + (size_t)row * 2048 + 16 * lane; buf[2 * e] = *(const v4u*)up; buf[2 * e + 1] = *(const v4u*)(up + 1024); } } while (0)
#define PU_COMPUTE(buf, g) do { float pt[8]; _Pragma("unroll") for (int e = 0; e < 8; ++e) pt[e] = dot16_f8(x1, buf[2 * e + 1], dot16_f8(x0, buf[2 * e], 0.f)); \
        float a4[4], a2[2], a1; \
        _Pragma("unroll") for (int i = 0; i < 4; ++i) { const float keep = (lane & 1) ? pt[2 * i + 1] : pt[2 * i], give = (lane & 1) ? pt[2 * i] : pt[2 * i + 1]; a4[i] = keep + __shfl_xor(give, 1); } \
        _Pragma("unroll") for (int i = 0; i < 2; ++i) { const float keep = (lane & 2) ? a4[2 * i + 1] : a4[2 * i], give = (lane & 2) ? a4[2 * i] : a4[2 * i + 1]; a2[i] = keep + __shfl_xor(give, 2); } \
        { const float keep = (lane & 4) ? a2[1] : a2[0], give = (lane & 4) ? a2[0] : a2[1]; a1 = keep + __shfl_xor(give, 4); } \
        a1 += __shfl_xor(a1, 8); a1 += __shfl_xor(a1, 16); a1 += __shfl_xor(a1, 32); \
        if ((lane >> 3) == ((g) & 7)) { if ((g) < 8) d0 = a1; else d1 = a1; } } while (0)
    PU_LOAD(ra, 0);
#pragma unroll 1
    for (int g = 0; g < 16; g += 2) {
        PU_LOAD(rb, g + 1);
        PU_COMPUTE(ra, g);
        if (g + 2 < 16) PU_LOAD(ra, g + 2);
        PU_COMPUTE(rb, g + 1);
    }
#undef PU_LOAD
#undef PU_COMPUTE
    const float z0 = d0 * rs2, z1 = d1 * rs2;
    const float a0 = 8.0f * z0 * (1.0f + erff(z0 * 0.7071067811865476f)) * g0, a1v = 8.0f * z1 * (1.0f + erff(z1 * 0.7071067811865476f)) * g1;
    unsigned* pk = PKV + ((tok >> 6) * 128) * 64 + (tok & 63);
    pk[(size_t)lane * 64] = ((unsigned)i0 << 2) | ((unsigned)__builtin_bit_cast(unsigned short, (_Float16)a0) << 16);
    pk[(size_t)(64 + lane) * 64] = ((unsigned)i1 << 2) | ((unsigned)__builtin_bit_cast(unsigned short, (_Float16)a1v) << 16);
}
#ifndef U_WAVES
#define U_WAVES 4
#endif
__device__ __forceinline__ void phase_peer_u(const Params& P, int vcu, int G, int wave) {
    const int lane = hw_lane();
    if (wave >= U_WAVES) return;
#pragma unroll 1
    for (int t = vcu * U_WAVES + wave; t < M; t += G * U_WAVES) peer_u_token(P, (size_t)t, lane);
}
typedef _Float16 h2_t __attribute__((ext_vector_type(2)));
__device__ __forceinline__ void peer_v_range(const Params& P, int c, int b0, int b1, int wv, int nwv, int lane) {
    const unsigned char* ws = P.ws;
    const bf16* H1B = (const bf16*)(ws + WS_B); const unsigned* PKV = (const unsigned*)(ws + WS_PKV);
    if (b0 + wv >= b1) return;
    unsigned w0[16], w1[16], w2[16], w3[16];
#define PV_LOAD(buf) do { _Pragma("unroll") for (int i = 0; i < 16; ++i) buf[i] = pl[i * 64]; pl += 16 * 64; asm volatile("" : "+v"(pl)); } while (0)
#define PV_PROC(buf) do { v2u vv[16]; _Pragma("unroll") for (int i = 0; i < 16; ++i) vv[i] = *(const LAS v2u*)(size_t)((buf[i] << 1) & 0x1fff8u);     \
        _Pragma("unroll") for (int i = 0; i < 16; ++i) { const _Float16 ah = __builtin_bit_cast(_Float16, (unsigned short)(buf[i] >> 16)); const h2_t a2 = {ah, ah}; \
            y0 = __builtin_elementwise_fma(a2, __builtin_bit_cast(h2_t, __builtin_amdgcn_cvt_scalef32_pk_f16_fp8(vv[i].x, 1.0f, false)), y0); \
            y1 = __builtin_elementwise_fma(a2, __builtin_bit_cast(h2_t, __builtin_amdgcn_cvt_scalef32_pk_f16_fp8(vv[i].x, 1.0f, true)), y1); \
            y2 = __builtin_elementwise_fma(a2, __builtin_bit_cast(h2_t, __builtin_amdgcn_cvt_scalef32_pk_f16_fp8(vv[i].y, 1.0f, false)), y2); \
            y3 = __builtin_elementwise_fma(a2, __builtin_bit_cast(h2_t, __builtin_amdgcn_cvt_scalef32_pk_f16_fp8(vv[i].y, 1.0f, true)), y3); } } while (0)
    const unsigned* pl = PKV + (size_t)(b0 + wv) * 128 * 64 + lane;
    PV_LOAD(w0); PV_LOAD(w1); PV_LOAD(w2);
    v4u hxn = *(const v4u*)(H1B + ((size_t)(b0 + wv) * 64 + lane) * 2048 + 8 * c);
#pragma unroll 1
    for (int b = b0 + wv; b < b1; b += nwv) {
        const size_t tok = (size_t)b * 64 + lane;
        const int bn = (b + nwv < b1) ? b + nwv : b;
        h2_t y0 = {0, 0}, y1 = {0, 0}, y2 = {0, 0}, y3 = {0, 0};
        v4u hx = hxn;
#pragma unroll 1
        for (int half = 0; half < 2; ++half) {
            PV_LOAD(w3); PV_PROC(w0);
            if (half == 1) { hxn = *(const v4u*)(H1B + ((size_t)bn * 64 + lane) * 2048 + 8 * c); pl += (ptrdiff_t)(bn - b - 1) * 128 * 64; }
            PV_LOAD(w0); PV_PROC(w1);
            PV_LOAD(w1); PV_PROC(w2);
            PV_LOAD(w2); PV_PROC(w3);
        }
        float y[8]; unpack8(y, hx);
        constexpr float S = 1.0f / 32.0f;
        y[0] += S * (float)y0[0]; y[1] += S * (float)y0[1]; y[2] += S * (float)y1[0]; y[3] += S * (float)y1[1];
        y[4] += S * (float)y2[0]; y[5] += S * (float)y2[1]; y[6] += S * (float)y3[0]; y[7] += S * (float)y3[1];
        float* op = P.out + tok * 2048 + 8 * c;
        *(f32x4*)op = (f32x4){y[0], y[1], y[2], y[3]}; *(f32x4*)(op + 4) = (f32x4){y[4], y[5], y[6], y[7]};
    }
#undef PV_LOAD
#undef PV_PROC
}
__device__ __forceinline__ void peer_v_fill(const Params& P, int c, int tid) {
    const v4u* src = (const v4u*)(P.ws + WS_VB + (size_t)c * 131072);
#pragma unroll 4
    for (int i = tid; i < 8192; i += NTHREADS) *(LAS v4u*)(size_t)(16 * i) = src[i];
}
__device__ __forceinline__ void phase_final(const Params& P, int vcu, int G, int wave) {
    const int lane = hw_lane();
    f32x4 gv[8];
#pragma unroll
    for (int j = 0; j < 8; ++j) gv[j] = ((const f32x4*)P.lnf)[lane + 64 * j];
#pragma unroll 1
    for (int t = vcu * NWAVES + wave; t < M; t += G * NWAVES) {
        f32x4* row = (f32x4*)(P.out + (size_t)t * 2048) + lane;
        f32x4 v[8]; float s = 0.f;
#pragma unroll
        for (int j = 0; j < 8; ++j) { v[j] = row[64 * j]; s += (v[j].x * v[j].x + v[j].y * v[j].y) + (v[j].z * v[j].z + v[j].w * v[j].w); }
        const float rs = rsqrtf(wave_sum(s) * (1.f / 2048.f) + EPS);
#pragma unroll
        for (int j = 0; j < 8; ++j) row[64 * j] = v[j] * rs * gv[j];
    }
}
#undef MFMA32
}
#define XB_TMO      128
#define XB_XCNT(j)  (256  + 64 * (j))
#define XB_XSUB(j)  (1280 + 64 * (j))
#define XB_XGEN(j)  (2304 + 64 * (j))
#define XB_TOP      3328
#define XB_TOPGEN   3392
#define XCD_BAR_WORDS 3456
#define XB_SPIN_CAP (1u << 22)
__device__ __forceinline__ unsigned xb_ld(unsigned* p)              { return __hip_atomic_load(p, __ATOMIC_RELAXED, __HIP_MEMORY_SCOPE_AGENT); }
__device__ __forceinline__ unsigned xb_add(unsigned* p, unsigned v) { return __hip_atomic_fetch_add(p, v, __ATOMIC_RELAXED, __HIP_MEMORY_SCOPE_AGENT); }
__device__ __forceinline__ unsigned xb_xcc_id() { return (unsigned)__builtin_amdgcn_s_getreg((3 << 11) | 20) & 0xFu; }
#define XB_SPIN(cond, bar) do { unsigned _sp = 0; while (cond) { __builtin_amdgcn_s_sleep(1); \
    if ((++_sp & 255u) == 0u) { if (xb_ld(&(bar)[XB_TMO])) break; if (_sp > XB_SPIN_CAP) { atomicAdd(&(bar)[XB_TMO], 1u); break; } } } } while (0)
struct XcdBarrier { unsigned* bar; unsigned x; volatile LAS unsigned* st; };
__device__ __forceinline__ XcdBarrier xcd_barrier_post(unsigned* bar, volatile LAS unsigned* st, bool leader) {
    XcdBarrier b; b.bar = bar; b.x = xb_xcc_id(); b.st = st;
    if (leader) (void)xb_add(&bar[XB_XCNT(b.x)], 1u);
    return b;
}
__device__ __forceinline__ void xcd_barrier_complete(unsigned* bar, unsigned x, unsigned& nloc, unsigned& nx) {
    const unsigned G = gridDim.x * gridDim.y * gridDim.z;
    unsigned sum, cnt, mine, sp = 0u;
    for (;;) {
        sum = 0u; cnt = 0u; mine = 0u;
#pragma unroll
        for (unsigned j = 0; j < 16; ++j) { const unsigned c = xb_ld(&bar[XB_XCNT(j)]); sum += c; cnt += (c > 0u) ? 1u : 0u; mine = (j == x) ? c : mine; }
        if (sum == G) break;
        __builtin_amdgcn_s_sleep(1);
        if ((++sp & 255u) == 0u) { if (xb_ld(&bar[XB_TMO])) break; if (sp > XB_SPIN_CAP) { atomicAdd(&bar[XB_TMO], 1u); break; } }
    }
    nloc = mine > 0u ? mine : 1u; nx = cnt > 0u ? cnt : 1u;
}
__device__ __forceinline__ void xcd_barrier(const XcdBarrier& b, int wave) {
    asm volatile("s_waitcnt vmcnt(0)" ::: "memory");
    __syncthreads();
    if (wave == 0 && hw_lane() == 0) {
        unsigned* bar = b.bar;
        __builtin_amdgcn_s_waitcnt(0);
        unsigned nloc = b.st[0], nx = b.st[1];
        if (nloc == 0u) { xcd_barrier_complete(bar, b.x, nloc, nx); b.st[0] = nloc; b.st[1] = nx; }
        const unsigned old = xb_add(&bar[XB_XSUB(b.x)], 1u);
        const unsigned gen = old / nloc;
        if (old + 1u == (gen + 1u) * nloc) {
            __builtin_amdgcn_fence(__ATOMIC_RELEASE, "agent");
            asm volatile("s_waitcnt vmcnt(0)" ::: "memory");
            const unsigned og = xb_add(&bar[XB_TOP], 1u);
            const unsigned tg = og / nx;
            if (og + 1u == (tg + 1u) * nx) xb_add(&bar[XB_TOPGEN], 1u);
            else XB_SPIN(xb_ld(&bar[XB_TOPGEN]) == tg, bar);
            __builtin_amdgcn_fence(__ATOMIC_ACQUIRE, "agent");
            xb_add(&bar[XB_XGEN(b.x)], 1u);
            asm volatile("s_waitcnt vmcnt(0)" ::: "memory");
        } else {
            XB_SPIN(xb_ld(&bar[XB_XGEN(b.x)]) == gen, bar);
            __builtin_amdgcn_fence(__ATOMIC_ACQUIRE, "agent");
            asm volatile("s_waitcnt vmcnt(0)" ::: "memory");
        }
    }
    __syncthreads();
}
constexpr int N_PHASES = 11;
#ifndef REP_PHASE
#define REP_PHASE -1
#endif
#ifndef REP_N
#define REP_N 1
#endif
#ifndef EXTRA_SYNCS
#define EXTRA_SYNCS 0
#endif
__global__ void __launch_bounds__(NTHREADS, 2) mega(Params P) {
    extern __shared__ __attribute__((aligned(16))) unsigned char lds_raw[];
    LAS unsigned char* lds = (LAS unsigned char*)lds_raw;
    cg::grid_group grid = cg::this_grid();
    const int wave = __builtin_amdgcn_readfirstlane((int)threadIdx.x >> 6);
    const int G = gridDim.x, bx = blockIdx.x;
    const int vcu = (G % 8 == 0) ? (bx % 8) * (G / 8) + bx / 8 : bx;
    unsigned char* ws = P.ws;
    const int lo = P.ph_lo, hi = P.ph_hi;
#define IN(k) (lo <= (k) && (k) < hi)
#ifndef CG_SEAMS
#define CG_SEAMS 1
#endif
    volatile LAS unsigned* xbst = (volatile LAS unsigned*)(lds + MISC_OFF + 8192);
    if (wave == 0 && hw_lane() == 0) { xbst[0] = 0u; xbst[1] = 0u; xbst[2] = 0u; xbst[3] = 0u; }
    __syncthreads();
    const XcdBarrier xbar = xcd_barrier_post((unsigned*)(ws + WS_CTL) + 4096, xbst, wave == 0 && hw_lane() == 0);
#define GSYNC(k) do { if ((k) < CG_SEAMS) grid.sync(); else xcd_barrier(xbar, wave); } while (0)
#define SEAM(k) do { if (IN(k) && IN((k) + 1)) GSYNC(k); } while (0)

    for (int rep_ = 0; rep_ < (REP_PHASE == 0 ? 1 + REP_N : 1); ++rep_) if (IN(0)) { if (rep_) GSYNC(9); phase_prep(P, lds, vcu, G, wave); }
    SEAM(0);
    for (int es_ = 0; es_ < EXTRA_SYNCS; ++es_) GSYNC(9);
    for (int rep_ = 0; rep_ < (REP_PHASE == 1 ? 1 + REP_N : 1); ++rep_) if (IN(1)) { if (rep_) GSYNC(9);
        pg8::GemmSet g; g.A0 = g.A1 = (const bf16*)(ws + WS_A); g.Bt0 = g.Bt1 = (const bf16*)(ws + WS_BT1); g.K = 2048;
        pg8::StaticOrder S; S.init(M, 4096, 0, G, bx);
        pg8::Epi1 E{(bf16*)(ws + WS_B), (bf16*)(ws + WS_CQ), (bf16*)(ws + WS_CKV), (float*)(ws + WS_SSQCQ), (float*)(ws + WS_SSQCKV)};
        pg8::gemm_phase<pg8::Epi1, pg8::StaticOrder>(lds, g, S, E, wave);
    }
    SEAM(1);
    for (int rep_ = 0; rep_ < (REP_PHASE == 2 ? 1 + REP_N : 1); ++rep_) if (IN(2)) { if (rep_) GSYNC(9);
        pg8::GemmSet g; g.A0 = (const bf16*)(ws + WS_CQ); g.A1 = (const bf16*)(ws + WS_CKV); g.Bt0 = (const bf16*)(ws + WS_BT2Q); g.Bt1 = (const bf16*)(ws + WS_BT2KV); g.K = 512;
        pg8::StaticOrder S; S.init(M, 1536, 2048, G, bx);
        pg8::Epi2 E{(bf16*)(ws + WS_QN), (bf16*)(ws + WS_QPE), (bf16*)(ws + WS_KN), (bf16*)(ws + WS_VM), (const float*)(ws + WS_SSQCQ), (const float*)(ws + WS_SSQCKV), (const f32x2*)(ws + WS_ROPE)};
        pg8::gemm_phase<pg8::Epi2, pg8::StaticOrder>(lds, g, S, E, wave);
        for (int it = G - 1 - bx; it < 128; it += G) kr_item((const bf16*)(ws + WS_A), (const bf16*)(ws + WS_BTKR), (const f32x2*)(ws + WS_ROPE), (bf16*)(ws + WS_KPE), it, wave, hw_lane());
    }
    SEAM(2);
    for (int rep_ = 0; rep_ < (REP_PHASE == 3 ? 1 + REP_N : 1); ++rep_) if (IN(3)) { if (rep_) GSYNC(9); att::phase_attn(P, lds, vcu, G, wave); }
    SEAM(3);
    for (int rep_ = 0; rep_ < (REP_PHASE == 4 ? 1 + REP_N : 1); ++rep_) if (IN(4)) { if (rep_) GSYNC(9);
        pg8::GemmSet g; g.A0 = g.A1 = (const bf16*)(ws + WS_A); g.Bt0 = g.Bt1 = (const bf16*)(ws + WS_BT3); g.K = 2048;
        pg8::StaticOrder S; S.init(M, 2048, 0, G, bx);
        pg8::Epi3 E{(bf16*)(ws + WS_B), P.x, (const float*)(ws + WS_SSQO), (float*)(ws + WS_SSQH), (LAS f32x2*)(lds + MISC_OFF)};
        pg8::gemm_phase<pg8::Epi3, pg8::StaticOrder>(lds, g, S, E, wave);
    }
    SEAM(4);
    for (int rep_ = 0; rep_ < (REP_PHASE == 5 ? 1 + REP_N : 1); ++rep_) if (IN(5)) { if (rep_) GSYNC(9);
        pg8::GemmSet g; g.A0 = g.A1 = (const bf16*)(ws + WS_B); g.Bt0 = g.Bt1 = (const bf16*)(ws + WS_BT4); g.K = 2048;
        pg8::StaticOrder S; S.init(M, 2048, 0, G, bx);
        pg8::Epi4 E{(bf16*)(ws + WS_QP)};
        pg8::gemm_phase<pg8::Epi4, pg8::StaticOrder>(lds, g, S, E, wave);
    }
#ifdef EXTRA_G4
    if (IN(5)) { GSYNC(9);
        pg8::GemmSet g; g.A0 = g.A1 = (const bf16*)(ws + WS_B); g.Bt0 = g.Bt1 = (const bf16*)(ws + WS_BT4); g.K = 2048;
        pg8::StaticOrder S; S.init(M, 2048, 0, G, bx);
#if EXTRA_G4 == 1
        pg8::Epi4 E{(bf16*)(ws + WS_QP)}; pg8::gemm_phase<pg8::Epi4, pg8::StaticOrder>(lds, g, S, E, wave);
#else
        pg8::EpiNull E{}; pg8::gemm_phase<pg8::EpiNull, pg8::StaticOrder>(lds, g, S, E, wave);
#endif
    }
#endif
    SEAM(5);
    for (int rep_ = 0; rep_ < (REP_PHASE == 6 ? 1 + REP_N : 1); ++rep_) if (IN(6)) { if (rep_) GSYNC(9); peer::phase_route(P, lds, vcu, G, wave); }
    SEAM(6);
    for (int rep_ = 0; rep_ < (REP_PHASE == 7 ? 1 + REP_N : 1); ++rep_) if (IN(7)) { if (rep_) GSYNC(9); peer::phase_regroup(P, vcu, G, wave); }
    SEAM(7);
    for (int rep_ = 0; rep_ < (REP_PHASE == 8 ? 1 + REP_N : 1); ++rep_) if (IN(8)) { if (rep_) GSYNC(9); peer::phase_peer_u(P, vcu, G, wave); }
    SEAM(8);
    for (int rep_ = 0; rep_ < (REP_PHASE == 9 ? 1 + REP_N : 1); ++rep_) if (IN(9)) { if (rep_) GSYNC(9);
        const int lane_ = hw_lane();
        for (int c = vcu; c < 256; c += G) { __syncthreads(); peer::peer_v_fill(P, c, wave * 64 + lane_); __syncthreads(); peer::peer_v_range(P, c, 0, 256, wave, NWAVES, lane_); }
    }
    SEAM(9);
    for (int rep_ = 0; rep_ < (REP_PHASE == 10 ? 1 + REP_N : 1); ++rep_) if (IN(10)) { if (rep_) GSYNC(9); peer::phase_final(P, vcu, G, wave); }
#undef IN
#undef SEAM
}

static int mega_grid() {
    static int grid = 0;
    if (grid == 0) {
        int dev = 0, cus = 0, per_cu = 0;
        (void)hipGetDevice(&dev); (void)hipDeviceGetAttribute(&cus, hipDeviceAttributeMultiprocessorCount, dev);
        (void)hipFuncSetAttribute((const void*)mega, hipFuncAttributeMaxDynamicSharedMemorySize, LDS_BYTES);
        (void)hipOccupancyMaxActiveBlocksPerMultiprocessor(&per_cu, (const void*)mega, NTHREADS, LDS_BYTES);
        if (per_cu < 1) { fprintf(stderr, "mega: occupancy query says %d blocks/CU\n", per_cu); per_cu = 1; }
        grid = cus;
        (void)hipGetLastError();
    }
    return grid;
}
static void fill_params(Params& P, void* const* d_in, void* d_out, void* d_ws) {
    P.x = (const float*)d_in[0]; P.ln1 = (const float*)d_in[1]; P.w_in = (const float*)d_in[2]; P.qan = (const float*)d_in[3]; P.kvan = (const float*)d_in[4];
    P.w_uq = (const float*)d_in[5]; P.w_ukv = (const float*)d_in[6]; P.ond = (const float*)d_in[7]; P.onm = (const float*)d_in[8]; P.w_o = (const float*)d_in[9];
    P.ln2 = (const float*)d_in[10]; P.wq = (const float*)d_in[11]; P.sk = (const float*)d_in[12]; P.pu = (const float*)d_in[13]; P.pv = (const float*)d_in[14]; P.lnf = (const float*)d_in[15];
    P.out = (float*)d_out; P.ws = (unsigned char*)d_ws;
}
static void launch_phases(Params P, int lo, int hi, hipStream_t st) {
    P.ph_lo = lo; P.ph_hi = hi;
    (void)hipMemsetAsync(P.ws + WS_CTL, 0, CTL_ZERO_BYTES, st);
    void* args[] = {&P};
    hipError_t e = hipLaunchCooperativeKernel((const void*)mega, dim3(mega_grid()), dim3(NTHREADS), args, LDS_BYTES, st);
    if (e != hipSuccess) fprintf(stderr, "mega launch [%d,%d) failed: %s\n", lo, hi, hipGetErrorString(e));
}
extern "C" void kernel_launch(void* const* d_in, const int* in_sizes, int n_in, void* d_out, int out_size, void* d_ws, size_t ws_size, hipStream_t stream) {
    Params P{}; fill_params(P, d_in, d_out, d_ws);
    launch_phases(P, 0, N_PHASES, stream);
}
```

```cpp
#include <hip/hip_runtime.h>
#include <hip/hip_cooperative_groups.h>
#include <cstdio>
#include <cstdint>
#include <cstddef>
namespace cg = cooperative_groups;
#define GAS __attribute__((address_space(1)))
#define LAS __attribute__((address_space(3)))
typedef unsigned short bf16;
typedef unsigned v4u __attribute__((ext_vector_type(4)));
typedef unsigned v2u __attribute__((ext_vector_type(2)));
typedef float f32x2 __attribute__((ext_vector_type(2)));
typedef float f32x4 __attribute__((ext_vector_type(4)));
typedef float f32x16 __attribute__((ext_vector_type(16)));
typedef short bf16x8 __attribute__((ext_vector_type(8)));
typedef short s16x4 __attribute__((ext_vector_type(4)));
typedef __bf16 bf16x2_t __attribute__((ext_vector_type(2)));

constexpr int M = 16384, SEQ = 2048, DM = 2048, NWAVES = 8, NTHREADS = 512;
constexpr float EPS = 1e-6f, LOG2E = 1.4426950408889634f;
constexpr float QSCALE_DIL = 0.08838834764831845f * LOG2E;
constexpr float QSCALE_MLA = 0.07216878364870323f * LOG2E;

constexpr size_t MiB = 1u << 20;
constexpr size_t WS_CTL = 0, CTL_ZERO_BYTES = 64 * 1024;
constexpr size_t WS_ROPE = 1 * MiB;
constexpr size_t WS_SK = 2 * MiB;
constexpr size_t WS_BTKR = 3 * MiB;
constexpr size_t WS_BT2Q = 4 * MiB;
constexpr size_t WS_BT2KV = 6 * MiB;
constexpr size_t WS_BT1 = 8 * MiB;
constexpr size_t WS_BT3 = 24 * MiB;
constexpr size_t WS_BT4 = 32 * MiB;
constexpr size_t WS_SSQCQ = 40 * MiB;
constexpr size_t WS_SSQCKV = 40 * MiB + 512 * 1024;
constexpr size_t WS_SSQO = 41 * MiB;
constexpr size_t WS_SSQH = 42 * MiB;
constexpr size_t WS_KPE = 44 * MiB;
constexpr size_t WS_UB = 48 * MiB;
constexpr size_t WS_VB = 112 * MiB;
constexpr size_t WS_A = 176 * MiB;
constexpr size_t WS_B = 240 * MiB;
constexpr size_t WS_C = 336 * MiB;
constexpr size_t WS_QN = WS_C, WS_QPE = WS_C + 32 * MiB, WS_KN = WS_C + 48 * MiB, WS_VM = WS_C + 80 * MiB;
constexpr size_t WS_QP = WS_C, WS_RIDX = WS_C + 64 * MiB, WS_RGATE = WS_C + 72 * MiB, WS_PKV = WS_C + 80 * MiB,
                 WS_SIDX = WS_C + 88 * MiB, WS_SGATE = WS_C + 96 * MiB, WS_GOFF = WS_C + 104 * MiB;
constexpr size_t WS_D = 448 * MiB;
constexpr size_t WS_CQ = WS_D, WS_CKV = WS_D + 16 * MiB;
constexpr size_t WS_END = 480 * MiB;

constexpr int RING_BYTES = 131072;
constexpr int MISC_OFF = RING_BYTES;
constexpr int LDS_BYTES = 147456;

#define LDS_WAIT() asm volatile("s_waitcnt lgkmcnt(0)" ::: "memory")
#define VM_WAIT() asm volatile("s_waitcnt vmcnt(0)" ::: "memory")

__device__ __forceinline__ unsigned f2bf(float f) { unsigned u = __builtin_bit_cast(unsigned, f); return (u + 0x7fffu + ((u >> 16) & 1u)) >> 16; }
__device__ __forceinline__ unsigned pk2(float lo, float hi) { f32x2 v = {lo, hi}; bf16x2_t b = __builtin_convertvector(v, bf16x2_t); return __builtin_bit_cast(unsigned, b); }
__device__ __forceinline__ float bflo(unsigned u) { return __builtin_bit_cast(float, u << 16); }
__device__ __forceinline__ float bfhi(unsigned u) { return __builtin_bit_cast(float, u & 0xffff0000u); }
__device__ __forceinline__ float bf2f(bf16 b) { return __builtin_bit_cast(float, (unsigned)b << 16); }
__device__ __forceinline__ float wave_sum(float v) {
#pragma unroll
    for (int o = 1; o < 64; o <<= 1) v += __shfl_xor(v, o);
    return v;
}

__device__ __forceinline__ int hw_lane() { int l; asm volatile("v_mbcnt_lo_u32_b32 %0, -1, 0\n\tv_mbcnt_hi_u32_b32 %0, -1, %0" : "=v"(l)); return l; }

struct Params {
    const float *x, *ln1, *w_in, *qan, *kvan, *w_uq, *w_ukv, *ond, *onm, *w_o, *ln2, *wq, *sk, *pu, *pv, *lnf;
    float* out; unsigned char* ws;
    int ph_lo, ph_hi;
};
__device__ __forceinline__ int map_ident(int c) { return c; }
__device__ __forceinline__ int map_kr(int c) { const int p = c - 4096; return 2 * (p & 31) + (p >> 5); }
__device__ __forceinline__ int map_uq(int c) { const int h = c / 192, e = c % 192; if (e < 128) return h * 128 + e; const int p = e - 128; return 1024 + h * 64 + 2 * (p & 31) + (p >> 5); }
__device__ __forceinline__ int map_ukv(int c) { const int h = c >> 8, e = c & 255; return e < 128 ? h * 128 + e : 1024 + h * 128 + (e - 128); }

template <int MAP>
__device__ __forceinline__ void p0_transpose_item(const float* __restrict__ W, int K, int ldw, int c0, const float* __restrict__ g0, const float* __restrict__ g1, int gsplit,
                                                  bf16* __restrict__ WT, LAS float* scr, int item, int nblk, int lane) {
    const int kb = item / nblk, nb = item % nblk, k0 = 64 * kb, n0 = c0 + 32 * nb;
    f32x4 wv[8];
#pragma unroll
    for (int i = 0; i < 8; ++i) wv[i] = *(const f32x4*)(W + (size_t)(k0 + (lane >> 3) + 8 * i) * ldw + n0 + 4 * (lane & 7));
#pragma unroll
    for (int i = 0; i < 8; ++i) { const int kk = (lane >> 3) + 8 * i, k = k0 + kk; f32x4 w = wv[i];
        if (g0) w = w * (k < gsplit ? g0[k] : g1[k - gsplit]);
        LAS float* d = scr + kk * 33 + 4 * (lane & 7); d[0] = w[0]; d[1] = w[1]; d[2] = w[2]; d[3] = w[3]; }
    LDS_WAIT(); asm volatile("" ::: "memory");
    const int c = lane & 7;
#pragma unroll
    for (int j = 0; j < 4; ++j) { const int n = (lane >> 3) + 8 * j; const LAS float* s = scr + (8 * c) * 33 + n;
        v4u o; o.x = pk2(s[0 * 33], s[1 * 33]); o.y = pk2(s[2 * 33], s[3 * 33]); o.z = pk2(s[4 * 33], s[5 * 33]); o.w = pk2(s[6 * 33], s[7 * 33]);
        const int src = n0 + n;
        const int dr = MAP == 0 ? map_ident(src) : MAP == 1 ? map_kr(src) : MAP == 2 ? map_uq(src) : map_ukv(src);
        *(v4u*)(WT + (size_t)dr * K + k0 + 8 * c) = o; }
    LDS_WAIT(); asm volatile("" ::: "memory");
}

#ifndef PREP_ONLY
#define PREP_ONLY -1
#endif
__device__ __forceinline__ void phase_prep(const Params& P, LAS unsigned char* lds, int vcu, int G, int wave, int only = -1) {
    const int lane = hw_lane(), tid = wave * 64 + lane;
    unsigned char* ws = P.ws;
    LAS float* scr = (LAS float*)(lds + wave * 16384);
    const int gw = vcu * NWAVES + wave, NGW = G * NWAVES;
    const int gt = vcu * NTHREADS + tid, NGT = G * NTHREADS;
#pragma unroll 1
    for (int pi = 0; pi < 3; ++pi) {
        const int part = (pi + wave) % 3;
        if (only >= 0 && only != part) continue;
        if (part == 0) {
    constexpr int I1 = 32 * 128, IKR = 32 * 2, I2Q = 8 * 48, I2KV = 8 * 64, I3 = 32 * 64, I4 = 32 * 64;
    constexpr int NITEMS = I1 + IKR + I2Q + I2KV + I3 + I4;
    for (int it = gw; it < NITEMS; it += NGW) {
        int r = it;
        if (r < I1) { p0_transpose_item<0>(P.w_in, 2048, 4160, 0, nullptr, nullptr, 0, (bf16*)(ws + WS_BT1), scr, r, 128, lane); continue; } r -= I1;
        if (r < IKR) { p0_transpose_item<1>(P.w_in, 2048, 4160, 4096, nullptr, nullptr, 0, (bf16*)(ws + WS_BTKR), scr, r, 2, lane); continue; } r -= IKR;
        if (r < I2Q) { p0_transpose_item<2>(P.w_uq, 512, 1536, 0, P.qan, P.qan, 512, (bf16*)(ws + WS_BT2Q), scr, r, 48, lane); continue; } r -= I2Q;
        if (r < I2KV) { p0_transpose_item<3>(P.w_ukv, 512, 2048, 0, P.kvan, P.kvan, 512, (bf16*)(ws + WS_BT2KV), scr, r, 64, lane); continue; } r -= I2KV;
        if (r < I3) { p0_transpose_item<0>(P.w_o, 2048, 2048, 0, P.ond, P.onm, 1024, (bf16*)(ws + WS_BT3), scr, r, 64, lane); continue; } r -= I3;
        p0_transpose_item<0>(P.wq, 2048, 2048, 0, P.ln2, P.ln2, 2048, (bf16*)(ws + WS_BT4), scr, r, 64, lane);
    }
        } else if (part == 1) {
    {
        bf16* XN = (bf16*)(ws + WS_A);
        f32x4 gv[8];
#pragma unroll
        for (int j = 0; j < 8; ++j) gv[j] = ((const f32x4*)P.ln1)[lane + 64 * j];
        for (int m0 = gw * 4; m0 < M; m0 += NGW * 4) {
            f32x4 v[4][8];
#pragma unroll
            for (int r = 0; r < 4; ++r) { const f32x4* xr = (const f32x4*)(P.x + (size_t)(m0 + r) * DM) + lane;
#pragma unroll
                for (int j = 0; j < 8; ++j) v[r][j] = __builtin_nontemporal_load(xr + 64 * j); }
#pragma unroll
            for (int r = 0; r < 4; ++r) { float s = 0.f;
#pragma unroll
                for (int j = 0; j < 8; ++j) s += (v[r][j].x * v[r][j].x + v[r][j].y * v[r][j].y) + (v[r][j].z * v[r][j].z + v[r][j].w * v[r][j].w);
                const float rs = rsqrtf(wave_sum(s) * (1.f / DM) + EPS);
                v2u* o8 = (v2u*)(XN + (size_t)(m0 + r) * DM) + lane;
#pragma unroll
                for (int j = 0; j < 8; ++j) { v2u o; o.x = pk2(v[r][j].x * rs * gv[j].x, v[r][j].y * rs * gv[j].y); o.y = pk2(v[r][j].z * rs * gv[j].z, v[r][j].w * rs * gv[j].w); o8[64 * j] = o; } }
        }
    }
        } else {
        v2u* ou = (v2u*)(ws + WS_UB);
#pragma unroll 8
        for (int i = gt; i < 16384 * 2048 / 8; i += NGT) {
            const f32x4 a = __builtin_nontemporal_load((const f32x4*)P.pu + 2 * i), b = __builtin_nontemporal_load((const f32x4*)P.pu + 2 * i + 1);
            const int k8 = (i & 255) * 2; const f32x4 g0 = ((const f32x4*)P.ln2)[k8] * 32.f, g1 = ((const f32x4*)P.ln2)[k8 + 1] * 32.f;
            int w0 = 0, w1 = 0;
            w0 = __builtin_amdgcn_cvt_pk_fp8_f32(a.x * g0.x, a.y * g0.y, w0, false); w0 = __builtin_amdgcn_cvt_pk_fp8_f32(a.z * g0.z, a.w * g0.w, w0, true);
            w1 = __builtin_amdgcn_cvt_pk_fp8_f32(b.x * g1.x, b.y * g1.y, w1, false); w1 = __builtin_amdgcn_cvt_pk_fp8_f32(b.z * g1.z, b.w * g1.w, w1, true);
            v2u w; w.x = (unsigned)w0; w.y = (unsigned)w1; ou[i] = w;
        }
        }
    }
    if (only < 0 || only == 3) {
        f32x2* R = (f32x2*)(ws + WS_ROPE);
        for (int i = gt; i < 2048 * 32; i += NGT) { const int pos = i >> 5, j = i & 31; const float freq = powf(10000.0f, -(float)j / 32.0f), ang = (float)pos * freq;
            f32x2 cs; cs.x = cosf(ang); cs.y = sinf(ang); R[i] = cs; }
    }
    if (only < 0 || only == 3) {
        v4u* o = (v4u*)(ws + WS_SK);
        for (int i = gt; i < 16 * 128 * 128 / 8; i += NGT) { const f32x4 a = ((const f32x4*)P.sk)[2 * i], b = ((const f32x4*)P.sk)[2 * i + 1];
            v4u w; w.x = pk2(a.x, a.y); w.y = pk2(a.z, a.w); w.z = pk2(b.x, b.y); w.w = pk2(b.z, b.w); o[i] = w; }
    }
    if (only < 0 || only == 4) {
        __syncthreads();
        LAS v2u* tl = (LAS v2u*)lds;
        v2u* ov = (v2u*)(ws + WS_VB);
        f32x4 ra[8], rb[8];
#define PV8_LOAD(tile_) do { const int _e0 = ((tile_) >> 2) * 64, _c0 = ((tile_) & 3) * 64; _Pragma("unroll") for (int k = 0; k < 8; ++k) { const int it = tid + 512 * k, e = it >> 6, c = it & 63; \
            const f32x4* src = (const f32x4*)(P.pv + (size_t)(_e0 + e) * 2048 + (size_t)(_c0 + c) * 8); ra[k] = __builtin_nontemporal_load(src); rb[k] = __builtin_nontemporal_load(src + 1); } } while (0)
        if (vcu < 1024) PV8_LOAD(vcu);
        for (int tile = vcu; tile < 1024; tile += G) {
            const int e0 = (tile >> 2) * 64, c0 = (tile & 3) * 64;
#pragma unroll
            for (int k = 0; k < 8; ++k) { const int it = tid + 512 * k, e = it >> 6, c = it & 63; const f32x4 a = ra[k], b = rb[k];
                int w0 = 0, w1 = 0;
                w0 = __builtin_amdgcn_cvt_pk_fp8_f32(a.x * 2.f, a.y * 2.f, w0, false); w0 = __builtin_amdgcn_cvt_pk_fp8_f32(a.z * 2.f, a.w * 2.f, w0, true);
                w1 = __builtin_amdgcn_cvt_pk_fp8_f32(b.x * 2.f, b.y * 2.f, w1, false); w1 = __builtin_amdgcn_cvt_pk_fp8_f32(b.z * 2.f, b.w * 2.f, w1, true);
                v2u w; w.x = (unsigned)w0; w.y = (unsigned)w1; tl[c * 65 + e] = w; }
            if (tile + G < 1024) PV8_LOAD(tile + G);
            __syncthreads();
#pragma unroll
            for (int k = 0; k < 8; ++k) { const int it = tid + 512 * k, c = it >> 6, e = it & 63; ov[(size_t)(c0 + c) * 16384 + e0 + e] = tl[c * 65 + e]; }
            __syncthreads();
        }
#undef PV8_LOAD
    }
}
namespace pg8 {
constexpr int BM = 256, BK = 64, HALF = 128, HTB = HALF * BK * 2, STAGE_BYTES = 8 * HTB, NXCD = 8, WGM = 8;
__host__ __device__ __forceinline__ int lds_byte(int r, int c) { const int st = (r >> 4) * 2 + (c >> 5), rr = r & 15, cc = c & 31, ob = rr * 64 + cc * 2; return st * 1024 + (ob ^ (((ob >> 9) & 1) << 5)); }
__host__ __device__ __forceinline__ void stage_rc(int b, int& R, int& C) { const int st = b / 1024, sb = b % 1024, swz = sb ^ (((sb >> 9) & 1) << 5); R = (st >> 1) * 16 + swz / 64; C = (st & 1) * 32 + (swz % 64) / 2; }
__host__ __device__ __forceinline__ int perm32(int rho) { const int n = rho >> 4, i = rho & 15; return 8 * (i >> 2) + 4 * n + (i & 3); }

struct Unit { int pm, pn, g; };
struct GemmSet { const bf16 *A0, *A1, *Bt0, *Bt1; int K; };

struct StaticOrder {
    int nM, nN0, nN, nwg, G, c;
    __device__ void init(int Mrows, int N0, int N1, int G_, int c_) { nM = Mrows / BM; nN0 = N0 / BM; nN = nN0 + N1 / BM; nwg = nM * nN; G = G_; c = c_; }
    __device__ bool next(int i, Unit& u) const {
        const long L = (long)i * G + c; if (L >= nwg) return false;
        int wgid = (int)L; { const int q = nwg / NXCD, r = nwg % NXCD, xcd = wgid % NXCD, off = wgid / NXCD; wgid = (xcd < r ? xcd * (q + 1) : r * (q + 1) + (xcd - r) * q) + off; }
        const int nig = WGM * nN, gid = wgid / nig, fm = gid * WGM, gsz = (nM - fm) < WGM ? (nM - fm) : WGM;
        u.pm = fm + ((wgid % nig) % gsz); int pn = (wgid % nig) / gsz; u.g = pn >= nN0 ? 1 : 0; u.pn = pn >= nN0 ? pn - nN0 : pn; return true;
    }
};

template <class Epi, class Sched>
__device__ __forceinline__ void gemm_phase(LAS unsigned char* lds, const GemmSet g, const Sched& S, const Epi& E, int wid) {
    const int lane = hw_lane(), tid = wid * 64 + lane, wr = wid >> 2, wc = wid & 3, fr = lane & 15, fq = lane >> 4;
    const int K = g.K, nt = K / BK;
    unsigned voffA[2], voffB[2];
#pragma unroll
    for (int i = 0; i < 2; ++i) { int R, C; stage_rc(tid * 16 + i * 8192, R, C); const int Rb = (R & ~31) + perm32(R & 31);
        voffA[i] = (unsigned)(R * K + C) * 2u; voffB[i] = (unsigned)(Rb * K + C) * 2u; }
    const size_t kstep = (size_t)(BK * 2);
    const size_t hstep = (size_t)HALF * K * 2;
    const size_t tstep = 2 * hstep;
    const unsigned ldsw = (unsigned)wid * 1024u;
    const int aoff = lds_byte(wr * 64 + fr, fq * 8), boff = lds_byte(wc * 32 + fr, fq * 8);
#define PG8_SA(b, h) (((b) * 2 + (h)) * HTB)
#define PG8_SB(b, h) ((4 + (b) * 2 + (h)) * HTB)
#define PG8_STAGE(bufoff, gbase, voff) do { _Pragma("unroll") for (int _i = 0; _i < 2; ++_i) \
        __builtin_amdgcn_global_load_lds((const unsigned*)((const char*)(gbase) + (voff)[_i]), (LAS unsigned*)(lds + (bufoff) + ldsw + _i * 8192), 16, 0, 0); } while (0)
#define PG8_LDA(dst, b, h) do { _Pragma("unroll") for (int m = 0; m < 4; ++m) _Pragma("unroll") for (int k = 0; k < 2; ++k) dst[m][k] = *(const LAS bf16x8*)(lds + PG8_SA(b, h) + aoff + m * 2048 + k * 1024); } while (0)
#define PG8_LDB(dst, b, h) do { _Pragma("unroll") for (int n = 0; n < 2; ++n) _Pragma("unroll") for (int k = 0; k < 2; ++k) dst[n][k] = *(const LAS bf16x8*)(lds + PG8_SB(b, h) + boff + n * 2048 + k * 1024); } while (0)
#define PG8_MMA(ai, bj, At, Bt) do { __builtin_amdgcn_s_setprio(1); _Pragma("unroll") for (int m = 0; m < 4; ++m) _Pragma("unroll") for (int n = 0; n < 2; ++n) _Pragma("unroll") for (int k = 0; k < 2; ++k) \
        acc[ai][bj][m][n] = __builtin_amdgcn_mfma_f32_16x16x32_bf16(Bt[n][k], At[m][k], acc[ai][bj][m][n], 0, 0, 0); __builtin_amdgcn_s_setprio(0); } while (0)
#define PG8_WAIT_V(n) asm volatile("s_waitcnt vmcnt(" #n ")" ::: "memory")
#define PG8_WAIT_L(n) asm volatile("s_waitcnt lgkmcnt(" #n ")" ::: "memory")
#define PG8_BAR __builtin_amdgcn_s_barrier()
#define PG8_SCHED __builtin_amdgcn_sched_barrier(0)
    Unit cur, nxt; int ui = 0;
    if (!S.next(0, cur)) return;
    f32x4 acc[2][2][4][2];
#pragma unroll
    for (int a = 0; a < 2; ++a)
#pragma unroll
        for (int b = 0; b < 2; ++b)
#pragma unroll
            for (int m = 0; m < 4; ++m)
#pragma unroll
                for (int n = 0; n < 2; ++n) acc[a][b][m][n] = (f32x4){0.f, 0.f, 0.f, 0.f};
    bf16x8 At[4][2], B0[2][2], B1[2][2];
    const char* cA = (const char*)(cur.g ? g.A1 : g.A0) + (size_t)cur.pm * tstep; const char* cB = (const char*)(cur.g ? g.Bt1 : g.Bt0) + (size_t)cur.pn * tstep;
    E.unit_begin(cur, 0, tid);
    PG8_STAGE(PG8_SB(0, 0), cB, voffB); PG8_STAGE(PG8_SB(0, 1), cB + hstep, voffB); PG8_STAGE(PG8_SA(0, 0), cA, voffA); PG8_STAGE(PG8_SA(0, 1), cA + hstep, voffA);
    if (wr == 1) PG8_BAR;
    PG8_WAIT_V(2); PG8_BAR;
    PG8_STAGE(PG8_SB(1, 0), cB + kstep, voffB); PG8_STAGE(PG8_SA(1, 0), cA + kstep, voffA); PG8_STAGE(PG8_SB(1, 1), cB + hstep + kstep, voffB);
    PG8_WAIT_V(6); PG8_BAR;
    for (;;) {
        const bool has_next = S.next(ui + 1, nxt);
        const char* nA = has_next ? (const char*)(nxt.g ? g.A1 : g.A0) + (size_t)nxt.pm * tstep : cA; const char* nB = has_next ? (const char*)(nxt.g ? g.Bt1 : g.Bt0) + (size_t)nxt.pn * tstep : cB;
        for (int t = 0; t < nt; t += 2) {
            const bool last = (t == nt - 2);
            const char* a1 = cA + (size_t)(t + 1) * kstep;
            const char* a2 = last ? nA : cA + (size_t)(t + 2) * kstep; const char* b2 = last ? nB : cB + (size_t)(t + 2) * kstep;
            const char* a3 = a2 + kstep; const char* b3 = b2 + kstep;
            if constexpr (Epi::MIDSCALE) { if (t == nt / 2) E.midscale(acc, ui & 1, wr, fr); }
            PG8_LDB(B0, 0, 0); PG8_LDB(B1, 0, 1); PG8_SCHED; PG8_LDA(At, 0, 0); PG8_STAGE(PG8_SA(1, 1), a1 + hstep, voffA);
            PG8_WAIT_V(8); PG8_WAIT_L(0); PG8_BAR; PG8_MMA(0, 0, At, B0); PG8_MMA(0, 1, At, B1); PG8_BAR; PG8_SCHED;
            PG8_LDA(At, 0, 1); PG8_STAGE(PG8_SB(0, 0), b2, voffB); PG8_STAGE(PG8_SB(0, 1), b2 + hstep, voffB); PG8_STAGE(PG8_SA(0, 0), a2, voffA);
            PG8_WAIT_V(8); PG8_WAIT_L(0); PG8_BAR; PG8_MMA(1, 0, At, B0); PG8_MMA(1, 1, At, B1); PG8_BAR; PG8_SCHED;
            PG8_LDB(B0, 1, 0); PG8_LDB(B1, 1, 1); PG8_SCHED; PG8_LDA(At, 1, 0); PG8_STAGE(PG8_SA(0, 1), a2 + hstep, voffA);
            PG8_WAIT_V(8); PG8_WAIT_L(0); PG8_BAR; PG8_MMA(0, 0, At, B0); PG8_MMA(0, 1, At, B1); PG8_BAR; PG8_SCHED;
            PG8_LDA(At, 1, 1); PG8_STAGE(PG8_SB(1, 0), b3, voffB); PG8_STAGE(PG8_SB(1, 1), b3 + hstep, voffB); PG8_STAGE(PG8_SA(1, 0), a3, voffA);
            PG8_WAIT_V(8); PG8_WAIT_L(0); PG8_BAR; PG8_MMA(1, 0, At, B0); PG8_MMA(1, 1, At, B1); PG8_BAR; PG8_SCHED;
        }
        if (wr == 0) PG8_BAR;
        E(acc, cur, ui & 1, wr, wc, fr, fq);
        if (!has_next) break;
#pragma unroll
        for (int a = 0; a < 2; ++a)
#pragma unroll
            for (int b = 0; b < 2; ++b)
#pragma unroll
                for (int m = 0; m < 4; ++m)
#pragma unroll
                    for (int n = 0; n < 2; ++n) acc[a][b][m][n] = (f32x4){0.f, 0.f, 0.f, 0.f};
        cur = nxt; cA = nA; cB = nB; ++ui;
        E.unit_begin(cur, ui & 1, tid);
        if (wr == 1) PG8_BAR;
    }
    PG8_WAIT_V(0);
    PG8_BAR;
#undef PG8_SA
#undef PG8_SB
#undef PG8_STAGE
#undef PG8_LDA
#undef PG8_LDB
#undef PG8_MMA
#undef PG8_WAIT_V
#undef PG8_WAIT_L
#undef PG8_BAR
#undef PG8_SCHED
}
}
namespace pg8 {
__device__ __forceinline__ v4u pack8(const f32x4& v0, const f32x4& v1) { v4u w; w.x = pk2(v0[0], v0[1]); w.y = pk2(v0[2], v0[3]); w.z = pk2(v1[0], v1[1]); w.w = pk2(v1[2], v1[3]); return w; }
__device__ __forceinline__ float sq8(const f32x4& v0, const f32x4& v1) { return (v0[0] * v0[0] + v0[1] * v0[1]) + (v0[2] * v0[2] + v0[3] * v0[3]) + (v1[0] * v1[0] + v1[1] * v1[1]) + (v1[2] * v1[2] + v1[3] * v1[3]); }

struct Epi1 {
    static constexpr bool MIDSCALE = false;
    bf16 *QKV, *CQ, *CKV; float *SSQCQ, *SSQCKV;
    __device__ __forceinline__ void midscale(f32x4 (&)[2][2][4][2], int, int, int) const {}
    __device__ __forceinline__ void unit_begin(const Unit&, int, int) const {}
    __device__ __forceinline__ void operator()(const f32x4 (&acc)[2][2][4][2], const Unit& u, int par, int wr, int wc, int fr, int fq) const {
        const int pn = u.pn; bf16* base; int ldc, colt; float sc = 1.f; float* ssq = nullptr; int sslot = 0;
        if (pn < 12) { base = QKV; ldc = 3072; colt = pn * 256; if (pn < 4) sc = QSCALE_DIL; }
        else if (pn < 14) { base = CQ; ldc = 512; colt = (pn - 12) * 256; ssq = SSQCQ; sslot = (pn - 12) * 4 + wc; }
        else { base = CKV; ldc = 512; colt = (pn - 14) * 256; ssq = SSQCKV; sslot = (pn - 14) * 4 + wc; }
        const int row0 = u.pm * BM + wr * 64 + fr, col0 = colt + wc * 32 + 8 * fq;
#pragma unroll
        for (int ai = 0; ai < 2; ++ai)
#pragma unroll
            for (int m = 0; m < 4; ++m) { const int row = row0 + ai * HALF + m * 16; bf16* rowp = base + (size_t)row * ldc + col0; float ss = 0.f;
#pragma unroll
                for (int bj = 0; bj < 2; ++bj) { const f32x4 v0 = acc[ai][bj][m][0] * sc, v1 = acc[ai][bj][m][1] * sc; ss += sq8(v0, v1); *(v4u*)(rowp + bj * HALF) = pack8(v0, v1); }
                if (ssq) { ss += __shfl_xor(ss, 16); ss += __shfl_xor(ss, 32); if (fq == 0) ssq[(size_t)row * 8 + sslot] = ss; } }
    }
};

struct Epi2 {
    static constexpr bool MIDSCALE = false;
    bf16 *QN, *QPE, *KN, *VM; const float *SSQCQ, *SSQCKV; const f32x2* ROPE;
    __device__ __forceinline__ void midscale(f32x4 (&)[2][2][4][2], int, int, int) const {}
    __device__ __forceinline__ void unit_begin(const Unit&, int, int) const {}
    __device__ __forceinline__ void operator()(const f32x4 (&acc)[2][2][4][2], const Unit& u, int par, int wr, int wc, int fr, int fq) const {
        const int pn = u.pn; bf16* base; int ldc, colt; float sc = 1.f; bool rope = false; const float* ssq;
        if (u.g == 0) { ssq = SSQCQ; sc = QSCALE_MLA; if (pn < 4) { base = QN; ldc = 1024; colt = pn * 256; } else { base = QPE; ldc = 512; colt = (pn - 4) * 256; rope = true; } }
        else { ssq = SSQCKV; if (pn < 4) { base = KN; ldc = 1024; colt = pn * 256; } else { base = VM; ldc = 1024; colt = (pn - 4) * 256; } }
        const int row0 = u.pm * BM + wr * 64 + fr, col0 = colt + wc * 32 + 8 * fq;
#pragma unroll
        for (int ai = 0; ai < 2; ++ai)
#pragma unroll
            for (int m = 0; m < 4; ++m) { const int row = row0 + ai * HALF + m * 16; bf16* rowp = base + (size_t)row * ldc + col0;
                const f32x4 p0 = *(const f32x4*)(ssq + (size_t)row * 8), p1 = *(const f32x4*)(ssq + (size_t)row * 8 + 4);
                const float rs = rsqrtf(((p0[0] + p0[1]) + (p0[2] + p0[3]) + (p1[0] + p1[1]) + (p1[2] + p1[3])) * (1.f / 512.f) + EPS) * sc;
#pragma unroll
                for (int bj = 0; bj < 2; ++bj) { f32x4 v0 = acc[ai][bj][m][0] * rs, v1 = acc[ai][bj][m][1] * rs;
                    if (rope) { const int j0 = ((col0 + bj * HALF) & 63) >> 1; const f32x4* rp = (const f32x4*)(ROPE + (size_t)(row & (SEQ - 1)) * 32 + j0);
                        const f32x4 r0 = rp[0], r1 = rp[1];
                        f32x4 w0, w1;
                        w0[0] = v0[0] * r0[0] - v0[1] * r0[1]; w0[1] = v0[0] * r0[1] + v0[1] * r0[0];
                        w0[2] = v0[2] * r0[2] - v0[3] * r0[3]; w0[3] = v0[2] * r0[3] + v0[3] * r0[2];
                        w1[0] = v1[0] * r1[0] - v1[1] * r1[1]; w1[1] = v1[0] * r1[1] + v1[1] * r1[0];
                        w1[2] = v1[2] * r1[2] - v1[3] * r1[3]; w1[3] = v1[2] * r1[3] + v1[3] * r1[2];
                        v0 = w0; v1 = w1; }
                    *(v4u*)(rowp + bj * HALF) = pack8(v0, v1); } }
    }
};

struct Epi3 {
    static constexpr bool MIDSCALE = true;
    bf16* H1B; const float* X; const float* SSQO; float* SSQH; LAS f32x2* RS;
    __device__ __forceinline__ void unit_begin(const Unit& u, int par, int tid) const {
        if (tid < 256) { const f32x4* p = (const f32x4*)(SSQO + (size_t)(u.pm * BM + tid) * 16); const f32x4 a0 = p[0], a1 = p[1], b0 = p[2], b1 = p[3];
            const float ra = rsqrtf(((a0[0] + a0[1]) + (a0[2] + a0[3]) + (a1[0] + a1[1]) + (a1[2] + a1[3])) * (1.f / 1024.f) + EPS);
            const float rb = rsqrtf(((b0[0] + b0[1]) + (b0[2] + b0[3]) + (b1[0] + b1[1]) + (b1[2] + b1[3])) * (1.f / 1024.f) + EPS);
            f32x2 v; v.x = ra / rb; v.y = rb; RS[par * 256 + tid] = v; }
    }
    __device__ __forceinline__ void midscale(f32x4 (&acc)[2][2][4][2], int par, int wr, int fr) const {
#pragma unroll
        for (int ai = 0; ai < 2; ++ai)
#pragma unroll
            for (int m = 0; m < 4; ++m) { const float f = RS[par * 256 + ai * HALF + wr * 64 + m * 16 + fr].x;
#pragma unroll
                for (int bj = 0; bj < 2; ++bj) { acc[ai][bj][m][0] = acc[ai][bj][m][0] * f; acc[ai][bj][m][1] = acc[ai][bj][m][1] * f; } }
    }
    __device__ __forceinline__ void operator()(const f32x4 (&acc)[2][2][4][2], const Unit& u, int par, int wr, int wc, int fr, int fq) const {
        const int row0 = u.pm * BM + wr * 64 + fr, col0 = u.pn * BM + wc * 32 + 8 * fq, sslot = u.pn * 4 + wc;
#pragma unroll
        for (int ai = 0; ai < 2; ++ai)
#pragma unroll
            for (int m = 0; m < 4; ++m) { const int row = row0 + ai * HALF + m * 16; const float rb = RS[par * 256 + ai * HALF + wr * 64 + m * 16 + fr].y; float ss = 0.f;
#pragma unroll
                for (int bj = 0; bj < 2; ++bj) { const float* xp = X + (size_t)row * DM + col0 + bj * HALF; const f32x4 x0 = *(const f32x4*)xp, x1 = *(const f32x4*)(xp + 4);
                    const f32x4 v0 = acc[ai][bj][m][0] * rb + x0, v1 = acc[ai][bj][m][1] * rb + x1; ss += sq8(v0, v1);
                    *(v4u*)(H1B + (size_t)row * DM + col0 + bj * HALF) = pack8(v0, v1); }
                ss += __shfl_xor(ss, 16); ss += __shfl_xor(ss, 32); if (fq == 0) SSQH[(size_t)row * 32 + sslot] = ss; }
    }
};

struct Epi4 {
    static constexpr bool MIDSCALE = false;
    bf16* QP;
    __device__ __forceinline__ void midscale(f32x4 (&)[2][2][4][2], int, int, int) const {}
    __device__ __forceinline__ void unit_begin(const Unit&, int, int) const {}
    __device__ __forceinline__ void operator()(const f32x4 (&acc)[2][2][4][2], const Unit& u, int par, int wr, int wc, int fr, int fq) const {
        const int row0 = u.pm * BM + wr * 64 + fr, col0 = u.pn * BM + wc * 32 + 8 * fq;
#pragma unroll
        for (int ai = 0; ai < 2; ++ai)
#pragma unroll
            for (int m = 0; m < 4; ++m) { const int row = row0 + ai * HALF + m * 16;
#pragma unroll
                for (int bj = 0; bj < 2; ++bj) *(v4u*)(QP + (size_t)row * DM + col0 + bj * HALF) = pack8(acc[ai][bj][m][0], acc[ai][bj][m][1]); }
    }
};
struct EpiNull {
    static constexpr bool MIDSCALE = false;
    __device__ __forceinline__ void midscale(f32x4 (&)[2][2][4][2], int, int, int) const {}
    __device__ __forceinline__ void unit_begin(const Unit&, int, int) const {}
    __device__ __forceinline__ void operator()(const f32x4 (&acc)[2][2][4][2], const Unit& u, int par, int wr, int wc, int fr, int fq) const {
#pragma unroll
        for (int ai = 0; ai < 2; ++ai)
#pragma unroll
            for (int bj = 0; bj < 2; ++bj)
#pragma unroll
                for (int m = 0; m < 4; ++m)
#pragma unroll
                    for (int n = 0; n < 2; ++n) asm volatile("" :: "v"(acc[ai][bj][m][n]));
    }
};
}

__device__ __forceinline__ void kr_item(const bf16* __restrict__ XN, const bf16* __restrict__ BT, const f32x2* __restrict__ ROPE, bf16* __restrict__ KPE, int item, int wave, int lane) {
    const int fr = lane & 15, fq = lane >> 4, row = item * 128 + wave * 16 + fr;
    const bf16* ap = XN + (size_t)row * 2048 + fq * 8; const bf16* bp = BT + (size_t)fr * 2048 + fq * 8;
    f32x4 acc[4];
#pragma unroll
    for (int nb = 0; nb < 4; ++nb) acc[nb] = (f32x4){0.f, 0.f, 0.f, 0.f};
#pragma unroll 4
    for (int k0 = 0; k0 < 2048; k0 += 32) {
        const bf16x8 a = *(const bf16x8*)(ap + k0);
#pragma unroll
        for (int nb = 0; nb < 4; ++nb) { const bf16x8 b = *(const bf16x8*)(bp + (size_t)nb * 16 * 2048 + k0); acc[nb] = __builtin_amdgcn_mfma_f32_16x16x32_bf16(b, a, acc[nb], 0, 0, 0); }
    }
    const int pos = row & (SEQ - 1);
#pragma unroll
    for (int nb = 0; nb < 4; ++nb) { const int j0 = 8 * nb + 2 * fq; const f32x4 r = *(const f32x4*)(ROPE + (size_t)pos * 32 + j0); const f32x4 v = acc[nb];
        v2u o; o.x = pk2(v[0] * r[0] - v[1] * r[1], v[0] * r[1] + v[1] * r[0]); o.y = pk2(v[2] * r[2] - v[3] * r[3], v[2] * r[3] + v[3] * r[2]);
        *(v2u*)(KPE + (size_t)row * 64 + 16 * nb + 4 * fq) = o; }
}
namespace att {
typedef short v4i16_t __attribute__((ext_vector_type(4)));
#define MFMA32(a, b, c) __builtin_amdgcn_mfma_f32_32x32x16_bf16((a), (b), (c), 0, 0, 0)
__device__ __forceinline__ s16x4 vtr(const LAS unsigned char* p) { return __builtin_bit_cast(s16x4, __builtin_amdgcn_ds_read_tr16_b64_v4i16((LAS v4i16_t*)p)); }
__device__ __forceinline__ int crow(int r, int hi) { return (r & 3) + 8 * (r >> 2) + 4 * hi; }
constexpr int VS = 320;
constexpr int KS = 400;
constexpr float NEG = -1e30f;

__device__ __forceinline__ bf16x8 pack8r(const f32x16& p, int s) {
    v4u w; w.x = pk2(p[8 * s + 0], p[8 * s + 1]); w.y = pk2(p[8 * s + 2], p[8 * s + 3]); w.z = pk2(p[8 * s + 4], p[8 * s + 5]); w.w = pk2(p[8 * s + 6], p[8 * s + 7]);
    return __builtin_bit_cast(bf16x8, w);
}
__device__ __forceinline__ void pv32(f32x16 (&o)[4], const LAS unsigned char* vb, const bf16x8 pb0, const bf16x8 pb1) {
#pragma unroll
    for (int d = 0; d < 4; ++d) {
        const s16x4 l0 = vtr(vb + d * 64), h0 = vtr(vb + d * 64 + 8 * VS), l1 = vtr(vb + d * 64 + 16 * VS), h1 = vtr(vb + d * 64 + 24 * VS);
        const bf16x8 a0 = __builtin_shufflevector(l0, h0, 0, 1, 2, 3, 4, 5, 6, 7), a1 = __builtin_shufflevector(l1, h1, 0, 1, 2, 3, 4, 5, 6, 7);
        o[d] = MFMA32(a0, pb0, o[d]); o[d] = MFMA32(a1, pb1, o[d]);
    }
}
template <int NS>
__device__ __forceinline__ void softmax_step(f32x16 (&s)[NS], float& m, float& l, f32x16 (&o)[4], bf16x8 (&pb)[2 * NS]) {
    float mx = s[0][0];
#pragma unroll
    for (int t = 0; t < NS; ++t)
#pragma unroll
        for (int r = 0; r < 16; ++r) mx = fmaxf(mx, s[t][r]);
    mx = fmaxf(mx, __shfl_xor(mx, 32));
    const float mn = fmaxf(m, mx), alpha = __builtin_amdgcn_exp2f(m - mn); m = mn;
    float ps = 0.f;
#pragma unroll
    for (int t = 0; t < NS; ++t)
#pragma unroll
        for (int r = 0; r < 16; ++r) { const float p = __builtin_amdgcn_exp2f(s[t][r] - mn); s[t][r] = p; ps += p; }
    l = l * alpha + ps;
    if (!__all(alpha == 1.0f)) {
#pragma unroll
        for (int d = 0; d < 4; ++d) o[d] = o[d] * alpha;
    }
#pragma unroll
    for (int t = 0; t < NS; ++t) { pb[2 * t] = pack8r(s[t], 0); pb[2 * t + 1] = pack8r(s[t], 1); }
}
__device__ __forceinline__ void store_o(f32x16 (&o)[4], float l, bf16* __restrict__ orow  , float* __restrict__ ssq  , int hh) {
    l += __shfl_xor(l, 32);
    const float inv = 1.0f / l; float ss = 0.f;
#pragma unroll
    for (int d = 0; d < 4; ++d) { o[d] = o[d] * inv;
#pragma unroll
        for (int g = 0; g < 4; ++g) { const float a = o[d][4 * g], b = o[d][4 * g + 1], c = o[d][4 * g + 2], e = o[d][4 * g + 3];
            ss += (a * a + b * b) + (c * c + e * e);
            v2u w; w.x = pk2(a, b); w.y = pk2(c, e); *(v2u*)(orow + 32 * d + 8 * g + 4 * hh) = w; } }
    ss += __shfl_xor(ss, 32);
    if (hh == 0) *ssq = ss;
}

constexpr int KTB = 64 * KS, VTB = 64 * VS, BUFB = KTB + VTB;
__device__ __forceinline__ void mla_unit(const unsigned char* ws, LAS unsigned char* lds, int b, int h, int qblk, int tid, int wave, int lane) {
    const bf16* QN = (const bf16*)(ws + WS_QN); const bf16* QPE = (const bf16*)(ws + WS_QPE);
    bf16* O = (bf16*)(ws + WS_A); float* SSQO = (float*)(ws + WS_SSQO);
    const int r32 = lane & 31, hh = lane >> 5;
    const size_t tok0 = (size_t)b * SEQ;
    const int row_lo = qblk * 256 + wave * 32, qrow = row_lo + r32;
    bf16x8 qf[12];
    { const bf16* qn = QN + (tok0 + qrow) * 1024 + h * 128 + 8 * hh;
#pragma unroll
      for (int s = 0; s < 8; ++s) qf[s] = *(const bf16x8*)(qn + 16 * s);
      const bf16* qp = QPE + (tok0 + qrow) * 512 + h * 64 + 8 * hh;
#pragma unroll
      for (int s = 0; s < 4; ++s) qf[8 + s] = *(const bf16x8*)(qp + 16 * s); }
    const int c0 = tid, c1 = tid + 512;
    const unsigned okn0 = (unsigned)WS_KN + (unsigned)(((unsigned)tok0 + (c0 >> 4)) * 1024u + h * 128 + (c0 & 15) * 8) * 2u, okn1 = okn0 + 32u * 1024u * 2u;
    const unsigned okp = (unsigned)WS_KPE + (unsigned)(((unsigned)tok0 + (tid >> 3)) * 64u + (tid & 7) * 8) * 2u;
    const unsigned ov0 = okn0 + (unsigned)(WS_VM - WS_KN), ov1 = ov0 + 32u * 1024u * 2u;
    const int lkn0 = (c0 >> 4) * KS + (c0 & 15) * 16, lkn1 = (c1 >> 4) * KS + (c1 & 15) * 16, lkp = (tid >> 3) * KS + 256 + (tid & 7) * 16;
    const int lv0 = KTB + (c0 >> 4) * VS + (c0 & 15) * 16, lv1 = KTB + (c1 >> 4) * VS + (c1 & 15) * 16;
    v4u st0, st1, st2, st3, st4;
#define MLA_GLOAD(kt) do { const unsigned _o = (unsigned)(kt) * 131072u, _p = (unsigned)(kt) * 8192u; st0 = *(const v4u*)(ws + (size_t)(okn0 + _o)); st1 = *(const v4u*)(ws + (size_t)(okn1 + _o)); \
        st2 = *(const v4u*)(ws + (size_t)(okp + _p)); st3 = *(const v4u*)(ws + (size_t)(ov0 + _o)); st4 = *(const v4u*)(ws + (size_t)(ov1 + _o)); } while (0)
#define MLA_LWRITE(buf) do { LAS unsigned char* _b = lds + (buf) * BUFB; *(LAS v4u*)(_b + lkn0) = st0; *(LAS v4u*)(_b + lkn1) = st1; *(LAS v4u*)(_b + lkp) = st2; \
        *(LAS v4u*)(_b + lv0) = st3; *(LAS v4u*)(_b + lv1) = st4; } while (0)
    const int nkt = 4 * (qblk + 1);
    MLA_GLOAD(0); MLA_LWRITE(0);
    __syncthreads();
    f32x16 o[4];
#pragma unroll
    for (int d = 0; d < 4; ++d)
#pragma unroll
        for (int r = 0; r < 16; ++r) o[d][r] = 0.f;
    float m = NEG, l = 0.f;
    const int kread = r32 * KS + 16 * hh;
    const int vread = KTB + (4 * hh + ((lane & 15) >> 2)) * VS + (16 * ((lane >> 4) & 1) + 4 * (lane & 3)) * 2;
    for (int kt = 0; kt < nkt; ++kt) {
        if (kt + 1 < nkt) MLA_GLOAD(kt + 1);
        const int k0 = kt * 64;
        if (k0 <= row_lo + 31) {
            const LAS unsigned char* kb = lds + (kt & 1) * BUFB;
            const bool diag = (k0 + 63 > row_lo);
#pragma unroll
            for (int sub = 0; sub < 2; ++sub) {
                if (sub == 1 && k0 + 32 > row_lo + 31) break;
                f32x16 s[1];
#pragma unroll
                for (int r = 0; r < 16; ++r) s[0][r] = 0.f;
#pragma unroll
                for (int ks = 0; ks < 12; ++ks) { const bf16x8 kf = *(const LAS bf16x8*)(kb + kread + sub * 32 * KS + 32 * ks); s[0] = MFMA32(kf, qf[ks], s[0]); }
                if (diag) {
#pragma unroll
                    for (int r = 0; r < 16; ++r) { const int key = k0 + 32 * sub + crow(r, hh); if (key > qrow) s[0][r] = NEG; }
                }
                bf16x8 pb[2];
                softmax_step<1>(s, m, l, o, pb);
                pv32(o, kb + vread + sub * 32 * VS, pb[0], pb[1]);
            }
        }
        if (kt + 1 < nkt) MLA_LWRITE((kt + 1) & 1);
        __syncthreads();
    }
#undef MLA_GLOAD
#undef MLA_LWRITE
    store_o(o, l, O + (tok0 + qrow) * 2048 + 1024 + h * 128, SSQO + (tok0 + qrow) * 16 + 8 + h, hh);
}

constexpr int DKS = 272, DSH = 32 * DKS + 32 * VS;
__device__ __forceinline__ void dil_tile(const unsigned char* ws, LAS unsigned char* vl  , LAS unsigned char* sh  , int b, int h, int j, int r16, int tid, int lane) {
    const bf16* QKV = (const bf16*)(ws + WS_B);
    const int r32 = lane & 31, hh = lane >> 5;
    const size_t tok0 = (size_t)b * SEQ;
    const int tq = 512 * j + 16 * r32 + r16;
    bf16x8 qf[8];
    { const bf16* qp = QKV + (tok0 + tq) * 3072 + h * 128 + 8 * hh;
#pragma unroll
      for (int s = 0; s < 8; ++s) qf[s] = *(const bf16x8*)(qp + 16 * s); }
    const float slope2 = __builtin_amdgcn_exp2f(-(float)(h + 1)) * LOG2E;
    const int m0 = (j == 0) ? 4 : 0, n3 = j + 1, n2 = 8 - m0, n1 = 20 - m0, nt = n3 + n2;
    const unsigned kcol = (unsigned)WS_B + ((unsigned)tok0 * 3072u + 1024u + h * 128 + 8 * hh) * 2u;
    const unsigned vcol = (unsigned)WS_B + ((unsigned)tok0 * 3072u + 2048u + h * 128 + (lane & 15) * 8) * 2u;
    const int vrow = lane >> 4;
    const int vwr = vrow * VS + (lane & 15) * 16;
    const int vread = (4 * hh + ((lane & 15) >> 2)) * VS + (16 * ((lane >> 4) & 1) + 4 * (lane & 3)) * 2;
    int kbase, kstride, maxd;
#define DIL_DESC(idx) do { const int _i = (idx); if (_i < n3) { kbase = 512 * (j - _i) + r16; kstride = 16; maxd = 2048; } \
        else if (_i < n3 + n2) { kbase = 4 * (128 * j - 128 + 32 * (m0 + _i - n3)) + (r16 & 3); kstride = 4; maxd = 512; } \
        else { kbase = 512 * j - 128 + 32 * (m0 + _i - n3 - n2); kstride = 1; maxd = 128; } } while (0)
    bf16x8 kc[8]; v4u vn[8];
    DIL_DESC(0);
    { const unsigned kp = kcol + (unsigned)(kbase + kstride * r32) * 6144u;
#pragma unroll
      for (int s = 0; s < 8; ++s) kc[s] = *(const bf16x8*)(ws + (size_t)(kp + 32 * s));
#pragma unroll
      for (int i = 0; i < 8; ++i) vn[i] = *(const v4u*)(ws + (size_t)(vcol + (unsigned)(kbase + kstride * (4 * i + vrow)) * 6144u));
#pragma unroll
      for (int i = 0; i < 8; ++i) *(LAS v4u*)(vl + vwr + 4 * i * VS) = vn[i]; }
    f32x16 o[4];
#pragma unroll
    for (int d = 0; d < 4; ++d)
#pragma unroll
        for (int r = 0; r < 16; ++r) o[d][r] = 0.f;
    float m = NEG, l = 0.f;
    for (int idx = 0; idx < nt; ++idx) {
        const int cb = kbase, cs = kstride, cm = maxd;
        const bool more = idx + 1 < nt;
        if (more) {
            DIL_DESC(idx + 1);
#pragma unroll
            for (int i = 0; i < 8; ++i) vn[i] = *(const v4u*)(ws + (size_t)(vcol + (unsigned)(kbase + kstride * (4 * i + vrow)) * 6144u));
        }
        f32x16 s[1];
#pragma unroll
        for (int r = 0; r < 16; ++r) s[0][r] = 0.f;
#pragma unroll
        for (int ks = 0; ks < 8; ++ks) s[0] = MFMA32(kc[ks], qf[ks], s[0]);
        if (more) {
            const unsigned kp = kcol + (unsigned)(kbase + kstride * r32) * 6144u;
#pragma unroll
            for (int s2 = 0; s2 < 8; ++s2) kc[s2] = *(const bf16x8*)(ws + (size_t)(kp + 32 * s2));
        }
        const int d0 = tq - cb - cs * 4 * hh;
#pragma unroll
        for (int r = 0; r < 16; ++r) { const int dist = d0 - cs * ((r & 3) + 8 * (r >> 2)); const float v = s[0][r] - slope2 * (float)dist; s[0][r] = ((unsigned)dist <= (unsigned)cm) ? v : NEG; }
        bf16x8 pb[2];
        softmax_step<1>(s, m, l, o, pb);
        pv32(o, vl + vread, pb[0], pb[1]);
        if (more) {
#pragma unroll
            for (int i = 0; i < 8; ++i) *(LAS v4u*)(vl + vwr + 4 * i * VS) = vn[i];
        }
    }
#undef DIL_DESC
    {
        const int kb0 = 512 * j - 128 + 32 * m0;
        const int row = tid >> 4, ch = tid & 15;
        const unsigned gk = (unsigned)WS_B + (((unsigned)tok0 + kb0 + row) * 3072u + 1024u + h * 128 + ch * 8) * 2u;
        const int lk = row * DKS + ch * 16, lv = 32 * DKS + row * VS + ch * 16;
        const int kread = r32 * DKS + 16 * hh;
        const int vread1 = 32 * DKS + (4 * hh + ((lane & 15) >> 2)) * VS + (16 * ((lane >> 4) & 1) + 4 * (lane & 3)) * 2;
        v4u sk = *(const v4u*)(ws + (size_t)gk), sv = *(const v4u*)(ws + (size_t)(gk + 2048u));
        *(LAS v4u*)(sh + lk) = sk; *(LAS v4u*)(sh + lv) = sv;
        __syncthreads();
        for (int mi = 0; mi < n1; ++mi) {
            const bool more = mi + 1 < n1;
            if (more) { const unsigned g2 = gk + (unsigned)(mi + 1) * 32u * 6144u; sk = *(const v4u*)(ws + (size_t)g2); sv = *(const v4u*)(ws + (size_t)(g2 + 2048u)); }
            const LAS unsigned char* tb = sh + (mi & 1) * DSH;
            f32x16 s[1];
#pragma unroll
            for (int r = 0; r < 16; ++r) s[0][r] = 0.f;
#pragma unroll
            for (int ks = 0; ks < 8; ++ks) { const bf16x8 kf = *(const LAS bf16x8*)(tb + kread + 32 * ks); s[0] = MFMA32(kf, qf[ks], s[0]); }
            const int d0 = tq - (kb0 + 32 * mi) - 4 * hh;
#pragma unroll
            for (int r = 0; r < 16; ++r) { const int dist = d0 - ((r & 3) + 8 * (r >> 2)); const float v = s[0][r] - slope2 * (float)dist; s[0][r] = ((unsigned)dist <= 128u) ? v : NEG; }
            bf16x8 pb[2];
            softmax_step<1>(s, m, l, o, pb);
            pv32(o, tb + vread1, pb[0], pb[1]);
            if (more) { LAS unsigned char* nb = sh + ((mi + 1) & 1) * DSH; *(LAS v4u*)(nb + lk) = sk; *(LAS v4u*)(nb + lv) = sv; }
            __syncthreads();
        }
    }
    store_o(o, l, (bf16*)(const_cast<unsigned char*>(ws) + WS_A) + (tok0 + tq) * 2048 + h * 128, (float*)(const_cast<unsigned char*>(ws) + WS_SSQO) + (tok0 + tq) * 16 + h, hh);
}

__device__ __forceinline__ void phase_attn(const Params& P, LAS unsigned char* lds, int vcu, int G, int wave) {
    const int lane = hw_lane(), tid = wave * 64 + lane;
    const unsigned char* ws = P.ws;
#ifndef REP_MLA
#define REP_MLA 1
#endif
#ifndef REP_DIL
#define REP_DIL 1
#endif
    for (int rm_ = 0; rm_ < REP_MLA; ++rm_)
    for (int u = vcu; u < 256; u += G) { const int bh = u >> 2, pr = u & 3;
        mla_unit(ws, lds, bh >> 3, bh & 7, 7 - pr, tid, wave, lane);
        mla_unit(ws, lds, bh >> 3, bh & 7, pr, tid, wave, lane); }
    __syncthreads();
    LAS unsigned char* vl = lds + wave * (32 * VS); LAS unsigned char* sh = lds + NWAVES * (32 * VS);
    for (int rd_ = 0; rd_ < REP_DIL; ++rd_)
    if (G == 256) {
#pragma unroll 1
        for (int k = 0; k < 2; ++k) { const int t = (vcu >> 5) * 512 + k * 256 + (vcu & 31) * 8 + wave; const int bh = t >> 6, rem = t & 63, jj = rem >> 4, r16 = rem & 15;
            dil_tile(ws, vl, sh, bh >> 3, bh & 7, k == 0 ? jj : 3 - jj, r16, tid, lane); }
    } else {
#pragma unroll 1
        for (int t = vcu * 8 + wave; t < 4096; t += G * 8) { const int bh = t >> 6, rem = t & 63; dil_tile(ws, vl, sh, bh >> 3, bh & 7, rem >> 4, rem & 15, tid, lane); }
    }
}
}
namespace peer {
typedef __bf16 bf2_t __attribute__((ext_vector_type(2)));
#define MFMA32(a, b, c) __builtin_amdgcn_mfma_f32_32x32x16_bf16((a), (b), (c), 0, 0, 0)
__device__ __forceinline__ float fmax3(float a, float b, float c) { return fmaxf(fmaxf(a, b), c); }
__device__ __forceinline__ float asf(unsigned u) { return __builtin_bit_cast(float, u); }
__device__ __forceinline__ unsigned asu(float f) { return __builtin_bit_cast(unsigned, f); }

__device__ __forceinline__ void route_item(const unsigned char* ws, LAS unsigned* sc, int tile, int h, int lane) {
    const bf16* QP = (const bf16*)(ws + WS_QP); const bf16* SK = (const bf16*)(ws + WS_SK);
    int* RIDX = (int*)(ws + WS_RIDX); float* RGATE = (float*)(ws + WS_RGATE);
    const int r32 = lane & 31, hh = lane >> 5;
    const size_t tok = (size_t)tile * 32 + r32;
    float rs2; { const f32x4* sp = (const f32x4*)((const float*)(ws + WS_SSQH) + tok * 32); f32x4 a = sp[0];
#pragma unroll
        for (int i = 1; i < 8; ++i) a = a + sp[i];
        rs2 = rsqrtf(((a[0] + a[1]) + (a[2] + a[3])) * (1.f / 2048.f) + EPS); }
#pragma unroll 1
    for (int p = 0; p < 2; ++p) {
        f32x16 s[4];
#pragma unroll
        for (int kb = 0; kb < 4; ++kb)
#pragma unroll
            for (int r = 0; r < 16; ++r) s[kb][r] = 0.f;
        const bf16* qp = QP + tok * 2048 + h * 256 + p * 128 + 8 * hh;
        const bf16* kp = SK + ((size_t)(h * 2 + p) * 128 + r32) * 128 + 8 * hh;
#pragma unroll
        for (int ks = 0; ks < 8; ++ks) { const bf16x8 q = *(const bf16x8*)(qp + 16 * ks);
#pragma unroll
            for (int kb = 0; kb < 4; ++kb) { const bf16x8 k = *(const bf16x8*)(kp + (size_t)kb * 32 * 128 + 16 * ks); s[kb] = MFMA32(k, q, s[kb]); } }
#pragma unroll
        for (int kb = 0; kb < 4; ++kb)
#pragma unroll
            for (int r = 0; r < 16; ++r) s[kb][r] = asf((asu(s[kb][r] * rs2) & ~127u) | (unsigned)(32 * kb + (r & 3) + 8 * (r >> 2) + 4 * hh));
#pragma unroll 1
        for (int k = 0; k < 16; ++k) {
            float mx = s[0][0];
#pragma unroll
            for (int kb = 0; kb < 4; ++kb)
#pragma unroll
                for (int r = 0; r < 16; r += 2) mx = fmax3(mx, s[kb][r], s[kb][r + 1]);
            mx = fmaxf(mx, __shfl_xor(mx, 32));
            if (hh == 0) sc[(p * 32 + r32) * 16 + k] = asu(mx);
#pragma unroll
            for (int kb = 0; kb < 4; ++kb)
#pragma unroll
                for (int r = 0; r < 16; ++r) s[kb][r] = (s[kb][r] == mx) ? -3.0e38f : s[kb][r];
        }
    }
    unsigned t1[16], t2[16];
#pragma unroll
    for (int i = 0; i < 16; i += 4) { const v4u a = *(const LAS v4u*)(sc + r32 * 16 + i), b = *(const LAS v4u*)(sc + (32 + r32) * 16 + i);
        t1[i] = a.x; t1[i + 1] = a.y; t1[i + 2] = a.z; t1[i + 3] = a.w; t2[i] = b.x; t2[i + 1] = b.y; t2[i + 2] = b.z; t2[i + 3] = b.w; }
    float c[50]; int n = 0;
#pragma unroll
    for (int i = 0; i < 16; ++i)
#pragma unroll
        for (int j = 0; j < 16; ++j) if ((i + 1) * (j + 1) <= 16) { const float v = asf(t1[i] & ~127u) + asf(t2[j] & ~127u); c[n] = asf((asu(v) & ~255u) | (unsigned)(i * 16 + j)); ++n; }
    float best[8]; float bmax = 0.f, esum = 0.f;
#pragma unroll
    for (int k = 0; k < 16; ++k) {
        float mx = c[0];
#pragma unroll
        for (int q = 1; q < 49; q += 2) mx = fmax3(mx, c[q], c[q + 1]);
        mx = fmaxf(mx, c[49]);
#pragma unroll
        for (int q = 0; q < 50; ++q) c[q] = (c[q] == mx) ? -3.0e38f : c[q];
        const float val = asf(asu(mx) & ~255u);
        if (k == 0) bmax = val;
        esum += __expf(val - bmax);
        if ((k >> 3) == hh) best[k & 7] = mx;
    }
    const float inv = 1.0f / esum;
    int idx[8]; float gate[8];
#pragma unroll
    for (int k = 0; k < 8; ++k) { const unsigned code = asu(best[k]) & 255u; const unsigned a = sc[r32 * 16 + (code >> 4)], b = sc[(32 + r32) * 16 + (code & 15)];
        idx[k] = (int)((a & 127u) * 128u + (b & 127u)); gate[k] = __expf(asf(asu(best[k]) & ~255u) - bmax) * inv; }
    int* ip = RIDX + tok * 128 + h * 16 + 8 * hh; float* gp = RGATE + tok * 128 + h * 16 + 8 * hh;
    *(v4u*)ip = (v4u){(unsigned)idx[0], (unsigned)idx[1], (unsigned)idx[2], (unsigned)idx[3]}; *(v4u*)(ip + 4) = (v4u){(unsigned)idx[4], (unsigned)idx[5], (unsigned)idx[6], (unsigned)idx[7]};
    *(f32x4*)gp = (f32x4){gate[0], gate[1], gate[2], gate[3]}; *(f32x4*)(gp + 4) = (f32x4){gate[4], gate[5], gate[6], gate[7]};
}

__device__ __forceinline__ void phase_route(const Params& P, LAS unsigned char* lds, int vcu, int G, int wave) {
    const int lane = hw_lane();
    LAS unsigned* sc = (LAS unsigned*)(lds + wave * 4096);
#pragma unroll 1
    for (int it = vcu * NWAVES + wave; it < 512 * 8; it += G * NWAVES) route_item(P.ws, sc, it >> 3, it & 7, lane);
}

__device__ __forceinline__ void phase_regroup(const Params& P, int vcu, int G, int wave) {
    const int lane = hw_lane();
    const unsigned char* ws = P.ws;
    const int* RIDX = (const int*)(ws + WS_RIDX); const float* RGATE = (const float*)(ws + WS_RGATE);
    int* SIDX = (int*)(ws + WS_SIDX); float* SGATE = (float*)(ws + WS_SGATE); unsigned char* GOFF = (unsigned char*)(ws + WS_GOFF);
    const unsigned long long lt = (1ull << lane) - 1ull;
#pragma unroll 1
    for (int t = vcu * NWAVES + wave; t < M; t += G * NWAVES) {
        const size_t tok = (size_t)t;
        const int i0 = RIDX[tok * 128 + lane], i1 = RIDX[tok * 128 + 64 + lane];
        const float g0 = RGATE[tok * 128 + lane], g1 = RGATE[tok * 128 + 64 + lane];
        const int q0 = i0 >> 10, q1 = i1 >> 10;
        int off = 0, pos0 = 0, pos1 = 0, myoff = 0;
#pragma unroll
        for (int g = 0; g < 16; ++g) {
            const unsigned long long m0 = __ballot(q0 == g), m1 = __ballot(q1 == g);
            const int c0 = __popcll(m0), c1 = __popcll(m1);
            if (q0 == g) pos0 = off + __popcll(m0 & lt);
            if (q1 == g) pos1 = off + c0 + __popcll(m1 & lt);
            if (lane == g) myoff = off;
            off += c0 + c1;
        }
        if (lane == 16) myoff = 128;
        SIDX[tok * 128 + pos0] = i0; SIDX[tok * 128 + pos1] = i1;
        SGATE[tok * 128 + pos0] = g0; SGATE[tok * 128 + pos1] = g1;
        if (lane < 32) GOFF[tok * 32 + lane] = (unsigned char)(lane <= 16 ? myoff : 128);
    }
}
__device__ __forceinline__ float dot16_f8(const float (&x)[16], const v4u& u, float c) {
    const int u0 = (int)u.x, u1 = (int)u.y, u2 = (int)u.z, u3 = (int)u.w;
    const f32x2 a0 = __builtin_amdgcn_cvt_pk_f32_fp8(u0, false), a1 = __builtin_amdgcn_cvt_pk_f32_fp8(u0, true);
    const f32x2 a2 = __builtin_amdgcn_cvt_pk_f32_fp8(u1, false), a3 = __builtin_amdgcn_cvt_pk_f32_fp8(u1, true);
    const f32x2 a4 = __builtin_amdgcn_cvt_pk_f32_fp8(u2, false), a5 = __builtin_amdgcn_cvt_pk_f32_fp8(u2, true);
    const f32x2 a6 = __builtin_amdgcn_cvt_pk_f32_fp8(u3, false), a7 = __builtin_amdgcn_cvt_pk_f32_fp8(u3, true);
    c = fmaf(x[0], a0.x, c); c = fmaf(x[1], a0.y, c); c = fmaf(x[2], a1.x, c); c = fmaf(x[3], a1.y, c);
    c = fmaf(x[4], a2.x, c); c = fmaf(x[5], a2.y, c); c = fmaf(x[6], a3.x, c); c = fmaf(x[7], a3.y, c);
    c = fmaf(x[8], a4.x, c); c = fmaf(x[9], a4.y, c); c = fmaf(x[10], a5.x, c); c = fmaf(x[11], a5.y, c);
    c = fmaf(x[12], a6.x, c); c = fmaf(x[13], a6.y, c); c = fmaf(x[14], a7.x, c); c = fmaf(x[15], a7.y, c);
    return c;
}
__device__ __forceinline__ void unpack8(float* x, const v4u& v) { x[0] = bflo(v.x); x[1] = bfhi(v.x); x[2] = bflo(v.y); x[3] = bfhi(v.y); x[4] = bflo(v.z); x[5] = bfhi(v.z); x[6] = bflo(v.w); x[7] = bfhi(v.w); }
__device__ __forceinline__ void peer_u_token(const Params& P, size_t tok, int lane) {
    const unsigned char* ws = P.ws;
    const bf16* H1B = (const bf16*)(ws + WS_B); const unsigned char* U8 = ws + WS_UB;
    const int* RIDX = (const int*)(ws + WS_SIDX); const float* RGATE = (const float*)(ws + WS_SGATE); const float* SSQH = (const float*)(ws + WS_SSQH);
    unsigned* PKV = (unsigned*)(ws + WS_PKV);
    float x0[16], x1[16];
    { const bf16* hp = H1B + tok * 2048 + 16 * lane; const v4u a = *(const v4u*)hp, b = *(const v4u*)(hp + 8), c = *(const v4u*)(hp + 1024), d = *(const v4u*)(hp + 1032);
      unpack8(x0, a); unpack8(x0 + 8, b); unpack8(x1, c); unpack8(x1 + 8, d); }
    const float rs2 = rsqrtf(wave_sum(lane < 32 ? SSQH[tok * 32 + lane] : 0.f) * (1.f / 2048.f) + EPS) * (1.f / 32.f);
    const int i0 = RIDX[tok * 128 + lane], i1 = RIDX[tok * 128 + 64 + lane];
    const float g0 = RGATE[tok * 128 + lane], g1 = RGATE[tok * 128 + 64 + lane];
    float d0 = 0.f, d1 = 0.f;
    v4u ra[16], rb[16];
#define PU_LOAD(buf, g) do { _Pragma("unroll") for (int e = 0; e < 8; ++e) { const int row = __builtin_amdgcn_readlane((g) < 8 ? i0 : i1, ((g) & 7) * 8 + e); \
        const unsigned char* up = U8 + (size_t)row * 2048 + 16 * lane; buf[2 * e] = *(const v4u*)up; buf[2 * e + 1] = *(const v4u*)(up + 1024); } } while (0)
#define PU_COMPUTE(buf, g) do { float pt[8]; _Pragma("unroll") for (int e = 0; e < 8; ++e) pt[e] = dot16_f8(x1, buf[2 * e + 1], dot16_f8(x0, buf[2 * e], 0.f)); \
        float a4[4], a2[2], a1; \
        _Pragma("unroll") for (int i = 0; i < 4; ++i) { const float keep = (lane & 1) ? pt[2 * i + 1] : pt[2 * i], give = (lane & 1) ? pt[2 * i] : pt[2 * i + 1]; a4[i] = keep + __shfl_xor(give, 1); } \
        _Pragma("unroll") for (int i = 0; i < 2; ++i) { const float keep = (lane & 2) ? a4[2 * i + 1] : a4[2 * i], give = (lane & 2) ? a4[2 * i] : a4[2 * i + 1]; a2[i] = keep + __shfl_xor(give, 2); } \
        { const float keep = (lane & 4) ? a2[1] : a2[0], give = (lane & 4) ? a2[0] : a2[1]; a1 = keep + __shfl_xor(give, 4); } \
        a1 += __shfl_xor(a1, 8); a1 += __shfl_xor(a1, 16); a1 += __shfl_xor(a1, 32); \
        if ((lane >> 3) == ((g) & 7)) { if ((g) < 8) d0 = a1; else d1 = a1; } } while (0)
    PU_LOAD(ra, 0);
#pragma unroll 1
    for (int g = 0; g < 16; g += 2) {
        PU_LOAD(rb, g + 1);
        PU_COMPUTE(ra, g);
        if (g + 2 < 16) PU_LOAD(ra, g + 2);
        PU_COMPUTE(rb, g + 1);
    }
#undef PU_LOAD
#undef PU_COMPUTE
    const float z0 = d0 * rs2, z1 = d1 * rs2;
    const float a0 = 8.0f * z0 * (1.0f + erff(z0 * 0.7071067811865476f)) * g0, a1v = 8.0f * z1 * (1.0f + erff(z1 * 0.7071067811865476f)) * g1;
    unsigned* pk = PKV + ((tok >> 6) * 128) * 64 + (tok & 63) * 4;
    pk[(size_t)(lane >> 2) * 256 + (lane & 3)] = ((unsigned)i0 << 2) | ((unsigned)__builtin_bit_cast(unsigned short, (_Float16)a0) << 16);
    pk[(size_t)(16 + (lane >> 2)) * 256 + (lane & 3)] = ((unsigned)i1 << 2) | ((unsigned)__builtin_bit_cast(unsigned short, (_Float16)a1v) << 16);
}
#ifndef U_WAVES
#define U_WAVES 4
#endif
__device__ __forceinline__ void phase_peer_u(const Params& P, int vcu, int G, int wave) {
    const int lane = hw_lane();
    if (wave >= U_WAVES) return;
#pragma unroll 1
    for (int t = vcu * U_WAVES + wave; t < M; t += G * U_WAVES) peer_u_token(P, (size_t)t, lane);
}
typedef _Float16 h2_t __attribute__((ext_vector_type(2)));
__device__ __forceinline__ void peer_v_range(const Params& P, int c, int b0, int b1, int wv, int nwv, int lane) {
    const unsigned char* ws = P.ws;
    const bf16* H1B = (const bf16*)(ws + WS_B); const unsigned* PKV = (const unsigned*)(ws + WS_PKV);
    if (b0 + wv >= b1) return;
    unsigned w0[16], w1[16], w2[16], w3[16];
#define PV_LOAD(buf) do { _Pragma("unroll") for (int q = 0; q < 4; ++q) { const v4u t4 = pl[q * 64]; buf[4 * q] = t4.x; buf[4 * q + 1] = t4.y; buf[4 * q + 2] = t4.z; buf[4 * q + 3] = t4.w; } pl += 4 * 64; asm volatile("" : "+v"(pl)); } while (0)
#define PV_PROC(buf) do { v2u vv[16]; _Pragma("unroll") for (int i = 0; i < 16; ++i) vv[i] = *(const LAS v2u*)(size_t)((buf[i] << 1) & 0x1fff8u);     \
        _Pragma("unroll") for (int i = 0; i < 16; ++i) { const _Float16 ah = __builtin_bit_cast(_Float16, (unsigned short)(buf[i] >> 16)); const h2_t a2 = {ah, ah}; \
            y0 = __builtin_elementwise_fma(a2, __builtin_bit_cast(h2_t, __builtin_amdgcn_cvt_scalef32_pk_f16_fp8(vv[i].x, 1.0f, false)), y0); \
            y1 = __builtin_elementwise_fma(a2, __builtin_bit_cast(h2_t, __builtin_amdgcn_cvt_scalef32_pk_f16_fp8(vv[i].x, 1.0f, true)), y1); \
            y2 = __builtin_elementwise_fma(a2, __builtin_bit_cast(h2_t, __builtin_amdgcn_cvt_scalef32_pk_f16_fp8(vv[i].y, 1.0f, false)), y2); \
            y3 = __builtin_elementwise_fma(a2, __builtin_bit_cast(h2_t, __builtin_amdgcn_cvt_scalef32_pk_f16_fp8(vv[i].y, 1.0f, true)), y3); } } while (0)
    const v4u* pl = (const v4u*)PKV + (size_t)(b0 + wv) * 32 * 64 + lane;
    PV_LOAD(w0); PV_LOAD(w1); PV_LOAD(w2);
    v4u hxn = *(const v4u*)(H1B + ((size_t)(b0 + wv) * 64 + lane) * 2048 + 8 * c);
#pragma unroll 1
    for (int b = b0 + wv; b < b1; b += nwv) {
        const size_t tok = (size_t)b * 64 + lane;
        const int bn = (b + nwv < b1) ? b + nwv : b;
        h2_t y0 = {0, 0}, y1 = {0, 0}, y2 = {0, 0}, y3 = {0, 0};
        v4u hx = hxn;
#pragma unroll 1
        for (int half = 0; half < 2; ++half) {
            PV_LOAD(w3); PV_PROC(w0);
            if (half == 1) { hxn = *(const v4u*)(H1B + ((size_t)bn * 64 + lane) * 2048 + 8 * c); pl += (ptrdiff_t)(bn - b - 1) * 32 * 64; }
            PV_LOAD(w0); PV_PROC(w1);
            PV_LOAD(w1); PV_PROC(w2);
            PV_LOAD(w2); PV_PROC(w3);
        }
        float y[8]; unpack8(y, hx);
        constexpr float S = 1.0f / 32.0f;
        y[0] += S * (float)y0[0]; y[1] += S * (float)y0[1]; y[2] += S * (float)y1[0]; y[3] += S * (float)y1[1];
        y[4] += S * (float)y2[0]; y[5] += S * (float)y2[1]; y[6] += S * (float)y3[0]; y[7] += S * (float)y3[1];
        float* op = P.out + tok * 2048 + 8 * c;
        *(f32x4*)op = (f32x4){y[0], y[1], y[2], y[3]}; *(f32x4*)(op + 4) = (f32x4){y[4], y[5], y[6], y[7]};
    }
#undef PV_LOAD
#undef PV_PROC
}
__device__ __forceinline__ void peer_v_fill(const Params& P, int c, int tid) {
    const v4u* src = (const v4u*)(P.ws + WS_VB + (size_t)c * 131072);
#pragma unroll 4
    for (int i = tid; i < 8192; i += NTHREADS) *(LAS v4u*)(size_t)(16 * i) = src[i];
}
__device__ __forceinline__ void phase_final(const Params& P, int vcu, int G, int wave) {
    const int lane = hw_lane();
    f32x4 gv[8];
#pragma unroll
    for (int j = 0; j < 8; ++j) gv[j] = ((const f32x4*)P.lnf)[lane + 64 * j];
#pragma unroll 1
    for (int t = vcu * NWAVES + wave; t < M; t += G * NWAVES) {
        f32x4* row = (f32x4*)(P.out + (size_t)t * 2048) + lane;
        f32x4 v[8]; float s = 0.f;
#pragma unroll
        for (int j = 0; j < 8; ++j) { v[j] = row[64 * j]; s += (v[j].x * v[j].x + v[j].y * v[j].y) + (v[j].z * v[j].z + v[j].w * v[j].w); }
        const float rs = rsqrtf(wave_sum(s) * (1.f / 2048.f) + EPS);
#pragma unroll
        for (int j = 0; j < 8; ++j) row[64 * j] = v[j] * rs * gv[j];
    }
}
#undef MFMA32
}
#define XB_TMO      128
#define XB_XCNT(j)  (256  + 64 * (j))
#define XB_XSUB(j)  (1280 + 64 * (j))
#define XB_XGEN(j)  (2304 + 64 * (j))
#define XB_TOP      3328
#define XB_TOPGEN   3392
#define XCD_BAR_WORDS 3456
#define XB_SPIN_CAP (1u << 22)
__device__ __forceinline__ unsigned xb_ld(unsigned* p)              { return __hip_atomic_load(p, __ATOMIC_RELAXED, __HIP_MEMORY_SCOPE_AGENT); }
__device__ __forceinline__ unsigned xb_add(unsigned* p, unsigned v) { return __hip_atomic_fetch_add(p, v, __ATOMIC_RELAXED, __HIP_MEMORY_SCOPE_AGENT); }
__device__ __forceinline__ unsigned xb_xcc_id() { return (unsigned)__builtin_amdgcn_s_getreg((3 << 11) | 20) & 0xFu; }
#define XB_SPIN(cond, bar) do { unsigned _sp = 0; while (cond) { __builtin_amdgcn_s_sleep(1); \
    if ((++_sp & 255u) == 0u) { if (xb_ld(&(bar)[XB_TMO])) break; if (_sp > XB_SPIN_CAP) { atomicAdd(&(bar)[XB_TMO], 1u); break; } } } } while (0)
struct XcdBarrier { unsigned* bar; unsigned x; volatile LAS unsigned* st; };
__device__ __forceinline__ XcdBarrier xcd_barrier_post(unsigned* bar, volatile LAS unsigned* st, bool leader) {
    XcdBarrier b; b.bar = bar; b.x = xb_xcc_id(); b.st = st;
    if (leader) (void)xb_add(&bar[XB_XCNT(b.x)], 1u);
    return b;
}
__device__ __forceinline__ void xcd_barrier_complete(unsigned* bar, unsigned x, unsigned& nloc, unsigned& nx) {
    const unsigned G = gridDim.x * gridDim.y * gridDim.z;
    unsigned sum, cnt, mine, sp = 0u;
    for (;;) {
        sum = 0u; cnt = 0u; mine = 0u;
#pragma unroll
        for (unsigned j = 0; j < 16; ++j) { const unsigned c = xb_ld(&bar[XB_XCNT(j)]); sum += c; cnt += (c > 0u) ? 1u : 0u; mine = (j == x) ? c : mine; }
        if (sum == G) break;
        __builtin_amdgcn_s_sleep(1);
        if ((++sp & 255u) == 0u) { if (xb_ld(&bar[XB_TMO])) break; if (sp > XB_SPIN_CAP) { atomicAdd(&bar[XB_TMO], 1u); break; } }
    }
    nloc = mine > 0u ? mine : 1u; nx = cnt > 0u ? cnt : 1u;
}
__device__ __forceinline__ void xcd_barrier(const XcdBarrier& b, int wave) {
    asm volatile("s_waitcnt vmcnt(0)" ::: "memory");
    __syncthreads();
    if (wave == 0 && hw_lane() == 0) {
        unsigned* bar = b.bar;
        __builtin_amdgcn_s_waitcnt(0);
        unsigned nloc = b.st[0], nx = b.st[1];
        if (nloc == 0u) { xcd_barrier_complete(bar, b.x, nloc, nx); b.st[0] = nloc; b.st[1] = nx; }
        const unsigned old = xb_add(&bar[XB_XSUB(b.x)], 1u);
        const unsigned gen = old / nloc;
        if (old + 1u == (gen + 1u) * nloc) {
            __builtin_amdgcn_fence(__ATOMIC_RELEASE, "agent");
            asm volatile("s_waitcnt vmcnt(0)" ::: "memory");
            const unsigned og = xb_add(&bar[XB_TOP], 1u);
            const unsigned tg = og / nx;
            if (og + 1u == (tg + 1u) * nx) xb_add(&bar[XB_TOPGEN], 1u);
            else XB_SPIN(xb_ld(&bar[XB_TOPGEN]) == tg, bar);
            __builtin_amdgcn_fence(__ATOMIC_ACQUIRE, "agent");
            xb_add(&bar[XB_XGEN(b.x)], 1u);
            asm volatile("s_waitcnt vmcnt(0)" ::: "memory");
        } else {
            XB_SPIN(xb_ld(&bar[XB_XGEN(b.x)]) == gen, bar);
            __builtin_amdgcn_fence(__ATOMIC_ACQUIRE, "agent");
            asm volatile("s_waitcnt vmcnt(0)" ::: "memory");
        }
    }
    __syncthreads();
}
constexpr int N_PHASES = 11;
#ifndef REP_PHASE
#define REP_PHASE -1
#endif
#ifndef REP_N
#define REP_N 1
#endif
#ifndef EXTRA_SYNCS
#define EXTRA_SYNCS 0
#endif
__global__ void __launch_bounds__(NTHREADS, 2) mega(Params P) {
    extern __shared__ __attribute__((aligned(16))) unsigned char lds_raw[];
    LAS unsigned char* lds = (LAS unsigned char*)lds_raw;
    cg::grid_group grid = cg::this_grid();
    const int wave = __builtin_amdgcn_readfirstlane((int)threadIdx.x >> 6);
    const int G = gridDim.x, bx = blockIdx.x;
    const int vcu = (G % 8 == 0) ? (bx % 8) * (G / 8) + bx / 8 : bx;
    unsigned char* ws = P.ws;
    const int lo = P.ph_lo, hi = P.ph_hi;
#define IN(k) (lo <= (k) && (k) < hi)
#ifndef CG_SEAMS
#define CG_SEAMS 1
#endif
    volatile LAS unsigned* xbst = (volatile LAS unsigned*)(lds + MISC_OFF + 8192);
    if (wave == 0 && hw_lane() == 0) { xbst[0] = 0u; xbst[1] = 0u; xbst[2] = 0u; xbst[3] = 0u; }
    __syncthreads();
    const XcdBarrier xbar = xcd_barrier_post((unsigned*)(ws + WS_CTL) + 4096, xbst, wave == 0 && hw_lane() == 0);
#define GSYNC(k) do { if ((k) < CG_SEAMS) grid.sync(); else xcd_barrier(xbar, wave); } while (0)
#define SEAM(k) do { if (IN(k) && IN((k) + 1)) GSYNC(k); } while (0)

    for (int rep_ = 0; rep_ < (REP_PHASE == 0 ? 1 + REP_N : 1); ++rep_) if (IN(0)) { if (rep_) GSYNC(9); phase_prep(P, lds, vcu, G, wave, rep_ ? PREP_ONLY : -1); }
    SEAM(0);
    for (int es_ = 0; es_ < EXTRA_SYNCS; ++es_) GSYNC(9);
    for (int rep_ = 0; rep_ < (REP_PHASE == 1 ? 1 + REP_N : 1); ++rep_) if (IN(1)) { if (rep_) GSYNC(9);
        pg8::GemmSet g; g.A0 = g.A1 = (const bf16*)(ws + WS_A); g.Bt0 = g.Bt1 = (const bf16*)(ws + WS_BT1); g.K = 2048;
        pg8::StaticOrder S; S.init(M, 4096, 0, G, bx);
        pg8::Epi1 E{(bf16*)(ws + WS_B), (bf16*)(ws + WS_CQ), (bf16*)(ws + WS_CKV), (float*)(ws + WS_SSQCQ), (float*)(ws + WS_SSQCKV)};
        pg8::gemm_phase<pg8::Epi1, pg8::StaticOrder>(lds, g, S, E, wave);
    }
    SEAM(1);
    for (int rep_ = 0; rep_ < (REP_PHASE == 2 ? 1 + REP_N : 1); ++rep_) if (IN(2)) { if (rep_) GSYNC(9);
        pg8::GemmSet g; g.A0 = (const bf16*)(ws + WS_CQ); g.A1 = (const bf16*)(ws + WS_CKV); g.Bt0 = (const bf16*)(ws + WS_BT2Q); g.Bt1 = (const bf16*)(ws + WS_BT2KV); g.K = 512;
        pg8::StaticOrder S; S.init(M, 1536, 2048, G, bx);
        pg8::Epi2 E{(bf16*)(ws + WS_QN), (bf16*)(ws + WS_QPE), (bf16*)(ws + WS_KN), (bf16*)(ws + WS_VM), (const float*)(ws + WS_SSQCQ), (const float*)(ws + WS_SSQCKV), (const f32x2*)(ws + WS_ROPE)};
        pg8::gemm_phase<pg8::Epi2, pg8::StaticOrder>(lds, g, S, E, wave);
        for (int it = G - 1 - bx; it < 128; it += G) kr_item((const bf16*)(ws + WS_A), (const bf16*)(ws + WS_BTKR), (const f32x2*)(ws + WS_ROPE), (bf16*)(ws + WS_KPE), it, wave, hw_lane());
    }
    SEAM(2);
    for (int rep_ = 0; rep_ < (REP_PHASE == 3 ? 1 + REP_N : 1); ++rep_) if (IN(3)) { if (rep_) GSYNC(9); att::phase_attn(P, lds, vcu, G, wave); }
    SEAM(3);
    for (int rep_ = 0; rep_ < (REP_PHASE == 4 ? 1 + REP_N : 1); ++rep_) if (IN(4)) { if (rep_) GSYNC(9);
        pg8::GemmSet g; g.A0 = g.A1 = (const bf16*)(ws + WS_A); g.Bt0 = g.Bt1 = (const bf16*)(ws + WS_BT3); g.K = 2048;
        pg8::StaticOrder S; S.init(M, 2048, 0, G, bx);
        pg8::Epi3 E{(bf16*)(ws + WS_B), P.x, (const float*)(ws + WS_SSQO), (float*)(ws + WS_SSQH), (LAS f32x2*)(lds + MISC_OFF)};
        pg8::gemm_phase<pg8::Epi3, pg8::StaticOrder>(lds, g, S, E, wave);
    }
    SEAM(4);
    for (int rep_ = 0; rep_ < (REP_PHASE == 5 ? 1 + REP_N : 1); ++rep_) if (IN(5)) { if (rep_) GSYNC(9);
        pg8::GemmSet g; g.A0 = g.A1 = (const bf16*)(ws + WS_B); g.Bt0 = g.Bt1 = (const bf16*)(ws + WS_BT4); g.K = 2048;
        pg8::StaticOrder S; S.init(M, 2048, 0, G, bx);
        pg8::Epi4 E{(bf16*)(ws + WS_QP)};
        pg8::gemm_phase<pg8::Epi4, pg8::StaticOrder>(lds, g, S, E, wave);
    }
#ifdef EXTRA_G4
    if (IN(5)) { GSYNC(9);
        pg8::GemmSet g; g.A0 = g.A1 = (const bf16*)(ws + WS_B); g.Bt0 = g.Bt1 = (const bf16*)(ws + WS_BT4); g.K = 2048;
        pg8::StaticOrder S; S.init(M, 2048, 0, G, bx);
#if EXTRA_G4 == 1
        pg8::Epi4 E{(bf16*)(ws + WS_QP)}; pg8::gemm_phase<pg8::Epi4, pg8::StaticOrder>(lds, g, S, E, wave);
#else
        pg8::EpiNull E{}; pg8::gemm_phase<pg8::EpiNull, pg8::StaticOrder>(lds, g, S, E, wave);
#endif
    }
#endif
    SEAM(5);
    for (int rep_ = 0; rep_ < (REP_PHASE == 6 ? 1 + REP_N : 1); ++rep_) if (IN(6)) { if (rep_) GSYNC(9); peer::phase_route(P, lds, vcu, G, wave); }
    SEAM(6);
    for (int rep_ = 0; rep_ < (REP_PHASE == 7 ? 1 + REP_N : 1); ++rep_) if (IN(7)) { if (rep_) GSYNC(9); peer::phase_regroup(P, vcu, G, wave); }
    SEAM(7);
    for (int rep_ = 0; rep_ < (REP_PHASE == 8 ? 1 + REP_N : 1); ++rep_) if (IN(8)) { if (rep_) GSYNC(9); peer::phase_peer_u(P, vcu, G, wave); }
    SEAM(8);
    for (int rep_ = 0; rep_ < (REP_PHASE == 9 ? 1 + REP_N : 1); ++rep_) if (IN(9)) { if (rep_) GSYNC(9);
        const int lane_ = hw_lane();
        for (int c = vcu; c < 256; c += G) { __syncthreads(); peer::peer_v_fill(P, c, wave * 64 + lane_); __syncthreads(); peer::peer_v_range(P, c, 0, 256, wave, NWAVES, lane_); }
    }
    SEAM(9);
    for (int rep_ = 0; rep_ < (REP_PHASE == 10 ? 1 + REP_N : 1); ++rep_) if (IN(10)) { if (rep_) GSYNC(9); peer::phase_final(P, vcu, G, wave); }
#undef IN
#undef SEAM
}

static int mega_grid() {
    static int grid = 0;
    if (grid == 0) {
        int dev = 0, cus = 0, per_cu = 0;
        (void)hipGetDevice(&dev); (void)hipDeviceGetAttribute(&cus, hipDeviceAttributeMultiprocessorCount, dev);
        (void)hipFuncSetAttribute((const void*)mega, hipFuncAttributeMaxDynamicSharedMemorySize, LDS_BYTES);
        (void)hipOccupancyMaxActiveBlocksPerMultiprocessor(&per_cu, (const void*)mega, NTHREADS, LDS_BYTES);
        if (per_cu < 1) { fprintf(stderr, "mega: occupancy query says %d blocks/CU\n", per_cu); per_cu = 1; }
        grid = cus;
        (void)hipGetLastError();
    }
    return grid;
}
static void fill_params(Params& P, void* const* d_in, void* d_out, void* d_ws) {
    P.x = (const float*)d_in[0]; P.ln1 = (const float*)d_in[1]; P.w_in = (const float*)d_in[2]; P.qan = (const float*)d_in[3]; P.kvan = (const float*)d_in[4];
    P.w_uq = (const float*)d_in[5]; P.w_ukv = (const float*)d_in[6]; P.ond = (const float*)d_in[7]; P.onm = (const float*)d_in[8]; P.w_o = (const float*)d_in[9];
    P.ln2 = (const float*)d_in[10]; P.wq = (const float*)d_in[11]; P.sk = (const float*)d_in[12]; P.pu = (const float*)d_in[13]; P.pv = (const float*)d_in[14]; P.lnf = (const float*)d_in[15];
    P.out = (float*)d_out; P.ws = (unsigned char*)d_ws;
}
static void launch_phases(Params P, int lo, int hi, hipStream_t st) {
    P.ph_lo = lo; P.ph_hi = hi;
    (void)hipMemsetAsync(P.ws + WS_CTL, 0, CTL_ZERO_BYTES, st);
    void* args[] = {&P};
    hipError_t e = hipLaunchCooperativeKernel((const void*)mega, dim3(mega_grid()), dim3(NTHREADS), args, LDS_BYTES, st);
    if (e != hipSuccess) fprintf(stderr, "mega launch [%d,%d) failed: %s\n", lo, hi, hipGetErrorString(e));
}
extern "C" void kernel_launch(void* const* d_in, const int* in_sizes, int n_in, void* d_out, int out_size, void* d_ws, size_t ws_size, hipStream_t stream) {
    Params P{}; fill_params(P, d_in, d_out, d_ws);
    launch_phases(P, 0, N_PHASES, stream);
}
```

```cpp
#include <hip/hip_runtime.h>
#include <hip/hip_cooperative_groups.h>
#include <cstdio>
#include <cstdint>
#include <cstddef>
namespace cg = cooperative_groups;
#define GAS __attribute__((address_space(1)))
#define LAS __attribute__((address_space(3)))
typedef unsigned short bf16;
typedef unsigned v4u __attribute__((ext_vector_type(4)));
typedef unsigned v2u __attribute__((ext_vector_type(2)));
typedef float f32x2 __attribute__((ext_vector_type(2)));
typedef float f32x4 __attribute__((ext_vector_type(4)));
typedef float f32x16 __attribute__((ext_vector_type(16)));
typedef short bf16x8 __attribute__((ext_vector_type(8)));
typedef short s16x4 __attribute__((ext_vector_type(4)));
typedef __bf16 bf16x2_t __attribute__((ext_vector_type(2)));
typedef float f32x32 __attribute__((ext_vector_type(32)));
typedef unsigned v6u __attribute__((ext_vector_type(6)));
constexpr int CW_FLAG = 64;
constexpr float U6_SCALE = 64.0f;

constexpr int M = 16384, SEQ = 2048, DM = 2048, NWAVES = 8, NTHREADS = 512;
constexpr float EPS = 1e-6f, LOG2E = 1.4426950408889634f;
constexpr float QSCALE_DIL = 0.08838834764831845f * LOG2E;
constexpr float QSCALE_MLA = 0.07216878364870323f * LOG2E;

constexpr size_t MiB = 1u << 20;
constexpr size_t WS_CTL = 0, CTL_ZERO_BYTES = 64 * 1024;
constexpr size_t WS_ROPE = 1 * MiB;
constexpr size_t WS_SK = 2 * MiB;
constexpr size_t WS_BTKR = 3 * MiB;
constexpr size_t WS_BT2Q = 4 * MiB;
constexpr size_t WS_BT2KV = 6 * MiB;
constexpr size_t WS_BT1 = 8 * MiB;
constexpr size_t WS_BT3 = 24 * MiB;
constexpr size_t WS_BT4 = 32 * MiB;
constexpr size_t WS_SSQCQ = 40 * MiB;
constexpr size_t WS_SSQCKV = 40 * MiB + 512 * 1024;
constexpr size_t WS_SSQO = 41 * MiB;
constexpr size_t WS_SSQH = 42 * MiB;
constexpr size_t WS_KPE = 44 * MiB;
constexpr size_t WS_UB = 48 * MiB;
constexpr size_t WS_VB = 112 * MiB;
constexpr size_t WS_A = 176 * MiB;
constexpr size_t WS_B = 240 * MiB;
constexpr size_t WS_C = 336 * MiB;
constexpr size_t WS_QN = WS_C, WS_QPE = WS_C + 32 * MiB, WS_KN = WS_C + 48 * MiB, WS_VM = WS_C + 80 * MiB;
constexpr size_t WS_QP = WS_C, WS_RIDX = WS_C + 64 * MiB, WS_RGATE = WS_C + 72 * MiB, WS_PKV = WS_C + 80 * MiB,
                 WS_SIDX = WS_C + 88 * MiB, WS_SGATE = WS_C + 96 * MiB, WS_GOFF = WS_C + 104 * MiB;
constexpr size_t WS_D = 448 * MiB;
constexpr size_t WS_CQ = WS_D, WS_CKV = WS_D + 16 * MiB;
constexpr size_t WS_END = 480 * MiB;

constexpr int RING_BYTES = 131072;
constexpr int MISC_OFF = RING_BYTES;
constexpr int LDS_BYTES = 147456;

#define LDS_WAIT() asm volatile("s_waitcnt lgkmcnt(0)" ::: "memory")
#define VM_WAIT() asm volatile("s_waitcnt vmcnt(0)" ::: "memory")

__device__ __forceinline__ unsigned f2bf(float f) { unsigned u = __builtin_bit_cast(unsigned, f); return (u + 0x7fffu + ((u >> 16) & 1u)) >> 16; }
__device__ __forceinline__ unsigned pk2(float lo, float hi) { f32x2 v = {lo, hi}; bf16x2_t b = __builtin_convertvector(v, bf16x2_t); return __builtin_bit_cast(unsigned, b); }
__device__ __forceinline__ float bflo(unsigned u) { return __builtin_bit_cast(float, u << 16); }
__device__ __forceinline__ float bfhi(unsigned u) { return __builtin_bit_cast(float, u & 0xffff0000u); }
__device__ __forceinline__ float bf2f(bf16 b) { return __builtin_bit_cast(float, (unsigned)b << 16); }
__device__ __forceinline__ float wave_sum(float v) {
#pragma unroll
    for (int o = 1; o < 64; o <<= 1) v += __shfl_xor(v, o);
    return v;
}

__device__ __forceinline__ int hw_lane() { int l; asm volatile("v_mbcnt_lo_u32_b32 %0, -1, 0\n\tv_mbcnt_hi_u32_b32 %0, -1, %0" : "=v"(l)); return l; }

struct Params {
    const float *x, *ln1, *w_in, *qan, *kvan, *w_uq, *w_ukv, *ond, *onm, *w_o, *ln2, *wq, *sk, *pu, *pv, *lnf;
    float* out; unsigned char* ws;
    int ph_lo, ph_hi;
};
__device__ __forceinline__ int map_ident(int c) { return c; }
__device__ __forceinline__ int map_kr(int c) { const int p = c - 4096; return 2 * (p & 31) + (p >> 5); }
__device__ __forceinline__ int map_uq(int c) { const int h = c / 192, e = c % 192; if (e < 128) return h * 128 + e; const int p = e - 128; return 1024 + h * 64 + 2 * (p & 31) + (p >> 5); }
__device__ __forceinline__ int map_ukv(int c) { const int h = c >> 8, e = c & 255; return e < 128 ? h * 128 + e : 1024 + h * 128 + (e - 128); }

template <int MAP>
__device__ __forceinline__ void p0_transpose_item(const float* __restrict__ W, int K, int ldw, int c0, const float* __restrict__ g0, const float* __restrict__ g1, int gsplit,
                                                  bf16* __restrict__ WT, LAS float* scr, int item, int nblk, int lane) {
    const int kb = item / nblk, nb = item % nblk, k0 = 64 * kb, n0 = c0 + 32 * nb;
    f32x4 wv[8];
#pragma unroll
    for (int i = 0; i < 8; ++i) wv[i] = *(const f32x4*)(W + (size_t)(k0 + (lane >> 3) + 8 * i) * ldw + n0 + 4 * (lane & 7));
#pragma unroll
    for (int i = 0; i < 8; ++i) { const int kk = (lane >> 3) + 8 * i, k = k0 + kk; f32x4 w = wv[i];
        if (g0) w = w * (k < gsplit ? g0[k] : g1[k - gsplit]);
        LAS float* d = scr + kk * 33 + 4 * (lane & 7); d[0] = w[0]; d[1] = w[1]; d[2] = w[2]; d[3] = w[3]; }
    LDS_WAIT(); asm volatile("" ::: "memory");
    const int c = lane & 7;
#pragma unroll
    for (int j = 0; j < 4; ++j) { const int n = (lane >> 3) + 8 * j; const LAS float* s = scr + (8 * c) * 33 + n;
        v4u o; o.x = pk2(s[0 * 33], s[1 * 33]); o.y = pk2(s[2 * 33], s[3 * 33]); o.z = pk2(s[4 * 33], s[5 * 33]); o.w = pk2(s[6 * 33], s[7 * 33]);
        const int src = n0 + n;
        const int dr = MAP == 0 ? map_ident(src) : MAP == 1 ? map_kr(src) : MAP == 2 ? map_uq(src) : map_ukv(src);
        *(v4u*)(WT + (size_t)dr * K + k0 + 8 * c) = o; }
    LDS_WAIT(); asm volatile("" ::: "memory");
}

#ifndef PREP_ONLY
#define PREP_ONLY -1
#endif
__device__ __forceinline__ void phase_prep(const Params& P, LAS unsigned char* lds, int vcu, int G, int wave, int only = -1) {
    const int lane = hw_lane(), tid = wave * 64 + lane;
    unsigned char* ws = P.ws;
    LAS float* scr = (LAS float*)(lds + wave * 16384);
    const int gw = vcu * NWAVES + wave, NGW = G * NWAVES;
    const int gt = vcu * NTHREADS + tid, NGT = G * NTHREADS;
#pragma unroll 1
    for (int pi = 0; pi < 3; ++pi) {
        const int part = (pi + wave) % 3;
        if (only >= 0 && only != part) continue;
        if (part == 0) {
    constexpr int I1 = 32 * 128, IKR = 32 * 2, I2Q = 8 * 48, I2KV = 8 * 64, I3 = 32 * 64, I4 = 32 * 64;
    constexpr int NITEMS = I1 + IKR + I2Q + I2KV + I3 + I4;
    for (int it = gw; it < NITEMS; it += NGW) {
        int r = it;
        if (r < I1) { p0_transpose_item<0>(P.w_in, 2048, 4160, 0, nullptr, nullptr, 0, (bf16*)(ws + WS_BT1), scr, r, 128, lane); continue; } r -= I1;
        if (r < IKR) { p0_transpose_item<1>(P.w_in, 2048, 4160, 4096, nullptr, nullptr, 0, (bf16*)(ws + WS_BTKR), scr, r, 2, lane); continue; } r -= IKR;
        if (r < I2Q) { p0_transpose_item<2>(P.w_uq, 512, 1536, 0, P.qan, P.qan, 512, (bf16*)(ws + WS_BT2Q), scr, r, 48, lane); continue; } r -= I2Q;
        if (r < I2KV) { p0_transpose_item<3>(P.w_ukv, 512, 2048, 0, P.kvan, P.kvan, 512, (bf16*)(ws + WS_BT2KV), scr, r, 64, lane); continue; } r -= I2KV;
        if (r < I3) { p0_transpose_item<0>(P.w_o, 2048, 2048, 0, P.ond, P.onm, 1024, (bf16*)(ws + WS_BT3), scr, r, 64, lane); continue; } r -= I3;
        p0_transpose_item<0>(P.wq, 2048, 2048, 0, P.ln2, P.ln2, 2048, (bf16*)(ws + WS_BT4), scr, r, 64, lane);
    }
        } else if (part == 1) {
    {
        bf16* XN = (bf16*)(ws + WS_A);
        f32x4 gv[8];
#pragma unroll
        for (int j = 0; j < 8; ++j) gv[j] = ((const f32x4*)P.ln1)[lane + 64 * j];
        for (int m0 = gw * 4; m0 < M; m0 += NGW * 4) {
            f32x4 v[4][8];
#pragma unroll
            for (int r = 0; r < 4; ++r) { const f32x4* xr = (const f32x4*)(P.x + (size_t)(m0 + r) * DM) + lane;
#pragma unroll
                for (int j = 0; j < 8; ++j) v[r][j] = __builtin_nontemporal_load(xr + 64 * j); }
#pragma unroll
            for (int r = 0; r < 4; ++r) { float s = 0.f;
#pragma unroll
                for (int j = 0; j < 8; ++j) s += (v[r][j].x * v[r][j].x + v[r][j].y * v[r][j].y) + (v[r][j].z * v[r][j].z + v[r][j].w * v[r][j].w);
                const float rs = rsqrtf(wave_sum(s) * (1.f / DM) + EPS);
                v2u* o8 = (v2u*)(XN + (size_t)(m0 + r) * DM) + lane;
#pragma unroll
                for (int j = 0; j < 8; ++j) { v2u o; o.x = pk2(v[r][j].x * rs * gv[j].x, v[r][j].y * rs * gv[j].y); o.y = pk2(v[r][j].z * rs * gv[j].z, v[r][j].w * rs * gv[j].w); o8[64 * j] = o; } }
        }
    }
        } else {
        {
            f32x16 ta, tb;
#pragma unroll
            for (int i = 0; i < 16; ++i) { ta[i] = (float)(i & 7); tb[i] = (float)((i + 16) & 7) * 0.5f + (float)(i >> 3); }
            const f32x32 r = __builtin_amdgcn_cvt_scalef32_pk32_f32_fp6(__builtin_amdgcn_cvt_scalef32_2xpk16_fp6_f32(ta, tb, 1.0f), 1.0f);
            bool ok = true;
#pragma unroll
            for (int i = 0; i < 16; ++i) ok = ok && (r[2 * i] == ta[i]) && (r[2 * i + 1] == tb[i]);
            if (!ok) __hip_atomic_store((unsigned*)(ws + WS_CTL) + CW_FLAG, 1u, __ATOMIC_RELAXED, __HIP_MEMORY_SCOPE_AGENT);
        }
        unsigned char* ou = ws + WS_UB;
#pragma unroll 1
        for (int i = gt; i < 16384 * 64; i += NGT) {
            const int e = i >> 6, l = i & 63; const f32x4* src = (const f32x4*)(P.pu + (size_t)e * 2048 + 32 * l); const f32x4* gp = (const f32x4*)(P.ln2 + 32 * l);
            f32x16 xa, xb;
#pragma unroll
            for (int j = 0; j < 4; ++j) { const f32x4 v = __builtin_nontemporal_load(src + j) * gp[j] * U6_SCALE; xa[4 * j] = v[0]; xa[4 * j + 1] = v[1]; xa[4 * j + 2] = v[2]; xa[4 * j + 3] = v[3]; }
#pragma unroll
            for (int j = 0; j < 4; ++j) { const f32x4 v = __builtin_nontemporal_load(src + 4 + j) * gp[4 + j] * U6_SCALE; xb[4 * j] = v[0]; xb[4 * j + 1] = v[1]; xb[4 * j + 2] = v[2]; xb[4 * j + 3] = v[3]; }
            const v6u p6 = __builtin_amdgcn_cvt_scalef32_2xpk16_fp6_f32(xa, xb, 1.0f);
            unsigned char* row = ou + (size_t)e * 1536;
            *(v4u*)(row + 16 * l) = (v4u){p6[0], p6[1], p6[2], p6[3]}; *(v2u*)(row + 1024 + 8 * l) = (v2u){p6[4], p6[5]};
        }
        }
    }
    if (only < 0 || only == 3) {
        f32x2* R = (f32x2*)(ws + WS_ROPE);
        for (int i = gt; i < 2048 * 32; i += NGT) { const int pos = i >> 5, j = i & 31; const float freq = powf(10000.0f, -(float)j / 32.0f), ang = (float)pos * freq;
            f32x2 cs; cs.x = cosf(ang); cs.y = sinf(ang); R[i] = cs; }
    }
    if (only < 0 || only == 3) {
        v4u* o = (v4u*)(ws + WS_SK);
        for (int i = gt; i < 16 * 128 * 128 / 8; i += NGT) { const f32x4 a = ((const f32x4*)P.sk)[2 * i], b = ((const f32x4*)P.sk)[2 * i + 1];
            v4u w; w.x = pk2(a.x, a.y); w.y = pk2(a.z, a.w); w.z = pk2(b.x, b.y); w.w = pk2(b.z, b.w); o[i] = w; }
    }
    if (only < 0 || only == 4) {
        __syncthreads();
        LAS v2u* tl = (LAS v2u*)lds;
        v2u* ov = (v2u*)(ws + WS_VB);
        f32x4 ra[8], rb[8];
#define PV8_LOAD(tile_) do { const int _e0 = ((tile_) >> 2) * 64, _c0 = ((tile_) & 3) * 64; _Pragma("unroll") for (int k = 0; k < 8; ++k) { const int it = tid + 512 * k, e = it >> 6, c = it & 63; \
            const f32x4* src = (const f32x4*)(P.pv + (size_t)(_e0 + e) * 2048 + (size_t)(_c0 + c) * 8); ra[k] = __builtin_nontemporal_load(src); rb[k] = __builtin_nontemporal_load(src + 1); } } while (0)
        if (vcu < 1024) PV8_LOAD(vcu);
        for (int tile = vcu; tile < 1024; tile += G) {
            const int e0 = (tile >> 2) * 64, c0 = (tile & 3) * 64;
#pragma unroll
            for (int k = 0; k < 8; ++k) { const int it = tid + 512 * k, e = it >> 6, c = it & 63; const f32x4 a = ra[k], b = rb[k];
                int w0 = 0, w1 = 0;
                w0 = __builtin_amdgcn_cvt_pk_fp8_f32(a.x * 2.f, a.y * 2.f, w0, false); w0 = __builtin_amdgcn_cvt_pk_fp8_f32(a.z * 2.f, a.w * 2.f, w0, true);
                w1 = __builtin_amdgcn_cvt_pk_fp8_f32(b.x * 2.f, b.y * 2.f, w1, false); w1 = __builtin_amdgcn_cvt_pk_fp8_f32(b.z * 2.f, b.w * 2.f, w1, true);
                v2u w; w.x = (unsigned)w0; w.y = (unsigned)w1; tl[c * 65 + e] = w; }
            if (tile + G < 1024) PV8_LOAD(tile + G);
            __syncthreads();
#pragma unroll
            for (int k = 0; k < 8; ++k) { const int it = tid + 512 * k, c = it >> 6, e = it & 63; ov[(size_t)(c0 + c) * 16384 + e0 + e] = tl[c * 65 + e]; }
            __syncthreads();
        }
#undef PV8_LOAD
    }
}
namespace pg8 {
constexpr int BM = 256, BK = 64, HALF = 128, HTB = HALF * BK * 2, STAGE_BYTES = 8 * HTB, NXCD = 8, WGM = 8;
__host__ __device__ __forceinline__ int lds_byte(int r, int c) { const int st = (r >> 4) * 2 + (c >> 5), rr = r & 15, cc = c & 31, ob = rr * 64 + cc * 2; return st * 1024 + (ob ^ (((ob >> 9) & 1) << 5)); }
__host__ __device__ __forceinline__ void stage_rc(int b, int& R, int& C) { const int st = b / 1024, sb = b % 1024, swz = sb ^ (((sb >> 9) & 1) << 5); R = (st >> 1) * 16 + swz / 64; C = (st & 1) * 32 + (swz % 64) / 2; }
__host__ __device__ __forceinline__ int perm32(int rho) { const int n = rho >> 4, i = rho & 15; return 8 * (i >> 2) + 4 * n + (i & 3); }

struct Unit { int pm, pn, g; };
struct GemmSet { const bf16 *A0, *A1, *Bt0, *Bt1; int K; };

struct StaticOrder {
    int nM, nN0, nN, nwg, G, c;
    __device__ void init(int Mrows, int N0, int N1, int G_, int c_) { nM = Mrows / BM; nN0 = N0 / BM; nN = nN0 + N1 / BM; nwg = nM * nN; G = G_; c = c_; }
    __device__ bool next(int i, Unit& u) const {
        const long L = (long)i * G + c; if (L >= nwg) return false;
        int wgid = (int)L; { const int q = nwg / NXCD, r = nwg % NXCD, xcd = wgid % NXCD, off = wgid / NXCD; wgid = (xcd < r ? xcd * (q + 1) : r * (q + 1) + (xcd - r) * q) + off; }
        const int nig = WGM * nN, gid = wgid / nig, fm = gid * WGM, gsz = (nM - fm) < WGM ? (nM - fm) : WGM;
        u.pm = fm + ((wgid % nig) % gsz); int pn = (wgid % nig) / gsz; u.g = pn >= nN0 ? 1 : 0; u.pn = pn >= nN0 ? pn - nN0 : pn; return true;
    }
};

template <class Epi, class Sched>
__device__ __forceinline__ void gemm_phase(LAS unsigned char* lds, const GemmSet g, const Sched& S, const Epi& E, int wid) {
    const int lane = hw_lane(), tid = wid * 64 + lane, wr = wid >> 2, wc = wid & 3, fr = lane & 15, fq = lane >> 4;
    const int K = g.K, nt = K / BK;
    unsigned voffA[2], voffB[2];
#pragma unroll
    for (int i = 0; i < 2; ++i) { int R, C; stage_rc(tid * 16 + i * 8192, R, C); const int Rb = (R & ~31) + perm32(R & 31);
        voffA[i] = (unsigned)(R * K + C) * 2u; voffB[i] = (unsigned)(Rb * K + C) * 2u; }
    const size_t kstep = (size_t)(BK * 2);
    const size_t hstep = (size_t)HALF * K * 2;
    const size_t tstep = 2 * hstep;
    const unsigned ldsw = (unsigned)wid * 1024u;
    const int aoff = lds_byte(wr * 64 + fr, fq * 8), boff = lds_byte(wc * 32 + fr, fq * 8);
#define PG8_SA(b, h) (((b) * 2 + (h)) * HTB)
#define PG8_SB(b, h) ((4 + (b) * 2 + (h)) * HTB)
#define PG8_STAGE(bufoff, gbase, voff) do { _Pragma("unroll") for (int _i = 0; _i < 2; ++_i) \
        __builtin_amdgcn_global_load_lds((const unsigned*)((const char*)(gbase) + (voff)[_i]), (LAS unsigned*)(lds + (bufoff) + ldsw + _i * 8192), 16, 0, 0); } while (0)
#define PG8_LDA(dst, b, h) do { _Pragma("unroll") for (int m = 0; m < 4; ++m) _Pragma("unroll") for (int k = 0; k < 2; ++k) dst[m][k] = *(const LAS bf16x8*)(lds + PG8_SA(b, h) + aoff + m * 2048 + k * 1024); } while (0)
#define PG8_LDB(dst, b, h) do { _Pragma("unroll") for (int n = 0; n < 2; ++n) _Pragma("unroll") for (int k = 0; k < 2; ++k) dst[n][k] = *(const LAS bf16x8*)(lds + PG8_SB(b, h) + boff + n * 2048 + k * 1024); } while (0)
#define PG8_MMA(ai, bj, At, Bt) do { __builtin_amdgcn_s_setprio(1); _Pragma("unroll") for (int m = 0; m < 4; ++m) _Pragma("unroll") for (int n = 0; n < 2; ++n) _Pragma("unroll") for (int k = 0; k < 2; ++k) \
        acc[ai][bj][m][n] = __builtin_amdgcn_mfma_f32_16x16x32_bf16(Bt[n][k], At[m][k], acc[ai][bj][m][n], 0, 0, 0); __builtin_amdgcn_s_setprio(0); } while (0)
#define PG8_WAIT_V(n) asm volatile("s_waitcnt vmcnt(" #n ")" ::: "memory")
#define PG8_WAIT_L(n) asm volatile("s_waitcnt lgkmcnt(" #n ")" ::: "memory")
#define PG8_BAR __builtin_amdgcn_s_barrier()
#define PG8_SCHED __builtin_amdgcn_sched_barrier(0)
    Unit cur, nxt; int ui = 0;
    if (!S.next(0, cur)) return;
    f32x4 acc[2][2][4][2];
#pragma unroll
    for (int a = 0; a < 2; ++a)
#pragma unroll
        for (int b = 0; b < 2; ++b)
#pragma unroll
            for (int m = 0; m < 4; ++m)
#pragma unroll
                for (int n = 0; n < 2; ++n) acc[a][b][m][n] = (f32x4){0.f, 0.f, 0.f, 0.f};
    bf16x8 At[4][2], B0[2][2], B1[2][2];
    const char* cA = (const char*)(cur.g ? g.A1 : g.A0) + (size_t)cur.pm * tstep; const char* cB = (const char*)(cur.g ? g.Bt1 : g.Bt0) + (size_t)cur.pn * tstep;
    E.unit_begin(cur, 0, tid);
    PG8_STAGE(PG8_SB(0, 0), cB, voffB); PG8_STAGE(PG8_SB(0, 1), cB + hstep, voffB); PG8_STAGE(PG8_SA(0, 0), cA, voffA); PG8_STAGE(PG8_SA(0, 1), cA + hstep, voffA);
    if (wr == 1) PG8_BAR;
    PG8_WAIT_V(2); PG8_BAR;
    PG8_STAGE(PG8_SB(1, 0), cB + kstep, voffB); PG8_STAGE(PG8_SA(1, 0), cA + kstep, voffA); PG8_STAGE(PG8_SB(1, 1), cB + hstep + kstep, voffB);
    PG8_WAIT_V(6); PG8_BAR;
    for (;;) {
        const bool has_next = S.next(ui + 1, nxt);
        const char* nA = has_next ? (const char*)(nxt.g ? g.A1 : g.A0) + (size_t)nxt.pm * tstep : cA; const char* nB = has_next ? (const char*)(nxt.g ? g.Bt1 : g.Bt0) + (size_t)nxt.pn * tstep : cB;
        for (int t = 0; t < nt; t += 2) {
            const bool last = (t == nt - 2);
            const char* a1 = cA + (size_t)(t + 1) * kstep;
            const char* a2 = last ? nA : cA + (size_t)(t + 2) * kstep; const char* b2 = last ? nB : cB + (size_t)(t + 2) * kstep;
            const char* a3 = a2 + kstep; const char* b3 = b2 + kstep;
            if constexpr (Epi::MIDSCALE) { if (t == nt / 2) E.midscale(acc, ui & 1, wr, fr); }
            PG8_LDB(B0, 0, 0); PG8_LDB(B1, 0, 1); PG8_SCHED; PG8_LDA(At, 0, 0); PG8_STAGE(PG8_SA(1, 1), a1 + hstep, voffA);
            PG8_WAIT_V(8); PG8_WAIT_L(0); PG8_BAR; PG8_MMA(0, 0, At, B0); PG8_MMA(0, 1, At, B1); PG8_BAR; PG8_SCHED;
            PG8_LDA(At, 0, 1); PG8_STAGE(PG8_SB(0, 0), b2, voffB); PG8_STAGE(PG8_SB(0, 1), b2 + hstep, voffB); PG8_STAGE(PG8_SA(0, 0), a2, voffA);
            PG8_WAIT_V(8); PG8_WAIT_L(0); PG8_BAR; PG8_MMA(1, 0, At, B0); PG8_MMA(1, 1, At, B1); PG8_BAR; PG8_SCHED;
            PG8_LDB(B0, 1, 0); PG8_LDB(B1, 1, 1); PG8_SCHED; PG8_LDA(At, 1, 0); PG8_STAGE(PG8_SA(0, 1), a2 + hstep, voffA);
            PG8_WAIT_V(8); PG8_WAIT_L(0); PG8_BAR; PG8_MMA(0, 0, At, B0); PG8_MMA(0, 1, At, B1); PG8_BAR; PG8_SCHED;
            PG8_LDA(At, 1, 1); PG8_STAGE(PG8_SB(1, 0), b3, voffB); PG8_STAGE(PG8_SB(1, 1), b3 + hstep, voffB); PG8_STAGE(PG8_SA(1, 0), a3, voffA);
            PG8_WAIT_V(8); PG8_WAIT_L(0); PG8_BAR; PG8_MMA(1, 0, At, B0); PG8_MMA(1, 1, At, B1); PG8_BAR; PG8_SCHED;
        }
        if (wr == 0) PG8_BAR;
        E(acc, cur, ui & 1, wr, wc, fr, fq);
        if (!has_next) break;
#pragma unroll
        for (int a = 0; a < 2; ++a)
#pragma unroll
            for (int b = 0; b < 2; ++b)
#pragma unroll
                for (int m = 0; m < 4; ++m)
#pragma unroll
                    for (int n = 0; n < 2; ++n) acc[a][b][m][n] = (f32x4){0.f, 0.f, 0.f, 0.f};
        cur = nxt; cA = nA; cB = nB; ++ui;
        E.unit_begin(cur, ui & 1, tid);
        if (wr == 1) PG8_BAR;
    }
    PG8_WAIT_V(0);
    PG8_BAR;
#undef PG8_SA
#undef PG8_SB
#undef PG8_STAGE
#undef PG8_LDA
#undef PG8_LDB
#undef PG8_MMA
#undef PG8_WAIT_V
#undef PG8_WAIT_L
#undef PG8_BAR
#undef PG8_SCHED
}
}
namespace pg8 {
__device__ __forceinline__ v4u pack8(const f32x4& v0, const f32x4& v1) { v4u w; w.x = pk2(v0[0], v0[1]); w.y = pk2(v0[2], v0[3]); w.z = pk2(v1[0], v1[1]); w.w = pk2(v1[2], v1[3]); return w; }
__device__ __forceinline__ float sq8(const f32x4& v0, const f32x4& v1) { return (v0[0] * v0[0] + v0[1] * v0[1]) + (v0[2] * v0[2] + v0[3] * v0[3]) + (v1[0] * v1[0] + v1[1] * v1[1]) + (v1[2] * v1[2] + v1[3] * v1[3]); }

struct Epi1 {
    static constexpr bool MIDSCALE = false;
    bf16 *QKV, *CQ, *CKV; float *SSQCQ, *SSQCKV;
    __device__ __forceinline__ void midscale(f32x4 (&)[2][2][4][2], int, int, int) const {}
    __device__ __forceinline__ void unit_begin(const Unit&, int, int) const {}
    __device__ __forceinline__ void operator()(const f32x4 (&acc)[2][2][4][2], const Unit& u, int par, int wr, int wc, int fr, int fq) const {
        const int pn = u.pn; bf16* base; int ldc, colt; float sc = 1.f; float* ssq = nullptr; int sslot = 0;
        if (pn < 12) { base = QKV; ldc = 3072; colt = pn * 256; if (pn < 4) sc = QSCALE_DIL; }
        else if (pn < 14) { base = CQ; ldc = 512; colt = (pn - 12) * 256; ssq = SSQCQ; sslot = (pn - 12) * 4 + wc; }
        else { base = CKV; ldc = 512; colt = (pn - 14) * 256; ssq = SSQCKV; sslot = (pn - 14) * 4 + wc; }
        const int row0 = u.pm * BM + wr * 64 + fr, col0 = colt + wc * 32 + 8 * fq;
#pragma unroll
        for (int ai = 0; ai < 2; ++ai)
#pragma unroll
            for (int m = 0; m < 4; ++m) { const int row = row0 + ai * HALF + m * 16; bf16* rowp = base + (size_t)row * ldc + col0; float ss = 0.f;
#pragma unroll
                for (int bj = 0; bj < 2; ++bj) { const f32x4 v0 = acc[ai][bj][m][0] * sc, v1 = acc[ai][bj][m][1] * sc; ss += sq8(v0, v1); *(v4u*)(rowp + bj * HALF) = pack8(v0, v1); }
                if (ssq) { ss += __shfl_xor(ss, 16); ss += __shfl_xor(ss, 32); if (fq == 0) ssq[(size_t)row * 8 + sslot] = ss; } }
    }
};

struct Epi2 {
    static constexpr bool MIDSCALE = false;
    bf16 *QN, *QPE, *KN, *VM; const float *SSQCQ, *SSQCKV; const f32x2* ROPE;
    __device__ __forceinline__ void midscale(f32x4 (&)[2][2][4][2], int, int, int) const {}
    __device__ __forceinline__ void unit_begin(const Unit&, int, int) const {}
    __device__ __forceinline__ void operator()(const f32x4 (&acc)[2][2][4][2], const Unit& u, int par, int wr, int wc, int fr, int fq) const {
        const int pn = u.pn; bf16* base; int ldc, colt; float sc = 1.f; bool rope = false; const float* ssq;
        if (u.g == 0) { ssq = SSQCQ; sc = QSCALE_MLA; if (pn < 4) { base = QN; ldc = 1024; colt = pn * 256; } else { base = QPE; ldc = 512; colt = (pn - 4) * 256; rope = true; } }
        else { ssq = SSQCKV; if (pn < 4) { base = KN; ldc = 1024; colt = pn * 256; } else { base = VM; ldc = 1024; colt = (pn - 4) * 256; } }
        const int row0 = u.pm * BM + wr * 64 + fr, col0 = colt + wc * 32 + 8 * fq;
#pragma unroll
        for (int ai = 0; ai < 2; ++ai)
#pragma unroll
            for (int m = 0; m < 4; ++m) { const int row = row0 + ai * HALF + m * 16; bf16* rowp = base + (size_t)row * ldc + col0;
                const f32x4 p0 = *(const f32x4*)(ssq + (size_t)row * 8), p1 = *(const f32x4*)(ssq + (size_t)row * 8 + 4);
                const float rs = rsqrtf(((p0[0] + p0[1]) + (p0[2] + p0[3]) + (p1[0] + p1[1]) + (p1[2] + p1[3])) * (1.f / 512.f) + EPS) * sc;
#pragma unroll
                for (int bj = 0; bj < 2; ++bj) { f32x4 v0 = acc[ai][bj][m][0] * rs, v1 = acc[ai][bj][m][1] * rs;
                    if (rope) { const int j0 = ((col0 + bj * HALF) & 63) >> 1; const f32x4* rp = (const f32x4*)(ROPE + (size_t)(row & (SEQ - 1)) * 32 + j0);
                        const f32x4 r0 = rp[0], r1 = rp[1];
                        f32x4 w0, w1;
                        w0[0] = v0[0] * r0[0] - v0[1] * r0[1]; w0[1] = v0[0] * r0[1] + v0[1] * r0[0];
                        w0[2] = v0[2] * r0[2] - v0[3] * r0[3]; w0[3] = v0[2] * r0[3] + v0[3] * r0[2];
                        w1[0] = v1[0] * r1[0] - v1[1] * r1[1]; w1[1] = v1[0] * r1[1] + v1[1] * r1[0];
                        w1[2] = v1[2] * r1[2] - v1[3] * r1[3]; w1[3] = v1[2] * r1[3] + v1[3] * r1[2];
                        v0 = w0; v1 = w1; }
                    *(v4u*)(rowp + bj * HALF) = pack8(v0, v1); } }
    }
};

struct Epi3 {
    static constexpr bool MIDSCALE = true;
    bf16* H1B; const float* X; const float* SSQO; float* SSQH; LAS f32x2* RS;
    __device__ __forceinline__ void unit_begin(const Unit& u, int par, int tid) const {
        if (tid < 256) { const f32x4* p = (const f32x4*)(SSQO + (size_t)(u.pm * BM + tid) * 16); const f32x4 a0 = p[0], a1 = p[1], b0 = p[2], b1 = p[3];
            const float ra = rsqrtf(((a0[0] + a0[1]) + (a0[2] + a0[3]) + (a1[0] + a1[1]) + (a1[2] + a1[3])) * (1.f / 1024.f) + EPS);
            const float rb = rsqrtf(((b0[0] + b0[1]) + (b0[2] + b0[3]) + (b1[0] + b1[1]) + (b1[2] + b1[3])) * (1.f / 1024.f) + EPS);
            f32x2 v; v.x = ra / rb; v.y = rb; RS[par * 256 + tid] = v; }
    }
    __device__ __forceinline__ void midscale(f32x4 (&acc)[2][2][4][2], int par, int wr, int fr) const {
#pragma unroll
        for (int ai = 0; ai < 2; ++ai)
#pragma unroll
            for (int m = 0; m < 4; ++m) { const float f = RS[par * 256 + ai * HALF + wr * 64 + m * 16 + fr].x;
#pragma unroll
                for (int bj = 0; bj < 2; ++bj) { acc[ai][bj][m][0] = acc[ai][bj][m][0] * f; acc[ai][bj][m][1] = acc[ai][bj][m][1] * f; } }
    }
    __device__ __forceinline__ void operator()(const f32x4 (&acc)[2][2][4][2], const Unit& u, int par, int wr, int wc, int fr, int fq) const {
        const int row0 = u.pm * BM + wr * 64 + fr, col0 = u.pn * BM + wc * 32 + 8 * fq, sslot = u.pn * 4 + wc;
#pragma unroll
        for (int ai = 0; ai < 2; ++ai)
#pragma unroll
            for (int m = 0; m < 4; ++m) { const int row = row0 + ai * HALF + m * 16; const float rb = RS[par * 256 + ai * HALF + wr * 64 + m * 16 + fr].y; float ss = 0.f;
#pragma unroll
                for (int bj = 0; bj < 2; ++bj) { const float* xp = X + (size_t)row * DM + col0 + bj * HALF; const f32x4 x0 = *(const f32x4*)xp, x1 = *(const f32x4*)(xp + 4);
                    const f32x4 v0 = acc[ai][bj][m][0] * rb + x0, v1 = acc[ai][bj][m][1] * rb + x1; ss += sq8(v0, v1);
                    *(v4u*)(H1B + (size_t)row * DM + col0 + bj * HALF) = pack8(v0, v1); }
                ss += __shfl_xor(ss, 16); ss += __shfl_xor(ss, 32); if (fq == 0) SSQH[(size_t)row * 32 + sslot] = ss; }
    }
};

struct Epi4 {
    static constexpr bool MIDSCALE = false;
    bf16* QP;
    __device__ __forceinline__ void midscale(f32x4 (&)[2][2][4][2], int, int, int) const {}
    __device__ __forceinline__ void unit_begin(const Unit&, int, int) const {}
    __device__ __forceinline__ void operator()(const f32x4 (&acc)[2][2][4][2], const Unit& u, int par, int wr, int wc, int fr, int fq) const {
        const int row0 = u.pm * BM + wr * 64 + fr, col0 = u.pn * BM + wc * 32 + 8 * fq;
#pragma unroll
        for (int ai = 0; ai < 2; ++ai)
#pragma unroll
            for (int m = 0; m < 4; ++m) { const int row = row0 + ai * HALF + m * 16;
#pragma unroll
                for (int bj = 0; bj < 2; ++bj) *(v4u*)(QP + (size_t)row * DM + col0 + bj * HALF) = pack8(acc[ai][bj][m][0], acc[ai][bj][m][1]); }
    }
};
struct EpiNull {
    static constexpr bool MIDSCALE = false;
    __device__ __forceinline__ void midscale(f32x4 (&)[2][2][4][2], int, int, int) const {}
    __device__ __forceinline__ void unit_begin(const Unit&, int, int) const {}
    __device__ __forceinline__ void operator()(const f32x4 (&acc)[2][2][4][2], const Unit& u, int par, int wr, int wc, int fr, int fq) const {
#pragma unroll
        for (int ai = 0; ai < 2; ++ai)
#pragma unroll
            for (int bj = 0; bj < 2; ++bj)
#pragma unroll
                for (int m = 0; m < 4; ++m)
#pragma unroll
                    for (int n = 0; n < 2; ++n) asm volatile("" :: "v"(acc[ai][bj][m][n]));
    }
};
}

__device__ __forceinline__ void kr_item64(const bf16* __restrict__ XN, const bf16* __restrict__ BT, const f32x2* __restrict__ ROPE, bf16* __restrict__ KPE, LAS f32x4* red, int item, int wave, int lane) {
    const int fr = lane & 15, fq = lane >> 4, rg = wave & 3, kh = wave >> 2, row = item * 64 + rg * 16 + fr;
    const bf16* ap = XN + (size_t)row * 2048 + kh * 1024 + fq * 8; const bf16* bp = BT + (size_t)fr * 2048 + kh * 1024 + fq * 8;
    f32x4 acc[4];
#pragma unroll
    for (int nb = 0; nb < 4; ++nb) acc[nb] = (f32x4){0.f, 0.f, 0.f, 0.f};
#pragma unroll 4
    for (int k0 = 0; k0 < 1024; k0 += 32) {
        const bf16x8 a = *(const bf16x8*)(ap + k0);
#pragma unroll
        for (int nb = 0; nb < 4; ++nb) { const bf16x8 b = *(const bf16x8*)(bp + (size_t)nb * 16 * 2048 + k0); acc[nb] = __builtin_amdgcn_mfma_f32_16x16x32_bf16(b, a, acc[nb], 0, 0, 0); }
    }
    if (kh == 1) {
#pragma unroll
        for (int nb = 0; nb < 4; ++nb) red[(rg * 4 + nb) * 64 + lane] = acc[nb];
    }
    __syncthreads();
    if (kh == 0) {
        const int pos = row & (SEQ - 1);
#pragma unroll
        for (int nb = 0; nb < 4; ++nb) { const int j0 = 8 * nb + 2 * fq; const f32x4 r = *(const f32x4*)(ROPE + (size_t)pos * 32 + j0); const f32x4 v = acc[nb] + red[(rg * 4 + nb) * 64 + lane];
            v2u o; o.x = pk2(v[0] * r[0] - v[1] * r[1], v[0] * r[1] + v[1] * r[0]); o.y = pk2(v[2] * r[2] - v[3] * r[3], v[2] * r[3] + v[3] * r[2]);
            *(v2u*)(KPE + (size_t)row * 64 + 16 * nb + 4 * fq) = o; }
    }
    __syncthreads();
}
namespace att {
typedef short v4i16_t __attribute__((ext_vector_type(4)));
#define MFMA32(a, b, c) __builtin_amdgcn_mfma_f32_32x32x16_bf16((a), (b), (c), 0, 0, 0)
__device__ __forceinline__ s16x4 vtr(const LAS unsigned char* p) { return __builtin_bit_cast(s16x4, __builtin_amdgcn_ds_read_tr16_b64_v4i16((LAS v4i16_t*)p)); }
__device__ __forceinline__ int crow(int r, int hi) { return (r & 3) + 8 * (r >> 2) + 4 * hi; }
constexpr int VS = 320;
constexpr int KS = 400;
constexpr float NEG = -1e30f;

__device__ __forceinline__ bf16x8 pack8r(const f32x16& p, int s) {
    v4u w; w.x = pk2(p[8 * s + 0], p[8 * s + 1]); w.y = pk2(p[8 * s + 2], p[8 * s + 3]); w.z = pk2(p[8 * s + 4], p[8 * s + 5]); w.w = pk2(p[8 * s + 6], p[8 * s + 7]);
    return __builtin_bit_cast(bf16x8, w);
}
__device__ __forceinline__ void pv32(f32x16 (&o)[4], const LAS unsigned char* vb, const bf16x8 pb0, const bf16x8 pb1) {
#pragma unroll
    for (int d = 0; d < 4; ++d) {
        const s16x4 l0 = vtr(vb + d * 64), h0 = vtr(vb + d * 64 + 8 * VS), l1 = vtr(vb + d * 64 + 16 * VS), h1 = vtr(vb + d * 64 + 24 * VS);
        const bf16x8 a0 = __builtin_shufflevector(l0, h0, 0, 1, 2, 3, 4, 5, 6, 7), a1 = __builtin_shufflevector(l1, h1, 0, 1, 2, 3, 4, 5, 6, 7);
        o[d] = MFMA32(a0, pb0, o[d]); o[d] = MFMA32(a1, pb1, o[d]);
    }
}
template <int NS>
__device__ __forceinline__ void softmax_step(f32x16 (&s)[NS], float& m, float& l, f32x16 (&o)[4], bf16x8 (&pb)[2 * NS]) {
    float mx = s[0][0];
#pragma unroll
    for (int t = 0; t < NS; ++t)
#pragma unroll
        for (int r = 0; r < 16; ++r) mx = fmaxf(mx, s[t][r]);
    mx = fmaxf(mx, __shfl_xor(mx, 32));
    const float mn = fmaxf(m, mx), alpha = __builtin_amdgcn_exp2f(m - mn); m = mn;
    float ps = 0.f;
#pragma unroll
    for (int t = 0; t < NS; ++t)
#pragma unroll
        for (int r = 0; r < 16; ++r) { const float p = __builtin_amdgcn_exp2f(s[t][r] - mn); s[t][r] = p; ps += p; }
    l = l * alpha + ps;
    if (!__all(alpha == 1.0f)) {
#pragma unroll
        for (int d = 0; d < 4; ++d) o[d] = o[d] * alpha;
    }
#pragma unroll
    for (int t = 0; t < NS; ++t) { pb[2 * t] = pack8r(s[t], 0); pb[2 * t + 1] = pack8r(s[t], 1); }
}
__device__ __forceinline__ void store_o(f32x16 (&o)[4], float l, bf16* __restrict__ orow  , float* __restrict__ ssq  , int hh) {
    l += __shfl_xor(l, 32);
    const float inv = 1.0f / l; float ss = 0.f;
#pragma unroll
    for (int d = 0; d < 4; ++d) { o[d] = o[d] * inv;
#pragma unroll
        for (int g = 0; g < 4; ++g) { const float a = o[d][4 * g], b = o[d][4 * g + 1], c = o[d][4 * g + 2], e = o[d][4 * g + 3];
            ss += (a * a + b * b) + (c * c + e * e);
            v2u w; w.x = pk2(a, b); w.y = pk2(c, e); *(v2u*)(orow + 32 * d + 8 * g + 4 * hh) = w; } }
    ss += __shfl_xor(ss, 32);
    if (hh == 0) *ssq = ss;
}

constexpr int KTB = 64 * KS, VTB = 64 * VS, BUFB = KTB + VTB;
__device__ __forceinline__ void mla_unit(const unsigned char* ws, LAS unsigned char* lds, int b, int h, int qblk, int tid, int wave, int lane) {
    const bf16* QN = (const bf16*)(ws + WS_QN); const bf16* QPE = (const bf16*)(ws + WS_QPE);
    bf16* O = (bf16*)(ws + WS_A); float* SSQO = (float*)(ws + WS_SSQO);
    const int r32 = lane & 31, hh = lane >> 5;
    const size_t tok0 = (size_t)b * SEQ;
    const int row_lo = qblk * 256 + wave * 32, qrow = row_lo + r32;
    bf16x8 qf[12];
    { const bf16* qn = QN + (tok0 + qrow) * 1024 + h * 128 + 8 * hh;
#pragma unroll
      for (int s = 0; s < 8; ++s) qf[s] = *(const bf16x8*)(qn + 16 * s);
      const bf16* qp = QPE + (tok0 + qrow) * 512 + h * 64 + 8 * hh;
#pragma unroll
      for (int s = 0; s < 4; ++s) qf[8 + s] = *(const bf16x8*)(qp + 16 * s); }
    const int c0 = tid, c1 = tid + 512;
    const unsigned okn0 = (unsigned)WS_KN + (unsigned)(((unsigned)tok0 + (c0 >> 4)) * 1024u + h * 128 + (c0 & 15) * 8) * 2u, okn1 = okn0 + 32u * 1024u * 2u;
    const unsigned okp = (unsigned)WS_KPE + (unsigned)(((unsigned)tok0 + (tid >> 3)) * 64u + (tid & 7) * 8) * 2u;
    const unsigned ov0 = okn0 + (unsigned)(WS_VM - WS_KN), ov1 = ov0 + 32u * 1024u * 2u;
    const int lkn0 = (c0 >> 4) * KS + (c0 & 15) * 16, lkn1 = (c1 >> 4) * KS + (c1 & 15) * 16, lkp = (tid >> 3) * KS + 256 + (tid & 7) * 16;
    const int lv0 = KTB + (c0 >> 4) * VS + (c0 & 15) * 16, lv1 = KTB + (c1 >> 4) * VS + (c1 & 15) * 16;
    v4u st0, st1, st2, st3, st4;
#define MLA_GLOAD(kt) do { const unsigned _o = (unsigned)(kt) * 131072u, _p = (unsigned)(kt) * 8192u; st0 = *(const v4u*)(ws + (size_t)(okn0 + _o)); st1 = *(const v4u*)(ws + (size_t)(okn1 + _o)); \
        st2 = *(const v4u*)(ws + (size_t)(okp + _p)); st3 = *(const v4u*)(ws + (size_t)(ov0 + _o)); st4 = *(const v4u*)(ws + (size_t)(ov1 + _o)); } while (0)
#define MLA_LWRITE(buf) do { LAS unsigned char* _b = lds + (buf) * BUFB; *(LAS v4u*)(_b + lkn0) = st0; *(LAS v4u*)(_b + lkn1) = st1; *(LAS v4u*)(_b + lkp) = st2; \
        *(LAS v4u*)(_b + lv0) = st3; *(LAS v4u*)(_b + lv1) = st4; } while (0)
    const int nkt = 4 * (qblk + 1);
    MLA_GLOAD(0); MLA_LWRITE(0);
    __syncthreads();
    f32x16 o[4];
#pragma unroll
    for (int d = 0; d < 4; ++d)
#pragma unroll
        for (int r = 0; r < 16; ++r) o[d][r] = 0.f;
    float m = NEG, l = 0.f;
    const int kread = r32 * KS + 16 * hh;
    const int vread = KTB + (4 * hh + ((lane & 15) >> 2)) * VS + (16 * ((lane >> 4) & 1) + 4 * (lane & 3)) * 2;
    for (int kt = 0; kt < nkt; ++kt) {
        if (kt + 1 < nkt) MLA_GLOAD(kt + 1);
        const int k0 = kt * 64;
        if (k0 <= row_lo + 31) {
            const LAS unsigned char* kb = lds + (kt & 1) * BUFB;
            const bool diag = (k0 + 63 > row_lo);
#pragma unroll
            for (int sub = 0; sub < 2; ++sub) {
                if (sub == 1 && k0 + 32 > row_lo + 31) break;
                f32x16 s[1];
#pragma unroll
                for (int r = 0; r < 16; ++r) s[0][r] = 0.f;
#pragma unroll
                for (int ks = 0; ks < 12; ++ks) { const bf16x8 kf = *(const LAS bf16x8*)(kb + kread + sub * 32 * KS + 32 * ks); s[0] = MFMA32(kf, qf[ks], s[0]); }
                if (diag) {
#pragma unroll
                    for (int r = 0; r < 16; ++r) { const int key = k0 + 32 * sub + crow(r, hh); if (key > qrow) s[0][r] = NEG; }
                }
                bf16x8 pb[2];
                softmax_step<1>(s, m, l, o, pb);
                pv32(o, kb + vread + sub * 32 * VS, pb[0], pb[1]);
            }
        }
        if (kt + 1 < nkt) MLA_LWRITE((kt + 1) & 1);
        __syncthreads();
    }
#undef MLA_GLOAD
#undef MLA_LWRITE
    store_o(o, l, O + (tok0 + qrow) * 2048 + 1024 + h * 128, SSQO + (tok0 + qrow) * 16 + 8 + h, hh);
}

constexpr int DKS = 272, DSH = 32 * DKS + 32 * VS;
__device__ __forceinline__ void dil_tile(const unsigned char* ws, LAS unsigned char* vl  , LAS unsigned char* sh  , int b, int h, int j, int r16, int tid, int lane) {
    const bf16* QKV = (const bf16*)(ws + WS_B);
    const int r32 = lane & 31, hh = lane >> 5;
    const size_t tok0 = (size_t)b * SEQ;
    const int tq = 512 * j + 16 * r32 + r16;
    bf16x8 qf[8];
    { const bf16* qp = QKV + (tok0 + tq) * 3072 + h * 128 + 8 * hh;
#pragma unroll
      for (int s = 0; s < 8; ++s) qf[s] = *(const bf16x8*)(qp + 16 * s); }
    const float slope2 = __builtin_amdgcn_exp2f(-(float)(h + 1)) * LOG2E;
    const int m0 = (j == 0) ? 4 : 0, n3 = j + 1, n2 = 8 - m0, n1 = 20 - m0, nt = n3 + n2;
    const unsigned kcol = (unsigned)WS_B + ((unsigned)tok0 * 3072u + 1024u + h * 128 + 8 * hh) * 2u;
    const unsigned vcol = (unsigned)WS_B + ((unsigned)tok0 * 3072u + 2048u + h * 128 + (lane & 15) * 8) * 2u;
    const int vrow = lane >> 4;
    const int vwr = vrow * VS + (lane & 15) * 16;
    const int vread = (4 * hh + ((lane & 15) >> 2)) * VS + (16 * ((lane >> 4) & 1) + 4 * (lane & 3)) * 2;
    int kbase, kstride, maxd;
#define DIL_DESC(idx) do { const int _i = (idx); if (_i < n3) { kbase = 512 * (j - _i) + r16; kstride = 16; maxd = 2048; } \
        else if (_i < n3 + n2) { kbase = 4 * (128 * j - 128 + 32 * (m0 + _i - n3)) + (r16 & 3); kstride = 4; maxd = 512; } \
        else { kbase = 512 * j - 128 + 32 * (m0 + _i - n3 - n2); kstride = 1; maxd = 128; } } while (0)
    bf16x8 kc[8]; v4u vn[8];
    DIL_DESC(0);
    { const unsigned kp = kcol + (unsigned)(kbase + kstride * r32) * 6144u;
#pragma unroll
      for (int s = 0; s < 8; ++s) kc[s] = *(const bf16x8*)(ws + (size_t)(kp + 32 * s));
#pragma unroll
      for (int i = 0; i < 8; ++i) vn[i] = *(const v4u*)(ws + (size_t)(vcol + (unsigned)(kbase + kstride * (4 * i + vrow)) * 6144u));
#pragma unroll
      for (int i = 0; i < 8; ++i) *(LAS v4u*)(vl + vwr + 4 * i * VS) = vn[i]; }
    f32x16 o[4];
#pragma unroll
    for (int d = 0; d < 4; ++d)
#pragma unroll
        for (int r = 0; r < 16; ++r) o[d][r] = 0.f;
    float m = NEG, l = 0.f;
    for (int idx = 0; idx < nt; ++idx) {
        const int cb = kbase, cs = kstride, cm = maxd;
        const bool more = idx + 1 < nt;
        if (more) {
            DIL_DESC(idx + 1);
#pragma unroll
            for (int i = 0; i < 8; ++i) vn[i] = *(const v4u*)(ws + (size_t)(vcol + (unsigned)(kbase + kstride * (4 * i + vrow)) * 6144u));
        }
        f32x16 s[1];
#pragma unroll
        for (int r = 0; r < 16; ++r) s[0][r] = 0.f;
#pragma unroll
        for (int ks = 0; ks < 8; ++ks) s[0] = MFMA32(kc[ks], qf[ks], s[0]);
        if (more) {
            const unsigned kp = kcol + (unsigned)(kbase + kstride * r32) * 6144u;
#pragma unroll
            for (int s2 = 0; s2 < 8; ++s2) kc[s2] = *(const bf16x8*)(ws + (size_t)(kp + 32 * s2));
        }
        const int d0 = tq - cb - cs * 4 * hh;
#pragma unroll
        for (int r = 0; r < 16; ++r) { const int dist = d0 - cs * ((r & 3) + 8 * (r >> 2)); const float v = s[0][r] - slope2 * (float)dist; s[0][r] = ((unsigned)dist <= (unsigned)cm) ? v : NEG; }
        bf16x8 pb[2];
        softmax_step<1>(s, m, l, o, pb);
        pv32(o, vl + vread, pb[0], pb[1]);
        if (more) {
#pragma unroll
            for (int i = 0; i < 8; ++i) *(LAS v4u*)(vl + vwr + 4 * i * VS) = vn[i];
        }
    }
#undef DIL_DESC
    {
        const int kb0 = 512 * j - 128 + 32 * m0;
        const int row = tid >> 4, ch = tid & 15;
        const unsigned gk = (unsigned)WS_B + (((unsigned)tok0 + kb0 + row) * 3072u + 1024u + h * 128 + ch * 8) * 2u;
        const int lk = row * DKS + ch * 16, lv = 32 * DKS + row * VS + ch * 16;
        const int kread = r32 * DKS + 16 * hh;
        const int vread1 = 32 * DKS + (4 * hh + ((lane & 15) >> 2)) * VS + (16 * ((lane >> 4) & 1) + 4 * (lane & 3)) * 2;
        v4u sk = *(const v4u*)(ws + (size_t)gk), sv = *(const v4u*)(ws + (size_t)(gk + 2048u));
        *(LAS v4u*)(sh + lk) = sk; *(LAS v4u*)(sh + lv) = sv;
        __syncthreads();
        for (int mi = 0; mi < n1; ++mi) {
            const bool more = mi + 1 < n1;
            if (more) { const unsigned g2 = gk + (unsigned)(mi + 1) * 32u * 6144u; sk = *(const v4u*)(ws + (size_t)g2); sv = *(const v4u*)(ws + (size_t)(g2 + 2048u)); }
            const LAS unsigned char* tb = sh + (mi & 1) * DSH;
            f32x16 s[1];
#pragma unroll
            for (int r = 0; r < 16; ++r) s[0][r] = 0.f;
#pragma unroll
            for (int ks = 0; ks < 8; ++ks) { const bf16x8 kf = *(const LAS bf16x8*)(tb + kread + 32 * ks); s[0] = MFMA32(kf, qf[ks], s[0]); }
            const int d0 = tq - (kb0 + 32 * mi) - 4 * hh;
#pragma unroll
            for (int r = 0; r < 16; ++r) { const int dist = d0 - ((r & 3) + 8 * (r >> 2)); const float v = s[0][r] - slope2 * (float)dist; s[0][r] = ((unsigned)dist <= 128u) ? v : NEG; }
            bf16x8 pb[2];
            softmax_step<1>(s, m, l, o, pb);
            pv32(o, tb + vread1, pb[0], pb[1]);
            if (more) { LAS unsigned char* nb = sh + ((mi + 1) & 1) * DSH; *(LAS v4u*)(nb + lk) = sk; *(LAS v4u*)(nb + lv) = sv; }
            __syncthreads();
        }
    }
    store_o(o, l, (bf16*)(const_cast<unsigned char*>(ws) + WS_A) + (tok0 + tq) * 2048 + h * 128, (float*)(const_cast<unsigned char*>(ws) + WS_SSQO) + (tok0 + tq) * 16 + h, hh);
}

__device__ __forceinline__ void phase_attn(const Params& P, LAS unsigned char* lds, int vcu, int G, int wave) {
    const int lane = hw_lane(), tid = wave * 64 + lane;
    const unsigned char* ws = P.ws;
#ifndef REP_MLA
#define REP_MLA 1
#endif
#ifndef REP_DIL
#define REP_DIL 1
#endif
    for (int rm_ = 0; rm_ < REP_MLA; ++rm_)
    for (int u = vcu; u < 256; u += G) { const int bh = u >> 2, pr = u & 3;
        mla_unit(ws, lds, bh >> 3, bh & 7, 7 - pr, tid, wave, lane);
        mla_unit(ws, lds, bh >> 3, bh & 7, pr, tid, wave, lane); }
    __syncthreads();
    LAS unsigned char* vl = lds + wave * (32 * VS); LAS unsigned char* sh = lds + NWAVES * (32 * VS);
    for (int rd_ = 0; rd_ < REP_DIL; ++rd_)
    if (G == 256) {
#pragma unroll 1
        for (int k = 0; k < 2; ++k) { const int t = (vcu >> 5) * 512 + k * 256 + (vcu & 31) * 8 + wave; const int bh = t >> 6, rem = t & 63, jj = rem >> 4, r16 = rem & 15;
            dil_tile(ws, vl, sh, bh >> 3, bh & 7, k == 0 ? jj : 3 - jj, r16, tid, lane); }
    } else {
#pragma unroll 1
        for (int t = vcu * 8 + wave; t < 4096; t += G * 8) { const int bh = t >> 6, rem = t & 63; dil_tile(ws, vl, sh, bh >> 3, bh & 7, rem >> 4, rem & 15, tid, lane); }
    }
}
}
namespace peer {
typedef __bf16 bf2_t __attribute__((ext_vector_type(2)));
#define MFMA32(a, b, c) __builtin_amdgcn_mfma_f32_32x32x16_bf16((a), (b), (c), 0, 0, 0)
__device__ __forceinline__ float fmax3(float a, float b, float c) { return fmaxf(fmaxf(a, b), c); }
__device__ __forceinline__ float asf(unsigned u) { return __builtin_bit_cast(float, u); }
__device__ __forceinline__ unsigned asu(float f) { return __builtin_bit_cast(unsigned, f); }

__device__ __forceinline__ void route_item(const unsigned char* ws, LAS unsigned* sc, int tile, int h, int lane) {
    const bf16* QP = (const bf16*)(ws + WS_QP); const bf16* SK = (const bf16*)(ws + WS_SK);
    int* RIDX = (int*)(ws + WS_RIDX); float* RGATE = (float*)(ws + WS_RGATE);
    const int r32 = lane & 31, hh = lane >> 5;
    const size_t tok = (size_t)tile * 32 + r32;
    float rs2; { const f32x4* sp = (const f32x4*)((const float*)(ws + WS_SSQH) + tok * 32); f32x4 a = sp[0];
#pragma unroll
        for (int i = 1; i < 8; ++i) a = a + sp[i];
        rs2 = rsqrtf(((a[0] + a[1]) + (a[2] + a[3])) * (1.f / 2048.f) + EPS); }
#pragma unroll 1
    for (int p = 0; p < 2; ++p) {
        f32x16 s[4];
#pragma unroll
        for (int kb = 0; kb < 4; ++kb)
#pragma unroll
            for (int r = 0; r < 16; ++r) s[kb][r] = 0.f;
        const bf16* qp = QP + tok * 2048 + h * 256 + p * 128 + 8 * hh;
        const bf16* kp = SK + ((size_t)(h * 2 + p) * 128 + r32) * 128 + 8 * hh;
#pragma unroll
        for (int ks = 0; ks < 8; ++ks) { const bf16x8 q = *(const bf16x8*)(qp + 16 * ks);
#pragma unroll
            for (int kb = 0; kb < 4; ++kb) { const bf16x8 k = *(const bf16x8*)(kp + (size_t)kb * 32 * 128 + 16 * ks); s[kb] = MFMA32(k, q, s[kb]); } }
#pragma unroll
        for (int kb = 0; kb < 4; ++kb)
#pragma unroll
            for (int r = 0; r < 16; ++r) s[kb][r] = asf((asu(s[kb][r] * rs2) & ~127u) | (unsigned)(32 * kb + (r & 3) + 8 * (r >> 2) + 4 * hh));
#pragma unroll 1
        for (int k = 0; k < 16; ++k) {
            float mx = s[0][0];
#pragma unroll
            for (int kb = 0; kb < 4; ++kb)
#pragma unroll
                for (int r = 0; r < 16; r += 2) mx = fmax3(mx, s[kb][r], s[kb][r + 1]);
            mx = fmaxf(mx, __shfl_xor(mx, 32));
            if (hh == 0) sc[(p * 32 + r32) * 16 + k] = asu(mx);
#pragma unroll
            for (int kb = 0; kb < 4; ++kb)
#pragma unroll
                for (int r = 0; r < 16; ++r) s[kb][r] = (s[kb][r] == mx) ? -3.0e38f : s[kb][r];
        }
    }
    unsigned t1[16], t2[16];
#pragma unroll
    for (int i = 0; i < 16; i += 4) { const v4u a = *(const LAS v4u*)(sc + r32 * 16 + i), b = *(const LAS v4u*)(sc + (32 + r32) * 16 + i);
        t1[i] = a.x; t1[i + 1] = a.y; t1[i + 2] = a.z; t1[i + 3] = a.w; t2[i] = b.x; t2[i + 1] = b.y; t2[i + 2] = b.z; t2[i + 3] = b.w; }
    float c[50]; int n = 0;
#pragma unroll
    for (int i = 0; i < 16; ++i)
#pragma unroll
        for (int j = 0; j < 16; ++j) if ((i + 1) * (j + 1) <= 16) { const float v = asf(t1[i] & ~127u) + asf(t2[j] & ~127u); c[n] = asf((asu(v) & ~255u) | (unsigned)(i * 16 + j)); ++n; }
    float best[8]; float bmax = 0.f, esum = 0.f;
#pragma unroll
    for (int k = 0; k < 16; ++k) {
        float mx = c[0];
#pragma unroll
        for (int q = 1; q < 49; q += 2) mx = fmax3(mx, c[q], c[q + 1]);
        mx = fmaxf(mx, c[49]);
#pragma unroll
        for (int q = 0; q < 50; ++q) c[q] = (c[q] == mx) ? -3.0e38f : c[q];
        const float val = asf(asu(mx) & ~255u);
        if (k == 0) bmax = val;
        esum += __expf(val - bmax);
        if ((k >> 3) == hh) best[k & 7] = mx;
    }
    const float inv = 1.0f / esum;
    int idx[8]; float gate[8];
#pragma unroll
    for (int k = 0; k < 8; ++k) { const unsigned code = asu(best[k]) & 255u; const unsigned a = sc[r32 * 16 + (code >> 4)], b = sc[(32 + r32) * 16 + (code & 15)];
        idx[k] = (int)((a & 127u) * 128u + (b & 127u)); gate[k] = __expf(asf(asu(best[k]) & ~255u) - bmax) * inv; }
    int* ip = RIDX + tok * 128 + h * 16 + 8 * hh; float* gp = RGATE + tok * 128 + h * 16 + 8 * hh;
    *(v4u*)ip = (v4u){(unsigned)idx[0], (unsigned)idx[1], (unsigned)idx[2], (unsigned)idx[3]}; *(v4u*)(ip + 4) = (v4u){(unsigned)idx[4], (unsigned)idx[5], (unsigned)idx[6], (unsigned)idx[7]};
    *(f32x4*)gp = (f32x4){gate[0], gate[1], gate[2], gate[3]}; *(f32x4*)(gp + 4) = (f32x4){gate[4], gate[5], gate[6], gate[7]};
}

__device__ __forceinline__ void phase_route(const Params& P, LAS unsigned char* lds, int vcu, int G, int wave) {
    const int lane = hw_lane();
    LAS unsigned* sc = (LAS unsigned*)(lds + wave * 4096);
#pragma unroll 1
    for (int it = vcu * NWAVES + wave; it < 512 * 8; it += G * NWAVES) route_item(P.ws, sc, it >> 3, it & 7, lane);
}

__device__ __forceinline__ void phase_regroup(const Params& P, int vcu, int G, int wave) {
    const int lane = hw_lane();
    const unsigned char* ws = P.ws;
    const int* RIDX = (const int*)(ws + WS_RIDX); const float* RGATE = (const float*)(ws + WS_RGATE);
    int* SIDX = (int*)(ws + WS_SIDX); float* SGATE = (float*)(ws + WS_SGATE); unsigned char* GOFF = (unsigned char*)(ws + WS_GOFF);
    const unsigned long long lt = (1ull << lane) - 1ull;
#pragma unroll 1
    for (int t = vcu * NWAVES + wave; t < M; t += G * NWAVES) {
        const size_t tok = (size_t)t;
        const int i0 = RIDX[tok * 128 + lane], i1 = RIDX[tok * 128 + 64 + lane];
        const float g0 = RGATE[tok * 128 + lane], g1 = RGATE[tok * 128 + 64 + lane];
        const int q0 = i0 >> 10, q1 = i1 >> 10;
        int off = 0, pos0 = 0, pos1 = 0, myoff = 0;
#pragma unroll
        for (int g = 0; g < 16; ++g) {
            const unsigned long long m0 = __ballot(q0 == g), m1 = __ballot(q1 == g);
            const int c0 = __popcll(m0), c1 = __popcll(m1);
            if (q0 == g) pos0 = off + __popcll(m0 & lt);
            if (q1 == g) pos1 = off + c0 + __popcll(m1 & lt);
            if (lane == g) myoff = off;
            off += c0 + c1;
        }
        if (lane == 16) myoff = 128;
        SIDX[tok * 128 + pos0] = i0; SIDX[tok * 128 + pos1] = i1;
        SGATE[tok * 128 + pos0] = g0; SGATE[tok * 128 + pos1] = g1;
        if (lane < 32) GOFF[tok * 32 + lane] = (unsigned char)(lane <= 16 ? myoff : 128);
    }
}
__device__ __forceinline__ float dot16_f8(const float (&x)[16], const v4u& u, float c) {
    const int u0 = (int)u.x, u1 = (int)u.y, u2 = (int)u.z, u3 = (int)u.w;
    const f32x2 a0 = __builtin_amdgcn_cvt_pk_f32_fp8(u0, false), a1 = __builtin_amdgcn_cvt_pk_f32_fp8(u0, true);
    const f32x2 a2 = __builtin_amdgcn_cvt_pk_f32_fp8(u1, false), a3 = __builtin_amdgcn_cvt_pk_f32_fp8(u1, true);
    const f32x2 a4 = __builtin_amdgcn_cvt_pk_f32_fp8(u2, false), a5 = __builtin_amdgcn_cvt_pk_f32_fp8(u2, true);
    const f32x2 a6 = __builtin_amdgcn_cvt_pk_f32_fp8(u3, false), a7 = __builtin_amdgcn_cvt_pk_f32_fp8(u3, true);
    c = fmaf(x[0], a0.x, c); c = fmaf(x[1], a0.y, c); c = fmaf(x[2], a1.x, c); c = fmaf(x[3], a1.y, c);
    c = fmaf(x[4], a2.x, c); c = fmaf(x[5], a2.y, c); c = fmaf(x[6], a3.x, c); c = fmaf(x[7], a3.y, c);
    c = fmaf(x[8], a4.x, c); c = fmaf(x[9], a4.y, c); c = fmaf(x[10], a5.x, c); c = fmaf(x[11], a5.y, c);
    c = fmaf(x[12], a6.x, c); c = fmaf(x[13], a6.y, c); c = fmaf(x[14], a7.x, c); c = fmaf(x[15], a7.y, c);
    return c;
}
__device__ __forceinline__ void unpack8(float* x, const v4u& v) { x[0] = bflo(v.x); x[1] = bfhi(v.x); x[2] = bflo(v.y); x[3] = bfhi(v.y); x[4] = bflo(v.z); x[5] = bfhi(v.z); x[6] = bflo(v.w); x[7] = bfhi(v.w); }
#ifndef U_WAVES
#define U_WAVES 8
#endif
__device__ __forceinline__ void peer_u_wave(const Params& P, int t0, int tstep, int tend, int lane) {
    const unsigned char* ws = P.ws;
    const bf16* H1B = (const bf16*)(ws + WS_B); const unsigned char* U8 = ws + WS_UB;
    const int* SIDX = (const int*)(ws + WS_SIDX); const float* SGATE = (const float*)(ws + WS_SGATE); const float* SSQH = (const float*)(ws + WS_SSQH);
    unsigned* PKV = (unsigned*)(ws + WS_PKV);
    if (t0 >= tend) return;
    int i0, i1; float g0, g1, rs2; float x[32];
    int i0n, i1n; float g0n, g1n, ssn; v4u xa, xb, xc, xd;
#define PU_META(t) do { const size_t _t = (size_t)(t); const bf16* hp = H1B + _t * 2048 + 32 * lane; xa = *(const v4u*)hp; xb = *(const v4u*)(hp + 8); xc = *(const v4u*)(hp + 16); xd = *(const v4u*)(hp + 24); \
        ssn = lane < 32 ? SSQH[_t * 32 + lane] : 0.f; i0n = SIDX[_t * 128 + lane]; i1n = SIDX[_t * 128 + 64 + lane]; g0n = SGATE[_t * 128 + lane]; g1n = SGATE[_t * 128 + 64 + lane]; } while (0)
#define PU_SWAP() do { i0 = i0n; i1 = i1n; g0 = g0n; g1 = g1n; unpack8(x, xa); unpack8(x + 8, xb); unpack8(x + 16, xc); unpack8(x + 24, xd); \
        rs2 = rsqrtf(wave_sum(ssn) * (1.f / 2048.f) + EPS) * (1.f / U6_SCALE); } while (0)
#define PU_LOAD(buf4, buf2, ia, ib, g) do { _Pragma("unroll") for (int e = 0; e < 8; ++e) { const int row = __builtin_amdgcn_readlane((g) < 8 ? ia : ib, ((g) & 7) * 8 + e); \
        const unsigned char* up = U8 + (size_t)row * 1536 + 16 * lane; buf4[e] = *(const v4u*)up; buf2[e] = *(const v2u*)(up + 1024 - 8 * lane); } } while (0)
#define PU_COMPUTE(buf4, buf2, g) do { float pt[8]; _Pragma("unroll") for (int e = 0; e < 8; ++e) { \
            const f32x32 r = __builtin_amdgcn_cvt_scalef32_pk32_f32_fp6((v6u){buf4[e].x, buf4[e].y, buf4[e].z, buf4[e].w, buf2[e].x, buf2[e].y}, 1.0f); \
            float s0 = 0.f, s1 = 0.f; _Pragma("unroll") for (int k = 0; k < 16; ++k) { s0 = fmaf(x[k], r[2 * k], s0); s1 = fmaf(x[16 + k], r[2 * k + 1], s1); } pt[e] = s0 + s1; }     \
        float a4[4], a2[2], a1; \
        _Pragma("unroll") for (int i = 0; i < 4; ++i) { const float keep = (lane & 1) ? pt[2 * i + 1] : pt[2 * i], give = (lane & 1) ? pt[2 * i] : pt[2 * i + 1]; a4[i] = keep + __shfl_xor(give, 1); } \
        _Pragma("unroll") for (int i = 0; i < 2; ++i) { const float keep = (lane & 2) ? a4[2 * i + 1] : a4[2 * i], give = (lane & 2) ? a4[2 * i] : a4[2 * i + 1]; a2[i] = keep + __shfl_xor(give, 2); } \
        { const float keep = (lane & 4) ? a2[1] : a2[0], give = (lane & 4) ? a2[0] : a2[1]; a1 = keep + __shfl_xor(give, 4); } \
        a1 += __shfl_xor(a1, 8); a1 += __shfl_xor(a1, 16); a1 += __shfl_xor(a1, 32); \
        if ((lane >> 3) == ((g) & 7)) { if ((g) < 8) d0 = a1; else d1 = a1; } } while (0)
    v4u ra4[8], rb4[8]; v2u ra2[8], rb2[8];
    PU_META(t0); PU_SWAP();
    PU_LOAD(ra4, ra2, i0, i1, 0);
#pragma unroll 1
    for (int t = t0; t < tend; t += tstep) {
        const bool more = t + tstep < tend;
        float d0 = 0.f, d1 = 0.f;
#pragma unroll 1
        for (int g = 0; g < 16; g += 2) {
            PU_LOAD(rb4, rb2, i0, i1, g + 1);
            if (g == 10 && more) PU_META(t + tstep);
            PU_COMPUTE(ra4, ra2, g);
            if (g + 2 < 16) PU_LOAD(ra4, ra2, i0, i1, g + 2); else if (more) PU_LOAD(ra4, ra2, i0n, i1n, 0);
            PU_COMPUTE(rb4, rb2, g + 1);
        }
        const size_t tok = (size_t)t;
        const float z0 = d0 * rs2, z1 = d1 * rs2;
        const float a0 = 8.0f * z0 * (1.0f + erff(z0 * 0.7071067811865476f)) * g0, a1v = 8.0f * z1 * (1.0f + erff(z1 * 0.7071067811865476f)) * g1;
        unsigned* pk = PKV + ((tok >> 6) * 128) * 64 + (tok & 63) * 4;
        pk[(size_t)(lane >> 2) * 256 + (lane & 3)] = ((unsigned)i0 << 2) | ((unsigned)__builtin_bit_cast(unsigned short, (_Float16)a0) << 16);
        pk[(size_t)(16 + (lane >> 2)) * 256 + (lane & 3)] = ((unsigned)i1 << 2) | ((unsigned)__builtin_bit_cast(unsigned short, (_Float16)a1v) << 16);
        if (more) PU_SWAP();
    }
#undef PU_META
#undef PU_SWAP
#undef PU_LOAD
#undef PU_COMPUTE
}
__device__ __forceinline__ void phase_peer_u(const Params& P, int vcu, int G, int wave) {
    const int lane = hw_lane();
    if (wave >= U_WAVES) return;
    peer_u_wave(P, vcu * U_WAVES + wave, G * U_WAVES, M, lane);
}
typedef _Float16 h2_t __attribute__((ext_vector_type(2)));
__device__ __forceinline__ void peer_v_range(const Params& P, int c, int b0, int b1, int wv, int nwv, int lane) {
    const unsigned char* ws = P.ws;
    const bf16* H1B = (const bf16*)(ws + WS_B); const unsigned* PKV = (const unsigned*)(ws + WS_PKV);
    if (b0 + wv >= b1) return;
    unsigned w0[16], w1[16], w2[16], w3[16];
#define PV_LOAD(buf) do { _Pragma("unroll") for (int q = 0; q < 4; ++q) { const v4u t4 = pl[q * 64]; buf[4 * q] = t4.x; buf[4 * q + 1] = t4.y; buf[4 * q + 2] = t4.z; buf[4 * q + 3] = t4.w; } pl += 4 * 64; asm volatile("" : "+v"(pl)); } while (0)
#define PV_PROC(buf) do { v2u vv[16]; _Pragma("unroll") for (int i = 0; i < 16; ++i) vv[i] = *(const LAS v2u*)(size_t)((buf[i] << 1) & 0x1fff8u);     \
        _Pragma("unroll") for (int i = 0; i < 16; ++i) { const _Float16 ah = __builtin_bit_cast(_Float16, (unsigned short)(buf[i] >> 16)); const h2_t a2 = {ah, ah}; \
            y0 = __builtin_elementwise_fma(a2, __builtin_bit_cast(h2_t, __builtin_amdgcn_cvt_scalef32_pk_f16_fp8(vv[i].x, 1.0f, false)), y0); \
            y1 = __builtin_elementwise_fma(a2, __builtin_bit_cast(h2_t, __builtin_amdgcn_cvt_scalef32_pk_f16_fp8(vv[i].x, 1.0f, true)), y1); \
            y2 = __builtin_elementwise_fma(a2, __builtin_bit_cast(h2_t, __builtin_amdgcn_cvt_scalef32_pk_f16_fp8(vv[i].y, 1.0f, false)), y2); \
            y3 = __builtin_elementwise_fma(a2, __builtin_bit_cast(h2_t, __builtin_amdgcn_cvt_scalef32_pk_f16_fp8(vv[i].y, 1.0f, true)), y3); } } while (0)
    const v4u* pl = (const v4u*)PKV + (size_t)(b0 + wv) * 32 * 64 + lane;
    PV_LOAD(w0); PV_LOAD(w1); PV_LOAD(w2);
    v4u hxn = *(const v4u*)(H1B + ((size_t)(b0 + wv) * 64 + lane) * 2048 + 8 * c);
#pragma unroll 1
    for (int b = b0 + wv; b < b1; b += nwv) {
        const size_t tok = (size_t)b * 64 + lane;
        const int bn = (b + nwv < b1) ? b + nwv : b;
        h2_t y0 = {0, 0}, y1 = {0, 0}, y2 = {0, 0}, y3 = {0, 0};
        v4u hx = hxn;
#pragma unroll 1
        for (int half = 0; half < 2; ++half) {
            PV_LOAD(w3); PV_PROC(w0);
            if (half == 1) { hxn = *(const v4u*)(H1B + ((size_t)bn * 64 + lane) * 2048 + 8 * c); pl += (ptrdiff_t)(bn - b - 1) * 32 * 64; }
            PV_LOAD(w0); PV_PROC(w1);
            PV_LOAD(w1); PV_PROC(w2);
            PV_LOAD(w2); PV_PROC(w3);
        }
        float y[8]; unpack8(y, hx);
        constexpr float S = 1.0f / 32.0f;
        y[0] += S * (float)y0[0]; y[1] += S * (float)y0[1]; y[2] += S * (float)y1[0]; y[3] += S * (float)y1[1];
        y[4] += S * (float)y2[0]; y[5] += S * (float)y2[1]; y[6] += S * (float)y3[0]; y[7] += S * (float)y3[1];
        float* op = P.out + tok * 2048 + 8 * c;
        *(f32x4*)op = (f32x4){y[0], y[1], y[2], y[3]}; *(f32x4*)(op + 4) = (f32x4){y[4], y[5], y[6], y[7]};
    }
#undef PV_LOAD
#undef PV_PROC
}
__device__ __forceinline__ void peer_v_fill(const Params& P, int c, int tid) {
    const v4u* src = (const v4u*)(P.ws + WS_VB + (size_t)c * 131072);
#pragma unroll 4
    for (int i = tid; i < 8192; i += NTHREADS) *(LAS v4u*)(size_t)(16 * i) = src[i];
}
__device__ __forceinline__ void phase_final(const Params& P, int vcu, int G, int wave) {
    const int lane = hw_lane();
    const bool poison = __hip_atomic_load((const unsigned*)(P.ws + WS_CTL) + CW_FLAG, __ATOMIC_RELAXED, __HIP_MEMORY_SCOPE_AGENT) != 0u;
    f32x4 gv[8];
#pragma unroll
    for (int j = 0; j < 8; ++j) gv[j] = ((const f32x4*)P.lnf)[lane + 64 * j];
#pragma unroll 1
    for (int t = vcu * NWAVES + wave; t < M; t += G * NWAVES) {
        f32x4* row = (f32x4*)(P.out + (size_t)t * 2048) + lane;
        f32x4 v[8]; float s = 0.f;
#pragma unroll
        for (int j = 0; j < 8; ++j) { v[j] = row[64 * j]; s += (v[j].x * v[j].x + v[j].y * v[j].y) + (v[j].z * v[j].z + v[j].w * v[j].w); }
        const float rs = poison ? __builtin_nanf("") : rsqrtf(wave_sum(s) * (1.f / 2048.f) + EPS);
#pragma unroll
        for (int j = 0; j < 8; ++j) row[64 * j] = v[j] * rs * gv[j];
    }
}
#undef MFMA32
}
#define XB_TMO      128
#define XB_XCNT(j)  (256  + 64 * (j))
#define XB_XSUB(j)  (1280 + 64 * (j))
#define XB_XGEN(j)  (2304 + 64 * (j))
#define XB_TOP      3328
#define XB_TOPGEN   3392
#define XCD_BAR_WORDS 3456
#define XB_SPIN_CAP (1u << 22)
__device__ __forceinline__ unsigned xb_ld(unsigned* p)              { return __hip_atomic_load(p, __ATOMIC_RELAXED, __HIP_MEMORY_SCOPE_AGENT); }
__device__ __forceinline__ unsigned xb_add(unsigned* p, unsigned v) { return __hip_atomic_fetch_add(p, v, __ATOMIC_RELAXED, __HIP_MEMORY_SCOPE_AGENT); }
__device__ __forceinline__ unsigned xb_xcc_id() { return (unsigned)__builtin_amdgcn_s_getreg((3 << 11) | 20) & 0xFu; }
#define XB_SPIN(cond, bar) do { unsigned _sp = 0; while (cond) { __builtin_amdgcn_s_sleep(1); \
    if ((++_sp & 255u) == 0u) { if (xb_ld(&(bar)[XB_TMO])) break; if (_sp > XB_SPIN_CAP) { atomicAdd(&(bar)[XB_TMO], 1u); break; } } } } while (0)
struct XcdBarrier { unsigned* bar; unsigned x; volatile LAS unsigned* st; };
__device__ __forceinline__ XcdBarrier xcd_barrier_post(unsigned* bar, volatile LAS unsigned* st, bool leader) {
    XcdBarrier b; b.bar = bar; b.x = xb_xcc_id(); b.st = st;
    if (leader) (void)xb_add(&bar[XB_XCNT(b.x)], 1u);
    return b;
}
__device__ __forceinline__ void xcd_barrier_complete(unsigned* bar, unsigned x, unsigned& nloc, unsigned& nx) {
    const unsigned G = gridDim.x * gridDim.y * gridDim.z;
    unsigned sum, cnt, mine, sp = 0u;
    for (;;) {
        sum = 0u; cnt = 0u; mine = 0u;
#pragma unroll
        for (unsigned j = 0; j < 16; ++j) { const unsigned c = xb_ld(&bar[XB_XCNT(j)]); sum += c; cnt += (c > 0u) ? 1u : 0u; mine = (j == x) ? c : mine; }
        if (sum == G) break;
        __builtin_amdgcn_s_sleep(1);
        if ((++sp & 255u) == 0u) { if (xb_ld(&bar[XB_TMO])) break; if (sp > XB_SPIN_CAP) { atomicAdd(&bar[XB_TMO], 1u); break; } }
    }
    nloc = mine > 0u ? mine : 1u; nx = cnt > 0u ? cnt : 1u;
}
__device__ __forceinline__ void xcd_barrier(const XcdBarrier& b, int wave) {
    asm volatile("s_waitcnt vmcnt(0)" ::: "memory");
    __syncthreads();
    if (wave == 0 && hw_lane() == 0) {
        unsigned* bar = b.bar;
        __builtin_amdgcn_s_waitcnt(0);
        unsigned nloc = b.st[0], nx = b.st[1];
        if (nloc == 0u) { xcd_barrier_complete(bar, b.x, nloc, nx); b.st[0] = nloc; b.st[1] = nx; }
        const unsigned old = xb_add(&bar[XB_XSUB(b.x)], 1u);
        const unsigned gen = old / nloc;
        if (old + 1u == (gen + 1u) * nloc) {
            __builtin_amdgcn_fence(__ATOMIC_RELEASE, "agent");
            asm volatile("s_waitcnt vmcnt(0)" ::: "memory");
            const unsigned og = xb_add(&bar[XB_TOP], 1u);
            const unsigned tg = og / nx;
            if (og + 1u == (tg + 1u) * nx) xb_add(&bar[XB_TOPGEN], 1u);
            else XB_SPIN(xb_ld(&bar[XB_TOPGEN]) == tg, bar);
            __builtin_amdgcn_fence(__ATOMIC_ACQUIRE, "agent");
            xb_add(&bar[XB_XGEN(b.x)], 1u);
            asm volatile("s_waitcnt vmcnt(0)" ::: "memory");
        } else {
            XB_SPIN(xb_ld(&bar[XB_XGEN(b.x)]) == gen, bar);
            __builtin_amdgcn_fence(__ATOMIC_ACQUIRE, "agent");
            asm volatile("s_waitcnt vmcnt(0)" ::: "memory");
        }
    }
    __syncthreads();
}
constexpr int N_PHASES = 11;
#ifndef REP_PHASE
#define REP_PHASE -1
#endif
#ifndef REP_N
#define REP_N 1
#endif
#ifndef EXTRA_SYNCS
#define EXTRA_SYNCS 0
#endif
__global__ void __launch_bounds__(NTHREADS, 2) mega(Params P) {
    extern __shared__ __attribute__((aligned(16))) unsigned char lds_raw[];
    LAS unsigned char* lds = (LAS unsigned char*)lds_raw;
    cg::grid_group grid = cg::this_grid();
    const int wave = __builtin_amdgcn_readfirstlane((int)threadIdx.x >> 6);
    const int G = gridDim.x, bx = blockIdx.x;
    const int vcu = (G % 8 == 0) ? (bx % 8) * (G / 8) + bx / 8 : bx;
    unsigned char* ws = P.ws;
    const int lo = P.ph_lo, hi = P.ph_hi;
#define IN(k) (lo <= (k) && (k) < hi)
#ifndef CG_SEAMS
#define CG_SEAMS 1
#endif
    volatile LAS unsigned* xbst = (volatile LAS unsigned*)(lds + MISC_OFF + 8192);
    if (wave == 0 && hw_lane() == 0) { xbst[0] = 0u; xbst[1] = 0u; xbst[2] = 0u; xbst[3] = 0u; }
    __syncthreads();
    const XcdBarrier xbar = xcd_barrier_post((unsigned*)(ws + WS_CTL) + 4096, xbst, wave == 0 && hw_lane() == 0);
#define GSYNC(k) do { if ((k) < CG_SEAMS) grid.sync(); else xcd_barrier(xbar, wave); } while (0)
#define SEAM(k) do { if (IN(k) && IN((k) + 1)) GSYNC(k); } while (0)

    for (int rep_ = 0; rep_ < (REP_PHASE == 0 ? 1 + REP_N : 1); ++rep_) if (IN(0)) { if (rep_) GSYNC(9); phase_prep(P, lds, vcu, G, wave, rep_ ? PREP_ONLY : -1); }
    SEAM(0);
    for (int es_ = 0; es_ < EXTRA_SYNCS; ++es_) GSYNC(9);
    for (int rep_ = 0; rep_ < (REP_PHASE == 1 ? 1 + REP_N : 1); ++rep_) if (IN(1)) { if (rep_) GSYNC(9);
        pg8::GemmSet g; g.A0 = g.A1 = (const bf16*)(ws + WS_A); g.Bt0 = g.Bt1 = (const bf16*)(ws + WS_BT1); g.K = 2048;
        pg8::StaticOrder S; S.init(M, 4096, 0, G, bx);
        pg8::Epi1 E{(bf16*)(ws + WS_B), (bf16*)(ws + WS_CQ), (bf16*)(ws + WS_CKV), (float*)(ws + WS_SSQCQ), (float*)(ws + WS_SSQCKV)};
        pg8::gemm_phase<pg8::Epi1, pg8::StaticOrder>(lds, g, S, E, wave);
    }
    SEAM(1);
    for (int rep_ = 0; rep_ < (REP_PHASE == 2 ? 1 + REP_N : 1); ++rep_) if (IN(2)) { if (rep_) GSYNC(9);
        for (int it = bx; it < 256; it += G) kr_item64((const bf16*)(ws + WS_A), (const bf16*)(ws + WS_BTKR), (const f32x2*)(ws + WS_ROPE), (bf16*)(ws + WS_KPE), (LAS f32x4*)lds, it, wave, hw_lane());
        pg8::GemmSet g; g.A0 = (const bf16*)(ws + WS_CQ); g.A1 = (const bf16*)(ws + WS_CKV); g.Bt0 = (const bf16*)(ws + WS_BT2Q); g.Bt1 = (const bf16*)(ws + WS_BT2KV); g.K = 512;
        pg8::StaticOrder S; S.init(M, 1536, 2048, G, bx);
        pg8::Epi2 E{(bf16*)(ws + WS_QN), (bf16*)(ws + WS_QPE), (bf16*)(ws + WS_KN), (bf16*)(ws + WS_VM), (const float*)(ws + WS_SSQCQ), (const float*)(ws + WS_SSQCKV), (const f32x2*)(ws + WS_ROPE)};
        pg8::gemm_phase<pg8::Epi2, pg8::StaticOrder>(lds, g, S, E, wave);
    }
    SEAM(2);
    for (int rep_ = 0; rep_ < (REP_PHASE == 3 ? 1 + REP_N : 1); ++rep_) if (IN(3)) { if (rep_) GSYNC(9); att::phase_attn(P, lds, vcu, G, wave); }
    SEAM(3);
    for (int rep_ = 0; rep_ < (REP_PHASE == 4 ? 1 + REP_N : 1); ++rep_) if (IN(4)) { if (rep_) GSYNC(9);
        pg8::GemmSet g; g.A0 = g.A1 = (const bf16*)(ws + WS_A); g.Bt0 = g.Bt1 = (const bf16*)(ws + WS_BT3); g.K = 2048;
        pg8::StaticOrder S; S.init(M, 2048, 0, G, bx);
        pg8::Epi3 E{(bf16*)(ws + WS_B), P.x, (const float*)(ws + WS_SSQO), (float*)(ws + WS_SSQH), (LAS f32x2*)(lds + MISC_OFF)};
        pg8::gemm_phase<pg8::Epi3, pg8::StaticOrder>(lds, g, S, E, wave);
    }
    SEAM(4);
    for (int rep_ = 0; rep_ < (REP_PHASE == 5 ? 1 + REP_N : 1); ++rep_) if (IN(5)) { if (rep_) GSYNC(9);
        pg8::GemmSet g; g.A0 = g.A1 = (const bf16*)(ws + WS_B); g.Bt0 = g.Bt1 = (const bf16*)(ws + WS_BT4); g.K = 2048;
        pg8::StaticOrder S; S.init(M, 2048, 0, G, bx);
        pg8::Epi4 E{(bf16*)(ws + WS_QP)};
        pg8::gemm_phase<pg8::Epi4, pg8::StaticOrder>(lds, g, S, E, wave);
    }
#ifdef EXTRA_G4
    if (IN(5)) { GSYNC(9);
        pg8::GemmSet g; g.A0 = g.A1 = (const bf16*)(ws + WS_B); g.Bt0 = g.Bt1 = (const bf16*)(ws + WS_BT4); g.K = 2048;
        pg8::StaticOrder S; S.init(M, 2048, 0, G, bx);
#if EXTRA_G4 == 1
        pg8::Epi4 E{(bf16*)(ws + WS_QP)}; pg8::gemm_phase<pg8::Epi4, pg8::StaticOrder>(lds, g, S, E, wave);
#else
        pg8::EpiNull E{}; pg8::gemm_phase<pg8::EpiNull, pg8::StaticOrder>(lds, g, S, E, wave);
#endif
    }
#endif
    SEAM(5);
    for (int rep_ = 0; rep_ < (REP_PHASE == 6 ? 1 + REP_N : 1); ++rep_) if (IN(6)) { if (rep_) GSYNC(9); peer::phase_route(P, lds, vcu, G, wave); }
    SEAM(6);
    for (int rep_ = 0; rep_ < (REP_PHASE == 7 ? 1 + REP_N : 1); ++rep_) if (IN(7)) { if (rep_) GSYNC(9); peer::phase_regroup(P, vcu, G, wave); }
    SEAM(7);
    for (int rep_ = 0; rep_ < (REP_PHASE == 8 ? 1 + REP_N : 1); ++rep_) if (IN(8)) { if (rep_) GSYNC(9); peer::phase_peer_u(P, vcu, G, wave); }
    SEAM(8);
    for (int rep_ = 0; rep_ < (REP_PHASE == 9 ? 1 + REP_N : 1); ++rep_) if (IN(9)) { if (rep_) GSYNC(9);
        const int lane_ = hw_lane();
        for (int c = vcu; c < 256; c += G) { __syncthreads(); peer::peer_v_fill(P, c, wave * 64 + lane_); __syncthreads(); peer::peer_v_range(P, c, 0, 256, wave, NWAVES, lane_); }
    }
    SEAM(9);
    for (int rep_ = 0; rep_ < (REP_PHASE == 10 ? 1 + REP_N : 1); ++rep_) if (IN(10)) { if (rep_) GSYNC(9); peer::phase_final(P, vcu, G, wave); }
#undef IN
#undef SEAM
}

static int mega_grid() {
    static int grid = 0;
    if (grid == 0) {
        int dev = 0, cus = 0, per_cu = 0;
        (void)hipGetDevice(&dev); (void)hipDeviceGetAttribute(&cus, hipDeviceAttributeMultiprocessorCount, dev);
        (void)hipFuncSetAttribute((const void*)mega, hipFuncAttributeMaxDynamicSharedMemorySize, LDS_BYTES);
        (void)hipOccupancyMaxActiveBlocksPerMultiprocessor(&per_cu, (const void*)mega, NTHREADS, LDS_BYTES);
        if (per_cu < 1) { fprintf(stderr, "mega: occupancy query says %d blocks/CU\n", per_cu); per_cu = 1; }
        grid = cus;
        (void)hipGetLastError();
    }
    return grid;
}
static void fill_params(Params& P, void* const* d_in, void* d_out, void* d_ws) {
    P.x = (const float*)d_in[0]; P.ln1 = (const float*)d_in[1]; P.w_in = (const float*)d_in[2]; P.qan = (const float*)d_in[3]; P.kvan = (const float*)d_in[4];
    P.w_uq = (const float*)d_in[5]; P.w_ukv = (const float*)d_in[6]; P.ond = (const float*)d_in[7]; P.onm = (const float*)d_in[8]; P.w_o = (const float*)d_in[9];
    P.ln2 = (const float*)d_in[10]; P.wq = (const float*)d_in[11]; P.sk = (const float*)d_in[12]; P.pu = (const float*)d_in[13]; P.pv = (const float*)d_in[14]; P.lnf = (const float*)d_in[15];
    P.out = (float*)d_out; P.ws = (unsigned char*)d_ws;
}
static void launch_phases(Params P, int lo, int hi, hipStream_t st) {
    P.ph_lo = lo; P.ph_hi = hi;
    (void)hipMemsetAsync(P.ws + WS_CTL, 0, CTL_ZERO_BYTES, st);
    void* args[] = {&P};
    hipError_t e = hipLaunchCooperativeKernel((const void*)mega, dim3(mega_grid()), dim3(NTHREADS), args, LDS_BYTES, st);
    if (e != hipSuccess) fprintf(stderr, "mega launch [%d,%d) failed: %s\n", lo, hi, hipGetErrorString(e));
}
extern "C" void kernel_launch(void* const* d_in, const int* in_sizes, int n_in, void* d_out, int out_size, void* d_ws, size_t ws_size, hipStream_t stream) {
    Params P{}; fill_params(P, d_in, d_out, d_ws);
    launch_phases(P, 0, N_PHASES, stream);
}
```

```cpp
#include <hip/hip_runtime.h>
#include <hip/hip_cooperative_groups.h>
#include <cstdio>
#include <cstdint>
#include <cstddef>
namespace cg = cooperative_groups;
#define GAS __attribute__((address_space(1)))
#define LAS __attribute__((address_space(3)))
typedef unsigned short bf16;
typedef unsigned v4u __attribute__((ext_vector_type(4)));
typedef unsigned v2u __attribute__((ext_vector_type(2)));
typedef float f32x2 __attribute__((ext_vector_type(2)));
typedef float f32x4 __attribute__((ext_vector_type(4)));
typedef float f32x16 __attribute__((ext_vector_type(16)));
typedef short bf16x8 __attribute__((ext_vector_type(8)));
typedef short s16x4 __attribute__((ext_vector_type(4)));
typedef __bf16 bf16x2_t __attribute__((ext_vector_type(2)));
typedef float f32x32 __attribute__((ext_vector_type(32)));
typedef unsigned v6u __attribute__((ext_vector_type(6)));
constexpr int CW_FLAG = 64;
constexpr float U6_SCALE = 64.0f;

constexpr int M = 16384, SEQ = 2048, DM = 2048, NWAVES = 8, NTHREADS = 512;
constexpr float EPS = 1e-6f, LOG2E = 1.4426950408889634f;
constexpr float QSCALE_DIL = 0.08838834764831845f * LOG2E;
constexpr float QSCALE_MLA = 0.07216878364870323f * LOG2E;

constexpr size_t MiB = 1u << 20;
constexpr size_t WS_CTL = 0, CTL_ZERO_BYTES = 64 * 1024;
constexpr size_t WS_ROPE = 1 * MiB;
constexpr size_t WS_SK = 2 * MiB;
constexpr size_t WS_BTKR = 3 * MiB;
constexpr size_t WS_BT2Q = 4 * MiB;
constexpr size_t WS_BT2KV = 6 * MiB;
constexpr size_t WS_BT1 = 8 * MiB;
constexpr size_t WS_BT3 = 24 * MiB;
constexpr size_t WS_BT4 = 32 * MiB;
constexpr size_t WS_SSQCQ = 40 * MiB;
constexpr size_t WS_SSQCKV = 40 * MiB + 512 * 1024;
constexpr size_t WS_SSQO = 41 * MiB;
constexpr size_t WS_SSQH = 42 * MiB;
constexpr size_t WS_KPE = 44 * MiB;
constexpr size_t WS_UB = 48 * MiB;
constexpr size_t WS_VB = 112 * MiB;
constexpr size_t WS_A = 176 * MiB;
constexpr size_t WS_B = 240 * MiB;
constexpr size_t WS_C = 336 * MiB;
constexpr size_t WS_QN = WS_C, WS_QPE = WS_C + 32 * MiB, WS_KN = WS_C + 48 * MiB, WS_VM = WS_C + 80 * MiB;
constexpr size_t WS_QP = WS_C, WS_RIDX = WS_C + 64 * MiB, WS_RGATE = WS_C + 72 * MiB, WS_PKV = WS_C + 80 * MiB,
                 WS_SIDX = WS_C + 88 * MiB, WS_SGATE = WS_C + 96 * MiB, WS_GOFF = WS_C + 104 * MiB;
constexpr size_t WS_D = 448 * MiB;
constexpr size_t WS_CQ = WS_D, WS_CKV = WS_D + 16 * MiB;
constexpr size_t WS_END = 480 * MiB;

constexpr int RING_BYTES = 131072;
constexpr int MISC_OFF = RING_BYTES;
constexpr int LDS_BYTES = 147456;

#define LDS_WAIT() asm volatile("s_waitcnt lgkmcnt(0)" ::: "memory")
#define VM_WAIT() asm volatile("s_waitcnt vmcnt(0)" ::: "memory")

__device__ __forceinline__ unsigned f2bf(float f) { unsigned u = __builtin_bit_cast(unsigned, f); return (u + 0x7fffu + ((u >> 16) & 1u)) >> 16; }
__device__ __forceinline__ unsigned pk2(float lo, float hi) { f32x2 v = {lo, hi}; bf16x2_t b = __builtin_convertvector(v, bf16x2_t); return __builtin_bit_cast(unsigned, b); }
__device__ __forceinline__ float bflo(unsigned u) { return __builtin_bit_cast(float, u << 16); }
__device__ __forceinline__ float bfhi(unsigned u) { return __builtin_bit_cast(float, u & 0xffff0000u); }
__device__ __forceinline__ float bf2f(bf16 b) { return __builtin_bit_cast(float, (unsigned)b << 16); }
__device__ __forceinline__ float wave_sum(float v) {
#pragma unroll
    for (int o = 1; o < 64; o <<= 1) v += __shfl_xor(v, o);
    return v;
}

__device__ __forceinline__ int hw_lane() { int l; asm volatile("v_mbcnt_lo_u32_b32 %0, -1, 0\n\tv_mbcnt_hi_u32_b32 %0, -1, %0" : "=v"(l)); return l; }

struct Params {
    const float *x, *ln1, *w_in, *qan, *kvan, *w_uq, *w_ukv, *ond, *onm, *w_o, *ln2, *wq, *sk, *pu, *pv, *lnf;
    float* out; unsigned char* ws;
    int ph_lo, ph_hi;
};
__device__ __forceinline__ int map_ident(int c) { return c; }
__device__ __forceinline__ int map_kr(int c) { const int p = c - 4096; return 2 * (p & 31) + (p >> 5); }
__device__ __forceinline__ int map_uq(int c) { const int h = c / 192, e = c % 192; if (e < 128) return h * 128 + e; const int p = e - 128; return 1024 + h * 64 + 2 * (p & 31) + (p >> 5); }
__device__ __forceinline__ int map_ukv(int c) { const int h = c >> 8, e = c & 255; return e < 128 ? h * 128 + e : 1024 + h * 128 + (e - 128); }

template <int MAP>
__device__ __forceinline__ void p0_transpose_item(const float* __restrict__ W, int K, int ldw, int c0, const float* __restrict__ g0, const float* __restrict__ g1, int gsplit,
                                                  bf16* __restrict__ WT, LAS float* scr, int item, int nblk, int lane) {
    const int kb = item / nblk, nb = item % nblk, k0 = 64 * kb, n0 = c0 + 32 * nb;
    f32x4 wv[8];
#pragma unroll
    for (int i = 0; i < 8; ++i) wv[i] = *(const f32x4*)(W + (size_t)(k0 + (lane >> 3) + 8 * i) * ldw + n0 + 4 * (lane & 7));
#pragma unroll
    for (int i = 0; i < 8; ++i) { const int kk = (lane >> 3) + 8 * i, k = k0 + kk; f32x4 w = wv[i];
        if (g0) w = w * (k < gsplit ? g0[k] : g1[k - gsplit]);
        LAS float* d = scr + kk * 33 + 4 * (lane & 7); d[0] = w[0]; d[1] = w[1]; d[2] = w[2]; d[3] = w[3]; }
    LDS_WAIT(); asm volatile("" ::: "memory");
    const int c = lane & 7;
#pragma unroll
    for (int j = 0; j < 4; ++j) { const int n = (lane >> 3) + 8 * j; const LAS float* s = scr + (8 * c) * 33 + n;
        v4u o; o.x = pk2(s[0 * 33], s[1 * 33]); o.y = pk2(s[2 * 33], s[3 * 33]); o.z = pk2(s[4 * 33], s[5 * 33]); o.w = pk2(s[6 * 33], s[7 * 33]);
        const int src = n0 + n;
        const int dr = MAP == 0 ? map_ident(src) : MAP == 1 ? map_kr(src) : MAP == 2 ? map_uq(src) : map_ukv(src);
        *(v4u*)(WT + (size_t)dr * K + k0 + 8 * c) = o; }
    LDS_WAIT(); asm volatile("" ::: "memory");
}

#ifndef PREP_ONLY
#define PREP_ONLY -1
#endif
__device__ __forceinline__ void phase_prep(const Params& P, LAS unsigned char* lds, int vcu, int G, int wave, int only = -1) {
    const int lane = hw_lane(), tid = wave * 64 + lane;
    unsigned char* ws = P.ws;
    LAS float* scr = (LAS float*)(lds + wave * 16384);
    const int gw = vcu * NWAVES + wave, NGW = G * NWAVES;
    const int gt = vcu * NTHREADS + tid, NGT = G * NTHREADS;
#pragma unroll 1
    for (int pi = 0; pi < 3; ++pi) {
        const int part = (pi + wave) % 3;
        if (only >= 0 && only != part) continue;
        if (part == 0) {
    constexpr int I1 = 32 * 128, IKR = 32 * 2, I2Q = 8 * 48, I2KV = 8 * 64, I3 = 32 * 64, I4 = 32 * 64;
    constexpr int NITEMS = I1 + IKR + I2Q + I2KV + I3 + I4;
    for (int it = gw; it < NITEMS; it += NGW) {
        int r = it;
        if (r < I1) { p0_transpose_item<0>(P.w_in, 2048, 4160, 0, nullptr, nullptr, 0, (bf16*)(ws + WS_BT1), scr, r, 128, lane); continue; } r -= I1;
        if (r < IKR) { p0_transpose_item<1>(P.w_in, 2048, 4160, 4096, nullptr, nullptr, 0, (bf16*)(ws + WS_BTKR), scr, r, 2, lane); continue; } r -= IKR;
        if (r < I2Q) { p0_transpose_item<2>(P.w_uq, 512, 1536, 0, P.qan, P.qan, 512, (bf16*)(ws + WS_BT2Q), scr, r, 48, lane); continue; } r -= I2Q;
        if (r < I2KV) { p0_transpose_item<3>(P.w_ukv, 512, 2048, 0, P.kvan, P.kvan, 512, (bf16*)(ws + WS_BT2KV), scr, r, 64, lane); continue; } r -= I2KV;
        if (r < I3) { p0_transpose_item<0>(P.w_o, 2048, 2048, 0, P.ond, P.onm, 1024, (bf16*)(ws + WS_BT3), scr, r, 64, lane); continue; } r -= I3;
        p0_transpose_item<0>(P.wq, 2048, 2048, 0, P.ln2, P.ln2, 2048, (bf16*)(ws + WS_BT4), scr, r, 64, lane);
    }
        } else if (part == 1) {
    {
        bf16* XN = (bf16*)(ws + WS_A);
        f32x4 gv[8];
#pragma unroll
        for (int j = 0; j < 8; ++j) gv[j] = ((const f32x4*)P.ln1)[lane + 64 * j];
        for (int m0 = gw * 4; m0 < M; m0 += NGW * 4) {
            f32x4 v[4][8];
#pragma unroll
            for (int r = 0; r < 4; ++r) { const f32x4* xr = (const f32x4*)(P.x + (size_t)(m0 + r) * DM) + lane;
#pragma unroll
                for (int j = 0; j < 8; ++j) v[r][j] = __builtin_nontemporal_load(xr + 64 * j); }
#pragma unroll
            for (int r = 0; r < 4; ++r) { float s = 0.f;
#pragma unroll
                for (int j = 0; j < 8; ++j) s += (v[r][j].x * v[r][j].x + v[r][j].y * v[r][j].y) + (v[r][j].z * v[r][j].z + v[r][j].w * v[r][j].w);
                const float rs = rsqrtf(wave_sum(s) * (1.f / DM) + EPS);
                v2u* o8 = (v2u*)(XN + (size_t)(m0 + r) * DM) + lane;
#pragma unroll
                for (int j = 0; j < 8; ++j) { v2u o; o.x = pk2(v[r][j].x * rs * gv[j].x, v[r][j].y * rs * gv[j].y); o.y = pk2(v[r][j].z * rs * gv[j].z, v[r][j].w * rs * gv[j].w); o8[64 * j] = o; } }
        }
    }
        } else {
        {
            f32x16 ta, tb;
#pragma unroll
            for (int i = 0; i < 16; ++i) { ta[i] = (float)(i & 7); tb[i] = (float)((i + 16) & 7) * 0.5f + (float)(i >> 3); }
            const f32x32 r = __builtin_amdgcn_cvt_scalef32_pk32_f32_fp6(__builtin_amdgcn_cvt_scalef32_2xpk16_fp6_f32(ta, tb, 1.0f), 1.0f);
            bool ok = true;
#pragma unroll
            for (int i = 0; i < 16; ++i) ok = ok && (r[2 * i] == ta[i]) && (r[2 * i + 1] == tb[i]);
            if (!ok) __hip_atomic_store((unsigned*)(ws + WS_CTL) + CW_FLAG, 1u, __ATOMIC_RELAXED, __HIP_MEMORY_SCOPE_AGENT);
        }
        unsigned char* ou = ws + WS_UB;
#pragma unroll 1
        for (int i = gt; i < 16384 * 64; i += NGT) {
            const int e = i >> 6, l = i & 63; const f32x4* src = (const f32x4*)(P.pu + (size_t)e * 2048 + 32 * l); const f32x4* gp = (const f32x4*)(P.ln2 + 32 * l);
            f32x16 xa, xb;
#pragma unroll
            for (int j = 0; j < 4; ++j) { const f32x4 v = __builtin_nontemporal_load(src + j) * gp[j] * U6_SCALE; xa[4 * j] = v[0]; xa[4 * j + 1] = v[1]; xa[4 * j + 2] = v[2]; xa[4 * j + 3] = v[3]; }
#pragma unroll
            for (int j = 0; j < 4; ++j) { const f32x4 v = __builtin_nontemporal_load(src + 4 + j) * gp[4 + j] * U6_SCALE; xb[4 * j] = v[0]; xb[4 * j + 1] = v[1]; xb[4 * j + 2] = v[2]; xb[4 * j + 3] = v[3]; }
            const v6u p6 = __builtin_amdgcn_cvt_scalef32_2xpk16_fp6_f32(xa, xb, 1.0f);
            unsigned char* row = ou + (size_t)e * 1536;
            *(v4u*)(row + 16 * l) = (v4u){p6[0], p6[1], p6[2], p6[3]}; *(v2u*)(row + 1024 + 8 * l) = (v2u){p6[4], p6[5]};
        }
        }
    }
    if (only < 0 || only == 3) {
        f32x2* R = (f32x2*)(ws + WS_ROPE);
        for (int i = gt; i < 2048 * 32; i += NGT) { const int pos = i >> 5, j = i & 31; const float freq = powf(10000.0f, -(float)j / 32.0f), ang = (float)pos * freq;
            f32x2 cs; cs.x = cosf(ang); cs.y = sinf(ang); R[i] = cs; }
    }
    if (only < 0 || only == 3) {
        v4u* o = (v4u*)(ws + WS_SK);
        for (int i = gt; i < 16 * 128 * 128 / 8; i += NGT) { const f32x4 a = ((const f32x4*)P.sk)[2 * i], b = ((const f32x4*)P.sk)[2 * i + 1];
            v4u w; w.x = pk2(a.x, a.y); w.y = pk2(a.z, a.w); w.z = pk2(b.x, b.y); w.w = pk2(b.z, b.w); o[i] = w; }
    }
    if (only < 0 || only == 4) {
        __syncthreads();
        LAS v2u* tl = (LAS v2u*)lds;
        v2u* ov = (v2u*)(ws + WS_VB);
        f32x4 ra[8], rb[8];
#define PV8_LOAD(tile_) do { const int _e0 = ((tile_) >> 2) * 64, _c0 = ((tile_) & 3) * 64; _Pragma("unroll") for (int k = 0; k < 8; ++k) { const int it = tid + 512 * k, e = it >> 6, c = it & 63; \
            const f32x4* src = (const f32x4*)(P.pv + (size_t)(_e0 + e) * 2048 + (size_t)(_c0 + c) * 8); ra[k] = __builtin_nontemporal_load(src); rb[k] = __builtin_nontemporal_load(src + 1); } } while (0)
        if (vcu < 1024) PV8_LOAD(vcu);
        for (int tile = vcu; tile < 1024; tile += G) {
            const int e0 = (tile >> 2) * 64, c0 = (tile & 3) * 64;
#pragma unroll
            for (int k = 0; k < 8; ++k) { const int it = tid + 512 * k, e = it >> 6, c = it & 63; const f32x4 a = ra[k], b = rb[k];
                int w0 = 0, w1 = 0;
                w0 = __builtin_amdgcn_cvt_pk_fp8_f32(a.x * 2.f, a.y * 2.f, w0, false); w0 = __builtin_amdgcn_cvt_pk_fp8_f32(a.z * 2.f, a.w * 2.f, w0, true);
                w1 = __builtin_amdgcn_cvt_pk_fp8_f32(b.x * 2.f, b.y * 2.f, w1, false); w1 = __builtin_amdgcn_cvt_pk_fp8_f32(b.z * 2.f, b.w * 2.f, w1, true);
                v2u w; w.x = (unsigned)w0; w.y = (unsigned)w1; tl[c * 65 + e] = w; }
            if (tile + G < 1024) PV8_LOAD(tile + G);
            __syncthreads();
#pragma unroll
            for (int k = 0; k < 8; ++k) { const int it = tid + 512 * k, c = it >> 6, e = it & 63; ov[(size_t)(c0 + c) * 16384 + e0 + e] = tl[c * 65 + e]; }
            __syncthreads();
        }
#undef PV8_LOAD
    }
}
namespace pg8 {
constexpr int BM = 256, BK = 64, HALF = 128, HTB = HALF * BK * 2, STAGE_BYTES = 8 * HTB, NXCD = 8, WGM = 8;
__host__ __device__ __forceinline__ int lds_byte(int r, int c) { const int st = (r >> 4) * 2 + (c >> 5), rr = r & 15, cc = c & 31, ob = rr * 64 + cc * 2; return st * 1024 + (ob ^ (((ob >> 9) & 1) << 5)); }
__host__ __device__ __forceinline__ void stage_rc(int b, int& R, int& C) { const int st = b / 1024, sb = b % 1024, swz = sb ^ (((sb >> 9) & 1) << 5); R = (st >> 1) * 16 + swz / 64; C = (st & 1) * 32 + (swz % 64) / 2; }
__host__ __device__ __forceinline__ int perm32(int rho) { const int n = rho >> 4, i = rho & 15; return 8 * (i >> 2) + 4 * n + (i & 3); }

struct Unit { int pm, pn, g; };
struct GemmSet { const bf16 *A0, *A1, *Bt0, *Bt1; int K; };

struct StaticOrder {
    int nM, nN0, nN, nwg, G, c;
    __device__ void init(int Mrows, int N0, int N1, int G_, int c_) { nM = Mrows / BM; nN0 = N0 / BM; nN = nN0 + N1 / BM; nwg = nM * nN; G = G_; c = c_; }
    __device__ bool next(int i, Unit& u) const {
        const long L = (long)i * G + c; if (L >= nwg) return false;
        int wgid = (int)L; { const int q = nwg / NXCD, r = nwg % NXCD, xcd = wgid % NXCD, off = wgid / NXCD; wgid = (xcd < r ? xcd * (q + 1) : r * (q + 1) + (xcd - r) * q) + off; }
        const int nig = WGM * nN, gid = wgid / nig, fm = gid * WGM, gsz = (nM - fm) < WGM ? (nM - fm) : WGM;
        u.pm = fm + ((wgid % nig) % gsz); int pn = (wgid % nig) / gsz; u.g = pn >= nN0 ? 1 : 0; u.pn = pn >= nN0 ? pn - nN0 : pn; return true;
    }
};

template <class Epi, class Sched>
__device__ __forceinline__ void gemm_phase(LAS unsigned char* lds, const GemmSet g, const Sched& S, const Epi& E, int wid) {
    const int lane = hw_lane(), tid = wid * 64 + lane, wr = wid >> 2, wc = wid & 3, fr = lane & 15, fq = lane >> 4;
    const int K = g.K, nt = K / BK;
    unsigned voffA[2], voffB[2];
#pragma unroll
    for (int i = 0; i < 2; ++i) { int R, C; stage_rc(tid * 16 + i * 8192, R, C); const int Rb = (R & ~31) + perm32(R & 31);
        voffA[i] = (unsigned)(R * K + C) * 2u; voffB[i] = (unsigned)(Rb * K + C) * 2u; }
    const size_t kstep = (size_t)(BK * 2);
    const size_t hstep = (size_t)HALF * K * 2;
    const size_t tstep = 2 * hstep;
    const unsigned ldsw = (unsigned)wid * 1024u;
    const int aoff = lds_byte(wr * 64 + fr, fq * 8), boff = lds_byte(wc * 32 + fr, fq * 8);
#define PG8_SA(b, h) (((b) * 2 + (h)) * HTB)
#define PG8_SB(b, h) ((4 + (b) * 2 + (h)) * HTB)
#define PG8_STAGE(bufoff, gbase, voff) do { _Pragma("unroll") for (int _i = 0; _i < 2; ++_i) \
        __builtin_amdgcn_global_load_lds((const unsigned*)((const char*)(gbase) + (voff)[_i]), (LAS unsigned*)(lds + (bufoff) + ldsw + _i * 8192), 16, 0, 0); } while (0)
#define PG8_LDA(dst, b, h) do { _Pragma("unroll") for (int m = 0; m < 4; ++m) _Pragma("unroll") for (int k = 0; k < 2; ++k) dst[m][k] = *(const LAS bf16x8*)(lds + PG8_SA(b, h) + aoff + m * 2048 + k * 1024); } while (0)
#define PG8_LDB(dst, b, h) do { _Pragma("unroll") for (int n = 0; n < 2; ++n) _Pragma("unroll") for (int k = 0; k < 2; ++k) dst[n][k] = *(const LAS bf16x8*)(lds + PG8_SB(b, h) + boff + n * 2048 + k * 1024); } while (0)
#define PG8_MMA(ai, bj, At, Bt) do { __builtin_amdgcn_s_setprio(1); _Pragma("unroll") for (int m = 0; m < 4; ++m) _Pragma("unroll") for (int n = 0; n < 2; ++n) _Pragma("unroll") for (int k = 0; k < 2; ++k) \
        acc[ai][bj][m][n] = __builtin_amdgcn_mfma_f32_16x16x32_bf16(Bt[n][k], At[m][k], acc[ai][bj][m][n], 0, 0, 0); __builtin_amdgcn_s_setprio(0); } while (0)
#define PG8_WAIT_V(n) asm volatile("s_waitcnt vmcnt(" #n ")" ::: "memory")
#define PG8_WAIT_L(n) asm volatile("s_waitcnt lgkmcnt(" #n ")" ::: "memory")
#define PG8_BAR __builtin_amdgcn_s_barrier()
#define PG8_SCHED __builtin_amdgcn_sched_barrier(0)
    Unit cur, nxt; int ui = 0;
    if (!S.next(0, cur)) return;
    f32x4 acc[2][2][4][2];
#pragma unroll
    for (int a = 0; a < 2; ++a)
#pragma unroll
        for (int b = 0; b < 2; ++b)
#pragma unroll
            for (int m = 0; m < 4; ++m)
#pragma unroll
                for (int n = 0; n < 2; ++n) acc[a][b][m][n] = (f32x4){0.f, 0.f, 0.f, 0.f};
    bf16x8 At[4][2], B0[2][2], B1[2][2];
    const char* cA = (const char*)(cur.g ? g.A1 : g.A0) + (size_t)cur.pm * tstep; const char* cB = (const char*)(cur.g ? g.Bt1 : g.Bt0) + (size_t)cur.pn * tstep;
    E.unit_begin(cur, 0, tid);
    PG8_STAGE(PG8_SB(0, 0), cB, voffB); PG8_STAGE(PG8_SB(0, 1), cB + hstep, voffB); PG8_STAGE(PG8_SA(0, 0), cA, voffA); PG8_STAGE(PG8_SA(0, 1), cA + hstep, voffA);
    if (wr == 1) PG8_BAR;
    PG8_WAIT_V(2); PG8_BAR;
    PG8_STAGE(PG8_SB(1, 0), cB + kstep, voffB); PG8_STAGE(PG8_SA(1, 0), cA + kstep, voffA); PG8_STAGE(PG8_SB(1, 1), cB + hstep + kstep, voffB);
    PG8_WAIT_V(6); PG8_BAR;
    for (;;) {
        const bool has_next = S.next(ui + 1, nxt);
        const char* nA = has_next ? (const char*)(nxt.g ? g.A1 : g.A0) + (size_t)nxt.pm * tstep : cA; const char* nB = has_next ? (const char*)(nxt.g ? g.Bt1 : g.Bt0) + (size_t)nxt.pn * tstep : cB;
        for (int t = 0; t < nt; t += 2) {
            const bool last = (t == nt - 2);
            const char* a1 = cA + (size_t)(t + 1) * kstep;
            const char* a2 = last ? nA : cA + (size_t)(t + 2) * kstep; const char* b2 = last ? nB : cB + (size_t)(t + 2) * kstep;
            const char* a3 = a2 + kstep; const char* b3 = b2 + kstep;
            if constexpr (Epi::MIDSCALE) { if (t == nt / 2) E.midscale(acc, ui & 1, wr, fr); }
            PG8_LDB(B0, 0, 0); PG8_LDB(B1, 0, 1); PG8_SCHED; PG8_LDA(At, 0, 0); PG8_STAGE(PG8_SA(1, 1), a1 + hstep, voffA);
            PG8_WAIT_V(8); PG8_WAIT_L(0); PG8_BAR; PG8_MMA(0, 0, At, B0); PG8_MMA(0, 1, At, B1); PG8_BAR; PG8_SCHED;
            PG8_LDA(At, 0, 1); PG8_STAGE(PG8_SB(0, 0), b2, voffB); PG8_STAGE(PG8_SB(0, 1), b2 + hstep, voffB); PG8_STAGE(PG8_SA(0, 0), a2, voffA);
            PG8_WAIT_V(8); PG8_WAIT_L(0); PG8_BAR; PG8_MMA(1, 0, At, B0); PG8_MMA(1, 1, At, B1); PG8_BAR; PG8_SCHED;
            PG8_LDB(B0, 1, 0); PG8_LDB(B1, 1, 1); PG8_SCHED; PG8_LDA(At, 1, 0); PG8_STAGE(PG8_SA(0, 1), a2 + hstep, voffA);
            PG8_WAIT_V(8); PG8_WAIT_L(0); PG8_BAR; PG8_MMA(0, 0, At, B0); PG8_MMA(0, 1, At, B1); PG8_BAR; PG8_SCHED;
            PG8_LDA(At, 1, 1); PG8_STAGE(PG8_SB(1, 0), b3, voffB); PG8_STAGE(PG8_SB(1, 1), b3 + hstep, voffB); PG8_STAGE(PG8_SA(1, 0), a3, voffA);
            PG8_WAIT_V(8); PG8_WAIT_L(0); PG8_BAR; PG8_MMA(1, 0, At, B0); PG8_MMA(1, 1, At, B1); PG8_BAR; PG8_SCHED;
        }
        if (wr == 0) PG8_BAR;
        E(acc, cur, ui & 1, wr, wc, fr, fq);
        if (!has_next) break;
#pragma unroll
        for (int a = 0; a < 2; ++a)
#pragma unroll
            for (int b = 0; b < 2; ++b)
#pragma unroll
                for (int m = 0; m < 4; ++m)
#pragma unroll
                    for (int n = 0; n < 2; ++n) acc[a][b][m][n] = (f32x4){0.f, 0.f, 0.f, 0.f};
        cur = nxt; cA = nA; cB = nB; ++ui;
        E.unit_begin(cur, ui & 1, tid);
        if (wr == 1) PG8_BAR;
    }
    PG8_WAIT_V(0);
    PG8_BAR;
#undef PG8_SA
#undef PG8_SB
#undef PG8_STAGE
#undef PG8_LDA
#undef PG8_LDB
#undef PG8_MMA
#undef PG8_WAIT_V
#undef PG8_WAIT_L
#undef PG8_BAR
#undef PG8_SCHED
}
}
namespace pg8 {
__device__ __forceinline__ v4u pack8(const f32x4& v0, const f32x4& v1) { v4u w; w.x = pk2(v0[0], v0[1]); w.y = pk2(v0[2], v0[3]); w.z = pk2(v1[0], v1[1]); w.w = pk2(v1[2], v1[3]); return w; }
__device__ __forceinline__ float sq8(const f32x4& v0, const f32x4& v1) { return (v0[0] * v0[0] + v0[1] * v0[1]) + (v0[2] * v0[2] + v0[3] * v0[3]) + (v1[0] * v1[0] + v1[1] * v1[1]) + (v1[2] * v1[2] + v1[3] * v1[3]); }

struct Epi1 {
    static constexpr bool MIDSCALE = false;
    bf16 *QKV, *CQ, *CKV; float *SSQCQ, *SSQCKV;
    __device__ __forceinline__ void midscale(f32x4 (&)[2][2][4][2], int, int, int) const {}
    __device__ __forceinline__ void unit_begin(const Unit&, int, int) const {}
    __device__ __forceinline__ void operator()(const f32x4 (&acc)[2][2][4][2], const Unit& u, int par, int wr, int wc, int fr, int fq) const {
        const int pn = u.pn; bf16* base; int ldc, colt; float sc = 1.f; float* ssq = nullptr; int sslot = 0;
        if (pn < 12) { base = QKV; ldc = 3072; colt = pn * 256; if (pn < 4) sc = QSCALE_DIL; }
        else if (pn < 14) { base = CQ; ldc = 512; colt = (pn - 12) * 256; ssq = SSQCQ; sslot = (pn - 12) * 4 + wc; }
        else { base = CKV; ldc = 512; colt = (pn - 14) * 256; ssq = SSQCKV; sslot = (pn - 14) * 4 + wc; }
        const int row0 = u.pm * BM + wr * 64 + fr, col0 = colt + wc * 32 + 8 * fq;
#pragma unroll
        for (int ai = 0; ai < 2; ++ai)
#pragma unroll
            for (int m = 0; m < 4; ++m) { const int row = row0 + ai * HALF + m * 16; bf16* rowp = base + (size_t)row * ldc + col0; float ss = 0.f;
#pragma unroll
                for (int bj = 0; bj < 2; ++bj) { const f32x4 v0 = acc[ai][bj][m][0] * sc, v1 = acc[ai][bj][m][1] * sc; ss += sq8(v0, v1); *(v4u*)(rowp + bj * HALF) = pack8(v0, v1); }
                if (ssq) { ss += __shfl_xor(ss, 16); ss += __shfl_xor(ss, 32); if (fq == 0) ssq[(size_t)row * 8 + sslot] = ss; } }
    }
};

struct Epi2 {
    static constexpr bool MIDSCALE = false;
    bf16 *QN, *QPE, *KN, *VM; const float *SSQCQ, *SSQCKV; const f32x2* ROPE;
    __device__ __forceinline__ void midscale(f32x4 (&)[2][2][4][2], int, int, int) const {}
    __device__ __forceinline__ void unit_begin(const Unit&, int, int) const {}
    __device__ __forceinline__ void operator()(const f32x4 (&acc)[2][2][4][2], const Unit& u, int par, int wr, int wc, int fr, int fq) const {
        const int pn = u.pn; bf16* base; int ldc, colt; float sc = 1.f; bool rope = false; const float* ssq;
        if (u.g == 0) { ssq = SSQCQ; sc = QSCALE_MLA; if (pn < 4) { base = QN; ldc = 1024; colt = pn * 256; } else { base = QPE; ldc = 512; colt = (pn - 4) * 256; rope = true; } }
        else { ssq = SSQCKV; if (pn < 4) { base = KN; ldc = 1024; colt = pn * 256; } else { base = VM; ldc = 1024; colt = (pn - 4) * 256; } }
        const int row0 = u.pm * BM + wr * 64 + fr, col0 = colt + wc * 32 + 8 * fq;
#pragma unroll
        for (int ai = 0; ai < 2; ++ai)
#pragma unroll
            for (int m = 0; m < 4; ++m) { const int row = row0 + ai * HALF + m * 16; bf16* rowp = base + (size_t)row * ldc + col0;
                const f32x4 p0 = *(const f32x4*)(ssq + (size_t)row * 8), p1 = *(const f32x4*)(ssq + (size_t)row * 8 + 4);
                const float rs = rsqrtf(((p0[0] + p0[1]) + (p0[2] + p0[3]) + (p1[0] + p1[1]) + (p1[2] + p1[3])) * (1.f / 512.f) + EPS) * sc;
#pragma unroll
                for (int bj = 0; bj < 2; ++bj) { f32x4 v0 = acc[ai][bj][m][0] * rs, v1 = acc[ai][bj][m][1] * rs;
                    if (rope) { const int j0 = ((col0 + bj * HALF) & 63) >> 1; const f32x4* rp = (const f32x4*)(ROPE + (size_t)(row & (SEQ - 1)) * 32 + j0);
                        const f32x4 r0 = rp[0], r1 = rp[1];
                        f32x4 w0, w1;
                        w0[0] = v0[0] * r0[0] - v0[1] * r0[1]; w0[1] = v0[0] * r0[1] + v0[1] * r0[0];
                        w0[2] = v0[2] * r0[2] - v0[3] * r0[3]; w0[3] = v0[2] * r0[3] + v0[3] * r0[2];
                        w1[0] = v1[0] * r1[0] - v1[1] * r1[1]; w1[1] = v1[0] * r1[1] + v1[1] * r1[0];
                        w1[2] = v1[2] * r1[2] - v1[3] * r1[3]; w1[3] = v1[2] * r1[3] + v1[3] * r1[2];
                        v0 = w0; v1 = w1; }
                    *(v4u*)(rowp + bj * HALF) = pack8(v0, v1); } }
    }
};

struct Epi3 {
    static constexpr bool MIDSCALE = true;
    bf16* H1B; const float* X; const float* SSQO; float* SSQH; LAS f32x2* RS;
    __device__ __forceinline__ void unit_begin(const Unit& u, int par, int tid) const {
        if (tid < 256) { const f32x4* p = (const f32x4*)(SSQO + (size_t)(u.pm * BM + tid) * 16); const f32x4 a0 = p[0], a1 = p[1], b0 = p[2], b1 = p[3];
            const float ra = rsqrtf(((a0[0] + a0[1]) + (a0[2] + a0[3]) + (a1[0] + a1[1]) + (a1[2] + a1[3])) * (1.f / 1024.f) + EPS);
            const float rb = rsqrtf(((b0[0] + b0[1]) + (b0[2] + b0[3]) + (b1[0] + b1[1]) + (b1[2] + b1[3])) * (1.f / 1024.f) + EPS);
            f32x2 v; v.x = ra / rb; v.y = rb; RS[par * 256 + tid] = v; }
    }
    __device__ __forceinline__ void midscale(f32x4 (&acc)[2][2][4][2], int par, int wr, int fr) const {
#pragma unroll
        for (int ai = 0; ai < 2; ++ai)
#pragma unroll
            for (int m = 0; m < 4; ++m) { const float f = RS[par * 256 + ai * HALF + wr * 64 + m * 16 + fr].x;
#pragma unroll
                for (int bj = 0; bj < 2; ++bj) { acc[ai][bj][m][0] = acc[ai][bj][m][0] * f; acc[ai][bj][m][1] = acc[ai][bj][m][1] * f; } }
    }
    __device__ __forceinline__ void operator()(const f32x4 (&acc)[2][2][4][2], const Unit& u, int par, int wr, int wc, int fr, int fq) const {
        const int row0 = u.pm * BM + wr * 64 + fr, col0 = u.pn * BM + wc * 32 + 8 * fq, sslot = u.pn * 4 + wc;
#pragma unroll
        for (int ai = 0; ai < 2; ++ai)
#pragma unroll
            for (int m = 0; m < 4; ++m) { const int row = row0 + ai * HALF + m * 16; const float rb = RS[par * 256 + ai * HALF + wr * 64 + m * 16 + fr].y; float ss = 0.f;
#pragma unroll
                for (int bj = 0; bj < 2; ++bj) { const float* xp = X + (size_t)row * DM + col0 + bj * HALF; const f32x4 x0 = *(const f32x4*)xp, x1 = *(const f32x4*)(xp + 4);
                    const f32x4 v0 = acc[ai][bj][m][0] * rb + x0, v1 = acc[ai][bj][m][1] * rb + x1; ss += sq8(v0, v1);
                    *(v4u*)(H1B + (size_t)row * DM + col0 + bj * HALF) = pack8(v0, v1); }
                ss += __shfl_xor(ss, 16); ss += __shfl_xor(ss, 32); if (fq == 0) SSQH[(size_t)row * 32 + sslot] = ss; }
    }
};

struct Epi4 {
    static constexpr bool MIDSCALE = false;
    bf16* QP;
    __device__ __forceinline__ void midscale(f32x4 (&)[2][2][4][2], int, int, int) const {}
    __device__ __forceinline__ void unit_begin(const Unit&, int, int) const {}
    __device__ __forceinline__ void operator()(const f32x4 (&acc)[2][2][4][2], const Unit& u, int par, int wr, int wc, int fr, int fq) const {
        const int row0 = u.pm * BM + wr * 64 + fr, col0 = u.pn * BM + wc * 32 + 8 * fq;
#pragma unroll
        for (int ai = 0; ai < 2; ++ai)
#pragma unroll
            for (int m = 0; m < 4; ++m) { const int row = row0 + ai * HALF + m * 16;
#pragma unroll
                for (int bj = 0; bj < 2; ++bj) *(v4u*)(QP + (size_t)row * DM + col0 + bj * HALF) = pack8(acc[ai][bj][m][0], acc[ai][bj][m][1]); }
    }
};
struct EpiNull {
    static constexpr bool MIDSCALE = false;
    __device__ __forceinline__ void midscale(f32x4 (&)[2][2][4][2], int, int, int) const {}
    __device__ __forceinline__ void unit_begin(const Unit&, int, int) const {}
    __device__ __forceinline__ void operator()(const f32x4 (&acc)[2][2][4][2], const Unit& u, int par, int wr, int wc, int fr, int fq) const {
#pragma unroll
        for (int ai = 0; ai < 2; ++ai)
#pragma unroll
            for (int bj = 0; bj < 2; ++bj)
#pragma unroll
                for (int m = 0; m < 4; ++m)
#pragma unroll
                    for (int n = 0; n < 2; ++n) asm volatile("" :: "v"(acc[ai][bj][m][n]));
    }
};
}

__device__ __forceinline__ void kr_item64(const bf16* __restrict__ XN, const bf16* __restrict__ BT, const f32x2* __restrict__ ROPE, bf16* __restrict__ KPE, LAS f32x4* red, int item, int wave, int lane) {
    const int fr = lane & 15, fq = lane >> 4, rg = wave & 3, kh = wave >> 2, row = item * 64 + rg * 16 + fr;
    const bf16* ap = XN + (size_t)row * 2048 + kh * 1024 + fq * 8; const bf16* bp = BT + (size_t)fr * 2048 + kh * 1024 + fq * 8;
    f32x4 acc[4];
#pragma unroll
    for (int nb = 0; nb < 4; ++nb) acc[nb] = (f32x4){0.f, 0.f, 0.f, 0.f};
#pragma unroll 4
    for (int k0 = 0; k0 < 1024; k0 += 32) {
        const bf16x8 a = *(const bf16x8*)(ap + k0);
#pragma unroll
        for (int nb = 0; nb < 4; ++nb) { const bf16x8 b = *(const bf16x8*)(bp + (size_t)nb * 16 * 2048 + k0); acc[nb] = __builtin_amdgcn_mfma_f32_16x16x32_bf16(b, a, acc[nb], 0, 0, 0); }
    }
    if (kh == 1) {
#pragma unroll
        for (int nb = 0; nb < 4; ++nb) red[(rg * 4 + nb) * 64 + lane] = acc[nb];
    }
    __syncthreads();
    if (kh == 0) {
        const int pos = row & (SEQ - 1);
#pragma unroll
        for (int nb = 0; nb < 4; ++nb) { const int j0 = 8 * nb + 2 * fq; const f32x4 r = *(const f32x4*)(ROPE + (size_t)pos * 32 + j0); const f32x4 v = acc[nb] + red[(rg * 4 + nb) * 64 + lane];
            v2u o; o.x = pk2(v[0] * r[0] - v[1] * r[1], v[0] * r[1] + v[1] * r[0]); o.y = pk2(v[2] * r[2] - v[3] * r[3], v[2] * r[3] + v[3] * r[2]);
            *(v2u*)(KPE + (size_t)row * 64 + 16 * nb + 4 * fq) = o; }
    }
    __syncthreads();
}
namespace att {
typedef short v4i16_t __attribute__((ext_vector_type(4)));
#define MFMA32(a, b, c) __builtin_amdgcn_mfma_f32_32x32x16_bf16((a), (b), (c), 0, 0, 0)
__device__ __forceinline__ s16x4 vtr(const LAS unsigned char* p) { return __builtin_bit_cast(s16x4, __builtin_amdgcn_ds_read_tr16_b64_v4i16((LAS v4i16_t*)p)); }
__device__ __forceinline__ int crow(int r, int hi) { return (r & 3) + 8 * (r >> 2) + 4 * hi; }
constexpr int VS = 320;
constexpr int KS = 400;
constexpr float NEG = -1e30f;

__device__ __forceinline__ bf16x8 pack8r(const f32x16& p, int s) {
    v4u w; w.x = pk2(p[8 * s + 0], p[8 * s + 1]); w.y = pk2(p[8 * s + 2], p[8 * s + 3]); w.z = pk2(p[8 * s + 4], p[8 * s + 5]); w.w = pk2(p[8 * s + 6], p[8 * s + 7]);
    return __builtin_bit_cast(bf16x8, w);
}
__device__ __forceinline__ void pv32(f32x16 (&o)[4], const LAS unsigned char* vb, const bf16x8 pb0, const bf16x8 pb1) {
#pragma unroll
    for (int d = 0; d < 4; ++d) {
        const s16x4 l0 = vtr(vb + d * 64), h0 = vtr(vb + d * 64 + 8 * VS), l1 = vtr(vb + d * 64 + 16 * VS), h1 = vtr(vb + d * 64 + 24 * VS);
        const bf16x8 a0 = __builtin_shufflevector(l0, h0, 0, 1, 2, 3, 4, 5, 6, 7), a1 = __builtin_shufflevector(l1, h1, 0, 1, 2, 3, 4, 5, 6, 7);
        o[d] = MFMA32(a0, pb0, o[d]); o[d] = MFMA32(a1, pb1, o[d]);
    }
}
template <int NS>
__device__ __forceinline__ void softmax_step(f32x16 (&s)[NS], float& m, float& l, f32x16 (&o)[4], bf16x8 (&pb)[2 * NS]) {
    float mx = s[0][0];
#pragma unroll
    for (int t = 0; t < NS; ++t)
#pragma unroll
        for (int r = 0; r < 16; ++r) mx = fmaxf(mx, s[t][r]);
    mx = fmaxf(mx, __shfl_xor(mx, 32));
    const float mn = fmaxf(m, mx), alpha = __builtin_amdgcn_exp2f(m - mn); m = mn;
    float ps = 0.f;
#pragma unroll
    for (int t = 0; t < NS; ++t)
#pragma unroll
        for (int r = 0; r < 16; ++r) { const float p = __builtin_amdgcn_exp2f(s[t][r] - mn); s[t][r] = p; ps += p; }
    l = l * alpha + ps;
    if (!__all(alpha == 1.0f)) {
#pragma unroll
        for (int d = 0; d < 4; ++d) o[d] = o[d] * alpha;
    }
#pragma unroll
    for (int t = 0; t < NS; ++t) { pb[2 * t] = pack8r(s[t], 0); pb[2 * t + 1] = pack8r(s[t], 1); }
}
__device__ __forceinline__ void store_o(f32x16 (&o)[4], float l, bf16* __restrict__ orow  , float* __restrict__ ssq  , int hh) {
    l += __shfl_xor(l, 32);
    const float inv = 1.0f / l; float ss = 0.f;
#pragma unroll
    for (int d = 0; d < 4; ++d) { o[d] = o[d] * inv;
#pragma unroll
        for (int g = 0; g < 4; ++g) { const float a = o[d][4 * g], b = o[d][4 * g + 1], c = o[d][4 * g + 2], e = o[d][4 * g + 3];
            ss += (a * a + b * b) + (c * c + e * e);
            v2u w; w.x = pk2(a, b); w.y = pk2(c, e); *(v2u*)(orow + 32 * d + 8 * g + 4 * hh) = w; } }
    ss += __shfl_xor(ss, 32);
    if (hh == 0) *ssq = ss;
}

constexpr int KTB = 64 * KS, VTB = 64 * VS, BUFB = KTB + VTB;
__device__ __forceinline__ void mla_unit(const unsigned char* ws, LAS unsigned char* lds, int b, int h, int qblk, int tid, int wave, int lane) {
    const bf16* QN = (const bf16*)(ws + WS_QN); const bf16* QPE = (const bf16*)(ws + WS_QPE);
    bf16* O = (bf16*)(ws + WS_A); float* SSQO = (float*)(ws + WS_SSQO);
    const int r32 = lane & 31, hh = lane >> 5;
    const size_t tok0 = (size_t)b * SEQ;
    const int row_lo = qblk * 256 + wave * 32, qrow = row_lo + r32;
    bf16x8 qf[12];
    { const bf16* qn = QN + (tok0 + qrow) * 1024 + h * 128 + 8 * hh;
#pragma unroll
      for (int s = 0; s < 8; ++s) qf[s] = *(const bf16x8*)(qn + 16 * s);
      const bf16* qp = QPE + (tok0 + qrow) * 512 + h * 64 + 8 * hh;
#pragma unroll
      for (int s = 0; s < 4; ++s) qf[8 + s] = *(const bf16x8*)(qp + 16 * s); }
    const int c0 = tid, c1 = tid + 512;
    const unsigned okn0 = (unsigned)WS_KN + (unsigned)(((unsigned)tok0 + (c0 >> 4)) * 1024u + h * 128 + (c0 & 15) * 8) * 2u, okn1 = okn0 + 32u * 1024u * 2u;
    const unsigned okp = (unsigned)WS_KPE + (unsigned)(((unsigned)tok0 + (tid >> 3)) * 64u + (tid & 7) * 8) * 2u;
    const unsigned ov0 = okn0 + (unsigned)(WS_VM - WS_KN), ov1 = ov0 + 32u * 1024u * 2u;
    const int lkn0 = (c0 >> 4) * KS + (c0 & 15) * 16, lkn1 = (c1 >> 4) * KS + (c1 & 15) * 16, lkp = (tid >> 3) * KS + 256 + (tid & 7) * 16;
    const int lv0 = KTB + (c0 >> 4) * VS + (c0 & 15) * 16, lv1 = KTB + (c1 >> 4) * VS + (c1 & 15) * 16;
    v4u st0, st1, st2, st3, st4;
#define MLA_GLOAD(kt) do { const unsigned _o = (unsigned)(kt) * 131072u, _p = (unsigned)(kt) * 8192u; st0 = *(const v4u*)(ws + (size_t)(okn0 + _o)); st1 = *(const v4u*)(ws + (size_t)(okn1 + _o)); \
        st2 = *(const v4u*)(ws + (size_t)(okp + _p)); st3 = *(const v4u*)(ws + (size_t)(ov0 + _o)); st4 = *(const v4u*)(ws + (size_t)(ov1 + _o)); } while (0)
#define MLA_LWRITE(buf) do { LAS unsigned char* _b = lds + (buf) * BUFB; *(LAS v4u*)(_b + lkn0) = st0; *(LAS v4u*)(_b + lkn1) = st1; *(LAS v4u*)(_b + lkp) = st2; \
        *(LAS v4u*)(_b + lv0) = st3; *(LAS v4u*)(_b + lv1) = st4; } while (0)
    const int nkt = 4 * (qblk + 1);
    MLA_GLOAD(0); MLA_LWRITE(0);
    __syncthreads();
    f32x16 o[4];
#pragma unroll
    for (int d = 0; d < 4; ++d)
#pragma unroll
        for (int r = 0; r < 16; ++r) o[d][r] = 0.f;
    float m = NEG, l = 0.f;
    const int kread = r32 * KS + 16 * hh;
    const int vread = KTB + (4 * hh + ((lane & 15) >> 2)) * VS + (16 * ((lane >> 4) & 1) + 4 * (lane & 3)) * 2;
    for (int kt = 0; kt < nkt; ++kt) {
        if (kt + 1 < nkt) MLA_GLOAD(kt + 1);
        const int k0 = kt * 64;
        if (k0 <= row_lo + 31) {
            const LAS unsigned char* kb = lds + (kt & 1) * BUFB;
            const bool diag = (k0 + 63 > row_lo);
#pragma unroll
            for (int sub = 0; sub < 2; ++sub) {
                if (sub == 1 && k0 + 32 > row_lo + 31) break;
                f32x16 s[1];
#pragma unroll
                for (int r = 0; r < 16; ++r) s[0][r] = 0.f;
#pragma unroll
                for (int ks = 0; ks < 12; ++ks) { const bf16x8 kf = *(const LAS bf16x8*)(kb + kread + sub * 32 * KS + 32 * ks); s[0] = MFMA32(kf, qf[ks], s[0]); }
                if (diag) {
#pragma unroll
                    for (int r = 0; r < 16; ++r) { const int key = k0 + 32 * sub + crow(r, hh); if (key > qrow) s[0][r] = NEG; }
                }
                bf16x8 pb[2];
                softmax_step<1>(s, m, l, o, pb);
                pv32(o, kb + vread + sub * 32 * VS, pb[0], pb[1]);
            }
        }
        if (kt + 1 < nkt) MLA_LWRITE((kt + 1) & 1);
        __syncthreads();
    }
#undef MLA_GLOAD
#undef MLA_LWRITE
    store_o(o, l, O + (tok0 + qrow) * 2048 + 1024 + h * 128, SSQO + (tok0 + qrow) * 16 + 8 + h, hh);
}

constexpr int DKS = 272, DSH = 32 * DKS + 32 * VS;
__device__ __forceinline__ void dil_tile(const unsigned char* ws, LAS unsigned char* vl  , LAS unsigned char* sh  , int b, int h, int j, int r16, int tid, int lane) {
    const bf16* QKV = (const bf16*)(ws + WS_B);
    const int r32 = lane & 31, hh = lane >> 5;
    const size_t tok0 = (size_t)b * SEQ;
    const int tq = 512 * j + 16 * r32 + r16;
    bf16x8 qf[8];
    { const bf16* qp = QKV + (tok0 + tq) * 3072 + h * 128 + 8 * hh;
#pragma unroll
      for (int s = 0; s < 8; ++s) qf[s] = *(const bf16x8*)(qp + 16 * s); }
    const float slope2 = __builtin_amdgcn_exp2f(-(float)(h + 1)) * LOG2E;
    const int m0 = (j == 0) ? 4 : 0, n3 = j + 1, n2 = 8 - m0, n1 = 20 - m0, nt = n3 + n2;
    const unsigned kcol = (unsigned)WS_B + ((unsigned)tok0 * 3072u + 1024u + h * 128 + 8 * hh) * 2u;
    const unsigned vcol = (unsigned)WS_B + ((unsigned)tok0 * 3072u + 2048u + h * 128 + (lane & 15) * 8) * 2u;
    const int vrow = lane >> 4;
    const int vwr = vrow * VS + (lane & 15) * 16;
    const int vread = (4 * hh + ((lane & 15) >> 2)) * VS + (16 * ((lane >> 4) & 1) + 4 * (lane & 3)) * 2;
    int kbase, kstride, maxd;
#define DIL_DESC(idx) do { const int _i = (idx); if (_i < n3) { kbase = 512 * (j - _i) + r16; kstride = 16; maxd = 2048; } \
        else if (_i < n3 + n2) { kbase = 4 * (128 * j - 128 + 32 * (m0 + _i - n3)) + (r16 & 3); kstride = 4; maxd = 512; } \
        else { kbase = 512 * j - 128 + 32 * (m0 + _i - n3 - n2); kstride = 1; maxd = 128; } } while (0)
    bf16x8 kc[8]; v4u vn[8];
    DIL_DESC(0);
    { const unsigned kp = kcol + (unsigned)(kbase + kstride * r32) * 6144u;
#pragma unroll
      for (int s = 0; s < 8; ++s) kc[s] = *(const bf16x8*)(ws + (size_t)(kp + 32 * s));
#pragma unroll
      for (int i = 0; i < 8; ++i) vn[i] = *(const v4u*)(ws + (size_t)(vcol + (unsigned)(kbase + kstride * (4 * i + vrow)) * 6144u));
#pragma unroll
      for (int i = 0; i < 8; ++i) *(LAS v4u*)(vl + vwr + 4 * i * VS) = vn[i]; }
    f32x16 o[4];
#pragma unroll
    for (int d = 0; d < 4; ++d)
#pragma unroll
        for (int r = 0; r < 16; ++r) o[d][r] = 0.f;
    float m = NEG, l = 0.f;
    for (int idx = 0; idx < nt; ++idx) {
        const int cb = kbase, cs = kstride, cm = maxd;
        const bool more = idx + 1 < nt;
        if (more) {
            DIL_DESC(idx + 1);
#pragma unroll
            for (int i = 0; i < 8; ++i) vn[i] = *(const v4u*)(ws + (size_t)(vcol + (unsigned)(kbase + kstride * (4 * i + vrow)) * 6144u));
        }
        f32x16 s[1];
#pragma unroll
        for (int r = 0; r < 16; ++r) s[0][r] = 0.f;
#pragma unroll
        for (int ks = 0; ks < 8; ++ks) s[0] = MFMA32(kc[ks], qf[ks], s[0]);
        if (more) {
            const unsigned kp = kcol + (unsigned)(kbase + kstride * r32) * 6144u;
#pragma unroll
            for (int s2 = 0; s2 < 8; ++s2) kc[s2] = *(const bf16x8*)(ws + (size_t)(kp + 32 * s2));
        }
        const int d0 = tq - cb - cs * 4 * hh;
#pragma unroll
        for (int r = 0; r < 16; ++r) { const int dist = d0 - cs * ((r & 3) + 8 * (r >> 2)); const float v = s[0][r] - slope2 * (float)dist; s[0][r] = ((unsigned)dist <= (unsigned)cm) ? v : NEG; }
        bf16x8 pb[2];
        softmax_step<1>(s, m, l, o, pb);
        pv32(o, vl + vread, pb[0], pb[1]);
        if (more) {
#pragma unroll
            for (int i = 0; i < 8; ++i) *(LAS v4u*)(vl + vwr + 4 * i * VS) = vn[i];
        }
    }
#undef DIL_DESC
    {
        const int kb0 = 512 * j - 128 + 32 * m0;
        const int row = tid >> 4, ch = tid & 15;
        const unsigned gk = (unsigned)WS_B + (((unsigned)tok0 + kb0 + row) * 3072u + 1024u + h * 128 + ch * 8) * 2u;
        const int lk = row * DKS + ch * 16, lv = 32 * DKS + row * VS + ch * 16;
        const int kread = r32 * DKS + 16 * hh;
        const int vread1 = 32 * DKS + (4 * hh + ((lane & 15) >> 2)) * VS + (16 * ((lane >> 4) & 1) + 4 * (lane & 3)) * 2;
        v4u sk = *(const v4u*)(ws + (size_t)gk), sv = *(const v4u*)(ws + (size_t)(gk + 2048u));
        *(LAS v4u*)(sh + lk) = sk; *(LAS v4u*)(sh + lv) = sv;
        __syncthreads();
        for (int mi = 0; mi < n1; ++mi) {
            const bool more = mi + 1 < n1;
            if (more) { const unsigned g2 = gk + (unsigned)(mi + 1) * 32u * 6144u; sk = *(const v4u*)(ws + (size_t)g2); sv = *(const v4u*)(ws + (size_t)(g2 + 2048u)); }
            const LAS unsigned char* tb = sh + (mi & 1) * DSH;
            f32x16 s[1];
#pragma unroll
            for (int r = 0; r < 16; ++r) s[0][r] = 0.f;
#pragma unroll
            for (int ks = 0; ks < 8; ++ks) { const bf16x8 kf = *(const LAS bf16x8*)(tb + kread + 32 * ks); s[0] = MFMA32(kf, qf[ks], s[0]); }
            const int d0 = tq - (kb0 + 32 * mi) - 4 * hh;
#pragma unroll
            for (int r = 0; r < 16; ++r) { const int dist = d0 - ((r & 3) + 8 * (r >> 2)); const float v = s[0][r] - slope2 * (float)dist; s[0][r] = ((unsigned)dist <= 128u) ? v : NEG; }
            bf16x8 pb[2];
            softmax_step<1>(s, m, l, o, pb);
            pv32(o, tb + vread1, pb[0], pb[1]);
            if (more) { LAS unsigned char* nb = sh + ((mi + 1) & 1) * DSH; *(LAS v4u*)(nb + lk) = sk; *(LAS v4u*)(nb + lv) = sv; }
            __syncthreads();
        }
    }
    store_o(o, l, (bf16*)(const_cast<unsigned char*>(ws) + WS_A) + (tok0 + tq) * 2048 + h * 128, (float*)(const_cast<unsigned char*>(ws) + WS_SSQO) + (tok0 + tq) * 16 + h, hh);
}

__device__ __forceinline__ void phase_attn(const Params& P, LAS unsigned char* lds, int vcu, int G, int wave) {
    const int lane = hw_lane(), tid = wave * 64 + lane;
    const unsigned char* ws = P.ws;
#ifndef REP_MLA
#define REP_MLA 1
#endif
#ifndef REP_DIL
#define REP_DIL 1
#endif
    for (int rm_ = 0; rm_ < REP_MLA; ++rm_)
    for (int u = vcu; u < 256; u += G) { const int bh = u >> 2, pr = u & 3;
        mla_unit(ws, lds, bh >> 3, bh & 7, 7 - pr, tid, wave, lane);
        mla_unit(ws, lds, bh >> 3, bh & 7, pr, tid, wave, lane); }
    __syncthreads();
    LAS unsigned char* vl = lds + wave * (32 * VS); LAS unsigned char* sh = lds + NWAVES * (32 * VS);
    for (int rd_ = 0; rd_ < REP_DIL; ++rd_)
    if (G == 256) {
#pragma unroll 1
        for (int k = 0; k < 2; ++k) { const int t = (vcu >> 5) * 512 + k * 256 + (vcu & 31) * 8 + wave; const int bh = t >> 6, rem = t & 63, jj = rem >> 4, r16 = rem & 15;
            dil_tile(ws, vl, sh, bh >> 3, bh & 7, k == 0 ? jj : 3 - jj, r16, tid, lane); }
    } else {
#pragma unroll 1
        for (int t = vcu * 8 + wave; t < 4096; t += G * 8) { const int bh = t >> 6, rem = t & 63; dil_tile(ws, vl, sh, bh >> 3, bh & 7, rem >> 4, rem & 15, tid, lane); }
    }
}
}
namespace peer {
typedef __bf16 bf2_t __attribute__((ext_vector_type(2)));
#define MFMA32(a, b, c) __builtin_amdgcn_mfma_f32_32x32x16_bf16((a), (b), (c), 0, 0, 0)
__device__ __forceinline__ float fmax3(float a, float b, float c) { return fmaxf(fmaxf(a, b), c); }
__device__ __forceinline__ float asf(unsigned u) { return __builtin_bit_cast(float, u); }
__device__ __forceinline__ unsigned asu(float f) { return __builtin_bit_cast(unsigned, f); }

__device__ __forceinline__ void ce_desc(float& a, float& b) { const float hi = fmaxf(a, b), lo = fminf(a, b); a = hi; b = lo; }
template <bool DESC> __device__ __forceinline__ void bitonic_merge16(float (&t)[16]) {
#pragma unroll
    for (int j = 8; j > 0; j >>= 1)
#pragma unroll
        for (int i = 0; i < 16; ++i) { const int l = i ^ j; if (l > i) { if (DESC) ce_desc(t[i], t[l]); else ce_desc(t[l], t[i]); } }
}
__device__ __forceinline__ void top16_of_64(float (&v)[64], float (&out)[16]) {
#pragma unroll
    for (int k = 2; k <= 16; k <<= 1)
#pragma unroll
        for (int j = k >> 1; j > 0; j >>= 1)
#pragma unroll
            for (int i = 0; i < 64; ++i) { const int l = i ^ j; if (l > i) { if ((i & k) == 0) ce_desc(v[i], v[l]); else ce_desc(v[l], v[i]); } }
    float t0[16], t1[16];
#pragma unroll
    for (int i = 0; i < 16; ++i) { t0[i] = fmaxf(v[i], v[16 + i]); t1[i] = fmaxf(v[32 + i], v[48 + i]); }
    bitonic_merge16<true>(t0); bitonic_merge16<false>(t1);
#pragma unroll
    for (int i = 0; i < 16; ++i) out[i] = fmaxf(t0[i], t1[i]);
    bitonic_merge16<true>(out);
}
__device__ __forceinline__ void route_item(const unsigned char* ws, LAS unsigned* sc, int tile, int h, int lane) {
    const bf16* QP = (const bf16*)(ws + WS_QP); const bf16* SK = (const bf16*)(ws + WS_SK);
    int* RIDX = (int*)(ws + WS_RIDX); float* RGATE = (float*)(ws + WS_RGATE);
    const int r32 = lane & 31, hh = lane >> 5;
    const size_t tok = (size_t)tile * 32 + r32;
    float rs2; { const f32x4* sp = (const f32x4*)((const float*)(ws + WS_SSQH) + tok * 32); f32x4 a = sp[0];
#pragma unroll
        for (int i = 1; i < 8; ++i) a = a + sp[i];
        rs2 = rsqrtf(((a[0] + a[1]) + (a[2] + a[3])) * (1.f / 2048.f) + EPS); }
#pragma unroll 1
    for (int p = 0; p < 2; ++p) {
        f32x16 s[4];
#pragma unroll
        for (int kb = 0; kb < 4; ++kb)
#pragma unroll
            for (int r = 0; r < 16; ++r) s[kb][r] = 0.f;
        const bf16* qp = QP + tok * 2048 + h * 256 + p * 128 + 8 * hh;
        const bf16* kp = SK + ((size_t)(h * 2 + p) * 128 + r32) * 128 + 8 * hh;
#pragma unroll
        for (int ks = 0; ks < 8; ++ks) { const bf16x8 q = *(const bf16x8*)(qp + 16 * ks);
#pragma unroll
            for (int kb = 0; kb < 4; ++kb) { const bf16x8 k = *(const bf16x8*)(kp + (size_t)kb * 32 * 128 + 16 * ks); s[kb] = MFMA32(k, q, s[kb]); } }
#pragma unroll
        for (int kb = 0; kb < 4; ++kb)
#pragma unroll
            for (int r = 0; r < 16; ++r) s[kb][r] = asf((asu(s[kb][r] * rs2) & ~127u) | (unsigned)(32 * kb + (r & 3) + 8 * (r >> 2) + 4 * hh));
        {
            float v[64], u[16];
#pragma unroll
            for (int kb = 0; kb < 4; ++kb)
#pragma unroll
                for (int r = 0; r < 16; ++r) v[16 * kb + r] = s[kb][r];
            top16_of_64(v, u);
            float w[16];
#pragma unroll
            for (int i = 0; i < 16; ++i) w[i] = fmaxf(u[i], __shfl_xor(u[15 - i], 32));
            bitonic_merge16<true>(w);
            if (hh == 0) {
#pragma unroll
                for (int i = 0; i < 16; i += 4) *(LAS v4u*)(sc + (p * 32 + r32) * 16 + i) = (v4u){asu(w[i]), asu(w[i + 1]), asu(w[i + 2]), asu(w[i + 3])};
            }
        }
    }
    unsigned t1[16], t2[16];
#pragma unroll
    for (int i = 0; i < 16; i += 4) { const v4u a = *(const LAS v4u*)(sc + r32 * 16 + i), b = *(const LAS v4u*)(sc + (32 + r32) * 16 + i);
        t1[i] = a.x; t1[i + 1] = a.y; t1[i + 2] = a.z; t1[i + 3] = a.w; t2[i] = b.x; t2[i + 1] = b.y; t2[i + 2] = b.z; t2[i + 3] = b.w; }
    float c[64]; int n = 0;
#pragma unroll
    for (int i = 0; i < 16; ++i)
#pragma unroll
        for (int j = 0; j < 16; ++j) if ((i + 1) * (j + 1) <= 16) { const float v = asf(t1[i] & ~127u) + asf(t2[j] & ~127u); c[n] = asf((asu(v) & ~255u) | (unsigned)(i * 16 + j)); ++n; }
#pragma unroll
    for (int q = 50; q < 64; ++q) c[q] = -3.0e38f;
    float top[16];
    top16_of_64(c, top);
    float best[8]; const float bmax = asf(asu(top[0]) & ~255u); float esum = 0.f;
#pragma unroll
    for (int k = 0; k < 16; ++k) { esum += __expf(asf(asu(top[k]) & ~255u) - bmax); if ((k >> 3) == hh) best[k & 7] = top[k]; }
    const float inv = 1.0f / esum;
    int idx[8]; float gate[8];
#pragma unroll
    for (int k = 0; k < 8; ++k) { const unsigned code = asu(best[k]) & 255u; const unsigned a = sc[r32 * 16 + (code >> 4)], b = sc[(32 + r32) * 16 + (code & 15)];
        idx[k] = (int)((a & 127u) * 128u + (b & 127u)); gate[k] = __expf(asf(asu(best[k]) & ~255u) - bmax) * inv; }
    int* ip = RIDX + tok * 128 + h * 16 + 8 * hh; float* gp = RGATE + tok * 128 + h * 16 + 8 * hh;
    *(v4u*)ip = (v4u){(unsigned)idx[0], (unsigned)idx[1], (unsigned)idx[2], (unsigned)idx[3]}; *(v4u*)(ip + 4) = (v4u){(unsigned)idx[4], (unsigned)idx[5], (unsigned)idx[6], (unsigned)idx[7]};
    *(f32x4*)gp = (f32x4){gate[0], gate[1], gate[2], gate[3]}; *(f32x4*)(gp + 4) = (f32x4){gate[4], gate[5], gate[6], gate[7]};
}

__device__ __forceinline__ void phase_route(const Params& P, LAS unsigned char* lds, int vcu, int G, int wave) {
    const int lane = hw_lane();
    LAS unsigned* sc = (LAS unsigned*)(lds + wave * 4096);
#pragma unroll 1
    for (int it = vcu * NWAVES + wave; it < 512 * 8; it += G * NWAVES) route_item(P.ws, sc, it >> 3, it & 7, lane);
}

__device__ __forceinline__ float dot16_f8(const float (&x)[16], const v4u& u, float c) {
    const int u0 = (int)u.x, u1 = (int)u.y, u2 = (int)u.z, u3 = (int)u.w;
    const f32x2 a0 = __builtin_amdgcn_cvt_pk_f32_fp8(u0, false), a1 = __builtin_amdgcn_cvt_pk_f32_fp8(u0, true);
    const f32x2 a2 = __builtin_amdgcn_cvt_pk_f32_fp8(u1, false), a3 = __builtin_amdgcn_cvt_pk_f32_fp8(u1, true);
    const f32x2 a4 = __builtin_amdgcn_cvt_pk_f32_fp8(u2, false), a5 = __builtin_amdgcn_cvt_pk_f32_fp8(u2, true);
    const f32x2 a6 = __builtin_amdgcn_cvt_pk_f32_fp8(u3, false), a7 = __builtin_amdgcn_cvt_pk_f32_fp8(u3, true);
    c = fmaf(x[0], a0.x, c); c = fmaf(x[1], a0.y, c); c = fmaf(x[2], a1.x, c); c = fmaf(x[3], a1.y, c);
    c = fmaf(x[4], a2.x, c); c = fmaf(x[5], a2.y, c); c = fmaf(x[6], a3.x, c); c = fmaf(x[7], a3.y, c);
    c = fmaf(x[8], a4.x, c); c = fmaf(x[9], a4.y, c); c = fmaf(x[10], a5.x, c); c = fmaf(x[11], a5.y, c);
    c = fmaf(x[12], a6.x, c); c = fmaf(x[13], a6.y, c); c = fmaf(x[14], a7.x, c); c = fmaf(x[15], a7.y, c);
    return c;
}
__device__ __forceinline__ void unpack8(float* x, const v4u& v) { x[0] = bflo(v.x); x[1] = bfhi(v.x); x[2] = bflo(v.y); x[3] = bfhi(v.y); x[4] = bflo(v.z); x[5] = bfhi(v.z); x[6] = bflo(v.w); x[7] = bfhi(v.w); }
#ifndef U_WAVES
#define U_WAVES 8
#endif
__device__ __forceinline__ void peer_u_wave(const Params& P, LAS unsigned* sc  , int t0, int tstep, int tend, int lane) {
    const unsigned char* ws = P.ws;
    const bf16* H1B = (const bf16*)(ws + WS_B); const unsigned char* U8 = ws + WS_UB;
    const int* RIDX = (const int*)(ws + WS_RIDX); const float* RGATE = (const float*)(ws + WS_RGATE); const float* SSQH = (const float*)(ws + WS_SSQH);
    const unsigned long long ltmask = (1ull << lane) - 1ull;
    unsigned* PKV = (unsigned*)(ws + WS_PKV);
    if (t0 >= tend) return;
    int i0, i1; float g0, g1, rs2; float x[32];
    int i0n, i1n; float g0n, g1n, ssn; v4u xa, xb, xc, xd;
#define PU_META(t) do { const size_t _t = (size_t)(t); const bf16* hp = H1B + _t * 2048 + 32 * lane; xa = *(const v4u*)hp; xb = *(const v4u*)(hp + 8); xc = *(const v4u*)(hp + 16); xd = *(const v4u*)(hp + 24); \
        ssn = lane < 32 ? SSQH[_t * 32 + lane] : 0.f; i0n = RIDX[_t * 128 + lane]; i1n = RIDX[_t * 128 + 64 + lane]; g0n = RGATE[_t * 128 + lane]; g1n = RGATE[_t * 128 + 64 + lane]; } while (0)
#define PU_SORT() do {   \
        { const int q0 = i0n >> 10, q1 = i1n >> 10; int off = 0, pos0 = 0, pos1 = 0; \
          _Pragma("unroll") for (int gq = 0; gq < 16; ++gq) { const unsigned long long m0 = __ballot(q0 == gq), m1 = __ballot(q1 == gq); const int c0 = __popcll(m0), c1 = __popcll(m1); \
              if (q0 == gq) pos0 = off + __popcll(m0 & ltmask); if (q1 == gq) pos1 = off + c0 + __popcll(m1 & ltmask); off += c0 + c1; } \
          sc[pos0] = (unsigned)i0n; sc[pos1] = (unsigned)i1n; sc[128 + pos0] = asu(g0n); sc[128 + pos1] = asu(g1n); \
          i0n = (int)sc[lane]; i1n = (int)sc[64 + lane]; g0n = asf(sc[128 + lane]); g1n = asf(sc[192 + lane]); } } while (0)
#define PU_SWAP() do { i0 = i0n; i1 = i1n; g0 = g0n; g1 = g1n; \
        unpack8(x, xa); unpack8(x + 8, xb); unpack8(x + 16, xc); unpack8(x + 24, xd); \
        rs2 = rsqrtf(wave_sum(ssn) * (1.f / 2048.f) + EPS) * (1.f / U6_SCALE); } while (0)
#define PU_LOAD(buf4, buf2, ia, ib, g) do { _Pragma("unroll") for (int e = 0; e < 8; ++e) { const int row = __builtin_amdgcn_readlane((g) < 8 ? ia : ib, ((g) & 7) * 8 + e); \
        const unsigned char* up = U8 + (size_t)row * 1536 + 16 * lane; buf4[e] = *(const v4u*)up; buf2[e] = *(const v2u*)(up + 1024 - 8 * lane); } } while (0)
#define PU_COMPUTE(buf4, buf2, g) do { float pt[8]; _Pragma("unroll") for (int e = 0; e < 8; ++e) { \
            const f32x32 r = __builtin_amdgcn_cvt_scalef32_pk32_f32_fp6((v6u){buf4[e].x, buf4[e].y, buf4[e].z, buf4[e].w, buf2[e].x, buf2[e].y}, 1.0f); \
            float s0 = 0.f, s1 = 0.f; _Pragma("unroll") for (int k = 0; k < 16; ++k) { s0 = fmaf(x[k], r[2 * k], s0); s1 = fmaf(x[16 + k], r[2 * k + 1], s1); } pt[e] = s0 + s1; }     \
        float a4[4], a2[2], a1; \
        _Pragma("unroll") for (int i = 0; i < 4; ++i) { const float keep = (lane & 1) ? pt[2 * i + 1] : pt[2 * i], give = (lane & 1) ? pt[2 * i] : pt[2 * i + 1]; a4[i] = keep + __shfl_xor(give, 1); } \
        _Pragma("unroll") for (int i = 0; i < 2; ++i) { const float keep = (lane & 2) ? a4[2 * i + 1] : a4[2 * i], give = (lane & 2) ? a4[2 * i] : a4[2 * i + 1]; a2[i] = keep + __shfl_xor(give, 2); } \
        { const float keep = (lane & 4) ? a2[1] : a2[0], give = (lane & 4) ? a2[0] : a2[1]; a1 = keep + __shfl_xor(give, 4); } \
        a1 += __shfl_xor(a1, 8); a1 += __shfl_xor(a1, 16); a1 += __shfl_xor(a1, 32); \
        if ((lane >> 3) == ((g) & 7)) { if ((g) < 8) d0 = a1; else d1 = a1; } } while (0)
    v4u ra4[8], rb4[8]; v2u ra2[8], rb2[8];
    PU_META(t0); PU_SORT(); PU_SWAP();
    PU_LOAD(ra4, ra2, i0, i1, 0);
#pragma unroll 1
    for (int t = t0; t < tend; t += tstep) {
        const bool more = t + tstep < tend;
        float d0 = 0.f, d1 = 0.f;
#pragma unroll 1
        for (int g = 0; g < 16; g += 2) {
            PU_LOAD(rb4, rb2, i0, i1, g + 1);
            if (g == 10 && more) PU_META(t + tstep);
            PU_COMPUTE(ra4, ra2, g);
            if (g + 2 < 16) PU_LOAD(ra4, ra2, i0, i1, g + 2); else if (more) { PU_SORT(); PU_LOAD(ra4, ra2, i0n, i1n, 0); }
            PU_COMPUTE(rb4, rb2, g + 1);
        }
        const size_t tok = (size_t)t;
        const float z0 = d0 * rs2, z1 = d1 * rs2;
        const float a0 = 8.0f * z0 * (1.0f + erff(z0 * 0.7071067811865476f)) * g0, a1v = 8.0f * z1 * (1.0f + erff(z1 * 0.7071067811865476f)) * g1;
        unsigned* pk = PKV + ((tok >> 6) * 128) * 64 + (tok & 63) * 4;
        pk[(size_t)(lane >> 2) * 256 + (lane & 3)] = ((unsigned)i0 << 2) | ((unsigned)__builtin_bit_cast(unsigned short, (_Float16)a0) << 16);
        pk[(size_t)(16 + (lane >> 2)) * 256 + (lane & 3)] = ((unsigned)i1 << 2) | ((unsigned)__builtin_bit_cast(unsigned short, (_Float16)a1v) << 16);
        if (more) PU_SWAP();
    }
#undef PU_META
#undef PU_SORT
#undef PU_SWAP
#undef PU_LOAD
#undef PU_COMPUTE
}
__device__ __forceinline__ void phase_peer_u(const Params& P, LAS unsigned char* lds, int vcu, int G, int wave) {
    const int lane = hw_lane();
    if (wave >= U_WAVES) return;
    peer_u_wave(P, (LAS unsigned*)(lds + wave * 1024), vcu * U_WAVES + wave, G * U_WAVES, M, lane);
}
typedef _Float16 h2_t __attribute__((ext_vector_type(2)));
__device__ __forceinline__ void peer_v_range(const Params& P, int c, int b0, int b1, int wv, int nwv, int lane) {
    const unsigned char* ws = P.ws;
    const bf16* H1B = (const bf16*)(ws + WS_B); const unsigned* PKV = (const unsigned*)(ws + WS_PKV);
    if (b0 + wv >= b1) return;
    unsigned w0[16], w1[16], w2[16], w3[16];
#define PV_LOAD(buf) do { _Pragma("unroll") for (int q = 0; q < 4; ++q) { const v4u t4 = pl[q * 64]; buf[4 * q] = t4.x; buf[4 * q + 1] = t4.y; buf[4 * q + 2] = t4.z; buf[4 * q + 3] = t4.w; } pl += 4 * 64; asm volatile("" : "+v"(pl)); } while (0)
#define PV_PROC(buf) do { v2u vv[16]; _Pragma("unroll") for (int i = 0; i < 16; ++i) vv[i] = *(const LAS v2u*)(size_t)((buf[i] << 1) & 0x1fff8u);     \
        _Pragma("unroll") for (int i = 0; i < 16; ++i) { const _Float16 ah = __builtin_bit_cast(_Float16, (unsigned short)(buf[i] >> 16)); const h2_t a2 = {ah, ah}; \
            y0 = __builtin_elementwise_fma(a2, __builtin_bit_cast(h2_t, __builtin_amdgcn_cvt_scalef32_pk_f16_fp8(vv[i].x, 1.0f, false)), y0); \
            y1 = __builtin_elementwise_fma(a2, __builtin_bit_cast(h2_t, __builtin_amdgcn_cvt_scalef32_pk_f16_fp8(vv[i].x, 1.0f, true)), y1); \
            y2 = __builtin_elementwise_fma(a2, __builtin_bit_cast(h2_t, __builtin_amdgcn_cvt_scalef32_pk_f16_fp8(vv[i].y, 1.0f, false)), y2); \
            y3 = __builtin_elementwise_fma(a2, __builtin_bit_cast(h2_t, __builtin_amdgcn_cvt_scalef32_pk_f16_fp8(vv[i].y, 1.0f, true)), y3); } } while (0)
    const v4u* pl = (const v4u*)PKV + (size_t)(b0 + wv) * 32 * 64 + lane;
    PV_LOAD(w0); PV_LOAD(w1); PV_LOAD(w2);
    v4u hxn = *(const v4u*)(H1B + ((size_t)(b0 + wv) * 64 + lane) * 2048 + 8 * c);
#pragma unroll 1
    for (int b = b0 + wv; b < b1; b += nwv) {
        const size_t tok = (size_t)b * 64 + lane;
        const int bn = (b + nwv < b1) ? b + nwv : b;
        h2_t y0 = {0, 0}, y1 = {0, 0}, y2 = {0, 0}, y3 = {0, 0};
        v4u hx = hxn;
#pragma unroll 1
        for (int half = 0; half < 2; ++half) {
            PV_LOAD(w3); PV_PROC(w0);
            if (half == 1) { hxn = *(const v4u*)(H1B + ((size_t)bn * 64 + lane) * 2048 + 8 * c); pl += (ptrdiff_t)(bn - b - 1) * 32 * 64; }
            PV_LOAD(w0); PV_PROC(w1);
            PV_LOAD(w1); PV_PROC(w2);
            PV_LOAD(w2); PV_PROC(w3);
        }
        float y[8]; unpack8(y, hx);
        constexpr float S = 1.0f / 32.0f;
        y[0] += S * (float)y0[0]; y[1] += S * (float)y0[1]; y[2] += S * (float)y1[0]; y[3] += S * (float)y1[1];
        y[4] += S * (float)y2[0]; y[5] += S * (float)y2[1]; y[6] += S * (float)y3[0]; y[7] += S * (float)y3[1];
        float* op = P.out + tok * 2048 + 8 * c;
        *(f32x4*)op = (f32x4){y[0], y[1], y[2], y[3]}; *(f32x4*)(op + 4) = (f32x4){y[4], y[5], y[6], y[7]};
    }
#undef PV_LOAD
#undef PV_PROC
}
__device__ __forceinline__ void peer_v_fill(const Params& P, int c, int tid) {
    const v4u* src = (const v4u*)(P.ws + WS_VB + (size_t)c * 131072);
#pragma unroll 4
    for (int i = tid; i < 8192; i += NTHREADS) *(LAS v4u*)(size_t)(16 * i) = src[i];
}
__device__ __forceinline__ void phase_final(const Params& P, int vcu, int G, int wave) {
    const int lane = hw_lane();
    const bool poison = __hip_atomic_load((const unsigned*)(P.ws + WS_CTL) + CW_FLAG, __ATOMIC_RELAXED, __HIP_MEMORY_SCOPE_AGENT) != 0u;
    f32x4 gv[8];
#pragma unroll
    for (int j = 0; j < 8; ++j) gv[j] = ((const f32x4*)P.lnf)[lane + 64 * j];
#pragma unroll 1
    for (int t = vcu * NWAVES + wave; t < M; t += G * NWAVES) {
        f32x4* row = (f32x4*)(P.out + (size_t)t * 2048) + lane;
        f32x4 v[8]; float s = 0.f;
#pragma unroll
        for (int j = 0; j < 8; ++j) { v[j] = row[64 * j]; s += (v[j].x * v[j].x + v[j].y * v[j].y) + (v[j].z * v[j].z + v[j].w * v[j].w); }
        const float rs = poison ? __builtin_nanf("") : rsqrtf(wave_sum(s) * (1.f / 2048.f) + EPS);
#pragma unroll
        for (int j = 0; j < 8; ++j) row[64 * j] = v[j] * rs * gv[j];
    }
}
#undef MFMA32
}
#define XB_TMO      128
#define XB_XCNT(j)  (256  + 64 * (j))
#define XB_XSUB(j)  (1280 + 64 * (j))
#define XB_XGEN(j)  (2304 + 64 * (j))
#define XB_TOP      3328
#define XB_TOPGEN   3392
#define XCD_BAR_WORDS 3456
#define XB_SPIN_CAP (1u << 22)
__device__ __forceinline__ unsigned xb_ld(unsigned* p)              { return __hip_atomic_load(p, __ATOMIC_RELAXED, __HIP_MEMORY_SCOPE_AGENT); }
__device__ __forceinline__ unsigned xb_add(unsigned* p, unsigned v) { return __hip_atomic_fetch_add(p, v, __ATOMIC_RELAXED, __HIP_MEMORY_SCOPE_AGENT); }
__device__ __forceinline__ unsigned xb_xcc_id() { return (unsigned)__builtin_amdgcn_s_getreg((3 << 11) | 20) & 0xFu; }
#define XB_SPIN(cond, bar) do { unsigned _sp = 0; while (cond) { __builtin_amdgcn_s_sleep(1); \
    if ((++_sp & 255u) == 0u) { if (xb_ld(&(bar)[XB_TMO])) break; if (_sp > XB_SPIN_CAP) { atomicAdd(&(bar)[XB_TMO], 1u); break; } } } } while (0)
struct XcdBarrier { unsigned* bar; unsigned x; volatile LAS unsigned* st; };
__device__ __forceinline__ XcdBarrier xcd_barrier_post(unsigned* bar, volatile LAS unsigned* st, bool leader) {
    XcdBarrier b; b.bar = bar; b.x = xb_xcc_id(); b.st = st;
    if (leader) (void)xb_add(&bar[XB_XCNT(b.x)], 1u);
    return b;
}
__device__ __forceinline__ void xcd_barrier_complete(unsigned* bar, unsigned x, unsigned& nloc, unsigned& nx) {
    const unsigned G = gridDim.x * gridDim.y * gridDim.z;
    unsigned sum, cnt, mine, sp = 0u;
    for (;;) {
        sum = 0u; cnt = 0u; mine = 0u;
#pragma unroll
        for (unsigned j = 0; j < 16; ++j) { const unsigned c = xb_ld(&bar[XB_XCNT(j)]); sum += c; cnt += (c > 0u) ? 1u : 0u; mine = (j == x) ? c : mine; }
        if (sum == G) break;
        __builtin_amdgcn_s_sleep(1);
        if ((++sp & 255u) == 0u) { if (xb_ld(&bar[XB_TMO])) break; if (sp > XB_SPIN_CAP) { atomicAdd(&bar[XB_TMO], 1u); break; } }
    }
    nloc = mine > 0u ? mine : 1u; nx = cnt > 0u ? cnt : 1u;
}
__device__ __forceinline__ void xcd_barrier(const XcdBarrier& b, int wave) {
    asm volatile("s_waitcnt vmcnt(0)" ::: "memory");
    __syncthreads();
    if (wave == 0 && hw_lane() == 0) {
        unsigned* bar = b.bar;
        __builtin_amdgcn_s_waitcnt(0);
        unsigned nloc = b.st[0], nx = b.st[1];
        if (nloc == 0u) { xcd_barrier_complete(bar, b.x, nloc, nx); b.st[0] = nloc; b.st[1] = nx; }
        const unsigned old = xb_add(&bar[XB_XSUB(b.x)], 1u);
        const unsigned gen = old / nloc;
        if (old + 1u == (gen + 1u) * nloc) {
            __builtin_amdgcn_fence(__ATOMIC_RELEASE, "agent");
            asm volatile("s_waitcnt vmcnt(0)" ::: "memory");
            const unsigned og = xb_add(&bar[XB_TOP], 1u);
            const unsigned tg = og / nx;
            if (og + 1u == (tg + 1u) * nx) xb_add(&bar[XB_TOPGEN], 1u);
            else XB_SPIN(xb_ld(&bar[XB_TOPGEN]) == tg, bar);
            __builtin_amdgcn_fence(__ATOMIC_ACQUIRE, "agent");
            xb_add(&bar[XB_XGEN(b.x)], 1u);
            asm volatile("s_waitcnt vmcnt(0)" ::: "memory");
        } else {
            XB_SPIN(xb_ld(&bar[XB_XGEN(b.x)]) == gen, bar);
            __builtin_amdgcn_fence(__ATOMIC_ACQUIRE, "agent");
            asm volatile("s_waitcnt vmcnt(0)" ::: "memory");
        }
    }
    __syncthreads();
}
constexpr int N_PHASES = 10;
#ifndef REP_PHASE
#define REP_PHASE -1
#endif
#ifndef REP_N
#define REP_N 1
#endif
#ifndef EXTRA_SYNCS
#define EXTRA_SYNCS 0
#endif
__global__ void __launch_bounds__(NTHREADS, 2) mega(Params P) {
    extern __shared__ __attribute__((aligned(16))) unsigned char lds_raw[];
    LAS unsigned char* lds = (LAS unsigned char*)lds_raw;
    cg::grid_group grid = cg::this_grid();
    const int wave = __builtin_amdgcn_readfirstlane((int)threadIdx.x >> 6);
    const int G = gridDim.x, bx = blockIdx.x;
    const int vcu = (G % 8 == 0) ? (bx % 8) * (G / 8) + bx / 8 : bx;
    unsigned char* ws = P.ws;
    const int lo = P.ph_lo, hi = P.ph_hi;
#define IN(k) (lo <= (k) && (k) < hi)
#ifndef CG_SEAMS
#define CG_SEAMS 0
#endif
    volatile LAS unsigned* xbst = (volatile LAS unsigned*)(lds + MISC_OFF + 8192);
    if (wave == 0 && hw_lane() == 0) { xbst[0] = 0u; xbst[1] = 0u; xbst[2] = 0u; xbst[3] = 0u; }
    __syncthreads();
    const XcdBarrier xbar = xcd_barrier_post((unsigned*)(ws + WS_CTL) + 4096, xbst, wave == 0 && hw_lane() == 0);
    if (lo == 0) grid.sync();
#define GSYNC(k) do { if ((k) < CG_SEAMS) grid.sync(); else xcd_barrier(xbar, wave); } while (0)
#define SEAM(k) do { if (IN(k) && IN((k) + 1)) GSYNC(k); } while (0)

    for (int rep_ = 0; rep_ < (REP_PHASE == 0 ? 1 + REP_N : 1); ++rep_) if (IN(0)) { if (rep_) GSYNC(9); phase_prep(P, lds, vcu, G, wave, rep_ ? PREP_ONLY : -1); }
    SEAM(0);
    for (int es_ = 0; es_ < EXTRA_SYNCS; ++es_) GSYNC(9);
    for (int rep_ = 0; rep_ < (REP_PHASE == 1 ? 1 + REP_N : 1); ++rep_) if (IN(1)) { if (rep_) GSYNC(9);
        pg8::GemmSet g; g.A0 = g.A1 = (const bf16*)(ws + WS_A); g.Bt0 = g.Bt1 = (const bf16*)(ws + WS_BT1); g.K = 2048;
        pg8::StaticOrder S; S.init(M, 4096, 0, G, bx);
        pg8::Epi1 E{(bf16*)(ws + WS_B), (bf16*)(ws + WS_CQ), (bf16*)(ws + WS_CKV), (float*)(ws + WS_SSQCQ), (float*)(ws + WS_SSQCKV)};
        pg8::gemm_phase<pg8::Epi1, pg8::StaticOrder>(lds, g, S, E, wave);
    }
    SEAM(1);
    for (int rep_ = 0; rep_ < (REP_PHASE == 2 ? 1 + REP_N : 1); ++rep_) if (IN(2)) { if (rep_) GSYNC(9);
        for (int it = bx; it < 256; it += G) kr_item64((const bf16*)(ws + WS_A), (const bf16*)(ws + WS_BTKR), (const f32x2*)(ws + WS_ROPE), (bf16*)(ws + WS_KPE), (LAS f32x4*)lds, it, wave, hw_lane());
        pg8::GemmSet g; g.A0 = (const bf16*)(ws + WS_CQ); g.A1 = (const bf16*)(ws + WS_CKV); g.Bt0 = (const bf16*)(ws + WS_BT2Q); g.Bt1 = (const bf16*)(ws + WS_BT2KV); g.K = 512;
        pg8::StaticOrder S; S.init(M, 1536, 2048, G, bx);
        pg8::Epi2 E{(bf16*)(ws + WS_QN), (bf16*)(ws + WS_QPE), (bf16*)(ws + WS_KN), (bf16*)(ws + WS_VM), (const float*)(ws + WS_SSQCQ), (const float*)(ws + WS_SSQCKV), (const f32x2*)(ws + WS_ROPE)};
        pg8::gemm_phase<pg8::Epi2, pg8::StaticOrder>(lds, g, S, E, wave);
    }
    SEAM(2);
    for (int rep_ = 0; rep_ < (REP_PHASE == 3 ? 1 + REP_N : 1); ++rep_) if (IN(3)) { if (rep_) GSYNC(9); att::phase_attn(P, lds, vcu, G, wave); }
    SEAM(3);
    for (int rep_ = 0; rep_ < (REP_PHASE == 4 ? 1 + REP_N : 1); ++rep_) if (IN(4)) { if (rep_) GSYNC(9);
        pg8::GemmSet g; g.A0 = g.A1 = (const bf16*)(ws + WS_A); g.Bt0 = g.Bt1 = (const bf16*)(ws + WS_BT3); g.K = 2048;
        pg8::StaticOrder S; S.init(M, 2048, 0, G, bx);
        pg8::Epi3 E{(bf16*)(ws + WS_B), P.x, (const float*)(ws + WS_SSQO), (float*)(ws + WS_SSQH), (LAS f32x2*)(lds + MISC_OFF)};
        pg8::gemm_phase<pg8::Epi3, pg8::StaticOrder>(lds, g, S, E, wave);
    }
    SEAM(4);
    for (int rep_ = 0; rep_ < (REP_PHASE == 5 ? 1 + REP_N : 1); ++rep_) if (IN(5)) { if (rep_) GSYNC(9);
        pg8::GemmSet g; g.A0 = g.A1 = (const bf16*)(ws + WS_B); g.Bt0 = g.Bt1 = (const bf16*)(ws + WS_BT4); g.K = 2048;
        pg8::StaticOrder S; S.init(M, 2048, 0, G, bx);
        pg8::Epi4 E{(bf16*)(ws + WS_QP)};
        pg8::gemm_phase<pg8::Epi4, pg8::StaticOrder>(lds, g, S, E, wave);
    }
#ifdef EXTRA_G4
    if (IN(5)) { GSYNC(9);
        pg8::GemmSet g; g.A0 = g.A1 = (const bf16*)(ws + WS_B); g.Bt0 = g.Bt1 = (const bf16*)(ws + WS_BT4); g.K = 2048;
        pg8::StaticOrder S; S.init(M, 2048, 0, G, bx);
#if EXTRA_G4 == 1
        pg8::Epi4 E{(bf16*)(ws + WS_QP)}; pg8::gemm_phase<pg8::Epi4, pg8::StaticOrder>(lds, g, S, E, wave);
#else
        pg8::EpiNull E{}; pg8::gemm_phase<pg8::EpiNull, pg8::StaticOrder>(lds, g, S, E, wave);
#endif
    }
#endif
    SEAM(5);
    for (int rep_ = 0; rep_ < (REP_PHASE == 6 ? 1 + REP_N : 1); ++rep_) if (IN(6)) { if (rep_) GSYNC(9); peer::phase_route(P, lds, vcu, G, wave); }
    SEAM(6);
    for (int rep_ = 0; rep_ < (REP_PHASE == 7 ? 1 + REP_N : 1); ++rep_) if (IN(7)) { if (rep_) GSYNC(9); peer::phase_peer_u(P, lds, vcu, G, wave); }
    SEAM(7);
    for (int rep_ = 0; rep_ < (REP_PHASE == 8 ? 1 + REP_N : 1); ++rep_) if (IN(8)) { if (rep_) GSYNC(9);
        const int lane_ = hw_lane();
        for (int c = vcu; c < 256; c += G) { __syncthreads(); peer::peer_v_fill(P, c, wave * 64 + lane_); __syncthreads(); peer::peer_v_range(P, c, 0, 256, wave, NWAVES, lane_); }
    }
    SEAM(8);
    for (int rep_ = 0; rep_ < (REP_PHASE == 9 ? 1 + REP_N : 1); ++rep_) if (IN(9)) { if (rep_) GSYNC(9); peer::phase_final(P, vcu, G, wave); }
#undef IN
#undef SEAM
}

static int mega_grid() {
    static int grid = 0;
    if (grid == 0) {
        int dev = 0, cus = 0, per_cu = 0;
        (void)hipGetDevice(&dev); (void)hipDeviceGetAttribute(&cus, hipDeviceAttributeMultiprocessorCount, dev);
        (void)hipFuncSetAttribute((const void*)mega, hipFuncAttributeMaxDynamicSharedMemorySize, LDS_BYTES);
        (void)hipOccupancyMaxActiveBlocksPerMultiprocessor(&per_cu, (const void*)mega, NTHREADS, LDS_BYTES);
        if (per_cu < 1) { fprintf(stderr, "mega: occupancy query says %d blocks/CU\n", per_cu); per_cu = 1; }
        grid = cus;
        (void)hipGetLastError();
    }
    return grid;
}
static void fill_params(Params& P, void* const* d_in, void* d_out, void* d_ws) {
    P.x = (const float*)d_in[0]; P.ln1 = (const float*)d_in[1]; P.w_in = (const float*)d_in[2]; P.qan = (const float*)d_in[3]; P.kvan = (const float*)d_in[4];
    P.w_uq = (const float*)d_in[5]; P.w_ukv = (const float*)d_in[6]; P.ond = (const float*)d_in[7]; P.onm = (const float*)d_in[8]; P.w_o = (const float*)d_in[9];
    P.ln2 = (const float*)d_in[10]; P.wq = (const float*)d_in[11]; P.sk = (const float*)d_in[12]; P.pu = (const float*)d_in[13]; P.pv = (const float*)d_in[14]; P.lnf = (const float*)d_in[15];
    P.out = (float*)d_out; P.ws = (unsigned char*)d_ws;
}
static void launch_phases(Params P, int lo, int hi, hipStream_t st) {
    P.ph_lo = lo; P.ph_hi = hi;
    (void)hipMemsetAsync(P.ws + WS_CTL, 0, CTL_ZERO_BYTES, st);
    void* args[] = {&P};
    hipError_t e = hipLaunchCooperativeKernel((const void*)mega, dim3(mega_grid()), dim3(NTHREADS), args, LDS_BYTES, st);
    if (e != hipSuccess) fprintf(stderr, "mega launch [%d,%d) failed: %s\n", lo, hi, hipGetErrorString(e));
}
extern "C" void kernel_launch(void* const* d_in, const int* in_sizes, int n_in, void* d_out, int out_size, void* d_ws, size_t ws_size, hipStream_t stream) {
    Params P{}; fill_params(P, d_in, d_out, d_ws);
    launch_phases(P, 0, N_PHASES, stream);
}
```

```cpp
#include <hip/hip_runtime.h>
#include <hip/hip_cooperative_groups.h>
#include <cstdio>
#include <cstdint>
#include <cstddef>
namespace cg = cooperative_groups;
#define GAS __attribute__((address_space(1)))
#define LAS __attribute__((address_space(3)))
typedef unsigned short bf16;
typedef unsigned v4u __attribute__((ext_vector_type(4)));
typedef unsigned v2u __attribute__((ext_vector_type(2)));
typedef float f32x2 __attribute__((ext_vector_type(2)));
typedef float f32x4 __attribute__((ext_vector_type(4)));
typedef float f32x16 __attribute__((ext_vector_type(16)));
typedef short bf16x8 __attribute__((ext_vector_type(8)));
typedef short s16x4 __attribute__((ext_vector_type(4)));
typedef __bf16 bf16x2_t __attribute__((ext_vector_type(2)));
typedef float f32x32 __attribute__((ext_vector_type(32)));
typedef unsigned v6u __attribute__((ext_vector_type(6)));
constexpr int CW_FLAG = 64;
constexpr float U6_SCALE = 64.0f;

constexpr int M = 16384, SEQ = 2048, DM = 2048, NWAVES = 8, NTHREADS = 512;
constexpr float EPS = 1e-6f, LOG2E = 1.4426950408889634f;
constexpr float QSCALE_DIL = 0.08838834764831845f * LOG2E;
constexpr float QSCALE_MLA = 0.07216878364870323f * LOG2E;

constexpr size_t MiB = 1u << 20;
constexpr size_t WS_CTL = 0, CTL_ZERO_BYTES = 64 * 1024;
constexpr size_t WS_ROPE = 1 * MiB;
constexpr size_t WS_SK = 2 * MiB;
constexpr size_t WS_BTKR = 3 * MiB;
constexpr size_t WS_BT2Q = 4 * MiB;
constexpr size_t WS_BT2KV = 6 * MiB;
constexpr size_t WS_BT1 = 8 * MiB;
constexpr size_t WS_BT3 = 24 * MiB;
constexpr size_t WS_BT4 = 32 * MiB;
constexpr size_t WS_SSQCQ = 40 * MiB;
constexpr size_t WS_SSQCKV = 40 * MiB + 512 * 1024;
constexpr size_t WS_SSQO = 41 * MiB;
constexpr size_t WS_SSQH = 42 * MiB;
constexpr size_t WS_KPE = 44 * MiB;
constexpr size_t WS_UB = 48 * MiB;
constexpr size_t WS_VB = 112 * MiB;
constexpr size_t WS_A = 176 * MiB;
constexpr size_t WS_B = 240 * MiB;
constexpr size_t WS_C = 336 * MiB;
constexpr size_t WS_QN = WS_C, WS_QPE = WS_C + 32 * MiB, WS_KN = WS_C + 48 * MiB, WS_VM = WS_C + 80 * MiB;
constexpr size_t WS_QP = WS_C, WS_RIDX = WS_C + 64 * MiB, WS_RGATE = WS_C + 72 * MiB, WS_PKV = WS_C + 80 * MiB,
                 WS_SIDX = WS_C + 88 * MiB, WS_SGATE = WS_C + 96 * MiB, WS_GOFF = WS_C + 104 * MiB;
constexpr size_t WS_D = 448 * MiB;
constexpr size_t WS_CQ = WS_D, WS_CKV = WS_D + 16 * MiB;
constexpr size_t WS_END = 480 * MiB;

constexpr int RING_BYTES = 131072;
constexpr int MISC_OFF = RING_BYTES;
constexpr int LDS_BYTES = 147456;

#define LDS_WAIT() asm volatile("s_waitcnt lgkmcnt(0)" ::: "memory")
#define VM_WAIT() asm volatile("s_waitcnt vmcnt(0)" ::: "memory")

__device__ __forceinline__ unsigned f2bf(float f) { unsigned u = __builtin_bit_cast(unsigned, f); return (u + 0x7fffu + ((u >> 16) & 1u)) >> 16; }
__device__ __forceinline__ unsigned pk2(float lo, float hi) { f32x2 v = {lo, hi}; bf16x2_t b = __builtin_convertvector(v, bf16x2_t); return __builtin_bit_cast(unsigned, b); }
__device__ __forceinline__ float bflo(unsigned u) { return __builtin_bit_cast(float, u << 16); }
__device__ __forceinline__ float bfhi(unsigned u) { return __builtin_bit_cast(float, u & 0xffff0000u); }
__device__ __forceinline__ float bf2f(bf16 b) { return __builtin_bit_cast(float, (unsigned)b << 16); }
__device__ __forceinline__ float wave_sum(float v) {
#pragma unroll
    for (int o = 1; o < 64; o <<= 1) v += __shfl_xor(v, o);
    return v;
}

__device__ __forceinline__ int hw_lane() { int l; asm volatile("v_mbcnt_lo_u32_b32 %0, -1, 0\n\tv_mbcnt_hi_u32_b32 %0, -1, %0" : "=v"(l)); return l; }

struct Params {
    const float *x, *ln1, *w_in, *qan, *kvan, *w_uq, *w_ukv, *ond, *onm, *w_o, *ln2, *wq, *sk, *pu, *pv, *lnf;
    float* out; unsigned char* ws;
    int ph_lo, ph_hi;
};
__device__ __forceinline__ int map_ident(int c) { return c; }
__device__ __forceinline__ int map_kr(int c) { const int p = c - 4096; return 2 * (p & 31) + (p >> 5); }
__device__ __forceinline__ int map_uq(int c) { const int h = c / 192, e = c % 192; if (e < 128) return h * 128 + e; const int p = e - 128; return 1024 + h * 64 + 2 * (p & 31) + (p >> 5); }
__device__ __forceinline__ int map_ukv(int c) { const int h = c >> 8, e = c & 255; return e < 128 ? h * 128 + e : 1024 + h * 128 + (e - 128); }

template <int MAP>
__device__ __forceinline__ void p0_transpose_item(const float* __restrict__ W, int K, int ldw, int c0, const float* __restrict__ g0, const float* __restrict__ g1, int gsplit,
                                                  bf16* __restrict__ WT, LAS float* scr, int item, int nblk, int lane) {
    const int kb = item / nblk, nb = item % nblk, k0 = 64 * kb, n0 = c0 + 32 * nb;
    f32x4 wv[8];
#pragma unroll
    for (int i = 0; i < 8; ++i) wv[i] = *(const f32x4*)(W + (size_t)(k0 + (lane >> 3) + 8 * i) * ldw + n0 + 4 * (lane & 7));
#pragma unroll
    for (int i = 0; i < 8; ++i) { const int kk = (lane >> 3) + 8 * i, k = k0 + kk; f32x4 w = wv[i];
        if (g0) w = w * (k < gsplit ? g0[k] : g1[k - gsplit]);
        LAS float* d = scr + kk * 33 + 4 * (lane & 7); d[0] = w[0]; d[1] = w[1]; d[2] = w[2]; d[3] = w[3]; }
    LDS_WAIT(); asm volatile("" ::: "memory");
    const int c = lane & 7;
#pragma unroll
    for (int j = 0; j < 4; ++j) { const int n = (lane >> 3) + 8 * j; const LAS float* s = scr + (8 * c) * 33 + n;
        v4u o; o.x = pk2(s[0 * 33], s[1 * 33]); o.y = pk2(s[2 * 33], s[3 * 33]); o.z = pk2(s[4 * 33], s[5 * 33]); o.w = pk2(s[6 * 33], s[7 * 33]);
        const int src = n0 + n;
        const int dr = MAP == 0 ? map_ident(src) : MAP == 1 ? map_kr(src) : MAP == 2 ? map_uq(src) : map_ukv(src);
        *(v4u*)(WT + (size_t)dr * K + k0 + 8 * c) = o; }
    LDS_WAIT(); asm volatile("" ::: "memory");
}

#ifndef PREP_ONLY
#define PREP_ONLY -1
#endif
__device__ __forceinline__ void phase_prep(const Params& P, LAS unsigned char* lds, int vcu, int G, int wave, int only = -1) {
    const int lane = hw_lane(), tid = wave * 64 + lane;
    unsigned char* ws = P.ws;
    LAS float* scr = (LAS float*)(lds + wave * 16384);
    const int gw = vcu * NWAVES + wave, NGW = G * NWAVES;
    const int gt = vcu * NTHREADS + tid, NGT = G * NTHREADS;
#pragma unroll 1
    for (int pi = 0; pi < 3; ++pi) {
        const int part = (pi + wave) % 3;
        if (only >= 0 && only != part) continue;
        if (part == 0) {
    constexpr int I1 = 32 * 128, IKR = 32 * 2, I2Q = 8 * 48, I2KV = 8 * 64, I3 = 32 * 64, I4 = 32 * 64;
    constexpr int NITEMS = I1 + IKR + I2Q + I2KV + I3 + I4;
    for (int it = gw; it < NITEMS; it += NGW) {
        int r = it;
        if (r < I1) { p0_transpose_item<0>(P.w_in, 2048, 4160, 0, nullptr, nullptr, 0, (bf16*)(ws + WS_BT1), scr, r, 128, lane); continue; } r -= I1;
        if (r < IKR) { p0_transpose_item<1>(P.w_in, 2048, 4160, 4096, nullptr, nullptr, 0, (bf16*)(ws + WS_BTKR), scr, r, 2, lane); continue; } r -= IKR;
        if (r < I2Q) { p0_transpose_item<2>(P.w_uq, 512, 1536, 0, P.qan, P.qan, 512, (bf16*)(ws + WS_BT2Q), scr, r, 48, lane); continue; } r -= I2Q;
        if (r < I2KV) { p0_transpose_item<3>(P.w_ukv, 512, 2048, 0, P.kvan, P.kvan, 512, (bf16*)(ws + WS_BT2KV), scr, r, 64, lane); continue; } r -= I2KV;
        if (r < I3) { p0_transpose_item<0>(P.w_o, 2048, 2048, 0, P.ond, P.onm, 1024, (bf16*)(ws + WS_BT3), scr, r, 64, lane); continue; } r -= I3;
        p0_transpose_item<0>(P.wq, 2048, 2048, 0, P.ln2, P.ln2, 2048, (bf16*)(ws + WS_BT4), scr, r, 64, lane);
    }
        } else if (part == 1) {
    {
        bf16* XN = (bf16*)(ws + WS_A);
        f32x4 gv[8];
#pragma unroll
        for (int j = 0; j < 8; ++j) gv[j] = ((const f32x4*)P.ln1)[lane + 64 * j];
        for (int m0 = gw * 4; m0 < M; m0 += NGW * 4) {
            f32x4 v[4][8];
#pragma unroll
            for (int r = 0; r < 4; ++r) { const f32x4* xr = (const f32x4*)(P.x + (size_t)(m0 + r) * DM) + lane;
#pragma unroll
                for (int j = 0; j < 8; ++j) v[r][j] = __builtin_nontemporal_load(xr + 64 * j); }
#pragma unroll
            for (int r = 0; r < 4; ++r) { float s = 0.f;
#pragma unroll
                for (int j = 0; j < 8; ++j) s += (v[r][j].x * v[r][j].x + v[r][j].y * v[r][j].y) + (v[r][j].z * v[r][j].z + v[r][j].w * v[r][j].w);
                const float rs = rsqrtf(wave_sum(s) * (1.f / DM) + EPS);
                v2u* o8 = (v2u*)(XN + (size_t)(m0 + r) * DM) + lane;
#pragma unroll
                for (int j = 0; j < 8; ++j) { v2u o; o.x = pk2(v[r][j].x * rs * gv[j].x, v[r][j].y * rs * gv[j].y); o.y = pk2(v[r][j].z * rs * gv[j].z, v[r][j].w * rs * gv[j].w); o8[64 * j] = o; } }
        }
    }
        } else {
        {
            f32x16 ta, tb;
#pragma unroll
            for (int i = 0; i < 16; ++i) { ta[i] = (float)(i & 7); tb[i] = (float)((i + 16) & 7) * 0.5f + (float)(i >> 3); }
            const f32x32 r = __builtin_amdgcn_cvt_scalef32_pk32_f32_fp6(__builtin_amdgcn_cvt_scalef32_2xpk16_fp6_f32(ta, tb, 1.0f), 1.0f);
            bool ok = true;
#pragma unroll
            for (int i = 0; i < 16; ++i) ok = ok && (r[2 * i] == ta[i]) && (r[2 * i + 1] == tb[i]);
            if (!ok) __hip_atomic_store((unsigned*)(ws + WS_CTL) + CW_FLAG, 1u, __ATOMIC_RELAXED, __HIP_MEMORY_SCOPE_AGENT);
        }
        unsigned char* ou = ws + WS_UB;
        {
            const int l = gt & 63; f32x4 gp[8];
#pragma unroll
            for (int j = 0; j < 8; ++j) gp[j] = ((const f32x4*)(P.ln2 + 32 * l))[j] * U6_SCALE;
#pragma unroll 3
            for (int i = gt; i < 16384 * 64; i += NGT) {
                const int e = i >> 6; const f32x4* src = (const f32x4*)(P.pu + (size_t)e * 2048 + 32 * l);
                f32x16 xa, xb;
#pragma unroll
                for (int j = 0; j < 4; ++j) { const f32x4 v = __builtin_nontemporal_load(src + j) * gp[j]; xa[4 * j] = v[0]; xa[4 * j + 1] = v[1]; xa[4 * j + 2] = v[2]; xa[4 * j + 3] = v[3]; }
#pragma unroll
                for (int j = 0; j < 4; ++j) { const f32x4 v = __builtin_nontemporal_load(src + 4 + j) * gp[4 + j]; xb[4 * j] = v[0]; xb[4 * j + 1] = v[1]; xb[4 * j + 2] = v[2]; xb[4 * j + 3] = v[3]; }
                const v6u p6 = __builtin_amdgcn_cvt_scalef32_2xpk16_fp6_f32(xa, xb, 1.0f);
                unsigned char* row = ou + (size_t)e * 1536;
                *(v4u*)(row + 16 * l) = (v4u){p6[0], p6[1], p6[2], p6[3]}; *(v2u*)(row + 1024 + 8 * l) = (v2u){p6[4], p6[5]};
            }
        }
        }
    }
    if (only < 0 || only == 3) {
        f32x2* R = (f32x2*)(ws + WS_ROPE);
        for (int i = gt; i < 2048 * 32; i += NGT) { const int pos = i >> 5, j = i & 31; const float freq = powf(10000.0f, -(float)j / 32.0f), ang = (float)pos * freq;
            f32x2 cs; cs.x = cosf(ang); cs.y = sinf(ang); R[i] = cs; }
    }
    if (only < 0 || only == 3) {
        v4u* o = (v4u*)(ws + WS_SK);
        for (int i = gt; i < 16 * 128 * 128 / 8; i += NGT) { const f32x4 a = ((const f32x4*)P.sk)[2 * i], b = ((const f32x4*)P.sk)[2 * i + 1];
            v4u w; w.x = pk2(a.x, a.y); w.y = pk2(a.z, a.w); w.z = pk2(b.x, b.y); w.w = pk2(b.z, b.w); o[i] = w; }
    }
    if (only < 0 || only == 4) {
        __syncthreads();
        LAS v2u* tl = (LAS v2u*)lds;
        v2u* ov = (v2u*)(ws + WS_VB);
        f32x4 ra[8], rb[8];
#define PV8_LOAD(tile_) do { const int _e0 = ((tile_) >> 2) * 64, _c0 = ((tile_) & 3) * 64; _Pragma("unroll") for (int k = 0; k < 8; ++k) { const int it = tid + 512 * k, e = it >> 6, c = it & 63; \
            const f32x4* src = (const f32x4*)(P.pv + (size_t)(_e0 + e) * 2048 + (size_t)(_c0 + c) * 8); ra[k] = __builtin_nontemporal_load(src); rb[k] = __builtin_nontemporal_load(src + 1); } } while (0)
        if (vcu < 1024) PV8_LOAD(vcu);
        for (int tile = vcu; tile < 1024; tile += G) {
            const int e0 = (tile >> 2) * 64, c0 = (tile & 3) * 64;
#pragma unroll
            for (int k = 0; k < 8; ++k) { const int it = tid + 512 * k, e = it >> 6, c = it & 63; const f32x4 a = ra[k], b = rb[k];
                int w0 = 0, w1 = 0;
                w0 = __builtin_amdgcn_cvt_pk_fp8_f32(a.x * 2.f, a.y * 2.f, w0, false); w0 = __builtin_amdgcn_cvt_pk_fp8_f32(a.z * 2.f, a.w * 2.f, w0, true);
                w1 = __builtin_amdgcn_cvt_pk_fp8_f32(b.x * 2.f, b.y * 2.f, w1, false); w1 = __builtin_amdgcn_cvt_pk_fp8_f32(b.z * 2.f, b.w * 2.f, w1, true);
                v2u w; w.x = (unsigned)w0; w.y = (unsigned)w1; tl[c * 65 + e] = w; }
            if (tile + G < 1024) PV8_LOAD(tile + G);
            __syncthreads();
#pragma unroll
            for (int k = 0; k < 8; ++k) { const int it = tid + 512 * k, c = it >> 6, e = it & 63; ov[(size_t)(c0 + c) * 16384 + e0 + e] = tl[c * 65 + e]; }
            __syncthreads();
        }
#undef PV8_LOAD
    }
}
namespace pg8 {
constexpr int BM = 256, BK = 64, HALF = 128, HTB = HALF * BK * 2, STAGE_BYTES = 8 * HTB, NXCD = 8, WGM = 8;
__host__ __device__ __forceinline__ int lds_byte(int r, int c) { const int st = (r >> 4) * 2 + (c >> 5), rr = r & 15, cc = c & 31, ob = rr * 64 + cc * 2; return st * 1024 + (ob ^ (((ob >> 9) & 1) << 5)); }
__host__ __device__ __forceinline__ void stage_rc(int b, int& R, int& C) { const int st = b / 1024, sb = b % 1024, swz = sb ^ (((sb >> 9) & 1) << 5); R = (st >> 1) * 16 + swz / 64; C = (st & 1) * 32 + (swz % 64) / 2; }
__host__ __device__ __forceinline__ int perm32(int rho) { const int n = rho >> 4, i = rho & 15; return 8 * (i >> 2) + 4 * n + (i & 3); }

struct Unit { int pm, pn, g; };
struct GemmSet { const bf16 *A0, *A1, *Bt0, *Bt1; int K; };

struct StaticOrder {
    int nM, nN0, nN, nwg, G, c;
    __device__ void init(int Mrows, int N0, int N1, int G_, int c_) { nM = Mrows / BM; nN0 = N0 / BM; nN = nN0 + N1 / BM; nwg = nM * nN; G = G_; c = c_; }
    __device__ bool next(int i, Unit& u) const {
        const long L = (long)i * G + c; if (L >= nwg) return false;
        int wgid = (int)L; { const int q = nwg / NXCD, r = nwg % NXCD, xcd = wgid % NXCD, off = wgid / NXCD; wgid = (xcd < r ? xcd * (q + 1) : r * (q + 1) + (xcd - r) * q) + off; }
        const int nig = WGM * nN, gid = wgid / nig, fm = gid * WGM, gsz = (nM - fm) < WGM ? (nM - fm) : WGM;
        u.pm = fm + ((wgid % nig) % gsz); int pn = (wgid % nig) / gsz; u.g = pn >= nN0 ? 1 : 0; u.pn = pn >= nN0 ? pn - nN0 : pn; return true;
    }
};
struct ForcedOrder {
    StaticOrder S; int mmask, nmask;
    __device__ bool next(int i, Unit& u) const { if (!S.next(i, u)) return false; u.pm &= mmask; u.pn &= nmask; return true; }
};

template <class Epi, class Sched>
__device__ __forceinline__ void gemm_phase(LAS unsigned char* lds, const GemmSet g, const Sched& S, const Epi& E, int wid) {
    const int lane = hw_lane(), tid = wid * 64 + lane, wr = wid >> 2, wc = wid & 3, fr = lane & 15, fq = lane >> 4;
    const int K = g.K, nt = K / BK;
    unsigned voffA[2], voffB[2];
#pragma unroll
    for (int i = 0; i < 2; ++i) { int R, C; stage_rc(tid * 16 + i * 8192, R, C); const int Rb = (R >> 5) * 64 + perm32(R & 31);
        voffA[i] = (unsigned)(R * K + C) * 2u; voffB[i] = (unsigned)(Rb * K + C) * 2u; }
    const size_t kstep = (size_t)(BK * 2);
    const size_t hstep = (size_t)HALF * K * 2;
    const size_t hstepB = (size_t)32 * K * 2;
    const size_t tstep = 2 * hstep;
    const unsigned ldsw = (unsigned)wid * 1024u;
    const int aoff = lds_byte(wr * 64 + fr, fq * 8), boff = lds_byte(wc * 32 + fr, fq * 8);
#define PG8_SA(b, h) (((b) * 2 + (h)) * HTB)
#define PG8_SB(b, h) ((4 + (b) * 2 + (h)) * HTB)
#define PG8_STAGE(bufoff, gbase, voff) do { _Pragma("unroll") for (int _i = 0; _i < 2; ++_i) \
        __builtin_amdgcn_global_load_lds((const unsigned*)((const char*)(gbase) + (voff)[_i]), (LAS unsigned*)(lds + (bufoff) + ldsw + _i * 8192), 16, 0, 0); } while (0)
#define PG8_LDA(dst, b, h) do { _Pragma("unroll") for (int m = 0; m < 4; ++m) _Pragma("unroll") for (int k = 0; k < 2; ++k) dst[m][k] = *(const LAS bf16x8*)(lds + PG8_SA(b, h) + aoff + m * 2048 + k * 1024); } while (0)
#define PG8_LDB(dst, b, h) do { _Pragma("unroll") for (int n = 0; n < 2; ++n) _Pragma("unroll") for (int k = 0; k < 2; ++k) dst[n][k] = *(const LAS bf16x8*)(lds + PG8_SB(b, h) + boff + n * 2048 + k * 1024); } while (0)
#define PG8_MMA(ai, bj, At, Bt) do { __builtin_amdgcn_s_setprio(1); _Pragma("unroll") for (int m = 0; m < 4; ++m) _Pragma("unroll") for (int n = 0; n < 2; ++n) _Pragma("unroll") for (int k = 0; k < 2; ++k) \
        acc[ai][bj][m][n] = __builtin_amdgcn_mfma_f32_16x16x32_bf16(Bt[n][k], At[m][k], acc[ai][bj][m][n], 0, 0, 0); __builtin_amdgcn_s_setprio(0); } while (0)
#define PG8_WAIT_V(n) asm volatile("s_waitcnt vmcnt(" #n ")" ::: "memory")
#define PG8_WAIT_L(n) asm volatile("s_waitcnt lgkmcnt(" #n ")" ::: "memory")
#define PG8_BAR __builtin_amdgcn_s_barrier()
#define PG8_SCHED __builtin_amdgcn_sched_barrier(0)
    Unit cur, nxt; int ui = 0;
    if (!S.next(0, cur)) return;
    f32x4 acc[2][2][4][2];
#pragma unroll
    for (int a = 0; a < 2; ++a)
#pragma unroll
        for (int b = 0; b < 2; ++b)
#pragma unroll
            for (int m = 0; m < 4; ++m)
#pragma unroll
                for (int n = 0; n < 2; ++n) acc[a][b][m][n] = (f32x4){0.f, 0.f, 0.f, 0.f};
    bf16x8 At[4][2], B0[2][2], B1[2][2];
    const char* cA = (const char*)(cur.g ? g.A1 : g.A0) + (size_t)cur.pm * tstep; const char* cB = (const char*)(cur.g ? g.Bt1 : g.Bt0) + (size_t)cur.pn * tstep;
    E.unit_begin(cur, 0, tid);
    PG8_STAGE(PG8_SB(0, 0), cB, voffB); PG8_STAGE(PG8_SB(0, 1), cB + hstepB, voffB); PG8_STAGE(PG8_SA(0, 0), cA, voffA); PG8_STAGE(PG8_SA(0, 1), cA + hstep, voffA);
    if (wr == 1) PG8_BAR;
    PG8_WAIT_V(2); PG8_BAR;
    PG8_STAGE(PG8_SB(1, 0), cB + kstep, voffB); PG8_STAGE(PG8_SA(1, 0), cA + kstep, voffA); PG8_STAGE(PG8_SB(1, 1), cB + hstepB + kstep, voffB);
    PG8_WAIT_V(6); PG8_BAR;
    for (;;) {
        const bool has_next = S.next(ui + 1, nxt);
        const char* nA = has_next ? (const char*)(nxt.g ? g.A1 : g.A0) + (size_t)nxt.pm * tstep : cA; const char* nB = has_next ? (const char*)(nxt.g ? g.Bt1 : g.Bt0) + (size_t)nxt.pn * tstep : cB;
        for (int t = 0; t < nt; t += 2) {
            const bool last = (t == nt - 2);
            const char* a1 = cA + (size_t)(t + 1) * kstep;
            const char* a2 = last ? nA : cA + (size_t)(t + 2) * kstep; const char* b2 = last ? nB : cB + (size_t)(t + 2) * kstep;
            const char* a3 = a2 + kstep; const char* b3 = b2 + kstep;
            if constexpr (Epi::MIDSCALE) { if (t == nt / 2) E.midscale(acc, ui & 1, wr, fr); }
            PG8_LDB(B0, 0, 0); PG8_LDB(B1, 0, 1); PG8_SCHED; PG8_LDA(At, 0, 0); PG8_STAGE(PG8_SA(1, 1), a1 + hstep, voffA);
            PG8_WAIT_V(8); PG8_WAIT_L(0); PG8_BAR; PG8_MMA(0, 0, At, B0); PG8_MMA(0, 1, At, B1); PG8_BAR; PG8_SCHED;
            PG8_LDA(At, 0, 1); PG8_STAGE(PG8_SB(0, 0), b2, voffB); PG8_STAGE(PG8_SB(0, 1), b2 + hstepB, voffB); PG8_STAGE(PG8_SA(0, 0), a2, voffA);
            PG8_WAIT_V(8); PG8_WAIT_L(0); PG8_BAR; PG8_MMA(1, 0, At, B0); PG8_MMA(1, 1, At, B1); PG8_BAR; PG8_SCHED;
            PG8_LDB(B0, 1, 0); PG8_LDB(B1, 1, 1); PG8_SCHED; PG8_LDA(At, 1, 0); PG8_STAGE(PG8_SA(0, 1), a2 + hstep, voffA);
            PG8_WAIT_V(8); PG8_WAIT_L(0); PG8_BAR; PG8_MMA(0, 0, At, B0); PG8_MMA(0, 1, At, B1); PG8_BAR; PG8_SCHED;
            PG8_LDA(At, 1, 1); PG8_STAGE(PG8_SB(1, 0), b3, voffB); PG8_STAGE(PG8_SB(1, 1), b3 + hstepB, voffB); PG8_STAGE(PG8_SA(1, 0), a3, voffA);
            PG8_WAIT_V(8); PG8_WAIT_L(0); PG8_BAR; PG8_MMA(1, 0, At, B0); PG8_MMA(1, 1, At, B1); PG8_BAR; PG8_SCHED;
        }
        if (wr == 0) PG8_BAR;
        E(acc, cur, ui & 1, wr, wc, fr, fq);
        if (!has_next) break;
#pragma unroll
        for (int a = 0; a < 2; ++a)
#pragma unroll
            for (int b = 0; b < 2; ++b)
#pragma unroll
                for (int m = 0; m < 4; ++m)
#pragma unroll
                    for (int n = 0; n < 2; ++n) acc[a][b][m][n] = (f32x4){0.f, 0.f, 0.f, 0.f};
        cur = nxt; cA = nA; cB = nB; ++ui;
        E.unit_begin(cur, ui & 1, tid);
        if (wr == 1) PG8_BAR;
    }
    PG8_WAIT_V(0);
    PG8_BAR;
#undef PG8_SA
#undef PG8_SB
#undef PG8_STAGE
#undef PG8_LDA
#undef PG8_LDB
#undef PG8_MMA
#undef PG8_WAIT_V
#undef PG8_WAIT_L
#undef PG8_BAR
#undef PG8_SCHED
}
}
namespace pg8 {
__device__ __forceinline__ v4u pack8(const f32x4& v0, const f32x4& v1) { v4u w; w.x = pk2(v0[0], v0[1]); w.y = pk2(v0[2], v0[3]); w.z = pk2(v1[0], v1[1]); w.w = pk2(v1[2], v1[3]); return w; }
__device__ __forceinline__ float sq8(const f32x4& v0, const f32x4& v1) { return (v0[0] * v0[0] + v0[1] * v0[1]) + (v0[2] * v0[2] + v0[3] * v0[3]) + (v1[0] * v1[0] + v1[1] * v1[1]) + (v1[2] * v1[2] + v1[3] * v1[3]); }

struct Epi1 {
    static constexpr bool MIDSCALE = false;
    bf16 *QKV, *CQ, *CKV; float *SSQCQ, *SSQCKV;
    __device__ __forceinline__ void midscale(f32x4 (&)[2][2][4][2], int, int, int) const {}
    __device__ __forceinline__ void unit_begin(const Unit&, int, int) const {}
    __device__ __forceinline__ void operator()(const f32x4 (&acc)[2][2][4][2], const Unit& u, int par, int wr, int wc, int fr, int fq) const {
        const int pn = u.pn; bf16* base; int ldc, colt; float sc = 1.f; float* ssq = nullptr; int sslot = 0;
        if (pn < 12) { base = QKV; ldc = 3072; colt = pn * 256; if (pn < 4) sc = QSCALE_DIL; }
        else if (pn < 14) { base = CQ; ldc = 512; colt = (pn - 12) * 256; ssq = SSQCQ; sslot = (pn - 12) * 4 + wc; }
        else { base = CKV; ldc = 512; colt = (pn - 14) * 256; ssq = SSQCKV; sslot = (pn - 14) * 4 + wc; }
        const int row0 = u.pm * BM + wr * 64 + fr, col0 = colt + wc * 64 + 8 * fq;
#pragma unroll
        for (int ai = 0; ai < 2; ++ai)
#pragma unroll
            for (int m = 0; m < 4; ++m) { const int row = row0 + ai * HALF + m * 16; bf16* rowp = base + (size_t)row * ldc + col0; float ss = 0.f;
#pragma unroll
                for (int bj = 0; bj < 2; ++bj) { const f32x4 v0 = acc[ai][bj][m][0] * sc, v1 = acc[ai][bj][m][1] * sc; ss += sq8(v0, v1); *(v4u*)(rowp + bj * 32) = pack8(v0, v1); }
                if (ssq) { ss += __shfl_xor(ss, 16); ss += __shfl_xor(ss, 32); if (fq == 0) ssq[(size_t)row * 8 + sslot] = ss; } }
    }
};

struct Epi2 {
    static constexpr bool MIDSCALE = false;
    bf16 *QN, *QPE, *KN, *VM; const float *SSQCQ, *SSQCKV; const f32x2* ROPE;
    __device__ __forceinline__ void midscale(f32x4 (&)[2][2][4][2], int, int, int) const {}
    __device__ __forceinline__ void unit_begin(const Unit&, int, int) const {}
    __device__ __forceinline__ void operator()(const f32x4 (&acc)[2][2][4][2], const Unit& u, int par, int wr, int wc, int fr, int fq) const {
        const int pn = u.pn; bf16* base; int ldc, colt; float sc = 1.f; bool rope = false; const float* ssq;
        if (u.g == 0) { ssq = SSQCQ; sc = QSCALE_MLA; if (pn < 4) { base = QN; ldc = 1024; colt = pn * 256; } else { base = QPE; ldc = 512; colt = (pn - 4) * 256; rope = true; } }
        else { ssq = SSQCKV; if (pn < 4) { base = KN; ldc = 1024; colt = pn * 256; } else { base = VM; ldc = 1024; colt = (pn - 4) * 256; } }
        const int row0 = u.pm * BM + wr * 64 + fr, col0 = colt + wc * 64 + 8 * fq;
#pragma unroll
        for (int ai = 0; ai < 2; ++ai)
#pragma unroll
            for (int m = 0; m < 4; ++m) { const int row = row0 + ai * HALF + m * 16; bf16* rowp = base + (size_t)row * ldc + col0;
                const f32x4 p0 = *(const f32x4*)(ssq + (size_t)row * 8), p1 = *(const f32x4*)(ssq + (size_t)row * 8 + 4);
                const float rs = rsqrtf(((p0[0] + p0[1]) + (p0[2] + p0[3]) + (p1[0] + p1[1]) + (p1[2] + p1[3])) * (1.f / 512.f) + EPS) * sc;
#pragma unroll
                for (int bj = 0; bj < 2; ++bj) { f32x4 v0 = acc[ai][bj][m][0] * rs, v1 = acc[ai][bj][m][1] * rs;
                    if (rope) { const int j0 = ((col0 + bj * 32) & 63) >> 1; const f32x4* rp = (const f32x4*)(ROPE + (size_t)(row & (SEQ - 1)) * 32 + j0);
                        const f32x4 r0 = rp[0], r1 = rp[1];
                        f32x4 w0, w1;
                        w0[0] = v0[0] * r0[0] - v0[1] * r0[1]; w0[1] = v0[0] * r0[1] + v0[1] * r0[0];
                        w0[2] = v0[2] * r0[2] - v0[3] * r0[3]; w0[3] = v0[2] * r0[3] + v0[3] * r0[2];
                        w1[0] = v1[0] * r1[0] - v1[1] * r1[1]; w1[1] = v1[0] * r1[1] + v1[1] * r1[0];
                        w1[2] = v1[2] * r1[2] - v1[3] * r1[3]; w1[3] = v1[2] * r1[3] + v1[3] * r1[2];
                        v0 = w0; v1 = w1; }
                    *(v4u*)(rowp + bj * 32) = pack8(v0, v1); } }
    }
};

struct Epi3 {
    static constexpr bool MIDSCALE = true;
    bf16* H1B; const float* X; const float* SSQO; float* SSQH; LAS f32x2* RS;
    __device__ __forceinline__ void unit_begin(const Unit& u, int par, int tid) const {
        if (tid < 256) { const f32x4* p = (const f32x4*)(SSQO + (size_t)(u.pm * BM + tid) * 16); const f32x4 a0 = p[0], a1 = p[1], b0 = p[2], b1 = p[3];
            const float ra = rsqrtf(((a0[0] + a0[1]) + (a0[2] + a0[3]) + (a1[0] + a1[1]) + (a1[2] + a1[3])) * (1.f / 1024.f) + EPS);
            const float rb = rsqrtf(((b0[0] + b0[1]) + (b0[2] + b0[3]) + (b1[0] + b1[1]) + (b1[2] + b1[3])) * (1.f / 1024.f) + EPS);
            f32x2 v; v.x = ra / rb; v.y = rb; RS[par * 256 + tid] = v; }
    }
    __device__ __forceinline__ void midscale(f32x4 (&acc)[2][2][4][2], int par, int wr, int fr) const {
#pragma unroll
        for (int ai = 0; ai < 2; ++ai)
#pragma unroll
            for (int m = 0; m < 4; ++m) { const float f = RS[par * 256 + ai * HALF + wr * 64 + m * 16 + fr].x;
#pragma unroll
                for (int bj = 0; bj < 2; ++bj) { acc[ai][bj][m][0] = acc[ai][bj][m][0] * f; acc[ai][bj][m][1] = acc[ai][bj][m][1] * f; } }
    }
    __device__ __forceinline__ void operator()(const f32x4 (&acc)[2][2][4][2], const Unit& u, int par, int wr, int wc, int fr, int fq) const {
        const int row0 = u.pm * BM + wr * 64 + fr, col0 = u.pn * BM + wc * 64 + 8 * fq, sslot = u.pn * 4 + wc;
#pragma unroll
        for (int ai = 0; ai < 2; ++ai)
#pragma unroll
            for (int m = 0; m < 4; ++m) { const int row = row0 + ai * HALF + m * 16; const float rb = RS[par * 256 + ai * HALF + wr * 64 + m * 16 + fr].y; float ss = 0.f;
#pragma unroll
                for (int bj = 0; bj < 2; ++bj) { const float* xp = X + (size_t)row * DM + col0 + bj * 32; const f32x4 x0 = *(const f32x4*)xp, x1 = *(const f32x4*)(xp + 4);
                    const f32x4 v0 = acc[ai][bj][m][0] * rb + x0, v1 = acc[ai][bj][m][1] * rb + x1; ss += sq8(v0, v1);
                    *(v4u*)(H1B + (size_t)row * DM + col0 + bj * 32) = pack8(v0, v1); }
                ss += __shfl_xor(ss, 16); ss += __shfl_xor(ss, 32); if (fq == 0) SSQH[(size_t)row * 32 + sslot] = ss; }
    }
};

struct Epi4 {
    static constexpr bool MIDSCALE = false;
    bf16* QP;
    __device__ __forceinline__ void midscale(f32x4 (&)[2][2][4][2], int, int, int) const {}
    __device__ __forceinline__ void unit_begin(const Unit&, int, int) const {}
    __device__ __forceinline__ void operator()(const f32x4 (&acc)[2][2][4][2], const Unit& u, int par, int wr, int wc, int fr, int fq) const {
        const int row0 = u.pm * BM + wr * 64 + fr, col0 = u.pn * BM + wc * 64 + 8 * fq;
#pragma unroll
        for (int ai = 0; ai < 2; ++ai)
#pragma unroll
            for (int m = 0; m < 4; ++m) { const int row = row0 + ai * HALF + m * 16;
#pragma unroll
                for (int bj = 0; bj < 2; ++bj) *(v4u*)(QP + (size_t)row * DM + col0 + bj * 32) = pack8(acc[ai][bj][m][0], acc[ai][bj][m][1]); }
    }
};
struct EpiSmall {
    static constexpr bool MIDSCALE = false;
    bf16* QP;
    __device__ __forceinline__ void midscale(f32x4 (&)[2][2][4][2], int, int, int) const {}
    __device__ __forceinline__ void unit_begin(const Unit&, int, int) const {}
    __device__ __forceinline__ void operator()(const f32x4 (&acc)[2][2][4][2], const Unit& u, int par, int wr, int wc, int fr, int fq) const {
        const int row0 = (blockIdx.x * 16) + fr, col0 = wc * 64 + 8 * fq;
#pragma unroll
        for (int ai = 0; ai < 2; ++ai)
#pragma unroll
            for (int m = 0; m < 4; ++m) { const int row = row0;
#pragma unroll
                for (int bj = 0; bj < 2; ++bj) *(v4u*)(QP + (size_t)row * DM + col0 + bj * 32 + (ai * 4 + m) * 256) = pack8(acc[ai][bj][m][0], acc[ai][bj][m][1]); }
    }
};
struct EpiNull {
    static constexpr bool MIDSCALE = false;
    __device__ __forceinline__ void midscale(f32x4 (&)[2][2][4][2], int, int, int) const {}
    __device__ __forceinline__ void unit_begin(const Unit&, int, int) const {}
    __device__ __forceinline__ void operator()(const f32x4 (&acc)[2][2][4][2], const Unit& u, int par, int wr, int wc, int fr, int fq) const {
#pragma unroll
        for (int ai = 0; ai < 2; ++ai)
#pragma unroll
            for (int bj = 0; bj < 2; ++bj)
#pragma unroll
                for (int m = 0; m < 4; ++m)
#pragma unroll
                    for (int n = 0; n < 2; ++n) asm volatile("" :: "v"(acc[ai][bj][m][n]));
    }
};
}

__device__ __forceinline__ void kr_item64(const bf16* __restrict__ XN, const bf16* __restrict__ BT, const f32x2* __restrict__ ROPE, bf16* __restrict__ KPE, LAS f32x4* red, int item, int wave, int lane) {
    const int fr = lane & 15, fq = lane >> 4, rg = wave & 3, kh = wave >> 2, row = item * 64 + rg * 16 + fr;
    const bf16* ap = XN + (size_t)row * 2048 + kh * 1024 + fq * 8; const bf16* bp = BT + (size_t)fr * 2048 + kh * 1024 + fq * 8;
    f32x4 acc[4];
#pragma unroll
    for (int nb = 0; nb < 4; ++nb) acc[nb] = (f32x4){0.f, 0.f, 0.f, 0.f};
#pragma unroll 4
    for (int k0 = 0; k0 < 1024; k0 += 32) {
        const bf16x8 a = *(const bf16x8*)(ap + k0);
#pragma unroll
        for (int nb = 0; nb < 4; ++nb) { const bf16x8 b = *(const bf16x8*)(bp + (size_t)nb * 16 * 2048 + k0); acc[nb] = __builtin_amdgcn_mfma_f32_16x16x32_bf16(b, a, acc[nb], 0, 0, 0); }
    }
    if (kh == 1) {
#pragma unroll
        for (int nb = 0; nb < 4; ++nb) red[(rg * 4 + nb) * 64 + lane] = acc[nb];
    }
    __syncthreads();
    if (kh == 0) {
        const int pos = row & (SEQ - 1);
#pragma unroll
        for (int nb = 0; nb < 4; ++nb) { const int j0 = 8 * nb + 2 * fq; const f32x4 r = *(const f32x4*)(ROPE + (size_t)pos * 32 + j0); const f32x4 v = acc[nb] + red[(rg * 4 + nb) * 64 + lane];
            v2u o; o.x = pk2(v[0] * r[0] - v[1] * r[1], v[0] * r[1] + v[1] * r[0]); o.y = pk2(v[2] * r[2] - v[3] * r[3], v[2] * r[3] + v[3] * r[2]);
            *(v2u*)(KPE + (size_t)row * 64 + 16 * nb + 4 * fq) = o; }
    }
    __syncthreads();
}
namespace att {
typedef short v4i16_t __attribute__((ext_vector_type(4)));
#define MFMA32(a, b, c) __builtin_amdgcn_mfma_f32_32x32x16_bf16((a), (b), (c), 0, 0, 0)
__device__ __forceinline__ s16x4 vtr(const LAS unsigned char* p) { return __builtin_bit_cast(s16x4, __builtin_amdgcn_ds_read_tr16_b64_v4i16((LAS v4i16_t*)p)); }
__device__ __forceinline__ int crow(int r, int hi) { return (r & 3) + 8 * (r >> 2) + 4 * hi; }
constexpr int VS = 320;
constexpr int KS = 400;
constexpr float NEG = -1e30f;

__device__ __forceinline__ bf16x8 pack8r(const f32x16& p, int s) {
    v4u w; w.x = pk2(p[8 * s + 0], p[8 * s + 1]); w.y = pk2(p[8 * s + 2], p[8 * s + 3]); w.z = pk2(p[8 * s + 4], p[8 * s + 5]); w.w = pk2(p[8 * s + 6], p[8 * s + 7]);
    return __builtin_bit_cast(bf16x8, w);
}
__device__ __forceinline__ void pv32(f32x16 (&o)[4], const LAS unsigned char* vb, const bf16x8 pb0, const bf16x8 pb1) {
#pragma unroll
    for (int d = 0; d < 4; ++d) {
        const s16x4 l0 = vtr(vb + d * 64), h0 = vtr(vb + d * 64 + 8 * VS), l1 = vtr(vb + d * 64 + 16 * VS), h1 = vtr(vb + d * 64 + 24 * VS);
        const bf16x8 a0 = __builtin_shufflevector(l0, h0, 0, 1, 2, 3, 4, 5, 6, 7), a1 = __builtin_shufflevector(l1, h1, 0, 1, 2, 3, 4, 5, 6, 7);
        o[d] = MFMA32(a0, pb0, o[d]); o[d] = MFMA32(a1, pb1, o[d]);
    }
}
template <int NS>
__device__ __forceinline__ void softmax_step(f32x16 (&s)[NS], float& m, float& l, f32x16 (&o)[4], bf16x8 (&pb)[2 * NS]) {
    float mx = s[0][0];
#pragma unroll
    for (int t = 0; t < NS; ++t)
#pragma unroll
        for (int r = 0; r < 16; ++r) mx = fmaxf(mx, s[t][r]);
    mx = fmaxf(mx, __shfl_xor(mx, 32));
    const float mn = fmaxf(m, mx), alpha = __builtin_amdgcn_exp2f(m - mn); m = mn;
    float ps = 0.f;
#pragma unroll
    for (int t = 0; t < NS; ++t)
#pragma unroll
        for (int r = 0; r < 16; ++r) { const float p = __builtin_amdgcn_exp2f(s[t][r] - mn); s[t][r] = p; ps += p; }
    l = l * alpha + ps;
    if (!__all(alpha == 1.0f)) {
#pragma unroll
        for (int d = 0; d < 4; ++d) o[d] = o[d] * alpha;
    }
#pragma unroll
    for (int t = 0; t < NS; ++t) { pb[2 * t] = pack8r(s[t], 0); pb[2 * t + 1] = pack8r(s[t], 1); }
}
__device__ __forceinline__ void store_o(f32x16 (&o)[4], float l, bf16* __restrict__ orow  , float* __restrict__ ssq  , int hh) {
    l += __shfl_xor(l, 32);
    const float inv = 1.0f / l; float ss = 0.f;
#pragma unroll
    for (int d = 0; d < 4; ++d) { o[d] = o[d] * inv;
#pragma unroll
        for (int g = 0; g < 4; ++g) { const float a = o[d][4 * g], b = o[d][4 * g + 1], c = o[d][4 * g + 2], e = o[d][4 * g + 3];
            ss += (a * a + b * b) + (c * c + e * e);
            v2u w; w.x = pk2(a, b); w.y = pk2(c, e); *(v2u*)(orow + 32 * d + 8 * g + 4 * hh) = w; } }
    ss += __shfl_xor(ss, 32);
    if (hh == 0) *ssq = ss;
}

constexpr int KTB = 64 * KS, VTB = 64 * VS, BUFB = KTB + VTB;
__device__ __forceinline__ void mla_unit(const unsigned char* ws, LAS unsigned char* lds, int b, int h, int qblk, int tid, int wave, int lane) {
    const bf16* QN = (const bf16*)(ws + WS_QN); const bf16* QPE = (const bf16*)(ws + WS_QPE);
    bf16* O = (bf16*)(ws + WS_A); float* SSQO = (float*)(ws + WS_SSQO);
    const int r32 = lane & 31, hh = lane >> 5;
    const size_t tok0 = (size_t)b * SEQ;
    const int row_lo = qblk * 256 + wave * 32, qrow = row_lo + r32;
    bf16x8 qf[12];
    { const bf16* qn = QN + (tok0 + qrow) * 1024 + h * 128 + 8 * hh;
#pragma unroll
      for (int s = 0; s < 8; ++s) qf[s] = *(const bf16x8*)(qn + 16 * s);
      const bf16* qp = QPE + (tok0 + qrow) * 512 + h * 64 + 8 * hh;
#pragma unroll
      for (int s = 0; s < 4; ++s) qf[8 + s] = *(const bf16x8*)(qp + 16 * s); }
    const int c0 = tid, c1 = tid + 512;
    const unsigned okn0 = (unsigned)WS_KN + (unsigned)(((unsigned)tok0 + (c0 >> 4)) * 1024u + h * 128 + (c0 & 15) * 8) * 2u, okn1 = okn0 + 32u * 1024u * 2u;
    const unsigned okp = (unsigned)WS_KPE + (unsigned)(((unsigned)tok0 + (tid >> 3)) * 64u + (tid & 7) * 8) * 2u;
    const unsigned ov0 = okn0 + (unsigned)(WS_VM - WS_KN), ov1 = ov0 + 32u * 1024u * 2u;
    const int lkn0 = (c0 >> 4) * KS + (c0 & 15) * 16, lkn1 = (c1 >> 4) * KS + (c1 & 15) * 16, lkp = (tid >> 3) * KS + 256 + (tid & 7) * 16;
    const int lv0 = KTB + (c0 >> 4) * VS + (c0 & 15) * 16, lv1 = KTB + (c1 >> 4) * VS + (c1 & 15) * 16;
    v4u st0, st1, st2, st3, st4;
#define MLA_GLOAD(kt) do { const unsigned _o = (unsigned)(kt) * 131072u, _p = (unsigned)(kt) * 8192u; st0 = *(const v4u*)(ws + (size_t)(okn0 + _o)); st1 = *(const v4u*)(ws + (size_t)(okn1 + _o)); \
        st2 = *(const v4u*)(ws + (size_t)(okp + _p)); st3 = *(const v4u*)(ws + (size_t)(ov0 + _o)); st4 = *(const v4u*)(ws + (size_t)(ov1 + _o)); } while (0)
#define MLA_LWRITE(buf) do { LAS unsigned char* _b = lds + (buf) * BUFB; *(LAS v4u*)(_b + lkn0) = st0; *(LAS v4u*)(_b + lkn1) = st1; *(LAS v4u*)(_b + lkp) = st2; \
        *(LAS v4u*)(_b + lv0) = st3; *(LAS v4u*)(_b + lv1) = st4; } while (0)
    const int nkt = 4 * (qblk + 1);
    MLA_GLOAD(0); MLA_LWRITE(0);
    __syncthreads();
    f32x16 o[4];
#pragma unroll
    for (int d = 0; d < 4; ++d)
#pragma unroll
        for (int r = 0; r < 16; ++r) o[d][r] = 0.f;
    float m = NEG, l = 0.f;
    const int kread = r32 * KS + 16 * hh;
    const int vread = KTB + (4 * hh + ((lane & 15) >> 2)) * VS + (16 * ((lane >> 4) & 1) + 4 * (lane & 3)) * 2;
    for (int kt = 0; kt < nkt; ++kt) {
        if (kt + 1 < nkt) MLA_GLOAD(kt + 1);
        const int k0 = kt * 64;
        if (k0 <= row_lo + 31) {
            const LAS unsigned char* kb = lds + (kt & 1) * BUFB;
            const bool diag = (k0 + 63 > row_lo);
#pragma unroll
            for (int sub = 0; sub < 2; ++sub) {
                if (sub == 1 && k0 + 32 > row_lo + 31) break;
                f32x16 s[1];
#pragma unroll
                for (int r = 0; r < 16; ++r) s[0][r] = 0.f;
#pragma unroll
                for (int ks = 0; ks < 12; ++ks) { const bf16x8 kf = *(const LAS bf16x8*)(kb + kread + sub * 32 * KS + 32 * ks); s[0] = MFMA32(kf, qf[ks], s[0]); }
                if (diag) {
#pragma unroll
                    for (int r = 0; r < 16; ++r) { const int key = k0 + 32 * sub + crow(r, hh); if (key > qrow) s[0][r] = NEG; }
                }
                bf16x8 pb[2];
                softmax_step<1>(s, m, l, o, pb);
                pv32(o, kb + vread + sub * 32 * VS, pb[0], pb[1]);
            }
        }
        if (kt + 1 < nkt) MLA_LWRITE((kt + 1) & 1);
        __syncthreads();
    }
#undef MLA_GLOAD
#undef MLA_LWRITE
    store_o(o, l, O + (tok0 + qrow) * 2048 + 1024 + h * 128, SSQO + (tok0 + qrow) * 16 + 8 + h, hh);
}

constexpr int DKS = 272, DSH = 32 * DKS + 32 * VS;
__device__ __forceinline__ void dil_tile(const unsigned char* ws, LAS unsigned char* vl  , LAS unsigned char* sh  , int b, int h, int j, int r16, int tid, int lane) {
    const bf16* QKV = (const bf16*)(ws + WS_B);
    const int r32 = lane & 31, hh = lane >> 5;
    const size_t tok0 = (size_t)b * SEQ;
    const int tq = 512 * j + 16 * r32 + r16;
    bf16x8 qf[8];
    { const bf16* qp = QKV + (tok0 + tq) * 3072 + h * 128 + 8 * hh;
#pragma unroll
      for (int s = 0; s < 8; ++s) qf[s] = *(const bf16x8*)(qp + 16 * s); }
    const float slope2 = __builtin_amdgcn_exp2f(-(float)(h + 1)) * LOG2E;
    const int m0 = (j == 0) ? 4 : 0, n3 = j + 1, n2 = 8 - m0, n1 = 20 - m0, nt = n3 + n2;
    const unsigned vcol = (unsigned)WS_B + ((unsigned)tok0 * 3072u + 2048u + h * 128 + (lane & 15) * 8) * 2u;
    const int vrow = lane >> 4;
    const int vwr = vrow * VS + (lane & 15) * 16;
    const int vread = (4 * hh + ((lane & 15) >> 2)) * VS + (16 * ((lane >> 4) & 1) + 4 * (lane & 3)) * 2;
    int kbase, kstride, maxd;
#define DIL_DESC(idx) do { const int _i = (idx); if (_i < n3) { kbase = 512 * (j - _i) + r16; kstride = 16; maxd = 2048; } \
        else if (_i < n3 + n2) { kbase = 4 * (128 * j - 128 + 32 * (m0 + _i - n3)) + (r16 & 3); kstride = 4; maxd = 512; } \
        else { kbase = 512 * j - 128 + 32 * (m0 + _i - n3 - n2); kstride = 1; maxd = 128; } } while (0)
    v4u kq[8], vq[8];
    const unsigned kcc = (unsigned)WS_B + ((unsigned)tok0 * 3072u + 1024u + h * 128 + (lane & 15) * 8) * 2u;
    const int kwr = vrow * DKS + (lane & 15) * 16, kfr = r32 * DKS + 16 * hh;
    DIL_DESC(0);
#pragma unroll
    for (int i = 0; i < 8; ++i) { const unsigned ro = (unsigned)(kbase + kstride * (4 * i + vrow)) * 6144u; kq[i] = *(const v4u*)(ws + (size_t)(kcc + ro)); vq[i] = *(const v4u*)(ws + (size_t)(vcol + ro)); }
    f32x16 o[4];
#pragma unroll
    for (int d = 0; d < 4; ++d)
#pragma unroll
        for (int r = 0; r < 16; ++r) o[d][r] = 0.f;
    float m = NEG, l = 0.f;
    for (int idx = 0; idx < nt; ++idx) {
        const int cb = kbase, cs = kstride, cm = maxd;
        const bool more = idx + 1 < nt;
#pragma unroll
        for (int i = 0; i < 8; ++i) *(LAS v4u*)(vl + kwr + 4 * i * DKS) = kq[i];
        if (more) { DIL_DESC(idx + 1);
#pragma unroll
            for (int i = 0; i < 8; ++i) kq[i] = *(const v4u*)(ws + (size_t)(kcc + (unsigned)(kbase + kstride * (4 * i + vrow)) * 6144u)); }
        f32x16 s[1];
#pragma unroll
        for (int r = 0; r < 16; ++r) s[0][r] = 0.f;
#pragma unroll
        for (int ks = 0; ks < 8; ++ks) { const bf16x8 kf = *(const LAS bf16x8*)(vl + kfr + 32 * ks); s[0] = MFMA32(kf, qf[ks], s[0]); }
#pragma unroll
        for (int i = 0; i < 8; ++i) *(LAS v4u*)(vl + vwr + 4 * i * VS) = vq[i];
        if (more) {
#pragma unroll
            for (int i = 0; i < 8; ++i) vq[i] = *(const v4u*)(ws + (size_t)(vcol + (unsigned)(kbase + kstride * (4 * i + vrow)) * 6144u)); }
        const int d0 = tq - cb - cs * 4 * hh;
#pragma unroll
        for (int r = 0; r < 16; ++r) { const int dist = d0 - cs * ((r & 3) + 8 * (r >> 2)); const float v = s[0][r] - slope2 * (float)dist; s[0][r] = ((unsigned)dist <= (unsigned)cm) ? v : NEG; }
        bf16x8 pb[2];
        softmax_step<1>(s, m, l, o, pb);
        pv32(o, vl + vread, pb[0], pb[1]);
    }
#undef DIL_DESC
    {
        const int kb0 = 512 * j - 128 + 32 * m0;
        const int row = tid >> 4, ch = tid & 15;
        const unsigned gk = (unsigned)WS_B + (((unsigned)tok0 + kb0 + row) * 3072u + 1024u + h * 128 + ch * 8) * 2u;
        const int lk = row * DKS + ch * 16, lv = 32 * DKS + row * VS + ch * 16;
        const int kread = r32 * DKS + 16 * hh;
        const int vread1 = 32 * DKS + (4 * hh + ((lane & 15) >> 2)) * VS + (16 * ((lane >> 4) & 1) + 4 * (lane & 3)) * 2;
        v4u sk = *(const v4u*)(ws + (size_t)gk), sv = *(const v4u*)(ws + (size_t)(gk + 2048u));
        *(LAS v4u*)(sh + lk) = sk; *(LAS v4u*)(sh + lv) = sv;
        __syncthreads();
        for (int mi = 0; mi < n1; ++mi) {
            const bool more = mi + 1 < n1;
            if (more) { const unsigned g2 = gk + (unsigned)(mi + 1) * 32u * 6144u; sk = *(const v4u*)(ws + (size_t)g2); sv = *(const v4u*)(ws + (size_t)(g2 + 2048u)); }
            const LAS unsigned char* tb = sh + (mi & 1) * DSH;
            f32x16 s[1];
#pragma unroll
            for (int r = 0; r < 16; ++r) s[0][r] = 0.f;
#pragma unroll
            for (int ks = 0; ks < 8; ++ks) { const bf16x8 kf = *(const LAS bf16x8*)(tb + kread + 32 * ks); s[0] = MFMA32(kf, qf[ks], s[0]); }
            const int d0 = tq - (kb0 + 32 * mi) - 4 * hh;
#pragma unroll
            for (int r = 0; r < 16; ++r) { const int dist = d0 - ((r & 3) + 8 * (r >> 2)); const float v = s[0][r] - slope2 * (float)dist; s[0][r] = ((unsigned)dist <= 128u) ? v : NEG; }
            bf16x8 pb[2];
            softmax_step<1>(s, m, l, o, pb);
            pv32(o, tb + vread1, pb[0], pb[1]);
            if (more) { LAS unsigned char* nb = sh + ((mi + 1) & 1) * DSH; *(LAS v4u*)(nb + lk) = sk; *(LAS v4u*)(nb + lv) = sv; }
            __syncthreads();
        }
    }
    store_o(o, l, (bf16*)(const_cast<unsigned char*>(ws) + WS_A) + (tok0 + tq) * 2048 + h * 128, (float*)(const_cast<unsigned char*>(ws) + WS_SSQO) + (tok0 + tq) * 16 + h, hh);
}

__device__ __forceinline__ void phase_attn(const Params& P, LAS unsigned char* lds, int vcu, int G, int wave) {
    const int lane = hw_lane(), tid = wave * 64 + lane;
    const unsigned char* ws = P.ws;
#ifndef REP_MLA
#define REP_MLA 1
#endif
#ifndef REP_DIL
#define REP_DIL 1
#endif
    for (int rm_ = 0; rm_ < REP_MLA; ++rm_)
    for (int u = vcu; u < 256; u += G) { const int bh = u >> 2, pr = u & 3;
        mla_unit(ws, lds, bh >> 3, bh & 7, 7 - pr, tid, wave, lane);
        mla_unit(ws, lds, bh >> 3, bh & 7, pr, tid, wave, lane); }
    __syncthreads();
    LAS unsigned char* vl = lds + wave * (32 * VS); LAS unsigned char* sh = lds + NWAVES * (32 * VS);
    for (int rd_ = 0; rd_ < REP_DIL; ++rd_)
    if (G == 256) {
#pragma unroll 1
        for (int k = 0; k < 2; ++k) { const int t = (vcu >> 5) * 512 + k * 256 + (vcu & 31) * 8 + wave; const int bh = t >> 6, rem = t & 63, jj = rem >> 4, r16 = rem & 15;
            dil_tile(ws, vl, sh, bh >> 3, bh & 7, k == 0 ? jj : 3 - jj, r16, tid, lane); }
    } else {
#pragma unroll 1
        for (int t = vcu * 8 + wave; t < 4096; t += G * 8) { const int bh = t >> 6, rem = t & 63; dil_tile(ws, vl, sh, bh >> 3, bh & 7, rem >> 4, rem & 15, tid, lane); }
    }
}
}
namespace peer {
typedef __bf16 bf2_t __attribute__((ext_vector_type(2)));
#define MFMA32(a, b, c) __builtin_amdgcn_mfma_f32_32x32x16_bf16((a), (b), (c), 0, 0, 0)
__device__ __forceinline__ float fmax3(float a, float b, float c) { return fmaxf(fmaxf(a, b), c); }
__device__ __forceinline__ float asf(unsigned u) { return __builtin_bit_cast(float, u); }
__device__ __forceinline__ unsigned asu(float f) { return __builtin_bit_cast(unsigned, f); }

__device__ __forceinline__ void ce_desc(float& a, float& b) { const float hi = fmaxf(a, b), lo = fminf(a, b); a = hi; b = lo; }
template <bool DESC> __device__ __forceinline__ void bitonic_merge16(float (&t)[16]) {
#pragma unroll
    for (int j = 8; j > 0; j >>= 1)
#pragma unroll
        for (int i = 0; i < 16; ++i) { const int l = i ^ j; if (l > i) { if (DESC) ce_desc(t[i], t[l]); else ce_desc(t[l], t[i]); } }
}
__device__ __forceinline__ void top16_of_64(float (&v)[64], float (&out)[16]) {
#pragma unroll
    for (int k = 2; k <= 16; k <<= 1)
#pragma unroll
        for (int j = k >> 1; j > 0; j >>= 1)
#pragma unroll
            for (int i = 0; i < 64; ++i) { const int l = i ^ j; if (l > i) { if ((i & k) == 0) ce_desc(v[i], v[l]); else ce_desc(v[l], v[i]); } }
    float t0[16], t1[16];
#pragma unroll
    for (int i = 0; i < 16; ++i) { t0[i] = fmaxf(v[i], v[16 + i]); t1[i] = fmaxf(v[32 + i], v[48 + i]); }
    bitonic_merge16<true>(t0); bitonic_merge16<false>(t1);
#pragma unroll
    for (int i = 0; i < 16; ++i) out[i] = fmaxf(t0[i], t1[i]);
    bitonic_merge16<true>(out);
}
__device__ __forceinline__ void route_item(const unsigned char* ws, LAS unsigned* sc, int tile, int h, int lane) {
    const bf16* QP = (const bf16*)(ws + WS_QP); const bf16* SK = (const bf16*)(ws + WS_SK);
    int* RIDX = (int*)(ws + WS_RIDX); float* RGATE = (float*)(ws + WS_RGATE);
    const int r32 = lane & 31, hh = lane >> 5;
    const size_t tok = (size_t)tile * 32 + r32;
    float rs2; { const f32x4* sp = (const f32x4*)((const float*)(ws + WS_SSQH) + tok * 32); f32x4 a = sp[0];
#pragma unroll
        for (int i = 1; i < 8; ++i) a = a + sp[i];
        rs2 = rsqrtf(((a[0] + a[1]) + (a[2] + a[3])) * (1.f / 2048.f) + EPS); }
#pragma unroll 1
    for (int p = 0; p < 2; ++p) {
        f32x16 s[4];
#pragma unroll
        for (int kb = 0; kb < 4; ++kb)
#pragma unroll
            for (int r = 0; r < 16; ++r) s[kb][r] = 0.f;
        const bf16* qp = QP + tok * 2048 + h * 256 + p * 128 + 8 * hh;
        const bf16* kp = SK + ((size_t)(h * 2 + p) * 128 + r32) * 128 + 8 * hh;
#pragma unroll
        for (int ks = 0; ks < 8; ++ks) { const bf16x8 q = *(const bf16x8*)(qp + 16 * ks);
#pragma unroll
            for (int kb = 0; kb < 4; ++kb) { const bf16x8 k = *(const bf16x8*)(kp + (size_t)kb * 32 * 128 + 16 * ks); s[kb] = MFMA32(k, q, s[kb]); } }
#pragma unroll
        for (int kb = 0; kb < 4; ++kb)
#pragma unroll
            for (int r = 0; r < 16; ++r) s[kb][r] = asf((asu(s[kb][r] * rs2) & ~127u) | (unsigned)(32 * kb + (r & 3) + 8 * (r >> 2) + 4 * hh));
        {
            float v[64], u[16];
#pragma unroll
            for (int kb = 0; kb < 4; ++kb)
#pragma unroll
                for (int r = 0; r < 16; ++r) v[16 * kb + r] = s[kb][r];
            top16_of_64(v, u);
            float w[16];
#pragma unroll
            for (int i = 0; i < 16; ++i) w[i] = fmaxf(u[i], __shfl_xor(u[15 - i], 32));
            bitonic_merge16<true>(w);
            if (hh == 0) {
#pragma unroll
                for (int i = 0; i < 16; i += 4) *(LAS v4u*)(sc + (p * 32 + r32) * 16 + i) = (v4u){asu(w[i]), asu(w[i + 1]), asu(w[i + 2]), asu(w[i + 3])};
            }
        }
    }
    unsigned t1[16], t2[16];
#pragma unroll
    for (int i = 0; i < 16; i += 4) { const v4u a = *(const LAS v4u*)(sc + r32 * 16 + i), b = *(const LAS v4u*)(sc + (32 + r32) * 16 + i);
        t1[i] = a.x; t1[i + 1] = a.y; t1[i + 2] = a.z; t1[i + 3] = a.w; t2[i] = b.x; t2[i + 1] = b.y; t2[i + 2] = b.z; t2[i + 3] = b.w; }
    float c[64]; int n = 0;
#pragma unroll
    for (int i = 0; i < 16; ++i)
#pragma unroll
        for (int j = 0; j < 16; ++j) if ((i + 1) * (j + 1) <= 16) { const float v = asf(t1[i] & ~127u) + asf(t2[j] & ~127u); c[n] = asf((asu(v) & ~255u) | (unsigned)(i * 16 + j)); ++n; }
#pragma unroll
    for (int q = 50; q < 64; ++q) c[q] = -3.0e38f;
    float top[16];
    top16_of_64(c, top);
    float best[8]; const float bmax = asf(asu(top[0]) & ~255u); float esum = 0.f;
#pragma unroll
    for (int k = 0; k < 16; ++k) { esum += __expf(asf(asu(top[k]) & ~255u) - bmax); if ((k >> 3) == hh) best[k & 7] = top[k]; }
    const float inv = 1.0f / esum;
    int idx[8]; float gate[8];
#pragma unroll
    for (int k = 0; k < 8; ++k) { const unsigned code = asu(best[k]) & 255u; const unsigned a = sc[r32 * 16 + (code >> 4)], b = sc[(32 + r32) * 16 + (code & 15)];
        idx[k] = (int)((a & 127u) * 128u + (b & 127u)); gate[k] = __expf(asf(asu(best[k]) & ~255u) - bmax) * inv; }
    int* ip = RIDX + tok * 128 + h * 16 + 8 * hh; float* gp = RGATE + tok * 128 + h * 16 + 8 * hh;
    *(v4u*)ip = (v4u){(unsigned)idx[0], (unsigned)idx[1], (unsigned)idx[2], (unsigned)idx[3]}; *(v4u*)(ip + 4) = (v4u){(unsigned)idx[4], (unsigned)idx[5], (unsigned)idx[6], (unsigned)idx[7]};
    *(f32x4*)gp = (f32x4){gate[0], gate[1], gate[2], gate[3]}; *(f32x4*)(gp + 4) = (f32x4){gate[4], gate[5], gate[6], gate[7]};
}

__device__ __forceinline__ void phase_route(const Params& P, LAS unsigned char* lds, int vcu, int G, int wave) {
    const int lane = hw_lane();
    LAS unsigned* sc = (LAS unsigned*)(lds + wave * 4096);
#pragma unroll 1
    for (int it = vcu * NWAVES + wave; it < 512 * 8; it += G * NWAVES) route_item(P.ws, sc, it >> 3, it & 7, lane);
}

__device__ __forceinline__ float dot16_f8(const float (&x)[16], const v4u& u, float c) {
    const int u0 = (int)u.x, u1 = (int)u.y, u2 = (int)u.z, u3 = (int)u.w;
    const f32x2 a0 = __builtin_amdgcn_cvt_pk_f32_fp8(u0, false), a1 = __builtin_amdgcn_cvt_pk_f32_fp8(u0, true);
    const f32x2 a2 = __builtin_amdgcn_cvt_pk_f32_fp8(u1, false), a3 = __builtin_amdgcn_cvt_pk_f32_fp8(u1, true);
    const f32x2 a4 = __builtin_amdgcn_cvt_pk_f32_fp8(u2, false), a5 = __builtin_amdgcn_cvt_pk_f32_fp8(u2, true);
    const f32x2 a6 = __builtin_amdgcn_cvt_pk_f32_fp8(u3, false), a7 = __builtin_amdgcn_cvt_pk_f32_fp8(u3, true);
    c = fmaf(x[0], a0.x, c); c = fmaf(x[1], a0.y, c); c = fmaf(x[2], a1.x, c); c = fmaf(x[3], a1.y, c);
    c = fmaf(x[4], a2.x, c); c = fmaf(x[5], a2.y, c); c = fmaf(x[6], a3.x, c); c = fmaf(x[7], a3.y, c);
    c = fmaf(x[8], a4.x, c); c = fmaf(x[9], a4.y, c); c = fmaf(x[10], a5.x, c); c = fmaf(x[11], a5.y, c);
    c = fmaf(x[12], a6.x, c); c = fmaf(x[13], a6.y, c); c = fmaf(x[14], a7.x, c); c = fmaf(x[15], a7.y, c);
    return c;
}
__device__ __forceinline__ void unpack8(float* x, const v4u& v) { x[0] = bflo(v.x); x[1] = bfhi(v.x); x[2] = bflo(v.y); x[3] = bfhi(v.y); x[4] = bflo(v.z); x[5] = bfhi(v.z); x[6] = bflo(v.w); x[7] = bfhi(v.w); }
#ifndef U_WAVES
#define U_WAVES 8
#endif
__device__ __forceinline__ void peer_u_wave(const Params& P, LAS unsigned* sc  , int t0, int tstep, int tend, int lane) {
    const unsigned char* ws = P.ws;
    const bf16* H1B = (const bf16*)(ws + WS_B); const unsigned char* U8 = ws + WS_UB;
    const int* RIDX = (const int*)(ws + WS_RIDX); const float* RGATE = (const float*)(ws + WS_RGATE); const float* SSQH = (const float*)(ws + WS_SSQH);
    const unsigned long long ltmask = (1ull << lane) - 1ull;
    unsigned* PKV = (unsigned*)(ws + WS_PKV);
    if (t0 >= tend) return;
    int i0, i1; float g0, g1, rs2; float x[32];
    int i0n, i1n; float g0n, g1n, ssn; v4u xa, xb, xc, xd;
#define PU_META(t) do { const size_t _t = (size_t)(t); const bf16* hp = H1B + _t * 2048 + 32 * lane; xa = *(const v4u*)hp; xb = *(const v4u*)(hp + 8); xc = *(const v4u*)(hp + 16); xd = *(const v4u*)(hp + 24); \
        ssn = lane < 32 ? SSQH[_t * 32 + lane] : 0.f; i0n = RIDX[_t * 128 + lane]; i1n = RIDX[_t * 128 + 64 + lane]; g0n = RGATE[_t * 128 + lane]; g1n = RGATE[_t * 128 + 64 + lane]; } while (0)
#define PU_SORT() do {   \
        { const int q0 = i0n >> 10, q1 = i1n >> 10; int off = 0, pos0 = 0, pos1 = 0; \
          _Pragma("unroll") for (int gq = 0; gq < 16; ++gq) { const unsigned long long m0 = __ballot(q0 == gq), m1 = __ballot(q1 == gq); const int c0 = __popcll(m0), c1 = __popcll(m1); \
              if (q0 == gq) pos0 = off + __popcll(m0 & ltmask); if (q1 == gq) pos1 = off + c0 + __popcll(m1 & ltmask); off += c0 + c1; } \
          sc[pos0] = (unsigned)i0n; sc[pos1] = (unsigned)i1n; sc[128 + pos0] = asu(g0n); sc[128 + pos1] = asu(g1n); \
          i0n = (int)sc[lane]; i1n = (int)sc[64 + lane]; g0n = asf(sc[128 + lane]); g1n = asf(sc[192 + lane]); } } while (0)
#define PU_SWAP() do { i0 = i0n; i1 = i1n; g0 = g0n; g1 = g1n; \
        unpack8(x, xa); unpack8(x + 8, xb); unpack8(x + 16, xc); unpack8(x + 24, xd); \
        rs2 = rsqrtf(wave_sum(ssn) * (1.f / 2048.f) + EPS) * (1.f / U6_SCALE); } while (0)
#define PU_LOAD(buf4, buf2, ia, ib, g) do { _Pragma("unroll") for (int e = 0; e < 8; ++e) { const int row = __builtin_amdgcn_readlane((g) < 8 ? ia : ib, ((g) & 7) * 8 + e); \
        const unsigned char* up = U8 + (size_t)row * 1536 + 16 * lane; buf4[e] = *(const v4u*)up; buf2[e] = *(const v2u*)(up + 1024 - 8 * lane); } } while (0)
#define PU_COMPUTE(buf4, buf2, g) do { float pt[8]; _Pragma("unroll") for (int e = 0; e < 8; ++e) { \
            const f32x32 r = __builtin_amdgcn_cvt_scalef32_pk32_f32_fp6((v6u){buf4[e].x, buf4[e].y, buf4[e].z, buf4[e].w, buf2[e].x, buf2[e].y}, 1.0f); \
            float s0 = 0.f, s1 = 0.f; _Pragma("unroll") for (int k = 0; k < 16; ++k) { s0 = fmaf(x[k], r[2 * k], s0); s1 = fmaf(x[16 + k], r[2 * k + 1], s1); } pt[e] = s0 + s1; }     \
        float a4[4], a2[2], a1; \
        _Pragma("unroll") for (int i = 0; i < 4; ++i) { const float keep = (lane & 1) ? pt[2 * i + 1] : pt[2 * i], give = (lane & 1) ? pt[2 * i] : pt[2 * i + 1]; a4[i] = keep + __shfl_xor(give, 1); } \
        _Pragma("unroll") for (int i = 0; i < 2; ++i) { const float keep = (lane & 2) ? a4[2 * i + 1] : a4[2 * i], give = (lane & 2) ? a4[2 * i] : a4[2 * i + 1]; a2[i] = keep + __shfl_xor(give, 2); } \
        { const float keep = (lane & 4) ? a2[1] : a2[0], give = (lane & 4) ? a2[0] : a2[1]; a1 = keep + __shfl_xor(give, 4); } \
        a1 += __shfl_xor(a1, 8); a1 += __shfl_xor(a1, 16); a1 += __shfl_xor(a1, 32); \
        if ((lane >> 3) == ((g) & 7)) { if ((g) < 8) d0 = a1; else d1 = a1; } } while (0)
    v4u ra4[8], rb4[8]; v2u ra2[8], rb2[8];
    PU_META(t0); PU_SORT(); PU_SWAP();
    PU_LOAD(ra4, ra2, i0, i1, 0);
#pragma unroll 1
    for (int t = t0; t < tend; t += tstep) {
        const bool more = t + tstep < tend;
        float d0 = 0.f, d1 = 0.f;
#pragma unroll 1
        for (int g = 0; g < 16; g += 2) {
            PU_LOAD(rb4, rb2, i0, i1, g + 1);
            if (g == 10 && more) PU_META(t + tstep);
            PU_COMPUTE(ra4, ra2, g);
            if (g + 2 < 16) PU_LOAD(ra4, ra2, i0, i1, g + 2); else if (more) { PU_SORT(); PU_LOAD(ra4, ra2, i0n, i1n, 0); }
            PU_COMPUTE(rb4, rb2, g + 1);
        }
        const size_t tok = (size_t)t;
        const float z0 = d0 * rs2, z1 = d1 * rs2;
        const float a0 = 8.0f * z0 * (1.0f + erff(z0 * 0.7071067811865476f)) * g0, a1v = 8.0f * z1 * (1.0f + erff(z1 * 0.7071067811865476f)) * g1;
        unsigned* pk = PKV + ((tok >> 6) * 128) * 64 + (tok & 63) * 4;
        pk[(size_t)(lane >> 2) * 256 + (lane & 3)] = ((unsigned)i0 << 2) | ((unsigned)__builtin_bit_cast(unsigned short, (_Float16)a0) << 16);
        pk[(size_t)(16 + (lane >> 2)) * 256 + (lane & 3)] = ((unsigned)i1 << 2) | ((unsigned)__builtin_bit_cast(unsigned short, (_Float16)a1v) << 16);
        if (more) PU_SWAP();
    }
#undef PU_META
#undef PU_SORT
#undef PU_SWAP
#undef PU_LOAD
#undef PU_COMPUTE
}
__device__ __forceinline__ void phase_peer_u(const Params& P, LAS unsigned char* lds, int vcu, int G, int wave) {
    const int lane = hw_lane();
    if (wave >= U_WAVES) return;
    peer_u_wave(P, (LAS unsigned*)(lds + wave * 1024), vcu * U_WAVES + wave, G * U_WAVES, M, lane);
}
typedef _Float16 h2_t __attribute__((ext_vector_type(2)));
__device__ __forceinline__ void peer_v_range(const Params& P, int c, int b0, int b1, int wv, int nwv, int lane) {
    const unsigned char* ws = P.ws;
    const bf16* H1B = (const bf16*)(ws + WS_B); const unsigned* PKV = (const unsigned*)(ws + WS_PKV);
    if (b0 + wv >= b1) return;
    unsigned w0[16], w1[16], w2[16], w3[16];
#define PV_LOAD(buf) do { _Pragma("unroll") for (int q = 0; q < 4; ++q) { const v4u t4 = pl[q * 64]; buf[4 * q] = t4.x; buf[4 * q + 1] = t4.y; buf[4 * q + 2] = t4.z; buf[4 * q + 3] = t4.w; } pl += 4 * 64; asm volatile("" : "+v"(pl)); } while (0)
#define PV_PROC(buf) do { v2u vv[16]; _Pragma("unroll") for (int i = 0; i < 16; ++i) vv[i] = *(const LAS v2u*)(size_t)((buf[i] << 1) & 0x1fff8u);     \
        _Pragma("unroll") for (int i = 0; i < 16; ++i) { const _Float16 ah = __builtin_bit_cast(_Float16, (unsigned short)(buf[i] >> 16)); const h2_t a2 = {ah, ah}; \
            y0 = __builtin_elementwise_fma(a2, __builtin_bit_cast(h2_t, __builtin_amdgcn_cvt_scalef32_pk_f16_fp8(vv[i].x, 1.0f, false)), y0); \
            y1 = __builtin_elementwise_fma(a2, __builtin_bit_cast(h2_t, __builtin_amdgcn_cvt_scalef32_pk_f16_fp8(vv[i].x, 1.0f, true)), y1); \
            y2 = __builtin_elementwise_fma(a2, __builtin_bit_cast(h2_t, __builtin_amdgcn_cvt_scalef32_pk_f16_fp8(vv[i].y, 1.0f, false)), y2); \
            y3 = __builtin_elementwise_fma(a2, __builtin_bit_cast(h2_t, __builtin_amdgcn_cvt_scalef32_pk_f16_fp8(vv[i].y, 1.0f, true)), y3); } } while (0)
    const v4u* pl = (const v4u*)PKV + (size_t)(b0 + wv) * 32 * 64 + lane;
    PV_LOAD(w0); PV_LOAD(w1); PV_LOAD(w2);
    v4u hxn = *(const v4u*)(H1B + ((size_t)(b0 + wv) * 64 + lane) * 2048 + 8 * c);
#pragma unroll 1
    for (int b = b0 + wv; b < b1; b += nwv) {
        const size_t tok = (size_t)b * 64 + lane;
        const int bn = (b + nwv < b1) ? b + nwv : b;
        h2_t y0 = {0, 0}, y1 = {0, 0}, y2 = {0, 0}, y3 = {0, 0};
        v4u hx = hxn;
#pragma unroll 1
        for (int half = 0; half < 2; ++half) {
            PV_LOAD(w3); PV_PROC(w0);
            if (half == 1) { hxn = *(const v4u*)(H1B + ((size_t)bn * 64 + lane) * 2048 + 8 * c); pl += (ptrdiff_t)(bn - b - 1) * 32 * 64; }
            PV_LOAD(w0); PV_PROC(w1);
            PV_LOAD(w1); PV_PROC(w2);
            PV_LOAD(w2); PV_PROC(w3);
        }
        float y[8]; unpack8(y, hx);
        constexpr float S = 1.0f / 32.0f;
        y[0] += S * (float)y0[0]; y[1] += S * (float)y0[1]; y[2] += S * (float)y1[0]; y[3] += S * (float)y1[1];
        y[4] += S * (float)y2[0]; y[5] += S * (float)y2[1]; y[6] += S * (float)y3[0]; y[7] += S * (float)y3[1];
        float* op = P.out + tok * 2048 + 8 * c;
        *(f32x4*)op = (f32x4){y[0], y[1], y[2], y[3]}; *(f32x4*)(op + 4) = (f32x4){y[4], y[5], y[6], y[7]};
    }
#undef PV_LOAD
#undef PV_PROC
}
__device__ __forceinline__ void peer_v_fill(const Params& P, int c, int tid) {
    const v4u* src = (const v4u*)(P.ws + WS_VB + (size_t)c * 131072);
#pragma unroll 4
    for (int i = tid; i < 8192; i += NTHREADS) *(LAS v4u*)(size_t)(16 * i) = src[i];
}
__device__ __forceinline__ void phase_final(const Params& P, int vcu, int G, int wave) {
    const int lane = hw_lane();
    const bool poison = __hip_atomic_load((const unsigned*)(P.ws + WS_CTL) + CW_FLAG, __ATOMIC_RELAXED, __HIP_MEMORY_SCOPE_AGENT) != 0u;
    f32x4 gv[8];
#pragma unroll
    for (int j = 0; j < 8; ++j) gv[j] = ((const f32x4*)P.lnf)[lane + 64 * j];
#pragma unroll 1
    for (int t = vcu * NWAVES + wave; t < M; t += G * NWAVES) {
        f32x4* row = (f32x4*)(P.out + (size_t)t * 2048) + lane;
        f32x4 v[8]; float s = 0.f;
#pragma unroll
        for (int j = 0; j < 8; ++j) { v[j] = row[64 * j]; s += (v[j].x * v[j].x + v[j].y * v[j].y) + (v[j].z * v[j].z + v[j].w * v[j].w); }
        const float rs = poison ? __builtin_nanf("") : rsqrtf(wave_sum(s) * (1.f / 2048.f) + EPS);
#pragma unroll
        for (int j = 0; j < 8; ++j) row[64 * j] = v[j] * rs * gv[j];
    }
}
#undef MFMA32
}
#define XB_TMO      128
#define XB_XCNT(j)  (256  + 64 * (j))
#define XB_XSUB(j)  (1280 + 64 * (j))
#define XB_XGEN(j)  (2304 + 64 * (j))
#define XB_TOP      3328
#define XB_TOPGEN   3392
#define XCD_BAR_WORDS 3456
#define XB_SPIN_CAP (1u << 22)
__device__ __forceinline__ unsigned xb_ld(unsigned* p)              { return __hip_atomic_load(p, __ATOMIC_RELAXED, __HIP_MEMORY_SCOPE_AGENT); }
__device__ __forceinline__ unsigned xb_add(unsigned* p, unsigned v) { return __hip_atomic_fetch_add(p, v, __ATOMIC_RELAXED, __HIP_MEMORY_SCOPE_AGENT); }
__device__ __forceinline__ unsigned xb_xcc_id() { return (unsigned)__builtin_amdgcn_s_getreg((3 << 11) | 20) & 0xFu; }
#define XB_SPIN(cond, bar) do { unsigned _sp = 0; while (cond) { __builtin_amdgcn_s_sleep(1); \
    if ((++_sp & 255u) == 0u) { if (xb_ld(&(bar)[XB_TMO])) break; if (_sp > XB_SPIN_CAP) { atomicAdd(&(bar)[XB_TMO], 1u); break; } } } } while (0)
struct XcdBarrier { unsigned* bar; unsigned x; volatile LAS unsigned* st; };
__device__ __forceinline__ XcdBarrier xcd_barrier_post(unsigned* bar, volatile LAS unsigned* st, bool leader) {
    XcdBarrier b; b.bar = bar; b.x = xb_xcc_id(); b.st = st;
    if (leader) (void)xb_add(&bar[XB_XCNT(b.x)], 1u);
    return b;
}
__device__ __forceinline__ void xcd_barrier_complete(unsigned* bar, unsigned x, unsigned& nloc, unsigned& nx) {
    const unsigned G = gridDim.x * gridDim.y * gridDim.z;
    unsigned sum, cnt, mine, sp = 0u;
    for (;;) {
        sum = 0u; cnt = 0u; mine = 0u;
#pragma unroll
        for (unsigned j = 0; j < 16; ++j) { const unsigned c = xb_ld(&bar[XB_XCNT(j)]); sum += c; cnt += (c > 0u) ? 1u : 0u; mine = (j == x) ? c : mine; }
        if (sum == G) break;
        __builtin_amdgcn_s_sleep(1);
        if ((++sp & 255u) == 0u) { if (xb_ld(&bar[XB_TMO])) break; if (sp > XB_SPIN_CAP) { atomicAdd(&bar[XB_TMO], 1u); break; } }
    }
    nloc = mine > 0u ? mine : 1u; nx = cnt > 0u ? cnt : 1u;
}
__device__ __forceinline__ void xcd_barrier(const XcdBarrier& b, int wave) {
    asm volatile("s_waitcnt vmcnt(0)" ::: "memory");
    __syncthreads();
    if (wave == 0 && hw_lane() == 0) {
        unsigned* bar = b.bar;
        __builtin_amdgcn_s_waitcnt(0);
        unsigned nloc = b.st[0], nx = b.st[1];
        if (nloc == 0u) { xcd_barrier_complete(bar, b.x, nloc, nx); b.st[0] = nloc; b.st[1] = nx; }
        const unsigned old = xb_add(&bar[XB_XSUB(b.x)], 1u);
        const unsigned gen = old / nloc;
        if (old + 1u == (gen + 1u) * nloc) {
            __builtin_amdgcn_fence(__ATOMIC_RELEASE, "agent");
            asm volatile("s_waitcnt vmcnt(0)" ::: "memory");
            const unsigned og = xb_add(&bar[XB_TOP], 1u);
            const unsigned tg = og / nx;
            if (og + 1u == (tg + 1u) * nx) xb_add(&bar[XB_TOPGEN], 1u);
            else XB_SPIN(xb_ld(&bar[XB_TOPGEN]) == tg, bar);
            __builtin_amdgcn_fence(__ATOMIC_ACQUIRE, "agent");
            xb_add(&bar[XB_XGEN(b.x)], 1u);
            asm volatile("s_waitcnt vmcnt(0)" ::: "memory");
        } else {
            XB_SPIN(xb_ld(&bar[XB_XGEN(b.x)]) == gen, bar);
            __builtin_amdgcn_fence(__ATOMIC_ACQUIRE, "agent");
            asm volatile("s_waitcnt vmcnt(0)" ::: "memory");
        }
    }
    __syncthreads();
}
constexpr int N_PHASES = 10;
#ifndef REP_PHASE
#define REP_PHASE -1
#endif
#ifndef REP_N
#define REP_N 1
#endif
#ifndef EXTRA_SYNCS
#define EXTRA_SYNCS 0
#endif
__global__ void __launch_bounds__(NTHREADS, 2) mega(Params P) {
    extern __shared__ __attribute__((aligned(16))) unsigned char lds_raw[];
    LAS unsigned char* lds = (LAS unsigned char*)lds_raw;
    cg::grid_group grid = cg::this_grid();
    const int wave = __builtin_amdgcn_readfirstlane((int)threadIdx.x >> 6);
    const int G = gridDim.x, bx = blockIdx.x;
    const int vcu = (G % 8 == 0) ? (bx % 8) * (G / 8) + bx / 8 : bx;
    unsigned char* ws = P.ws;
    const int lo = P.ph_lo, hi = P.ph_hi;
#define IN(k) (lo <= (k) && (k) < hi)
#ifndef CG_SEAMS
#define CG_SEAMS 0
#endif
    volatile LAS unsigned* xbst = (volatile LAS unsigned*)(lds + MISC_OFF + 8192);
    if (wave == 0 && hw_lane() == 0) { xbst[0] = 0u; xbst[1] = 0u; xbst[2] = 0u; xbst[3] = 0u; }
    __syncthreads();
    const XcdBarrier xbar = xcd_barrier_post((unsigned*)(ws + WS_CTL) + 4096, xbst, wave == 0 && hw_lane() == 0);
    if (lo == 0) grid.sync();
#define GSYNC(k) do { if ((k) < CG_SEAMS) grid.sync(); else xcd_barrier(xbar, wave); } while (0)
#define SEAM(k) do { if (IN(k) && IN((k) + 1)) GSYNC(k); } while (0)

    for (int rep_ = 0; rep_ < (REP_PHASE == 0 ? 1 + REP_N : 1); ++rep_) if (IN(0)) { if (rep_) GSYNC(9); phase_prep(P, lds, vcu, G, wave, rep_ ? PREP_ONLY : -1); }
    SEAM(0);
    for (int es_ = 0; es_ < EXTRA_SYNCS; ++es_) GSYNC(9);
    for (int rep_ = 0; rep_ < (REP_PHASE == 1 ? 1 + REP_N : 1); ++rep_) if (IN(1)) { if (rep_) GSYNC(9);
        pg8::GemmSet g; g.A0 = g.A1 = (const bf16*)(ws + WS_A); g.Bt0 = g.Bt1 = (const bf16*)(ws + WS_BT1); g.K = 2048;
        pg8::StaticOrder S; S.init(M, 4096, 0, G, bx);
        pg8::Epi1 E{(bf16*)(ws + WS_B), (bf16*)(ws + WS_CQ), (bf16*)(ws + WS_CKV), (float*)(ws + WS_SSQCQ), (float*)(ws + WS_SSQCKV)};
        pg8::gemm_phase<pg8::Epi1, pg8::StaticOrder>(lds, g, S, E, wave);
    }
#ifdef EXTRA_G1
    if (IN(1)) { GSYNC(9);
        pg8::GemmSet g; g.A0 = g.A1 = (const bf16*)(ws + WS_A); g.Bt0 = g.Bt1 = (const bf16*)(ws + WS_BT1); g.K = 2048;
        pg8::ForcedOrder S; S.S.init(M, 4096, 0, G, bx); S.mmask = (EXTRA_G1 & 1) ? 0 : ~0; S.nmask = (EXTRA_G1 & 2) ? 0 : ~0;
        pg8::EpiNull E{}; pg8::gemm_phase<pg8::EpiNull, pg8::ForcedOrder>(lds, g, S, E, wave);
    }
#endif
    SEAM(1);
    for (int rep_ = 0; rep_ < (REP_PHASE == 2 ? 1 + REP_N : 1); ++rep_) if (IN(2)) { if (rep_) GSYNC(9);
        for (int it = bx; it < 256; it += G) kr_item64((const bf16*)(ws + WS_A), (const bf16*)(ws + WS_BTKR), (const f32x2*)(ws + WS_ROPE), (bf16*)(ws + WS_KPE), (LAS f32x4*)lds, it, wave, hw_lane());
        pg8::GemmSet g; g.A0 = (const bf16*)(ws + WS_CQ); g.A1 = (const bf16*)(ws + WS_CKV); g.Bt0 = (const bf16*)(ws + WS_BT2Q); g.Bt1 = (const bf16*)(ws + WS_BT2KV); g.K = 512;
        pg8::StaticOrder S; S.init(M, 1536, 2048, G, bx);
        pg8::Epi2 E{(bf16*)(ws + WS_QN), (bf16*)(ws + WS_QPE), (bf16*)(ws + WS_KN), (bf16*)(ws + WS_VM), (const float*)(ws + WS_SSQCQ), (const float*)(ws + WS_SSQCKV), (const f32x2*)(ws + WS_ROPE)};
        pg8::gemm_phase<pg8::Epi2, pg8::StaticOrder>(lds, g, S, E, wave);
    }
#ifdef EXTRA_G2
    if (IN(2)) { GSYNC(9);
        pg8::GemmSet g; g.A0 = (const bf16*)(ws + WS_CQ); g.A1 = (const bf16*)(ws + WS_CKV); g.Bt0 = (const bf16*)(ws + WS_BT2Q); g.Bt1 = (const bf16*)(ws + WS_BT2KV); g.K = 512;
        pg8::StaticOrder S; S.init(M, 1536, 2048, G, bx);
#if EXTRA_G2 == 1
        pg8::Epi2 E{(bf16*)(ws + WS_QN), (bf16*)(ws + WS_QPE), (bf16*)(ws + WS_KN), (bf16*)(ws + WS_VM), (const float*)(ws + WS_SSQCQ), (const float*)(ws + WS_SSQCKV), (const f32x2*)(ws + WS_ROPE)};
        pg8::gemm_phase<pg8::Epi2, pg8::StaticOrder>(lds, g, S, E, wave);
#else
        pg8::EpiNull E{}; pg8::gemm_phase<pg8::EpiNull, pg8::StaticOrder>(lds, g, S, E, wave);
#endif
    }
#endif
    SEAM(2);
    for (int rep_ = 0; rep_ < (REP_PHASE == 3 ? 1 + REP_N : 1); ++rep_) if (IN(3)) { if (rep_) GSYNC(9); att::phase_attn(P, lds, vcu, G, wave); }
    SEAM(3);
    for (int rep_ = 0; rep_ < (REP_PHASE == 4 ? 1 + REP_N : 1); ++rep_) if (IN(4)) { if (rep_) GSYNC(9);
        pg8::GemmSet g; g.A0 = g.A1 = (const bf16*)(ws + WS_A); g.Bt0 = g.Bt1 = (const bf16*)(ws + WS_BT3); g.K = 2048;
        pg8::StaticOrder S; S.init(M, 2048, 0, G, bx);
        pg8::Epi3 E{(bf16*)(ws + WS_B), P.x, (const float*)(ws + WS_SSQO), (float*)(ws + WS_SSQH), (LAS f32x2*)(lds + MISC_OFF)};
        pg8::gemm_phase<pg8::Epi3, pg8::StaticOrder>(lds, g, S, E, wave);
    }
    SEAM(4);
    for (int rep_ = 0; rep_ < (REP_PHASE == 5 ? 1 + REP_N : 1); ++rep_) if (IN(5)) { if (rep_) GSYNC(9);
        pg8::GemmSet g; g.A0 = g.A1 = (const bf16*)(ws + WS_B); g.Bt0 = g.Bt1 = (const bf16*)(ws + WS_BT4); g.K = 2048;
        pg8::StaticOrder S; S.init(M, 2048, 0, G, bx);
        pg8::Epi4 E{(bf16*)(ws + WS_QP)};
        pg8::gemm_phase<pg8::Epi4, pg8::StaticOrder>(lds, g, S, E, wave);
    }
#ifdef EXTRA_G4
    if (IN(5)) { GSYNC(9);
        pg8::GemmSet g; g.A0 = g.A1 = (const bf16*)(ws + WS_B); g.Bt0 = g.Bt1 = (const bf16*)(ws + WS_BT4); g.K = 2048;
        pg8::StaticOrder S; S.init(M, 2048, 0, G, bx);
#if EXTRA_G4 == 1
        pg8::Epi4 E{(bf16*)(ws + WS_QP)}; pg8::gemm_phase<pg8::Epi4, pg8::StaticOrder>(lds, g, S, E, wave);
#elif EXTRA_G4 == 3
        pg8::EpiSmall E{(bf16*)(ws + WS_A)}; pg8::gemm_phase<pg8::EpiSmall, pg8::StaticOrder>(lds, g, S, E, wave);
#else
        pg8::EpiNull E{}; pg8::gemm_phase<pg8::EpiNull, pg8::StaticOrder>(lds, g, S, E, wave);
#endif
    }
#endif
    SEAM(5);
    for (int rep_ = 0; rep_ < (REP_PHASE == 6 ? 1 + REP_N : 1); ++rep_) if (IN(6)) { if (rep_) GSYNC(9); peer::phase_route(P, lds, vcu, G, wave); }
    SEAM(6);
    for (int rep_ = 0; rep_ < (REP_PHASE == 7 ? 1 + REP_N : 1); ++rep_) if (IN(7)) { if (rep_) GSYNC(9); peer::phase_peer_u(P, lds, vcu, G, wave); }
    SEAM(7);
    for (int rep_ = 0; rep_ < (REP_PHASE == 8 ? 1 + REP_N : 1); ++rep_) if (IN(8)) { if (rep_) GSYNC(9);
        const int lane_ = hw_lane();
        for (int c = vcu; c < 256; c += G) { __syncthreads(); peer::peer_v_fill(P, c, wave * 64 + lane_); __syncthreads(); peer::peer_v_range(P, c, 0, 256, wave, NWAVES, lane_); }
    }
    SEAM(8);
    for (int rep_ = 0; rep_ < (REP_PHASE == 9 ? 1 + REP_N : 1); ++rep_) if (IN(9)) { if (rep_) GSYNC(9); peer::phase_final(P, vcu, G, wave); }
#undef IN
#undef SEAM
}

static int mega_grid() {
    static int grid = 0;
    if (grid == 0) {
        int dev = 0, cus = 0, per_cu = 0;
        (void)hipGetDevice(&dev); (void)hipDeviceGetAttribute(&cus, hipDeviceAttributeMultiprocessorCount, dev);
        (void)hipFuncSetAttribute((const void*)mega, hipFuncAttributeMaxDynamicSharedMemorySize, LDS_BYTES);
        (void)hipOccupancyMaxActiveBlocksPerMultiprocessor(&per_cu, (const void*)mega, NTHREADS, LDS_BYTES);
        if (per_cu < 1) { fprintf(stderr, "mega: occupancy query says %d blocks/CU\n", per_cu); per_cu = 1; }
        grid = cus;
        (void)hipGetLastError();
    }
    return grid;
}
static void fill_params(Params& P, void* const* d_in, void* d_out, void* d_ws) {
    P.x = (const float*)d_in[0]; P.ln1 = (const float*)d_in[1]; P.w_in = (const float*)d_in[2]; P.qan = (const float*)d_in[3]; P.kvan = (const float*)d_in[4];
    P.w_uq = (const float*)d_in[5]; P.w_ukv = (const float*)d_in[6]; P.ond = (const float*)d_in[7]; P.onm = (const float*)d_in[8]; P.w_o = (const float*)d_in[9];
    P.ln2 = (const float*)d_in[10]; P.wq = (const float*)d_in[11]; P.sk = (const float*)d_in[12]; P.pu = (const float*)d_in[13]; P.pv = (const float*)d_in[14]; P.lnf = (const float*)d_in[15];
    P.out = (float*)d_out; P.ws = (unsigned char*)d_ws;
}
static void launch_phases(Params P, int lo, int hi, hipStream_t st) {
    P.ph_lo = lo; P.ph_hi = hi;
    (void)hipMemsetAsync(P.ws + WS_CTL, 0, CTL_ZERO_BYTES, st);
    void* args[] = {&P};
    hipError_t e = hipLaunchCooperativeKernel((const void*)mega, dim3(mega_grid()), dim3(NTHREADS), args, LDS_BYTES, st);
    if (e != hipSuccess) fprintf(stderr, "mega launch [%d,%d) failed: %s\n", lo, hi, hipGetErrorString(e));
}
extern "C" void kernel_launch(void* const* d_in, const int* in_sizes, int n_in, void* d_out, int out_size, void* d_ws, size_t ws_size, hipStream_t stream) {
    Params P{}; fill_params(P, d_in, d_out, d_ws);
    launch_phases(P, 0, N_PHASES, stream);
}
```

```cpp
#include <hip/hip_runtime.h>
#include <hip/hip_cooperative_groups.h>
#include <cstdio>
#include <cstdint>
#include <cstddef>
namespace cg = cooperative_groups;
#define GAS __attribute__((address_space(1)))
#define LAS __attribute__((address_space(3)))
typedef unsigned short bf16;
typedef unsigned v4u __attribute__((ext_vector_type(4)));
typedef unsigned v2u __attribute__((ext_vector_type(2)));
typedef float f32x2 __attribute__((ext_vector_type(2)));
typedef float f32x4 __attribute__((ext_vector_type(4)));
typedef float f32x16 __attribute__((ext_vector_type(16)));
typedef short bf16x8 __attribute__((ext_vector_type(8)));
typedef short s16x4 __attribute__((ext_vector_type(4)));
typedef __bf16 bf16x2_t __attribute__((ext_vector_type(2)));
typedef float f32x32 __attribute__((ext_vector_type(32)));
typedef unsigned v6u __attribute__((ext_vector_type(6)));
constexpr int CW_FLAG = 64;
constexpr float U6_SCALE = 64.0f;

constexpr int M = 16384, SEQ = 2048, DM = 2048, NWAVES = 8, NTHREADS = 512;
constexpr float EPS = 1e-6f, LOG2E = 1.4426950408889634f;
constexpr float QSCALE_DIL = 0.08838834764831845f * LOG2E;
constexpr float QSCALE_MLA = 0.07216878364870323f * LOG2E;

constexpr size_t MiB = 1u << 20;
constexpr size_t WS_CTL = 0, CTL_ZERO_BYTES = 64 * 1024;
constexpr size_t WS_ROPE = 1 * MiB;
constexpr size_t WS_SK = 2 * MiB;
constexpr size_t WS_BTKR = 3 * MiB;
constexpr size_t WS_BT2Q = 4 * MiB;
constexpr size_t WS_BT2KV = 6 * MiB;
constexpr size_t WS_BT1 = 8 * MiB;
constexpr size_t WS_BT3 = 24 * MiB;
constexpr size_t WS_BT4 = 32 * MiB;
constexpr size_t WS_SSQCQ = 40 * MiB;
constexpr size_t WS_SSQCKV = 40 * MiB + 512 * 1024;
constexpr size_t WS_SSQO = 41 * MiB;
constexpr size_t WS_SSQH = 42 * MiB;
constexpr size_t WS_KPE = 44 * MiB;
constexpr size_t WS_UB = 48 * MiB;
constexpr size_t WS_VB = 112 * MiB;
constexpr size_t WS_A = 176 * MiB;
constexpr size_t WS_B = 240 * MiB;
constexpr size_t WS_C = 336 * MiB;
constexpr size_t WS_QN = WS_C, WS_QPE = WS_C + 32 * MiB, WS_KN = WS_C + 48 * MiB, WS_VM = WS_C + 80 * MiB;
constexpr size_t WS_QP = WS_C, WS_RIDX = WS_C + 64 * MiB, WS_RGATE = WS_C + 72 * MiB, WS_PKV = WS_C + 80 * MiB,
                 WS_SIDX = WS_C + 88 * MiB, WS_SGATE = WS_C + 96 * MiB, WS_GOFF = WS_C + 104 * MiB;
constexpr size_t WS_D = 448 * MiB;
constexpr size_t WS_CQ = WS_D, WS_CKV = WS_D + 16 * MiB;
constexpr size_t WS_END = 480 * MiB;

constexpr int RING_BYTES = 131072;
constexpr int MISC_OFF = RING_BYTES;
constexpr int LDS_BYTES = 147456;

#define LDS_WAIT() asm volatile("s_waitcnt lgkmcnt(0)" ::: "memory")
#define VM_WAIT() asm volatile("s_waitcnt vmcnt(0)" ::: "memory")

__device__ __forceinline__ unsigned f2bf(float f) { unsigned u = __builtin_bit_cast(unsigned, f); return (u + 0x7fffu + ((u >> 16) & 1u)) >> 16; }
__device__ __forceinline__ unsigned pk2(float lo, float hi) { f32x2 v = {lo, hi}; bf16x2_t b = __builtin_convertvector(v, bf16x2_t); return __builtin_bit_cast(unsigned, b); }
__device__ __forceinline__ float bflo(unsigned u) { return __builtin_bit_cast(float, u << 16); }
__device__ __forceinline__ float bfhi(unsigned u) { return __builtin_bit_cast(float, u & 0xffff0000u); }
__device__ __forceinline__ float bf2f(bf16 b) { return __builtin_bit_cast(float, (unsigned)b << 16); }
__device__ __forceinline__ float wave_sum(float v) {
#pragma unroll
    for (int o = 1; o < 64; o <<= 1) v += __shfl_xor(v, o);
    return v;
}

__device__ __forceinline__ int hw_lane() { int l; asm volatile("v_mbcnt_lo_u32_b32 %0, -1, 0\n\tv_mbcnt_hi_u32_b32 %0, -1, %0" : "=v"(l)); return l; }

struct Params {
    const float *x, *ln1, *w_in, *qan, *kvan, *w_uq, *w_ukv, *ond, *onm, *w_o, *ln2, *wq, *sk, *pu, *pv, *lnf;
    float* out; unsigned char* ws;
    int ph_lo, ph_hi;
};
__device__ __forceinline__ int map_ident(int c) { return c; }
__device__ __forceinline__ int map_kr(int c) { const int p = c - 4096; return 2 * (p & 31) + (p >> 5); }
__device__ __forceinline__ int map_uq(int c) { const int h = c / 192, e = c % 192; if (e < 128) return h * 128 + e; const int p = e - 128; return 1024 + h * 64 + 2 * (p & 31) + (p >> 5); }
__device__ __forceinline__ int map_ukv(int c) { const int h = c >> 8, e = c & 255; return e < 128 ? h * 128 + e : 1024 + h * 128 + (e - 128); }

template <int MAP>
__device__ __forceinline__ void p0_transpose_item(const float* __restrict__ W, int K, int ldw, int c0, const float* __restrict__ g0, const float* __restrict__ g1, int gsplit,
                                                  bf16* __restrict__ WT, LAS float* scr, int item, int nblk, int lane) {
    const int kb = item / nblk, nb = item % nblk, k0 = 64 * kb, n0 = c0 + 32 * nb;
    f32x4 wv[8];
#pragma unroll
    for (int i = 0; i < 8; ++i) wv[i] = *(const f32x4*)(W + (size_t)(k0 + (lane >> 3) + 8 * i) * ldw + n0 + 4 * (lane & 7));
#pragma unroll
    for (int i = 0; i < 8; ++i) { const int kk = (lane >> 3) + 8 * i, k = k0 + kk; f32x4 w = wv[i];
        if (g0) w = w * (k < gsplit ? g0[k] : g1[k - gsplit]);
        LAS float* d = scr + kk * 33 + 4 * (lane & 7); d[0] = w[0]; d[1] = w[1]; d[2] = w[2]; d[3] = w[3]; }
    LDS_WAIT(); asm volatile("" ::: "memory");
    const int c = lane & 7;
#pragma unroll
    for (int j = 0; j < 4; ++j) { const int n = (lane >> 3) + 8 * j; const LAS float* s = scr + (8 * c) * 33 + n;
        v4u o; o.x = pk2(s[0 * 33], s[1 * 33]); o.y = pk2(s[2 * 33], s[3 * 33]); o.z = pk2(s[4 * 33], s[5 * 33]); o.w = pk2(s[6 * 33], s[7 * 33]);
        const int src = n0 + n;
        const int dr = MAP == 0 ? map_ident(src) : MAP == 1 ? map_kr(src) : MAP == 2 ? map_uq(src) : map_ukv(src);
        *(v4u*)(WT + (size_t)dr * K + k0 + 8 * c) = o; }
    LDS_WAIT(); asm volatile("" ::: "memory");
}

#ifndef PREP_ONLY
#define PREP_ONLY -1
#endif
__device__ __forceinline__ void phase_prep(const Params& P, LAS unsigned char* lds, int vcu, int G, int wave, int only = -1) {
    const int lane = hw_lane(), tid = wave * 64 + lane;
    unsigned char* ws = P.ws;
    LAS float* scr = (LAS float*)(lds + wave * 16384);
    const int gw = vcu * NWAVES + wave, NGW = G * NWAVES;
    const int gt = vcu * NTHREADS + tid, NGT = G * NTHREADS;
#pragma unroll 1
    for (int pi = 0; pi < 3; ++pi) {
        const int part = (pi + wave) % 3;
        if (only >= 0 && only != part) continue;
        if (part == 0) {
    constexpr int I1 = 32 * 128, IKR = 32 * 2, I2Q = 8 * 48, I2KV = 8 * 64, I3 = 32 * 64, I4 = 32 * 64;
    constexpr int NITEMS = I1 + IKR + I2Q + I2KV + I3 + I4;
    for (int it = gw; it < NITEMS; it += NGW) {
        int r = it;
        if (r < I1) { p0_transpose_item<0>(P.w_in, 2048, 4160, 0, nullptr, nullptr, 0, (bf16*)(ws + WS_BT1), scr, r, 128, lane); continue; } r -= I1;
        if (r < IKR) { p0_transpose_item<1>(P.w_in, 2048, 4160, 4096, nullptr, nullptr, 0, (bf16*)(ws + WS_BTKR), scr, r, 2, lane); continue; } r -= IKR;
        if (r < I2Q) { p0_transpose_item<2>(P.w_uq, 512, 1536, 0, P.qan, P.qan, 512, (bf16*)(ws + WS_BT2Q), scr, r, 48, lane); continue; } r -= I2Q;
        if (r < I2KV) { p0_transpose_item<3>(P.w_ukv, 512, 2048, 0, P.kvan, P.kvan, 512, (bf16*)(ws + WS_BT2KV), scr, r, 64, lane); continue; } r -= I2KV;
        if (r < I3) { p0_transpose_item<0>(P.w_o, 2048, 2048, 0, P.ond, P.onm, 1024, (bf16*)(ws + WS_BT3), scr, r, 64, lane); continue; } r -= I3;
        p0_transpose_item<0>(P.wq, 2048, 2048, 0, P.ln2, P.ln2, 2048, (bf16*)(ws + WS_BT4), scr, r, 64, lane);
    }
        } else if (part == 1) {
    {
        bf16* XN = (bf16*)(ws + WS_A);
        f32x4 gv[8];
#pragma unroll
        for (int j = 0; j < 8; ++j) gv[j] = ((const f32x4*)P.ln1)[lane + 64 * j];
        for (int m0 = gw * 4; m0 < M; m0 += NGW * 4) {
            f32x4 v[4][8];
#pragma unroll
            for (int r = 0; r < 4; ++r) { const f32x4* xr = (const f32x4*)(P.x + (size_t)(m0 + r) * DM) + lane;
#pragma unroll
                for (int j = 0; j < 8; ++j) v[r][j] = __builtin_nontemporal_load(xr + 64 * j); }
#pragma unroll
            for (int r = 0; r < 4; ++r) { float s = 0.f;
#pragma unroll
                for (int j = 0; j < 8; ++j) s += (v[r][j].x * v[r][j].x + v[r][j].y * v[r][j].y) + (v[r][j].z * v[r][j].z + v[r][j].w * v[r][j].w);
                const float rs = rsqrtf(wave_sum(s) * (1.f / DM) + EPS);
                v2u* o8 = (v2u*)(XN + (size_t)(m0 + r) * DM) + lane;
#pragma unroll
                for (int j = 0; j < 8; ++j) { v2u o; o.x = pk2(v[r][j].x * rs * gv[j].x, v[r][j].y * rs * gv[j].y); o.y = pk2(v[r][j].z * rs * gv[j].z, v[r][j].w * rs * gv[j].w); o8[64 * j] = o; } }
        }
    }
        } else {
        {
            f32x16 ta, tb;
#pragma unroll
            for (int i = 0; i < 16; ++i) { ta[i] = (float)(i & 7); tb[i] = (float)((i + 16) & 7) * 0.5f + (float)(i >> 3); }
            const f32x32 r = __builtin_amdgcn_cvt_scalef32_pk32_f32_fp6(__builtin_amdgcn_cvt_scalef32_2xpk16_fp6_f32(ta, tb, 1.0f), 1.0f);
            bool ok = true;
#pragma unroll
            for (int i = 0; i < 16; ++i) ok = ok && (r[2 * i] == ta[i]) && (r[2 * i + 1] == tb[i]);
            if (!ok) __hip_atomic_store((unsigned*)(ws + WS_CTL) + CW_FLAG, 1u, __ATOMIC_RELAXED, __HIP_MEMORY_SCOPE_AGENT);
        }
        unsigned char* ou = ws + WS_UB;
        {
            const int l = gt & 63; f32x4 gp[8];
#pragma unroll
            for (int j = 0; j < 8; ++j) gp[j] = ((const f32x4*)(P.ln2 + 32 * l))[j] * U6_SCALE;
#pragma unroll 3
            for (int i = gt; i < 16384 * 64; i += NGT) {
                const int e = i >> 6; const f32x4* src = (const f32x4*)(P.pu + (size_t)e * 2048 + 32 * l);
                f32x16 xa, xb;
#pragma unroll
                for (int j = 0; j < 4; ++j) { const f32x4 v = __builtin_nontemporal_load(src + j) * gp[j]; xa[4 * j] = v[0]; xa[4 * j + 1] = v[1]; xa[4 * j + 2] = v[2]; xa[4 * j + 3] = v[3]; }
#pragma unroll
                for (int j = 0; j < 4; ++j) { const f32x4 v = __builtin_nontemporal_load(src + 4 + j) * gp[4 + j]; xb[4 * j] = v[0]; xb[4 * j + 1] = v[1]; xb[4 * j + 2] = v[2]; xb[4 * j + 3] = v[3]; }
                const v6u p6 = __builtin_amdgcn_cvt_scalef32_2xpk16_fp6_f32(xa, xb, 1.0f);
                unsigned char* row = ou + (size_t)e * 1536;
                *(v4u*)(row + 16 * l) = (v4u){p6[0], p6[1], p6[2], p6[3]}; *(v2u*)(row + 1024 + 8 * l) = (v2u){p6[4], p6[5]};
            }
        }
        }
    }
    if (only < 0 || only == 3) {
        f32x2* R = (f32x2*)(ws + WS_ROPE);
        for (int i = gt; i < 2048 * 32; i += NGT) { const int pos = i >> 5, j = i & 31; const float freq = powf(10000.0f, -(float)j / 32.0f), ang = (float)pos * freq;
            f32x2 cs; cs.x = cosf(ang); cs.y = sinf(ang); R[i] = cs; }
    }
    if (only < 0 || only == 3) {
        v4u* o = (v4u*)(ws + WS_SK);
        for (int i = gt; i < 16 * 128 * 128 / 8; i += NGT) { const f32x4 a = ((const f32x4*)P.sk)[2 * i], b = ((const f32x4*)P.sk)[2 * i + 1];
            v4u w; w.x = pk2(a.x, a.y); w.y = pk2(a.z, a.w); w.z = pk2(b.x, b.y); w.w = pk2(b.z, b.w); o[i] = w; }
    }
    if (only < 0 || only == 4) {
        __syncthreads();
        LAS v2u* tl = (LAS v2u*)lds;
        v2u* ov = (v2u*)(ws + WS_VB);
        f32x4 ra[8], rb[8];
#define PV8_LOAD(tile_) do { const int _e0 = ((tile_) >> 2) * 64, _c0 = ((tile_) & 3) * 64; _Pragma("unroll") for (int k = 0; k < 8; ++k) { const int it = tid + 512 * k, e = it >> 6, c = it & 63; \
            const f32x4* src = (const f32x4*)(P.pv + (size_t)(_e0 + e) * 2048 + (size_t)(_c0 + c) * 8); ra[k] = __builtin_nontemporal_load(src); rb[k] = __builtin_nontemporal_load(src + 1); } } while (0)
        if (vcu < 1024) PV8_LOAD(vcu);
        for (int tile = vcu; tile < 1024; tile += G) {
            const int e0 = (tile >> 2) * 64, c0 = (tile & 3) * 64;
#pragma unroll
            for (int k = 0; k < 8; ++k) { const int it = tid + 512 * k, e = it >> 6, c = it & 63; const f32x4 a = ra[k], b = rb[k];
                int w0 = 0, w1 = 0;
                w0 = __builtin_amdgcn_cvt_pk_fp8_f32(a.x * 2.f, a.y * 2.f, w0, false); w0 = __builtin_amdgcn_cvt_pk_fp8_f32(a.z * 2.f, a.w * 2.f, w0, true);
                w1 = __builtin_amdgcn_cvt_pk_fp8_f32(b.x * 2.f, b.y * 2.f, w1, false); w1 = __builtin_amdgcn_cvt_pk_fp8_f32(b.z * 2.f, b.w * 2.f, w1, true);
                v2u w; w.x = (unsigned)w0; w.y = (unsigned)w1; tl[c * 65 + e] = w; }
            if (tile + G < 1024) PV8_LOAD(tile + G);
            __syncthreads();
#pragma unroll
            for (int k = 0; k < 8; ++k) { const int it = tid + 512 * k, c = it >> 6, e = it & 63; ov[(size_t)(c0 + c) * 16384 + e0 + e] = tl[c * 65 + e]; }
            __syncthreads();
        }
#undef PV8_LOAD
    }
}
namespace pg8 {
constexpr int BM = 256, BK = 64, HALF = 128, HTB = HALF * BK * 2, STAGE_BYTES = 8 * HTB, NXCD = 8, WGM = 8;
__host__ __device__ __forceinline__ int lds_byte(int r, int c) { const int st = (r >> 4) * 2 + (c >> 5), rr = r & 15, cc = c & 31, ob = rr * 64 + cc * 2; return st * 1024 + (ob ^ (((ob >> 9) & 1) << 5)); }
__host__ __device__ __forceinline__ void stage_rc(int b, int& R, int& C) { const int st = b / 1024, sb = b % 1024, swz = sb ^ (((sb >> 9) & 1) << 5); R = (st >> 1) * 16 + swz / 64; C = (st & 1) * 32 + (swz % 64) / 2; }
__host__ __device__ __forceinline__ int perm32(int rho) { const int n = rho >> 4, i = rho & 15; return 8 * (i >> 2) + 4 * n + (i & 3); }

struct Unit { int pm, pn, g; };
struct GemmSet { const bf16 *A0, *A1, *Bt0, *Bt1; int K; };

struct StaticOrder {
    int nM, nN0, nN, nwg, G, c;
    __device__ void init(int Mrows, int N0, int N1, int G_, int c_) { nM = Mrows / BM; nN0 = N0 / BM; nN = nN0 + N1 / BM; nwg = nM * nN; G = G_; c = c_; }
    __device__ bool next(int i, Unit& u) const {
        const long L = (long)i * G + c; if (L >= nwg) return false;
        int wgid = (int)L; { const int q = nwg / NXCD, r = nwg % NXCD, xcd = wgid % NXCD, off = wgid / NXCD; wgid = (xcd < r ? xcd * (q + 1) : r * (q + 1) + (xcd - r) * q) + off; }
        const int nig = WGM * nN, gid = wgid / nig, fm = gid * WGM, gsz = (nM - fm) < WGM ? (nM - fm) : WGM;
        u.pm = fm + ((wgid % nig) % gsz); int pn = (wgid % nig) / gsz; u.g = pn >= nN0 ? 1 : 0; u.pn = pn >= nN0 ? pn - nN0 : pn; return true;
    }
};
struct ForcedOrder {
    StaticOrder S; int mmask, nmask;
    __device__ bool next(int i, Unit& u) const { if (!S.next(i, u)) return false; u.pm &= mmask; u.pn &= nmask; return true; }
};

template <class Epi, class Sched>
__device__ __forceinline__ void gemm_phase(LAS unsigned char* lds, const GemmSet g, const Sched& S, const Epi& E, int wid) {
    const int lane = hw_lane(), tid = wid * 64 + lane, wr = wid >> 2, wc = wid & 3, fr = lane & 15, fq = lane >> 4;
    const int K = g.K, nt = K / BK;
    unsigned voffA[2], voffB[2];
#pragma unroll
    for (int i = 0; i < 2; ++i) { int R, C; stage_rc(tid * 16 + i * 8192, R, C); const int Rb = (R >> 5) * 64 + perm32(R & 31);
        voffA[i] = (unsigned)(R * K + C) * 2u; voffB[i] = (unsigned)(Rb * K + C) * 2u; }
    const size_t kstep = (size_t)(BK * 2);
    const size_t hstep = (size_t)HALF * K * 2;
    const size_t hstepB = (size_t)32 * K * 2;
    const size_t tstep = 2 * hstep;
    const unsigned ldsw = (unsigned)wid * 1024u;
    const int aoff = lds_byte(wr * 64 + fr, fq * 8), boff = lds_byte(wc * 32 + fr, fq * 8);
#define PG8_SA(b, h) (((b) * 2 + (h)) * HTB)
#define PG8_SB(b, h) ((4 + (b) * 2 + (h)) * HTB)
#define PG8_STAGE(bufoff, gbase, voff) do { _Pragma("unroll") for (int _i = 0; _i < 2; ++_i) \
        __builtin_amdgcn_global_load_lds((const unsigned*)((const char*)(gbase) + (voff)[_i]), (LAS unsigned*)(lds + (bufoff) + ldsw + _i * 8192), 16, 0, 0); } while (0)
#define PG8_LDA(dst, b, h) do { _Pragma("unroll") for (int m = 0; m < 4; ++m) _Pragma("unroll") for (int k = 0; k < 2; ++k) dst[m][k] = *(const LAS bf16x8*)(lds + PG8_SA(b, h) + aoff + m * 2048 + k * 1024); } while (0)
#define PG8_LDB(dst, b, h) do { _Pragma("unroll") for (int n = 0; n < 2; ++n) _Pragma("unroll") for (int k = 0; k < 2; ++k) dst[n][k] = *(const LAS bf16x8*)(lds + PG8_SB(b, h) + boff + n * 2048 + k * 1024); } while (0)
#define PG8_MMA(ai, bj, At, Bt) do { __builtin_amdgcn_s_setprio(1); _Pragma("unroll") for (int m = 0; m < 4; ++m) _Pragma("unroll") for (int n = 0; n < 2; ++n) _Pragma("unroll") for (int k = 0; k < 2; ++k) \
        acc[ai][bj][m][n] = __builtin_amdgcn_mfma_f32_16x16x32_bf16(Bt[n][k], At[m][k], acc[ai][bj][m][n], 0, 0, 0); __builtin_amdgcn_s_setprio(0); } while (0)
#define PG8_WAIT_V(n) asm volatile("s_waitcnt vmcnt(" #n ")" ::: "memory")
#define PG8_WAIT_L(n) asm volatile("s_waitcnt lgkmcnt(" #n ")" ::: "memory")
#define PG8_BAR __builtin_amdgcn_s_barrier()
#define PG8_SCHED __builtin_amdgcn_sched_barrier(0)
    Unit cur, nxt; int ui = 0;
    if (!S.next(0, cur)) return;
    f32x4 acc[2][2][4][2];
#pragma unroll
    for (int a = 0; a < 2; ++a)
#pragma unroll
        for (int b = 0; b < 2; ++b)
#pragma unroll
            for (int m = 0; m < 4; ++m)
#pragma unroll
                for (int n = 0; n < 2; ++n) acc[a][b][m][n] = (f32x4){0.f, 0.f, 0.f, 0.f};
    bf16x8 At[4][2], B0[2][2], B1[2][2];
    const char* cA = (const char*)(cur.g ? g.A1 : g.A0) + (size_t)cur.pm * tstep; const char* cB = (const char*)(cur.g ? g.Bt1 : g.Bt0) + (size_t)cur.pn * tstep;
    E.unit_begin(cur, 0, tid);
    PG8_STAGE(PG8_SB(0, 0), cB, voffB); PG8_STAGE(PG8_SB(0, 1), cB + hstepB, voffB); PG8_STAGE(PG8_SA(0, 0), cA, voffA); PG8_STAGE(PG8_SA(0, 1), cA + hstep, voffA);
    if (wr == 1) PG8_BAR;
    PG8_WAIT_V(2); PG8_BAR;
    PG8_STAGE(PG8_SB(1, 0), cB + kstep, voffB); PG8_STAGE(PG8_SA(1, 0), cA + kstep, voffA); PG8_STAGE(PG8_SB(1, 1), cB + hstepB + kstep, voffB);
    PG8_WAIT_V(6); PG8_BAR;
    for (;;) {
        const bool has_next = S.next(ui + 1, nxt);
        const char* nA = has_next ? (const char*)(nxt.g ? g.A1 : g.A0) + (size_t)nxt.pm * tstep : cA; const char* nB = has_next ? (const char*)(nxt.g ? g.Bt1 : g.Bt0) + (size_t)nxt.pn * tstep : cB;
        for (int t = 0; t < nt; t += 2) {
            const bool last = (t == nt - 2);
            const char* a1 = cA + (size_t)(t + 1) * kstep;
            const char* a2 = last ? nA : cA + (size_t)(t + 2) * kstep; const char* b2 = last ? nB : cB + (size_t)(t + 2) * kstep;
            const char* a3 = a2 + kstep; const char* b3 = b2 + kstep;
            if constexpr (Epi::MIDSCALE) { if (t == nt / 2) E.midscale(acc, ui & 1, wr, fr); }
            PG8_LDB(B0, 0, 0); PG8_LDB(B1, 0, 1); PG8_SCHED; PG8_LDA(At, 0, 0); PG8_STAGE(PG8_SA(1, 1), a1 + hstep, voffA);
            PG8_WAIT_V(8); PG8_WAIT_L(0); PG8_BAR; PG8_MMA(0, 0, At, B0); PG8_MMA(0, 1, At, B1); PG8_BAR; PG8_SCHED;
            PG8_LDA(At, 0, 1); PG8_STAGE(PG8_SB(0, 0), b2, voffB); PG8_STAGE(PG8_SB(0, 1), b2 + hstepB, voffB); PG8_STAGE(PG8_SA(0, 0), a2, voffA);
            PG8_WAIT_V(8); PG8_WAIT_L(0); PG8_BAR; PG8_MMA(1, 0, At, B0); PG8_MMA(1, 1, At, B1); PG8_BAR; PG8_SCHED;
            PG8_LDB(B0, 1, 0); PG8_LDB(B1, 1, 1); PG8_SCHED; PG8_LDA(At, 1, 0); PG8_STAGE(PG8_SA(0, 1), a2 + hstep, voffA);
            PG8_WAIT_V(8); PG8_WAIT_L(0); PG8_BAR; PG8_MMA(0, 0, At, B0); PG8_MMA(0, 1, At, B1); PG8_BAR; PG8_SCHED;
            PG8_LDA(At, 1, 1); PG8_STAGE(PG8_SB(1, 0), b3, voffB); PG8_STAGE(PG8_SB(1, 1), b3 + hstepB, voffB); PG8_STAGE(PG8_SA(1, 0), a3, voffA);
            PG8_WAIT_V(8); PG8_WAIT_L(0); PG8_BAR; PG8_MMA(1, 0, At, B0); PG8_MMA(1, 1, At, B1); PG8_BAR; PG8_SCHED;
        }
        if (wr == 0) PG8_BAR;
        E(acc, cur, ui & 1, wr, wc, fr, fq);
        if (!has_next) break;
#pragma unroll
        for (int a = 0; a < 2; ++a)
#pragma unroll
            for (int b = 0; b < 2; ++b)
#pragma unroll
                for (int m = 0; m < 4; ++m)
#pragma unroll
                    for (int n = 0; n < 2; ++n) acc[a][b][m][n] = (f32x4){0.f, 0.f, 0.f, 0.f};
        cur = nxt; cA = nA; cB = nB; ++ui;
        E.unit_begin(cur, ui & 1, tid);
        if (wr == 1) PG8_BAR;
    }
    PG8_WAIT_V(0);
    PG8_BAR;
#undef PG8_SA
#undef PG8_SB
#undef PG8_STAGE
#undef PG8_LDA
#undef PG8_LDB
#undef PG8_MMA
#undef PG8_WAIT_V
#undef PG8_WAIT_L
#undef PG8_BAR
#undef PG8_SCHED
}
}
namespace pg8 {
__device__ __forceinline__ v4u pack8(const f32x4& v0, const f32x4& v1) { v4u w; w.x = pk2(v0[0], v0[1]); w.y = pk2(v0[2], v0[3]); w.z = pk2(v1[0], v1[1]); w.w = pk2(v1[2], v1[3]); return w; }
__device__ __forceinline__ float sq8(const f32x4& v0, const f32x4& v1) { return (v0[0] * v0[0] + v0[1] * v0[1]) + (v0[2] * v0[2] + v0[3] * v0[3]) + (v1[0] * v1[0] + v1[1] * v1[1]) + (v1[2] * v1[2] + v1[3] * v1[3]); }

struct Epi1 {
    static constexpr bool MIDSCALE = false;
    bf16 *QKV, *CQ, *CKV; float *SSQCQ, *SSQCKV;
    __device__ __forceinline__ void midscale(f32x4 (&)[2][2][4][2], int, int, int) const {}
    __device__ __forceinline__ void unit_begin(const Unit&, int, int) const {}
    __device__ __forceinline__ void operator()(const f32x4 (&acc)[2][2][4][2], const Unit& u, int par, int wr, int wc, int fr, int fq) const {
        const int pn = u.pn; bf16* base; int ldc, colt; float sc = 1.f; float* ssq = nullptr; int sslot = 0;
        if (pn < 12) { base = QKV; ldc = 3072; colt = pn * 256; if (pn < 4) sc = QSCALE_DIL; }
        else if (pn < 14) { base = CQ; ldc = 512; colt = (pn - 12) * 256; ssq = SSQCQ; sslot = (pn - 12) * 4 + wc; }
        else { base = CKV; ldc = 512; colt = (pn - 14) * 256; ssq = SSQCKV; sslot = (pn - 14) * 4 + wc; }
        const int row0 = u.pm * BM + wr * 64 + fr, col0 = colt + wc * 64 + 8 * fq;
#pragma unroll
        for (int ai = 0; ai < 2; ++ai)
#pragma unroll
            for (int m = 0; m < 4; ++m) { const int row = row0 + ai * HALF + m * 16; bf16* rowp = base + (size_t)row * ldc + col0; float ss = 0.f;
#pragma unroll
                for (int bj = 0; bj < 2; ++bj) { const f32x4 v0 = acc[ai][bj][m][0] * sc, v1 = acc[ai][bj][m][1] * sc; ss += sq8(v0, v1); *(v4u*)(rowp + bj * 32) = pack8(v0, v1); }
                if (ssq) { ss += __shfl_xor(ss, 16); ss += __shfl_xor(ss, 32); if (fq == 0) ssq[(size_t)row * 8 + sslot] = ss; } }
    }
};

struct Epi2 {
    static constexpr bool MIDSCALE = false;
    bf16 *QN, *QPE, *KN, *VM; const float *SSQCQ, *SSQCKV; const f32x2* ROPE;
    __device__ __forceinline__ void midscale(f32x4 (&)[2][2][4][2], int, int, int) const {}
    __device__ __forceinline__ void unit_begin(const Unit&, int, int) const {}
    __device__ __forceinline__ void operator()(const f32x4 (&acc)[2][2][4][2], const Unit& u, int par, int wr, int wc, int fr, int fq) const {
        const int pn = u.pn; bf16* base; int ldc, colt; float sc = 1.f; bool rope = false; const float* ssq;
        if (u.g == 0) { ssq = SSQCQ; sc = QSCALE_MLA; if (pn < 4) { base = QN; ldc = 1024; colt = pn * 256; } else { base = QPE; ldc = 512; colt = (pn - 4) * 256; rope = true; } }
        else { ssq = SSQCKV; if (pn < 4) { base = KN; ldc = 1024; colt = pn * 256; } else { base = VM; ldc = 1024; colt = (pn - 4) * 256; } }
        const int row0 = u.pm * BM + wr * 64 + fr, col0 = colt + wc * 64 + 8 * fq;
#pragma unroll
        for (int ai = 0; ai < 2; ++ai)
#pragma unroll
            for (int m = 0; m < 4; ++m) { const int row = row0 + ai * HALF + m * 16; bf16* rowp = base + (size_t)row * ldc + col0;
                const f32x4 p0 = *(const f32x4*)(ssq + (size_t)row * 8), p1 = *(const f32x4*)(ssq + (size_t)row * 8 + 4);
                const float rs = rsqrtf(((p0[0] + p0[1]) + (p0[2] + p0[3]) + (p1[0] + p1[1]) + (p1[2] + p1[3])) * (1.f / 512.f) + EPS) * sc;
#pragma unroll
                for (int bj = 0; bj < 2; ++bj) { f32x4 v0 = acc[ai][bj][m][0] * rs, v1 = acc[ai][bj][m][1] * rs;
                    if (rope) { const int j0 = ((col0 + bj * 32) & 63) >> 1; const f32x4* rp = (const f32x4*)(ROPE + (size_t)(row & (SEQ - 1)) * 32 + j0);
                        const f32x4 r0 = rp[0], r1 = rp[1];
                        f32x4 w0, w1;
                        w0[0] = v0[0] * r0[0] - v0[1] * r0[1]; w0[1] = v0[0] * r0[1] + v0[1] * r0[0];
                        w0[2] = v0[2] * r0[2] - v0[3] * r0[3]; w0[3] = v0[2] * r0[3] + v0[3] * r0[2];
                        w1[0] = v1[0] * r1[0] - v1[1] * r1[1]; w1[1] = v1[0] * r1[1] + v1[1] * r1[0];
                        w1[2] = v1[2] * r1[2] - v1[3] * r1[3]; w1[3] = v1[2] * r1[3] + v1[3] * r1[2];
                        v0 = w0; v1 = w1; }
                    *(v4u*)(rowp + bj * 32) = pack8(v0, v1); } }
    }
};

struct Epi3 {
    static constexpr bool MIDSCALE = true;
    bf16* H1B; const float* X; const float* SSQO; float* SSQH; LAS f32x2* RS;
    __device__ __forceinline__ void unit_begin(const Unit& u, int par, int tid) const {
        if (tid < 256) { const f32x4* p = (const f32x4*)(SSQO + (size_t)(u.pm * BM + tid) * 16); const f32x4 a0 = p[0], a1 = p[1], b0 = p[2], b1 = p[3];
            const float ra = rsqrtf(((a0[0] + a0[1]) + (a0[2] + a0[3]) + (a1[0] + a1[1]) + (a1[2] + a1[3])) * (1.f / 1024.f) + EPS);
            const float rb = rsqrtf(((b0[0] + b0[1]) + (b0[2] + b0[3]) + (b1[0] + b1[1]) + (b1[2] + b1[3])) * (1.f / 1024.f) + EPS);
            f32x2 v; v.x = ra / rb; v.y = rb; RS[par * 256 + tid] = v; }
    }
    __device__ __forceinline__ void midscale(f32x4 (&acc)[2][2][4][2], int par, int wr, int fr) const {
#pragma unroll
        for (int ai = 0; ai < 2; ++ai)
#pragma unroll
            for (int m = 0; m < 4; ++m) { const float f = RS[par * 256 + ai * HALF + wr * 64 + m * 16 + fr].x;
#pragma unroll
                for (int bj = 0; bj < 2; ++bj) { acc[ai][bj][m][0] = acc[ai][bj][m][0] * f; acc[ai][bj][m][1] = acc[ai][bj][m][1] * f; } }
    }
    __device__ __forceinline__ void operator()(const f32x4 (&acc)[2][2][4][2], const Unit& u, int par, int wr, int wc, int fr, int fq) const {
        const int row0 = u.pm * BM + wr * 64 + fr, col0 = u.pn * BM + wc * 64 + 8 * fq, sslot = u.pn * 4 + wc;
#pragma unroll
        for (int ai = 0; ai < 2; ++ai)
#pragma unroll
            for (int m = 0; m < 4; ++m) { const int row = row0 + ai * HALF + m * 16; const float rb = RS[par * 256 + ai * HALF + wr * 64 + m * 16 + fr].y; float ss = 0.f;
#pragma unroll
                for (int bj = 0; bj < 2; ++bj) { const float* xp = X + (size_t)row * DM + col0 + bj * 32; const f32x4 x0 = *(const f32x4*)xp, x1 = *(const f32x4*)(xp + 4);
                    const f32x4 v0 = acc[ai][bj][m][0] * rb + x0, v1 = acc[ai][bj][m][1] * rb + x1; ss += sq8(v0, v1);
                    *(v4u*)(H1B + (size_t)row * DM + col0 + bj * 32) = pack8(v0, v1); }
                ss += __shfl_xor(ss, 16); ss += __shfl_xor(ss, 32); if (fq == 0) SSQH[(size_t)row * 32 + sslot] = ss; }
    }
};

struct Epi4 {
    static constexpr bool MIDSCALE = false;
    bf16* QP;
    __device__ __forceinline__ void midscale(f32x4 (&)[2][2][4][2], int, int, int) const {}
    __device__ __forceinline__ void unit_begin(const Unit&, int, int) const {}
    __device__ __forceinline__ void operator()(const f32x4 (&acc)[2][2][4][2], const Unit& u, int par, int wr, int wc, int fr, int fq) const {
        const int row0 = u.pm * BM + wr * 64 + fr, col0 = u.pn * BM + wc * 64 + 8 * fq;
#pragma unroll
        for (int ai = 0; ai < 2; ++ai)
#pragma unroll
            for (int m = 0; m < 4; ++m) { const int row = row0 + ai * HALF + m * 16;
#pragma unroll
                for (int bj = 0; bj < 2; ++bj) *(v4u*)(QP + (size_t)row * DM + col0 + bj * 32) = pack8(acc[ai][bj][m][0], acc[ai][bj][m][1]); }
    }
};
struct EpiSmall {
    static constexpr bool MIDSCALE = false;
    bf16* QP;
    __device__ __forceinline__ void midscale(f32x4 (&)[2][2][4][2], int, int, int) const {}
    __device__ __forceinline__ void unit_begin(const Unit&, int, int) const {}
    __device__ __forceinline__ void operator()(const f32x4 (&acc)[2][2][4][2], const Unit& u, int par, int wr, int wc, int fr, int fq) const {
        const int row0 = (blockIdx.x * 16) + fr, col0 = wc * 64 + 8 * fq;
#pragma unroll
        for (int ai = 0; ai < 2; ++ai)
#pragma unroll
            for (int m = 0; m < 4; ++m) { const int row = row0;
#pragma unroll
                for (int bj = 0; bj < 2; ++bj) *(v4u*)(QP + (size_t)row * DM + col0 + bj * 32 + (ai * 4 + m) * 256) = pack8(acc[ai][bj][m][0], acc[ai][bj][m][1]); }
    }
};
struct EpiNull {
    static constexpr bool MIDSCALE = false;
    __device__ __forceinline__ void midscale(f32x4 (&)[2][2][4][2], int, int, int) const {}
    __device__ __forceinline__ void unit_begin(const Unit&, int, int) const {}
    __device__ __forceinline__ void operator()(const f32x4 (&acc)[2][2][4][2], const Unit& u, int par, int wr, int wc, int fr, int fq) const {
#pragma unroll
        for (int ai = 0; ai < 2; ++ai)
#pragma unroll
            for (int bj = 0; bj < 2; ++bj)
#pragma unroll
                for (int m = 0; m < 4; ++m)
#pragma unroll
                    for (int n = 0; n < 2; ++n) asm volatile("" :: "v"(acc[ai][bj][m][n]));
    }
};
}

__device__ __forceinline__ void kr_item64(const bf16* __restrict__ XN, const bf16* __restrict__ BT, const f32x2* __restrict__ ROPE, bf16* __restrict__ KPE, LAS f32x4* red, int item, int wave, int lane) {
    const int fr = lane & 15, fq = lane >> 4, rg = wave & 3, kh = wave >> 2, row = item * 64 + rg * 16 + fr;
    const bf16* ap = XN + (size_t)row * 2048 + kh * 1024 + fq * 8; const bf16* bp = BT + (size_t)fr * 2048 + kh * 1024 + fq * 8;
    f32x4 acc[4];
#pragma unroll
    for (int nb = 0; nb < 4; ++nb) acc[nb] = (f32x4){0.f, 0.f, 0.f, 0.f};
#pragma unroll 4
    for (int k0 = 0; k0 < 1024; k0 += 32) {
        const bf16x8 a = *(const bf16x8*)(ap + k0);
#pragma unroll
        for (int nb = 0; nb < 4; ++nb) { const bf16x8 b = *(const bf16x8*)(bp + (size_t)nb * 16 * 2048 + k0); acc[nb] = __builtin_amdgcn_mfma_f32_16x16x32_bf16(b, a, acc[nb], 0, 0, 0); }
    }
    if (kh == 1) {
#pragma unroll
        for (int nb = 0; nb < 4; ++nb) red[(rg * 4 + nb) * 64 + lane] = acc[nb];
    }
    __syncthreads();
    if (kh == 0) {
        const int pos = row & (SEQ - 1);
#pragma unroll
        for (int nb = 0; nb < 4; ++nb) { const int j0 = 8 * nb + 2 * fq; const f32x4 r = *(const f32x4*)(ROPE + (size_t)pos * 32 + j0); const f32x4 v = acc[nb] + red[(rg * 4 + nb) * 64 + lane];
            v2u o; o.x = pk2(v[0] * r[0] - v[1] * r[1], v[0] * r[1] + v[1] * r[0]); o.y = pk2(v[2] * r[2] - v[3] * r[3], v[2] * r[3] + v[3] * r[2]);
            *(v2u*)(KPE + (size_t)row * 64 + 16 * nb + 4 * fq) = o; }
    }
    __syncthreads();
}
namespace att {
typedef short v4i16_t __attribute__((ext_vector_type(4)));
#define MFMA32(a, b, c) __builtin_amdgcn_mfma_f32_32x32x16_bf16((a), (b), (c), 0, 0, 0)
__device__ __forceinline__ s16x4 vtr(const LAS unsigned char* p) { return __builtin_bit_cast(s16x4, __builtin_amdgcn_ds_read_tr16_b64_v4i16((LAS v4i16_t*)p)); }
__device__ __forceinline__ int crow(int r, int hi) { return (r & 3) + 8 * (r >> 2) + 4 * hi; }
constexpr int VS = 320;
constexpr int KS = 400;
constexpr float NEG = -1e30f;

__device__ __forceinline__ bf16x8 pack8r(const f32x16& p, int s) {
    v4u w; w.x = pk2(p[8 * s + 0], p[8 * s + 1]); w.y = pk2(p[8 * s + 2], p[8 * s + 3]); w.z = pk2(p[8 * s + 4], p[8 * s + 5]); w.w = pk2(p[8 * s + 6], p[8 * s + 7]);
    return __builtin_bit_cast(bf16x8, w);
}
__device__ __forceinline__ void pv32(f32x16 (&o)[4], const LAS unsigned char* vb, const bf16x8 pb0, const bf16x8 pb1) {
#pragma unroll
    for (int d = 0; d < 4; ++d) {
        const s16x4 l0 = vtr(vb + d * 64), h0 = vtr(vb + d * 64 + 8 * VS), l1 = vtr(vb + d * 64 + 16 * VS), h1 = vtr(vb + d * 64 + 24 * VS);
        const bf16x8 a0 = __builtin_shufflevector(l0, h0, 0, 1, 2, 3, 4, 5, 6, 7), a1 = __builtin_shufflevector(l1, h1, 0, 1, 2, 3, 4, 5, 6, 7);
        o[d] = MFMA32(a0, pb0, o[d]); o[d] = MFMA32(a1, pb1, o[d]);
    }
}
template <int NS>
__device__ __forceinline__ void softmax_step(f32x16 (&s)[NS], float& m, float& l, f32x16 (&o)[4], bf16x8 (&pb)[2 * NS]) {
    float mx = s[0][0];
#pragma unroll
    for (int t = 0; t < NS; ++t)
#pragma unroll
        for (int r = 0; r < 16; ++r) mx = fmaxf(mx, s[t][r]);
    mx = fmaxf(mx, __shfl_xor(mx, 32));
    const float mn = fmaxf(m, mx), alpha = __builtin_amdgcn_exp2f(m - mn); m = mn;
    float ps = 0.f;
#pragma unroll
    for (int t = 0; t < NS; ++t)
#pragma unroll
        for (int r = 0; r < 16; ++r) { const float p = __builtin_amdgcn_exp2f(s[t][r] - mn); s[t][r] = p; ps += p; }
    l = l * alpha + ps;
    if (!__all(alpha == 1.0f)) {
#pragma unroll
        for (int d = 0; d < 4; ++d) o[d] = o[d] * alpha;
    }
#pragma unroll
    for (int t = 0; t < NS; ++t) { pb[2 * t] = pack8r(s[t], 0); pb[2 * t + 1] = pack8r(s[t], 1); }
}
__device__ __forceinline__ void store_o(f32x16 (&o)[4], float l, bf16* __restrict__ orow  , float* __restrict__ ssq  , int hh) {
    l += __shfl_xor(l, 32);
    const float inv = 1.0f / l; float ss = 0.f;
#pragma unroll
    for (int d = 0; d < 4; ++d) { o[d] = o[d] * inv;
#pragma unroll
        for (int g = 0; g < 4; ++g) { const float a = o[d][4 * g], b = o[d][4 * g + 1], c = o[d][4 * g + 2], e = o[d][4 * g + 3];
            ss += (a * a + b * b) + (c * c + e * e);
            v2u w; w.x = pk2(a, b); w.y = pk2(c, e); *(v2u*)(orow + 32 * d + 8 * g + 4 * hh) = w; } }
    ss += __shfl_xor(ss, 32);
    if (hh == 0) *ssq = ss;
}

constexpr int KTB = 64 * KS, VTB = 64 * VS, BUFB = KTB + VTB;
__device__ __forceinline__ void mla_unit(const unsigned char* ws, LAS unsigned char* lds, int b, int h, int qblk, int tid, int wave, int lane) {
    const bf16* QN = (const bf16*)(ws + WS_QN); const bf16* QPE = (const bf16*)(ws + WS_QPE);
    bf16* O = (bf16*)(ws + WS_A); float* SSQO = (float*)(ws + WS_SSQO);
    const int r32 = lane & 31, hh = lane >> 5;
    const size_t tok0 = (size_t)b * SEQ;
    const int row_lo = qblk * 256 + wave * 32, qrow = row_lo + r32;
    bf16x8 qf[12];
    { const bf16* qn = QN + (tok0 + qrow) * 1024 + h * 128 + 8 * hh;
#pragma unroll
      for (int s = 0; s < 8; ++s) qf[s] = *(const bf16x8*)(qn + 16 * s);
      const bf16* qp = QPE + (tok0 + qrow) * 512 + h * 64 + 8 * hh;
#pragma unroll
      for (int s = 0; s < 4; ++s) qf[8 + s] = *(const bf16x8*)(qp + 16 * s); }
    const int c0 = tid, c1 = tid + 512;
    const unsigned okn0 = (unsigned)WS_KN + (unsigned)(((unsigned)tok0 + (c0 >> 4)) * 1024u + h * 128 + (c0 & 15) * 8) * 2u, okn1 = okn0 + 32u * 1024u * 2u;
    const unsigned okp = (unsigned)WS_KPE + (unsigned)(((unsigned)tok0 + (tid >> 3)) * 64u + (tid & 7) * 8) * 2u;
    const unsigned ov0 = okn0 + (unsigned)(WS_VM - WS_KN), ov1 = ov0 + 32u * 1024u * 2u;
    const int lkn0 = (c0 >> 4) * KS + (c0 & 15) * 16, lkn1 = (c1 >> 4) * KS + (c1 & 15) * 16, lkp = (tid >> 3) * KS + 256 + (tid & 7) * 16;
    const int lv0 = KTB + (c0 >> 4) * VS + (c0 & 15) * 16, lv1 = KTB + (c1 >> 4) * VS + (c1 & 15) * 16;
    v4u st0, st1, st2, st3, st4;
#define MLA_GLOAD(kt) do { const unsigned _o = (unsigned)(kt) * 131072u, _p = (unsigned)(kt) * 8192u; st0 = *(const v4u*)(ws + (size_t)(okn0 + _o)); st1 = *(const v4u*)(ws + (size_t)(okn1 + _o)); \
        st2 = *(const v4u*)(ws + (size_t)(okp + _p)); st3 = *(const v4u*)(ws + (size_t)(ov0 + _o)); st4 = *(const v4u*)(ws + (size_t)(ov1 + _o)); } while (0)
#define MLA_LWRITE(buf) do { LAS unsigned char* _b = lds + (buf) * BUFB; *(LAS v4u*)(_b + lkn0) = st0; *(LAS v4u*)(_b + lkn1) = st1; *(LAS v4u*)(_b + lkp) = st2; \
        *(LAS v4u*)(_b + lv0) = st3; *(LAS v4u*)(_b + lv1) = st4; } while (0)
    const int nkt = 4 * (qblk + 1);
    MLA_GLOAD(0); MLA_LWRITE(0);
    __syncthreads();
    f32x16 o[4];
#pragma unroll
    for (int d = 0; d < 4; ++d)
#pragma unroll
        for (int r = 0; r < 16; ++r) o[d][r] = 0.f;
    float m = NEG, l = 0.f;
    const int kread = r32 * KS + 16 * hh;
    const int vread = KTB + (4 * hh + ((lane & 15) >> 2)) * VS + (16 * ((lane >> 4) & 1) + 4 * (lane & 3)) * 2;
    for (int kt = 0; kt < nkt; ++kt) {
        if (kt + 1 < nkt) MLA_GLOAD(kt + 1);
        const int k0 = kt * 64;
        if (k0 <= row_lo + 31) {
            const LAS unsigned char* kb = lds + (kt & 1) * BUFB;
            const bool diag = (k0 + 63 > row_lo);
#pragma unroll
            for (int sub = 0; sub < 2; ++sub) {
                if (sub == 1 && k0 + 32 > row_lo + 31) break;
                f32x16 s[1];
#pragma unroll
                for (int r = 0; r < 16; ++r) s[0][r] = 0.f;
#pragma unroll
                for (int ks = 0; ks < 12; ++ks) { const bf16x8 kf = *(const LAS bf16x8*)(kb + kread + sub * 32 * KS + 32 * ks); s[0] = MFMA32(kf, qf[ks], s[0]); }
                if (diag) {
#pragma unroll
                    for (int r = 0; r < 16; ++r) { const int key = k0 + 32 * sub + crow(r, hh); if (key > qrow) s[0][r] = NEG; }
                }
                bf16x8 pb[2];
                softmax_step<1>(s, m, l, o, pb);
                pv32(o, kb + vread + sub * 32 * VS, pb[0], pb[1]);
            }
        }
        if (kt + 1 < nkt) MLA_LWRITE((kt + 1) & 1);
        __syncthreads();
    }
#undef MLA_GLOAD
#undef MLA_LWRITE
    store_o(o, l, O + (tok0 + qrow) * 2048 + 1024 + h * 128, SSQO + (tok0 + qrow) * 16 + 8 + h, hh);
}

constexpr int DKS = 272, DSH = 32 * DKS + 32 * VS;
__device__ __forceinline__ void dil_tile(const unsigned char* ws, LAS unsigned char* vl  , LAS unsigned char* sh  , int b, int h, int j, int r16, int tid, int lane) {
    const bf16* QKV = (const bf16*)(ws + WS_B);
    const int r32 = lane & 31, hh = lane >> 5;
    const size_t tok0 = (size_t)b * SEQ;
    const int tq = 512 * j + 16 * r32 + r16;
    bf16x8 qf[8];
    { const bf16* qp = QKV + (tok0 + tq) * 3072 + h * 128 + 8 * hh;
#pragma unroll
      for (int s = 0; s < 8; ++s) qf[s] = *(const bf16x8*)(qp + 16 * s); }
    const float slope2 = __builtin_amdgcn_exp2f(-(float)(h + 1)) * LOG2E;
    const int m0 = (j == 0) ? 4 : 0, n3 = j + 1, n2 = 8 - m0, n1 = 20 - m0, nt = n3 + n2;
    const unsigned vcol = (unsigned)WS_B + ((unsigned)tok0 * 3072u + 2048u + h * 128 + (lane & 15) * 8) * 2u;
    const int vrow = lane >> 4;
    const int vwr = vrow * VS + (lane & 15) * 16;
    const int vread = (4 * hh + ((lane & 15) >> 2)) * VS + (16 * ((lane >> 4) & 1) + 4 * (lane & 3)) * 2;
    int kbase, kstride, maxd;
#define DIL_DESC(idx) do { const int _i = (idx); if (_i < n3) { kbase = 512 * (j - _i) + r16; kstride = 16; maxd = 2048; } \
        else if (_i < n3 + n2) { kbase = 4 * (128 * j - 128 + 32 * (m0 + _i - n3)) + (r16 & 3); kstride = 4; maxd = 512; } \
        else { kbase = 512 * j - 128 + 32 * (m0 + _i - n3 - n2); kstride = 1; maxd = 128; } } while (0)
    v4u kq[8], vq[8];
    const unsigned kcc = (unsigned)WS_B + ((unsigned)tok0 * 3072u + 1024u + h * 128 + (lane & 15) * 8) * 2u;
    const int kwr = vrow * DKS + (lane & 15) * 16, kfr = r32 * DKS + 16 * hh;
    DIL_DESC(0);
#pragma unroll
    for (int i = 0; i < 8; ++i) { const unsigned ro = (unsigned)(kbase + kstride * (4 * i + vrow)) * 6144u; kq[i] = *(const v4u*)(ws + (size_t)(kcc + ro)); vq[i] = *(const v4u*)(ws + (size_t)(vcol + ro)); }
    f32x16 o[4];
#pragma unroll
    for (int d = 0; d < 4; ++d)
#pragma unroll
        for (int r = 0; r < 16; ++r) o[d][r] = 0.f;
    float m = NEG, l = 0.f;
    for (int idx = 0; idx < nt; ++idx) {
        const int cb = kbase, cs = kstride, cm = maxd;
        const bool more = idx + 1 < nt;
#pragma unroll
        for (int i = 0; i < 8; ++i) *(LAS v4u*)(vl + kwr + 4 * i * DKS) = kq[i];
        if (more) { DIL_DESC(idx + 1);
#pragma unroll
            for (int i = 0; i < 8; ++i) kq[i] = *(const v4u*)(ws + (size_t)(kcc + (unsigned)(kbase + kstride * (4 * i + vrow)) * 6144u)); }
        f32x16 s[1];
#pragma unroll
        for (int r = 0; r < 16; ++r) s[0][r] = 0.f;
#pragma unroll
        for (int ks = 0; ks < 8; ++ks) { const bf16x8 kf = *(const LAS bf16x8*)(vl + kfr + 32 * ks); s[0] = MFMA32(kf, qf[ks], s[0]); }
#pragma unroll
        for (int i = 0; i < 8; ++i) *(LAS v4u*)(vl + vwr + 4 * i * VS) = vq[i];
        if (more) {
#pragma unroll
            for (int i = 0; i < 8; ++i) vq[i] = *(const v4u*)(ws + (size_t)(vcol + (unsigned)(kbase + kstride * (4 * i + vrow)) * 6144u)); }
        const int d0 = tq - cb - cs * 4 * hh;
#pragma unroll
        for (int r = 0; r < 16; ++r) { const int dist = d0 - cs * ((r & 3) + 8 * (r >> 2)); const float v = s[0][r] - slope2 * (float)dist; s[0][r] = ((unsigned)dist <= (unsigned)cm) ? v : NEG; }
        bf16x8 pb[2];
        softmax_step<1>(s, m, l, o, pb);
        pv32(o, vl + vread, pb[0], pb[1]);
    }
#undef DIL_DESC
    {
        const int kb0 = 512 * j - 128 + 32 * m0;
        const int row = tid >> 4, ch = tid & 15;
        const unsigned gk = (unsigned)WS_B + (((unsigned)tok0 + kb0 + row) * 3072u + 1024u + h * 128 + ch * 8) * 2u;
        const int lk = row * DKS + ch * 16, lv = 32 * DKS + row * VS + ch * 16;
        const int kread = r32 * DKS + 16 * hh;
        const int vread1 = 32 * DKS + (4 * hh + ((lane & 15) >> 2)) * VS + (16 * ((lane >> 4) & 1) + 4 * (lane & 3)) * 2;
        v4u sk = *(const v4u*)(ws + (size_t)gk), sv = *(const v4u*)(ws + (size_t)(gk + 2048u));
        *(LAS v4u*)(sh + lk) = sk; *(LAS v4u*)(sh + lv) = sv;
        __syncthreads();
        for (int mi = 0; mi < n1; ++mi) {
            const bool more = mi + 1 < n1;
            if (more) { const unsigned g2 = gk + (unsigned)(mi + 1) * 32u * 6144u; sk = *(const v4u*)(ws + (size_t)g2); sv = *(const v4u*)(ws + (size_t)(g2 + 2048u)); }
            const LAS unsigned char* tb = sh + (mi & 1) * DSH;
            f32x16 s[1];
#pragma unroll
            for (int r = 0; r < 16; ++r) s[0][r] = 0.f;
#pragma unroll
            for (int ks = 0; ks < 8; ++ks) { const bf16x8 kf = *(const LAS bf16x8*)(tb + kread + 32 * ks); s[0] = MFMA32(kf, qf[ks], s[0]); }
            const int d0 = tq - (kb0 + 32 * mi) - 4 * hh;
#pragma unroll
            for (int r = 0; r < 16; ++r) { const int dist = d0 - ((r & 3) + 8 * (r >> 2)); const float v = s[0][r] - slope2 * (float)dist; s[0][r] = ((unsigned)dist <= 128u) ? v : NEG; }
            bf16x8 pb[2];
            softmax_step<1>(s, m, l, o, pb);
            pv32(o, tb + vread1, pb[0], pb[1]);
            if (more) { LAS unsigned char* nb = sh + ((mi + 1) & 1) * DSH; *(LAS v4u*)(nb + lk) = sk; *(LAS v4u*)(nb + lv) = sv; }
            __syncthreads();
        }
    }
    store_o(o, l, (bf16*)(const_cast<unsigned char*>(ws) + WS_A) + (tok0 + tq) * 2048 + h * 128, (float*)(const_cast<unsigned char*>(ws) + WS_SSQO) + (tok0 + tq) * 16 + h, hh);
}

__device__ __forceinline__ void phase_attn(const Params& P, LAS unsigned char* lds, int vcu, int G, int wave) {
    const int lane = hw_lane(), tid = wave * 64 + lane;
    const unsigned char* ws = P.ws;
#ifndef REP_MLA
#define REP_MLA 1
#endif
#ifndef REP_DIL
#define REP_DIL 1
#endif
    for (int rm_ = 0; rm_ < REP_MLA; ++rm_)
    for (int u = vcu; u < 256; u += G) { const int bh = u >> 2, pr = u & 3;
        mla_unit(ws, lds, bh >> 3, bh & 7, 7 - pr, tid, wave, lane);
        mla_unit(ws, lds, bh >> 3, bh & 7, pr, tid, wave, lane); }
    __syncthreads();
    LAS unsigned char* vl = lds + wave * (32 * VS); LAS unsigned char* sh = lds + NWAVES * (32 * VS);
    for (int rd_ = 0; rd_ < REP_DIL; ++rd_)
    if (G == 256) {
#pragma unroll 1
        for (int k = 0; k < 2; ++k) { const int t = (vcu >> 5) * 512 + k * 256 + (vcu & 31) * 8 + wave; const int bh = t >> 6, rem = t & 63, jj = rem >> 4, r16 = rem & 15;
            dil_tile(ws, vl, sh, bh >> 3, bh & 7, k == 0 ? jj : 3 - jj, r16, tid, lane); }
    } else {
#pragma unroll 1
        for (int t = vcu * 8 + wave; t < 4096; t += G * 8) { const int bh = t >> 6, rem = t & 63; dil_tile(ws, vl, sh, bh >> 3, bh & 7, rem >> 4, rem & 15, tid, lane); }
    }
}
}
namespace peer {
typedef __bf16 bf2_t __attribute__((ext_vector_type(2)));
#define MFMA32(a, b, c) __builtin_amdgcn_mfma_f32_32x32x16_bf16((a), (b), (c), 0, 0, 0)
__device__ __forceinline__ float fmax3(float a, float b, float c) { return fmaxf(fmaxf(a, b), c); }
__device__ __forceinline__ float asf(unsigned u) { return __builtin_bit_cast(float, u); }
__device__ __forceinline__ unsigned asu(float f) { return __builtin_bit_cast(unsigned, f); }

__device__ __forceinline__ void ce_desc(float& a, float& b) { const float hi = fmaxf(a, b), lo = fminf(a, b); a = hi; b = lo; }
template <bool DESC> __device__ __forceinline__ void bitonic_merge16(float (&t)[16]) {
#pragma unroll
    for (int j = 8; j > 0; j >>= 1)
#pragma unroll
        for (int i = 0; i < 16; ++i) { const int l = i ^ j; if (l > i) { if (DESC) ce_desc(t[i], t[l]); else ce_desc(t[l], t[i]); } }
}
__device__ __forceinline__ void top16_of_64(float (&v)[64], float (&out)[16]) {
#pragma unroll
    for (int k = 2; k <= 16; k <<= 1)
#pragma unroll
        for (int j = k >> 1; j > 0; j >>= 1)
#pragma unroll
            for (int i = 0; i < 64; ++i) { const int l = i ^ j; if (l > i) { if ((i & k) == 0) ce_desc(v[i], v[l]); else ce_desc(v[l], v[i]); } }
    float t0[16], t1[16];
#pragma unroll
    for (int i = 0; i < 16; ++i) { t0[i] = fmaxf(v[i], v[16 + i]); t1[i] = fmaxf(v[32 + i], v[48 + i]); }
    bitonic_merge16<true>(t0); bitonic_merge16<false>(t1);
#pragma unroll
    for (int i = 0; i < 16; ++i) out[i] = fmaxf(t0[i], t1[i]);
    bitonic_merge16<true>(out);
}
__device__ __forceinline__ void route_item(const unsigned char* ws, LAS unsigned* sc, int tile, int h, int lane) {
    const bf16* QP = (const bf16*)(ws + WS_QP); const bf16* SK = (const bf16*)(ws + WS_SK);
    int* RIDX = (int*)(ws + WS_RIDX); float* RGATE = (float*)(ws + WS_RGATE);
    const int r32 = lane & 31, hh = lane >> 5;
    const size_t tok = (size_t)tile * 32 + r32;
    float rs2; { const f32x4* sp = (const f32x4*)((const float*)(ws + WS_SSQH) + tok * 32); f32x4 a = sp[0];
#pragma unroll
        for (int i = 1; i < 8; ++i) a = a + sp[i];
        rs2 = rsqrtf(((a[0] + a[1]) + (a[2] + a[3])) * (1.f / 2048.f) + EPS); }
#pragma unroll 1
    for (int p = 0; p < 2; ++p) {
        f32x16 s[4];
#pragma unroll
        for (int kb = 0; kb < 4; ++kb)
#pragma unroll
            for (int r = 0; r < 16; ++r) s[kb][r] = 0.f;
        const bf16* qp = QP + tok * 2048 + h * 256 + p * 128 + 8 * hh;
        const bf16* kp = SK + ((size_t)(h * 2 + p) * 128 + r32) * 128 + 8 * hh;
#pragma unroll
        for (int ks = 0; ks < 8; ++ks) { const bf16x8 q = *(const bf16x8*)(qp + 16 * ks);
#pragma unroll
            for (int kb = 0; kb < 4; ++kb) { const bf16x8 k = *(const bf16x8*)(kp + (size_t)kb * 32 * 128 + 16 * ks); s[kb] = MFMA32(k, q, s[kb]); } }
#pragma unroll
        for (int kb = 0; kb < 4; ++kb)
#pragma unroll
            for (int r = 0; r < 16; ++r) s[kb][r] = asf((asu(s[kb][r] * rs2) & ~127u) | (unsigned)(32 * kb + (r & 3) + 8 * (r >> 2) + 4 * hh));
        {
            float v[64], u[16];
#pragma unroll
            for (int kb = 0; kb < 4; ++kb)
#pragma unroll
                for (int r = 0; r < 16; ++r) v[16 * kb + r] = s[kb][r];
            top16_of_64(v, u);
            float w[16];
#pragma unroll
            for (int i = 0; i < 16; ++i) w[i] = fmaxf(u[i], __shfl_xor(u[15 - i], 32));
            bitonic_merge16<true>(w);
            if (hh == 0) {
#pragma unroll
                for (int i = 0; i < 16; i += 4) *(LAS v4u*)(sc + (p * 32 + r32) * 16 + i) = (v4u){asu(w[i]), asu(w[i + 1]), asu(w[i + 2]), asu(w[i + 3])};
            }
        }
    }
    unsigned t1[16], t2[16];
#pragma unroll
    for (int i = 0; i < 16; i += 4) { const v4u a = *(const LAS v4u*)(sc + r32 * 16 + i), b = *(const LAS v4u*)(sc + (32 + r32) * 16 + i);
        t1[i] = a.x; t1[i + 1] = a.y; t1[i + 2] = a.z; t1[i + 3] = a.w; t2[i] = b.x; t2[i + 1] = b.y; t2[i + 2] = b.z; t2[i + 3] = b.w; }
    float c[64]; int n = 0;
#pragma unroll
    for (int i = 0; i < 16; ++i)
#pragma unroll
        for (int j = 0; j < 16; ++j) if ((i + 1) * (j + 1) <= 16) { const float v = asf(t1[i] & ~127u) + asf(t2[j] & ~127u); c[n] = asf((asu(v) & ~255u) | (unsigned)(i * 16 + j)); ++n; }
#pragma unroll
    for (int q = 50; q < 64; ++q) c[q] = -3.0e38f;
    float top[16];
    top16_of_64(c, top);
    float best[8]; const float bmax = asf(asu(top[0]) & ~255u); float esum = 0.f;
#pragma unroll
    for (int k = 0; k < 16; ++k) { esum += __expf(asf(asu(top[k]) & ~255u) - bmax); if ((k >> 3) == hh) best[k & 7] = top[k]; }
    const float inv = 1.0f / esum;
    int idx[8]; float gate[8];
#pragma unroll
    for (int k = 0; k < 8; ++k) { const unsigned code = asu(best[k]) & 255u; const unsigned a = sc[r32 * 16 + (code >> 4)], b = sc[(32 + r32) * 16 + (code & 15)];
        idx[k] = (int)((a & 127u) * 128u + (b & 127u)); gate[k] = __expf(asf(asu(best[k]) & ~255u) - bmax) * inv; }
    int* ip = RIDX + tok * 128 + h * 16 + 8 * hh; float* gp = RGATE + tok * 128 + h * 16 + 8 * hh;
    *(v4u*)ip = (v4u){(unsigned)idx[0], (unsigned)idx[1], (unsigned)idx[2], (unsigned)idx[3]}; *(v4u*)(ip + 4) = (v4u){(unsigned)idx[4], (unsigned)idx[5], (unsigned)idx[6], (unsigned)idx[7]};
    *(f32x4*)gp = (f32x4){gate[0], gate[1], gate[2], gate[3]}; *(f32x4*)(gp + 4) = (f32x4){gate[4], gate[5], gate[6], gate[7]};
}

__device__ __forceinline__ void phase_route(const Params& P, LAS unsigned char* lds, int vcu, int G, int wave) {
    const int lane = hw_lane();
    LAS unsigned* sc = (LAS unsigned*)(lds + wave * 4096);
#pragma unroll 1
    for (int it = vcu * NWAVES + wave; it < 512 * 8; it += G * NWAVES) route_item(P.ws, sc, it >> 3, it & 7, lane);
}

__device__ __forceinline__ float dot16_f8(const float (&x)[16], const v4u& u, float c) {
    const int u0 = (int)u.x, u1 = (int)u.y, u2 = (int)u.z, u3 = (int)u.w;
    const f32x2 a0 = __builtin_amdgcn_cvt_pk_f32_fp8(u0, false), a1 = __builtin_amdgcn_cvt_pk_f32_fp8(u0, true);
    const f32x2 a2 = __builtin_amdgcn_cvt_pk_f32_fp8(u1, false), a3 = __builtin_amdgcn_cvt_pk_f32_fp8(u1, true);
    const f32x2 a4 = __builtin_amdgcn_cvt_pk_f32_fp8(u2, false), a5 = __builtin_amdgcn_cvt_pk_f32_fp8(u2, true);
    const f32x2 a6 = __builtin_amdgcn_cvt_pk_f32_fp8(u3, false), a7 = __builtin_amdgcn_cvt_pk_f32_fp8(u3, true);
    c = fmaf(x[0], a0.x, c); c = fmaf(x[1], a0.y, c); c = fmaf(x[2], a1.x, c); c = fmaf(x[3], a1.y, c);
    c = fmaf(x[4], a2.x, c); c = fmaf(x[5], a2.y, c); c = fmaf(x[6], a3.x, c); c = fmaf(x[7], a3.y, c);
    c = fmaf(x[8], a4.x, c); c = fmaf(x[9], a4.y, c); c = fmaf(x[10], a5.x, c); c = fmaf(x[11], a5.y, c);
    c = fmaf(x[12], a6.x, c); c = fmaf(x[13], a6.y, c); c = fmaf(x[14], a7.x, c); c = fmaf(x[15], a7.y, c);
    return c;
}
__device__ __forceinline__ void unpack8(float* x, const v4u& v) { x[0] = bflo(v.x); x[1] = bfhi(v.x); x[2] = bflo(v.y); x[3] = bfhi(v.y); x[4] = bflo(v.z); x[5] = bfhi(v.z); x[6] = bflo(v.w); x[7] = bfhi(v.w); }
#ifndef U_WAVES
#define U_WAVES 8
#endif
__device__ __forceinline__ void peer_u_wave(const Params& P, LAS unsigned* sc  , int t0, int tstep, int tend, int lane) {
    const unsigned char* ws = P.ws;
    const bf16* H1B = (const bf16*)(ws + WS_B); const unsigned char* U8 = ws + WS_UB;
    const int* RIDX = (const int*)(ws + WS_RIDX); const float* RGATE = (const float*)(ws + WS_RGATE); const float* SSQH = (const float*)(ws + WS_SSQH);
    const unsigned long long ltmask = (1ull << lane) - 1ull;
    unsigned* PKV = (unsigned*)(ws + WS_PKV);
    if (t0 >= tend) return;
    int i0, i1; float g0, g1, rs2; float x[32];
    int i0n, i1n; float g0n, g1n, ssn; v4u xa, xb, xc, xd;
#define PU_META(t) do { const size_t _t = (size_t)(t); const bf16* hp = H1B + _t * 2048 + 32 * lane; xa = *(const v4u*)hp; xb = *(const v4u*)(hp + 8); xc = *(const v4u*)(hp + 16); xd = *(const v4u*)(hp + 24); \
        ssn = lane < 32 ? SSQH[_t * 32 + lane] : 0.f; i0n = RIDX[_t * 128 + lane]; i1n = RIDX[_t * 128 + 64 + lane]; g0n = RGATE[_t * 128 + lane]; g1n = RGATE[_t * 128 + 64 + lane]; } while (0)
#define PU_SORT() do {   \
        { const int q0 = i0n >> 10, q1 = i1n >> 10; int off = 0, pos0 = 0, pos1 = 0; \
          _Pragma("unroll") for (int gq = 0; gq < 16; ++gq) { const unsigned long long m0 = __ballot(q0 == gq), m1 = __ballot(q1 == gq); const int c0 = __popcll(m0), c1 = __popcll(m1); \
              if (q0 == gq) pos0 = off + __popcll(m0 & ltmask); if (q1 == gq) pos1 = off + c0 + __popcll(m1 & ltmask); off += c0 + c1; } \
          sc[pos0] = (unsigned)i0n; sc[pos1] = (unsigned)i1n; sc[128 + pos0] = asu(g0n); sc[128 + pos1] = asu(g1n); \
          i0n = (int)sc[lane]; i1n = (int)sc[64 + lane]; g0n = asf(sc[128 + lane]); g1n = asf(sc[192 + lane]); } } while (0)
#define PU_SWAP() do { i0 = i0n; i1 = i1n; g0 = g0n; g1 = g1n; \
        unpack8(x, xa); unpack8(x + 8, xb); unpack8(x + 16, xc); unpack8(x + 24, xd); \
        rs2 = rsqrtf(wave_sum(ssn) * (1.f / 2048.f) + EPS) * (1.f / U6_SCALE); } while (0)
#define PU_LOAD(buf4, buf2, ia, ib, g) do { _Pragma("unroll") for (int e = 0; e < 8; ++e) { const int row = __builtin_amdgcn_readlane((g) < 8 ? ia : ib, ((g) & 7) * 8 + e); \
        const unsigned char* up = U8 + (size_t)row * 1536 + 16 * lane; buf4[e] = *(const v4u*)up; buf2[e] = *(const v2u*)(up + 1024 - 8 * lane); } } while (0)
#define PU_COMPUTE(buf4, buf2, g) do { float pt[8]; _Pragma("unroll") for (int e = 0; e < 8; ++e) { \
            const f32x32 r = __builtin_amdgcn_cvt_scalef32_pk32_f32_fp6((v6u){buf4[e].x, buf4[e].y, buf4[e].z, buf4[e].w, buf2[e].x, buf2[e].y}, 1.0f); \
            float s0 = 0.f, s1 = 0.f; _Pragma("unroll") for (int k = 0; k < 16; ++k) { s0 = fmaf(x[k], r[2 * k], s0); s1 = fmaf(x[16 + k], r[2 * k + 1], s1); } pt[e] = s0 + s1; }     \
        float a4[4], a2[2], a1; \
        _Pragma("unroll") for (int i = 0; i < 4; ++i) { const float keep = (lane & 1) ? pt[2 * i + 1] : pt[2 * i], give = (lane & 1) ? pt[2 * i] : pt[2 * i + 1]; a4[i] = keep + __shfl_xor(give, 1); } \
        _Pragma("unroll") for (int i = 0; i < 2; ++i) { const float keep = (lane & 2) ? a4[2 * i + 1] : a4[2 * i], give = (lane & 2) ? a4[2 * i] : a4[2 * i + 1]; a2[i] = keep + __shfl_xor(give, 2); } \
        { const float keep = (lane & 4) ? a2[1] : a2[0], give = (lane & 4) ? a2[0] : a2[1]; a1 = keep + __shfl_xor(give, 4); } \
        a1 += __shfl_xor(a1, 8); a1 += __shfl_xor(a1, 16); a1 += __shfl_xor(a1, 32); \
        if ((lane >> 3) == ((g) & 7)) { if ((g) < 8) d0 = a1; else d1 = a1; } } while (0)
    v4u ra4[8], rb4[8]; v2u ra2[8], rb2[8];
    PU_META(t0); PU_SORT(); PU_SWAP();
    PU_LOAD(ra4, ra2, i0, i1, 0);
#pragma unroll 1
    for (int t = t0; t < tend; t += tstep) {
        const bool more = t + tstep < tend;
        float d0 = 0.f, d1 = 0.f;
#pragma unroll 1
        for (int g = 0; g < 16; g += 2) {
            PU_LOAD(rb4, rb2, i0, i1, g + 1);
            if (g == 10 && more) PU_META(t + tstep);
            PU_COMPUTE(ra4, ra2, g);
            if (g + 2 < 16) PU_LOAD(ra4, ra2, i0, i1, g + 2); else if (more) { PU_SORT(); PU_LOAD(ra4, ra2, i0n, i1n, 0); }
            PU_COMPUTE(rb4, rb2, g + 1);
        }
        const size_t tok = (size_t)t;
        const float z0 = d0 * rs2, z1 = d1 * rs2;
        const float a0 = 8.0f * z0 * (1.0f + erff(z0 * 0.7071067811865476f)) * g0, a1v = 8.0f * z1 * (1.0f + erff(z1 * 0.7071067811865476f)) * g1;
        unsigned* pk = PKV + ((tok >> 6) * 128) * 64 + (tok & 63) * 4;
        pk[(size_t)(lane >> 2) * 256 + (lane & 3)] = ((unsigned)i0 << 2) | ((unsigned)__builtin_bit_cast(unsigned short, (_Float16)a0) << 16);
        pk[(size_t)(16 + (lane >> 2)) * 256 + (lane & 3)] = ((unsigned)i1 << 2) | ((unsigned)__builtin_bit_cast(unsigned short, (_Float16)a1v) << 16);
        if (more) PU_SWAP();
    }
#undef PU_META
#undef PU_SORT
#undef PU_SWAP
#undef PU_LOAD
#undef PU_COMPUTE
}
__device__ __forceinline__ void phase_peer_u(const Params& P, LAS unsigned char* lds, int vcu, int G, int wave) {
    const int lane = hw_lane();
    if (wave >= U_WAVES) return;
    peer_u_wave(P, (LAS unsigned*)(lds + wave * 1024), vcu * U_WAVES + wave, G * U_WAVES, M, lane);
}
typedef _Float16 h2_t __attribute__((ext_vector_type(2)));
__device__ __forceinline__ void peer_v_range(const Params& P, int c, int b0, int b1, int wv, int nwv, int lane) {
    const unsigned char* ws = P.ws;
    const bf16* H1B = (const bf16*)(ws + WS_B); const unsigned* PKV = (const unsigned*)(ws + WS_PKV);
    if (b0 + wv >= b1) return;
    unsigned w0[16], w1[16], w2[16], w3[16];
#define PV_LOAD(buf) do { _Pragma("unroll") for (int q = 0; q < 4; ++q) { const v4u t4 = pl[q * 64]; buf[4 * q] = t4.x; buf[4 * q + 1] = t4.y; buf[4 * q + 2] = t4.z; buf[4 * q + 3] = t4.w; } pl += 4 * 64; asm volatile("" : "+v"(pl)); } while (0)
#define PV_PROC(buf) do { v2u vv[16]; _Pragma("unroll") for (int i = 0; i < 16; ++i) vv[i] = *(const LAS v2u*)(size_t)((buf[i] << 1) & 0x1fff8u);     \
        _Pragma("unroll") for (int i = 0; i < 16; ++i) { const _Float16 ah = __builtin_bit_cast(_Float16, (unsigned short)(buf[i] >> 16)); const h2_t a2 = {ah, ah}; \
            y0 = __builtin_elementwise_fma(a2, __builtin_bit_cast(h2_t, __builtin_amdgcn_cvt_scalef32_pk_f16_fp8(vv[i].x, 1.0f, false)), y0); \
            y1 = __builtin_elementwise_fma(a2, __builtin_bit_cast(h2_t, __builtin_amdgcn_cvt_scalef32_pk_f16_fp8(vv[i].x, 1.0f, true)), y1); \
            y2 = __builtin_elementwise_fma(a2, __builtin_bit_cast(h2_t, __builtin_amdgcn_cvt_scalef32_pk_f16_fp8(vv[i].y, 1.0f, false)), y2); \
            y3 = __builtin_elementwise_fma(a2, __builtin_bit_cast(h2_t, __builtin_amdgcn_cvt_scalef32_pk_f16_fp8(vv[i].y, 1.0f, true)), y3); } } while (0)
    const v4u* pl = (const v4u*)PKV + (size_t)(b0 + wv) * 32 * 64 + lane;
    PV_LOAD(w0); PV_LOAD(w1); PV_LOAD(w2);
    v4u hxn = *(const v4u*)(H1B + ((size_t)(b0 + wv) * 64 + lane) * 2048 + 8 * c);
#pragma unroll 1
    for (int b = b0 + wv; b < b1; b += nwv) {
        const size_t tok = (size_t)b * 64 + lane;
        const int bn = (b + nwv < b1) ? b + nwv : b;
        h2_t y0 = {0, 0}, y1 = {0, 0}, y2 = {0, 0}, y3 = {0, 0};
        v4u hx = hxn;
#pragma unroll 1
        for (int half = 0; half < 2; ++half) {
            PV_LOAD(w3); PV_PROC(w0);
            if (half == 1) { hxn = *(const v4u*)(H1B + ((size_t)bn * 64 + lane) * 2048 + 8 * c); pl += (ptrdiff_t)(bn - b - 1) * 32 * 64; }
            PV_LOAD(w0); PV_PROC(w1);
            PV_LOAD(w1); PV_PROC(w2);
            PV_LOAD(w2); PV_PROC(w3);
        }
        float y[8]; unpack8(y, hx);
        constexpr float S = 1.0f / 32.0f;
        y[0] += S * (float)y0[0]; y[1] += S * (float)y0[1]; y[2] += S * (float)y1[0]; y[3] += S * (float)y1[1];
        y[4] += S * (float)y2[0]; y[5] += S * (float)y2[1]; y[6] += S * (float)y3[0]; y[7] += S * (float)y3[1];
        *(v4u*)((bf16*)(const_cast<unsigned char*>(ws) + WS_A) + tok * 2048 + 8 * c) = (v4u){pk2(y[0], y[1]), pk2(y[2], y[3]), pk2(y[4], y[5]), pk2(y[6], y[7])};
    }
#undef PV_LOAD
#undef PV_PROC
}
__device__ __forceinline__ void peer_v_fill(const Params& P, int c, int tid) {
    const v4u* src = (const v4u*)(P.ws + WS_VB + (size_t)c * 131072);
#pragma unroll 4
    for (int i = tid; i < 8192; i += NTHREADS) *(LAS v4u*)(size_t)(16 * i) = src[i];
}
__device__ __forceinline__ void phase_final(const Params& P, int vcu, int G, int wave) {
    const int lane = hw_lane();
    const bool poison = __hip_atomic_load((const unsigned*)(P.ws + WS_CTL) + CW_FLAG, __ATOMIC_RELAXED, __HIP_MEMORY_SCOPE_AGENT) != 0u;
    f32x4 gv[8];
#pragma unroll
    for (int j = 0; j < 8; ++j) gv[j] = ((const f32x4*)P.lnf)[lane + 64 * j];
#pragma unroll 1
    for (int t = vcu * NWAVES + wave; t < M; t += G * NWAVES) {
        const v2u* hrow = (const v2u*)((const bf16*)(P.ws + WS_A) + (size_t)t * 2048) + lane;
        f32x4* row = (f32x4*)(P.out + (size_t)t * 2048) + lane;
        f32x4 v[8]; float s = 0.f;
#pragma unroll
        for (int j = 0; j < 8; ++j) { const v2u h = hrow[64 * j]; v[j] = (f32x4){bflo(h.x), bfhi(h.x), bflo(h.y), bfhi(h.y)}; s += (v[j].x * v[j].x + v[j].y * v[j].y) + (v[j].z * v[j].z + v[j].w * v[j].w); }
        const float rs = poison ? __builtin_nanf("") : rsqrtf(wave_sum(s) * (1.f / 2048.f) + EPS);
#pragma unroll
        for (int j = 0; j < 8; ++j) row[64 * j] = v[j] * rs * gv[j];
    }
}
#undef MFMA32
}
#define XB_TMO      128
#define XB_XCNT(j)  (256  + 64 * (j))
#define XB_XSUB(j)  (1280 + 64 * (j))
#define XB_XGEN(j)  (2304 + 64 * (j))
#define XB_TOP      3328
#define XB_TOPGEN   3392
#define XCD_BAR_WORDS 3456
#define XB_SPIN_CAP (1u << 22)
__device__ __forceinline__ unsigned xb_ld(unsigned* p)              { return __hip_atomic_load(p, __ATOMIC_RELAXED, __HIP_MEMORY_SCOPE_AGENT); }
__device__ __forceinline__ unsigned xb_add(unsigned* p, unsigned v) { return __hip_atomic_fetch_add(p, v, __ATOMIC_RELAXED, __HIP_MEMORY_SCOPE_AGENT); }
__device__ __forceinline__ unsigned xb_xcc_id() { return (unsigned)__builtin_amdgcn_s_getreg((3 << 11) | 20) & 0xFu; }
#define XB_SPIN(cond, bar) do { unsigned _sp = 0; while (cond) { __builtin_amdgcn_s_sleep(1); \
    if ((++_sp & 255u) == 0u) { if (xb_ld(&(bar)[XB_TMO])) break; if (_sp > XB_SPIN_CAP) { atomicAdd(&(bar)[XB_TMO], 1u); break; } } } } while (0)
struct XcdBarrier { unsigned* bar; unsigned x; volatile LAS unsigned* st; };
__device__ __forceinline__ XcdBarrier xcd_barrier_post(unsigned* bar, volatile LAS unsigned* st, bool leader) {
    XcdBarrier b; b.bar = bar; b.x = xb_xcc_id(); b.st = st;
    if (leader) (void)xb_add(&bar[XB_XCNT(b.x)], 1u);
    return b;
}
__device__ __forceinline__ void xcd_barrier_complete(unsigned* bar, unsigned x, unsigned& nloc, unsigned& nx) {
    const unsigned G = gridDim.x * gridDim.y * gridDim.z;
    unsigned sum, cnt, mine, sp = 0u;
    for (;;) {
        sum = 0u; cnt = 0u; mine = 0u;
#pragma unroll
        for (unsigned j = 0; j < 16; ++j) { const unsigned c = xb_ld(&bar[XB_XCNT(j)]); sum += c; cnt += (c > 0u) ? 1u : 0u; mine = (j == x) ? c : mine; }
        if (sum == G) break;
        __builtin_amdgcn_s_sleep(1);
        if ((++sp & 255u) == 0u) { if (xb_ld(&bar[XB_TMO])) break; if (sp > XB_SPIN_CAP) { atomicAdd(&bar[XB_TMO], 1u); break; } }
    }
    nloc = mine > 0u ? mine : 1u; nx = cnt > 0u ? cnt : 1u;
}
__device__ __forceinline__ void xcd_barrier(const XcdBarrier& b, int wave) {
    asm volatile("s_waitcnt vmcnt(0)" ::: "memory");
    __syncthreads();
    if (wave == 0 && hw_lane() == 0) {
        unsigned* bar = b.bar;
        __builtin_amdgcn_s_waitcnt(0);
        unsigned nloc = b.st[0], nx = b.st[1];
        if (nloc == 0u) { xcd_barrier_complete(bar, b.x, nloc, nx); b.st[0] = nloc; b.st[1] = nx; }
        const unsigned old = xb_add(&bar[XB_XSUB(b.x)], 1u);
        const unsigned gen = old / nloc;
        if (old + 1u == (gen + 1u) * nloc) {
            __builtin_amdgcn_fence(__ATOMIC_RELEASE, "agent");
            asm volatile("s_waitcnt vmcnt(0)" ::: "memory");
            const unsigned og = xb_add(&bar[XB_TOP], 1u);
            const unsigned tg = og / nx;
            if (og + 1u == (tg + 1u) * nx) xb_add(&bar[XB_TOPGEN], 1u);
            else XB_SPIN(xb_ld(&bar[XB_TOPGEN]) == tg, bar);
            __builtin_amdgcn_fence(__ATOMIC_ACQUIRE, "agent");
            xb_add(&bar[XB_XGEN(b.x)], 1u);
            asm volatile("s_waitcnt vmcnt(0)" ::: "memory");
        } else {
            XB_SPIN(xb_ld(&bar[XB_XGEN(b.x)]) == gen, bar);
            __builtin_amdgcn_fence(__ATOMIC_ACQUIRE, "agent");
            asm volatile("s_waitcnt vmcnt(0)" ::: "memory");
        }
    }
    __syncthreads();
}
constexpr int N_PHASES = 10;
#ifndef REP_PHASE
#define REP_PHASE -1
#endif
#ifndef REP_N
#define REP_N 1
#endif
#ifndef EXTRA_SYNCS
#define EXTRA_SYNCS 0
#endif
__global__ void __launch_bounds__(NTHREADS, 2) mega(Params P) {
    extern __shared__ __attribute__((aligned(16))) unsigned char lds_raw[];
    LAS unsigned char* lds = (LAS unsigned char*)lds_raw;
    cg::grid_group grid = cg::this_grid();
    const int wave = __builtin_amdgcn_readfirstlane((int)threadIdx.x >> 6);
    const int G = gridDim.x, bx = blockIdx.x;
    const int vcu = (G % 8 == 0) ? (bx % 8) * (G / 8) + bx / 8 : bx;
    unsigned char* ws = P.ws;
    const int lo = P.ph_lo, hi = P.ph_hi;
#define IN(k) (lo <= (k) && (k) < hi)
#ifndef CG_SEAMS
#define CG_SEAMS 0
#endif
    volatile LAS unsigned* xbst = (volatile LAS unsigned*)(lds + MISC_OFF + 8192);
    if (wave == 0 && hw_lane() == 0) { xbst[0] = 0u; xbst[1] = 0u; xbst[2] = 0u; xbst[3] = 0u; }
    __syncthreads();
    const XcdBarrier xbar = xcd_barrier_post((unsigned*)(ws + WS_CTL) + 4096, xbst, wave == 0 && hw_lane() == 0);
    if (lo == 0) grid.sync();
#define GSYNC(k) do { if ((k) < CG_SEAMS) grid.sync(); else xcd_barrier(xbar, wave); } while (0)
#define SEAM(k) do { if (IN(k) && IN((k) + 1)) GSYNC(k); } while (0)

    for (int rep_ = 0; rep_ < (REP_PHASE == 0 ? 1 + REP_N : 1); ++rep_) if (IN(0)) { if (rep_) GSYNC(9); phase_prep(P, lds, vcu, G, wave, rep_ ? PREP_ONLY : -1); }
    SEAM(0);
    for (int es_ = 0; es_ < EXTRA_SYNCS; ++es_) GSYNC(9);
    for (int rep_ = 0; rep_ < (REP_PHASE == 1 ? 1 + REP_N : 1); ++rep_) if (IN(1)) { if (rep_) GSYNC(9);
        pg8::GemmSet g; g.A0 = g.A1 = (const bf16*)(ws + WS_A); g.Bt0 = g.Bt1 = (const bf16*)(ws + WS_BT1); g.K = 2048;
        pg8::StaticOrder S; S.init(M, 4096, 0, G, bx);
        pg8::Epi1 E{(bf16*)(ws + WS_B), (bf16*)(ws + WS_CQ), (bf16*)(ws + WS_CKV), (float*)(ws + WS_SSQCQ), (float*)(ws + WS_SSQCKV)};
        pg8::gemm_phase<pg8::Epi1, pg8::StaticOrder>(lds, g, S, E, wave);
    }
#ifdef EXTRA_G1
    if (IN(1)) { GSYNC(9);
        pg8::GemmSet g; g.A0 = g.A1 = (const bf16*)(ws + WS_A); g.Bt0 = g.Bt1 = (const bf16*)(ws + WS_BT1); g.K = 2048;
        pg8::ForcedOrder S; S.S.init(M, 4096, 0, G, bx); S.mmask = (EXTRA_G1 & 1) ? 0 : ~0; S.nmask = (EXTRA_G1 & 2) ? 0 : ~0;
        pg8::EpiNull E{}; pg8::gemm_phase<pg8::EpiNull, pg8::ForcedOrder>(lds, g, S, E, wave);
    }
#endif
    SEAM(1);
    for (int rep_ = 0; rep_ < (REP_PHASE == 2 ? 1 + REP_N : 1); ++rep_) if (IN(2)) { if (rep_) GSYNC(9);
        for (int it = bx; it < 256; it += G) kr_item64((const bf16*)(ws + WS_A), (const bf16*)(ws + WS_BTKR), (const f32x2*)(ws + WS_ROPE), (bf16*)(ws + WS_KPE), (LAS f32x4*)lds, it, wave, hw_lane());
        pg8::GemmSet g; g.A0 = (const bf16*)(ws + WS_CQ); g.A1 = (const bf16*)(ws + WS_CKV); g.Bt0 = (const bf16*)(ws + WS_BT2Q); g.Bt1 = (const bf16*)(ws + WS_BT2KV); g.K = 512;
        pg8::StaticOrder S; S.init(M, 1536, 2048, G, bx);
        pg8::Epi2 E{(bf16*)(ws + WS_QN), (bf16*)(ws + WS_QPE), (bf16*)(ws + WS_KN), (bf16*)(ws + WS_VM), (const float*)(ws + WS_SSQCQ), (const float*)(ws + WS_SSQCKV), (const f32x2*)(ws + WS_ROPE)};
        pg8::gemm_phase<pg8::Epi2, pg8::StaticOrder>(lds, g, S, E, wave);
    }
#ifdef EXTRA_G2
    if (IN(2)) { GSYNC(9);
        pg8::GemmSet g; g.A0 = (const bf16*)(ws + WS_CQ); g.A1 = (const bf16*)(ws + WS_CKV); g.Bt0 = (const bf16*)(ws + WS_BT2Q); g.Bt1 = (const bf16*)(ws + WS_BT2KV); g.K = 512;
        pg8::StaticOrder S; S.init(M, 1536, 2048, G, bx);
#if EXTRA_G2 == 1
        pg8::Epi2 E{(bf16*)(ws + WS_QN), (bf16*)(ws + WS_QPE), (bf16*)(ws + WS_KN), (bf16*)(ws + WS_VM), (const float*)(ws + WS_SSQCQ), (const float*)(ws + WS_SSQCKV), (const f32x2*)(ws + WS_ROPE)};
        pg8::gemm_phase<pg8::Epi2, pg8::StaticOrder>(lds, g, S, E, wave);
#else
        pg8::EpiNull E{}; pg8::gemm_phase<pg8::EpiNull, pg8::StaticOrder>(lds, g, S, E, wave);
#endif
    }
#endif
    SEAM(2);
    for (int rep_ = 0; rep_ < (REP_PHASE == 3 ? 1 + REP_N : 1); ++rep_) if (IN(3)) { if (rep_) GSYNC(9); att::phase_attn(P, lds, vcu, G, wave); }
    SEAM(3);
    for (int rep_ = 0; rep_ < (REP_PHASE == 4 ? 1 + REP_N : 1); ++rep_) if (IN(4)) { if (rep_) GSYNC(9);
        pg8::GemmSet g; g.A0 = g.A1 = (const bf16*)(ws + WS_A); g.Bt0 = g.Bt1 = (const bf16*)(ws + WS_BT3); g.K = 2048;
        pg8::StaticOrder S; S.init(M, 2048, 0, G, bx);
        pg8::Epi3 E{(bf16*)(ws + WS_B), P.x, (const float*)(ws + WS_SSQO), (float*)(ws + WS_SSQH), (LAS f32x2*)(lds + MISC_OFF)};
        pg8::gemm_phase<pg8::Epi3, pg8::StaticOrder>(lds, g, S, E, wave);
    }
    SEAM(4);
    for (int rep_ = 0; rep_ < (REP_PHASE == 5 ? 1 + REP_N : 1); ++rep_) if (IN(5)) { if (rep_) GSYNC(9);
        pg8::GemmSet g; g.A0 = g.A1 = (const bf16*)(ws + WS_B); g.Bt0 = g.Bt1 = (const bf16*)(ws + WS_BT4); g.K = 2048;
        pg8::StaticOrder S; S.init(M, 2048, 0, G, bx);
        pg8::Epi4 E{(bf16*)(ws + WS_QP)};
        pg8::gemm_phase<pg8::Epi4, pg8::StaticOrder>(lds, g, S, E, wave);
    }
#ifdef EXTRA_G4
    if (IN(5)) { GSYNC(9);
        pg8::GemmSet g; g.A0 = g.A1 = (const bf16*)(ws + WS_B); g.Bt0 = g.Bt1 = (const bf16*)(ws + WS_BT4); g.K = 2048;
        pg8::StaticOrder S; S.init(M, 2048, 0, G, bx);
#if EXTRA_G4 == 1
        pg8::Epi4 E{(bf16*)(ws + WS_QP)}; pg8::gemm_phase<pg8::Epi4, pg8::StaticOrder>(lds, g, S, E, wave);
#elif EXTRA_G4 == 3
        pg8::EpiSmall E{(bf16*)(ws + WS_A)}; pg8::gemm_phase<pg8::EpiSmall, pg8::StaticOrder>(lds, g, S, E, wave);
#else
        pg8::EpiNull E{}; pg8::gemm_phase<pg8::EpiNull, pg8::StaticOrder>(lds, g, S, E, wave);
#endif
    }
#endif
    SEAM(5);
    for (int rep_ = 0; rep_ < (REP_PHASE == 6 ? 1 + REP_N : 1); ++rep_) if (IN(6)) { if (rep_) GSYNC(9); peer::phase_route(P, lds, vcu, G, wave); }
    SEAM(6);
    for (int rep_ = 0; rep_ < (REP_PHASE == 7 ? 1 + REP_N : 1); ++rep_) if (IN(7)) { if (rep_) GSYNC(9); peer::phase_peer_u(P, lds, vcu, G, wave); }
    SEAM(7);
    for (int rep_ = 0; rep_ < (REP_PHASE == 8 ? 1 + REP_N : 1); ++rep_) if (IN(8)) { if (rep_) GSYNC(9);
        const int lane_ = hw_lane();
        for (int c = vcu; c < 256; c += G) { __syncthreads(); peer::peer_v_fill(P, c, wave * 64 + lane_); __syncthreads(); peer::peer_v_range(P, c, 0, 256, wave, NWAVES, lane_); }
    }
    SEAM(8);
    for (int rep_ = 0; rep_ < (REP_PHASE == 9 ? 1 + REP_N : 1); ++rep_) if (IN(9)) { if (rep_) GSYNC(9); peer::phase_final(P, vcu, G, wave); }
#undef IN
#undef SEAM
}

static int mega_grid() {
    static int grid = 0;
    if (grid == 0) {
        int dev = 0, cus = 0, per_cu = 0;
        (void)hipGetDevice(&dev); (void)hipDeviceGetAttribute(&cus, hipDeviceAttributeMultiprocessorCount, dev);
        (void)hipFuncSetAttribute((const void*)mega, hipFuncAttributeMaxDynamicSharedMemorySize, LDS_BYTES);
        (void)hipOccupancyMaxActiveBlocksPerMultiprocessor(&per_cu, (const void*)mega, NTHREADS, LDS_BYTES);
        if (per_cu < 1) { fprintf(stderr, "mega: occupancy query says %d blocks/CU\n", per_cu); per_cu = 1; }
        grid = cus;
        (void)hipGetLastError();
    }
    return grid;
}
static void fill_params(Params& P, void* const* d_in, void* d_out, void* d_ws) {
    P.x = (const float*)d_in[0]; P.ln1 = (const float*)d_in[1]; P.w_in = (const float*)d_in[2]; P.qan = (const float*)d_in[3]; P.kvan = (const float*)d_in[4];
    P.w_uq = (const float*)d_in[5]; P.w_ukv = (const float*)d_in[6]; P.ond = (const float*)d_in[7]; P.onm = (const float*)d_in[8]; P.w_o = (const float*)d_in[9];
    P.ln2 = (const float*)d_in[10]; P.wq = (const float*)d_in[11]; P.sk = (const float*)d_in[12]; P.pu = (const float*)d_in[13]; P.pv = (const float*)d_in[14]; P.lnf = (const float*)d_in[15];
    P.out = (float*)d_out; P.ws = (unsigned char*)d_ws;
}
static void launch_phases(Params P, int lo, int hi, hipStream_t st) {
    P.ph_lo = lo; P.ph_hi = hi;
    (void)hipMemsetAsync(P.ws + WS_CTL, 0, CTL_ZERO_BYTES, st);
    void* args[] = {&P};
    hipError_t e = hipLaunchCooperativeKernel((const void*)mega, dim3(mega_grid()), dim3(NTHREADS), args, LDS_BYTES, st);
    if (e != hipSuccess) fprintf(stderr, "mega launch [%d,%d) failed: %s\n", lo, hi, hipGetErrorString(e));
}
extern "C" void kernel_launch(void* const* d_in, const int* in_sizes, int n_in, void* d_out, int out_size, void* d_ws, size_t ws_size, hipStream_t stream) {
    Params P{}; fill_params(P, d_in, d_out, d_ws);
    launch_phases(P, 0, N_PHASES, stream);
}
```

```cpp
#include <hip/hip_runtime.h>
#include <hip/hip_cooperative_groups.h>
#include <cstdio>
#include <cstdint>
#include <cstddef>
namespace cg = cooperative_groups;
#define GAS __attribute__((address_space(1)))
#define LAS __attribute__((address_space(3)))
typedef unsigned short bf16;
typedef unsigned v4u __attribute__((ext_vector_type(4)));
typedef unsigned v2u __attribute__((ext_vector_type(2)));
typedef float f32x2 __attribute__((ext_vector_type(2)));
typedef float f32x4 __attribute__((ext_vector_type(4)));
typedef float f32x16 __attribute__((ext_vector_type(16)));
typedef short bf16x8 __attribute__((ext_vector_type(8)));
typedef short s16x4 __attribute__((ext_vector_type(4)));
typedef __bf16 bf16x2_t __attribute__((ext_vector_type(2)));
typedef float f32x32 __attribute__((ext_vector_type(32)));
typedef unsigned v6u __attribute__((ext_vector_type(6)));
constexpr int CW_FLAG = 64;
constexpr float U6_SCALE = 64.0f;

constexpr int M = 16384, SEQ = 2048, DM = 2048, NWAVES = 8, NTHREADS = 512;
constexpr float EPS = 1e-6f, LOG2E = 1.4426950408889634f;
constexpr float QSCALE_DIL = 0.08838834764831845f * LOG2E;
constexpr float QSCALE_MLA = 0.07216878364870323f * LOG2E;

constexpr size_t MiB = 1u << 20;
constexpr size_t WS_CTL = 0; constexpr int CTL_ZERO_BYTES = 32 * 1024;
constexpr size_t WS_ROPE = 1 * MiB;
constexpr size_t WS_SK = 2 * MiB;
constexpr size_t WS_BTKR = 3 * MiB;
constexpr size_t WS_BT2Q = 4 * MiB;
constexpr size_t WS_BT2KV = 6 * MiB;
constexpr size_t WS_BT1 = 8 * MiB;
constexpr size_t WS_BT3 = 24 * MiB;
constexpr size_t WS_BT4 = 32 * MiB;
constexpr size_t WS_SSQCQ = 40 * MiB;
constexpr size_t WS_SSQCKV = 40 * MiB + 512 * 1024;
constexpr size_t WS_SSQO = 41 * MiB;
constexpr size_t WS_SSQH = 42 * MiB;
constexpr size_t WS_KPE = 44 * MiB;
constexpr size_t WS_UB = 48 * MiB;
constexpr size_t WS_VB = 112 * MiB;
constexpr size_t WS_A = 176 * MiB;
constexpr size_t WS_B = 240 * MiB;
constexpr size_t WS_C = 336 * MiB;
constexpr size_t WS_QN = WS_C, WS_QPE = WS_C + 32 * MiB, WS_KN = WS_C + 48 * MiB, WS_VM = WS_C + 80 * MiB;
constexpr size_t WS_QP = WS_C, WS_RIDX = WS_C + 64 * MiB, WS_RGATE = WS_C + 72 * MiB, WS_PKV = WS_C + 80 * MiB,
                 WS_SIDX = WS_C + 88 * MiB, WS_SGATE = WS_C + 96 * MiB, WS_GOFF = WS_C + 104 * MiB;
constexpr size_t WS_D = 448 * MiB;
constexpr size_t WS_CQ = WS_D, WS_CKV = WS_D + 16 * MiB;
constexpr size_t WS_END = 480 * MiB;

constexpr int RING_BYTES = 131072;
constexpr int MISC_OFF = RING_BYTES;
constexpr int LDS_BYTES = 147456;

#define LDS_WAIT() asm volatile("s_waitcnt lgkmcnt(0)" ::: "memory")
#define VM_WAIT() asm volatile("s_waitcnt vmcnt(0)" ::: "memory")

__device__ __forceinline__ unsigned f2bf(float f) { unsigned u = __builtin_bit_cast(unsigned, f); return (u + 0x7fffu + ((u >> 16) & 1u)) >> 16; }
__device__ __forceinline__ unsigned pk2(float lo, float hi) { f32x2 v = {lo, hi}; bf16x2_t b = __builtin_convertvector(v, bf16x2_t); return __builtin_bit_cast(unsigned, b); }
__device__ __forceinline__ float bflo(unsigned u) { return __builtin_bit_cast(float, u << 16); }
__device__ __forceinline__ float bfhi(unsigned u) { return __builtin_bit_cast(float, u & 0xffff0000u); }
__device__ __forceinline__ float bf2f(bf16 b) { return __builtin_bit_cast(float, (unsigned)b << 16); }
__device__ __forceinline__ float wave_sum(float v) {
#pragma unroll
    for (int o = 1; o < 64; o <<= 1) v += __shfl_xor(v, o);
    return v;
}

__device__ __forceinline__ int hw_lane() { int l; asm volatile("v_mbcnt_lo_u32_b32 %0, -1, 0\n\tv_mbcnt_hi_u32_b32 %0, -1, %0" : "=v"(l)); return l; }

struct Params {
    const float *x, *ln1, *w_in, *qan, *kvan, *w_uq, *w_ukv, *ond, *onm, *w_o, *ln2, *wq, *sk, *pu, *pv, *lnf;
    float* out; unsigned char* ws;
    int ph_lo, ph_hi;
};
__device__ __forceinline__ int map_ident(int c) { return c; }
__device__ __forceinline__ int map_kr(int c) { const int p = c - 4096; return 2 * (p & 31) + (p >> 5); }
__device__ __forceinline__ int map_uq(int c) { const int h = c / 192, e = c % 192; if (e < 128) return h * 128 + e; const int p = e - 128; return 1024 + h * 64 + 2 * (p & 31) + (p >> 5); }
__device__ __forceinline__ int map_ukv(int c) { const int h = c >> 8, e = c & 255; return e < 128 ? h * 128 + e : 1024 + h * 128 + (e - 128); }

template <int MAP>
__device__ __forceinline__ void p0_transpose_item(const float* __restrict__ W, int K, int ldw, int c0, const float* __restrict__ g0, const float* __restrict__ g1, int gsplit,
                                                  bf16* __restrict__ WT, LAS float* scr, int item, int nblk, int lane) {
    const int kb = item / nblk, nb = item % nblk, k0 = 64 * kb, n0 = c0 + 32 * nb;
    f32x4 wv[8];
#pragma unroll
    for (int i = 0; i < 8; ++i) wv[i] = *(const f32x4*)(W + (size_t)(k0 + (lane >> 3) + 8 * i) * ldw + n0 + 4 * (lane & 7));
#pragma unroll
    for (int i = 0; i < 8; ++i) { const int kk = (lane >> 3) + 8 * i, k = k0 + kk; f32x4 w = wv[i];
        if (g0) w = w * (k < gsplit ? g0[k] : g1[k - gsplit]);
        LAS float* d = scr + kk * 33 + 4 * (lane & 7); d[0] = w[0]; d[1] = w[1]; d[2] = w[2]; d[3] = w[3]; }
    LDS_WAIT(); asm volatile("" ::: "memory");
    const int c = lane & 7;
#pragma unroll
    for (int j = 0; j < 4; ++j) { const int n = (lane >> 3) + 8 * j; const LAS float* s = scr + (8 * c) * 33 + n;
        v4u o; o.x = pk2(s[0 * 33], s[1 * 33]); o.y = pk2(s[2 * 33], s[3 * 33]); o.z = pk2(s[4 * 33], s[5 * 33]); o.w = pk2(s[6 * 33], s[7 * 33]);
        const int src = n0 + n;
        const int dr = MAP == 0 ? map_ident(src) : MAP == 1 ? map_kr(src) : MAP == 2 ? map_uq(src) : map_ukv(src);
        *(v4u*)(WT + (size_t)dr * K + k0 + 8 * c) = o; }
    LDS_WAIT(); asm volatile("" ::: "memory");
}

#ifndef PREP_ONLY
#define PREP_ONLY -1
#endif
__device__ __forceinline__ void phase_prep(const Params& P, LAS unsigned char* lds, int vcu, int G, int wave, int only = -1) {
    const int lane = hw_lane(), tid = wave * 64 + lane;
    unsigned char* ws = P.ws;
    LAS float* scr = (LAS float*)(lds + wave * 16384);
    const int gw = vcu * NWAVES + wave, NGW = G * NWAVES;
    const int gt = vcu * NTHREADS + tid, NGT = G * NTHREADS;
#pragma unroll 1
    for (int pi = 0; pi < 3; ++pi) {
        const int part = (pi + wave) % 3;
        if (only >= 0 && only != part) continue;
        if (part == 0) {
    constexpr int I1 = 32 * 128, IKR = 32 * 2, I2Q = 8 * 48, I2KV = 8 * 64, I3 = 32 * 64, I4 = 32 * 64;
    constexpr int NITEMS = I1 + IKR + I2Q + I2KV + I3 + I4;
    for (int it = gw; it < NITEMS; it += NGW) {
        int r = it;
        if (r < I1) { p0_transpose_item<0>(P.w_in, 2048, 4160, 0, nullptr, nullptr, 0, (bf16*)(ws + WS_BT1), scr, r, 128, lane); continue; } r -= I1;
        if (r < IKR) { p0_transpose_item<1>(P.w_in, 2048, 4160, 4096, nullptr, nullptr, 0, (bf16*)(ws + WS_BTKR), scr, r, 2, lane); continue; } r -= IKR;
        if (r < I2Q) { p0_transpose_item<2>(P.w_uq, 512, 1536, 0, P.qan, P.qan, 512, (bf16*)(ws + WS_BT2Q), scr, r, 48, lane); continue; } r -= I2Q;
        if (r < I2KV) { p0_transpose_item<3>(P.w_ukv, 512, 2048, 0, P.kvan, P.kvan, 512, (bf16*)(ws + WS_BT2KV), scr, r, 64, lane); continue; } r -= I2KV;
        if (r < I3) { p0_transpose_item<0>(P.w_o, 2048, 2048, 0, P.ond, P.onm, 1024, (bf16*)(ws + WS_BT3), scr, r, 64, lane); continue; } r -= I3;
        p0_transpose_item<0>(P.wq, 2048, 2048, 0, P.ln2, P.ln2, 2048, (bf16*)(ws + WS_BT4), scr, r, 64, lane);
    }
        } else if (part == 1) {
    {
        bf16* XN = (bf16*)(ws + WS_A);
        f32x4 gv[8];
#pragma unroll
        for (int j = 0; j < 8; ++j) gv[j] = ((const f32x4*)P.ln1)[lane + 64 * j];
        for (int m0 = gw * 4; m0 < M; m0 += NGW * 4) {
            f32x4 v[4][8];
#pragma unroll
            for (int r = 0; r < 4; ++r) { const f32x4* xr = (const f32x4*)(P.x + (size_t)(m0 + r) * DM) + lane;
#pragma unroll
                for (int j = 0; j < 8; ++j) v[r][j] = __builtin_nontemporal_load(xr + 64 * j); }
#pragma unroll
            for (int r = 0; r < 4; ++r) { float s = 0.f;
#pragma unroll
                for (int j = 0; j < 8; ++j) s += (v[r][j].x * v[r][j].x + v[r][j].y * v[r][j].y) + (v[r][j].z * v[r][j].z + v[r][j].w * v[r][j].w);
                const float rs = rsqrtf(wave_sum(s) * (1.f / DM) + EPS);
                v2u* o8 = (v2u*)(XN + (size_t)(m0 + r) * DM) + lane;
#pragma unroll
                for (int j = 0; j < 8; ++j) { v2u o; o.x = pk2(v[r][j].x * rs * gv[j].x, v[r][j].y * rs * gv[j].y); o.y = pk2(v[r][j].z * rs * gv[j].z, v[r][j].w * rs * gv[j].w); o8[64 * j] = o; } }
        }
    }
        } else {
        {
            f32x16 ta, tb;
#pragma unroll
            for (int i = 0; i < 16; ++i) { ta[i] = (float)(i & 7); tb[i] = (float)((i + 16) & 7) * 0.5f + (float)(i >> 3); }
            const f32x32 r = __builtin_amdgcn_cvt_scalef32_pk32_f32_fp6(__builtin_amdgcn_cvt_scalef32_2xpk16_fp6_f32(ta, tb, 1.0f), 1.0f);
            bool ok = true;
#pragma unroll
            for (int i = 0; i < 16; ++i) ok = ok && (r[2 * i] == ta[i]) && (r[2 * i + 1] == tb[i]);
            if (!ok) __hip_atomic_store((unsigned*)(ws + WS_CTL) + CW_FLAG, 1u, __ATOMIC_RELAXED, __HIP_MEMORY_SCOPE_AGENT);
        }
        unsigned char* ou = ws + WS_UB;
        {
            const int l = gt & 63; f32x4 gp[8];
#pragma unroll
            for (int j = 0; j < 8; ++j) gp[j] = ((const f32x4*)(P.ln2 + 32 * l))[j] * U6_SCALE;
#pragma unroll 3
            for (int i = gt; i < 16384 * 64; i += NGT) {
                const int e = i >> 6; const f32x4* src = (const f32x4*)(P.pu + (size_t)e * 2048 + 32 * l);
                f32x16 xa, xb;
#pragma unroll
                for (int j = 0; j < 4; ++j) { const f32x4 v = __builtin_nontemporal_load(src + j) * gp[j]; xa[4 * j] = v[0]; xa[4 * j + 1] = v[1]; xa[4 * j + 2] = v[2]; xa[4 * j + 3] = v[3]; }
#pragma unroll
                for (int j = 0; j < 4; ++j) { const f32x4 v = __builtin_nontemporal_load(src + 4 + j) * gp[4 + j]; xb[4 * j] = v[0]; xb[4 * j + 1] = v[1]; xb[4 * j + 2] = v[2]; xb[4 * j + 3] = v[3]; }
                const v6u p6 = __builtin_amdgcn_cvt_scalef32_2xpk16_fp6_f32(xa, xb, 1.0f);
                unsigned char* row = ou + (size_t)e * 1536;
                *(v4u*)(row + 16 * l) = (v4u){p6[0], p6[1], p6[2], p6[3]}; *(v2u*)(row + 1024 + 8 * l) = (v2u){p6[4], p6[5]};
            }
        }
        }
    }
    if (only < 0 || only == 3) {
        f32x2* R = (f32x2*)(ws + WS_ROPE);
        for (int i = gt; i < 2048 * 32; i += NGT) { const int pos = i >> 5, j = i & 31; const float freq = powf(10000.0f, -(float)j / 32.0f), ang = (float)pos * freq;
            f32x2 cs; cs.x = cosf(ang); cs.y = sinf(ang); R[i] = cs; }
    }
    if (only < 0 || only == 3) {
        v4u* o = (v4u*)(ws + WS_SK);
        for (int i = gt; i < 16 * 128 * 128 / 8; i += NGT) { const f32x4 a = ((const f32x4*)P.sk)[2 * i], b = ((const f32x4*)P.sk)[2 * i + 1];
            v4u w; w.x = pk2(a.x, a.y); w.y = pk2(a.z, a.w); w.z = pk2(b.x, b.y); w.w = pk2(b.z, b.w); o[i] = w; }
    }
    if (only < 0 || only == 4) {
        __syncthreads();
        LAS v2u* tl = (LAS v2u*)lds;
        v2u* ov = (v2u*)(ws + WS_VB);
        f32x4 ra[8], rb[8];
#define PV8_LOAD(tile_) do { const int _e0 = ((tile_) >> 2) * 64, _c0 = ((tile_) & 3) * 64; _Pragma("unroll") for (int k = 0; k < 8; ++k) { const int it = tid + 512 * k, e = it >> 6, c = it & 63; \
            const f32x4* src = (const f32x4*)(P.pv + (size_t)(_e0 + e) * 2048 + (size_t)(_c0 + c) * 8); ra[k] = __builtin_nontemporal_load(src); rb[k] = __builtin_nontemporal_load(src + 1); } } while (0)
        if (vcu < 1024) PV8_LOAD(vcu);
        for (int tile = vcu; tile < 1024; tile += G) {
            const int e0 = (tile >> 2) * 64, c0 = (tile & 3) * 64;
#pragma unroll
            for (int k = 0; k < 8; ++k) { const int it = tid + 512 * k, e = it >> 6, c = it & 63; const f32x4 a = ra[k], b = rb[k];
                int w0 = 0, w1 = 0;
                w0 = __builtin_amdgcn_cvt_pk_fp8_f32(a.x * 2.f, a.y * 2.f, w0, false); w0 = __builtin_amdgcn_cvt_pk_fp8_f32(a.z * 2.f, a.w * 2.f, w0, true);
                w1 = __builtin_amdgcn_cvt_pk_fp8_f32(b.x * 2.f, b.y * 2.f, w1, false); w1 = __builtin_amdgcn_cvt_pk_fp8_f32(b.z * 2.f, b.w * 2.f, w1, true);
                v2u w; w.x = (unsigned)w0; w.y = (unsigned)w1; tl[c * 65 + e] = w; }
            if (tile + G < 1024) PV8_LOAD(tile + G);
            __syncthreads();
#pragma unroll
            for (int k = 0; k < 8; ++k) { const int it = tid + 512 * k, c = it >> 6, e = it & 63; ov[(size_t)(c0 + c) * 16384 + e0 + e] = tl[c * 65 + e]; }
            __syncthreads();
        }
#undef PV8_LOAD
    }
}
namespace pg8 {
constexpr int BM = 256, BK = 64, HALF = 128, HTB = HALF * BK * 2, STAGE_BYTES = 8 * HTB, NXCD = 8, WGM = 8;
__host__ __device__ __forceinline__ int lds_byte(int r, int c) { const int st = (r >> 4) * 2 + (c >> 5), rr = r & 15, cc = c & 31, ob = rr * 64 + cc * 2; return st * 1024 + (ob ^ (((ob >> 9) & 1) << 5)); }
__host__ __device__ __forceinline__ void stage_rc(int b, int& R, int& C) { const int st = b / 1024, sb = b % 1024, swz = sb ^ (((sb >> 9) & 1) << 5); R = (st >> 1) * 16 + swz / 64; C = (st & 1) * 32 + (swz % 64) / 2; }
__host__ __device__ __forceinline__ int perm32(int rho) { const int n = rho >> 4, i = rho & 15; return 8 * (i >> 2) + 4 * n + (i & 3); }

struct Unit { int pm, pn, g; };
struct GemmSet { const bf16 *A0, *A1, *Bt0, *Bt1; int K; };

struct StaticOrder {
    int nM, nN0, nN, nwg, G, c;
    __device__ void init(int Mrows, int N0, int N1, int G_, int c_) { nM = Mrows / BM; nN0 = N0 / BM; nN = nN0 + N1 / BM; nwg = nM * nN; G = G_; c = c_; }
    __device__ bool next(int i, Unit& u) const {
        const long L = (long)i * G + c; if (L >= nwg) return false;
        int wgid = (int)L; { const int q = nwg / NXCD, r = nwg % NXCD, xcd = wgid % NXCD, off = wgid / NXCD; wgid = (xcd < r ? xcd * (q + 1) : r * (q + 1) + (xcd - r) * q) + off; }
        const int nig = WGM * nN, gid = wgid / nig, fm = gid * WGM, gsz = (nM - fm) < WGM ? (nM - fm) : WGM;
        u.pm = fm + ((wgid % nig) % gsz); int pn = (wgid % nig) / gsz; u.g = pn >= nN0 ? 1 : 0; u.pn = pn >= nN0 ? pn - nN0 : pn; return true;
    }
};
struct ForcedOrder {
    StaticOrder S; int mmask, nmask;
    __device__ bool next(int i, Unit& u) const { if (!S.next(i, u)) return false; u.pm &= mmask; u.pn &= nmask; return true; }
};

template <class Epi, class Sched>
__device__ __forceinline__ void gemm_phase(LAS unsigned char* lds, const GemmSet g, const Sched& S, const Epi& E, int wid) {
    const int lane = hw_lane(), tid = wid * 64 + lane, wr = wid >> 2, wc = wid & 3, fr = lane & 15, fq = lane >> 4;
    const int K = g.K, nt = K / BK;
    unsigned voffA[2], voffB[2];
#pragma unroll
    for (int i = 0; i < 2; ++i) { int R, C; stage_rc(tid * 16 + i * 8192, R, C); const int Rb = (R >> 5) * 64 + perm32(R & 31);
        voffA[i] = (unsigned)(R * K + C) * 2u; voffB[i] = (unsigned)(Rb * K + C) * 2u; }
    const size_t kstep = (size_t)(BK * 2);
    const size_t hstep = (size_t)HALF * K * 2;
    const size_t hstepB = (size_t)32 * K * 2;
    const size_t tstep = 2 * hstep;
    const unsigned ldsw = (unsigned)wid * 1024u;
    const int aoff = lds_byte(wr * 64 + fr, fq * 8), boff = lds_byte(wc * 32 + fr, fq * 8);
#define PG8_SA(b, h) (((b) * 2 + (h)) * HTB)
#define PG8_SB(b, h) ((4 + (b) * 2 + (h)) * HTB)
#define PG8_STAGE(bufoff, gbase, voff) do { _Pragma("unroll") for (int _i = 0; _i < 2; ++_i) \
        __builtin_amdgcn_global_load_lds((const unsigned*)((const char*)(gbase) + (voff)[_i]), (LAS unsigned*)(lds + (bufoff) + ldsw + _i * 8192), 16, 0, 0); } while (0)
#define PG8_LDA(dst, b, h) do { _Pragma("unroll") for (int m = 0; m < 4; ++m) _Pragma("unroll") for (int k = 0; k < 2; ++k) dst[m][k] = *(const LAS bf16x8*)(lds + PG8_SA(b, h) + aoff + m * 2048 + k * 1024); } while (0)
#define PG8_LDB(dst, b, h) do { _Pragma("unroll") for (int n = 0; n < 2; ++n) _Pragma("unroll") for (int k = 0; k < 2; ++k) dst[n][k] = *(const LAS bf16x8*)(lds + PG8_SB(b, h) + boff + n * 2048 + k * 1024); } while (0)
#define PG8_MMA(ai, bj, At, Bt) do { __builtin_amdgcn_s_setprio(1); _Pragma("unroll") for (int m = 0; m < 4; ++m) _Pragma("unroll") for (int n = 0; n < 2; ++n) _Pragma("unroll") for (int k = 0; k < 2; ++k) \
        acc[ai][bj][m][n] = __builtin_amdgcn_mfma_f32_16x16x32_bf16(Bt[n][k], At[m][k], acc[ai][bj][m][n], 0, 0, 0); __builtin_amdgcn_s_setprio(0); } while (0)
#define PG8_WAIT_V(n) asm volatile("s_waitcnt vmcnt(" #n ")" ::: "memory")
#define PG8_WAIT_L(n) asm volatile("s_waitcnt lgkmcnt(" #n ")" ::: "memory")
#define PG8_BAR __builtin_amdgcn_s_barrier()
#define PG8_SCHED __builtin_amdgcn_sched_barrier(0)
    Unit cur, nxt; int ui = 0;
    if (!S.next(0, cur)) return;
    f32x4 acc[2][2][4][2];
#pragma unroll
    for (int a = 0; a < 2; ++a)
#pragma unroll
        for (int b = 0; b < 2; ++b)
#pragma unroll
            for (int m = 0; m < 4; ++m)
#pragma unroll
                for (int n = 0; n < 2; ++n) acc[a][b][m][n] = (f32x4){0.f, 0.f, 0.f, 0.f};
    bf16x8 At[4][2], B0[2][2], B1[2][2];
    const char* cA = (const char*)(cur.g ? g.A1 : g.A0) + (size_t)cur.pm * tstep; const char* cB = (const char*)(cur.g ? g.Bt1 : g.Bt0) + (size_t)cur.pn * tstep;
    E.unit_begin(cur, 0, tid);
    PG8_STAGE(PG8_SB(0, 0), cB, voffB); PG8_STAGE(PG8_SB(0, 1), cB + hstepB, voffB); PG8_STAGE(PG8_SA(0, 0), cA, voffA); PG8_STAGE(PG8_SA(0, 1), cA + hstep, voffA);
    if (wr == 1) PG8_BAR;
    PG8_WAIT_V(2); PG8_BAR;
    PG8_STAGE(PG8_SB(1, 0), cB + kstep, voffB); PG8_STAGE(PG8_SA(1, 0), cA + kstep, voffA); PG8_STAGE(PG8_SB(1, 1), cB + hstepB + kstep, voffB);
    PG8_WAIT_V(6); PG8_BAR;
    for (;;) {
        const bool has_next = S.next(ui + 1, nxt);
        const char* nA = has_next ? (const char*)(nxt.g ? g.A1 : g.A0) + (size_t)nxt.pm * tstep : cA; const char* nB = has_next ? (const char*)(nxt.g ? g.Bt1 : g.Bt0) + (size_t)nxt.pn * tstep : cB;
        for (int t = 0; t < nt; t += 2) {
            const bool last = (t == nt - 2);
            const char* a1 = cA + (size_t)(t + 1) * kstep;
            const char* a2 = last ? nA : cA + (size_t)(t + 2) * kstep; const char* b2 = last ? nB : cB + (size_t)(t + 2) * kstep;
            const char* a3 = a2 + kstep; const char* b3 = b2 + kstep;
            if constexpr (Epi::MIDSCALE) { if (t == nt / 2) E.midscale(acc, ui & 1, wr, fr); }
            PG8_LDB(B0, 0, 0); PG8_LDB(B1, 0, 1); PG8_SCHED; PG8_LDA(At, 0, 0); PG8_STAGE(PG8_SA(1, 1), a1 + hstep, voffA);
            PG8_WAIT_V(8); PG8_WAIT_L(0); PG8_BAR; PG8_MMA(0, 0, At, B0); PG8_MMA(0, 1, At, B1); PG8_BAR; PG8_SCHED;
            PG8_LDA(At, 0, 1); PG8_STAGE(PG8_SB(0, 0), b2, voffB); PG8_STAGE(PG8_SB(0, 1), b2 + hstepB, voffB); PG8_STAGE(PG8_SA(0, 0), a2, voffA);
            PG8_WAIT_V(8); PG8_WAIT_L(0); PG8_BAR; PG8_MMA(1, 0, At, B0); PG8_MMA(1, 1, At, B1); PG8_BAR; PG8_SCHED;
            PG8_LDB(B0, 1, 0); PG8_LDB(B1, 1, 1); PG8_SCHED; PG8_LDA(At, 1, 0); PG8_STAGE(PG8_SA(0, 1), a2 + hstep, voffA);
            PG8_WAIT_V(8); PG8_WAIT_L(0); PG8_BAR; PG8_MMA(0, 0, At, B0); PG8_MMA(0, 1, At, B1); PG8_BAR; PG8_SCHED;
            PG8_LDA(At, 1, 1); PG8_STAGE(PG8_SB(1, 0), b3, voffB); PG8_STAGE(PG8_SB(1, 1), b3 + hstepB, voffB); PG8_STAGE(PG8_SA(1, 0), a3, voffA);
            PG8_WAIT_V(8); PG8_WAIT_L(0); PG8_BAR; PG8_MMA(1, 0, At, B0); PG8_MMA(1, 1, At, B1); PG8_BAR; PG8_SCHED;
        }
        if (wr == 0) PG8_BAR;
        E(acc, cur, ui & 1, wr, wc, fr, fq);
        if (!has_next) break;
#pragma unroll
        for (int a = 0; a < 2; ++a)
#pragma unroll
            for (int b = 0; b < 2; ++b)
#pragma unroll
                for (int m = 0; m < 4; ++m)
#pragma unroll
                    for (int n = 0; n < 2; ++n) acc[a][b][m][n] = (f32x4){0.f, 0.f, 0.f, 0.f};
        cur = nxt; cA = nA; cB = nB; ++ui;
        E.unit_begin(cur, ui & 1, tid);
        if (wr == 1) PG8_BAR;
    }
    PG8_WAIT_V(0);
    PG8_BAR;
#undef PG8_SA
#undef PG8_SB
#undef PG8_STAGE
#undef PG8_LDA
#undef PG8_LDB
#undef PG8_MMA
#undef PG8_WAIT_V
#undef PG8_WAIT_L
#undef PG8_BAR
#undef PG8_SCHED
}
}
namespace pg8 {
__device__ __forceinline__ v4u pack8(const f32x4& v0, const f32x4& v1) { v4u w; w.x = pk2(v0[0], v0[1]); w.y = pk2(v0[2], v0[3]); w.z = pk2(v1[0], v1[1]); w.w = pk2(v1[2], v1[3]); return w; }
__device__ __forceinline__ float sq8(const f32x4& v0, const f32x4& v1) { return (v0[0] * v0[0] + v0[1] * v0[1]) + (v0[2] * v0[2] + v0[3] * v0[3]) + (v1[0] * v1[0] + v1[1] * v1[1]) + (v1[2] * v1[2] + v1[3] * v1[3]); }

struct Epi1 {
    static constexpr bool MIDSCALE = false;
    bf16 *QKV, *CQ, *CKV; float *SSQCQ, *SSQCKV;
    __device__ __forceinline__ void midscale(f32x4 (&)[2][2][4][2], int, int, int) const {}
    __device__ __forceinline__ void unit_begin(const Unit&, int, int) const {}
    __device__ __forceinline__ void operator()(const f32x4 (&acc)[2][2][4][2], const Unit& u, int par, int wr, int wc, int fr, int fq) const {
        const int pn = u.pn; bf16* base; int ldc, colt; float sc = 1.f; float* ssq = nullptr; int sslot = 0;
        if (pn < 12) { base = QKV; ldc = 3072; colt = pn * 256; if (pn < 4) sc = QSCALE_DIL; }
        else if (pn < 14) { base = CQ; ldc = 512; colt = (pn - 12) * 256; ssq = SSQCQ; sslot = (pn - 12) * 4 + wc; }
        else { base = CKV; ldc = 512; colt = (pn - 14) * 256; ssq = SSQCKV; sslot = (pn - 14) * 4 + wc; }
        const int row0 = u.pm * BM + wr * 64 + fr, col0 = colt + wc * 64 + 8 * fq;
#pragma unroll
        for (int ai = 0; ai < 2; ++ai)
#pragma unroll
            for (int m = 0; m < 4; ++m) { const int row = row0 + ai * HALF + m * 16; bf16* rowp = base + (size_t)row * ldc + col0; float ss = 0.f;
#pragma unroll
                for (int bj = 0; bj < 2; ++bj) { const f32x4 v0 = acc[ai][bj][m][0] * sc, v1 = acc[ai][bj][m][1] * sc; ss += sq8(v0, v1); *(v4u*)(rowp + bj * 32) = pack8(v0, v1); }
                if (ssq) { ss += __shfl_xor(ss, 16); ss += __shfl_xor(ss, 32); if (fq == 0) ssq[(size_t)row * 8 + sslot] = ss; } }
    }
};

struct Epi2 {
    static constexpr bool MIDSCALE = false;
    bf16 *QN, *QPE, *KN, *VM; const float *SSQCQ, *SSQCKV; const f32x2* ROPE;
    __device__ __forceinline__ void midscale(f32x4 (&)[2][2][4][2], int, int, int) const {}
    __device__ __forceinline__ void unit_begin(const Unit&, int, int) const {}
    __device__ __forceinline__ void operator()(const f32x4 (&acc)[2][2][4][2], const Unit& u, int par, int wr, int wc, int fr, int fq) const {
        const int pn = u.pn; bf16* base; int ldc, colt; float sc = 1.f; bool rope = false; const float* ssq;
        if (u.g == 0) { ssq = SSQCQ; sc = QSCALE_MLA; if (pn < 4) { base = QN; ldc = 1024; colt = pn * 256; } else { base = QPE; ldc = 512; colt = (pn - 4) * 256; rope = true; } }
        else { ssq = SSQCKV; if (pn < 4) { base = KN; ldc = 1024; colt = pn * 256; } else { base = VM; ldc = 1024; colt = (pn - 4) * 256; } }
        const int row0 = u.pm * BM + wr * 64 + fr, col0 = colt + wc * 64 + 8 * fq;
#pragma unroll
        for (int ai = 0; ai < 2; ++ai)
#pragma unroll
            for (int m = 0; m < 4; ++m) { const int row = row0 + ai * HALF + m * 16; bf16* rowp = base + (size_t)row * ldc + col0;
                const f32x4 p0 = *(const f32x4*)(ssq + (size_t)row * 8), p1 = *(const f32x4*)(ssq + (size_t)row * 8 + 4);
                const float rs = rsqrtf(((p0[0] + p0[1]) + (p0[2] + p0[3]) + (p1[0] + p1[1]) + (p1[2] + p1[3])) * (1.f / 512.f) + EPS) * sc;
#pragma unroll
                for (int bj = 0; bj < 2; ++bj) { f32x4 v0 = acc[ai][bj][m][0] * rs, v1 = acc[ai][bj][m][1] * rs;
                    if (rope) { const int j0 = ((col0 + bj * 32) & 63) >> 1; const f32x4* rp = (const f32x4*)(ROPE + (size_t)(row & (SEQ - 1)) * 32 + j0);
                        const f32x4 r0 = rp[0], r1 = rp[1];
                        f32x4 w0, w1;
                        w0[0] = v0[0] * r0[0] - v0[1] * r0[1]; w0[1] = v0[0] * r0[1] + v0[1] * r0[0];
                        w0[2] = v0[2] * r0[2] - v0[3] * r0[3]; w0[3] = v0[2] * r0[3] + v0[3] * r0[2];
                        w1[0] = v1[0] * r1[0] - v1[1] * r1[1]; w1[1] = v1[0] * r1[1] + v1[1] * r1[0];
                        w1[2] = v1[2] * r1[2] - v1[3] * r1[3]; w1[3] = v1[2] * r1[3] + v1[3] * r1[2];
                        v0 = w0; v1 = w1; }
                    *(v4u*)(rowp + bj * 32) = pack8(v0, v1); } }
    }
};

struct Epi3 {
    static constexpr bool MIDSCALE = true;
    bf16* H1B; const float* X; const float* SSQO; float* SSQH; LAS f32x2* RS;
    __device__ __forceinline__ void unit_begin(const Unit& u, int par, int tid) const {
        if (tid < 256) { const f32x4* p = (const f32x4*)(SSQO + (size_t)(u.pm * BM + tid) * 16); const f32x4 a0 = p[0], a1 = p[1], b0 = p[2], b1 = p[3];
            const float ra = rsqrtf(((a0[0] + a0[1]) + (a0[2] + a0[3]) + (a1[0] + a1[1]) + (a1[2] + a1[3])) * (1.f / 1024.f) + EPS);
            const float rb = rsqrtf(((b0[0] + b0[1]) + (b0[2] + b0[3]) + (b1[0] + b1[1]) + (b1[2] + b1[3])) * (1.f / 1024.f) + EPS);
            f32x2 v; v.x = ra / rb; v.y = rb; RS[par * 256 + tid] = v; }
    }
    __device__ __forceinline__ void midscale(f32x4 (&acc)[2][2][4][2], int par, int wr, int fr) const {
#pragma unroll
        for (int ai = 0; ai < 2; ++ai)
#pragma unroll
            for (int m = 0; m < 4; ++m) { const float f = RS[par * 256 + ai * HALF + wr * 64 + m * 16 + fr].x;
#pragma unroll
                for (int bj = 0; bj < 2; ++bj) { acc[ai][bj][m][0] = acc[ai][bj][m][0] * f; acc[ai][bj][m][1] = acc[ai][bj][m][1] * f; } }
    }
    __device__ __forceinline__ void operator()(const f32x4 (&acc)[2][2][4][2], const Unit& u, int par, int wr, int wc, int fr, int fq) const {
        const int row0 = u.pm * BM + wr * 64 + fr, col0 = u.pn * BM + wc * 64 + 8 * fq, sslot = u.pn * 4 + wc;
#pragma unroll
        for (int ai = 0; ai < 2; ++ai)
#pragma unroll
            for (int m = 0; m < 4; ++m) { const int row = row0 + ai * HALF + m * 16; const float rb = RS[par * 256 + ai * HALF + wr * 64 + m * 16 + fr].y; float ss = 0.f;
#pragma unroll
                for (int bj = 0; bj < 2; ++bj) { const float* xp = X + (size_t)row * DM + col0 + bj * 32; const f32x4 x0 = *(const f32x4*)xp, x1 = *(const f32x4*)(xp + 4);
                    const f32x4 v0 = acc[ai][bj][m][0] * rb + x0, v1 = acc[ai][bj][m][1] * rb + x1; ss += sq8(v0, v1);
                    *(v4u*)(H1B + (size_t)row * DM + col0 + bj * 32) = pack8(v0, v1); }
                ss += __shfl_xor(ss, 16); ss += __shfl_xor(ss, 32); if (fq == 0) SSQH[(size_t)row * 32 + sslot] = ss; }
    }
};

struct Epi4 {
    static constexpr bool MIDSCALE = false;
    bf16* QP;
    __device__ __forceinline__ void midscale(f32x4 (&)[2][2][4][2], int, int, int) const {}
    __device__ __forceinline__ void unit_begin(const Unit&, int, int) const {}
    __device__ __forceinline__ void operator()(const f32x4 (&acc)[2][2][4][2], const Unit& u, int par, int wr, int wc, int fr, int fq) const {
        const int row0 = u.pm * BM + wr * 64 + fr, col0 = u.pn * BM + wc * 64 + 8 * fq;
#pragma unroll
        for (int ai = 0; ai < 2; ++ai)
#pragma unroll
            for (int m = 0; m < 4; ++m) { const int row = row0 + ai * HALF + m * 16;
#pragma unroll
                for (int bj = 0; bj < 2; ++bj) *(v4u*)(QP + (size_t)row * DM + col0 + bj * 32) = pack8(acc[ai][bj][m][0], acc[ai][bj][m][1]); }
    }
};
struct EpiSmall {
    static constexpr bool MIDSCALE = false;
    bf16* QP;
    __device__ __forceinline__ void midscale(f32x4 (&)[2][2][4][2], int, int, int) const {}
    __device__ __forceinline__ void unit_begin(const Unit&, int, int) const {}
    __device__ __forceinline__ void operator()(const f32x4 (&acc)[2][2][4][2], const Unit& u, int par, int wr, int wc, int fr, int fq) const {
        const int row0 = (blockIdx.x * 16) + fr, col0 = wc * 64 + 8 * fq;
#pragma unroll
        for (int ai = 0; ai < 2; ++ai)
#pragma unroll
            for (int m = 0; m < 4; ++m) { const int row = row0;
#pragma unroll
                for (int bj = 0; bj < 2; ++bj) *(v4u*)(QP + (size_t)row * DM + col0 + bj * 32 + (ai * 4 + m) * 256) = pack8(acc[ai][bj][m][0], acc[ai][bj][m][1]); }
    }
};
struct EpiNull {
    static constexpr bool MIDSCALE = false;
    __device__ __forceinline__ void midscale(f32x4 (&)[2][2][4][2], int, int, int) const {}
    __device__ __forceinline__ void unit_begin(const Unit&, int, int) const {}
    __device__ __forceinline__ void operator()(const f32x4 (&acc)[2][2][4][2], const Unit& u, int par, int wr, int wc, int fr, int fq) const {
#pragma unroll
        for (int ai = 0; ai < 2; ++ai)
#pragma unroll
            for (int bj = 0; bj < 2; ++bj)
#pragma unroll
                for (int m = 0; m < 4; ++m)
#pragma unroll
                    for (int n = 0; n < 2; ++n) asm volatile("" :: "v"(acc[ai][bj][m][n]));
    }
};
}

__device__ __forceinline__ void kr_item64(const bf16* __restrict__ XN, const bf16* __restrict__ BT, const f32x2* __restrict__ ROPE, bf16* __restrict__ KPE, LAS f32x4* red, int item, int wave, int lane) {
    const int fr = lane & 15, fq = lane >> 4, rg = wave & 3, kh = wave >> 2, row = item * 64 + rg * 16 + fr;
    const bf16* ap = XN + (size_t)row * 2048 + kh * 1024 + fq * 8; const bf16* bp = BT + (size_t)fr * 2048 + kh * 1024 + fq * 8;
    f32x4 acc[4];
#pragma unroll
    for (int nb = 0; nb < 4; ++nb) acc[nb] = (f32x4){0.f, 0.f, 0.f, 0.f};
#pragma unroll 4
    for (int k0 = 0; k0 < 1024; k0 += 32) {
        const bf16x8 a = *(const bf16x8*)(ap + k0);
#pragma unroll
        for (int nb = 0; nb < 4; ++nb) { const bf16x8 b = *(const bf16x8*)(bp + (size_t)nb * 16 * 2048 + k0); acc[nb] = __builtin_amdgcn_mfma_f32_16x16x32_bf16(b, a, acc[nb], 0, 0, 0); }
    }
    if (kh == 1) {
#pragma unroll
        for (int nb = 0; nb < 4; ++nb) red[(rg * 4 + nb) * 64 + lane] = acc[nb];
    }
    __syncthreads();
    if (kh == 0) {
        const int pos = row & (SEQ - 1);
#pragma unroll
        for (int nb = 0; nb < 4; ++nb) { const int j0 = 8 * nb + 2 * fq; const f32x4 r = *(const f32x4*)(ROPE + (size_t)pos * 32 + j0); const f32x4 v = acc[nb] + red[(rg * 4 + nb) * 64 + lane];
            v2u o; o.x = pk2(v[0] * r[0] - v[1] * r[1], v[0] * r[1] + v[1] * r[0]); o.y = pk2(v[2] * r[2] - v[3] * r[3], v[2] * r[3] + v[3] * r[2]);
            *(v2u*)(KPE + (size_t)row * 64 + 16 * nb + 4 * fq) = o; }
    }
    __syncthreads();
}
namespace att {
typedef short v4i16_t __attribute__((ext_vector_type(4)));
#define MFMA32(a, b, c) __builtin_amdgcn_mfma_f32_32x32x16_bf16((a), (b), (c), 0, 0, 0)
__device__ __forceinline__ s16x4 vtr(const LAS unsigned char* p) { return __builtin_bit_cast(s16x4, __builtin_amdgcn_ds_read_tr16_b64_v4i16((LAS v4i16_t*)p)); }
__device__ __forceinline__ int crow(int r, int hi) { return (r & 3) + 8 * (r >> 2) + 4 * hi; }
constexpr int VS = 320;
constexpr int KS = 400;
constexpr float NEG = -1e30f;

__device__ __forceinline__ bf16x8 pack8r(const f32x16& p, int s) {
    v4u w; w.x = pk2(p[8 * s + 0], p[8 * s + 1]); w.y = pk2(p[8 * s + 2], p[8 * s + 3]); w.z = pk2(p[8 * s + 4], p[8 * s + 5]); w.w = pk2(p[8 * s + 6], p[8 * s + 7]);
    return __builtin_bit_cast(bf16x8, w);
}
__device__ __forceinline__ void pv32(f32x16 (&o)[4], const LAS unsigned char* vb, const bf16x8 pb0, const bf16x8 pb1) {
#pragma unroll
    for (int d = 0; d < 4; ++d) {
        const s16x4 l0 = vtr(vb + d * 64), h0 = vtr(vb + d * 64 + 8 * VS), l1 = vtr(vb + d * 64 + 16 * VS), h1 = vtr(vb + d * 64 + 24 * VS);
        const bf16x8 a0 = __builtin_shufflevector(l0, h0, 0, 1, 2, 3, 4, 5, 6, 7), a1 = __builtin_shufflevector(l1, h1, 0, 1, 2, 3, 4, 5, 6, 7);
        o[d] = MFMA32(a0, pb0, o[d]); o[d] = MFMA32(a1, pb1, o[d]);
    }
}
template <int NS>
__device__ __forceinline__ void softmax_step(f32x16 (&s)[NS], float& m, float& l, f32x16 (&o)[4], bf16x8 (&pb)[2 * NS]) {
    float mx = s[0][0];
#pragma unroll
    for (int t = 0; t < NS; ++t)
#pragma unroll
        for (int r = 0; r < 16; ++r) mx = fmaxf(mx, s[t][r]);
    mx = fmaxf(mx, __shfl_xor(mx, 32));
    const float mn = fmaxf(m, mx), alpha = __builtin_amdgcn_exp2f(m - mn); m = mn;
    float ps = 0.f;
#pragma unroll
    for (int t = 0; t < NS; ++t)
#pragma unroll
        for (int r = 0; r < 16; ++r) { const float p = __builtin_amdgcn_exp2f(s[t][r] - mn); s[t][r] = p; ps += p; }
    l = l * alpha + ps;
    if (!__all(alpha == 1.0f)) {
#pragma unroll
        for (int d = 0; d < 4; ++d) o[d] = o[d] * alpha;
    }
#pragma unroll
    for (int t = 0; t < NS; ++t) { pb[2 * t] = pack8r(s[t], 0); pb[2 * t + 1] = pack8r(s[t], 1); }
}
__device__ __forceinline__ void store_o(f32x16 (&o)[4], float l, bf16* __restrict__ orow  , float* __restrict__ ssq  , int hh) {
    l += __shfl_xor(l, 32);
    const float inv = 1.0f / l; float ss = 0.f;
#pragma unroll
    for (int d = 0; d < 4; ++d) { o[d] = o[d] * inv;
#pragma unroll
        for (int g = 0; g < 4; ++g) { const float a = o[d][4 * g], b = o[d][4 * g + 1], c = o[d][4 * g + 2], e = o[d][4 * g + 3];
            ss += (a * a + b * b) + (c * c + e * e);
            v2u w; w.x = pk2(a, b); w.y = pk2(c, e); *(v2u*)(orow + 32 * d + 8 * g + 4 * hh) = w; } }
    ss += __shfl_xor(ss, 32);
    if (hh == 0) *ssq = ss;
}

constexpr int KTB = 64 * KS, VTB = 64 * VS, BUFB = KTB + VTB;
__device__ __forceinline__ void mla_unit(const unsigned char* ws, LAS unsigned char* lds, int b, int h, int qblk, int tid, int wave, int lane) {
    const bf16* QN = (const bf16*)(ws + WS_QN); const bf16* QPE = (const bf16*)(ws + WS_QPE);
    bf16* O = (bf16*)(ws + WS_A); float* SSQO = (float*)(ws + WS_SSQO);
    const int r32 = lane & 31, hh = lane >> 5;
    const size_t tok0 = (size_t)b * SEQ;
    const int row_lo = qblk * 256 + wave * 32, qrow = row_lo + r32;
    bf16x8 qf[12];
    { const bf16* qn = QN + (tok0 + qrow) * 1024 + h * 128 + 8 * hh;
#pragma unroll
      for (int s = 0; s < 8; ++s) qf[s] = *(const bf16x8*)(qn + 16 * s);
      const bf16* qp = QPE + (tok0 + qrow) * 512 + h * 64 + 8 * hh;
#pragma unroll
      for (int s = 0; s < 4; ++s) qf[8 + s] = *(const bf16x8*)(qp + 16 * s); }
    const int c0 = tid, c1 = tid + 512;
    const unsigned okn0 = (unsigned)WS_KN + (unsigned)(((unsigned)tok0 + (c0 >> 4)) * 1024u + h * 128 + (c0 & 15) * 8) * 2u, okn1 = okn0 + 32u * 1024u * 2u;
    const unsigned okp = (unsigned)WS_KPE + (unsigned)(((unsigned)tok0 + (tid >> 3)) * 64u + (tid & 7) * 8) * 2u;
    const unsigned ov0 = okn0 + (unsigned)(WS_VM - WS_KN), ov1 = ov0 + 32u * 1024u * 2u;
    const int lkn0 = (c0 >> 4) * KS + (c0 & 15) * 16, lkn1 = (c1 >> 4) * KS + (c1 & 15) * 16, lkp = (tid >> 3) * KS + 256 + (tid & 7) * 16;
    const int lv0 = KTB + (c0 >> 4) * VS + (c0 & 15) * 16, lv1 = KTB + (c1 >> 4) * VS + (c1 & 15) * 16;
    v4u st0, st1, st2, st3, st4;
#define MLA_GLOAD(kt) do { const unsigned _o = (unsigned)(kt) * 131072u, _p = (unsigned)(kt) * 8192u; st0 = *(const v4u*)(ws + (size_t)(okn0 + _o)); st1 = *(const v4u*)(ws + (size_t)(okn1 + _o)); \
        st2 = *(const v4u*)(ws + (size_t)(okp + _p)); st3 = *(const v4u*)(ws + (size_t)(ov0 + _o)); st4 = *(const v4u*)(ws + (size_t)(ov1 + _o)); } while (0)
#define MLA_LWRITE(buf) do { LAS unsigned char* _b = lds + (buf) * BUFB; *(LAS v4u*)(_b + lkn0) = st0; *(LAS v4u*)(_b + lkn1) = st1; *(LAS v4u*)(_b + lkp) = st2; \
        *(LAS v4u*)(_b + lv0) = st3; *(LAS v4u*)(_b + lv1) = st4; } while (0)
    const int nkt = 4 * (qblk + 1);
    MLA_GLOAD(0); MLA_LWRITE(0);
    __syncthreads();
    f32x16 o[4];
#pragma unroll
    for (int d = 0; d < 4; ++d)
#pragma unroll
        for (int r = 0; r < 16; ++r) o[d][r] = 0.f;
    float m = NEG, l = 0.f;
    const int kread = r32 * KS + 16 * hh;
    const int vread = KTB + (4 * hh + ((lane & 15) >> 2)) * VS + (16 * ((lane >> 4) & 1) + 4 * (lane & 3)) * 2;
    for (int kt = 0; kt < nkt; ++kt) {
        if (kt + 1 < nkt) MLA_GLOAD(kt + 1);
        const int k0 = kt * 64;
        if (k0 <= row_lo + 31) {
            const LAS unsigned char* kb = lds + (kt & 1) * BUFB;
            const bool diag = (k0 + 63 > row_lo);
#pragma unroll
            for (int sub = 0; sub < 2; ++sub) {
                if (sub == 1 && k0 + 32 > row_lo + 31) break;
                f32x16 s[1];
#pragma unroll
                for (int r = 0; r < 16; ++r) s[0][r] = 0.f;
#pragma unroll
                for (int ks = 0; ks < 12; ++ks) { const bf16x8 kf = *(const LAS bf16x8*)(kb + kread + sub * 32 * KS + 32 * ks); s[0] = MFMA32(kf, qf[ks], s[0]); }
                if (diag) {
#pragma unroll
                    for (int r = 0; r < 16; ++r) { const int key = k0 + 32 * sub + crow(r, hh); if (key > qrow) s[0][r] = NEG; }
                }
                bf16x8 pb[2];
                softmax_step<1>(s, m, l, o, pb);
                pv32(o, kb + vread + sub * 32 * VS, pb[0], pb[1]);
            }
        }
        if (kt + 1 < nkt) MLA_LWRITE((kt + 1) & 1);
        __syncthreads();
    }
#undef MLA_GLOAD
#undef MLA_LWRITE
    store_o(o, l, O + (tok0 + qrow) * 2048 + 1024 + h * 128, SSQO + (tok0 + qrow) * 16 + 8 + h, hh);
}

constexpr int DKS = 272, DSH = 32 * DKS + 32 * VS;
__device__ __forceinline__ void dil_tile(const unsigned char* ws, LAS unsigned char* vl  , LAS unsigned char* sh  , int b, int h, int j, int r16, int tid, int lane) {
    const bf16* QKV = (const bf16*)(ws + WS_B);
    const int r32 = lane & 31, hh = lane >> 5;
    const size_t tok0 = (size_t)b * SEQ;
    const int tq = 512 * j + 16 * r32 + r16;
    bf16x8 qf[8];
    { const bf16* qp = QKV + (tok0 + tq) * 3072 + h * 128 + 8 * hh;
#pragma unroll
      for (int s = 0; s < 8; ++s) qf[s] = *(const bf16x8*)(qp + 16 * s); }
    const float slope2 = __builtin_amdgcn_exp2f(-(float)(h + 1)) * LOG2E;
    const int m0 = (j == 0) ? 4 : 0, n3 = j + 1, n2 = 8 - m0, n1 = 20 - m0, nt = n3 + n2;
    const unsigned vcol = (unsigned)WS_B + ((unsigned)tok0 * 3072u + 2048u + h * 128 + (lane & 15) * 8) * 2u;
    const int vrow = lane >> 4;
    const int vwr = vrow * VS + (lane & 15) * 16;
    const int vread = (4 * hh + ((lane & 15) >> 2)) * VS + (16 * ((lane >> 4) & 1) + 4 * (lane & 3)) * 2;
    int kbase, kstride, maxd;
#define DIL_DESC(idx) do { const int _i = (idx); if (_i < n3) { kbase = 512 * (j - _i) + r16; kstride = 16; maxd = 2048; } \
        else if (_i < n3 + n2) { kbase = 4 * (128 * j - 128 + 32 * (m0 + _i - n3)) + (r16 & 3); kstride = 4; maxd = 512; } \
        else { kbase = 512 * j - 128 + 32 * (m0 + _i - n3 - n2); kstride = 1; maxd = 128; } } while (0)
    v4u kq[8], vq[8];
    const unsigned kcc = (unsigned)WS_B + ((unsigned)tok0 * 3072u + 1024u + h * 128 + (lane & 15) * 8) * 2u;
    const int kwr = vrow * DKS + (lane & 15) * 16, kfr = r32 * DKS + 16 * hh;
    DIL_DESC(0);
#pragma unroll
    for (int i = 0; i < 8; ++i) { const unsigned ro = (unsigned)(kbase + kstride * (4 * i + vrow)) * 6144u; kq[i] = *(const v4u*)(ws + (size_t)(kcc + ro)); vq[i] = *(const v4u*)(ws + (size_t)(vcol + ro)); }
    f32x16 o[4];
#pragma unroll
    for (int d = 0; d < 4; ++d)
#pragma unroll
        for (int r = 0; r < 16; ++r) o[d][r] = 0.f;
    float m = NEG, l = 0.f;
    for (int idx = 0; idx < nt; ++idx) {
        const int cb = kbase, cs = kstride, cm = maxd;
        const bool more = idx + 1 < nt;
#pragma unroll
        for (int i = 0; i < 8; ++i) *(LAS v4u*)(vl + kwr + 4 * i * DKS) = kq[i];
        if (more) { DIL_DESC(idx + 1);
#pragma unroll
            for (int i = 0; i < 8; ++i) kq[i] = *(const v4u*)(ws + (size_t)(kcc + (unsigned)(kbase + kstride * (4 * i + vrow)) * 6144u)); }
        f32x16 s[1];
#pragma unroll
        for (int r = 0; r < 16; ++r) s[0][r] = 0.f;
#pragma unroll
        for (int ks = 0; ks < 8; ++ks) { const bf16x8 kf = *(const LAS bf16x8*)(vl + kfr + 32 * ks); s[0] = MFMA32(kf, qf[ks], s[0]); }
#pragma unroll
        for (int i = 0; i < 8; ++i) *(LAS v4u*)(vl + vwr + 4 * i * VS) = vq[i];
        if (more) {
#pragma unroll
            for (int i = 0; i < 8; ++i) vq[i] = *(const v4u*)(ws + (size_t)(vcol + (unsigned)(kbase + kstride * (4 * i + vrow)) * 6144u)); }
        const int d0 = tq - cb - cs * 4 * hh;
#pragma unroll
        for (int r = 0; r < 16; ++r) { const int dist = d0 - cs * ((r & 3) + 8 * (r >> 2)); const float v = s[0][r] - slope2 * (float)dist; s[0][r] = ((unsigned)dist <= (unsigned)cm) ? v : NEG; }
        bf16x8 pb[2];
        softmax_step<1>(s, m, l, o, pb);
        pv32(o, vl + vread, pb[0], pb[1]);
    }
#undef DIL_DESC
    {
        const int kb0 = 512 * j - 128 + 32 * m0;
        const int row = tid >> 4, ch = tid & 15;
        const unsigned gk = (unsigned)WS_B + (((unsigned)tok0 + kb0 + row) * 3072u + 1024u + h * 128 + ch * 8) * 2u;
        const int lk = row * DKS + ch * 16, lv = 32 * DKS + row * VS + ch * 16;
        const int kread = r32 * DKS + 16 * hh;
        const int vread1 = 32 * DKS + (4 * hh + ((lane & 15) >> 2)) * VS + (16 * ((lane >> 4) & 1) + 4 * (lane & 3)) * 2;
        v4u sk = *(const v4u*)(ws + (size_t)gk), sv = *(const v4u*)(ws + (size_t)(gk + 2048u));
        *(LAS v4u*)(sh + lk) = sk; *(LAS v4u*)(sh + lv) = sv;
        __syncthreads();
        for (int mi = 0; mi < n1; ++mi) {
            const bool more = mi + 1 < n1;
            if (more) { const unsigned g2 = gk + (unsigned)(mi + 1) * 32u * 6144u; sk = *(const v4u*)(ws + (size_t)g2); sv = *(const v4u*)(ws + (size_t)(g2 + 2048u)); }
            const LAS unsigned char* tb = sh + (mi & 1) * DSH;
            f32x16 s[1];
#pragma unroll
            for (int r = 0; r < 16; ++r) s[0][r] = 0.f;
#pragma unroll
            for (int ks = 0; ks < 8; ++ks) { const bf16x8 kf = *(const LAS bf16x8*)(tb + kread + 32 * ks); s[0] = MFMA32(kf, qf[ks], s[0]); }
            const int d0 = tq - (kb0 + 32 * mi) - 4 * hh;
#pragma unroll
            for (int r = 0; r < 16; ++r) { const int dist = d0 - ((r & 3) + 8 * (r >> 2)); const float v = s[0][r] - slope2 * (float)dist; s[0][r] = ((unsigned)dist <= 128u) ? v : NEG; }
            bf16x8 pb[2];
            softmax_step<1>(s, m, l, o, pb);
            pv32(o, tb + vread1, pb[0], pb[1]);
            if (more) { LAS unsigned char* nb = sh + ((mi + 1) & 1) * DSH; *(LAS v4u*)(nb + lk) = sk; *(LAS v4u*)(nb + lv) = sv; }
            __syncthreads();
        }
    }
    store_o(o, l, (bf16*)(const_cast<unsigned char*>(ws) + WS_A) + (tok0 + tq) * 2048 + h * 128, (float*)(const_cast<unsigned char*>(ws) + WS_SSQO) + (tok0 + tq) * 16 + h, hh);
}

__device__ __forceinline__ void phase_attn(const Params& P, LAS unsigned char* lds, int vcu, int G, int wave) {
    const int lane = hw_lane(), tid = wave * 64 + lane;
    const unsigned char* ws = P.ws;
#ifndef REP_MLA
#define REP_MLA 1
#endif
#ifndef REP_DIL
#define REP_DIL 1
#endif
    for (int rm_ = 0; rm_ < REP_MLA; ++rm_)
    for (int u = vcu; u < 256; u += G) { const int bh = u >> 2, pr = u & 3;
        mla_unit(ws, lds, bh >> 3, bh & 7, 7 - pr, tid, wave, lane);
        mla_unit(ws, lds, bh >> 3, bh & 7, pr, tid, wave, lane); }
    __syncthreads();
    LAS unsigned char* vl = lds + wave * (32 * VS); LAS unsigned char* sh = lds + NWAVES * (32 * VS);
    for (int rd_ = 0; rd_ < REP_DIL; ++rd_)
    if (G == 256) {
#pragma unroll 1
        for (int k = 0; k < 2; ++k) { const int t = (vcu >> 5) * 512 + k * 256 + (vcu & 31) * 8 + wave; const int bh = t >> 6, rem = t & 63, jj = rem >> 4, r16 = rem & 15;
            dil_tile(ws, vl, sh, bh >> 3, bh & 7, k == 0 ? jj : 3 - jj, r16, tid, lane); }
    } else {
#pragma unroll 1
        for (int t = vcu * 8 + wave; t < 4096; t += G * 8) { const int bh = t >> 6, rem = t & 63; dil_tile(ws, vl, sh, bh >> 3, bh & 7, rem >> 4, rem & 15, tid, lane); }
    }
}
}
namespace peer {
typedef __bf16 bf2_t __attribute__((ext_vector_type(2)));
#define MFMA32(a, b, c) __builtin_amdgcn_mfma_f32_32x32x16_bf16((a), (b), (c), 0, 0, 0)
__device__ __forceinline__ float fmax3(float a, float b, float c) { return fmaxf(fmaxf(a, b), c); }
__device__ __forceinline__ float asf(unsigned u) { return __builtin_bit_cast(float, u); }
__device__ __forceinline__ unsigned asu(float f) { return __builtin_bit_cast(unsigned, f); }

__device__ __forceinline__ void ce_desc(float& a, float& b) { const float hi = fmaxf(a, b), lo = fminf(a, b); a = hi; b = lo; }
template <bool DESC> __device__ __forceinline__ void bitonic_merge16(float (&t)[16]) {
#pragma unroll
    for (int j = 8; j > 0; j >>= 1)
#pragma unroll
        for (int i = 0; i < 16; ++i) { const int l = i ^ j; if (l > i) { if (DESC) ce_desc(t[i], t[l]); else ce_desc(t[l], t[i]); } }
}
__device__ __forceinline__ void top16_of_64(float (&v)[64], float (&out)[16]) {
#pragma unroll
    for (int k = 2; k <= 16; k <<= 1)
#pragma unroll
        for (int j = k >> 1; j > 0; j >>= 1)
#pragma unroll
            for (int i = 0; i < 64; ++i) { const int l = i ^ j; if (l > i) { if ((i & k) == 0) ce_desc(v[i], v[l]); else ce_desc(v[l], v[i]); } }
    float t0[16], t1[16];
#pragma unroll
    for (int i = 0; i < 16; ++i) { t0[i] = fmaxf(v[i], v[16 + i]); t1[i] = fmaxf(v[32 + i], v[48 + i]); }
    bitonic_merge16<true>(t0); bitonic_merge16<false>(t1);
#pragma unroll
    for (int i = 0; i < 16; ++i) out[i] = fmaxf(t0[i], t1[i]);
    bitonic_merge16<true>(out);
}
__device__ __forceinline__ void route_item(const unsigned char* ws, LAS unsigned* sc, int tile, int h, int lane) {
    const bf16* QP = (const bf16*)(ws + WS_QP); const bf16* SK = (const bf16*)(ws + WS_SK);
    int* RIDX = (int*)(ws + WS_RIDX); float* RGATE = (float*)(ws + WS_RGATE);
    const int r32 = lane & 31, hh = lane >> 5;
    const size_t tok = (size_t)tile * 32 + r32;
    float rs2; { const f32x4* sp = (const f32x4*)((const float*)(ws + WS_SSQH) + tok * 32); f32x4 a = sp[0];
#pragma unroll
        for (int i = 1; i < 8; ++i) a = a + sp[i];
        rs2 = rsqrtf(((a[0] + a[1]) + (a[2] + a[3])) * (1.f / 2048.f) + EPS); }
#pragma unroll 1
    for (int p = 0; p < 2; ++p) {
        f32x16 s[4];
#pragma unroll
        for (int kb = 0; kb < 4; ++kb)
#pragma unroll
            for (int r = 0; r < 16; ++r) s[kb][r] = 0.f;
        const bf16* qp = QP + tok * 2048 + h * 256 + p * 128 + 8 * hh;
        const bf16* kp = SK + ((size_t)(h * 2 + p) * 128 + r32) * 128 + 8 * hh;
#pragma unroll
        for (int ks = 0; ks < 8; ++ks) { const bf16x8 q = *(const bf16x8*)(qp + 16 * ks);
#pragma unroll
            for (int kb = 0; kb < 4; ++kb) { const bf16x8 k = *(const bf16x8*)(kp + (size_t)kb * 32 * 128 + 16 * ks); s[kb] = MFMA32(k, q, s[kb]); } }
#pragma unroll
        for (int kb = 0; kb < 4; ++kb)
#pragma unroll
            for (int r = 0; r < 16; ++r) s[kb][r] = asf((asu(s[kb][r] * rs2) & ~127u) | (unsigned)(32 * kb + (r & 3) + 8 * (r >> 2) + 4 * hh));
        {
            float v[64], u[16];
#pragma unroll
            for (int kb = 0; kb < 4; ++kb)
#pragma unroll
                for (int r = 0; r < 16; ++r) v[16 * kb + r] = s[kb][r];
            top16_of_64(v, u);
            float w[16];
#pragma unroll
            for (int i = 0; i < 16; ++i) w[i] = fmaxf(u[i], __shfl_xor(u[15 - i], 32));
            bitonic_merge16<true>(w);
            if (hh == 0) {
#pragma unroll
                for (int i = 0; i < 16; i += 4) *(LAS v4u*)(sc + (p * 32 + r32) * 16 + i) = (v4u){asu(w[i]), asu(w[i + 1]), asu(w[i + 2]), asu(w[i + 3])};
            }
        }
    }
    unsigned t1[16], t2[16];
#pragma unroll
    for (int i = 0; i < 16; i += 4) { const v4u a = *(const LAS v4u*)(sc + r32 * 16 + i), b = *(const LAS v4u*)(sc + (32 + r32) * 16 + i);
        t1[i] = a.x; t1[i + 1] = a.y; t1[i + 2] = a.z; t1[i + 3] = a.w; t2[i] = b.x; t2[i + 1] = b.y; t2[i + 2] = b.z; t2[i + 3] = b.w; }
    float c[64]; int n = 0;
#pragma unroll
    for (int i = 0; i < 16; ++i)
#pragma unroll
        for (int j = 0; j < 16; ++j) if ((i + 1) * (j + 1) <= 16) { const float v = asf(t1[i] & ~127u) + asf(t2[j] & ~127u); c[n] = asf((asu(v) & ~255u) | (unsigned)(i * 16 + j)); ++n; }
#pragma unroll
    for (int q = 50; q < 64; ++q) c[q] = -3.0e38f;
    float top[16];
    top16_of_64(c, top);
    float best[8]; const float bmax = asf(asu(top[0]) & ~255u); float esum = 0.f;
#pragma unroll
    for (int k = 0; k < 16; ++k) { esum += __expf(asf(asu(top[k]) & ~255u) - bmax); if ((k >> 3) == hh) best[k & 7] = top[k]; }
    const float inv = 1.0f / esum;
    int idx[8]; float gate[8];
#pragma unroll
    for (int k = 0; k < 8; ++k) { const unsigned code = asu(best[k]) & 255u; const unsigned a = sc[r32 * 16 + (code >> 4)], b = sc[(32 + r32) * 16 + (code & 15)];
        idx[k] = (int)((a & 127u) * 128u + (b & 127u)); gate[k] = __expf(asf(asu(best[k]) & ~255u) - bmax) * inv; }
    int* ip = RIDX + tok * 128 + h * 16 + 8 * hh; float* gp = RGATE + tok * 128 + h * 16 + 8 * hh;
    *(v4u*)ip = (v4u){(unsigned)idx[0], (unsigned)idx[1], (unsigned)idx[2], (unsigned)idx[3]}; *(v4u*)(ip + 4) = (v4u){(unsigned)idx[4], (unsigned)idx[5], (unsigned)idx[6], (unsigned)idx[7]};
    *(f32x4*)gp = (f32x4){gate[0], gate[1], gate[2], gate[3]}; *(f32x4*)(gp + 4) = (f32x4){gate[4], gate[5], gate[6], gate[7]};
}

__device__ __forceinline__ void phase_route(const Params& P, LAS unsigned char* lds, int vcu, int G, int wave) {
    const int lane = hw_lane();
    LAS unsigned* sc = (LAS unsigned*)(lds + wave * 4096);
#pragma unroll 1
    for (int it = vcu * NWAVES + wave; it < 512 * 8; it += G * NWAVES) route_item(P.ws, sc, it >> 3, it & 7, lane);
}

__device__ __forceinline__ float dot16_f8(const float (&x)[16], const v4u& u, float c) {
    const int u0 = (int)u.x, u1 = (int)u.y, u2 = (int)u.z, u3 = (int)u.w;
    const f32x2 a0 = __builtin_amdgcn_cvt_pk_f32_fp8(u0, false), a1 = __builtin_amdgcn_cvt_pk_f32_fp8(u0, true);
    const f32x2 a2 = __builtin_amdgcn_cvt_pk_f32_fp8(u1, false), a3 = __builtin_amdgcn_cvt_pk_f32_fp8(u1, true);
    const f32x2 a4 = __builtin_amdgcn_cvt_pk_f32_fp8(u2, false), a5 = __builtin_amdgcn_cvt_pk_f32_fp8(u2, true);
    const f32x2 a6 = __builtin_amdgcn_cvt_pk_f32_fp8(u3, false), a7 = __builtin_amdgcn_cvt_pk_f32_fp8(u3, true);
    c = fmaf(x[0], a0.x, c); c = fmaf(x[1], a0.y, c); c = fmaf(x[2], a1.x, c); c = fmaf(x[3], a1.y, c);
    c = fmaf(x[4], a2.x, c); c = fmaf(x[5], a2.y, c); c = fmaf(x[6], a3.x, c); c = fmaf(x[7], a3.y, c);
    c = fmaf(x[8], a4.x, c); c = fmaf(x[9], a4.y, c); c = fmaf(x[10], a5.x, c); c = fmaf(x[11], a5.y, c);
    c = fmaf(x[12], a6.x, c); c = fmaf(x[13], a6.y, c); c = fmaf(x[14], a7.x, c); c = fmaf(x[15], a7.y, c);
    return c;
}
__device__ __forceinline__ void unpack8(float* x, const v4u& v) { x[0] = bflo(v.x); x[1] = bfhi(v.x); x[2] = bflo(v.y); x[3] = bfhi(v.y); x[4] = bflo(v.z); x[5] = bfhi(v.z); x[6] = bflo(v.w); x[7] = bfhi(v.w); }
#ifndef U_WAVES
#define U_WAVES 8
#endif
__device__ __forceinline__ void peer_u_wave(const Params& P, LAS unsigned* sc  , int t0, int tstep, int tend, int lane) {
    const unsigned char* ws = P.ws;
    const bf16* H1B = (const bf16*)(ws + WS_B); const unsigned char* U8 = ws + WS_UB;
    const int* RIDX = (const int*)(ws + WS_RIDX); const float* RGATE = (const float*)(ws + WS_RGATE); const float* SSQH = (const float*)(ws + WS_SSQH);
    const unsigned long long ltmask = (1ull << lane) - 1ull;
    unsigned* PKV = (unsigned*)(ws + WS_PKV);
    if (t0 >= tend) return;
    int i0, i1; float g0, g1, rs2; float x[32];
    int i0n, i1n; float g0n, g1n, ssn; v4u xa, xb, xc, xd;
#define PU_META(t) do { const size_t _t = (size_t)(t); const bf16* hp = H1B + _t * 2048 + 32 * lane; xa = *(const v4u*)hp; xb = *(const v4u*)(hp + 8); xc = *(const v4u*)(hp + 16); xd = *(const v4u*)(hp + 24); \
        ssn = lane < 32 ? SSQH[_t * 32 + lane] : 0.f; i0n = RIDX[_t * 128 + lane]; i1n = RIDX[_t * 128 + 64 + lane]; g0n = RGATE[_t * 128 + lane]; g1n = RGATE[_t * 128 + 64 + lane]; } while (0)
#define PU_SORT() do {   \
        { const int q0 = i0n >> 10, q1 = i1n >> 10; int off = 0, pos0 = 0, pos1 = 0; \
          _Pragma("unroll") for (int gq = 0; gq < 16; ++gq) { const unsigned long long m0 = __ballot(q0 == gq), m1 = __ballot(q1 == gq); const int c0 = __popcll(m0), c1 = __popcll(m1); \
              if (q0 == gq) pos0 = off + __popcll(m0 & ltmask); if (q1 == gq) pos1 = off + c0 + __popcll(m1 & ltmask); off += c0 + c1; } \
          sc[pos0] = (unsigned)i0n; sc[pos1] = (unsigned)i1n; sc[128 + pos0] = asu(g0n); sc[128 + pos1] = asu(g1n); \
          i0n = (int)sc[lane]; i1n = (int)sc[64 + lane]; g0n = asf(sc[128 + lane]); g1n = asf(sc[192 + lane]); } } while (0)
#define PU_SWAP() do { i0 = i0n; i1 = i1n; g0 = g0n; g1 = g1n; \
        unpack8(x, xa); unpack8(x + 8, xb); unpack8(x + 16, xc); unpack8(x + 24, xd); \
        rs2 = rsqrtf(wave_sum(ssn) * (1.f / 2048.f) + EPS) * (1.f / U6_SCALE); } while (0)
#define PU_LOAD(buf4, buf2, ia, ib, g) do { _Pragma("unroll") for (int e = 0; e < 8; ++e) { const int row = __builtin_amdgcn_readlane((g) < 8 ? ia : ib, ((g) & 7) * 8 + e); \
        const unsigned char* up = U8 + (size_t)row * 1536 + 16 * lane; buf4[e] = *(const v4u*)up; buf2[e] = *(const v2u*)(up + 1024 - 8 * lane); } } while (0)
#define PU_COMPUTE(buf4, buf2, g) do { float pt[8]; _Pragma("unroll") for (int e = 0; e < 8; ++e) { \
            const f32x32 r = __builtin_amdgcn_cvt_scalef32_pk32_f32_fp6((v6u){buf4[e].x, buf4[e].y, buf4[e].z, buf4[e].w, buf2[e].x, buf2[e].y}, 1.0f); \
            float s0 = 0.f, s1 = 0.f; _Pragma("unroll") for (int k = 0; k < 16; ++k) { s0 = fmaf(x[k], r[2 * k], s0); s1 = fmaf(x[16 + k], r[2 * k + 1], s1); } pt[e] = s0 + s1; }     \
        float a4[4], a2[2], a1; \
        _Pragma("unroll") for (int i = 0; i < 4; ++i) { const float keep = (lane & 1) ? pt[2 * i + 1] : pt[2 * i], give = (lane & 1) ? pt[2 * i] : pt[2 * i + 1]; a4[i] = keep + __shfl_xor(give, 1); } \
        _Pragma("unroll") for (int i = 0; i < 2; ++i) { const float keep = (lane & 2) ? a4[2 * i + 1] : a4[2 * i], give = (lane & 2) ? a4[2 * i] : a4[2 * i + 1]; a2[i] = keep + __shfl_xor(give, 2); } \
        { const float keep = (lane & 4) ? a2[1] : a2[0], give = (lane & 4) ? a2[0] : a2[1]; a1 = keep + __shfl_xor(give, 4); } \
        a1 += __shfl_xor(a1, 8); a1 += __shfl_xor(a1, 16); a1 += __shfl_xor(a1, 32); \
        if ((lane >> 3) == ((g) & 7)) { if ((g) < 8) d0 = a1; else d1 = a1; } } while (0)
    v4u ra4[8], rb4[8]; v2u ra2[8], rb2[8];
    PU_META(t0); PU_SORT(); PU_SWAP();
    PU_LOAD(ra4, ra2, i0, i1, 0);
#pragma unroll 1
    for (int t = t0; t < tend; t += tstep) {
        const bool more = t + tstep < tend;
        float d0 = 0.f, d1 = 0.f;
#pragma unroll 1
        for (int g = 0; g < 16; g += 2) {
            PU_LOAD(rb4, rb2, i0, i1, g + 1);
            if (g == 10 && more) PU_META(t + tstep);
            PU_COMPUTE(ra4, ra2, g);
            if (g + 2 < 16) PU_LOAD(ra4, ra2, i0, i1, g + 2); else if (more) { PU_SORT(); PU_LOAD(ra4, ra2, i0n, i1n, 0); }
            PU_COMPUTE(rb4, rb2, g + 1);
        }
        const size_t tok = (size_t)t;
        const float z0 = d0 * rs2, z1 = d1 * rs2;
        const float a0 = 8.0f * z0 * (1.0f + erff(z0 * 0.7071067811865476f)) * g0, a1v = 8.0f * z1 * (1.0f + erff(z1 * 0.7071067811865476f)) * g1;
        unsigned* pk = PKV + ((tok >> 6) * 128) * 64 + (tok & 63) * 4;
        pk[(size_t)(lane >> 2) * 256 + (lane & 3)] = ((unsigned)i0 << 2) | ((unsigned)__builtin_bit_cast(unsigned short, (_Float16)a0) << 16);
        pk[(size_t)(16 + (lane >> 2)) * 256 + (lane & 3)] = ((unsigned)i1 << 2) | ((unsigned)__builtin_bit_cast(unsigned short, (_Float16)a1v) << 16);
        if (more) PU_SWAP();
    }
#undef PU_META
#undef PU_SORT
#undef PU_SWAP
#undef PU_LOAD
#undef PU_COMPUTE
}
__device__ __forceinline__ void phase_peer_u(const Params& P, LAS unsigned char* lds, int vcu, int G, int wave) {
    const int lane = hw_lane();
    if (wave >= U_WAVES) return;
    peer_u_wave(P, (LAS unsigned*)(lds + wave * 1024), vcu * U_WAVES + wave, G * U_WAVES, M, lane);
}
typedef _Float16 h2_t __attribute__((ext_vector_type(2)));
__device__ __forceinline__ void peer_v_range(const Params& P, int c, int b0, int b1, int wv, int nwv, int lane) {
    const unsigned char* ws = P.ws;
    const bf16* H1B = (const bf16*)(ws + WS_B); const unsigned* PKV = (const unsigned*)(ws + WS_PKV);
    if (b0 + wv >= b1) return;
    unsigned w0[16], w1[16], w2[16], w3[16];
#define PV_LOAD(buf) do { _Pragma("unroll") for (int q = 0; q < 4; ++q) { const v4u t4 = pl[q * 64]; buf[4 * q] = t4.x; buf[4 * q + 1] = t4.y; buf[4 * q + 2] = t4.z; buf[4 * q + 3] = t4.w; } pl += 4 * 64; asm volatile("" : "+v"(pl)); } while (0)
#define PV_PROC(buf) do { v2u vv[16]; _Pragma("unroll") for (int i = 0; i < 16; ++i) vv[i] = *(const LAS v2u*)(size_t)((buf[i] << 1) & 0x1fff8u);     \
        _Pragma("unroll") for (int i = 0; i < 16; ++i) { const _Float16 ah = __builtin_bit_cast(_Float16, (unsigned short)(buf[i] >> 16)); const h2_t a2 = {ah, ah}; \
            y0 = __builtin_elementwise_fma(a2, __builtin_bit_cast(h2_t, __builtin_amdgcn_cvt_scalef32_pk_f16_fp8(vv[i].x, 1.0f, false)), y0); \
            y1 = __builtin_elementwise_fma(a2, __builtin_bit_cast(h2_t, __builtin_amdgcn_cvt_scalef32_pk_f16_fp8(vv[i].x, 1.0f, true)), y1); \
            y2 = __builtin_elementwise_fma(a2, __builtin_bit_cast(h2_t, __builtin_amdgcn_cvt_scalef32_pk_f16_fp8(vv[i].y, 1.0f, false)), y2); \
            y3 = __builtin_elementwise_fma(a2, __builtin_bit_cast(h2_t, __builtin_amdgcn_cvt_scalef32_pk_f16_fp8(vv[i].y, 1.0f, true)), y3); } } while (0)
    const v4u* pl = (const v4u*)PKV + (size_t)(b0 + wv) * 32 * 64 + lane;
    PV_LOAD(w0); PV_LOAD(w1); PV_LOAD(w2);
    v4u hxn = *(const v4u*)(H1B + ((size_t)(b0 + wv) * 64 + lane) * 2048 + 8 * c);
#pragma unroll 1
    for (int b = b0 + wv; b < b1; b += nwv) {
        const size_t tok = (size_t)b * 64 + lane;
        const int bn = (b + nwv < b1) ? b + nwv : b;
        h2_t y0 = {0, 0}, y1 = {0, 0}, y2 = {0, 0}, y3 = {0, 0};
        v4u hx = hxn;
#pragma unroll 1
        for (int half = 0; half < 2; ++half) {
            PV_LOAD(w3); PV_PROC(w0);
            if (half == 1) { hxn = *(const v4u*)(H1B + ((size_t)bn * 64 + lane) * 2048 + 8 * c); pl += (ptrdiff_t)(bn - b - 1) * 32 * 64; }
            PV_LOAD(w0); PV_PROC(w1);
            PV_LOAD(w1); PV_PROC(w2);
            PV_LOAD(w2); PV_PROC(w3);
        }
        float y[8]; unpack8(y, hx);
        constexpr float S = 1.0f / 32.0f;
        y[0] += S * (float)y0[0]; y[1] += S * (float)y0[1]; y[2] += S * (float)y1[0]; y[3] += S * (float)y1[1];
        y[4] += S * (float)y2[0]; y[5] += S * (float)y2[1]; y[6] += S * (float)y3[0]; y[7] += S * (float)y3[1];
        *(v4u*)((bf16*)(const_cast<unsigned char*>(ws) + WS_A) + tok * 2048 + 8 * c) = (v4u){pk2(y[0], y[1]), pk2(y[2], y[3]), pk2(y[4], y[5]), pk2(y[6], y[7])};
    }
#undef PV_LOAD
#undef PV_PROC
}
__device__ __forceinline__ void peer_v_fill(const Params& P, int c, int tid) {
    const v4u* src = (const v4u*)(P.ws + WS_VB + (size_t)c * 131072);
#pragma unroll 4
    for (int i = tid; i < 8192; i += NTHREADS) *(LAS v4u*)(size_t)(16 * i) = src[i];
}
__device__ __forceinline__ void phase_final(const Params& P, int vcu, int G, int wave) {
    const int lane = hw_lane();
    const bool poison = __hip_atomic_load((const unsigned*)(P.ws + WS_CTL) + CW_FLAG, __ATOMIC_RELAXED, __HIP_MEMORY_SCOPE_AGENT) != 0u;
    f32x4 gv[8];
#pragma unroll
    for (int j = 0; j < 8; ++j) gv[j] = ((const f32x4*)P.lnf)[lane + 64 * j];
#pragma unroll 1
    for (int t = vcu * NWAVES + wave; t < M; t += G * NWAVES) {
        const v2u* hrow = (const v2u*)((const bf16*)(P.ws + WS_A) + (size_t)t * 2048) + lane;
        f32x4* row = (f32x4*)(P.out + (size_t)t * 2048) + lane;
        f32x4 v[8]; float s = 0.f;
#pragma unroll
        for (int j = 0; j < 8; ++j) { const v2u h = hrow[64 * j]; v[j] = (f32x4){bflo(h.x), bfhi(h.x), bflo(h.y), bfhi(h.y)}; s += (v[j].x * v[j].x + v[j].y * v[j].y) + (v[j].z * v[j].z + v[j].w * v[j].w); }
        const float rs = poison ? __builtin_nanf("") : rsqrtf(wave_sum(s) * (1.f / 2048.f) + EPS);
#pragma unroll
        for (int j = 0; j < 8; ++j) row[64 * j] = v[j] * rs * gv[j];
    }
}
#undef MFMA32
}
#define XB_TMO      128
#define XB_XCNT(j)  (256  + 64 * (j))
#define XB_XSUB(j)  (1280 + 64 * (j))
#define XB_XGEN(j)  (2304 + 64 * (j))
#define XB_TOP      3328
#define XB_TOPGEN   3392
#define XCD_BAR_WORDS 3456
#define XB_SPIN_CAP (1u << 22)
__device__ __forceinline__ unsigned xb_ld(unsigned* p)              { return __hip_atomic_load(p, __ATOMIC_RELAXED, __HIP_MEMORY_SCOPE_AGENT); }
__device__ __forceinline__ unsigned xb_add(unsigned* p, unsigned v) { return __hip_atomic_fetch_add(p, v, __ATOMIC_RELAXED, __HIP_MEMORY_SCOPE_AGENT); }
__device__ __forceinline__ unsigned xb_xcc_id() { return (unsigned)__builtin_amdgcn_s_getreg((3 << 11) | 20) & 0xFu; }
#define XB_SPIN(cond, bar) do { unsigned _sp = 0; while (cond) { __builtin_amdgcn_s_sleep(1); \
    if ((++_sp & 255u) == 0u) { if (xb_ld(&(bar)[XB_TMO])) break; if (_sp > XB_SPIN_CAP) { atomicAdd(&(bar)[XB_TMO], 1u); break; } } } } while (0)
struct XcdBarrier { unsigned* bar; unsigned x; volatile LAS unsigned* st; };
__device__ __forceinline__ XcdBarrier xcd_barrier_post(unsigned* bar, volatile LAS unsigned* st, bool leader) {
    XcdBarrier b; b.bar = bar; b.x = xb_xcc_id(); b.st = st;
    if (leader) (void)xb_add(&bar[XB_XCNT(b.x)], 1u);
    return b;
}
__device__ __forceinline__ void xcd_barrier_complete(unsigned* bar, unsigned x, unsigned& nloc, unsigned& nx) {
    const unsigned G = gridDim.x * gridDim.y * gridDim.z;
    unsigned sum, cnt, mine, sp = 0u;
    for (;;) {
        sum = 0u; cnt = 0u; mine = 0u;
#pragma unroll
        for (unsigned j = 0; j < 16; ++j) { const unsigned c = xb_ld(&bar[XB_XCNT(j)]); sum += c; cnt += (c > 0u) ? 1u : 0u; mine = (j == x) ? c : mine; }
        if (sum == G) break;
        __builtin_amdgcn_s_sleep(1);
        if ((++sp & 255u) == 0u) { if (xb_ld(&bar[XB_TMO])) break; if (sp > XB_SPIN_CAP) { atomicAdd(&bar[XB_TMO], 1u); break; } }
    }
    nloc = mine > 0u ? mine : 1u; nx = cnt > 0u ? cnt : 1u;
}
__device__ __forceinline__ void xcd_barrier(const XcdBarrier& b, int wave) {
    asm volatile("s_waitcnt vmcnt(0)" ::: "memory");
    __syncthreads();
    if (wave == 0 && hw_lane() == 0) {
        unsigned* bar = b.bar;
        __builtin_amdgcn_s_waitcnt(0);
        unsigned nloc = b.st[0], nx = b.st[1];
        if (nloc == 0u) { xcd_barrier_complete(bar, b.x, nloc, nx); b.st[0] = nloc; b.st[1] = nx; }
        const unsigned old = xb_add(&bar[XB_XSUB(b.x)], 1u);
        const unsigned gen = old / nloc;
        if (old + 1u == (gen + 1u) * nloc) {
            __builtin_amdgcn_fence(__ATOMIC_RELEASE, "agent");
            asm volatile("s_waitcnt vmcnt(0)" ::: "memory");
            const unsigned og = xb_add(&bar[XB_TOP], 1u);
            const unsigned tg = og / nx;
            if (og + 1u == (tg + 1u) * nx) xb_add(&bar[XB_TOPGEN], 1u);
            else XB_SPIN(xb_ld(&bar[XB_TOPGEN]) == tg, bar);
            __builtin_amdgcn_fence(__ATOMIC_ACQUIRE, "agent");
            xb_add(&bar[XB_XGEN(b.x)], 1u);
            asm volatile("s_waitcnt vmcnt(0)" ::: "memory");
        } else {
            XB_SPIN(xb_ld(&bar[XB_XGEN(b.x)]) == gen, bar);
            __builtin_amdgcn_fence(__ATOMIC_ACQUIRE, "agent");
            asm volatile("s_waitcnt vmcnt(0)" ::: "memory");
        }
    }
    __syncthreads();
}
constexpr int N_PHASES = 10;
#ifndef REP_PHASE
#define REP_PHASE -1
#endif
#ifndef REP_N
#define REP_N 1
#endif
#ifndef EXTRA_SYNCS
#define EXTRA_SYNCS 0
#endif
__global__ void __launch_bounds__(NTHREADS, 2) mega(Params P) {
    extern __shared__ __attribute__((aligned(16))) unsigned char lds_raw[];
    LAS unsigned char* lds = (LAS unsigned char*)lds_raw;
    cg::grid_group grid = cg::this_grid();
    const int wave = __builtin_amdgcn_readfirstlane((int)threadIdx.x >> 6);
    const int G = gridDim.x, bx = blockIdx.x;
    const int vcu = (G % 8 == 0) ? (bx % 8) * (G / 8) + bx / 8 : bx;
    unsigned char* ws = P.ws;
    const int lo = P.ph_lo, hi = P.ph_hi;
#define IN(k) (lo <= (k) && (k) < hi)
#ifndef CG_SEAMS
#define CG_SEAMS 0
#endif
    volatile LAS unsigned* xbst = (volatile LAS unsigned*)(lds + MISC_OFF + 8192);
    if (wave == 0 && hw_lane() == 0) { xbst[0] = 0u; xbst[1] = 0u; xbst[2] = 0u; xbst[3] = 0u; }
    __syncthreads();
    if (bx == 0) {
        unsigned* ctl = (unsigned*)(ws + WS_CTL) + (wave * 64 + hw_lane());
#pragma unroll
        for (int j = 0; j < CTL_ZERO_BYTES / 4 / NTHREADS; ++j) __hip_atomic_store(ctl + j * NTHREADS, 0u, __ATOMIC_RELAXED, __HIP_MEMORY_SCOPE_AGENT);
        __threadfence();
    }
    grid.sync();
    const XcdBarrier xbar = xcd_barrier_post((unsigned*)(ws + WS_CTL) + 4096, xbst, wave == 0 && hw_lane() == 0);
#define GSYNC(k) do { if ((k) < CG_SEAMS) grid.sync(); else xcd_barrier(xbar, wave); } while (0)
#define SEAM(k) do { if (IN(k) && IN((k) + 1)) GSYNC(k); } while (0)

    for (int rep_ = 0; rep_ < (REP_PHASE == 0 ? 1 + REP_N : 1); ++rep_) if (IN(0)) { if (rep_) GSYNC(9); phase_prep(P, lds, vcu, G, wave, rep_ ? PREP_ONLY : -1); }
    SEAM(0);
    for (int es_ = 0; es_ < EXTRA_SYNCS; ++es_) GSYNC(9);
    for (int rep_ = 0; rep_ < (REP_PHASE == 1 ? 1 + REP_N : 1); ++rep_) if (IN(1)) { if (rep_) GSYNC(9);
        pg8::GemmSet g; g.A0 = g.A1 = (const bf16*)(ws + WS_A); g.Bt0 = g.Bt1 = (const bf16*)(ws + WS_BT1); g.K = 2048;
        pg8::StaticOrder S; S.init(M, 4096, 0, G, bx);
        pg8::Epi1 E{(bf16*)(ws + WS_B), (bf16*)(ws + WS_CQ), (bf16*)(ws + WS_CKV), (float*)(ws + WS_SSQCQ), (float*)(ws + WS_SSQCKV)};
        pg8::gemm_phase<pg8::Epi1, pg8::StaticOrder>(lds, g, S, E, wave);
    }
#ifdef EXTRA_G1
    if (IN(1)) { GSYNC(9);
        pg8::GemmSet g; g.A0 = g.A1 = (const bf16*)(ws + WS_A); g.Bt0 = g.Bt1 = (const bf16*)(ws + WS_BT1); g.K = 2048;
        pg8::ForcedOrder S; S.S.init(M, 4096, 0, G, bx); S.mmask = (EXTRA_G1 & 1) ? 0 : ~0; S.nmask = (EXTRA_G1 & 2) ? 0 : ~0;
        pg8::EpiNull E{}; pg8::gemm_phase<pg8::EpiNull, pg8::ForcedOrder>(lds, g, S, E, wave);
    }
#endif
    SEAM(1);
    for (int rep_ = 0; rep_ < (REP_PHASE == 2 ? 1 + REP_N : 1); ++rep_) if (IN(2)) { if (rep_) GSYNC(9);
        for (int it = bx; it < 256; it += G) kr_item64((const bf16*)(ws + WS_A), (const bf16*)(ws + WS_BTKR), (const f32x2*)(ws + WS_ROPE), (bf16*)(ws + WS_KPE), (LAS f32x4*)lds, it, wave, hw_lane());
        pg8::GemmSet g; g.A0 = (const bf16*)(ws + WS_CQ); g.A1 = (const bf16*)(ws + WS_CKV); g.Bt0 = (const bf16*)(ws + WS_BT2Q); g.Bt1 = (const bf16*)(ws + WS_BT2KV); g.K = 512;
        pg8::StaticOrder S; S.init(M, 1536, 2048, G, bx);
        pg8::Epi2 E{(bf16*)(ws + WS_QN), (bf16*)(ws + WS_QPE), (bf16*)(ws + WS_KN), (bf16*)(ws + WS_VM), (const float*)(ws + WS_SSQCQ), (const float*)(ws + WS_SSQCKV), (const f32x2*)(ws + WS_ROPE)};
        pg8::gemm_phase<pg8::Epi2, pg8::StaticOrder>(lds, g, S, E, wave);
    }
#ifdef EXTRA_G2
    if (IN(2)) { GSYNC(9);
        pg8::GemmSet g; g.A0 = (const bf16*)(ws + WS_CQ); g.A1 = (const bf16*)(ws + WS_CKV); g.Bt0 = (const bf16*)(ws + WS_BT2Q); g.Bt1 = (const bf16*)(ws + WS_BT2KV); g.K = 512;
        pg8::StaticOrder S; S.init(M, 1536, 2048, G, bx);
#if EXTRA_G2 == 1
        pg8::Epi2 E{(bf16*)(ws + WS_QN), (bf16*)(ws + WS_QPE), (bf16*)(ws + WS_KN), (bf16*)(ws + WS_VM), (const float*)(ws + WS_SSQCQ), (const float*)(ws + WS_SSQCKV), (const f32x2*)(ws + WS_ROPE)};
        pg8::gemm_phase<pg8::Epi2, pg8::StaticOrder>(lds, g, S, E, wave);
#else
        pg8::EpiNull E{}; pg8::gemm_phase<pg8::EpiNull, pg8::StaticOrder>(lds, g, S, E, wave);
#endif
    }
#endif
    SEAM(2);
    for (int rep_ = 0; rep_ < (REP_PHASE == 3 ? 1 + REP_N : 1); ++rep_) if (IN(3)) { if (rep_) GSYNC(9); att::phase_attn(P, lds, vcu, G, wave); }
    SEAM(3);
    for (int rep_ = 0; rep_ < (REP_PHASE == 4 ? 1 + REP_N : 1); ++rep_) if (IN(4)) { if (rep_) GSYNC(9);
        pg8::GemmSet g; g.A0 = g.A1 = (const bf16*)(ws + WS_A); g.Bt0 = g.Bt1 = (const bf16*)(ws + WS_BT3); g.K = 2048;
        pg8::StaticOrder S; S.init(M, 2048, 0, G, bx);
        pg8::Epi3 E{(bf16*)(ws + WS_B), P.x, (const float*)(ws + WS_SSQO), (float*)(ws + WS_SSQH), (LAS f32x2*)(lds + MISC_OFF)};
        pg8::gemm_phase<pg8::Epi3, pg8::StaticOrder>(lds, g, S, E, wave);
    }
    SEAM(4);
    for (int rep_ = 0; rep_ < (REP_PHASE == 5 ? 1 + REP_N : 1); ++rep_) if (IN(5)) { if (rep_) GSYNC(9);
        pg8::GemmSet g; g.A0 = g.A1 = (const bf16*)(ws + WS_B); g.Bt0 = g.Bt1 = (const bf16*)(ws + WS_BT4); g.K = 2048;
        pg8::StaticOrder S; S.init(M, 2048, 0, G, bx);
        pg8::Epi4 E{(bf16*)(ws + WS_QP)};
        pg8::gemm_phase<pg8::Epi4, pg8::StaticOrder>(lds, g, S, E, wave);
    }
#ifdef EXTRA_G4
    if (IN(5)) { GSYNC(9);
        pg8::GemmSet g; g.A0 = g.A1 = (const bf16*)(ws + WS_B); g.Bt0 = g.Bt1 = (const bf16*)(ws + WS_BT4); g.K = 2048;
        pg8::StaticOrder S; S.init(M, 2048, 0, G, bx);
#if EXTRA_G4 == 1
        pg8::Epi4 E{(bf16*)(ws + WS_QP)}; pg8::gemm_phase<pg8::Epi4, pg8::StaticOrder>(lds, g, S, E, wave);
#elif EXTRA_G4 == 3
        pg8::EpiSmall E{(bf16*)(ws + WS_A)}; pg8::gemm_phase<pg8::EpiSmall, pg8::StaticOrder>(lds, g, S, E, wave);
#else
        pg8::EpiNull E{}; pg8::gemm_phase<pg8::EpiNull, pg8::StaticOrder>(lds, g, S, E, wave);
#endif
    }
#endif
    SEAM(5);
    for (int rep_ = 0; rep_ < (REP_PHASE == 6 ? 1 + REP_N : 1); ++rep_) if (IN(6)) { if (rep_) GSYNC(9); peer::phase_route(P, lds, vcu, G, wave); }
    SEAM(6);
    for (int rep_ = 0; rep_ < (REP_PHASE == 7 ? 1 + REP_N : 1); ++rep_) if (IN(7)) { if (rep_) GSYNC(9); peer::phase_peer_u(P, lds, vcu, G, wave); }
    SEAM(7);
    for (int rep_ = 0; rep_ < (REP_PHASE == 8 ? 1 + REP_N : 1); ++rep_) if (IN(8)) { if (rep_) GSYNC(9);
        const int lane_ = hw_lane();
        for (int c = vcu; c < 256; c += G) { __syncthreads(); peer::peer_v_fill(P, c, wave * 64 + lane_); __syncthreads(); peer::peer_v_range(P, c, 0, 256, wave, NWAVES, lane_); }
    }
    SEAM(8);
    for (int rep_ = 0; rep_ < (REP_PHASE == 9 ? 1 + REP_N : 1); ++rep_) if (IN(9)) { if (rep_) GSYNC(9); peer::phase_final(P, vcu, G, wave); }
#undef IN
#undef SEAM
}

static int mega_grid() {
    static int grid = 0;
    if (grid == 0) {
        int dev = 0, cus = 0, per_cu = 0;
        (void)hipGetDevice(&dev); (void)hipDeviceGetAttribute(&cus, hipDeviceAttributeMultiprocessorCount, dev);
        (void)hipFuncSetAttribute((const void*)mega, hipFuncAttributeMaxDynamicSharedMemorySize, LDS_BYTES);
        (void)hipOccupancyMaxActiveBlocksPerMultiprocessor(&per_cu, (const void*)mega, NTHREADS, LDS_BYTES);
        if (per_cu < 1) { fprintf(stderr, "mega: occupancy query says %d blocks/CU\n", per_cu); per_cu = 1; }
        grid = cus;
        (void)hipGetLastError();
    }
    return grid;
}
static void fill_params(Params& P, void* const* d_in, void* d_out, void* d_ws) {
    P.x = (const float*)d_in[0]; P.ln1 = (const float*)d_in[1]; P.w_in = (const float*)d_in[2]; P.qan = (const float*)d_in[3]; P.kvan = (const float*)d_in[4];
    P.w_uq = (const float*)d_in[5]; P.w_ukv = (const float*)d_in[6]; P.ond = (const float*)d_in[7]; P.onm = (const float*)d_in[8]; P.w_o = (const float*)d_in[9];
    P.ln2 = (const float*)d_in[10]; P.wq = (const float*)d_in[11]; P.sk = (const float*)d_in[12]; P.pu = (const float*)d_in[13]; P.pv = (const float*)d_in[14]; P.lnf = (const float*)d_in[15];
    P.out = (float*)d_out; P.ws = (unsigned char*)d_ws;
}
static void launch_phases(Params P, int lo, int hi, hipStream_t st) {
    P.ph_lo = lo; P.ph_hi = hi;
    void* args[] = {&P};
    hipError_t e = hipLaunchCooperativeKernel((const void*)mega, dim3(mega_grid()), dim3(NTHREADS), args, LDS_BYTES, st);
    if (e != hipSuccess) fprintf(stderr, "mega launch [%d,%d) failed: %s\n", lo, hi, hipGetErrorString(e));
}
extern "C" void kernel_launch(void* const* d_in, const int* in_sizes, int n_in, void* d_out, int out_size, void* d_ws, size_t ws_size, hipStream_t stream) {
    Params P{}; fill_params(P, d_in, d_out, d_ws);
    launch_phases(P, 0, N_PHASES, stream);
}
```

```cpp
#include <hip/hip_runtime.h>
#include <hip/hip_cooperative_groups.h>
#include <cstdio>
#include <cstdint>
#include <cstddef>
namespace cg = cooperative_groups;
#define GAS __attribute__((address_space(1)))
#define LAS __attribute__((address_space(3)))
typedef unsigned short bf16;
typedef unsigned v4u __attribute__((ext_vector_type(4)));
typedef unsigned v2u __attribute__((ext_vector_type(2)));
typedef float f32x2 __attribute__((ext_vector_type(2)));
typedef float f32x4 __attribute__((ext_vector_type(4)));
typedef float f32x16 __attribute__((ext_vector_type(16)));
typedef short bf16x8 __attribute__((ext_vector_type(8)));
typedef short s16x4 __attribute__((ext_vector_type(4)));
typedef __bf16 bf16x2_t __attribute__((ext_vector_type(2)));
typedef float f32x32 __attribute__((ext_vector_type(32)));
typedef unsigned v6u __attribute__((ext_vector_type(6)));
typedef _Float16 h2_t __attribute__((ext_vector_type(2)));
constexpr int CW_ATT = 65;
constexpr int CW_FLAG = 64;
constexpr float U6_SCALE = 128.0f;

constexpr int M = 16384, SEQ = 2048, DM = 2048, NWAVES = 8, NTHREADS = 512;
constexpr float EPS = 1e-6f, LOG2E = 1.4426950408889634f;
constexpr float QSCALE_DIL = 0.08838834764831845f * LOG2E;
constexpr float QSCALE_MLA = 0.07216878364870323f * LOG2E;

constexpr size_t MiB = 1u << 20;
constexpr size_t WS_CTL = 0; constexpr int CTL_ZERO_BYTES = 32 * 1024;
constexpr size_t WS_ROPE = 1 * MiB;
constexpr size_t WS_SK = 2 * MiB;
constexpr size_t WS_BTKR = 3 * MiB;
constexpr size_t WS_BT2Q = 4 * MiB;
constexpr size_t WS_BT2KV = 6 * MiB;
constexpr size_t WS_BT1 = 8 * MiB;
constexpr size_t WS_BT3 = 24 * MiB;
constexpr size_t WS_BT4 = 32 * MiB;
constexpr size_t WS_SSQCQ = 40 * MiB;
constexpr size_t WS_SSQCKV = 40 * MiB + 512 * 1024;
constexpr size_t WS_SSQO = 41 * MiB;
constexpr size_t WS_SSQH = 42 * MiB;
constexpr size_t WS_KPE = 44 * MiB;
constexpr size_t WS_UB = 48 * MiB;
constexpr size_t WS_VB = 112 * MiB;
constexpr size_t WS_A = 176 * MiB;
constexpr size_t WS_B = 240 * MiB;
constexpr size_t WS_C = 336 * MiB;
constexpr size_t WS_QN = WS_C, WS_QPE = WS_C + 32 * MiB, WS_KN = WS_C + 48 * MiB, WS_VM = WS_C + 80 * MiB;
constexpr size_t WS_QP = WS_C, WS_RIDX = WS_C + 64 * MiB, WS_RGATE = WS_C + 72 * MiB, WS_PKV = WS_C + 80 * MiB,
                 WS_SIDX = WS_C + 88 * MiB, WS_SGATE = WS_C + 96 * MiB, WS_GOFF = WS_C + 104 * MiB;
constexpr size_t WS_D = 448 * MiB;
constexpr size_t WS_CQ = WS_D, WS_CKV = WS_D + 16 * MiB;
constexpr size_t WS_END = 480 * MiB;

constexpr int RING_BYTES = 131072;
constexpr int MISC_OFF = RING_BYTES;
constexpr int TR_OFF = 147456;
constexpr int LDS_BYTES = 163840;

#define LDS_WAIT() asm volatile("s_waitcnt lgkmcnt(0)" ::: "memory")
#define VM_WAIT() asm volatile("s_waitcnt vmcnt(0)" ::: "memory")

__device__ __forceinline__ unsigned f2bf(float f) { unsigned u = __builtin_bit_cast(unsigned, f); return (u + 0x7fffu + ((u >> 16) & 1u)) >> 16; }
__device__ __forceinline__ unsigned pk2(float lo, float hi) { f32x2 v = {lo, hi}; bf16x2_t b = __builtin_convertvector(v, bf16x2_t); return __builtin_bit_cast(unsigned, b); }
__device__ __forceinline__ float bflo(unsigned u) { return __builtin_bit_cast(float, u << 16); }
__device__ __forceinline__ float bfhi(unsigned u) { return __builtin_bit_cast(float, u & 0xffff0000u); }
__device__ __forceinline__ float bf2f(bf16 b) { return __builtin_bit_cast(float, (unsigned)b << 16); }
__device__ __forceinline__ float wave_sum(float v) {
#pragma unroll
    for (int o = 1; o < 64; o <<= 1) v += __shfl_xor(v, o);
    return v;
}

__device__ __forceinline__ int hw_lane() { int l; asm volatile("v_mbcnt_lo_u32_b32 %0, -1, 0\n\tv_mbcnt_hi_u32_b32 %0, -1, %0" : "=v"(l)); return l; }

struct Params {
    const float *x, *ln1, *w_in, *qan, *kvan, *w_uq, *w_ukv, *ond, *onm, *w_o, *ln2, *wq, *sk, *pu, *pv, *lnf;
    float* out; unsigned char* ws;
    int ph_lo, ph_hi;
};
__device__ __forceinline__ int map_ident(int c) { return c; }
__device__ __forceinline__ int map_kr(int c) { const int p = c - 4096; return 2 * (p & 31) + (p >> 5); }
__device__ __forceinline__ int map_uq(int c) { const int h = c / 192, e = c % 192; if (e < 128) return h * 128 + e; const int p = e - 128; return 1024 + h * 64 + 2 * (p & 31) + (p >> 5); }
__device__ __forceinline__ int map_ukv(int c) { const int h = c >> 8, e = c & 255; return e < 128 ? h * 128 + e : 1024 + h * 128 + (e - 128); }

template <int MAP>
__device__ __forceinline__ void p0_transpose_item(const float* __restrict__ W, int K, int ldw, int c0, const float* __restrict__ g0, const float* __restrict__ g1, int gsplit,
                                                  bf16* __restrict__ WT, LAS float* scr, int item, int nblk, int lane) {
    const int kb = item / nblk, nb = item % nblk, k0 = 64 * kb, n0 = c0 + 32 * nb;
    f32x4 wv[8];
#pragma unroll
    for (int i = 0; i < 8; ++i) wv[i] = *(const f32x4*)(W + (size_t)(k0 + (lane >> 3) + 8 * i) * ldw + n0 + 4 * (lane & 7));
#pragma unroll
    for (int i = 0; i < 8; ++i) { const int kk = (lane >> 3) + 8 * i, k = k0 + kk; f32x4 w = wv[i];
        if (g0) w = w * (k < gsplit ? g0[k] : g1[k - gsplit]);
        LAS float* d = scr + kk * 33 + 4 * (lane & 7); d[0] = w[0]; d[1] = w[1]; d[2] = w[2]; d[3] = w[3]; }
    LDS_WAIT(); asm volatile("" ::: "memory");
    const int c = lane & 7;
#pragma unroll
    for (int j = 0; j < 4; ++j) { const int n = (lane >> 3) + 8 * j; const LAS float* s = scr + (8 * c) * 33 + n;
        v4u o; o.x = pk2(s[0 * 33], s[1 * 33]); o.y = pk2(s[2 * 33], s[3 * 33]); o.z = pk2(s[4 * 33], s[5 * 33]); o.w = pk2(s[6 * 33], s[7 * 33]);
        const int src = n0 + n;
        const int dr = MAP == 0 ? map_ident(src) : MAP == 1 ? map_kr(src) : MAP == 2 ? map_uq(src) : map_ukv(src);
        *(v4u*)(WT + (size_t)dr * K + k0 + 8 * c) = o; }
    LDS_WAIT(); asm volatile("" ::: "memory");
}

#ifndef PREP_U_UNROLL
#define PREP_U_UNROLL 3
#endif
#ifndef PREP_ONLY
#define PREP_ONLY -1
#endif
__device__ __forceinline__ void phase_prep(const Params& P, LAS unsigned char* lds, int vcu, int G, int wave, int only = -1) {
    const int lane = hw_lane(), tid = wave * 64 + lane;
    unsigned char* ws = P.ws;
    LAS float* scr = (LAS float*)(lds + wave * 16384);
    const int gw = vcu * NWAVES + wave, NGW = G * NWAVES;
    const int gt = vcu * NTHREADS + tid, NGT = G * NTHREADS;
#pragma unroll 1
    for (int pi = 0; pi < 3; ++pi) {
        const int part = (pi + wave) % 3;
        if (only >= 0 && only != part) continue;
        if (part == 0) {
    constexpr int I1 = 32 * 128, IKR = 32 * 2, I2Q = 8 * 48, I2KV = 8 * 64, I3 = 32 * 64, I4 = 32 * 64;
    constexpr int NITEMS = I1 + IKR + I2Q + I2KV + I3 + I4;
    for (int it = gw; it < NITEMS; it += NGW) {
        int r = it;
        if (r < I1) { p0_transpose_item<0>(P.w_in, 2048, 4160, 0, nullptr, nullptr, 0, (bf16*)(ws + WS_BT1), scr, r, 128, lane); continue; } r -= I1;
        if (r < IKR) { p0_transpose_item<1>(P.w_in, 2048, 4160, 4096, nullptr, nullptr, 0, (bf16*)(ws + WS_BTKR), scr, r, 2, lane); continue; } r -= IKR;
        if (r < I2Q) { p0_transpose_item<2>(P.w_uq, 512, 1536, 0, P.qan, P.qan, 512, (bf16*)(ws + WS_BT2Q), scr, r, 48, lane); continue; } r -= I2Q;
        if (r < I2KV) { p0_transpose_item<3>(P.w_ukv, 512, 2048, 0, P.kvan, P.kvan, 512, (bf16*)(ws + WS_BT2KV), scr, r, 64, lane); continue; } r -= I2KV;
        if (r < I3) { p0_transpose_item<0>(P.w_o, 2048, 2048, 0, P.ond, P.onm, 1024, (bf16*)(ws + WS_BT3), scr, r, 64, lane); continue; } r -= I3;
        p0_transpose_item<0>(P.wq, 2048, 2048, 0, P.ln2, P.ln2, 2048, (bf16*)(ws + WS_BT4), scr, r, 64, lane);
    }
        } else if (part == 1) {
    {
        bf16* XN = (bf16*)(ws + WS_A);
        f32x4 gv[8];
#pragma unroll
        for (int j = 0; j < 8; ++j) gv[j] = ((const f32x4*)P.ln1)[lane + 64 * j];
        for (int m0 = gw * 4; m0 < M; m0 += NGW * 4) {
            f32x4 v[4][8];
#pragma unroll
            for (int r = 0; r < 4; ++r) { const f32x4* xr = (const f32x4*)(P.x + (size_t)(m0 + r) * DM) + lane;
#pragma unroll
                for (int j = 0; j < 8; ++j) v[r][j] = __builtin_nontemporal_load(xr + 64 * j); }
#pragma unroll
            for (int r = 0; r < 4; ++r) { float s = 0.f;
#pragma unroll
                for (int j = 0; j < 8; ++j) s += (v[r][j].x * v[r][j].x + v[r][j].y * v[r][j].y) + (v[r][j].z * v[r][j].z + v[r][j].w * v[r][j].w);
                const float rs = rsqrtf(wave_sum(s) * (1.f / DM) + EPS);
                v2u* o8 = (v2u*)(XN + (size_t)(m0 + r) * DM) + lane;
#pragma unroll
                for (int j = 0; j < 8; ++j) { v2u o; o.x = pk2(v[r][j].x * rs * gv[j].x, v[r][j].y * rs * gv[j].y); o.y = pk2(v[r][j].z * rs * gv[j].z, v[r][j].w * rs * gv[j].w); o8[64 * j] = o; } }
        }
    }
        } else {
        {
            const float tv[8] = {0.5f, 1.0f, 1.5f, 2.0f, 3.0f, 4.0f, 6.0f, -0.5f};
            unsigned pw = 0u;
            pw = __builtin_amdgcn_cvt_scalef32_pk_fp4_f32(pw, tv[0], tv[1], 1.0f, 0); pw = __builtin_amdgcn_cvt_scalef32_pk_fp4_f32(pw, tv[2], tv[3], 1.0f, 1);
            pw = __builtin_amdgcn_cvt_scalef32_pk_fp4_f32(pw, tv[4], tv[5], 1.0f, 2); pw = __builtin_amdgcn_cvt_scalef32_pk_fp4_f32(pw, tv[6], tv[7], 1.0f, 3);
            const h2_t r0 = __builtin_bit_cast(h2_t, __builtin_amdgcn_cvt_scalef32_pk_f16_fp4(pw, 1.0f, 0)), r1 = __builtin_bit_cast(h2_t, __builtin_amdgcn_cvt_scalef32_pk_f16_fp4(pw, 1.0f, 1));
            const h2_t r2 = __builtin_bit_cast(h2_t, __builtin_amdgcn_cvt_scalef32_pk_f16_fp4(pw, 1.0f, 2)), r3 = __builtin_bit_cast(h2_t, __builtin_amdgcn_cvt_scalef32_pk_f16_fp4(pw, 1.0f, 3));
            const bool ok = (float)r0[0] == tv[0] && (float)r0[1] == tv[1] && (float)r1[0] == tv[2] && (float)r1[1] == tv[3] && (float)r2[0] == tv[4] && (float)r2[1] == tv[5] && (float)r3[0] == tv[6] && (float)r3[1] == tv[7];
            if (!ok) __hip_atomic_store((unsigned*)(ws + WS_CTL) + CW_FLAG, 1u, __ATOMIC_RELAXED, __HIP_MEMORY_SCOPE_AGENT);
        }
        unsigned char* ou = ws + WS_UB;
        {
            const int l = gt & 63; f32x4 gp[8];
            const GAS float* lp = (const GAS float*)P.ln2 + 4 * l; asm volatile("" : "+v"(lp));
#pragma unroll
            for (int j = 0; j < 8; ++j) gp[j] = *(const GAS f32x4*)(lp + 256 * j) * U6_SCALE;
#pragma unroll PREP_U_UNROLL
            for (int i = gt; i < 16384 * 64; i += NGT) {
                const int e = i >> 6; const float* src = P.pu + (size_t)e * 2048 + 4 * l;
                f32x4 v[8];
#pragma unroll
                for (int j = 0; j < 8; ++j) v[j] = __builtin_nontemporal_load((const f32x4*)(src + 256 * j));
                v4u pw;
#pragma unroll
                for (int d = 0; d < 4; ++d) { unsigned w = 0u;
#pragma unroll
                    for (int n = 0; n < 8; ++n) { const int j = 2 * d + (n >> 2), c = n & 3;
                        const float f = __builtin_fmaf(v[j][c], gp[j][c], 8.5f); const unsigned q = (unsigned)__builtin_amdgcn_fmed3f(f, 1.0f, 15.5f); w |= q << (4 * n); }
                    pw[d] = w ^ 0x88888888u; }
                *(v4u*)(ou + (size_t)e * 1024 + 16 * l) = pw;
            }
        }
        }
    }
    if (only < 0 || only == 3) {
        f32x2* R = (f32x2*)(ws + WS_ROPE);
        for (int i = gt; i < 2048 * 32; i += NGT) { const int pos = i >> 5, j = i & 31; const float freq = powf(10000.0f, -(float)j / 32.0f), ang = (float)pos * freq;
            f32x2 cs; cs.x = cosf(ang); cs.y = sinf(ang); R[i] = cs; }
    }
    if (only < 0 || only == 3) {
        v4u* o = (v4u*)(ws + WS_SK);
        for (int i = gt; i < 16 * 128 * 128 / 8; i += NGT) { const f32x4 a = ((const f32x4*)P.sk)[2 * i], b = ((const f32x4*)P.sk)[2 * i + 1];
            v4u w; w.x = pk2(a.x, a.y); w.y = pk2(a.z, a.w); w.z = pk2(b.x, b.y); w.w = pk2(b.z, b.w); o[i] = w; }
    }
    if (only < 0 || only == 4) {
        __syncthreads();
        LAS unsigned* tl = (LAS unsigned*)lds;
        v2u* ov = (v2u*)(ws + WS_VB);
        f32x4 ra[8], rb[8];
#define PV8_LOAD(tile_) do { const int _e0 = ((tile_) >> 2) * 64, _c0 = ((tile_) & 3) * 64; _Pragma("unroll") for (int k = 0; k < 8; ++k) { const int it = tid + 512 * k, e = it >> 6, c = it & 63; \
            const f32x4* src = (const f32x4*)(P.pv + (size_t)(_e0 + e) * 2048 + (size_t)(_c0 + c) * 8); ra[k] = __builtin_nontemporal_load(src); rb[k] = __builtin_nontemporal_load(src + 1); } } while (0)
        if (vcu < 1024) PV8_LOAD(vcu);
        for (int tile = vcu; tile < 1024; tile += G) {
            const int e0 = (tile >> 2) * 64, s0 = (tile & 3) * 32;
#pragma unroll
            for (int k = 0; k < 8; ++k) { const int it = tid + 512 * k, e = it >> 6, c = it & 63; const f32x4 a = ra[k] * 4.f, b = rb[k] * 4.f;
                unsigned w = 0u;
                w = __builtin_amdgcn_cvt_scalef32_pk_fp4_f32(w, a.x, a.y, 1.0f, 0); w = __builtin_amdgcn_cvt_scalef32_pk_fp4_f32(w, a.z, a.w, 1.0f, 1);
                w = __builtin_amdgcn_cvt_scalef32_pk_fp4_f32(w, b.x, b.y, 1.0f, 2); w = __builtin_amdgcn_cvt_scalef32_pk_fp4_f32(w, b.z, b.w, 1.0f, 3);
                tl[((c >> 1) * 65 + e) * 2 + (c & 1)] = w; }
            if (tile + G < 1024) PV8_LOAD(tile + G);
            __syncthreads();
#pragma unroll
            for (int k = 0; k < 4; ++k) { const int it = tid + 512 * k, sl = it >> 6, e = it & 63; ov[(size_t)(s0 + sl) * 16384 + e0 + e] = *(const LAS v2u*)(tl + (sl * 65 + e) * 2); }
            __syncthreads();
        }
#undef PV8_LOAD
    }
}
#ifndef PG8_WGM
#define PG8_WGM 4
#endif
namespace pg8 {
constexpr int BM = 256, BK = 64, HALF = 128, HTB = HALF * BK * 2, STAGE_BYTES = 8 * HTB, NXCD = 8, WGM = PG8_WGM;
__host__ __device__ __forceinline__ int lds_byte(int r, int c) { const int st = (r >> 4) * 2 + (c >> 5), rr = r & 15, cc = c & 31, ob = rr * 64 + cc * 2; return st * 1024 + (ob ^ (((ob >> 9) & 1) << 5)); }
__host__ __device__ __forceinline__ void stage_rc(int b, int& R, int& C) { const int st = b / 1024, sb = b % 1024, swz = sb ^ (((sb >> 9) & 1) << 5); R = (st >> 1) * 16 + swz / 64; C = (st & 1) * 32 + (swz % 64) / 2; }
__host__ __device__ __forceinline__ int perm32(int rho) { const int n = rho >> 4, i = rho & 15; return 8 * (i >> 2) + 4 * n + (i & 3); }

struct Unit { int pm, pn, g; };
struct GemmSet { const bf16 *A0, *A1, *Bt0, *Bt1; int K;  unsigned* dummy; };

struct StaticOrder {
    int nM, nN0, nN, nwg, G, c, wgm;
    __device__ void init(int Mrows, int N0, int N1, int G_, int c_, int wgm_ = WGM) { nM = Mrows / BM; nN0 = N0 / BM; nN = nN0 + N1 / BM; nwg = nM * nN; G = G_; c = c_; wgm = wgm_; }
    __device__ bool next(int i, Unit& u) const {
        const long L = (long)i * G + c; if (L >= nwg) return false;
        int wgid = (int)L; { const int q = nwg / NXCD, r = nwg % NXCD, xcd = wgid % NXCD, off = wgid / NXCD; wgid = (xcd < r ? xcd * (q + 1) : r * (q + 1) + (xcd - r) * q) + off; }
        const int nig = wgm * nN, gid = wgid / nig, fm = gid * wgm, gsz = (nM - fm) < wgm ? (nM - fm) : wgm;
        u.pm = fm + ((wgid % nig) % gsz); int pn = (wgid % nig) / gsz; u.g = pn >= nN0 ? 1 : 0; u.pn = pn >= nN0 ? pn - nN0 : pn; return true;
    }
};
struct ForcedOrder {
    StaticOrder S; int mmask, nmask;
    __device__ bool next(int i, Unit& u) const { if (!S.next(i, u)) return false; u.pm &= mmask; u.pn &= nmask; return true; }
};

template <class Epi, class Sched>
__device__ __forceinline__ void gemm_phase(LAS unsigned char* lds, const GemmSet g, const Sched& S, const Epi& E, int wid) {
    const int lane = hw_lane(), tid = wid * 64 + lane, wr = wid >> 2, wc = wid & 3, fr = lane & 15, fq = lane >> 4;
    const int K = g.K, nt = K / BK;
    unsigned voffA[2], voffB[2];
#pragma unroll
    for (int i = 0; i < 2; ++i) { int R, C; stage_rc(tid * 16 + i * 8192, R, C); const int Rb = (R >> 5) * 64 + perm32(R & 31);
        voffA[i] = (unsigned)(R * K + C) * 2u; voffB[i] = (unsigned)(Rb * K + C) * 2u; }
    const size_t kstep = (size_t)(BK * 2);
    const size_t hstep = (size_t)HALF * K * 2;
    const size_t hstepB = (size_t)32 * K * 2;
    const size_t tstep = 2 * hstep;
    const unsigned ldsw = (unsigned)wid * 1024u;
    const int aoff = lds_byte(wr * 64 + fr, fq * 8), boff = lds_byte(wc * 32 + fr, fq * 8);
#define PG8_SA(b, h) (((b) * 2 + (h)) * HTB)
#define PG8_SB(b, h) ((4 + (b) * 2 + (h)) * HTB)
#define PG8_STAGE(bufoff, gbase, voff) do { _Pragma("unroll") for (int _i = 0; _i < 2; ++_i) \
        __builtin_amdgcn_global_load_lds((const unsigned*)((const char*)(gbase) + (voff)[_i]), (LAS unsigned*)(lds + (bufoff) + ldsw + _i * 8192), 16, 0, 0); } while (0)
#define PG8_LDA(dst, b, h) do { _Pragma("unroll") for (int m = 0; m < 4; ++m) _Pragma("unroll") for (int k = 0; k < 2; ++k) dst[m][k] = *(const LAS bf16x8*)(lds + PG8_SA(b, h) + aoff + m * 2048 + k * 1024); } while (0)
#define PG8_LDB(dst, b, h) do { _Pragma("unroll") for (int n = 0; n < 2; ++n) _Pragma("unroll") for (int k = 0; k < 2; ++k) dst[n][k] = *(const LAS bf16x8*)(lds + PG8_SB(b, h) + boff + n * 2048 + k * 1024); } while (0)
#define PG8_MMA(ai, bj, At, Bt) do { __builtin_amdgcn_s_setprio(1); _Pragma("unroll") for (int m = 0; m < 4; ++m) _Pragma("unroll") for (int n = 0; n < 2; ++n) _Pragma("unroll") for (int k = 0; k < 2; ++k) \
        acc[ai][bj][m][n] = __builtin_amdgcn_mfma_f32_16x16x32_bf16(Bt[n][k], At[m][k], acc[ai][bj][m][n], 0, 0, 0); __builtin_amdgcn_s_setprio(0); } while (0)
#define PG8_WAIT_V(n) asm volatile("s_waitcnt vmcnt(" #n ")" ::: "memory")
#define PG8_WAIT_L(n) asm volatile("s_waitcnt lgkmcnt(" #n ")" ::: "memory")
#define PG8_BAR __builtin_amdgcn_s_barrier()
#define PG8_SCHED __builtin_amdgcn_sched_barrier(0)
    Unit cur, nxt; int ui = 0;
    if (!S.next(0, cur)) return;
    f32x4 acc[2][2][4][2];
#pragma unroll
    for (int a = 0; a < 2; ++a)
#pragma unroll
        for (int b = 0; b < 2; ++b)
#pragma unroll
            for (int m = 0; m < 4; ++m)
#pragma unroll
                for (int n = 0; n < 2; ++n) acc[a][b][m][n] = (f32x4){0.f, 0.f, 0.f, 0.f};
    bf16x8 At[4][2], B0[2][2], B1[2][2];
    const char* cA = (const char*)(cur.g ? g.A1 : g.A0) + (size_t)cur.pm * tstep; const char* cB = (const char*)(cur.g ? g.Bt1 : g.Bt0) + (size_t)cur.pn * tstep;
    PG8_STAGE(PG8_SB(0, 0), cB, voffB); PG8_STAGE(PG8_SB(0, 1), cB + hstepB, voffB); PG8_STAGE(PG8_SA(0, 0), cA, voffA); PG8_STAGE(PG8_SA(0, 1), cA + hstep, voffA);
    E.unit_begin(cur, 0, tid);
#pragma unroll
    for (int j = 1; j < Epi::NSLOT; ++j) { Unit uj; if (S.next(j, uj)) E.unit_begin(uj, j, tid); }
    if (wr == 1) PG8_BAR;
    PG8_WAIT_V(2); PG8_BAR;
    PG8_STAGE(PG8_SB(1, 0), cB + kstep, voffB); PG8_STAGE(PG8_SA(1, 0), cA + kstep, voffA); PG8_STAGE(PG8_SB(1, 1), cB + hstepB + kstep, voffB);
    PG8_WAIT_V(6); PG8_BAR;
    for (;;) {
        const bool has_next = S.next(ui + 1, nxt);
        const char* nA = has_next ? (const char*)(nxt.g ? g.A1 : g.A0) + (size_t)nxt.pm * tstep : cA; const char* nB = has_next ? (const char*)(nxt.g ? g.Bt1 : g.Bt0) + (size_t)nxt.pn * tstep : cB;
        for (int t = 0; t < nt; t += 2) {
            const bool last = (t == nt - 2);
            const char* a1 = cA + (size_t)(t + 1) * kstep;
            const char* a2 = last ? nA : cA + (size_t)(t + 2) * kstep; const char* b2 = last ? nB : cB + (size_t)(t + 2) * kstep;
            const char* a3 = a2 + kstep; const char* b3 = b2 + kstep;
            if constexpr (Epi::MIDSCALE) { if (t == nt / 2) E.midscale(acc, ui % Epi::NSLOT, wr, fr); }
            PG8_LDB(B0, 0, 0); PG8_LDB(B1, 0, 1); PG8_SCHED; PG8_LDA(At, 0, 0); PG8_STAGE(PG8_SA(1, 1), a1 + hstep, voffA);
            PG8_WAIT_V(8); PG8_WAIT_L(0); PG8_BAR; PG8_MMA(0, 0, At, B0); PG8_MMA(0, 1, At, B1); PG8_BAR; PG8_SCHED;
            PG8_LDA(At, 0, 1); PG8_STAGE(PG8_SB(0, 0), b2, voffB); PG8_STAGE(PG8_SB(0, 1), b2 + hstepB, voffB); PG8_STAGE(PG8_SA(0, 0), a2, voffA);
            PG8_WAIT_V(8); PG8_WAIT_L(0); PG8_BAR; PG8_MMA(1, 0, At, B0); PG8_MMA(1, 1, At, B1); PG8_BAR; PG8_SCHED;
            PG8_LDB(B0, 1, 0); PG8_LDB(B1, 1, 1); PG8_SCHED; PG8_LDA(At, 1, 0); PG8_STAGE(PG8_SA(0, 1), a2 + hstep, voffA);
            PG8_WAIT_V(8); PG8_WAIT_L(0); PG8_BAR; PG8_MMA(0, 0, At, B0); PG8_MMA(0, 1, At, B1); PG8_BAR; PG8_SCHED;
            PG8_LDA(At, 1, 1); PG8_STAGE(PG8_SB(1, 0), b3, voffB); PG8_STAGE(PG8_SB(1, 1), b3 + hstepB, voffB); PG8_STAGE(PG8_SA(1, 0), a3, voffA);
            PG8_WAIT_V(8); PG8_WAIT_L(0); PG8_BAR; PG8_MMA(1, 0, At, B0); PG8_MMA(1, 1, At, B1); PG8_BAR; PG8_SCHED;
        }
        if (wr == 0) PG8_BAR;
        E(acc, cur, ui % Epi::NSLOT, wr, wc, fr, fq);
        if (!has_next) break;
#pragma unroll
        for (int a = 0; a < 2; ++a)
#pragma unroll
            for (int b = 0; b < 2; ++b)
#pragma unroll
                for (int m = 0; m < 4; ++m)
#pragma unroll
                    for (int n = 0; n < 2; ++n) acc[a][b][m][n] = (f32x4){0.f, 0.f, 0.f, 0.f};
        cur = nxt; cA = nA; cB = nB; ++ui;
        if (ui >= Epi::NSLOT) E.unit_begin(cur, ui % Epi::NSLOT, tid);
        if (wr == 1) PG8_BAR;
    }
    PG8_WAIT_V(0);
    PG8_BAR;
#undef PG8_SA
#undef PG8_SB
#undef PG8_STAGE
#undef PG8_LDA
#undef PG8_LDB
#undef PG8_MMA
#undef PG8_WAIT_V
#undef PG8_WAIT_L
#undef PG8_BAR
#undef PG8_SCHED
}
}
namespace pg8 {
__device__ __forceinline__ v4u pack8(const f32x4& v0, const f32x4& v1) { v4u w; w.x = pk2(v0[0], v0[1]); w.y = pk2(v0[2], v0[3]); w.z = pk2(v1[0], v1[1]); w.w = pk2(v1[2], v1[3]); return w; }
__device__ __forceinline__ float sq8(const f32x4& v0, const f32x4& v1) { return (v0[0] * v0[0] + v0[1] * v0[1]) + (v0[2] * v0[2] + v0[3] * v0[3]) + (v1[0] * v1[0] + v1[1] * v1[1]) + (v1[2] * v1[2] + v1[3] * v1[3]); }

struct TrPend { v4u o0, o1; bf16* d; };
__device__ __forceinline__ void tr_xchg(LAS unsigned char* tb, const v4u& v0, const v4u& v1, int fr, int fq, int r, int c, TrPend& p) {
    const int kw = (fr & 7) ^ (fr >> 3);
    *(LAS v4u*)(tb + fr * 128 + ((fq ^ kw) << 4)) = v0;
    *(LAS v4u*)(tb + fr * 128 + (((fq + 4) ^ kw) << 4)) = v1;
    asm volatile("" ::: "memory");
    p.o0 = *(const LAS v4u*)(tb + r * 128 + ((c ^ r) << 4)); p.o1 = *(const LAS v4u*)(tb + 1024 + r * 128 + ((c ^ r ^ 1) << 4));
    asm volatile("" ::: "memory");
}
#ifndef EPI_NT
#define EPI_NT 0
#endif
__device__ __forceinline__ void tr_flush(const TrPend& p, size_t ld, int r) {
    if (EPI_NT) { __builtin_nontemporal_store(p.o0, (v4u*)(p.d + (size_t)r * ld)); __builtin_nontemporal_store(p.o1, (v4u*)(p.d + (size_t)(r + 8) * ld)); }
    else { *(v4u*)(p.d + (size_t)r * ld) = p.o0; *(v4u*)(p.d + (size_t)(r + 8) * ld) = p.o1; }
}

struct Epi1 {
    static constexpr bool MIDSCALE = false; static constexpr int TAIL_STORES = 16, NSLOT = 2;
    bf16 *QKV, *CQ, *CKV; float *SSQCQ, *SSQCKV; LAS unsigned char* TB;
    __device__ __forceinline__ void midscale(f32x4 (&)[2][2][4][2], int, int, int) const {}
    __device__ __forceinline__ void unit_begin(const Unit&, int, int) const {}
    __device__ __forceinline__ void operator()(const f32x4 (&acc)[2][2][4][2], const Unit& u, int par, int wr, int wc, int fr, int fq) const {
        const int pn = u.pn; bf16* base; int ldc, colt; float sc = 1.f; float* ssq = nullptr; int sslot = 0;
        if (pn < 12) { base = QKV; ldc = 3072; colt = pn * 256; if (pn < 4) sc = QSCALE_DIL; }
        else if (pn < 14) { base = CQ; ldc = 512; colt = (pn - 12) * 256; ssq = SSQCQ; sslot = (pn - 12) * 4 + wc; }
        else { base = CKV; ldc = 512; colt = (pn - 14) * 256; ssq = SSQCKV; sslot = (pn - 14) * 4 + wc; }
        const int row0 = u.pm * BM + wr * 64, lane = fq * 16 + fr, sr = lane >> 3, sc8 = lane & 7;
        LAS unsigned char* tb = TB + (wr * 4 + wc) * 2048;
        bf16* dst = base + (size_t)row0 * ldc + colt + wc * 64 + 8 * sc8;
        TrPend pend;
#pragma unroll
        for (int g = 0; g < 8; ++g) { const int ai = g >> 2, m = g & 3, rb = ai * HALF + m * 16; float ss;
            const f32x4 v00 = acc[ai][0][m][0] * sc, v01 = acc[ai][0][m][1] * sc, v10 = acc[ai][1][m][0] * sc, v11 = acc[ai][1][m][1] * sc; ss = sq8(v00, v01) + sq8(v10, v11);
            TrPend cur; tr_xchg(tb, pack8(v00, v01), pack8(v10, v11), fr, fq, sr, sc8, cur); cur.d = dst + (size_t)rb * ldc;
            if (g) tr_flush(pend, (size_t)ldc, sr);
            pend = cur;
            if (ssq) { ss += __shfl_xor(ss, 16); ss += __shfl_xor(ss, 32); if (fq == 0) ssq[(size_t)(row0 + rb + fr) * 8 + sslot] = ss; } }
        tr_flush(pend, (size_t)ldc, sr);
    }
};

struct Epi2 {
    static constexpr bool MIDSCALE = false; static constexpr int TAIL_STORES = 16, NSLOT = 4;
    bf16 *QN, *QPE, *KN, *VM; const float *SSQCQ, *SSQCKV; const f32x2* ROPE; LAS float* RS; LAS unsigned char* TB;
    __device__ __forceinline__ void midscale(f32x4 (&)[2][2][4][2], int, int, int) const {}
    __device__ __forceinline__ void unit_begin(const Unit& u, int par, int tid) const {
        if (tid < 256) { const float* ssq = u.g == 0 ? SSQCQ : SSQCKV; const f32x4* p = (const f32x4*)(ssq + (size_t)(u.pm * BM + tid) * 8); const f32x4 p0 = p[0], p1 = p[1];
            RS[par * 256 + tid] = rsqrtf(((p0[0] + p0[1]) + (p0[2] + p0[3]) + (p1[0] + p1[1]) + (p1[2] + p1[3])) * (1.f / 512.f) + EPS) * (u.g == 0 ? QSCALE_MLA : 1.f); }
    }
    __device__ __forceinline__ void operator()(const f32x4 (&acc)[2][2][4][2], const Unit& u, int par, int wr, int wc, int fr, int fq) const {
        const int pn = u.pn; bf16* base; int ldc, colt; bool rope = false;
        if (u.g == 0) { if (pn < 4) { base = QN; ldc = 1024; colt = pn * 256; } else { base = QPE; ldc = 512; colt = (pn - 4) * 256; rope = true; } }
        else { if (pn < 4) { base = KN; ldc = 1024; colt = pn * 256; } else { base = VM; ldc = 1024; colt = (pn - 4) * 256; } }
        const int row0 = u.pm * BM + wr * 64, col0 = colt + wc * 64 + 8 * fq, lane = fq * 16 + fr, sr = lane >> 3, sc8 = lane & 7;
        LAS unsigned char* tb = TB + (wr * 4 + wc) * 2048;
        bf16* dst = base + (size_t)row0 * ldc + colt + wc * 64 + 8 * sc8;
        f32x4 rc[4];
#define EPI2_ROPE(dst, g) do { if (rope) { const int _row = row0 + ((g) >> 2) * HALF + ((g) & 3) * 16 + fr; _Pragma("unroll") for (int bj = 0; bj < 2; ++bj) { \
            const f32x4* rp = (const f32x4*)(ROPE + (size_t)(_row & (SEQ - 1)) * 32 + (((col0 + bj * 32) & 63) >> 1)); dst[2 * bj] = rp[0]; dst[2 * bj + 1] = rp[1]; } } } while (0)
        EPI2_ROPE(rc, 0);
        TrPend pend;
#pragma unroll
        for (int g = 0; g < 8; ++g) { const int ai = g >> 2, m = g & 3, rb = ai * HALF + m * 16;
            const float rs = RS[par * 256 + wr * 64 + rb + fr];
            v4u o[2];
#pragma unroll
            for (int bj = 0; bj < 2; ++bj) { f32x4 v0 = acc[ai][bj][m][0] * rs, v1 = acc[ai][bj][m][1] * rs;
                if (rope) { const f32x4 r0 = rc[2 * bj], r1 = rc[2 * bj + 1];
                    f32x4 w0, w1;
                    w0[0] = v0[0] * r0[0] - v0[1] * r0[1]; w0[1] = v0[0] * r0[1] + v0[1] * r0[0];
                    w0[2] = v0[2] * r0[2] - v0[3] * r0[3]; w0[3] = v0[2] * r0[3] + v0[3] * r0[2];
                    w1[0] = v1[0] * r1[0] - v1[1] * r1[1]; w1[1] = v1[0] * r1[1] + v1[1] * r1[0];
                    w1[2] = v1[2] * r1[2] - v1[3] * r1[3]; w1[3] = v1[2] * r1[3] + v1[3] * r1[2];
                    v0 = w0; v1 = w1; }
                o[bj] = pack8(v0, v1); }
            if (g < 7) EPI2_ROPE(rc, g + 1);
            TrPend cur; tr_xchg(tb, o[0], o[1], fr, fq, sr, sc8, cur); cur.d = dst + (size_t)rb * ldc;
            if (g) tr_flush(pend, (size_t)ldc, sr);
            pend = cur; }
        tr_flush(pend, (size_t)ldc, sr);
#undef EPI2_ROPE
    }
};

struct Epi3 {
    static constexpr bool MIDSCALE = true; static constexpr int TAIL_STORES = 16, NSLOT = 2;
    bf16* H1B; const float* X; const float* SSQO; float* SSQH; LAS f32x2* RS; LAS unsigned char* TB;
    __device__ __forceinline__ void unit_begin(const Unit& u, int par, int tid) const {
        if (tid < 256) { const f32x4* p = (const f32x4*)(SSQO + (size_t)(u.pm * BM + tid) * 16); const f32x4 a0 = p[0], a1 = p[1], b0 = p[2], b1 = p[3];
            const float ra = rsqrtf(((a0[0] + a0[1]) + (a0[2] + a0[3]) + (a1[0] + a1[1]) + (a1[2] + a1[3])) * (1.f / 1024.f) + EPS);
            const float rb = rsqrtf(((b0[0] + b0[1]) + (b0[2] + b0[3]) + (b1[0] + b1[1]) + (b1[2] + b1[3])) * (1.f / 1024.f) + EPS);
            f32x2 v; v.x = ra / rb; v.y = rb; RS[par * 256 + tid] = v; }
    }
    __device__ __forceinline__ void midscale(f32x4 (&acc)[2][2][4][2], int par, int wr, int fr) const {
#pragma unroll
        for (int ai = 0; ai < 2; ++ai)
#pragma unroll
            for (int m = 0; m < 4; ++m) { const float f = RS[par * 256 + ai * HALF + wr * 64 + m * 16 + fr].x;
#pragma unroll
                for (int bj = 0; bj < 2; ++bj) { acc[ai][bj][m][0] = acc[ai][bj][m][0] * f; acc[ai][bj][m][1] = acc[ai][bj][m][1] * f; } }
    }
    __device__ __forceinline__ void operator()(const f32x4 (&acc)[2][2][4][2], const Unit& u, int par, int wr, int wc, int fr, int fq) const {
        const int row0 = u.pm * BM + wr * 64 + fr, col0 = u.pn * BM + wc * 64 + 8 * fq, sslot = u.pn * 4 + wc, lane = fq * 16 + fr, sr = lane >> 3, sc8 = lane & 7;
        LAS unsigned char* tb = TB + (wr * 4 + wc) * 2048;
        bf16* dst = H1B + (size_t)(u.pm * BM + wr * 64) * DM + u.pn * BM + wc * 64 + 8 * sc8;
        f32x4 xc[4];
#define EPI3_X(dst, g) do { const float* xp = X + (size_t)(row0 + ((g) >> 2) * HALF + ((g) & 3) * 16) * DM + col0; \
            dst[0] = *(const f32x4*)xp; dst[1] = *(const f32x4*)(xp + 4); dst[2] = *(const f32x4*)(xp + 32); dst[3] = *(const f32x4*)(xp + 36); } while (0)
        EPI3_X(xc, 0);
        TrPend pend;
#pragma unroll
        for (int g = 0; g < 8; ++g) { const int ai = g >> 2, m = g & 3, row = row0 + ai * HALF + m * 16; const float rb = RS[par * 256 + ai * HALF + wr * 64 + m * 16 + fr].y;
            const f32x4 v00 = acc[ai][0][m][0] * rb + xc[0], v01 = acc[ai][0][m][1] * rb + xc[1], v10 = acc[ai][1][m][0] * rb + xc[2], v11 = acc[ai][1][m][1] * rb + xc[3];
            float ss = sq8(v00, v01) + sq8(v10, v11);
            if (g < 7) EPI3_X(xc, g + 1);
            TrPend cur; tr_xchg(tb, pack8(v00, v01), pack8(v10, v11), fr, fq, sr, sc8, cur); cur.d = dst + (size_t)(ai * HALF + m * 16) * DM;
            if (g) tr_flush(pend, (size_t)DM, sr);
            pend = cur;
            ss += __shfl_xor(ss, 16); ss += __shfl_xor(ss, 32); if (fq == 0) SSQH[(size_t)row * 32 + sslot] = ss; }
        tr_flush(pend, (size_t)DM, sr);
#undef EPI3_X
    }
};

struct Epi4 {
    static constexpr bool MIDSCALE = false; static constexpr int TAIL_STORES = 16, NSLOT = 2;
    bf16* QP; LAS unsigned char* TB;
    __device__ __forceinline__ void midscale(f32x4 (&)[2][2][4][2], int, int, int) const {}
    __device__ __forceinline__ void unit_begin(const Unit&, int, int) const {}
    __device__ __forceinline__ void operator()(const f32x4 (&acc)[2][2][4][2], const Unit& u, int par, int wr, int wc, int fr, int fq) const {
        const int lane = fq * 16 + fr, sr = lane >> 3, sc8 = lane & 7;
        LAS unsigned char* tb = TB + (wr * 4 + wc) * 2048;
        bf16* dst = QP + (size_t)(u.pm * BM + wr * 64) * DM + u.pn * BM + wc * 64 + 8 * sc8;
        TrPend pend;
#pragma unroll
        for (int g = 0; g < 8; ++g) { const int ai = g >> 2, m = g & 3;
            TrPend cur; tr_xchg(tb, pack8(acc[ai][0][m][0], acc[ai][0][m][1]), pack8(acc[ai][1][m][0], acc[ai][1][m][1]), fr, fq, sr, sc8, cur); cur.d = dst + (size_t)(ai * HALF + m * 16) * DM;
            if (g) tr_flush(pend, (size_t)DM, sr);
            pend = cur; }
        tr_flush(pend, (size_t)DM, sr);
    }
};
struct EpiSmall {
    static constexpr bool MIDSCALE = false; static constexpr int TAIL_STORES = 16, NSLOT = 2;
    bf16* QP;
    __device__ __forceinline__ void midscale(f32x4 (&)[2][2][4][2], int, int, int) const {}
    __device__ __forceinline__ void unit_begin(const Unit&, int, int) const {}
    __device__ __forceinline__ void operator()(const f32x4 (&acc)[2][2][4][2], const Unit& u, int par, int wr, int wc, int fr, int fq) const {
        const int row0 = (blockIdx.x * 16) + fr, col0 = wc * 64 + 8 * fq;
#pragma unroll
        for (int ai = 0; ai < 2; ++ai)
#pragma unroll
            for (int m = 0; m < 4; ++m) { const int row = row0;
#pragma unroll
                for (int bj = 0; bj < 2; ++bj) *(v4u*)(QP + (size_t)row * DM + col0 + bj * 32 + (ai * 4 + m) * 256) = pack8(acc[ai][bj][m][0], acc[ai][bj][m][1]); }
    }
};
struct EpiSmallT {
    static constexpr bool MIDSCALE = false; static constexpr int TAIL_STORES = 16, NSLOT = 2;
    bf16* QP; LAS unsigned char* TB;
    __device__ __forceinline__ void midscale(f32x4 (&)[2][2][4][2], int, int, int) const {}
    __device__ __forceinline__ void unit_begin(const Unit&, int, int) const {}
    __device__ __forceinline__ void operator()(const f32x4 (&acc)[2][2][4][2], const Unit& u, int par, int wr, int wc, int fr, int fq) const {
        const int lane = fq * 16 + fr, sr = lane >> 3, sc8 = lane & 7;
        LAS unsigned char* tb = TB + (wr * 4 + wc) * 2048;
        bf16* dst = QP + (size_t)(blockIdx.x * 32 + wr * 16) * DM + wc * 64 + 8 * sc8;
        TrPend pend;
#pragma unroll
        for (int g = 0; g < 8; ++g) { const int ai = g >> 2, m = g & 3;
            TrPend cur; tr_xchg(tb, pack8(acc[ai][0][m][0], acc[ai][0][m][1]), pack8(acc[ai][1][m][0], acc[ai][1][m][1]), fr, fq, sr, sc8, cur); cur.d = dst + g * 256;
            if (g) tr_flush(pend, (size_t)DM, sr);
            pend = cur; }
        tr_flush(pend, (size_t)DM, sr);
    }
};
struct EpiNoStoreT {
    static constexpr bool MIDSCALE = false; static constexpr int TAIL_STORES = 0, NSLOT = 2;
    LAS unsigned char* TB;
    __device__ __forceinline__ void midscale(f32x4 (&)[2][2][4][2], int, int, int) const {}
    __device__ __forceinline__ void unit_begin(const Unit&, int, int) const {}
    __device__ __forceinline__ void operator()(const f32x4 (&acc)[2][2][4][2], const Unit& u, int par, int wr, int wc, int fr, int fq) const {
        const int lane = fq * 16 + fr, r = lane >> 3, c = lane & 7;
        LAS unsigned char* tb = TB + (wr * 4 + wc) * 2048;
#ifndef NOSTORE_REP
#define NOSTORE_REP 1
#endif
#pragma unroll
        for (int g = 0; g < 8; ++g) { const int ai = g >> 2, m = g & 3;
#pragma unroll
            for (int rep = 0; rep < NOSTORE_REP; ++rep) {
                TrPend cur; tr_xchg(tb, pack8(acc[ai][0][m][0], acc[ai][0][m][1]), pack8(acc[ai][1][m][0], acc[ai][1][m][1]), fr, fq, r, c, cur);
                asm volatile("" :: "v"(cur.o0), "v"(cur.o1)); } }
    }
};
struct EpiNull {
    static constexpr bool MIDSCALE = false; static constexpr int TAIL_STORES = 0, NSLOT = 2;
    __device__ __forceinline__ void midscale(f32x4 (&)[2][2][4][2], int, int, int) const {}
    __device__ __forceinline__ void unit_begin(const Unit&, int, int) const {}
    __device__ __forceinline__ void operator()(const f32x4 (&acc)[2][2][4][2], const Unit& u, int par, int wr, int wc, int fr, int fq) const {
#pragma unroll
        for (int ai = 0; ai < 2; ++ai)
#pragma unroll
            for (int bj = 0; bj < 2; ++bj)
#pragma unroll
                for (int m = 0; m < 4; ++m)
#pragma unroll
                    for (int n = 0; n < 2; ++n) asm volatile("" :: "v"(acc[ai][bj][m][n]));
    }
};
}

#ifndef KR_DEPTH
#define KR_DEPTH 4
#endif
__device__ __forceinline__ void kr_item64(const bf16* __restrict__ XN, const bf16* __restrict__ BT, const f32x2* __restrict__ ROPE, bf16* __restrict__ KPE, LAS f32x4* red, int item, int wave, int lane) {
    const int fr = lane & 15, fq = lane >> 4, rg = wave & 3, kh = wave >> 2, row = item * 64 + rg * 16 + fr;
    const int lr = lane >> 3, lc = lane & 7;
    const bf16* ap = XN + (size_t)(item * 64 + rg * 16 + lr) * 2048 + kh * 1024 + lc * 8; const bf16* bp = BT + (size_t)(rg * 16 + lr) * 2048 + kh * 1024 + lc * 8;
    LAS unsigned char* sa = (LAS unsigned char*)red + 16384 + wave * 2304;
    LAS unsigned char* sbk = (LAS unsigned char*)red + 16384 + 18432 + kh * 9216;
    const int woff = lr * 144 + lc * 16, roff = fr * 144 + fq * 16;
    f32x4 acc[4];
#pragma unroll
    for (int nb = 0; nb < 4; ++nb) acc[nb] = (f32x4){0.f, 0.f, 0.f, 0.f};
    const int rot = __builtin_amdgcn_readfirstlane(((item >> 3) & 7) * 128);
#define KR_OFF(p) ((64 * (p) + rot) & 1023)
#define KR_LOAD(r, p) do { const int _o = KR_OFF(p); a[r][0] = *(const v4u*)(ap + _o); a[r][1] = *(const v4u*)(ap + 8 * 2048 + _o); \
        b[r][0] = *(const v4u*)(bp + _o); b[r][1] = *(const v4u*)(bp + 8 * 2048 + _o); } while (0)
    v4u a[KR_DEPTH][2], b[KR_DEPTH][2];
#pragma unroll
    for (int p = 0; p < KR_DEPTH; ++p) KR_LOAD(p, p);
#pragma unroll
    for (int p = 0; p < 16; ++p) {
        const int r = p % KR_DEPTH;
        LAS unsigned char* sb = sbk + (p & 1) * 18432;
        __builtin_amdgcn_sched_barrier(0);
        *(LAS v4u*)(sa + woff) = a[r][0]; *(LAS v4u*)(sa + 8 * 144 + woff) = a[r][1];
        *(LAS v4u*)(sb + 2304 * rg + woff) = b[r][0]; *(LAS v4u*)(sb + 2304 * rg + 8 * 144 + woff) = b[r][1];
        if (p + KR_DEPTH < 16) KR_LOAD(r, p + KR_DEPTH);
        __builtin_amdgcn_sched_barrier(0);
        asm volatile("s_waitcnt lgkmcnt(0)" ::: "memory");
        __builtin_amdgcn_s_barrier();
        asm volatile("" ::: "memory");
#pragma unroll
        for (int h = 0; h < 2; ++h) {
            const bf16x8 af = *(const LAS bf16x8*)(sa + roff + 64 * h);
#pragma unroll
            for (int nb = 0; nb < 4; ++nb) { const bf16x8 bf = *(const LAS bf16x8*)(sb + 2304 * nb + roff + 64 * h); acc[nb] = __builtin_amdgcn_mfma_f32_16x16x32_bf16(bf, af, acc[nb], 0, 0, 0); }
        }
        asm volatile("s_waitcnt lgkmcnt(0)" ::: "memory");
    }
#undef KR_OFF
#undef KR_LOAD
    if (kh == 1) {
#pragma unroll
        for (int nb = 0; nb < 4; ++nb) red[(rg * 4 + nb) * 64 + lane] = acc[nb];
    }
    __syncthreads();
    if (kh == 0) {
        const int pos = row & (SEQ - 1);
#pragma unroll
        for (int nb = 0; nb < 4; ++nb) { const int j0 = 8 * nb + 2 * fq; const f32x4 r = *(const f32x4*)(ROPE + (size_t)pos * 32 + j0); const f32x4 v = acc[nb] + red[(rg * 4 + nb) * 64 + lane];
            v2u o; o.x = pk2(v[0] * r[0] - v[1] * r[1], v[0] * r[1] + v[1] * r[0]); o.y = pk2(v[2] * r[2] - v[3] * r[3], v[2] * r[3] + v[3] * r[2]);
            *(v2u*)(KPE + (size_t)row * 64 + 16 * nb + 4 * fq) = o; }
    }
    __syncthreads();
}
namespace att {
typedef short v4i16_t __attribute__((ext_vector_type(4)));
#define MFMA32(a, b, c) __builtin_amdgcn_mfma_f32_32x32x16_bf16((a), (b), (c), 0, 0, 0)
__device__ __forceinline__ s16x4 vtr(const LAS unsigned char* p) { return __builtin_bit_cast(s16x4, __builtin_amdgcn_ds_read_tr16_b64_v4i16((LAS v4i16_t*)p)); }
__device__ __forceinline__ int crow(int r, int hi) { return (r & 3) + 8 * (r >> 2) + 4 * hi; }
constexpr int VS = 320;
constexpr int KS = 400;
constexpr float NEG = -1e30f;
#ifndef SM_THR
#define SM_THR 8.0f
#endif

__device__ __forceinline__ bf16x8 pack8r(const f32x16& p, int s) {
    v4u w; w.x = pk2(p[8 * s + 0], p[8 * s + 1]); w.y = pk2(p[8 * s + 2], p[8 * s + 3]); w.z = pk2(p[8 * s + 4], p[8 * s + 5]); w.w = pk2(p[8 * s + 6], p[8 * s + 7]);
    return __builtin_bit_cast(bf16x8, w);
}
__device__ __forceinline__ void pv32(f32x16 (&o)[4], const LAS unsigned char* vb, const bf16x8 pb0, const bf16x8 pb1) {
#pragma unroll
    for (int d = 0; d < 4; ++d) {
        const s16x4 l0 = vtr(vb + d * 64), h0 = vtr(vb + d * 64 + 8 * VS), l1 = vtr(vb + d * 64 + 16 * VS), h1 = vtr(vb + d * 64 + 24 * VS);
        const bf16x8 a0 = __builtin_shufflevector(l0, h0, 0, 1, 2, 3, 4, 5, 6, 7), a1 = __builtin_shufflevector(l1, h1, 0, 1, 2, 3, 4, 5, 6, 7);
        o[d] = MFMA32(a0, pb0, o[d]); o[d] = MFMA32(a1, pb1, o[d]);
    }
}
template <int NS>
__device__ __forceinline__ void softmax_step(f32x16 (&s)[NS], float& m, float& l, f32x16 (&o)[4], bf16x8 (&pb)[2 * NS]) {
    float mx = s[0][0];
#pragma unroll
    for (int t = 0; t < NS; ++t)
#pragma unroll
        for (int r = 0; r < 16; ++r) mx = fmaxf(mx, s[t][r]);
    mx = fmaxf(mx, __shfl_xor(mx, 32));
    if (!__all(mx - m <= SM_THR)) {
        const float mn = fmaxf(m, mx), alpha = __builtin_amdgcn_exp2f(m - mn); m = mn; l *= alpha;
#pragma unroll
        for (int d = 0; d < 4; ++d) o[d] = o[d] * alpha;
    }
    float ps = 0.f;
#pragma unroll
    for (int t = 0; t < NS; ++t)
#pragma unroll
        for (int r = 0; r < 16; ++r) { const float p = __builtin_amdgcn_exp2f(s[t][r] - m); s[t][r] = p; ps += p; }
    l += ps;
#pragma unroll
    for (int t = 0; t < NS; ++t) { pb[2 * t] = pack8r(s[t], 0); pb[2 * t + 1] = pack8r(s[t], 1); }
}
__device__ __forceinline__ void store_o(f32x16 (&o)[4], float l, bf16* __restrict__ orow  , float* __restrict__ ssq  , int hh) {
    l += __shfl_xor(l, 32);
    const float inv = 1.0f / l; float ss = 0.f;
#pragma unroll
    for (int d = 0; d < 4; ++d) { o[d] = o[d] * inv;
#pragma unroll
        for (int g = 0; g < 4; ++g) { const float a = o[d][4 * g], b = o[d][4 * g + 1], c = o[d][4 * g + 2], e = o[d][4 * g + 3];
            ss += (a * a + b * b) + (c * c + e * e);
            v2u w; w.x = pk2(a, b); w.y = pk2(c, e); *(v2u*)(orow + 32 * d + 8 * g + 4 * hh) = w; } }
    ss += __shfl_xor(ss, 32);
    if (hh == 0) *ssq = ss;
}

constexpr int KTB = 64 * KS, VTB = 64 * VS, BUFB = KTB + VTB;
__device__ __forceinline__ void mla_unit(const unsigned char* ws, LAS unsigned char* lds, int b, int h, int qblk, int tid, int wave, int lane) {
    const bf16* QN = (const bf16*)(ws + WS_QN); const bf16* QPE = (const bf16*)(ws + WS_QPE);
    bf16* O = (bf16*)(ws + WS_A); float* SSQO = (float*)(ws + WS_SSQO);
    const int r32 = lane & 31, hh = lane >> 5;
    const size_t tok0 = (size_t)b * SEQ;
    const int row_lo = qblk * 256 + wave * 32, qrow = row_lo + r32;
    bf16x8 qf[12];
    { const bf16* qn = QN + (tok0 + qrow) * 1024 + h * 128 + 8 * hh;
#pragma unroll
      for (int s = 0; s < 8; ++s) qf[s] = *(const bf16x8*)(qn + 16 * s);
      const bf16* qp = QPE + (tok0 + qrow) * 512 + h * 64 + 8 * hh;
#pragma unroll
      for (int s = 0; s < 4; ++s) qf[8 + s] = *(const bf16x8*)(qp + 16 * s); }
    const int c0 = tid, c1 = tid + 512;
    const unsigned okn0 = (unsigned)WS_KN + (unsigned)(((unsigned)tok0 + (c0 >> 4)) * 1024u + h * 128 + (c0 & 15) * 8) * 2u, okn1 = okn0 + 32u * 1024u * 2u;
    const unsigned okp = (unsigned)WS_KPE + (unsigned)(((unsigned)tok0 + (tid >> 3)) * 64u + (tid & 7) * 8) * 2u;
    const unsigned ov0 = okn0 + (unsigned)(WS_VM - WS_KN), ov1 = ov0 + 32u * 1024u * 2u;
    const int lkn0 = (c0 >> 4) * KS + (c0 & 15) * 16, lkn1 = (c1 >> 4) * KS + (c1 & 15) * 16, lkp = (tid >> 3) * KS + 256 + (tid & 7) * 16;
    const int lv0 = KTB + (c0 >> 4) * VS + (c0 & 15) * 16, lv1 = KTB + (c1 >> 4) * VS + (c1 & 15) * 16;
    v4u st0, st1, st2, st3, st4;
#define MLA_GLOAD(kt) do { const unsigned _o = (unsigned)(kt) * 131072u, _p = (unsigned)(kt) * 8192u; st0 = *(const v4u*)(ws + (size_t)(okn0 + _o)); st1 = *(const v4u*)(ws + (size_t)(okn1 + _o)); \
        st2 = *(const v4u*)(ws + (size_t)(okp + _p)); st3 = *(const v4u*)(ws + (size_t)(ov0 + _o)); st4 = *(const v4u*)(ws + (size_t)(ov1 + _o)); } while (0)
#define MLA_LWRITE(buf) do { LAS unsigned char* _b = lds + (buf) * BUFB; *(LAS v4u*)(_b + lkn0) = st0; *(LAS v4u*)(_b + lkn1) = st1; *(LAS v4u*)(_b + lkp) = st2; \
        *(LAS v4u*)(_b + lv0) = st3; *(LAS v4u*)(_b + lv1) = st4; } while (0)
    const int nkt = 4 * (qblk + 1);
    MLA_GLOAD(0); MLA_LWRITE(0);
    __syncthreads();
    f32x16 o[4];
#pragma unroll
    for (int d = 0; d < 4; ++d)
#pragma unroll
        for (int r = 0; r < 16; ++r) o[d][r] = 0.f;
    float m = NEG, l = 0.f;
    const int kread = r32 * KS + 16 * hh;
    const int vread = KTB + (4 * hh + ((lane & 15) >> 2)) * VS + (16 * ((lane >> 4) & 1) + 4 * (lane & 3)) * 2;
    for (int kt = 0; kt < nkt; ++kt) {
        if (kt + 1 < nkt) MLA_GLOAD(kt + 1);
        const int k0 = kt * 64;
        if (k0 <= row_lo + 31) {
            const LAS unsigned char* kb = lds + (kt & 1) * BUFB;
            const bool diag = (k0 + 63 > row_lo);
            const bool two = !(k0 + 32 > row_lo + 31);
            f32x16 s0[1], s1[1];
#pragma unroll
            for (int r = 0; r < 16; ++r) { s0[0][r] = 0.f; s1[0][r] = 0.f; }
#pragma unroll
            for (int ks = 0; ks < 12; ++ks) { const bf16x8 kf = *(const LAS bf16x8*)(kb + kread + 32 * ks); s0[0] = MFMA32(kf, qf[ks], s0[0]); }
            if (two) {
#pragma unroll
                for (int ks = 0; ks < 12; ++ks) { const bf16x8 kf = *(const LAS bf16x8*)(kb + kread + 32 * KS + 32 * ks); s1[0] = MFMA32(kf, qf[ks], s1[0]); }
            }
            {
                if (diag) {
#pragma unroll
                    for (int r = 0; r < 16; ++r) { const int key = k0 + crow(r, hh); if (key > qrow) s0[0][r] = NEG; }
                }
                bf16x8 pb[2];
                softmax_step<1>(s0, m, l, o, pb);
                pv32(o, kb + vread, pb[0], pb[1]);
            }
            if (two) {
                if (diag) {
#pragma unroll
                    for (int r = 0; r < 16; ++r) { const int key = k0 + 32 + crow(r, hh); if (key > qrow) s1[0][r] = NEG; }
                }
                bf16x8 pb[2];
                softmax_step<1>(s1, m, l, o, pb);
                pv32(o, kb + vread + 32 * VS, pb[0], pb[1]);
            }
        }
        if (kt + 1 < nkt) MLA_LWRITE((kt + 1) & 1);
        __syncthreads();
    }
#undef MLA_GLOAD
#undef MLA_LWRITE
    store_o(o, l, O + (tok0 + qrow) * 2048 + 1024 + h * 128, SSQO + (tok0 + qrow) * 16 + 8 + h, hh);
}

constexpr int DKS = 272, DSH = 32 * DKS + 32 * VS;
__device__ __forceinline__ void dil_tile(const unsigned char* ws, LAS unsigned char* vl  , LAS unsigned char* sh  , int b, int h, int j, int r16, int tid, int lane) {
    const bf16* QKV = (const bf16*)(ws + WS_B);
    const int r32 = lane & 31, hh = lane >> 5;
    const size_t tok0 = (size_t)b * SEQ;
    const int tq = 512 * j + 16 * r32 + r16;
    bf16x8 qf[8];
    { const bf16* qp = QKV + (tok0 + tq) * 3072 + h * 128 + 8 * hh;
#pragma unroll
      for (int s = 0; s < 8; ++s) qf[s] = *(const bf16x8*)(qp + 16 * s); }
    const float slope2 = __builtin_amdgcn_exp2f(-(float)(h + 1)) * LOG2E;
    const int m0 = (j == 0) ? 4 : 0, n3 = j + 1, n2 = 8 - m0, n1 = 20 - m0, nt = n3;
    const unsigned vcol = (unsigned)WS_B + ((unsigned)tok0 * 3072u + 2048u + h * 128 + (lane & 15) * 8) * 2u;
    const int vrow = lane >> 4;
    const int vwr = vrow * VS + (lane & 15) * 16;
    const int vread = (4 * hh + ((lane & 15) >> 2)) * VS + (16 * ((lane >> 4) & 1) + 4 * (lane & 3)) * 2;
    int kbase, kstride, maxd;
#define DIL_DESC(idx) do { kbase = 512 * (j - (idx)) + r16; kstride = 16; maxd = 2048; } while (0)
    v4u kq[8], vq[8];
    const unsigned kcc = (unsigned)WS_B + ((unsigned)tok0 * 3072u + 1024u + h * 128 + (lane & 15) * 8) * 2u;
    const int kwr = vrow * DKS + (lane & 15) * 16, kfr = r32 * DKS + 16 * hh;
    DIL_DESC(0);
#pragma unroll
    for (int i = 0; i < 8; ++i) { const unsigned ro = (unsigned)(kbase + kstride * (4 * i + vrow)) * 6144u; kq[i] = *(const v4u*)(ws + (size_t)(kcc + ro)); vq[i] = *(const v4u*)(ws + (size_t)(vcol + ro)); }
    f32x16 o[4];
#pragma unroll
    for (int d = 0; d < 4; ++d)
#pragma unroll
        for (int r = 0; r < 16; ++r) o[d][r] = 0.f;
    float m = NEG, l = 0.f;
    for (int idx = 0; idx < nt; ++idx) {
        const int cb = kbase, cs = kstride, cm = maxd;
        const bool more = idx + 1 < nt;
#pragma unroll
        for (int i = 0; i < 8; ++i) *(LAS v4u*)(vl + kwr + 4 * i * DKS) = kq[i];
        if (more) { DIL_DESC(idx + 1);
#pragma unroll
            for (int i = 0; i < 8; ++i) kq[i] = *(const v4u*)(ws + (size_t)(kcc + (unsigned)(kbase + kstride * (4 * i + vrow)) * 6144u)); }
        f32x16 s[1];
#pragma unroll
        for (int r = 0; r < 16; ++r) s[0][r] = 0.f;
#pragma unroll
        for (int ks = 0; ks < 8; ++ks) { const bf16x8 kf = *(const LAS bf16x8*)(vl + kfr + 32 * ks); s[0] = MFMA32(kf, qf[ks], s[0]); }
#pragma unroll
        for (int i = 0; i < 8; ++i) *(LAS v4u*)(vl + vwr + 4 * i * VS) = vq[i];
        if (more) {
#pragma unroll
            for (int i = 0; i < 8; ++i) vq[i] = *(const v4u*)(ws + (size_t)(vcol + (unsigned)(kbase + kstride * (4 * i + vrow)) * 6144u)); }
        const int d0 = tq - cb - cs * 4 * hh;
#pragma unroll
        for (int r = 0; r < 16; ++r) { const int dist = d0 - cs * ((r & 3) + 8 * (r >> 2)); const float v = s[0][r] - slope2 * (float)dist; s[0][r] = ((unsigned)dist <= (unsigned)cm) ? v : NEG; }
        bf16x8 pb[2];
        softmax_step<1>(s, m, l, o, pb);
        pv32(o, vl + vread, pb[0], pb[1]);
    }
#undef DIL_DESC
    {
        const int kb2 = 4 * (128 * j - 128 + 32 * m0) + (r16 & 2), sidx = (r16 & 1);
        const int row = tid >> 4, ch = tid & 15;
        const unsigned gk = (unsigned)WS_B + (((unsigned)tok0 + kb2 + 4 * row) * 3072u + 1024u + h * 128 + ch * 8) * 2u;
        const int lk = row * DKS + ch * 16, lv = 32 * DKS + row * VS + ch * 16;
        const int kread = r32 * DKS + 16 * hh;
        const int vread1 = 32 * DKS + (4 * hh + ((lane & 15) >> 2)) * VS + (16 * ((lane >> 4) & 1) + 4 * (lane & 3)) * 2;
        v4u ra[4], rb[4];
#define P2_LOAD(R, t) do { const unsigned _g = gk + (unsigned)(t) * 128u * 6144u; R[0] = *(const v4u*)(ws + (size_t)_g); R[1] = *(const v4u*)(ws + (size_t)(_g + 2048u)); \
            R[2] = *(const v4u*)(ws + (size_t)(_g + 6144u)); R[3] = *(const v4u*)(ws + (size_t)(_g + 8192u)); } while (0)
#define P2_WRITE(R, t) do { LAS unsigned char* _nb = sh + (((t) & 1) * 2) * DSH; *(LAS v4u*)(_nb + lk) = R[0]; *(LAS v4u*)(_nb + lv) = R[1]; *(LAS v4u*)(_nb + DSH + lk) = R[2]; *(LAS v4u*)(_nb + DSH + lv) = R[3]; } while (0)
#define P2_STEP(mi, RL, RW) do { \
            if ((mi) + 2 < n2) P2_LOAD(RL, (mi) + 2); \
            const LAS unsigned char* tb = sh + (((mi) & 1) * 2 + sidx) * DSH; \
            f32x16 s[1]; \
            _Pragma("unroll") for (int r = 0; r < 16; ++r) s[0][r] = 0.f; \
            _Pragma("unroll") for (int ks = 0; ks < 8; ++ks) { const bf16x8 kf = *(const LAS bf16x8*)(tb + kread + 32 * ks); s[0] = MFMA32(kf, qf[ks], s[0]); } \
            const int d0 = tq - (kb2 + sidx + 128 * (mi)) - 16 * hh; \
            _Pragma("unroll") for (int r = 0; r < 16; ++r) { const int dist = d0 - 4 * ((r & 3) + 8 * (r >> 2)); const float v = s[0][r] - slope2 * (float)dist; s[0][r] = ((unsigned)dist <= 512u) ? v : NEG; } \
            bf16x8 pb[2]; \
            softmax_step<1>(s, m, l, o, pb); \
            pv32(o, tb + vread1, pb[0], pb[1]); \
            if ((mi) + 1 < n2) P2_WRITE(RW, (mi) + 1); \
            __syncthreads(); } while (0)
        P2_LOAD(ra, 0);
        if (n2 > 1) P2_LOAD(rb, 1);
        __syncthreads();
        P2_WRITE(ra, 0);
        __syncthreads();
        for (int mi = 0; mi < n2; mi += 2) { P2_STEP(mi, ra, rb); if (mi + 1 < n2) P2_STEP(mi + 1, rb, ra); }
#undef P2_LOAD
#undef P2_WRITE
#undef P2_STEP
    }
    {
        const int kb0 = 512 * j - 128 + 32 * m0;
        const int row = tid >> 4, ch = tid & 15;
        const unsigned gk = (unsigned)WS_B + (((unsigned)tok0 + kb0 + row) * 3072u + 1024u + h * 128 + ch * 8) * 2u;
        const int lk = row * DKS + ch * 16, lv = 32 * DKS + row * VS + ch * 16;
        const int kread = r32 * DKS + 16 * hh;
        const int vread1 = 32 * DKS + (4 * hh + ((lane & 15) >> 2)) * VS + (16 * ((lane >> 4) & 1) + 4 * (lane & 3)) * 2;
        v4u ra[2], rb[2];
#define P1_LOAD(R, t) do { const unsigned _g = gk + (unsigned)(t) * 32u * 6144u; R[0] = *(const v4u*)(ws + (size_t)_g); R[1] = *(const v4u*)(ws + (size_t)(_g + 2048u)); } while (0)
#define P1_WRITE(R, t) do { LAS unsigned char* _nb = sh + ((t) & 1) * DSH; *(LAS v4u*)(_nb + lk) = R[0]; *(LAS v4u*)(_nb + lv) = R[1]; } while (0)
#define P1_STEP(mi, RL, RW) do { \
            if ((mi) + 2 < n1) P1_LOAD(RL, (mi) + 2); \
            const LAS unsigned char* tb = sh + ((mi) & 1) * DSH; \
            f32x16 s[1]; \
            _Pragma("unroll") for (int r = 0; r < 16; ++r) s[0][r] = 0.f; \
            _Pragma("unroll") for (int ks = 0; ks < 8; ++ks) { const bf16x8 kf = *(const LAS bf16x8*)(tb + kread + 32 * ks); s[0] = MFMA32(kf, qf[ks], s[0]); } \
            const int d0 = tq - (kb0 + 32 * (mi)) - 4 * hh; \
            _Pragma("unroll") for (int r = 0; r < 16; ++r) { const int dist = d0 - ((r & 3) + 8 * (r >> 2)); const float v = s[0][r] - slope2 * (float)dist; s[0][r] = ((unsigned)dist <= 128u) ? v : NEG; } \
            bf16x8 pb[2]; \
            softmax_step<1>(s, m, l, o, pb); \
            pv32(o, tb + vread1, pb[0], pb[1]); \
            if ((mi) + 1 < n1) P1_WRITE(RW, (mi) + 1); \
            __syncthreads(); } while (0)
        P1_LOAD(ra, 0);
        if (n1 > 1) P1_LOAD(rb, 1);
        P1_WRITE(ra, 0);
        __syncthreads();
        for (int mi = 0; mi < n1; mi += 2) { P1_STEP(mi, ra, rb); if (mi + 1 < n1) P1_STEP(mi + 1, rb, ra); }
#undef P1_LOAD
#undef P1_WRITE
#undef P1_STEP
    }
    store_o(o, l, (bf16*)(const_cast<unsigned char*>(ws) + WS_A) + (tok0 + tq) * 2048 + h * 128, (float*)(const_cast<unsigned char*>(ws) + WS_SSQO) + (tok0 + tq) * 16 + h, hh);
}

__device__ __forceinline__ void phase_attn(const Params& P, LAS unsigned char* lds, int vcu, int G, int wave) {
    const int lane = hw_lane(), tid = wave * 64 + lane;
    const unsigned char* ws = P.ws;
#ifndef REP_MLA
#define REP_MLA 1
#endif
#ifndef REP_DIL
#define REP_DIL 1
#endif
    for (int rm_ = 0; rm_ < REP_MLA; ++rm_)
    for (int u = vcu; u < 256; u += G) { const int bh = u >> 2, pr = u & 3;
#ifdef MLA_SHORT_FIRST
        mla_unit(ws, lds, bh >> 3, bh & 7, pr, tid, wave, lane);
        mla_unit(ws, lds, bh >> 3, bh & 7, 7 - pr, tid, wave, lane); }
#else
        mla_unit(ws, lds, bh >> 3, bh & 7, 7 - pr, tid, wave, lane);
        mla_unit(ws, lds, bh >> 3, bh & 7, pr, tid, wave, lane); }
#endif
    __syncthreads();
    LAS unsigned char* vl = lds + wave * (32 * VS); LAS unsigned char* sh = lds;
    for (int rd_ = 0; rd_ < REP_DIL; ++rd_)
#pragma unroll 1
    for (int k = 0; vcu + k * G < 512; ++k) { const int bt = vcu + k * G, bh = bt >> 3; int jj = (bt >> 1) & 3; if (k & 1) jj = 3 - jj;
        dil_tile(ws, vl, sh, bh >> 3, bh & 7, jj, 2 * (bt & 1) + (wave >> 2) + 4 * (wave & 3), tid, lane); }
}
}
namespace peer {
typedef __bf16 bf2_t __attribute__((ext_vector_type(2)));
#define MFMA32(a, b, c) __builtin_amdgcn_mfma_f32_32x32x16_bf16((a), (b), (c), 0, 0, 0)
__device__ __forceinline__ float fmax3(float a, float b, float c) { return fmaxf(fmaxf(a, b), c); }
__device__ __forceinline__ float asf(unsigned u) { return __builtin_bit_cast(float, u); }
__device__ __forceinline__ unsigned asu(float f) { return __builtin_bit_cast(unsigned, f); }

__device__ __forceinline__ void ce_desc(float& a, float& b) { const float hi = fmaxf(a, b), lo = fminf(a, b); a = hi; b = lo; }
template <bool DESC> __device__ __forceinline__ void bitonic_merge16(float (&t)[16]) {
#pragma unroll
    for (int j = 8; j > 0; j >>= 1)
#pragma unroll
        for (int i = 0; i < 16; ++i) { const int l = i ^ j; if (l > i) { if (DESC) ce_desc(t[i], t[l]); else ce_desc(t[l], t[i]); } }
}
__device__ __forceinline__ void top16_of_64(float (&v)[64], float (&out)[16]) {
#pragma unroll
    for (int k = 2; k <= 16; k <<= 1)
#pragma unroll
        for (int j = k >> 1; j > 0; j >>= 1)
#pragma unroll
            for (int i = 0; i < 64; ++i) { const int l = i ^ j; if (l > i) { if ((i & k) == 0) ce_desc(v[i], v[l]); else ce_desc(v[l], v[i]); } }
    float t0[16], t1[16];
#pragma unroll
    for (int i = 0; i < 16; ++i) { t0[i] = fmaxf(v[i], v[16 + i]); t1[i] = fmaxf(v[32 + i], v[48 + i]); }
    bitonic_merge16<true>(t0); bitonic_merge16<false>(t1);
#pragma unroll
    for (int i = 0; i < 16; ++i) out[i] = fmaxf(t0[i], t1[i]);
    bitonic_merge16<true>(out);
}
__device__ __forceinline__ void route_item(const unsigned char* ws, const LAS unsigned char* skl  , LAS unsigned* sc, int tile, int h, int lane) {
    const bf16* QP = (const bf16*)(ws + WS_QP);
    int* RIDX = (int*)(ws + WS_RIDX); float* RGATE = (float*)(ws + WS_RGATE);
    const int r32 = lane & 31, hh = lane >> 5;
    const size_t tok = (size_t)tile * 32 + r32;
    float rs2; { const f32x4* sp = (const f32x4*)((const float*)(ws + WS_SSQH) + tok * 32); f32x4 a = sp[0];
#pragma unroll
        for (int i = 1; i < 8; ++i) a = a + sp[i];
        rs2 = rsqrtf(((a[0] + a[1]) + (a[2] + a[3])) * (1.f / 2048.f) + EPS); }
#pragma unroll 1
    for (int p = 0; p < 2; ++p) {
        f32x16 s[4];
#pragma unroll
        for (int kb = 0; kb < 4; ++kb)
#pragma unroll
            for (int r = 0; r < 16; ++r) s[kb][r] = 0.f;
        const bf16* qp = QP + tok * 2048 + h * 256 + p * 128 + 8 * hh;
        const LAS unsigned char* kp = skl + (p * 128 + r32) * 272 + 16 * hh;
#pragma unroll
        for (int ks = 0; ks < 8; ++ks) { const bf16x8 q = *(const bf16x8*)(qp + 16 * ks);
#pragma unroll
            for (int kb = 0; kb < 4; ++kb) { const bf16x8 k = *(const LAS bf16x8*)(kp + kb * 32 * 272 + 32 * ks); s[kb] = MFMA32(k, q, s[kb]); } }
#pragma unroll
        for (int kb = 0; kb < 4; ++kb)
#pragma unroll
            for (int r = 0; r < 16; ++r) s[kb][r] = asf((asu(s[kb][r] * rs2) & ~127u) | (unsigned)(32 * kb + (r & 3) + 8 * (r >> 2) + 4 * hh));
        {
            float v[64], u[16];
#pragma unroll
            for (int kb = 0; kb < 4; ++kb)
#pragma unroll
                for (int r = 0; r < 16; ++r) v[16 * kb + r] = s[kb][r];
            top16_of_64(v, u);
            float w[16];
#pragma unroll
            for (int i = 0; i < 16; ++i) w[i] = fmaxf(u[i], __shfl_xor(u[15 - i], 32));
            bitonic_merge16<true>(w);
            if (hh == 0) {
#pragma unroll
                for (int i = 0; i < 16; i += 4) *(LAS v4u*)(sc + (p * 32 + r32) * 16 + i) = (v4u){asu(w[i]), asu(w[i + 1]), asu(w[i + 2]), asu(w[i + 3])};
            }
        }
    }
    unsigned t1[16], t2[16];
#pragma unroll
    for (int i = 0; i < 16; i += 4) { const v4u a = *(const LAS v4u*)(sc + r32 * 16 + i), b = *(const LAS v4u*)(sc + (32 + r32) * 16 + i);
        t1[i] = a.x; t1[i + 1] = a.y; t1[i + 2] = a.z; t1[i + 3] = a.w; t2[i] = b.x; t2[i + 1] = b.y; t2[i + 2] = b.z; t2[i + 3] = b.w; }
    float c[64]; int n = 0;
#pragma unroll
    for (int i = 0; i < 16; ++i)
#pragma unroll
        for (int j = 0; j < 16; ++j) if ((i + 1) * (j + 1) <= 16) { const float v = asf(t1[i] & ~127u) + asf(t2[j] & ~127u); c[n] = asf((asu(v) & ~255u) | (unsigned)(i * 16 + j)); ++n; }
#pragma unroll
    for (int q = 50; q < 64; ++q) c[q] = -3.0e38f;
    float top[16];
    top16_of_64(c, top);
    float best[8]; const float bmax = asf(asu(top[0]) & ~255u); float esum = 0.f;
#pragma unroll
    for (int k = 0; k < 16; ++k) { esum += __expf(asf(asu(top[k]) & ~255u) - bmax); if ((k >> 3) == hh) best[k & 7] = top[k]; }
    const float inv = 1.0f / esum;
    int idx[8]; float gate[8];
#pragma unroll
    for (int k = 0; k < 8; ++k) { const unsigned code = asu(best[k]) & 255u; const unsigned a = sc[r32 * 16 + (code >> 4)], b = sc[(32 + r32) * 16 + (code & 15)];
        idx[k] = (int)((a & 127u) * 128u + (b & 127u)); gate[k] = __expf(asf(asu(best[k]) & ~255u) - bmax) * inv; }
    int* ip = RIDX + tok * 128 + h * 16 + 8 * hh; float* gp = RGATE + tok * 128 + h * 16 + 8 * hh;
    *(v4u*)ip = (v4u){(unsigned)idx[0], (unsigned)idx[1], (unsigned)idx[2], (unsigned)idx[3]}; *(v4u*)(ip + 4) = (v4u){(unsigned)idx[4], (unsigned)idx[5], (unsigned)idx[6], (unsigned)idx[7]};
    *(f32x4*)gp = (f32x4){gate[0], gate[1], gate[2], gate[3]}; *(f32x4*)(gp + 4) = (f32x4){gate[4], gate[5], gate[6], gate[7]};
}

__device__ __forceinline__ void phase_route(const Params& P, LAS unsigned char* lds, int vcu, int G, int wave) {
    const int lane = hw_lane();
    LAS unsigned* sc = (LAS unsigned*)(lds + wave * 4096);
    LAS unsigned char* skl = lds + 32768;
    const bool part = (G % 8) == 0;
    const int m = part ? (vcu >> 3) : vcu, nm = part ? (G >> 3) : G;
#pragma unroll 1
    for (int hq = 0; hq < (part ? 1 : 8); ++hq) {
        const int h = part ? (vcu & 7) : hq;
        if (hq) __syncthreads();
        const v4u* src = (const v4u*)((const bf16*)(P.ws + WS_SK) + (size_t)h * 2 * 128 * 128) + (wave * 64 + lane);
        v4u t[8];
#pragma unroll
        for (int j = 0; j < 8; ++j) t[j] = src[512 * j];
#pragma unroll
        for (int j = 0; j < 8; ++j) { const int c = wave * 64 + lane + 512 * j; *(LAS v4u*)(skl + (c >> 4) * 272 + (c & 15) * 16) = t[j]; }
        __syncthreads();
#pragma unroll 1
        for (int tile = m * NWAVES + wave; tile < 512; tile += nm * NWAVES) route_item(P.ws, skl, sc, tile, h, lane);
    }
}

__device__ __forceinline__ float dot16_f8(const float (&x)[16], const v4u& u, float c) {
    const int u0 = (int)u.x, u1 = (int)u.y, u2 = (int)u.z, u3 = (int)u.w;
    const f32x2 a0 = __builtin_amdgcn_cvt_pk_f32_fp8(u0, false), a1 = __builtin_amdgcn_cvt_pk_f32_fp8(u0, true);
    const f32x2 a2 = __builtin_amdgcn_cvt_pk_f32_fp8(u1, false), a3 = __builtin_amdgcn_cvt_pk_f32_fp8(u1, true);
    const f32x2 a4 = __builtin_amdgcn_cvt_pk_f32_fp8(u2, false), a5 = __builtin_amdgcn_cvt_pk_f32_fp8(u2, true);
    const f32x2 a6 = __builtin_amdgcn_cvt_pk_f32_fp8(u3, false), a7 = __builtin_amdgcn_cvt_pk_f32_fp8(u3, true);
    c = fmaf(x[0], a0.x, c); c = fmaf(x[1], a0.y, c); c = fmaf(x[2], a1.x, c); c = fmaf(x[3], a1.y, c);
    c = fmaf(x[4], a2.x, c); c = fmaf(x[5], a2.y, c); c = fmaf(x[6], a3.x, c); c = fmaf(x[7], a3.y, c);
    c = fmaf(x[8], a4.x, c); c = fmaf(x[9], a4.y, c); c = fmaf(x[10], a5.x, c); c = fmaf(x[11], a5.y, c);
    c = fmaf(x[12], a6.x, c); c = fmaf(x[13], a6.y, c); c = fmaf(x[14], a7.x, c); c = fmaf(x[15], a7.y, c);
    return c;
}
__device__ __forceinline__ void unpack8(float* x, const v4u& v) { x[0] = bflo(v.x); x[1] = bfhi(v.x); x[2] = bflo(v.y); x[3] = bfhi(v.y); x[4] = bflo(v.z); x[5] = bfhi(v.z); x[6] = bflo(v.w); x[7] = bfhi(v.w); }
#ifndef U_META_G
#define U_META_G 8
#endif
#ifndef U_WAVES
#define U_WAVES 8
#endif
__device__ __forceinline__ void peer_u_wave(const Params& P, LAS unsigned* sc  , int t0, int tstep, int tend, int lane) {
    const unsigned char* ws = P.ws;
    const bf16* H1B = (const bf16*)(ws + WS_B); const unsigned char* U8 = ws + WS_UB;
    const int* RIDX = (const int*)(ws + WS_RIDX); const float* RGATE = (const float*)(ws + WS_RGATE); const float* SSQH = (const float*)(ws + WS_SSQH);
    const unsigned long long ltmask = (1ull << lane) - 1ull;
    unsigned* PKV = (unsigned*)(ws + WS_PKV);
    if (t0 >= tend) return;
    int i0, i1; float g0, g1, rs2; int xqh[4], xql[4]; float xs;
    int i0n, i1n; float g0n, g1n, ssn; v2u xr[8];
#define PU_META(t) do { const size_t _t = (size_t)(t); const bf16* hp = H1B + _t * 2048 + 4 * lane; _Pragma("unroll") for (int j = 0; j < 8; ++j) xr[j] = *(const v2u*)(hp + 256 * j); \
        ssn = lane < 32 ? SSQH[_t * 32 + lane] : 0.f; i0n = RIDX[_t * 128 + lane]; i1n = RIDX[_t * 128 + 64 + lane]; g0n = RGATE[_t * 128 + lane]; g1n = RGATE[_t * 128 + 64 + lane]; } while (0)
#define PU_SORT() do {   \
        { const int q0 = i0n >> 10, q1 = i1n >> 10; int off = 0, pos0 = 0, pos1 = 0; \
          _Pragma("unroll") for (int gq = 0; gq < 16; ++gq) { const unsigned long long m0 = __ballot(q0 == gq), m1 = __ballot(q1 == gq); const int c0 = __popcll(m0), c1 = __popcll(m1); \
              if (q0 == gq) pos0 = off + __popcll(m0 & ltmask); if (q1 == gq) pos1 = off + c0 + __popcll(m1 & ltmask); off += c0 + c1; } \
          sc[pos0] = (unsigned)i0n; sc[pos1] = (unsigned)i1n; sc[128 + pos0] = asu(g0n); sc[128 + pos1] = asu(g1n); \
          i0n = (int)sc[lane]; i1n = (int)sc[64 + lane]; g0n = asf(sc[128 + lane]); g1n = asf(sc[192 + lane]); } } while (0)
#define PU_SWAP() do { i0 = i0n; i1 = i1n; g0 = g0n; g1 = g1n; \
        { float _x[32]; _Pragma("unroll") for (int j = 0; j < 8; ++j) { _x[4 * j] = bflo(xr[j].x); _x[4 * j + 1] = bfhi(xr[j].x); _x[4 * j + 2] = bflo(xr[j].y); _x[4 * j + 3] = bfhi(xr[j].y); } \
          float _am = 0.f; _Pragma("unroll") for (int k = 0; k < 32; ++k) _am = fmaxf(_am, fabsf(_x[k])); \
          const float _inv = _am > 0.f ? 119.0f / _am : 0.f; xs = _am * (1.0f / 119.0f); \
          _Pragma("unroll") for (int d = 0; d < 4; ++d) { unsigned _h = 0u, _l = 0u; \
              _Pragma("unroll") for (int n = 0; n < 8; ++n) { const int q = (int)__builtin_rintf(_x[8 * d + n] * _inv), qh = (q + 8) >> 4, ql = q - 16 * qh; \
                  _h |= ((unsigned)qh & 15u) << (4 * n); _l |= ((unsigned)ql & 15u) << (4 * n); } \
              xqh[d] = (int)_h; xql[d] = (int)_l; } } \
        rs2 = rsqrtf(wave_sum(ssn) * (1.f / 2048.f) + EPS) * (1.f / U6_SCALE); } while (0)
#define PU_LOAD(buf4, buf2, ia, ib, g) do { _Pragma("unroll") for (int e = 0; e < 8; ++e) { const int row = __builtin_amdgcn_readlane((g) < 8 ? ia : ib, ((g) & 7) * 8 + e); \
        buf4[e] = *(const v4u*)(U8 + (size_t)row * 1024 + 16 * lane); } } while (0)
#define PU_COMPUTE(buf4, buf2, g) do { float pt[8]; _Pragma("unroll") for (int e = 0; e < 8; ++e) { \
            int sh = 0, sl = 0;                                               \
            _Pragma("unroll") for (int d = 0; d < 4; ++d) { const int w = (int)buf4[e][d]; sh = __builtin_amdgcn_sdot8(w, xqh[d], sh, false); sl = __builtin_amdgcn_sdot8(w, xql[d], sl, false); } \
            pt[e] = (float)(16 * sh + sl) * xs; } \
        float a4[4], a2[2], a1; \
        _Pragma("unroll") for (int i = 0; i < 4; ++i) { const float keep = (lane & 1) ? pt[2 * i + 1] : pt[2 * i], give = (lane & 1) ? pt[2 * i] : pt[2 * i + 1]; a4[i] = keep + __shfl_xor(give, 1); } \
        _Pragma("unroll") for (int i = 0; i < 2; ++i) { const float keep = (lane & 2) ? a4[2 * i + 1] : a4[2 * i], give = (lane & 2) ? a4[2 * i] : a4[2 * i + 1]; a2[i] = keep + __shfl_xor(give, 2); } \
        { const float keep = (lane & 4) ? a2[1] : a2[0], give = (lane & 4) ? a2[0] : a2[1]; a1 = keep + __shfl_xor(give, 4); } \
        a1 += __shfl_xor(a1, 8); a1 += __shfl_xor(a1, 16); a1 += __shfl_xor(a1, 32); \
        if ((lane >> 3) == ((g) & 7)) { if ((g) < 8) d0 = a1; else d1 = a1; } } while (0)
    v4u ra4[8], rb4[8], rc4[8], rd4[8];
    PU_META(t0); PU_SORT(); PU_SWAP();
    PU_LOAD(ra4, 0, i0, i1, 0); PU_LOAD(rb4, 0, i0, i1, 1); PU_LOAD(rc4, 0, i0, i1, 2);
#pragma unroll 1
    for (int t = t0; t < tend; t += tstep) {
        const bool more = t + tstep < tend;
        float d0 = 0.f, d1 = 0.f;
#pragma unroll 1
        for (int g = 0; g < 16; g += 4) {
            PU_LOAD(rd4, 0, i0, i1, g + 3);
            if (g == U_META_G && more) PU_META(t + tstep);
            PU_COMPUTE(ra4, 0, g);
            if (g + 4 < 16) PU_LOAD(ra4, 0, i0, i1, g + 4); else if (more) { PU_SORT(); PU_LOAD(ra4, 0, i0n, i1n, 0); }
            PU_COMPUTE(rb4, 0, g + 1);
            if (g + 4 < 16) PU_LOAD(rb4, 0, i0, i1, g + 5); else if (more) PU_LOAD(rb4, 0, i0n, i1n, 1);
            PU_COMPUTE(rc4, 0, g + 2);
            if (g + 4 < 16) PU_LOAD(rc4, 0, i0, i1, g + 6); else if (more) PU_LOAD(rc4, 0, i0n, i1n, 2);
            PU_COMPUTE(rd4, 0, g + 3);
        }
        const size_t tok = (size_t)t;
        const float z0 = d0 * rs2, z1 = d1 * rs2;
        const float a0 = 8.0f * z0 * (1.0f + erff(z0 * 0.7071067811865476f)) * g0, a1v = 8.0f * z1 * (1.0f + erff(z1 * 0.7071067811865476f)) * g1;
        unsigned* pk = PKV + ((tok >> 6) * 128) * 64 + (tok & 63) * 4;
        pk[(size_t)(lane >> 2) * 256 + (lane & 3)] = ((unsigned)i0 << 3) | (((unsigned)__builtin_bit_cast(unsigned short, (_Float16)a0) & 0xfffeu) << 16);
        pk[(size_t)(16 + (lane >> 2)) * 256 + (lane & 3)] = ((unsigned)i1 << 3) | (((unsigned)__builtin_bit_cast(unsigned short, (_Float16)a1v) & 0xfffeu) << 16);
        if (more) PU_SWAP();
    }
#undef PU_META
#undef PU_SORT
#undef PU_SWAP
#undef PU_LOAD
#undef PU_COMPUTE
}
__device__ __forceinline__ void phase_peer_u(const Params& P, LAS unsigned char* lds, int vcu, int G, int wave) {
    const int lane = hw_lane();
    if (wave >= U_WAVES) return;
    peer_u_wave(P, (LAS unsigned*)(lds + wave * 1024), vcu * U_WAVES + wave, G * U_WAVES, M, lane);
}
__device__ __forceinline__ void peer_v_range(const Params& P, int c, int b0, int b1, int wv, int nwv, int lane) {
    const unsigned char* ws = P.ws;
    const bf16* H1B = (const bf16*)(ws + WS_B); const unsigned* PKV = (const unsigned*)(ws + WS_PKV);
    if (b0 + wv >= b1) return;
    unsigned w0[16], w1[16], w2[16], w3[16];
#define PV_LOAD(buf) do { _Pragma("unroll") for (int q = 0; q < 4; ++q) { const v4u t4 = pl[q * 64]; buf[4 * q] = t4.x; buf[4 * q + 1] = t4.y; buf[4 * q + 2] = t4.z; buf[4 * q + 3] = t4.w; } pl += 4 * 64; asm volatile("" : "+v"(pl)); } while (0)
#define PV_F4(w, s) __builtin_bit_cast(h2_t, __builtin_amdgcn_cvt_scalef32_pk_f16_fp4((w), 1.0f, (s)))
#define PV_READ8(vv, buf, o) do { _Pragma("unroll") for (int i = 0; i < 8; ++i) vv[i] = *(const LAS v2u*)(size_t)(buf[(o) + i] & 0x1fff8u); } while (0)
#define PV_MATH8(vv, buf, o) do { _Pragma("unroll") for (int i = 0; i < 8; ++i) { const _Float16 ah = __builtin_bit_cast(_Float16, (unsigned short)(buf[(o) + i] >> 16)); const h2_t a2 = {ah, ah}; \
            y0 = __builtin_elementwise_fma(a2, PV_F4(vv[i].x, 0), y0); y1 = __builtin_elementwise_fma(a2, PV_F4(vv[i].x, 1), y1); \
            y2 = __builtin_elementwise_fma(a2, PV_F4(vv[i].x, 2), y2); y3 = __builtin_elementwise_fma(a2, PV_F4(vv[i].x, 3), y3); \
            y4 = __builtin_elementwise_fma(a2, PV_F4(vv[i].y, 0), y4); y5 = __builtin_elementwise_fma(a2, PV_F4(vv[i].y, 1), y5); \
            y6 = __builtin_elementwise_fma(a2, PV_F4(vv[i].y, 2), y6); y7 = __builtin_elementwise_fma(a2, PV_F4(vv[i].y, 3), y7); } } while (0)
#define PV_CHUNK(buf, nbuf) do { PV_READ8(vvb, buf, 8); PV_MATH8(vva, buf, 0); PV_READ8(vva, nbuf, 0); PV_MATH8(vvb, buf, 8); } while (0)
    v2u vva[8], vvb[8];
    const GAS v4u* pl = (const GAS v4u*)PKV + (size_t)(b0 + wv) * 32 * 64 + lane;
    PV_LOAD(w0); PV_LOAD(w1); PV_LOAD(w2);
    PV_READ8(vva, w0, 0);
    const v4u* hp0 = (const v4u*)(H1B + ((size_t)(b0 + wv) * 64 + lane) * 2048 + 16 * c);
    v4u hxn = hp0[0], hxn2 = hp0[1];
#pragma unroll 1
    for (int b = b0 + wv; b < b1; b += nwv) {
        const size_t tok = (size_t)b * 64 + lane;
        const int bn = (b + nwv < b1) ? b + nwv : b;
        h2_t y0 = {0, 0}, y1 = {0, 0}, y2 = {0, 0}, y3 = {0, 0}, y4 = {0, 0}, y5 = {0, 0}, y6 = {0, 0}, y7 = {0, 0};
        const v4u hx = hxn, hx2 = hxn2;
        { const v4u* hp = (const v4u*)(H1B + ((size_t)bn * 64 + lane) * 2048 + 16 * c); hxn = hp[0]; hxn2 = hp[1]; }
        PV_LOAD(w3); PV_CHUNK(w0, w1);
        PV_LOAD(w0); PV_CHUNK(w1, w2);
        PV_LOAD(w1); PV_CHUNK(w2, w3);
        PV_LOAD(w2); PV_CHUNK(w3, w0);
        PV_LOAD(w3); PV_CHUNK(w0, w1);
        pl += (ptrdiff_t)(bn - b - 1) * 32 * 64;
        PV_LOAD(w0); PV_CHUNK(w1, w2);
        PV_LOAD(w1); PV_CHUNK(w2, w3);
        PV_LOAD(w2); PV_CHUNK(w3, w0);
        float y[16]; unpack8(y, hx); unpack8(y + 8, hx2);
        constexpr float S = 1.0f / 64.0f;
        y[0] += S * (float)y0[0]; y[1] += S * (float)y0[1]; y[2] += S * (float)y1[0]; y[3] += S * (float)y1[1];
        y[4] += S * (float)y2[0]; y[5] += S * (float)y2[1]; y[6] += S * (float)y3[0]; y[7] += S * (float)y3[1];
        y[8] += S * (float)y4[0]; y[9] += S * (float)y4[1]; y[10] += S * (float)y5[0]; y[11] += S * (float)y5[1];
        y[12] += S * (float)y6[0]; y[13] += S * (float)y6[1]; y[14] += S * (float)y7[0]; y[15] += S * (float)y7[1];
        v4u* op = (v4u*)((bf16*)(const_cast<unsigned char*>(ws) + WS_A) + tok * 2048 + 16 * c);
        op[0] = (v4u){pk2(y[0], y[1]), pk2(y[2], y[3]), pk2(y[4], y[5]), pk2(y[6], y[7])}; op[1] = (v4u){pk2(y[8], y[9]), pk2(y[10], y[11]), pk2(y[12], y[13]), pk2(y[14], y[15])};
    }
#undef PV_LOAD
#undef PV_READ8
#undef PV_MATH8
#undef PV_CHUNK
#undef PV_F4
}
__device__ __forceinline__ void peer_v_fill(const Params& P, int c, int tid) {
    const v4u* src = (const v4u*)(P.ws + WS_VB + (size_t)c * 131072);
#pragma unroll 4
    for (int i = tid; i < 8192; i += NTHREADS) *(LAS v4u*)(size_t)(16 * i) = src[i];
}
__device__ __forceinline__ void phase_final(const Params& P, int vcu, int G, int wave) {
    const int lane = hw_lane();
    const bool poison = __hip_atomic_load((const unsigned*)(P.ws + WS_CTL) + CW_FLAG, __ATOMIC_RELAXED, __HIP_MEMORY_SCOPE_AGENT) != 0u;
    f32x4 gv[8];
#pragma unroll
    for (int j = 0; j < 8; ++j) gv[j] = ((const f32x4*)P.lnf)[lane + 64 * j];
#pragma unroll 1
    for (int t = vcu * NWAVES + wave; t < M; t += G * NWAVES) {
        const v2u* hrow = (const v2u*)((const bf16*)(P.ws + WS_A) + (size_t)t * 2048) + lane;
        f32x4* row = (f32x4*)(P.out + (size_t)t * 2048) + lane;
        f32x4 v[8]; float s = 0.f;
#pragma unroll
        for (int j = 0; j < 8; ++j) { const v2u h = hrow[64 * j]; v[j] = (f32x4){bflo(h.x), bfhi(h.x), bflo(h.y), bfhi(h.y)}; s += (v[j].x * v[j].x + v[j].y * v[j].y) + (v[j].z * v[j].z + v[j].w * v[j].w); }
        const float rs = poison ? __builtin_nanf("") : rsqrtf(wave_sum(s) * (1.f / 2048.f) + EPS);
#pragma unroll
        for (int j = 0; j < 8; ++j) row[64 * j] = v[j] * rs * gv[j];
    }
}
#undef MFMA32
}
#define XB_TMO      128
#define XB_XCNT(j)  (256  + 64 * (j))
#define XB_XSUB(j)  (1280 + 64 * (j))
#define XB_XGEN(j)  (2304 + 64 * (j))
#define XB_TOP      3328
#define XB_TOPGEN   3392
#define XCD_BAR_WORDS 3456
#define XB_SPIN_CAP (1u << 22)
__device__ __forceinline__ unsigned xb_ld(unsigned* p)              { return __hip_atomic_load(p, __ATOMIC_RELAXED, __HIP_MEMORY_SCOPE_AGENT); }
__device__ __forceinline__ unsigned xb_add(unsigned* p, unsigned v) { return __hip_atomic_fetch_add(p, v, __ATOMIC_RELAXED, __HIP_MEMORY_SCOPE_AGENT); }
__device__ __forceinline__ unsigned xb_xcc_id() { return (unsigned)__builtin_amdgcn_s_getreg((3 << 11) | 20) & 0xFu; }
#ifndef XB_SLEEP
#define XB_SLEEP 1
#endif
#define XB_SPIN(cond, bar) do { unsigned _sp = 0; while (cond) { __builtin_amdgcn_s_sleep(XB_SLEEP); \
    if ((++_sp & 255u) == 0u) { if (xb_ld(&(bar)[XB_TMO])) break; if (_sp > XB_SPIN_CAP) { atomicAdd(&(bar)[XB_TMO], 1u); break; } } } } while (0)
struct XcdBarrier { unsigned* bar; unsigned x; volatile LAS unsigned* st; };
__device__ __forceinline__ XcdBarrier xcd_barrier_post(unsigned* bar, volatile LAS unsigned* st, bool leader) {
    XcdBarrier b; b.bar = bar; b.x = xb_xcc_id(); b.st = st;
    if (leader) (void)xb_add(&bar[XB_XCNT(b.x)], 1u);
    return b;
}
__device__ __forceinline__ void xcd_barrier_complete(unsigned* bar, unsigned x, unsigned& nloc, unsigned& nx) {
    const unsigned G = gridDim.x * gridDim.y * gridDim.z;
    unsigned sum, cnt, mine, sp = 0u;
    for (;;) {
        sum = 0u; cnt = 0u; mine = 0u;
#pragma unroll
        for (unsigned j = 0; j < 16; ++j) { const unsigned c = xb_ld(&bar[XB_XCNT(j)]); sum += c; cnt += (c > 0u) ? 1u : 0u; mine = (j == x) ? c : mine; }
        if (sum == G) break;
        __builtin_amdgcn_s_sleep(1);
        if ((++sp & 255u) == 0u) { if (xb_ld(&bar[XB_TMO])) break; if (sp > XB_SPIN_CAP) { atomicAdd(&bar[XB_TMO], 1u); break; } }
    }
    nloc = mine > 0u ? mine : 1u; nx = cnt > 0u ? cnt : 1u;
}
__device__ __forceinline__ void xcd_barrier(const XcdBarrier& b, int wave) {
    asm volatile("s_waitcnt vmcnt(0)" ::: "memory");
    __syncthreads();
    if (wave == 0 && hw_lane() == 0) {
        unsigned* bar = b.bar;
        __builtin_amdgcn_s_waitcnt(0);
        unsigned nloc = b.st[0], nx = b.st[1];
        if (nloc == 0u) { xcd_barrier_complete(bar, b.x, nloc, nx); b.st[0] = nloc; b.st[1] = nx; }
        const unsigned old = xb_add(&bar[XB_XSUB(b.x)], 1u);
        const unsigned gen = old / nloc;
        if (old + 1u == (gen + 1u) * nloc) {
            __builtin_amdgcn_fence(__ATOMIC_RELEASE, "agent");
            asm volatile("s_waitcnt vmcnt(0)" ::: "memory");
            const unsigned og = xb_add(&bar[XB_TOP], 1u);
            const unsigned tg = og / nx;
            if (og + 1u == (tg + 1u) * nx) xb_add(&bar[XB_TOPGEN], 1u);
            else XB_SPIN(xb_ld(&bar[XB_TOPGEN]) == tg, bar);
            __builtin_amdgcn_fence(__ATOMIC_ACQUIRE, "agent");
            xb_add(&bar[XB_XGEN(b.x)], 1u);
            asm volatile("s_waitcnt vmcnt(0)" ::: "memory");
        } else {
            XB_SPIN(xb_ld(&bar[XB_XGEN(b.x)]) == gen, bar);
            __builtin_amdgcn_fence(__ATOMIC_ACQUIRE, "agent");
            asm volatile("s_waitcnt vmcnt(0)" ::: "memory");
        }
    }
    __syncthreads();
}
constexpr int N_PHASES = 10;
#ifndef REP_PHASE
#define REP_PHASE -1
#endif
#ifndef REP_N
#define REP_N 1
#endif
#ifndef EXTRA_SYNCS
#define EXTRA_SYNCS 0
#endif
__global__ void __launch_bounds__(NTHREADS, 2) mega(Params P) {
    extern __shared__ __attribute__((aligned(16))) unsigned char lds_raw[];
    LAS unsigned char* lds = (LAS unsigned char*)lds_raw;
    cg::grid_group grid = cg::this_grid();
    const int wave = __builtin_amdgcn_readfirstlane((int)threadIdx.x >> 6);
    const int G = gridDim.x, bx = blockIdx.x;
    const int vcu = (G % 8 == 0) ? (bx % 8) * (G / 8) + bx / 8 : bx;
    unsigned char* ws = P.ws;
    const int lo = P.ph_lo, hi = P.ph_hi;
#define IN(k) (lo <= (k) && (k) < hi)
#ifndef V_MAP_XCD
#define V_MAP_XCD 0
#endif
#ifndef WGM1
#define WGM1 4
#endif
#ifndef WGM2
#define WGM2 2
#endif
#ifndef WGM3
#define WGM3 2
#endif
#ifndef WGM4
#define WGM4 2
#endif
#ifndef CG_SEAMS
#define CG_SEAMS 0
#endif
    volatile LAS unsigned* xbst = (volatile LAS unsigned*)(lds + MISC_OFF + 8192);
    if (wave == 0 && hw_lane() == 0) { xbst[0] = 0u; xbst[1] = 0u; xbst[2] = 0u; xbst[3] = 0u; }
    __syncthreads();
    if (bx == 0) {
        unsigned* ctl = (unsigned*)(ws + WS_CTL) + (wave * 64 + hw_lane());
#pragma unroll
        for (int j = 0; j < CTL_ZERO_BYTES / 4 / NTHREADS; ++j) __hip_atomic_store(ctl + j * NTHREADS, 0u, __ATOMIC_RELAXED, __HIP_MEMORY_SCOPE_AGENT);
        __threadfence();
    }
    grid.sync();
#ifdef EXTRA_CG
    for (int i_ = 0; i_ < EXTRA_CG; ++i_) grid.sync();
#endif
    const XcdBarrier xbar = xcd_barrier_post((unsigned*)(ws + WS_CTL) + 4096, xbst, wave == 0 && hw_lane() == 0);
#define GSYNC(k) do { if ((k) < CG_SEAMS) grid.sync(); else xcd_barrier(xbar, wave); } while (0)
#define SEAM(k) do { if (IN(k) && IN((k) + 1)) GSYNC(k); } while (0)

    for (int rep_ = 0; rep_ < (REP_PHASE == 0 ? 1 + REP_N : 1); ++rep_) if (IN(0)) { if (rep_) GSYNC(9); phase_prep(P, lds, vcu, G, wave, rep_ ? PREP_ONLY : -1); }
#ifdef EXTRA_PREP
    if (IN(0)) { GSYNC(9); phase_prep(P, lds, vcu, G, wave, EXTRA_PREP); GSYNC(9); phase_prep(P, lds, vcu, G, wave, EXTRA_PREP); }
#endif
    SEAM(0);
    for (int es_ = 0; es_ < EXTRA_SYNCS; ++es_) GSYNC(9);
    for (int rep_ = 0; rep_ < (REP_PHASE == 1 ? 1 + REP_N : 1); ++rep_) if (IN(1)) { if (rep_) GSYNC(9);
        pg8::GemmSet g; g.dummy = (unsigned*)(ws + WS_CTL + 65536) + bx * NTHREADS; g.A0 = g.A1 = (const bf16*)(ws + WS_A); g.Bt0 = g.Bt1 = (const bf16*)(ws + WS_BT1); g.K = 2048;
        pg8::StaticOrder S; S.init(M, 4096, 0, G, bx, WGM1);
        pg8::Epi1 E{(bf16*)(ws + WS_B), (bf16*)(ws + WS_CQ), (bf16*)(ws + WS_CKV), (float*)(ws + WS_SSQCQ), (float*)(ws + WS_SSQCKV), lds + TR_OFF};
        pg8::gemm_phase<pg8::Epi1, pg8::StaticOrder>(lds, g, S, E, wave);
    }
#ifdef EXTRA_G1
    if (IN(1)) { GSYNC(9);
        pg8::GemmSet g; g.dummy = (unsigned*)(ws + WS_CTL + 65536) + bx * NTHREADS; g.A0 = g.A1 = (const bf16*)(ws + WS_A); g.Bt0 = g.Bt1 = (const bf16*)(ws + WS_BT1); g.K = 2048;
        pg8::ForcedOrder S; S.S.init(M, 4096, 0, G, bx); S.mmask = (EXTRA_G1 & 1) ? 0 : ~0; S.nmask = (EXTRA_G1 & 2) ? 0 : ~0;
        pg8::EpiNull E{}; pg8::gemm_phase<pg8::EpiNull, pg8::ForcedOrder>(lds, g, S, E, wave);
    }
#endif
    SEAM(1);
    for (int rep_ = 0; rep_ < (REP_PHASE == 2 ? 1 + REP_N : 1); ++rep_) if (IN(2)) { if (rep_) GSYNC(9);
#ifndef KPE_REP
#define KPE_REP 1
#endif
        const bool kbal = (G == 256);
        for (int kr_ = 0; kr_ < KPE_REP; ++kr_)
        for (int it = kbal ? 2 * (bx - 128) : bx, ke = kbal ? it + 2 : 256; it >= 0 && it < ke; it += kbal ? 1 : G) kr_item64((const bf16*)(ws + WS_A), (const bf16*)(ws + WS_BTKR), (const f32x2*)(ws + WS_ROPE), (bf16*)(ws + WS_KPE), (LAS f32x4*)lds, it, wave, hw_lane());
        pg8::GemmSet g; g.dummy = (unsigned*)(ws + WS_CTL + 65536) + bx * NTHREADS; g.A0 = (const bf16*)(ws + WS_CQ); g.A1 = (const bf16*)(ws + WS_CKV); g.Bt0 = (const bf16*)(ws + WS_BT2Q); g.Bt1 = (const bf16*)(ws + WS_BT2KV); g.K = 512;
        pg8::StaticOrder S; S.init(M, 1536, 2048, G, bx, WGM2);
        pg8::Epi2 E{(bf16*)(ws + WS_QN), (bf16*)(ws + WS_QPE), (bf16*)(ws + WS_KN), (bf16*)(ws + WS_VM), (const float*)(ws + WS_SSQCQ), (const float*)(ws + WS_SSQCKV), (const f32x2*)(ws + WS_ROPE), (LAS float*)(lds + MISC_OFF), lds + TR_OFF};
        pg8::gemm_phase<pg8::Epi2, pg8::StaticOrder>(lds, g, S, E, wave);
    }
#ifdef EXTRA_G2
    if (IN(2)) { GSYNC(9);
        pg8::GemmSet g; g.dummy = (unsigned*)(ws + WS_CTL + 65536) + bx * NTHREADS; g.A0 = (const bf16*)(ws + WS_CQ); g.A1 = (const bf16*)(ws + WS_CKV); g.Bt0 = (const bf16*)(ws + WS_BT2Q); g.Bt1 = (const bf16*)(ws + WS_BT2KV); g.K = 512;
        pg8::StaticOrder S; S.init(M, 1536, 2048, G, bx);
#if EXTRA_G2 == 1
        pg8::Epi2 E{(bf16*)(ws + WS_QN), (bf16*)(ws + WS_QPE), (bf16*)(ws + WS_KN), (bf16*)(ws + WS_VM), (const float*)(ws + WS_SSQCQ), (const float*)(ws + WS_SSQCKV), (const f32x2*)(ws + WS_ROPE), (LAS float*)(lds + MISC_OFF), lds + TR_OFF};
        pg8::gemm_phase<pg8::Epi2, pg8::StaticOrder>(lds, g, S, E, wave);
#else
        pg8::EpiNull E{}; pg8::gemm_phase<pg8::EpiNull, pg8::StaticOrder>(lds, g, S, E, wave);
#endif
    }
#endif
    SEAM(2);
    for (int rep_ = 0; rep_ < (REP_PHASE == 3 ? 1 + REP_N : 1); ++rep_) if (IN(3)) { if (rep_) GSYNC(9); att::phase_attn(P, lds, vcu, G, wave); }
    SEAM(3);
    for (int rep_ = 0; rep_ < (REP_PHASE == 4 ? 1 + REP_N : 1); ++rep_) if (IN(4)) { if (rep_) GSYNC(9);
        pg8::GemmSet g; g.dummy = (unsigned*)(ws + WS_CTL + 65536) + bx * NTHREADS; g.A0 = g.A1 = (const bf16*)(ws + WS_A); g.Bt0 = g.Bt1 = (const bf16*)(ws + WS_BT3); g.K = 2048;
        pg8::StaticOrder S; S.init(M, 2048, 0, G, bx, WGM3);
        pg8::Epi3 E{(bf16*)(ws + WS_B), P.x, (const float*)(ws + WS_SSQO), (float*)(ws + WS_SSQH), (LAS f32x2*)(lds + MISC_OFF), lds + TR_OFF};
        pg8::gemm_phase<pg8::Epi3, pg8::StaticOrder>(lds, g, S, E, wave);
    }
    SEAM(4);
    for (int rep_ = 0; rep_ < (REP_PHASE == 5 ? 1 + REP_N : 1); ++rep_) if (IN(5)) { if (rep_) GSYNC(9);
        pg8::GemmSet g; g.dummy = (unsigned*)(ws + WS_CTL + 65536) + bx * NTHREADS; g.A0 = g.A1 = (const bf16*)(ws + WS_B); g.Bt0 = g.Bt1 = (const bf16*)(ws + WS_BT4); g.K = 2048;
        pg8::StaticOrder S; S.init(M, 2048, 0, G, bx, WGM4);
        pg8::Epi4 E{(bf16*)(ws + WS_QP), lds + TR_OFF};
        pg8::gemm_phase<pg8::Epi4, pg8::StaticOrder>(lds, g, S, E, wave);
    }
#ifdef EXTRA_G4
    if (IN(5)) { GSYNC(9);
        pg8::GemmSet g; g.dummy = (unsigned*)(ws + WS_CTL + 65536) + bx * NTHREADS; g.A0 = g.A1 = (const bf16*)(ws + WS_B); g.Bt0 = g.Bt1 = (const bf16*)(ws + WS_BT4); g.K = 2048;
        pg8::StaticOrder S; S.init(M, 2048, 0, G, bx);
#if EXTRA_G4 == 1
        pg8::Epi4 E{(bf16*)(ws + WS_QP), lds + TR_OFF}; pg8::gemm_phase<pg8::Epi4, pg8::StaticOrder>(lds, g, S, E, wave);
#elif EXTRA_G4 == 5
        pg8::EpiNoStoreT E{lds + TR_OFF}; pg8::gemm_phase<pg8::EpiNoStoreT, pg8::StaticOrder>(lds, g, S, E, wave);
#elif EXTRA_G4 == 4
        pg8::EpiSmallT E{(bf16*)(ws + WS_A), lds + TR_OFF}; pg8::gemm_phase<pg8::EpiSmallT, pg8::StaticOrder>(lds, g, S, E, wave);
#elif EXTRA_G4 == 3
        pg8::EpiSmall E{(bf16*)(ws + WS_A)}; pg8::gemm_phase<pg8::EpiSmall, pg8::StaticOrder>(lds, g, S, E, wave);
#else
        pg8::EpiNull E{}; pg8::gemm_phase<pg8::EpiNull, pg8::StaticOrder>(lds, g, S, E, wave);
#endif
    }
#endif
    SEAM(5);
    for (int rep_ = 0; rep_ < (REP_PHASE == 6 ? 1 + REP_N : 1); ++rep_) if (IN(6)) { if (rep_) GSYNC(9); peer::phase_route(P, lds, vcu, G, wave); }
    SEAM(6);
    for (int rep_ = 0; rep_ < (REP_PHASE == 7 ? 1 + REP_N : 1); ++rep_) if (IN(7)) { if (rep_) GSYNC(9); peer::phase_peer_u(P, lds, vcu, G, wave); }
    SEAM(7);
    for (int rep_ = 0; rep_ < (REP_PHASE == 8 ? 1 + REP_N : 1); ++rep_) if (IN(8)) { if (rep_) GSYNC(9);
        const int lane_ = hw_lane();
        for (int it = vcu; it < 256; it += G) { const int c = V_MAP_XCD ? it & 127 : it >> 1, hf = V_MAP_XCD ? it >> 7 : it & 1; __syncthreads(); peer::peer_v_fill(P, c, wave * 64 + lane_); __syncthreads(); peer::peer_v_range(P, c, 128 * hf, 128 * hf + 128, wave, NWAVES, lane_); }
    }
    SEAM(8);
    for (int rep_ = 0; rep_ < (REP_PHASE == 9 ? 1 + REP_N : 1); ++rep_) if (IN(9)) { if (rep_) GSYNC(9); peer::phase_final(P, vcu, G, wave); }
#undef IN
#undef SEAM
}

static int mega_grid() {
    static int grid = 0;
    if (grid == 0) {
        int dev = 0, cus = 0, per_cu = 0;
        (void)hipGetDevice(&dev); (void)hipDeviceGetAttribute(&cus, hipDeviceAttributeMultiprocessorCount, dev);
        (void)hipFuncSetAttribute((const void*)mega, hipFuncAttributeMaxDynamicSharedMemorySize, LDS_BYTES);
        (void)hipOccupancyMaxActiveBlocksPerMultiprocessor(&per_cu, (const void*)mega, NTHREADS, LDS_BYTES);
        if (per_cu < 1) { fprintf(stderr, "mega: occupancy query says %d blocks/CU\n", per_cu); per_cu = 1; }
        grid = cus;
        (void)hipGetLastError();
    }
    return grid;
}
static void fill_params(Params& P, void* const* d_in, void* d_out, void* d_ws) {
    P.x = (const float*)d_in[0]; P.ln1 = (const float*)d_in[1]; P.w_in = (const float*)d_in[2]; P.qan = (const float*)d_in[3]; P.kvan = (const float*)d_in[4];
    P.w_uq = (const float*)d_in[5]; P.w_ukv = (const float*)d_in[6]; P.ond = (const float*)d_in[7]; P.onm = (const float*)d_in[8]; P.w_o = (const float*)d_in[9];
    P.ln2 = (const float*)d_in[10]; P.wq = (const float*)d_in[11]; P.sk = (const float*)d_in[12]; P.pu = (const float*)d_in[13]; P.pv = (const float*)d_in[14]; P.lnf = (const float*)d_in[15];
    P.out = (float*)d_out; P.ws = (unsigned char*)d_ws;
}
static void launch_phases(Params P, int lo, int hi, hipStream_t st) {
    P.ph_lo = lo; P.ph_hi = hi;
    void* args[] = {&P};
    hipError_t e = hipLaunchCooperativeKernel((const void*)mega, dim3(mega_grid()), dim3(NTHREADS), args, LDS_BYTES, st);
    if (e != hipSuccess) fprintf(stderr, "mega launch [%d,%d) failed: %s\n", lo, hi, hipGetErrorString(e));
}
extern "C" void kernel_launch(void* const* d_in, const int* in_sizes, int n_in, void* d_out, int out_size, void* d_ws, size_t ws_size, hipStream_t stream) {
    Params P{}; fill_params(P, d_in, d_out, d_ws);
    launch_phases(P, 0, N_PHASES, stream);
}
```
